# Optimizing an MI355X kernel written in HIP

```python
import math
import jax, jax.numpy as jnp
from jax import lax
import numpy as np

D_MODEL = 1024
BATCH = 1
SEQ = 16384
DEPTH = 2
DEC_BATCH = 8
DEC_SEQ = 4096
PAST_LEN = 128

HEAD_DIM = 64
BLOCK = 128
EPS = 1e-6
SUBLN_EPS = 1e-5
NEG = -1e30
A_HEADS = 4
A_KV_HEADS = 2
A_WINDOW = 128
B_HEADS = 4
B_VDIM = 2 * HEAD_DIM
C_PAIRS = ((128, 1), (512, 4), (2048, 16))
C_GROUPS = 3
C_HEADS = 4
C_SIDE = 64
C_REACH = 1024
D_FF = 2816
CONV_W = 3
A_Q = A_HEADS * HEAD_DIM
A_KV = A_KV_HEADS * HEAD_DIM
B_QK = B_HEADS * 2 * HEAD_DIM
B_V = B_HEADS * B_VDIM
C_QKV = C_GROUPS * C_HEADS * HEAD_DIM
D_IN = A_Q + 2 * A_KV + 2 * B_QK + B_V + 3 * C_QKV
D_MIX = A_Q + B_V + C_HEADS * HEAD_DIM

kernel_name = "hymba_style_hybrid_encoder"


def rmsnorm(x, g, eps=EPS):
    xf = x.astype(jnp.float32)
    y = xf * lax.rsqrt(jnp.mean(xf * xf, axis=-1, keepdims=True) + eps)
    return (y * g.astype(jnp.float32)).astype(x.dtype)


def alibi_slopes(n):
    return jnp.asarray(2.0 ** (-8.0 * np.arange(1, n + 1) / n), dtype=jnp.float32)


def c_offsets():
    return jnp.asarray(np.stack([d * np.arange(-(w // (2 * d)), w // (2 * d) + 1) for (w, d) in C_PAIRS]), dtype=jnp.int32)


def window_gqa_sink(q, k, v, sink):
    B, S = q.shape[0], q.shape[1]
    nb = S // BLOCK
    g = A_HEADS // A_KV_HEADS
    scale = HEAD_DIM ** -0.5
    qb = q.astype(jnp.float32).reshape(B, nb, BLOCK, A_KV_HEADS, g, HEAD_DIM)
    pad = ((0, 0), (BLOCK, BLOCK), (0, 0), (0, 0))

    def band(t):
        tb = jnp.pad(t.astype(jnp.float32), pad).reshape(B, nb + 2, BLOCK, A_KV_HEADS, HEAD_DIM)
        return jnp.concatenate([tb[:, :-2], tb[:, 1:-1], tb[:, 2:]], axis=2)

    kb, vb = band(k), band(v)
    qi = jnp.arange(BLOCK)[:, None]
    kc = jnp.arange(3 * BLOCK)[None, :]
    dist = kc - BLOCK - qi
    s_pos = jnp.arange(nb)[:, None, None] * BLOCK + kc[None] - BLOCK
    valid = (jnp.abs(dist)[None] <= A_WINDOW) & (s_pos >= 0) & (s_pos < S)
    slopes = alibi_slopes(A_HEADS).reshape(A_KV_HEADS, g)
    logits = jnp.einsum('bnqhgd,bnkhd->bnhgqk', qb, kb) * scale
    logits = logits - slopes[:, :, None, None] * jnp.abs(dist).astype(jnp.float32)
    logits = jnp.where(valid[None, :, None, None], logits, NEG)
    sink_b = sink.astype(jnp.float32).reshape(A_KV_HEADS, g)[:, :, None, None]
    m = jnp.maximum(jnp.max(logits, axis=-1, keepdims=True), sink_b)
    p = jnp.exp(logits - m)
    den = jnp.sum(p, axis=-1, keepdims=True) + jnp.exp(sink_b - m)
    o = jnp.einsum('bnhgqk,bnkhd->bnqhgd', p / den, vb)
    return o.reshape(B, S, A_HEADS * HEAD_DIM).astype(q.dtype)


def diff_attention(q, k, v, lam, lam_init, subln_g):
    B, S = q.shape[0], q.shape[1]
    nb = S // BLOCK
    scale = HEAD_DIM ** -0.5
    slopes = alibi_slopes(B_HEADS)
    kf = k.astype(jnp.float32)
    vf = v.astype(jnp.float32)
    qb = jnp.moveaxis(q.astype(jnp.float32).reshape(B, nb, BLOCK, B_HEADS, 2, HEAD_DIM), 1, 0)
    kpos = jnp.arange(S)

    def one_block(args):
        qblk, i = args
        qpos = i * BLOCK + jnp.arange(BLOCK)
        logits = jnp.einsum('bqhmd,bkhmd->bhmqk', qblk, kf) * scale
        logits = logits - slopes[:, None, None, None] * jnp.abs(qpos[:, None] - kpos[None, :]).astype(jnp.float32)
        a = jax.nn.softmax(logits, axis=-1)
        w = a[:, :, 0] - lam * a[:, :, 1]
        return jnp.einsum('bhqk,bkhe->bqhe', w, vf)

    o = lax.map(one_block, (qb, jnp.arange(nb)))
    o = jnp.moveaxis(o, 0, 1).reshape(B, S, B_HEADS, B_VDIM)
    o = rmsnorm(o, subln_g, SUBLN_EPS) * (1.0 - lam_init)
    return o.reshape(B, S, B_HEADS * B_VDIM).astype(q.dtype)


def dilated_attention(q, k, v):
    B, S = q.shape[0], q.shape[1]
    nb = S // BLOCK
    scale = HEAD_DIM ** -0.5
    span = BLOCK + 2 * C_REACH
    offs = c_offsets()
    slopes = alibi_slopes(C_GROUPS * C_HEADS).reshape(C_GROUPS, C_HEADS)
    pad = ((0, 0), (C_REACH, C_REACH), (0, 0), (0, 0), (0, 0))
    kp = jnp.pad(k.astype(jnp.float32), pad)
    vp = jnp.pad(v.astype(jnp.float32), pad)
    qb = jnp.moveaxis(q.astype(jnp.float32).reshape(B, nb, BLOCK, C_GROUPS, C_HEADS, HEAD_DIM), 1, 0)
    loc = jnp.arange(BLOCK)[:, None, None] + C_REACH + offs[None]
    gidx = jnp.arange(C_GROUPS)[None, :, None]
    dpen = jnp.abs(offs).astype(jnp.float32)[:, None, :]

    def one_block(args):
        qblk, i = args
        ks = lax.dynamic_slice_in_dim(kp, i * BLOCK, span, axis=1)
        vs = lax.dynamic_slice_in_dim(vp, i * BLOCK, span, axis=1)
        kg = ks[:, loc, gidx]
        vg = vs[:, loc, gidx]
        spos = i * BLOCK + jnp.arange(BLOCK)[:, None, None] + offs[None]
        valid = (spos >= 0) & (spos < S)
        logits = jnp.einsum('bqghd,bqgjhd->bqghj', qblk, kg) * scale
        logits = logits - slopes[:, :, None] * dpen
        logits = jnp.where(valid[None, :, :, None, :], logits, NEG)
        lse = jax.nn.logsumexp(logits, axis=-1)
        og = jnp.einsum('bqghj,bqgjhd->bqghd', jnp.exp(logits - lse[..., None]), vg)
        wg = jax.nn.softmax(lse, axis=2)
        return jnp.einsum('bqgh,bqghd->bqhd', wg, og)

    o = lax.map(one_block, (qb, jnp.arange(nb)))
    return jnp.moveaxis(o, 0, 1).reshape(B, S, C_HEADS * HEAD_DIM).astype(q.dtype)


def conv_gated_mlp(h, w_up, conv_w, conv_b, w_down):
    u = h @ w_up
    up = jnp.pad(u, ((0, 0), (1, 1), (0, 0)))
    u = up[:, :-2] * conv_w[0] + up[:, 1:-1] * conv_w[1] + up[:, 2:] * conv_w[2] + conv_b
    gate, val = jnp.split(u, 2, axis=-1)
    return (jax.nn.silu(gate) * val) @ w_down


def trunk(x, ln1, w_in, a_sink, lam_q1, lam_k1, lam_q2, lam_k2, subln, w_out,
          ln2, w_up, conv_w, conv_b, w_down, ln_f):
    B, S = x.shape[0], x.shape[1]
    cuts = np.cumsum([A_Q, A_KV, A_KV, B_QK, B_QK, B_V, C_QKV, C_QKV])
    for l in range(DEPTH):
        h = rmsnorm(x, ln1[l])
        proj = h @ w_in[l]
        aq, ak, av, bq, bk, bv, cq, ck, cv = jnp.split(proj, [int(c) for c in cuts], axis=-1)
        o_a = window_gqa_sink(aq.reshape(B, S, A_HEADS, HEAD_DIM),
                              ak.reshape(B, S, A_KV_HEADS, HEAD_DIM),
                              av.reshape(B, S, A_KV_HEADS, HEAD_DIM), a_sink[l])
        lam_init = 0.8 - 0.6 * math.exp(-0.3 * l)
        lam = (jnp.exp(jnp.sum(lam_q1[l].astype(jnp.float32) * lam_k1[l].astype(jnp.float32)))
               - jnp.exp(jnp.sum(lam_q2[l].astype(jnp.float32) * lam_k2[l].astype(jnp.float32))) + lam_init)
        o_b = diff_attention(bq.reshape(B, S, B_HEADS, 2, HEAD_DIM),
                             bk.reshape(B, S, B_HEADS, 2, HEAD_DIM),
                             bv.reshape(B, S, B_HEADS, B_VDIM), lam, lam_init, subln[l])
        cshape = (B, S, C_GROUPS, C_HEADS, HEAD_DIM)
        o_c = dilated_attention(cq.reshape(cshape), ck.reshape(cshape), cv.reshape(cshape))
        x = x + jnp.concatenate([o_a, o_b, o_c], axis=-1) @ w_out[l]
        x = x + conv_gated_mlp(rmsnorm(x, ln2[l]), w_up[l], conv_w[l], conv_b[l], w_down[l])
    return rmsnorm(x, ln_f)


def setup_inputs(seed: int = 0) -> dict:
    key = jax.random.key(seed)
    ks = jax.random.split(key, 20)
    f32 = jnp.float32
    nrm = lambda k, s, sc: jax.random.normal(k, s, f32) * sc
    return {
        "x_prompt": nrm(ks[0], (BATCH, SEQ, D_MODEL), 1.0),
        "x_sample": nrm(ks[1], (DEC_BATCH, DEC_SEQ, D_MODEL), 1.0),
        "ln1": 1.0 + nrm(ks[2], (DEPTH, D_MODEL), 0.02),
        "w_in": nrm(ks[3], (DEPTH, D_MODEL, D_IN), D_MODEL ** -0.5),
        "a_sink": nrm(ks[4], (DEPTH, A_HEADS), 0.5),
        "lam_q1": nrm(ks[5], (DEPTH, HEAD_DIM), 0.1),
        "lam_k1": nrm(ks[6], (DEPTH, HEAD_DIM), 0.1),
        "lam_q2": nrm(ks[7], (DEPTH, HEAD_DIM), 0.1),
        "lam_k2": nrm(ks[8], (DEPTH, HEAD_DIM), 0.1),
        "subln": 1.0 + nrm(ks[9], (DEPTH, B_VDIM), 0.02),
        "w_out": nrm(ks[10], (DEPTH, D_MIX, D_MODEL), 0.5 * D_MIX ** -0.5),
        "ln2": 1.0 + nrm(ks[11], (DEPTH, D_MODEL), 0.02),
        "w_up": nrm(ks[12], (DEPTH, D_MODEL, 2 * D_FF), D_MODEL ** -0.5),
        "conv_w": nrm(ks[13], (DEPTH, CONV_W, 2 * D_FF), CONV_W ** -0.5),
        "conv_b": nrm(ks[14], (DEPTH, 2 * D_FF), 0.02),
        "w_down": nrm(ks[15], (DEPTH, D_FF, D_MODEL), 0.5 * D_FF ** -0.5),
        "ln_f": 1.0 + nrm(ks[16], (D_MODEL,), 0.02),
    }


def reference(x_prompt, x_sample, ln1, w_in, a_sink, lam_q1, lam_k1, lam_q2, lam_k2, subln,
              w_out, ln2, w_up, conv_w, conv_b, w_down, ln_f):
    y_prompt = trunk(x_prompt, ln1, w_in, a_sink, lam_q1, lam_k1, lam_q2, lam_k2, subln, w_out,
                     ln2, w_up, conv_w, conv_b, w_down, ln_f)
    y_sample = trunk(x_sample, ln1, w_in, a_sink, lam_q1, lam_k1, lam_q2, lam_k2, subln, w_out,
                     ln2, w_up, conv_w, conv_b, w_down, ln_f)
    return (y_prompt, y_sample)
```

```cpp
#include <hip/hip_runtime.h>
#include <hip/hip_cooperative_groups.h>
#include <cstdio>
#include <cstdint>
#include <cmath>
namespace cg = cooperative_groups;
namespace pg8 {
#define PG8_LAS __attribute__((address_space(3)))
typedef unsigned short bf16_t;
typedef short bf16x8 __attribute__((ext_vector_type(8)));
typedef float f32x4 __attribute__((ext_vector_type(4)));
typedef unsigned u32x4 __attribute__((ext_vector_type(4)));
constexpr int BM = 256, BK = 64, HALF = 128, HTB = HALF * BK * 2  , STAGE_BYTES = 8 * HTB, NXCD = 8, WGM = 8;

__host__ __device__ __forceinline__ int lds_byte(int r, int c) { const int st = (r >> 4) * 2 + (c >> 5), rr = r & 15, cc = c & 31, ob = rr * 64 + cc * 2; return st * 1024 + (ob ^ (((ob >> 9) & 1) << 5)); }
__host__ __device__ __forceinline__ void stage_rc(int b, int& R, int& C) { const int st = b / 1024, sb = b % 1024, swz = sb ^ (((sb >> 9) & 1) << 5); R = (st >> 1) * 16 + swz / 64; C = (st & 1) * 32 + (swz % 64) / 2; }
__host__ __device__ __forceinline__ int perm32(int rho) { const int n = rho >> 4, i = rho & 15; return 8 * (i >> 2) + 4 * n + (i & 3); }

struct Unit { int pm, pn; };
struct Gemm { const bf16_t* A; const bf16_t* Bt; int M, N, K; };

struct StaticOrder {
    int nM, nN, nwg, G, c;
    __host__ __device__ void init(int M, int N, int G_, int c_) { nM = M / BM; nN = N / BM; nwg = nM * nN; G = G_; c = c_; }
    __host__ __device__ bool next(int i, Unit& u) const {
        const long L = (long)i * G + c; if (L >= nwg) return false;
        int wgid = (int)L; { const int q = nwg / NXCD, r = nwg % NXCD, xcd = wgid % NXCD, off = wgid / NXCD; wgid = (xcd < r ? xcd * (q + 1) : r * (q + 1) + (xcd - r) * q) + off; }
        const int nig = WGM * nN, gid = wgid / nig, fm = gid * WGM, gsz = (nM - fm) < WGM ? (nM - fm) : WGM;
        u.pm = fm + ((wgid % nig) % gsz); u.pn = (wgid % nig) / gsz; return true;
    }
    __device__ __forceinline__ void a_ready(const Unit&) const {}
    __device__ __forceinline__ void done(const Unit&) const {}
};

__device__ __forceinline__ unsigned cvt_pk_bf16(float lo, float hi) { unsigned r; asm volatile("v_cvt_pk_bf16_f32 %0, %1, %2" : "=v"(r) : "v"(lo), "v"(hi)); return r; }
struct EpiBf16S {
    static constexpr bool PERM = true, AFTER_DRAIN = false;
    bf16_t* O; int ldc; unsigned scalemask; float sc;
    __device__ __forceinline__ void operator()(const f32x4 (&acc)[2][2][4][2], const Unit& u, int wr, int wc, int fr, int fq) const {
        const int row0 = u.pm * BM + wr * 64 + fr; const int col0 = u.pn * BM + wc * 32 + 8 * fq;
        const float s = ((scalemask >> u.pn) & 1u) ? sc : 1.f;
#pragma unroll
        for (int ai = 0; ai < 2; ++ai)
#pragma unroll
            for (int m = 0; m < 4; ++m) { bf16_t* rowp = O + (size_t)(row0 + ai * HALF + m * 16) * ldc + col0;
#pragma unroll
                for (int bj = 0; bj < 2; ++bj) { f32x4 v0 = acc[ai][bj][m][0] * s, v1 = acc[ai][bj][m][1] * s;
                    u32x4 w; w.x = cvt_pk_bf16(v0[0], v0[1]); w.y = cvt_pk_bf16(v0[2], v0[3]); w.z = cvt_pk_bf16(v1[0], v1[1]); w.w = cvt_pk_bf16(v1[2], v1[3]);
                    *(u32x4*)(rowp + bj * HALF) = w; } }
    }
};
struct EpiRes {
    static constexpr bool PERM = false, AFTER_DRAIN = false;
    const float* base; float* out; int ldc;
    __device__ __forceinline__ void operator()(const f32x4 (&acc)[2][2][4][2], const Unit& u, int wr, int wc, int fr, int fq) const {
        const int col0 = u.pn * BM + wc * 32 + 4 * fq;
#pragma unroll
        for (int ai = 0; ai < 2; ++ai)
#pragma unroll
            for (int m = 0; m < 4; ++m) { const size_t off = (size_t)(u.pm * BM + ai * HALF + wr * 64 + m * 16 + fr) * ldc + col0;
#pragma unroll
                for (int bj = 0; bj < 2; ++bj)
#pragma unroll
                    for (int n = 0; n < 2; ++n) { const f32x4 bs = *(const f32x4*)(base + off + bj * HALF + n * 16); *(f32x4*)(out + off + bj * HALF + n * 16) = bs + acc[ai][bj][m][n]; }
                asm volatile("" ::: "memory"); }
    }
};
template <class Epi, class Sched, bool ALIGN_EPI = false, bool SP2 = false>
__device__ __forceinline__ void gemm_phase(PG8_LAS unsigned char* lds, const Gemm g, const Sched& S, const Epi& E) {
    int tid_l = threadIdx.x; asm volatile("" : "+v"(tid_l)); const int tid = tid_l, wid = __builtin_amdgcn_readfirstlane(tid >> 6), lane = tid & 63, wr = wid >> 2, wc = wid & 3, fr = lane & 15, fq = lane >> 4;
    const int K = g.K, nt = K / BK;
    unsigned voffA[2], voffB[2];
#pragma unroll
    for (int i = 0; i < 2; ++i) { int R, C; stage_rc(tid * 16 + i * 8192, R, C); const int Rb = Epi::PERM ? ((R & ~31) + perm32(R & 31)) : R;
        voffA[i] = (unsigned)(R * K + C) * 2u; voffB[i] = (unsigned)(Rb * K + C) * 2u; }
    const size_t kstep = (size_t)(BK * 2);
    const size_t hstep = (size_t)HALF * K * 2;
    const size_t tstep = 2 * hstep;
    const unsigned ldsw = (unsigned)wid * 1024u;
    const int aoff = lds_byte(wr * 64 + fr, fq * 8), boff = lds_byte(wc * 32 + fr, fq * 8);
#define PG8_SA(b, h) (((b) * 2 + (h)) * HTB)
#define PG8_SB(b, h) ((4 + (b) * 2 + (h)) * HTB)
#define PG8_STAGE(bufoff, gbase, voff) do { _Pragma("unroll") for (int _i = 0; _i < 2; ++_i) \
        __builtin_amdgcn_global_load_lds((const unsigned*)((const char*)(gbase) + (voff)[_i]), (PG8_LAS unsigned*)(lds + (bufoff) + ldsw + _i * 8192), 16, 0, 0); } while (0)
#define PG8_LDA(dst, b, h) do { _Pragma("unroll") for (int m = 0; m < 4; ++m) _Pragma("unroll") for (int k = 0; k < 2; ++k) dst[m][k] = *(const PG8_LAS bf16x8*)(lds + PG8_SA(b, h) + aoff + m * 2048 + k * 1024); } while (0)
#define PG8_LDB(dst, b, h) do { _Pragma("unroll") for (int n = 0; n < 2; ++n) _Pragma("unroll") for (int k = 0; k < 2; ++k) dst[n][k] = *(const PG8_LAS bf16x8*)(lds + PG8_SB(b, h) + boff + n * 2048 + k * 1024); } while (0)
#define PG8_MMA(ai, bj, At, Bt) do { __builtin_amdgcn_s_setprio(1); _Pragma("unroll") for (int m = 0; m < 4; ++m) _Pragma("unroll") for (int n = 0; n < 2; ++n) _Pragma("unroll") for (int k = 0; k < 2; ++k) \
        acc[ai][bj][m][n] = __builtin_amdgcn_mfma_f32_16x16x32_bf16(Bt[n][k], At[m][k], acc[ai][bj][m][n], 0, 0, 0); __builtin_amdgcn_s_setprio(0); } while (0)
#define PG8_WAIT_V(n) asm volatile("s_waitcnt vmcnt(" #n ")" ::: "memory")
#define PG8_WAIT_L(n) asm volatile("s_waitcnt lgkmcnt(" #n ")" ::: "memory")
#define PG8_BAR __builtin_amdgcn_s_barrier()
#define PG8_SCHED __builtin_amdgcn_sched_barrier(0)
    Unit cur, nxt; int ui = 0;
    if (!S.next(0, cur)) return;
    f32x4 acc[2][2][4][2];
#pragma unroll
    for (int a = 0; a < 2; ++a)
#pragma unroll
        for (int b = 0; b < 2; ++b)
#pragma unroll
            for (int m = 0; m < 4; ++m)
#pragma unroll
                for (int n = 0; n < 2; ++n) acc[a][b][m][n] = (f32x4){0.f, 0.f, 0.f, 0.f};
    bf16x8 At[4][2], B0[2][2], B1[2][2];
    const char* cA = (const char*)g.A + (size_t)cur.pm * tstep; const char* cB = (const char*)g.Bt + (size_t)cur.pn * tstep;
    S.a_ready(cur);
    if constexpr (SP2) {
        PG8_STAGE(PG8_SB(0, 0), cB, voffB); PG8_STAGE(PG8_SB(0, 1), cB + hstep, voffB); PG8_STAGE(PG8_SA(0, 0), cA, voffA); PG8_STAGE(PG8_SA(0, 1), cA + hstep, voffA);
        if (wr == 1) PG8_BAR;
        PG8_WAIT_V(2); PG8_BAR;
        PG8_STAGE(PG8_SB(1, 0), cB + kstep, voffB); PG8_STAGE(PG8_SA(1, 0), cA + kstep, voffA); PG8_STAGE(PG8_SB(1, 1), cB + hstep + kstep, voffB);
        PG8_WAIT_V(6); PG8_BAR;
    } else {
        PG8_STAGE(PG8_SB(0, 0), cB, voffB); PG8_STAGE(PG8_SA(0, 0), cA, voffA); PG8_STAGE(PG8_SB(0, 1), cB + hstep, voffB); PG8_STAGE(PG8_SA(0, 1), cA + hstep, voffA);
        if (wr == 1) PG8_BAR;
        PG8_WAIT_V(4); PG8_BAR;
        PG8_STAGE(PG8_SB(1, 0), cB + kstep, voffB); PG8_STAGE(PG8_SA(1, 0), cA + kstep, voffA); PG8_STAGE(PG8_SB(1, 1), cB + hstep + kstep, voffB);
        PG8_WAIT_V(6); PG8_BAR;
    }
    for (;;) {
        const bool has_next = S.next(ui + 1, nxt);
        const char* nA = has_next ? (const char*)g.A + (size_t)nxt.pm * tstep : cA; const char* nB = has_next ? (const char*)g.Bt + (size_t)nxt.pn * tstep : cB;
        for (int t = 0; t < nt; t += 2) {
            const bool last = (t == nt - 2);
            const char* a1 = cA + (size_t)(t + 1) * kstep;
            const char* a2 = last ? nA : cA + (size_t)(t + 2) * kstep; const char* b2 = last ? nB : cB + (size_t)(t + 2) * kstep;
            const char* a3 = a2 + kstep; const char* b3 = b2 + kstep;
            if (last && has_next) S.a_ready(nxt);
            if constexpr (SP2) {
            PG8_LDB(B0, 0, 0); PG8_LDB(B1, 0, 1); PG8_SCHED; PG8_LDA(At, 0, 0); PG8_STAGE(PG8_SA(1, 1), a1 + hstep, voffA);
            PG8_WAIT_V(8); PG8_WAIT_L(0); PG8_BAR; PG8_MMA(0, 0, At, B0); PG8_MMA(0, 1, At, B1); PG8_BAR; PG8_SCHED;
            PG8_LDA(At, 0, 1); PG8_STAGE(PG8_SB(0, 0), b2, voffB); PG8_STAGE(PG8_SB(0, 1), b2 + hstep, voffB); PG8_STAGE(PG8_SA(0, 0), a2, voffA);
            PG8_WAIT_V(8); PG8_WAIT_L(0); PG8_BAR; PG8_MMA(1, 0, At, B0); PG8_MMA(1, 1, At, B1); PG8_BAR; PG8_SCHED;
            PG8_LDB(B0, 1, 0); PG8_LDB(B1, 1, 1); PG8_SCHED; PG8_LDA(At, 1, 0); PG8_STAGE(PG8_SA(0, 1), a2 + hstep, voffA);
            PG8_WAIT_V(8); PG8_WAIT_L(0); PG8_BAR; PG8_MMA(0, 0, At, B0); PG8_MMA(0, 1, At, B1); PG8_BAR; PG8_SCHED;
            PG8_LDA(At, 1, 1); PG8_STAGE(PG8_SB(1, 0), b3, voffB); PG8_STAGE(PG8_SB(1, 1), b3 + hstep, voffB); PG8_STAGE(PG8_SA(1, 0), a3, voffA);
            PG8_WAIT_V(8); PG8_WAIT_L(0); PG8_BAR; PG8_MMA(1, 0, At, B0); PG8_MMA(1, 1, At, B1); PG8_BAR; PG8_SCHED;
            } else {
            PG8_LDB(B0, 0, 0); PG8_SCHED; PG8_LDA(At, 0, 0); PG8_STAGE(PG8_SA(1, 1), a1 + hstep, voffA);
            PG8_WAIT_L(8); PG8_BAR; PG8_WAIT_L(0); PG8_MMA(0, 0, At, B0); PG8_BAR; PG8_SCHED;
            PG8_LDB(B1, 0, 1); PG8_STAGE(PG8_SB(0, 0), b2, voffB);
            PG8_BAR; PG8_WAIT_L(0); PG8_MMA(0, 1, At, B1); PG8_BAR;
            PG8_LDA(At, 0, 1); PG8_STAGE(PG8_SA(0, 0), a2, voffA);
            PG8_BAR; PG8_WAIT_L(0); PG8_MMA(1, 0, At, B0); PG8_BAR; PG8_SCHED;
            PG8_STAGE(PG8_SB(0, 1), b2 + hstep, voffB);
            PG8_WAIT_V(6); PG8_BAR; PG8_MMA(1, 1, At, B1); PG8_BAR;
            PG8_LDB(B0, 1, 0); PG8_SCHED; PG8_LDA(At, 1, 0); PG8_STAGE(PG8_SA(0, 1), a2 + hstep, voffA);
            PG8_WAIT_L(8); PG8_BAR; PG8_WAIT_L(0); PG8_MMA(0, 0, At, B0); PG8_BAR; PG8_SCHED;
            PG8_LDB(B1, 1, 1); PG8_STAGE(PG8_SB(1, 0), b3, voffB);
            PG8_BAR; PG8_WAIT_L(0); PG8_MMA(0, 1, At, B1); PG8_BAR;
            PG8_LDA(At, 1, 1); PG8_STAGE(PG8_SA(1, 0), a3, voffA);
            PG8_BAR; PG8_WAIT_L(0); PG8_MMA(1, 0, At, B0); PG8_BAR; PG8_SCHED;
            PG8_STAGE(PG8_SB(1, 1), b3 + hstep, voffB);
            PG8_WAIT_V(6); PG8_BAR; PG8_MMA(1, 1, At, B1); PG8_BAR;
            }
        }
        if constexpr (ALIGN_EPI) { if (wr == 0) PG8_BAR; }
        if constexpr (!Epi::AFTER_DRAIN) { E(acc, cur, wr, wc, fr, fq); S.done(cur); }
        if (!has_next) break;
#pragma unroll
        for (int a = 0; a < 2; ++a)
#pragma unroll
            for (int b = 0; b < 2; ++b)
#pragma unroll
                for (int m = 0; m < 4; ++m)
#pragma unroll
                    for (int n = 0; n < 2; ++n) acc[a][b][m][n] = (f32x4){0.f, 0.f, 0.f, 0.f};
        cur = nxt; cA = nA; cB = nB; ++ui;
        if constexpr (ALIGN_EPI) { if (wr == 1) PG8_BAR; }
    }
    PG8_WAIT_V(0);
    if constexpr (!ALIGN_EPI) { if (wr == 0) PG8_BAR; }
    PG8_BAR;
    if constexpr (Epi::AFTER_DRAIN) { E.fused(acc, cur, wr, wc, fr, fq, lds, wid, lane); S.done(cur); }
#undef PG8_SA
#undef PG8_SB
#undef PG8_STAGE
#undef PG8_LDA
#undef PG8_LDB
#undef PG8_MMA
#undef PG8_WAIT_V
#undef PG8_WAIT_L
#undef PG8_BAR
#undef PG8_SCHED
}
}
typedef __bf16 bf16x2_t __attribute__((ext_vector_type(2)));
__device__ __forceinline__ unsigned cvt_pk(float lo, float hi) { float __attribute__((ext_vector_type(2))) v = {lo, hi}; bf16x2_t b = __builtin_convertvector(v, bf16x2_t); return __builtin_bit_cast(unsigned, b); }
#define LAS __attribute__((address_space(3)))
typedef unsigned short bf16_t;
typedef short bf16x8 __attribute__((ext_vector_type(8)));
typedef short s16x4 __attribute__((ext_vector_type(4)));
typedef float f32x16 __attribute__((ext_vector_type(16)));
typedef float f32x4 __attribute__((ext_vector_type(4)));
typedef float f32x2 __attribute__((ext_vector_type(2)));
typedef unsigned u32x4 __attribute__((ext_vector_type(4)));
typedef unsigned u32x2 __attribute__((ext_vector_type(2)));

constexpr int DM = 1024, DIN = 4352, DFF = 2816, DUP = 2 * DFF, DEPTH = 2;
constexpr int CH_ROWS = 16384, NCHUNK = 3;
constexpr int TW = 2064;
constexpr int T_A = 0, T_B = 256, T_C = 1280, T_L = 2048;
constexpr float LOG2E = 1.4426950408889634f, LN2 = 0.6931471805599453f;
constexpr float QSCALE = 0.125f * LOG2E;
constexpr size_t MiB = 1u << 20;
constexpr size_t WS_WIN = 0, WS_WOUT = 18 * MiB, WS_WUP = 22 * MiB, WS_WDN = 44 * MiB, WS_HB = 56 * MiB, WS_PROJ = 88 * MiB, WS_TMP = 264 * MiB, WS_END = 394 * MiB;
constexpr int LDS_BYTES = 147456;
constexpr int NTHREADS = 512;

struct Args { const float* in[17]; float* out; unsigned char* ws; };

__device__ __forceinline__ float wave_sum(float v) {
#pragma unroll
    for (int o = 1; o < 64; o <<= 1) v += __shfl_xor(v, o);
    return v;
}
__device__ __forceinline__ unsigned f2bf(float f) { unsigned u = __builtin_bit_cast(unsigned, f); return (u + 0x7fffu + ((u >> 16) & 1u)) >> 16; }
__device__ __forceinline__ unsigned pk2(float lo, float hi) { return f2bf(lo) | (f2bf(hi) << 16); }
__device__ __forceinline__ float bf2f(unsigned short b) { return __builtin_bit_cast(float, (unsigned)b << 16); }

__device__ __forceinline__ void transpose_item(const float* W, int K, int N, bf16_t* WT, LAS float* scr, int item, int lane) {
    const int nblk = N / 32, kb = item / nblk, nb = item % nblk, k0 = 64 * kb, n0 = 32 * nb;
#pragma unroll 8
    for (int i = 0; i < 32; ++i) { const int kk = 2 * i + (lane >> 5); scr[kk * 33 + (lane & 31)] = W[(size_t)(k0 + kk) * N + n0 + (lane & 31)]; }
    asm volatile("s_waitcnt lgkmcnt(0)" ::: "memory");
    const int c = lane & 7;
#pragma unroll
    for (int j = 0; j < 4; ++j) { const int n = (lane >> 3) + 8 * j; const LAS float* s = scr + (8 * c) * 33 + n;
        u32x4 o; o.x = pk2(s[0 * 33], s[1 * 33]); o.y = pk2(s[2 * 33], s[3 * 33]); o.z = pk2(s[4 * 33], s[5 * 33]); o.w = pk2(s[6 * 33], s[7 * 33]);
        *(u32x4*)(WT + (size_t)(n0 + n) * K + k0 + 8 * c) = o; }
    asm volatile("s_waitcnt lgkmcnt(0)" ::: "memory");
}

__device__ __forceinline__ void rms_row_to_bf16(const float* xrow, const float* gain, bf16_t* orow, int lane) {
    const f32x4* xr = (const f32x4*)xrow + lane; const f32x4* gr = (const f32x4*)gain + lane;
    f32x4 v[4]; float s = 0.f;
#pragma unroll
    for (int j = 0; j < 4; ++j) { v[j] = xr[64 * j]; s += (v[j].x * v[j].x + v[j].y * v[j].y) + (v[j].z * v[j].z + v[j].w * v[j].w); }
    const float rstd = 1.f / sqrtf(wave_sum(s) * (1.f / DM) + 1e-6f);
    u32x2* o8 = (u32x2*)orow + lane;
#pragma unroll
    for (int j = 0; j < 4; ++j) { const f32x4 g = gr[64 * j]; u32x2 w; w.x = pk2(v[j].x * rstd * g.x, v[j].y * rstd * g.y); w.y = pk2(v[j].z * rstd * g.z, v[j].w * rstd * g.w); o8[64 * j] = w; }
}
__device__ __forceinline__ void rms_row_f32(float* xrow, const float* gain, int lane) {
    f32x4* xr = (f32x4*)xrow + lane; const f32x4* gr = (const f32x4*)gain + lane;
    f32x4 v[4]; float s = 0.f;
#pragma unroll
    for (int j = 0; j < 4; ++j) { v[j] = xr[64 * j]; s += (v[j].x * v[j].x + v[j].y * v[j].y) + (v[j].z * v[j].z + v[j].w * v[j].w); }
    const float rstd = 1.f / sqrtf(wave_sum(s) * (1.f / DM) + 1e-6f);
#pragma unroll
    for (int j = 0; j < 4; ++j) { const f32x4 g = gr[64 * j]; xr[64 * j] = v[j] * rstd * g; }
}

constexpr int KSTR = 144;
constexpr int ATT_K_OFF = 0, ATT_V_OFF = 2 * 64 * KSTR, ATT_SCR_OFF = ATT_V_OFF + 2 * 64 * 320;
__device__ __forceinline__ int crow(int r, int hi) { return (r & 3) + 8 * (r >> 2) + 4 * hi; }
typedef short v4i16_t __attribute__((ext_vector_type(4)));
__device__ __forceinline__ s16x4 vtr(const LAS unsigned char* p) { return __builtin_bit_cast(s16x4, __builtin_amdgcn_ds_read_tr16_b64_v4i16((LAS v4i16_t*)p)); }

template <int VD, bool WIN>
__device__ __forceinline__ void attn_unit(LAS unsigned char* lds, const bf16_t* Qp, const bf16_t* Kp, const bf16_t* Vp, size_t pitch,
                                          int q0, int L, float slope2, int W, float m_init, float l_init,
                                          float* Oout, size_t opitch, float* lse_out, size_t lpitch) {
    constexpr int VSTR = VD * 2 + 64, ND = VD / 32, VCH = VD / 8, VLD = 64 * VCH / NTHREADS;
    int tid_l = threadIdx.x; asm volatile("" : "+v"(tid_l)); const int tid = tid_l, lane = tid & 63, r32 = lane & 31, hi = lane >> 5, wid = __builtin_amdgcn_readfirstlane(tid >> 6);
    const int qw = q0 + wid * 32;
    int tlo = 0, thi = L / 64;
    if (WIN) { const int a = q0 - W; tlo = a > 0 ? a / 64 : 0; const int b = q0 + 256 + W; thi = (b < L ? b : L) / 64; }
    bf16x8 qr[4];
    { const bf16_t* qrow = Qp + (size_t)(qw + r32) * pitch + hi * 8;
#pragma unroll
      for (int d0 = 0; d0 < 4; ++d0) qr[d0] = *(const bf16x8*)(qrow + d0 * 16); }
    f32x16 o[ND];
#pragma unroll
    for (int d = 0; d < ND; ++d)
#pragma unroll
        for (int r = 0; r < 16; ++r) o[d][r] = 0.f;
    float m = m_init, l = hi == 0 ? l_init : 0.f;
    LAS float* wsf = (LAS float*)(lds + ATT_SCR_OFF) + wid * 64;
    const int krow = tid >> 3, kch = tid & 7;
    u32x4 kreg; u32x4 vreg[VLD];
#define ATT_GLOAD(t) do { kreg = *(const u32x4*)(Kp + (size_t)(64 * (t) + krow) * pitch + kch * 8); \
        _Pragma("unroll") for (int i_ = 0; i_ < VLD; ++i_) { const int idx_ = tid + NTHREADS * i_; vreg[i_] = *(const u32x4*)(Vp + (size_t)(64 * (t) + idx_ / VCH) * pitch + (idx_ % VCH) * 8); } } while (0)
#define ATT_LSTORE(b) do { *(LAS u32x4*)(lds + ATT_K_OFF + (b) * 64 * KSTR + krow * KSTR + kch * 16) = kreg; \
        _Pragma("unroll") for (int i_ = 0; i_ < VLD; ++i_) { const int idx_ = tid + NTHREADS * i_; *(LAS u32x4*)(lds + ATT_V_OFF + (b) * 64 * VSTR + (idx_ / VCH) * VSTR + (idx_ % VCH) * 16) = vreg[i_]; } } while (0)
    const int n = thi - tlo;
    ATT_GLOAD(tlo); ATT_LSTORE(0); __syncthreads();
    const float Wf = (float)W;
    for (int i = 0; i < n; ++i) {
        const int t = tlo + i, buf = i & 1;
        if (i + 1 < n) ATT_GLOAD(t + 1);
        bool active = true;
        if (WIN) { const int kb = 64 * t; active = (kb + 63 >= qw - W) && (kb <= qw + 31 + W); }
        if (active) {
            const LAS unsigned char* Kb = lds + ATT_K_OFF + buf * 64 * KSTR + r32 * KSTR + hi * 16;
            f32x16 p0, p1;
#pragma unroll
            for (int r = 0; r < 16; ++r) { p0[r] = 0.f; p1[r] = 0.f; }
#pragma unroll
            for (int d0 = 0; d0 < 4; ++d0) {
                const bf16x8 a0 = *(const LAS bf16x8*)(Kb + d0 * 32), a1 = *(const LAS bf16x8*)(Kb + 32 * KSTR + d0 * 32);
                p0 = __builtin_amdgcn_mfma_f32_32x32x16_bf16(a0, qr[d0], p0, 0, 0, 0);
                p1 = __builtin_amdgcn_mfma_f32_32x32x16_bf16(a1, qr[d0], p1, 0, 0, 0);
                if (d0 & 1) __builtin_amdgcn_sched_barrier(0);
            }
            const float dq = (float)(64 * t + 4 * hi - (qw + r32));
            float rm = -INFINITY;
#pragma unroll
            for (int r = 0; r < 16; ++r) {
                const float t0 = dq + (float)((r & 3) + 8 * (r >> 2)), t1 = t0 + 32.f;
                p0[r] = __builtin_fmaf(-slope2, __builtin_fabsf(t0), p0[r]);
                p1[r] = __builtin_fmaf(-slope2, __builtin_fabsf(t1), p1[r]);
                if (WIN) { if (__builtin_fabsf(t0) > Wf) p0[r] = -INFINITY; if (__builtin_fabsf(t1) > Wf) p1[r] = -INFINITY; }
                rm = __builtin_fmaxf(rm, __builtin_fmaxf(p0[r], p1[r]));
            }
            rm = __builtin_fmaxf(rm, __shfl_xor(rm, 32));
            if (__any(rm > m)) {
                const float mn = __builtin_fmaxf(m, rm); const float f = __builtin_amdgcn_exp2f(m - mn); m = mn; l *= f;
                if (hi == 0) wsf[r32] = f;
#pragma unroll
                for (int r = 0; r < 16; ++r) { const float fr = wsf[crow(r, hi)];
#pragma unroll
                    for (int d = 0; d < ND; ++d) o[d][r] *= fr; }
            }
            float ls = 0.f;
#pragma unroll
            for (int r = 0; r < 16; ++r) { p0[r] = __builtin_amdgcn_exp2f(p0[r] - m); p1[r] = __builtin_amdgcn_exp2f(p1[r] - m); ls += p0[r] + p1[r]; }
            l += ls;
            u32x4 pw[4];
#pragma unroll
            for (int c = 0; c < 4; ++c) {
                const f32x16& P = (c >> 1) ? p1 : p0; const int b = 8 * (c & 1);
                pw[c].x = cvt_pk(P[b + 0], P[b + 1]); pw[c].y = cvt_pk(P[b + 2], P[b + 3]); pw[c].z = cvt_pk(P[b + 4], P[b + 5]); pw[c].w = cvt_pk(P[b + 6], P[b + 7]);
            }
            const LAS unsigned char* Vb = lds + ATT_V_OFF + buf * 64 * VSTR + (4 * hi + ((lane & 15) >> 2)) * VSTR + (16 * ((lane >> 4) & 1) + 4 * (lane & 3)) * 2;
#pragma unroll
            for (int c = 0; c < 4; ++c)
#pragma unroll
                for (int d = 0; d < ND; ++d) {
                    const s16x4 vlo = vtr(Vb + c * 16 * VSTR + d * 64), vhi = vtr(Vb + c * 16 * VSTR + 8 * VSTR + d * 64);
                    const bf16x8 vf = (bf16x8){vlo[0], vlo[1], vlo[2], vlo[3], vhi[0], vhi[1], vhi[2], vhi[3]};
                    o[d] = __builtin_amdgcn_mfma_f32_32x32x16_bf16(__builtin_bit_cast(bf16x8, pw[c]), vf, o[d], 0, 0, 0);
                    if (d == ND - 1) __builtin_amdgcn_sched_barrier(0);
                }
        }
        if (i + 1 < n) ATT_LSTORE(buf ^ 1);
        __syncthreads();
    }
#undef ATT_GLOAD
#undef ATT_LSTORE
    l += __shfl_xor(l, 32);
    if (hi == 0) wsf[r32] = 1.f / l;
#pragma unroll
    for (int r = 0; r < 16; ++r) { const float ir = wsf[crow(r, hi)]; float* orow = Oout + (size_t)(qw + crow(r, hi)) * opitch + r32;
#pragma unroll
        for (int d = 0; d < ND; ++d) orow[d * 32] = o[d][r] * ir; }
    if (lse_out != nullptr && hi == 0) lse_out[(size_t)(qw + r32) * lpitch] = (m + __builtin_log2f(l)) * LN2;
    __syncthreads();
}
__device__ __forceinline__ float alibi_slope(int i, int n) { return exp2f(-8.0f * (float)(i + 1) / (float)n); }
struct Ctx { int tid, lane, wave, G, cu, gw, NGW; };

__device__ __forceinline__ void ph_weights(const Args& a, const Ctx& c, LAS unsigned char* lds) {
    unsigned char* ws = a.ws;
    bf16_t* WinT = (bf16_t*)(ws + WS_WIN); bf16_t* WoutT = (bf16_t*)(ws + WS_WOUT); bf16_t* WupT = (bf16_t*)(ws + WS_WUP); bf16_t* WdnT = (bf16_t*)(ws + WS_WDN);
    const float* w_in = a.in[3]; const float* w_out = a.in[10]; const float* w_up = a.in[12]; const float* w_down = a.in[15];
    LAS float* scr = (LAS float*)(lds + c.wave * 16384);
    constexpr int I_IN = (DM / 64) * (DIN / 32), I_OUT = (DM / 64) * (DM / 32), I_UP = (DM / 64) * (DUP / 32), I_DN = (DFF / 64) * (DM / 32);
    constexpr int PER_L = I_IN + I_OUT + I_UP + I_DN;
    for (int it = c.gw; it < DEPTH * PER_L; it += c.NGW) {
        const int l = it / PER_L; int r = it % PER_L;
        if (r < I_IN) { transpose_item(w_in + (size_t)l * DM * DIN, DM, DIN, WinT + (size_t)l * DIN * DM, scr, r, c.lane); continue; } r -= I_IN;
        if (r < I_OUT) { transpose_item(w_out + (size_t)l * DM * DM, DM, DM, WoutT + (size_t)l * DM * DM, scr, r, c.lane); continue; } r -= I_OUT;
        if (r < I_UP) { transpose_item(w_up + (size_t)l * DM * DUP, DM, DUP, WupT + (size_t)l * DUP * DM, scr, r, c.lane); continue; } r -= I_UP;
        transpose_item(w_down + (size_t)l * DFF * DM, DFF, DM, WdnT + (size_t)l * DM * DFF, scr, r, c.lane);
    }
}
__device__ __forceinline__ const float* chunk_in(const Args& a, int ch) { return ch == 0 ? a.in[0] : a.in[1] + (size_t)(ch - 1) * CH_ROWS * DM; }
__device__ __forceinline__ float* chunk_out(const Args& a, int ch) { return a.out + (size_t)ch * CH_ROWS * DM; }

__device__ __forceinline__ void ph_norm_bf16(const Ctx& c, const float* xsrc, const float* gain, bf16_t* HB) {
    for (int r = c.gw; r < CH_ROWS; r += c.NGW) rms_row_to_bf16(xsrc + (size_t)r * DM, gain, HB + (size_t)r * DM, c.lane);
}
__device__ __forceinline__ void ph_final_norm(const Ctx& c, float* xo, const float* gain) {
    for (int r = c.gw; r < CH_ROWS; r += c.NGW) rms_row_f32(xo + (size_t)r * DM, gain, c.lane);
}

__device__ __forceinline__ void ph_attn(const Args& a, const Ctx& c, LAS unsigned char* lds, int ch, int layer) {
    const bf16_t* PROJ = (const bf16_t*)(a.ws + WS_PROJ); float* TMP = (float*)(a.ws + WS_TMP);
    const int SL = ch == 0 ? 16384 : 4096, sl_shift = ch == 0 ? 14 : 12;
    const int cu = c.cu, G = c.G;
#ifndef SKIP_B
    for (int ub = 2 * cu; ub < 512; ub += 2 * G)
        for (int k = 0; k < 2; ++k) {
            const int u = ub + k;
            int seq, h, mp, qb;
            if (ch == 0) { seq = 0; h = u >> 7; mp = (u >> 6) & 1; qb = u & 63; }
            else { seq = u >> 7; h = (u >> 5) & 3; mp = (u >> 4) & 1; qb = u & 15; }
            const size_t rb = (size_t)seq * SL;
            const bf16_t* base = PROJ + rb * DIN;
            attn_unit<128, false>(lds, base + 512 + (h * 2 + mp) * 64, base + 1024 + (h * 2 + mp) * 64, base + 1536 + h * 128, (size_t)DIN,
                                  qb * 256, SL, alibi_slope(h, 4) * LOG2E, 0, -1e30f, 0.f,
                                  TMP + rb * TW + T_B + (h * 2 + mp) * 128, (size_t)TW, nullptr, 0);
        }
#endif
#ifndef SKIP_AC
    for (int uu = cu; uu < 1024; uu += G) {
        const bf16_t *qp, *kp, *vp; size_t pitch, opitch, lpitch; int q0, L, W; float slope2, m_init, l_init; float *op, *lp;
        if (uu < 256) {
            const int hq = uu >> 6, blk = uu & 63;
            const int seq = (blk * 256) >> sl_shift, qb = blk - ((seq << sl_shift) >> 8);
            const size_t rb = (size_t)seq * SL; const bf16_t* base = PROJ + rb * DIN;
            qp = base + hq * 64; kp = base + 256 + (hq >> 1) * 64; vp = base + 384 + (hq >> 1) * 64; pitch = DIN; q0 = qb * 256; L = SL;
            slope2 = alibi_slope(hq, 4) * LOG2E; W = 128; m_init = a.in[4][layer * 4 + hq] * LOG2E; l_init = 1.f;
            op = TMP + rb * TW + T_A + hq * 64; opitch = TW; lp = nullptr; lpitch = 0;
        } else {
            const int uc = uu - 256;
            const int gh = uc >> 6, blk = uc & 63, gq = gh >> 2;
            const int dsh = 2 * gq, d = 1 << dsh;
            const int seq = (blk * 256) >> sl_shift, b2 = blk - ((seq << sl_shift) >> 8);
            const int nbr = (SL >> dsh) >> 8;
            const int res = b2 / nbr, qb = b2 % nbr;
            const size_t rb = (size_t)seq * SL + res; const bf16_t* base = PROJ + rb * DIN;
            qp = base + 2048 + gh * 64; kp = base + 2816 + gh * 64; vp = base + 3584 + gh * 64; pitch = (size_t)DIN * d; q0 = qb * 256; L = SL >> dsh;
            slope2 = alibi_slope(gh, 12) * (float)d * LOG2E; W = 64; m_init = -1e30f; l_init = 0.f;
            op = TMP + rb * TW + T_C + gh * 64; opitch = (size_t)TW * d; lp = TMP + rb * TW + T_L + gh; lpitch = (size_t)TW * d;
        }
        attn_unit<64, true>(lds, qp, kp, vp, pitch, q0, L, slope2, W, m_init, l_init, op, opitch, lp, lpitch);
    }
#endif
}

__device__ __forceinline__ void ph_combine(const Args& a, const Ctx& c, int layer) {
    const float* TMP = (const float*)(a.ws + WS_TMP); bf16_t* HB = (bf16_t*)(a.ws + WS_HB);
    const int lane = c.lane;
    const float lam_init = layer == 0 ? 0.2f : (0.8f - 0.6f * 0.7408182206817179f);
    const float s1 = wave_sum(a.in[5][layer * 64 + lane] * a.in[6][layer * 64 + lane]);
    const float s2 = wave_sum(a.in[7][layer * 64 + lane] * a.in[8][layer * 64 + lane]);
    const float lam = expf(s1) - expf(s2) + lam_init;
    const float* subln = a.in[9];
    const float g0 = subln[layer * 128 + 2 * lane] * (1.f - lam_init), g1 = subln[layer * 128 + 2 * lane + 1] * (1.f - lam_init);
    for (int r = c.gw; r < CH_ROWS; r += c.NGW) {
        const float* tr = TMP + (size_t)r * TW; bf16_t* mr = HB + (size_t)r * DM;
        { const f32x4 v = *(const f32x4*)(tr + T_A + 4 * lane); u32x2 w; w.x = pk2(v.x, v.y); w.y = pk2(v.z, v.w); *(u32x2*)(mr + 4 * lane) = w; }
#pragma unroll
        for (int h = 0; h < 4; ++h) {
            const f32x2 o0 = *(const f32x2*)(tr + T_B + (h * 2) * 128 + 2 * lane), o1 = *(const f32x2*)(tr + T_B + (h * 2 + 1) * 128 + 2 * lane);
            const float ox = o0.x - lam * o1.x, oy = o0.y - lam * o1.y;
            const float ss = wave_sum(ox * ox + oy * oy);
            const float rstd = 1.f / sqrtf(ss * (1.f / 128.f) + 1e-5f);
            *(unsigned*)(mr + 256 + h * 128 + 2 * lane) = pk2(ox * rstd * g0, oy * rstd * g1);
        }
#pragma unroll
        for (int h = 0; h < 4; ++h) {
            const float l0 = tr[T_L + h], l1 = tr[T_L + 4 + h], l2 = tr[T_L + 8 + h];
            const float mx = fmaxf(l0, fmaxf(l1, l2));
            const float w0 = expf(l0 - mx), w1 = expf(l1 - mx), w2 = expf(l2 - mx);
            const float inv = 1.f / (w0 + w1 + w2);
            const float o = (w0 * tr[T_C + h * 64 + lane] + w1 * tr[T_C + (4 + h) * 64 + lane] + w2 * tr[T_C + (8 + h) * 64 + lane]) * inv;
            mr[768 + h * 64 + lane] = (bf16_t)f2bf(o);
        }
    }
}

__device__ __forceinline__ void ph_conv(const Args& a, const Ctx& c, int ch, int layer) {
    const bf16_t* UB = (const bf16_t*)(a.ws + WS_PROJ); bf16_t* GB = (bf16_t*)(a.ws + WS_TMP);
    const int SL = ch == 0 ? 16384 : 4096;
    const float* cw = a.in[13] + (size_t)layer * 3 * DUP; const float* cb = a.in[14] + (size_t)layer * DUP;
    constexpr int NCP = DFF / 2, RB = 16;
    const int nitems = (CH_ROWS / RB) * NCP;
    for (int it = c.cu * NTHREADS + c.tid; it < nitems; it += c.G * NTHREADS) {
        const int cp = it % NCP, rb = it / NCP, c0 = cp * 2, r0 = rb * RB;
        float wg[3][2], wv[3][2], bg[2], bv[2];
#pragma unroll
        for (int k = 0; k < 3; ++k)
#pragma unroll
            for (int j = 0; j < 2; ++j) { wg[k][j] = cw[k * DUP + c0 + j]; wv[k][j] = cw[k * DUP + DFF + c0 + j]; }
#pragma unroll
        for (int j = 0; j < 2; ++j) { bg[j] = cb[c0 + j]; bv[j] = cb[DFF + c0 + j]; }
        const bool first = (r0 & (SL - 1)) == 0, last = ((r0 + RB) & (SL - 1)) == 0;
        unsigned pg_, pv_, cg_, cv_, ng_, nv_;
        pg_ = first ? 0u : *(const unsigned*)(UB + (size_t)(r0 - 1) * DUP + c0); pv_ = first ? 0u : *(const unsigned*)(UB + (size_t)(r0 - 1) * DUP + DFF + c0);
        cg_ = *(const unsigned*)(UB + (size_t)r0 * DUP + c0); cv_ = *(const unsigned*)(UB + (size_t)r0 * DUP + DFF + c0);
        for (int rr = 0; rr < RB; ++rr) {
            const int r = r0 + rr; const bool nz = (rr == RB - 1) && last;
            ng_ = nz ? 0u : *(const unsigned*)(UB + (size_t)(r + 1) * DUP + c0); nv_ = nz ? 0u : *(const unsigned*)(UB + (size_t)(r + 1) * DUP + DFF + c0);
            float res[2];
#pragma unroll
            for (int j = 0; j < 2; ++j) {
                const int sh = j * 16;
                const float gp = bf2f((unsigned short)(pg_ >> sh)), gc = bf2f((unsigned short)(cg_ >> sh)), gn = bf2f((unsigned short)(ng_ >> sh));
                const float vp = bf2f((unsigned short)(pv_ >> sh)), vc = bf2f((unsigned short)(cv_ >> sh)), vn = bf2f((unsigned short)(nv_ >> sh));
                const float gate = gp * wg[0][j] + gc * wg[1][j] + gn * wg[2][j] + bg[j];
                const float val = vp * wv[0][j] + vc * wv[1][j] + vn * wv[2][j] + bv[j];
                res[j] = gate / (1.f + __expf(-gate)) * val;
            }
            *(unsigned*)(GB + (size_t)r * DFF + c0) = pk2(res[0], res[1]);
            pg_ = cg_; pv_ = cv_; cg_ = ng_; cv_ = nv_;
        }
    }
}

constexpr int NSTEPS = 1 + NCHUNK * DEPTH * 9 + 1;
__global__ void __launch_bounds__(NTHREADS, 2) mega_fwd(Args a) {
    extern __shared__ __attribute__((aligned(16))) unsigned char lds_raw[];
    LAS unsigned char* lds = (LAS unsigned char*)lds_raw;
    cg::grid_group grid = cg::this_grid();
    for (int step = 0; step < NSTEPS; ++step) {
        int tid_l = threadIdx.x, cu_l = blockIdx.x, G_l = gridDim.x;
        asm volatile("" : "+v"(tid_l)); asm volatile("" : "+s"(cu_l), "+s"(G_l));
        Ctx c; c.tid = tid_l; c.lane = c.tid & 63; c.wave = __builtin_amdgcn_readfirstlane(c.tid >> 6);
        c.G = G_l; c.cu = cu_l; c.gw = c.cu * 8 + c.wave; c.NGW = c.G * 8;
        if (step == 0) ph_weights(a, c, lds);
        else if (step == NSTEPS - 1) ph_final_norm(c, chunk_out(a, NCHUNK - 1), a.in[16]);
        else {
            const int s = step - 1, ph = s % 9, cl = s / 9, layer = cl & 1, ch = cl >> 1;
            unsigned char* ws = a.ws;
            bf16_t* HB = (bf16_t*)(ws + WS_HB);
            float* xo = chunk_out(a, ch);
            const float* xsrc = layer == 0 ? chunk_in(a, ch) : (const float*)xo;
            if (ph == 0) {
                if (layer == 0 && ch > 0) ph_final_norm(c, chunk_out(a, ch - 1), a.in[16]);
                ph_norm_bf16(c, xsrc, a.in[2] + layer * DM, HB);
            } else if (ph == 1) {
#ifndef SKIP_G
                pg8::Gemm g{HB, (const bf16_t*)(ws + WS_WIN) + (size_t)layer * DIN * DM, CH_ROWS, DIN, DM}; pg8::StaticOrder S; S.init(CH_ROWS, DIN, c.G, c.cu);
                pg8::EpiBf16S E{(bf16_t*)(ws + WS_PROJ), DIN, 1805u, QSCALE};
                pg8::gemm_phase<pg8::EpiBf16S, pg8::StaticOrder, true, true>(lds, g, S, E);
#endif
            } else if (ph == 2) {
                ph_attn(a, c, lds, ch, layer);
            } else if (ph == 3) {
                ph_combine(a, c, layer);
            } else if (ph == 4) {
#ifndef SKIP_G
                pg8::Gemm g{HB, (const bf16_t*)(ws + WS_WOUT) + (size_t)layer * DM * DM, CH_ROWS, DM, DM}; pg8::StaticOrder S; S.init(CH_ROWS, DM, c.G, c.cu);
                pg8::EpiRes E{xsrc, xo, DM};
                pg8::gemm_phase<pg8::EpiRes, pg8::StaticOrder, true, true>(lds, g, S, E);
#endif
            } else if (ph == 5) {
                ph_norm_bf16(c, xo, a.in[11] + layer * DM, HB);
            } else if (ph == 6) {
#ifndef SKIP_G
                pg8::Gemm g{HB, (const bf16_t*)(ws + WS_WUP) + (size_t)layer * DUP * DM, CH_ROWS, DUP, DM}; pg8::StaticOrder S; S.init(CH_ROWS, DUP, c.G, c.cu);
                pg8::EpiBf16S E{(bf16_t*)(ws + WS_PROJ), DUP, 0u, 1.f};
                pg8::gemm_phase<pg8::EpiBf16S, pg8::StaticOrder, true, true>(lds, g, S, E);
#endif
            } else if (ph == 7) {
                ph_conv(a, c, ch, layer);
            } else {
#ifndef SKIP_G
                pg8::Gemm g{(const bf16_t*)(ws + WS_TMP), (const bf16_t*)(ws + WS_WDN) + (size_t)layer * DM * DFF, CH_ROWS, DM, DFF}; pg8::StaticOrder S; S.init(CH_ROWS, DM, c.G, c.cu);
                pg8::EpiRes E{xo, xo, DM};
                pg8::gemm_phase<pg8::EpiRes, pg8::StaticOrder, true, true>(lds, g, S, E);
#endif
            }
        }
        if (step != NSTEPS - 1) grid.sync();
    }
}

extern "C" void kernel_launch(void* const* d_in, const int* in_sizes, int n_in, void* d_out, int out_size, void* d_ws, size_t ws_size, hipStream_t stream) {
    static int grid = 0;
    if (grid == 0) {
        if (n_in != 17 || ws_size < WS_END) { fprintf(stderr, "kernel_launch: unexpected n_in %d / ws_size %zu (need %zu)\n", n_in, ws_size, (size_t)WS_END); grid = -1; return; }
        int dev = 0, cus = 0, per_cu = 0;
        (void)hipGetDevice(&dev); (void)hipDeviceGetAttribute(&cus, hipDeviceAttributeMultiprocessorCount, dev);
        if (hipFuncSetAttribute((const void*)mega_fwd, hipFuncAttributeMaxDynamicSharedMemorySize, LDS_BYTES) != hipSuccess) { fprintf(stderr, "hipFuncSetAttribute failed\n"); grid = -1; return; }
        if (hipOccupancyMaxActiveBlocksPerMultiprocessor(&per_cu, (const void*)mega_fwd, NTHREADS, LDS_BYTES) != hipSuccess || per_cu < 1) { fprintf(stderr, "occupancy query: %d\n", per_cu); per_cu = 1; }
        (void)hipGetLastError();
        grid = cus * 1;
    }
    if (grid < 0) return;
    Args a{};
    for (int i = 0; i < 17; ++i) a.in[i] = (const float*)d_in[i];
    a.out = (float*)d_out; a.ws = (unsigned char*)d_ws;
    void* args[] = {&a};
    hipError_t e = hipLaunchCooperativeKernel((const void*)mega_fwd, dim3(grid), dim3(NTHREADS), args, LDS_BYTES, stream);
    if (e != hipSuccess) fprintf(stderr, "cooperative launch failed: %s (grid %d)\n", hipGetErrorString(e), grid);
}
```

```cpp
#include <hip/hip_runtime.h>
#include <hip/hip_cooperative_groups.h>
#include <cstdio>
#include <cstdint>
#include <cmath>
namespace cg = cooperative_groups;
namespace pg8 {
#define PG8_LAS __attribute__((address_space(3)))
typedef unsigned short bf16_t;
typedef short bf16x8 __attribute__((ext_vector_type(8)));
typedef float f32x4 __attribute__((ext_vector_type(4)));
typedef unsigned u32x4 __attribute__((ext_vector_type(4)));
constexpr int BM = 256, BK = 64, HALF = 128, HTB = HALF * BK * 2  , STAGE_BYTES = 8 * HTB, NXCD = 8, WGM = 8;

__host__ __device__ __forceinline__ int lds_byte(int r, int c) { const int st = (r >> 4) * 2 + (c >> 5), rr = r & 15, cc = c & 31, ob = rr * 64 + cc * 2; return st * 1024 + (ob ^ (((ob >> 9) & 1) << 5)); }
__host__ __device__ __forceinline__ void stage_rc(int b, int& R, int& C) { const int st = b / 1024, sb = b % 1024, swz = sb ^ (((sb >> 9) & 1) << 5); R = (st >> 1) * 16 + swz / 64; C = (st & 1) * 32 + (swz % 64) / 2; }
__host__ __device__ __forceinline__ int perm32(int rho) { const int n = rho >> 4, i = rho & 15; return 8 * (i >> 2) + 4 * n + (i & 3); }

struct Unit { int pm, pn; };
struct Gemm { const bf16_t* A; const bf16_t* Bt; int M, N, K; };

struct StaticOrder {
    int nM, nN, nwg, G, c;
    __host__ __device__ void init(int M, int N, int G_, int c_) { nM = M / BM; nN = N / BM; nwg = nM * nN; G = G_; c = c_; }
    __host__ __device__ bool next(int i, Unit& u) const {
        const long L = (long)i * G + c; if (L >= nwg) return false;
        int wgid = (int)L; { const int q = nwg / NXCD, r = nwg % NXCD, xcd = wgid % NXCD, off = wgid / NXCD; wgid = (xcd < r ? xcd * (q + 1) : r * (q + 1) + (xcd - r) * q) + off; }
        const int nig = WGM * nN, gid = wgid / nig, fm = gid * WGM, gsz = (nM - fm) < WGM ? (nM - fm) : WGM;
        u.pm = fm + ((wgid % nig) % gsz); u.pn = (wgid % nig) / gsz; return true;
    }
    __device__ __forceinline__ void a_ready(const Unit&) const {}
    __device__ __forceinline__ void done(const Unit&) const {}
};

__device__ __forceinline__ unsigned cvt_pk_bf16(float lo, float hi) { unsigned r; asm volatile("v_cvt_pk_bf16_f32 %0, %1, %2" : "=v"(r) : "v"(lo), "v"(hi)); return r; }
struct EpiBf16S {
    static constexpr bool PERM = true, AFTER_DRAIN = false;
    bf16_t* O; int ldc; unsigned scalemask; float sc;
    __device__ __forceinline__ void operator()(const f32x4 (&acc)[2][2][4][2], const Unit& u, int wr, int wc, int fr, int fq) const {
        const int row0 = u.pm * BM + wr * 64 + fr; const int col0 = u.pn * BM + wc * 32 + 8 * fq;
        const float s = ((scalemask >> u.pn) & 1u) ? sc : 1.f;
#pragma unroll
        for (int ai = 0; ai < 2; ++ai)
#pragma unroll
            for (int m = 0; m < 4; ++m) { bf16_t* rowp = O + (size_t)(row0 + ai * HALF + m * 16) * ldc + col0;
#pragma unroll
                for (int bj = 0; bj < 2; ++bj) { f32x4 v0 = acc[ai][bj][m][0] * s, v1 = acc[ai][bj][m][1] * s;
                    u32x4 w; w.x = cvt_pk_bf16(v0[0], v0[1]); w.y = cvt_pk_bf16(v0[2], v0[3]); w.z = cvt_pk_bf16(v1[0], v1[1]); w.w = cvt_pk_bf16(v1[2], v1[3]);
                    *(u32x4*)(rowp + bj * HALF) = w; } }
    }
};
struct EpiRes {
    static constexpr bool PERM = false, AFTER_DRAIN = false;
    const float* base; float* out; int ldc;
    __device__ __forceinline__ void operator()(const f32x4 (&acc)[2][2][4][2], const Unit& u, int wr, int wc, int fr, int fq) const {
        const int col0 = u.pn * BM + wc * 32 + 4 * fq;
#pragma unroll
        for (int ai = 0; ai < 2; ++ai)
#pragma unroll
            for (int m = 0; m < 4; ++m) { const size_t off = (size_t)(u.pm * BM + ai * HALF + wr * 64 + m * 16 + fr) * ldc + col0;
#pragma unroll
                for (int bj = 0; bj < 2; ++bj)
#pragma unroll
                    for (int n = 0; n < 2; ++n) { const f32x4 bs = *(const f32x4*)(base + off + bj * HALF + n * 16); *(f32x4*)(out + off + bj * HALF + n * 16) = bs + acc[ai][bj][m][n]; }
                asm volatile("" ::: "memory"); }
    }
};
template <class Epi, class Sched, bool ALIGN_EPI = false, bool SP2 = false>
__device__ __forceinline__ void gemm_phase(PG8_LAS unsigned char* lds, const Gemm g, const Sched& S, const Epi& E) {
    int tid_l = threadIdx.x; asm volatile("" : "+v"(tid_l)); const int tid = tid_l, wid = __builtin_amdgcn_readfirstlane(tid >> 6), lane = tid & 63, wr = wid >> 2, wc = wid & 3, fr = lane & 15, fq = lane >> 4;
    const int K = g.K, nt = K / BK;
    unsigned voffA[2], voffB[2];
#pragma unroll
    for (int i = 0; i < 2; ++i) { int R, C; stage_rc(tid * 16 + i * 8192, R, C); const int Rb = Epi::PERM ? ((R & ~31) + perm32(R & 31)) : R;
        voffA[i] = (unsigned)(R * K + C) * 2u; voffB[i] = (unsigned)(Rb * K + C) * 2u; }
    const size_t kstep = (size_t)(BK * 2);
    const size_t hstep = (size_t)HALF * K * 2;
    const size_t tstep = 2 * hstep;
    const unsigned ldsw = (unsigned)wid * 1024u;
    const int aoff = lds_byte(wr * 64 + fr, fq * 8), boff = lds_byte(wc * 32 + fr, fq * 8);
#define PG8_SA(b, h) (((b) * 2 + (h)) * HTB)
#define PG8_SB(b, h) ((4 + (b) * 2 + (h)) * HTB)
#define PG8_STAGE(bufoff, gbase, voff) do { _Pragma("unroll") for (int _i = 0; _i < 2; ++_i) \
        __builtin_amdgcn_global_load_lds((const unsigned*)((const char*)(gbase) + (voff)[_i]), (PG8_LAS unsigned*)(lds + (bufoff) + ldsw + _i * 8192), 16, 0, 0); } while (0)
#define PG8_LDA(dst, b, h) do { _Pragma("unroll") for (int m = 0; m < 4; ++m) _Pragma("unroll") for (int k = 0; k < 2; ++k) dst[m][k] = *(const PG8_LAS bf16x8*)(lds + PG8_SA(b, h) + aoff + m * 2048 + k * 1024); } while (0)
#define PG8_LDB(dst, b, h) do { _Pragma("unroll") for (int n = 0; n < 2; ++n) _Pragma("unroll") for (int k = 0; k < 2; ++k) dst[n][k] = *(const PG8_LAS bf16x8*)(lds + PG8_SB(b, h) + boff + n * 2048 + k * 1024); } while (0)
#define PG8_MMA(ai, bj, At, Bt) do { __builtin_amdgcn_s_setprio(1); _Pragma("unroll") for (int m = 0; m < 4; ++m) _Pragma("unroll") for (int n = 0; n < 2; ++n) _Pragma("unroll") for (int k = 0; k < 2; ++k) \
        acc[ai][bj][m][n] = __builtin_amdgcn_mfma_f32_16x16x32_bf16(Bt[n][k], At[m][k], acc[ai][bj][m][n], 0, 0, 0); __builtin_amdgcn_s_setprio(0); } while (0)
#define PG8_WAIT_V(n) asm volatile("s_waitcnt vmcnt(" #n ")" ::: "memory")
#define PG8_WAIT_L(n) asm volatile("s_waitcnt lgkmcnt(" #n ")" ::: "memory")
#define PG8_BAR __builtin_amdgcn_s_barrier()
#define PG8_SCHED __builtin_amdgcn_sched_barrier(0)
    Unit cur, nxt; int ui = 0;
    if (!S.next(0, cur)) return;
    f32x4 acc[2][2][4][2];
#pragma unroll
    for (int a = 0; a < 2; ++a)
#pragma unroll
        for (int b = 0; b < 2; ++b)
#pragma unroll
            for (int m = 0; m < 4; ++m)
#pragma unroll
                for (int n = 0; n < 2; ++n) acc[a][b][m][n] = (f32x4){0.f, 0.f, 0.f, 0.f};
    bf16x8 At[4][2], B0[2][2], B1[2][2];
    const char* cA = (const char*)g.A + (size_t)cur.pm * tstep; const char* cB = (const char*)g.Bt + (size_t)cur.pn * tstep;
    S.a_ready(cur);
    if constexpr (SP2) {
        PG8_STAGE(PG8_SB(0, 0), cB, voffB); PG8_STAGE(PG8_SB(0, 1), cB + hstep, voffB); PG8_STAGE(PG8_SA(0, 0), cA, voffA); PG8_STAGE(PG8_SA(0, 1), cA + hstep, voffA);
        if (wr == 1) PG8_BAR;
        PG8_WAIT_V(2); PG8_BAR;
        PG8_STAGE(PG8_SB(1, 0), cB + kstep, voffB); PG8_STAGE(PG8_SA(1, 0), cA + kstep, voffA); PG8_STAGE(PG8_SB(1, 1), cB + hstep + kstep, voffB);
        PG8_WAIT_V(6); PG8_BAR;
    } else {
        PG8_STAGE(PG8_SB(0, 0), cB, voffB); PG8_STAGE(PG8_SA(0, 0), cA, voffA); PG8_STAGE(PG8_SB(0, 1), cB + hstep, voffB); PG8_STAGE(PG8_SA(0, 1), cA + hstep, voffA);
        if (wr == 1) PG8_BAR;
        PG8_WAIT_V(4); PG8_BAR;
        PG8_STAGE(PG8_SB(1, 0), cB + kstep, voffB); PG8_STAGE(PG8_SA(1, 0), cA + kstep, voffA); PG8_STAGE(PG8_SB(1, 1), cB + hstep + kstep, voffB);
        PG8_WAIT_V(6); PG8_BAR;
    }
    for (;;) {
        const bool has_next = S.next(ui + 1, nxt);
        const char* nA = has_next ? (const char*)g.A + (size_t)nxt.pm * tstep : cA; const char* nB = has_next ? (const char*)g.Bt + (size_t)nxt.pn * tstep : cB;
        for (int t = 0; t < nt; t += 2) {
            const bool last = (t == nt - 2);
            const char* a1 = cA + (size_t)(t + 1) * kstep;
            const char* a2 = last ? nA : cA + (size_t)(t + 2) * kstep; const char* b2 = last ? nB : cB + (size_t)(t + 2) * kstep;
            const char* a3 = a2 + kstep; const char* b3 = b2 + kstep;
            if (last && has_next) S.a_ready(nxt);
            if constexpr (SP2) {
            PG8_LDB(B0, 0, 0); PG8_LDB(B1, 0, 1); PG8_SCHED; PG8_LDA(At, 0, 0); PG8_STAGE(PG8_SA(1, 1), a1 + hstep, voffA);
            PG8_WAIT_V(8); PG8_WAIT_L(0); PG8_BAR; PG8_MMA(0, 0, At, B0); PG8_MMA(0, 1, At, B1); PG8_BAR; PG8_SCHED;
            PG8_LDA(At, 0, 1); PG8_STAGE(PG8_SB(0, 0), b2, voffB); PG8_STAGE(PG8_SB(0, 1), b2 + hstep, voffB); PG8_STAGE(PG8_SA(0, 0), a2, voffA);
            PG8_WAIT_V(8); PG8_WAIT_L(0); PG8_BAR; PG8_MMA(1, 0, At, B0); PG8_MMA(1, 1, At, B1); PG8_BAR; PG8_SCHED;
            PG8_LDB(B0, 1, 0); PG8_LDB(B1, 1, 1); PG8_SCHED; PG8_LDA(At, 1, 0); PG8_STAGE(PG8_SA(0, 1), a2 + hstep, voffA);
            PG8_WAIT_V(8); PG8_WAIT_L(0); PG8_BAR; PG8_MMA(0, 0, At, B0); PG8_MMA(0, 1, At, B1); PG8_BAR; PG8_SCHED;
            PG8_LDA(At, 1, 1); PG8_STAGE(PG8_SB(1, 0), b3, voffB); PG8_STAGE(PG8_SB(1, 1), b3 + hstep, voffB); PG8_STAGE(PG8_SA(1, 0), a3, voffA);
            PG8_WAIT_V(8); PG8_WAIT_L(0); PG8_BAR; PG8_MMA(1, 0, At, B0); PG8_MMA(1, 1, At, B1); PG8_BAR; PG8_SCHED;
            } else {
            PG8_LDB(B0, 0, 0); PG8_SCHED; PG8_LDA(At, 0, 0); PG8_STAGE(PG8_SA(1, 1), a1 + hstep, voffA);
            PG8_WAIT_L(8); PG8_BAR; PG8_WAIT_L(0); PG8_MMA(0, 0, At, B0); PG8_BAR; PG8_SCHED;
            PG8_LDB(B1, 0, 1); PG8_STAGE(PG8_SB(0, 0), b2, voffB);
            PG8_BAR; PG8_WAIT_L(0); PG8_MMA(0, 1, At, B1); PG8_BAR;
            PG8_LDA(At, 0, 1); PG8_STAGE(PG8_SA(0, 0), a2, voffA);
            PG8_BAR; PG8_WAIT_L(0); PG8_MMA(1, 0, At, B0); PG8_BAR; PG8_SCHED;
            PG8_STAGE(PG8_SB(0, 1), b2 + hstep, voffB);
            PG8_WAIT_V(6); PG8_BAR; PG8_MMA(1, 1, At, B1); PG8_BAR;
            PG8_LDB(B0, 1, 0); PG8_SCHED; PG8_LDA(At, 1, 0); PG8_STAGE(PG8_SA(0, 1), a2 + hstep, voffA);
            PG8_WAIT_L(8); PG8_BAR; PG8_WAIT_L(0); PG8_MMA(0, 0, At, B0); PG8_BAR; PG8_SCHED;
            PG8_LDB(B1, 1, 1); PG8_STAGE(PG8_SB(1, 0), b3, voffB);
            PG8_BAR; PG8_WAIT_L(0); PG8_MMA(0, 1, At, B1); PG8_BAR;
            PG8_LDA(At, 1, 1); PG8_STAGE(PG8_SA(1, 0), a3, voffA);
            PG8_BAR; PG8_WAIT_L(0); PG8_MMA(1, 0, At, B0); PG8_BAR; PG8_SCHED;
            PG8_STAGE(PG8_SB(1, 1), b3 + hstep, voffB);
            PG8_WAIT_V(6); PG8_BAR; PG8_MMA(1, 1, At, B1); PG8_BAR;
            }
        }
        if constexpr (ALIGN_EPI) { if (wr == 0) PG8_BAR; }
        if constexpr (!Epi::AFTER_DRAIN) { E(acc, cur, wr, wc, fr, fq); S.done(cur); }
        if (!has_next) break;
#pragma unroll
        for (int a = 0; a < 2; ++a)
#pragma unroll
            for (int b = 0; b < 2; ++b)
#pragma unroll
                for (int m = 0; m < 4; ++m)
#pragma unroll
                    for (int n = 0; n < 2; ++n) acc[a][b][m][n] = (f32x4){0.f, 0.f, 0.f, 0.f};
        cur = nxt; cA = nA; cB = nB; ++ui;
        if constexpr (ALIGN_EPI) { if (wr == 1) PG8_BAR; }
    }
    PG8_WAIT_V(0);
    if constexpr (!ALIGN_EPI) { if (wr == 0) PG8_BAR; }
    PG8_BAR;
    if constexpr (Epi::AFTER_DRAIN) { E.fused(acc, cur, wr, wc, fr, fq, lds, wid, lane); S.done(cur); }
#undef PG8_SA
#undef PG8_SB
#undef PG8_STAGE
#undef PG8_LDA
#undef PG8_LDB
#undef PG8_MMA
#undef PG8_WAIT_V
#undef PG8_WAIT_L
#undef PG8_BAR
#undef PG8_SCHED
}
}
typedef __bf16 bf16x2_t __attribute__((ext_vector_type(2)));
__device__ __forceinline__ unsigned cvt_pk(float lo, float hi) { float __attribute__((ext_vector_type(2))) v = {lo, hi}; bf16x2_t b = __builtin_convertvector(v, bf16x2_t); return __builtin_bit_cast(unsigned, b); }
#define LAS __attribute__((address_space(3)))
#define XB_TMO      128
#define XB_XCNT(j)  (256  + 64 * (j))
#define XB_XSUB(j)  (1280 + 64 * (j))
#define XB_XGEN(j)  (2304 + 64 * (j))
#define XB_TOP      3328
#define XB_TOPGEN   3392
#define XCD_BAR_WORDS 3456
#define XB_SPIN_CAP (1u << 18)

__device__ __forceinline__ unsigned xb_ld(unsigned* p)              { return __hip_atomic_load(p, __ATOMIC_RELAXED, __HIP_MEMORY_SCOPE_AGENT); }
__device__ __forceinline__ unsigned xb_add(unsigned* p, unsigned v) { return __hip_atomic_fetch_add(p, v, __ATOMIC_RELAXED, __HIP_MEMORY_SCOPE_AGENT); }
__device__ __forceinline__ unsigned xb_xcc_id() { return (unsigned)__builtin_amdgcn_s_getreg((3 << 11) | 20) & 0xFu; }
#define XB_SPIN(cond, bar) do { unsigned _sp = 0; while (cond) { __builtin_amdgcn_s_sleep(1); \
    if ((++_sp & 255u) == 0u) { if (xb_ld(&(bar)[XB_TMO])) break; if (_sp > XB_SPIN_CAP) { atomicAdd(&(bar)[XB_TMO], 1u); break; } } } } while (0)

struct XcdBarrier {
    unsigned* bar; unsigned x;
    volatile LAS unsigned* st;
};

__device__ __forceinline__ XcdBarrier xcd_barrier_post(unsigned* bar, volatile LAS unsigned* st) {
    XcdBarrier b; b.bar = bar; b.x = xb_xcc_id(); b.st = st;
    if (threadIdx.x == 0) (void)xb_add(&bar[XB_XCNT(b.x)], 1u);
    return b;
}
__device__ __forceinline__ void xcd_barrier_complete(unsigned* bar, unsigned x, unsigned& nloc, unsigned& nx) {
    const unsigned G = gridDim.x * gridDim.y * gridDim.z;
    unsigned sum, cnt, mine, sp = 0u;
    for (;;) {
        sum = 0u; cnt = 0u; mine = 0u;
#pragma unroll
        for (unsigned j = 0; j < 16; ++j) { const unsigned c = xb_ld(&bar[XB_XCNT(j)]); sum += c; cnt += (c > 0u) ? 1u : 0u; mine = (j == x) ? c : mine; }
        if (sum == G) break;
        __builtin_amdgcn_s_sleep(1);
        if ((++sp & 255u) == 0u) { if (xb_ld(&bar[XB_TMO])) break; if (sp > XB_SPIN_CAP) { atomicAdd(&bar[XB_TMO], 1u); break; } }
    }
    nloc = mine > 0u ? mine : 1u; nx = cnt > 0u ? cnt : 1u;
}

__device__ __forceinline__ void xcd_barrier(const XcdBarrier& b) {
    asm volatile("s_waitcnt vmcnt(0)" ::: "memory");
    __syncthreads();
    if (threadIdx.x == 0) {
        unsigned* bar = b.bar;
        __builtin_amdgcn_s_waitcnt(0);
        unsigned nloc = b.st[0], nx = b.st[1];
        if (nloc == 0u) { xcd_barrier_complete(bar, b.x, nloc, nx); b.st[0] = nloc; b.st[1] = nx; }
        const unsigned old = xb_add(&bar[XB_XSUB(b.x)], 1u);
        const unsigned gen = old / nloc;
        if (old + 1u == (gen + 1u) * nloc) {
            __builtin_amdgcn_fence(__ATOMIC_RELEASE, "agent");
            asm volatile("s_waitcnt vmcnt(0)" ::: "memory");
            const unsigned og = xb_add(&bar[XB_TOP], 1u);
            const unsigned tg = og / nx;
            if (og + 1u == (tg + 1u) * nx) xb_add(&bar[XB_TOPGEN], 1u);
            else XB_SPIN(xb_ld(&bar[XB_TOPGEN]) == tg, bar);
            __builtin_amdgcn_fence(__ATOMIC_ACQUIRE, "agent");
            xb_add(&bar[XB_XGEN(b.x)], 1u);
            asm volatile("s_waitcnt vmcnt(0)" ::: "memory");
        } else {
            XB_SPIN(xb_ld(&bar[XB_XGEN(b.x)]) == gen, bar);
            __builtin_amdgcn_fence(__ATOMIC_ACQUIRE, "agent");
            asm volatile("s_waitcnt vmcnt(0)" ::: "memory");
        }
    }
    __syncthreads();
}
typedef unsigned short bf16_t;
typedef short bf16x8 __attribute__((ext_vector_type(8)));
typedef short s16x4 __attribute__((ext_vector_type(4)));
typedef float f32x16 __attribute__((ext_vector_type(16)));
typedef float f32x4 __attribute__((ext_vector_type(4)));
typedef float f32x2 __attribute__((ext_vector_type(2)));
typedef unsigned u32x4 __attribute__((ext_vector_type(4)));
typedef unsigned u32x2 __attribute__((ext_vector_type(2)));

constexpr int DM = 1024, DIN = 4352, DFF = 2816, DUP = 2 * DFF, DEPTH = 2;
constexpr int CH_ROWS = 16384, NCHUNK = 3;
constexpr int TW = 2064;
constexpr int T_A = 0, T_B = 256, T_C = 1280, T_L = 2048;
constexpr float LOG2E = 1.4426950408889634f, LN2 = 0.6931471805599453f;
constexpr float QSCALE = 0.125f * LOG2E;
constexpr size_t MiB = 1u << 20;
constexpr size_t WS_WIN = 0, WS_WOUT = 18 * MiB, WS_WUP = 22 * MiB, WS_WDN = 44 * MiB, WS_HB = 56 * MiB, WS_PROJ = 88 * MiB, WS_TMP = 264 * MiB, WS_CTL = 394 * MiB, WS_END = 395 * MiB;
constexpr int LDS_BYTES = 147456;
constexpr int NTHREADS = 512;

struct Args { const float* in[17]; float* out; unsigned char* ws; };

__device__ __forceinline__ float wave_sum(float v) {
#pragma unroll
    for (int o = 1; o < 64; o <<= 1) v += __shfl_xor(v, o);
    return v;
}
__device__ __forceinline__ unsigned f2bf(float f) { unsigned u = __builtin_bit_cast(unsigned, f); return (u + 0x7fffu + ((u >> 16) & 1u)) >> 16; }
__device__ __forceinline__ unsigned pk2(float lo, float hi) { return f2bf(lo) | (f2bf(hi) << 16); }
__device__ __forceinline__ float bf2f(unsigned short b) { return __builtin_bit_cast(float, (unsigned)b << 16); }

__device__ __forceinline__ void transpose_item(const float* W, int K, int N, bf16_t* WT, LAS float* scr, int item, int lane) {
    const int nblk = N / 32, kb = item / nblk, nb = item % nblk, k0 = 64 * kb, n0 = 32 * nb;
#pragma unroll 8
    for (int i = 0; i < 32; ++i) { const int kk = 2 * i + (lane >> 5); scr[kk * 33 + (lane & 31)] = W[(size_t)(k0 + kk) * N + n0 + (lane & 31)]; }
    asm volatile("s_waitcnt lgkmcnt(0)" ::: "memory");
    const int c = lane & 7;
#pragma unroll
    for (int j = 0; j < 4; ++j) { const int n = (lane >> 3) + 8 * j; const LAS float* s = scr + (8 * c) * 33 + n;
        u32x4 o; o.x = pk2(s[0 * 33], s[1 * 33]); o.y = pk2(s[2 * 33], s[3 * 33]); o.z = pk2(s[4 * 33], s[5 * 33]); o.w = pk2(s[6 * 33], s[7 * 33]);
        *(u32x4*)(WT + (size_t)(n0 + n) * K + k0 + 8 * c) = o; }
    asm volatile("s_waitcnt lgkmcnt(0)" ::: "memory");
}

__device__ __forceinline__ void rms_row_to_bf16(const float* xrow, const float* gain, bf16_t* orow, int lane) {
    const f32x4* xr = (const f32x4*)xrow + lane; const f32x4* gr = (const f32x4*)gain + lane;
    f32x4 v[4]; float s = 0.f;
#pragma unroll
    for (int j = 0; j < 4; ++j) { v[j] = xr[64 * j]; s += (v[j].x * v[j].x + v[j].y * v[j].y) + (v[j].z * v[j].z + v[j].w * v[j].w); }
    const float rstd = 1.f / sqrtf(wave_sum(s) * (1.f / DM) + 1e-6f);
    u32x2* o8 = (u32x2*)orow + lane;
#pragma unroll
    for (int j = 0; j < 4; ++j) { const f32x4 g = gr[64 * j]; u32x2 w; w.x = pk2(v[j].x * rstd * g.x, v[j].y * rstd * g.y); w.y = pk2(v[j].z * rstd * g.z, v[j].w * rstd * g.w); o8[64 * j] = w; }
}
__device__ __forceinline__ void rms_row_f32(float* xrow, const float* gain, int lane) {
    f32x4* xr = (f32x4*)xrow + lane; const f32x4* gr = (const f32x4*)gain + lane;
    f32x4 v[4]; float s = 0.f;
#pragma unroll
    for (int j = 0; j < 4; ++j) { v[j] = xr[64 * j]; s += (v[j].x * v[j].x + v[j].y * v[j].y) + (v[j].z * v[j].z + v[j].w * v[j].w); }
    const float rstd = 1.f / sqrtf(wave_sum(s) * (1.f / DM) + 1e-6f);
#pragma unroll
    for (int j = 0; j < 4; ++j) { const f32x4 g = gr[64 * j]; xr[64 * j] = v[j] * rstd * g; }
}

constexpr int KSTR = 144;
constexpr int ATT_K_OFF = 0, ATT_V_OFF = 2 * 64 * KSTR, ATT_SCR_OFF = ATT_V_OFF + 2 * 64 * 320;
__device__ __forceinline__ int crow(int r, int hi) { return (r & 3) + 8 * (r >> 2) + 4 * hi; }
typedef short v4i16_t __attribute__((ext_vector_type(4)));
__device__ __forceinline__ s16x4 vtr(const LAS unsigned char* p) { return __builtin_bit_cast(s16x4, __builtin_amdgcn_ds_read_tr16_b64_v4i16((LAS v4i16_t*)p)); }

template <int VD, bool WIN>
__device__ __forceinline__ void attn_unit(LAS unsigned char* lds, const bf16_t* Qp, const bf16_t* Kp, const bf16_t* Vp, size_t pitch,
                                          int q0, int L, float slope2, int W, float m_init, float l_init,
                                          float* Oout, size_t opitch, float* lse_out, size_t lpitch) {
    constexpr int VSTR = VD * 2 + 64, ND = VD / 32, VCH = VD / 8, VLD = 64 * VCH / NTHREADS;
    int tid_l = threadIdx.x; asm volatile("" : "+v"(tid_l)); const int tid = tid_l, lane = tid & 63, r32 = lane & 31, hi = lane >> 5, wid = __builtin_amdgcn_readfirstlane(tid >> 6);
    const int qw = q0 + wid * 32;
    int tlo = 0, thi = L / 64;
    if (WIN) { const int a = q0 - W; tlo = a > 0 ? a / 64 : 0; const int b = q0 + 256 + W; thi = (b < L ? b : L) / 64; }
    bf16x8 qr[4];
    { const bf16_t* qrow = Qp + (size_t)(qw + r32) * pitch + hi * 8;
#pragma unroll
      for (int d0 = 0; d0 < 4; ++d0) qr[d0] = *(const bf16x8*)(qrow + d0 * 16); }
    f32x16 o[ND];
#pragma unroll
    for (int d = 0; d < ND; ++d)
#pragma unroll
        for (int r = 0; r < 16; ++r) o[d][r] = 0.f;
    float m = m_init, l = hi == 0 ? l_init : 0.f;
    LAS float* wsf = (LAS float*)(lds + ATT_SCR_OFF) + wid * 64;
    const int krow = tid >> 3, kch = tid & 7;
    u32x4 kreg; u32x4 vreg[VLD];
#define ATT_GLOAD(t) do { kreg = *(const u32x4*)(Kp + (size_t)(64 * (t) + krow) * pitch + kch * 8); \
        _Pragma("unroll") for (int i_ = 0; i_ < VLD; ++i_) { const int idx_ = tid + NTHREADS * i_; vreg[i_] = *(const u32x4*)(Vp + (size_t)(64 * (t) + idx_ / VCH) * pitch + (idx_ % VCH) * 8); } } while (0)
#define ATT_LSTORE(b) do { *(LAS u32x4*)(lds + ATT_K_OFF + (b) * 64 * KSTR + krow * KSTR + kch * 16) = kreg; \
        _Pragma("unroll") for (int i_ = 0; i_ < VLD; ++i_) { const int idx_ = tid + NTHREADS * i_; *(LAS u32x4*)(lds + ATT_V_OFF + (b) * 64 * VSTR + (idx_ / VCH) * VSTR + (idx_ % VCH) * 16) = vreg[i_]; } } while (0)
    const int n = thi - tlo;
    ATT_GLOAD(tlo); ATT_LSTORE(0); __syncthreads();
    const float Wf = (float)W;
    for (int i = 0; i < n; ++i) {
        const int t = tlo + i, buf = i & 1;
        if (i + 1 < n) ATT_GLOAD(t + 1);
        bool active = true;
        if (WIN) { const int kb = 64 * t; active = (kb + 63 >= qw - W) && (kb <= qw + 31 + W); }
        if (active) {
            const LAS unsigned char* Kb = lds + ATT_K_OFF + buf * 64 * KSTR + r32 * KSTR + hi * 16;
            f32x16 p0, p1;
#pragma unroll
            for (int r = 0; r < 16; ++r) { p0[r] = 0.f; p1[r] = 0.f; }
#pragma unroll
            for (int d0 = 0; d0 < 4; ++d0) {
                const bf16x8 a0 = *(const LAS bf16x8*)(Kb + d0 * 32), a1 = *(const LAS bf16x8*)(Kb + 32 * KSTR + d0 * 32);
                p0 = __builtin_amdgcn_mfma_f32_32x32x16_bf16(a0, qr[d0], p0, 0, 0, 0);
                p1 = __builtin_amdgcn_mfma_f32_32x32x16_bf16(a1, qr[d0], p1, 0, 0, 0);
                if (d0 & 1) __builtin_amdgcn_sched_barrier(0);
            }
            const float dq = (float)(64 * t + 4 * hi - (qw + r32));
            float rm = -INFINITY;
#pragma unroll
            for (int r = 0; r < 16; ++r) {
                const float t0 = dq + (float)((r & 3) + 8 * (r >> 2)), t1 = t0 + 32.f;
                p0[r] = __builtin_fmaf(-slope2, __builtin_fabsf(t0), p0[r]);
                p1[r] = __builtin_fmaf(-slope2, __builtin_fabsf(t1), p1[r]);
                if (WIN) { if (__builtin_fabsf(t0) > Wf) p0[r] = -INFINITY; if (__builtin_fabsf(t1) > Wf) p1[r] = -INFINITY; }
                rm = __builtin_fmaxf(rm, __builtin_fmaxf(p0[r], p1[r]));
            }
            rm = __builtin_fmaxf(rm, __shfl_xor(rm, 32));
            if (__any(rm > m)) {
                const float mn = __builtin_fmaxf(m, rm); const float f = __builtin_amdgcn_exp2f(m - mn); m = mn; l *= f;
                if (hi == 0) wsf[r32] = f;
#pragma unroll
                for (int r = 0; r < 16; ++r) { const float fr = wsf[crow(r, hi)];
#pragma unroll
                    for (int d = 0; d < ND; ++d) o[d][r] *= fr; }
            }
            float ls = 0.f;
#pragma unroll
            for (int r = 0; r < 16; ++r) { p0[r] = __builtin_amdgcn_exp2f(p0[r] - m); p1[r] = __builtin_amdgcn_exp2f(p1[r] - m); ls += p0[r] + p1[r]; }
            l += ls;
            u32x4 pw[4];
#pragma unroll
            for (int c = 0; c < 4; ++c) {
                const f32x16& P = (c >> 1) ? p1 : p0; const int b = 8 * (c & 1);
                pw[c].x = cvt_pk(P[b + 0], P[b + 1]); pw[c].y = cvt_pk(P[b + 2], P[b + 3]); pw[c].z = cvt_pk(P[b + 4], P[b + 5]); pw[c].w = cvt_pk(P[b + 6], P[b + 7]);
            }
            const LAS unsigned char* Vb = lds + ATT_V_OFF + buf * 64 * VSTR + (4 * hi + ((lane & 15) >> 2)) * VSTR + (16 * ((lane >> 4) & 1) + 4 * (lane & 3)) * 2;
#pragma unroll
            for (int c = 0; c < 4; ++c)
#pragma unroll
                for (int d = 0; d < ND; ++d) {
                    const s16x4 vlo = vtr(Vb + c * 16 * VSTR + d * 64), vhi = vtr(Vb + c * 16 * VSTR + 8 * VSTR + d * 64);
                    const bf16x8 vf = (bf16x8){vlo[0], vlo[1], vlo[2], vlo[3], vhi[0], vhi[1], vhi[2], vhi[3]};
                    o[d] = __builtin_amdgcn_mfma_f32_32x32x16_bf16(__builtin_bit_cast(bf16x8, pw[c]), vf, o[d], 0, 0, 0);
                    if (d == ND - 1) __builtin_amdgcn_sched_barrier(0);
                }
        }
        if (i + 1 < n) ATT_LSTORE(buf ^ 1);
        __syncthreads();
    }
#undef ATT_GLOAD
#undef ATT_LSTORE
    l += __shfl_xor(l, 32);
    if (hi == 0) wsf[r32] = 1.f / l;
#pragma unroll
    for (int r = 0; r < 16; ++r) { const float ir = wsf[crow(r, hi)]; float* orow = Oout + (size_t)(qw + crow(r, hi)) * opitch + r32;
#pragma unroll
        for (int d = 0; d < ND; ++d) orow[d * 32] = o[d][r] * ir; }
    if (lse_out != nullptr && hi == 0) lse_out[(size_t)(qw + r32) * lpitch] = (m + __builtin_log2f(l)) * LN2;
    __syncthreads();
}
__device__ __forceinline__ float alibi_slope(int i, int n) { return exp2f(-8.0f * (float)(i + 1) / (float)n); }
struct Ctx { int tid, lane, wave, G, cu, gw, NGW; };

__device__ __forceinline__ void ph_weights(const Args& a, const Ctx& c, LAS unsigned char* lds) {
    unsigned char* ws = a.ws;
    bf16_t* WinT = (bf16_t*)(ws + WS_WIN); bf16_t* WoutT = (bf16_t*)(ws + WS_WOUT); bf16_t* WupT = (bf16_t*)(ws + WS_WUP); bf16_t* WdnT = (bf16_t*)(ws + WS_WDN);
    const float* w_in = a.in[3]; const float* w_out = a.in[10]; const float* w_up = a.in[12]; const float* w_down = a.in[15];
    LAS float* scr = (LAS float*)(lds + c.wave * 16384);
    constexpr int I_IN = (DM / 64) * (DIN / 32), I_OUT = (DM / 64) * (DM / 32), I_UP = (DM / 64) * (DUP / 32), I_DN = (DFF / 64) * (DM / 32);
    constexpr int PER_L = I_IN + I_OUT + I_UP + I_DN;
    for (int it = c.gw; it < DEPTH * PER_L; it += c.NGW) {
        const int l = it / PER_L; int r = it % PER_L;
        if (r < I_IN) { transpose_item(w_in + (size_t)l * DM * DIN, DM, DIN, WinT + (size_t)l * DIN * DM, scr, r, c.lane); continue; } r -= I_IN;
        if (r < I_OUT) { transpose_item(w_out + (size_t)l * DM * DM, DM, DM, WoutT + (size_t)l * DM * DM, scr, r, c.lane); continue; } r -= I_OUT;
        if (r < I_UP) { transpose_item(w_up + (size_t)l * DM * DUP, DM, DUP, WupT + (size_t)l * DUP * DM, scr, r, c.lane); continue; } r -= I_UP;
        transpose_item(w_down + (size_t)l * DFF * DM, DFF, DM, WdnT + (size_t)l * DM * DFF, scr, r, c.lane);
    }
}
__device__ __forceinline__ const float* chunk_in(const Args& a, int ch) { return ch == 0 ? a.in[0] : a.in[1] + (size_t)(ch - 1) * CH_ROWS * DM; }
__device__ __forceinline__ float* chunk_out(const Args& a, int ch) { return a.out + (size_t)ch * CH_ROWS * DM; }

__device__ __forceinline__ void ph_norm_bf16(const Ctx& c, const float* xsrc, const float* gain, bf16_t* HB) {
    for (int r = c.gw; r < CH_ROWS; r += c.NGW) rms_row_to_bf16(xsrc + (size_t)r * DM, gain, HB + (size_t)r * DM, c.lane);
}
__device__ __forceinline__ void ph_final_norm(const Ctx& c, float* xo, const float* gain) {
    for (int r = c.gw; r < CH_ROWS; r += c.NGW) rms_row_f32(xo + (size_t)r * DM, gain, c.lane);
}

__device__ __forceinline__ void ph_attn(const Args& a, const Ctx& c, LAS unsigned char* lds, int ch, int layer) {
    const bf16_t* PROJ = (const bf16_t*)(a.ws + WS_PROJ); float* TMP = (float*)(a.ws + WS_TMP);
    const int SL = ch == 0 ? 16384 : 4096, sl_shift = ch == 0 ? 14 : 12;
    const int cu = c.cu, G = c.G;
#ifndef SKIP_B
#ifdef PROBE_B2
    for (int rep_ = 0; rep_ < 2; ++rep_)
#endif
    for (int ub = 2 * cu; ub < 512; ub += 2 * G)
        for (int k = 0; k < 2; ++k) {
            const int u = ub + k;
            int seq, h, mp, qb;
            if (ch == 0) { seq = 0; h = u >> 7; mp = (u >> 6) & 1; qb = u & 63; }
            else { seq = u >> 7; h = (u >> 5) & 3; mp = (u >> 4) & 1; qb = u & 15; }
            const size_t rb = (size_t)seq * SL;
            const bf16_t* base = PROJ + rb * DIN;
            attn_unit<128, false>(lds, base + 512 + (h * 2 + mp) * 64, base + 1024 + (h * 2 + mp) * 64, base + 1536 + h * 128, (size_t)DIN,
                                  qb * 256, SL, alibi_slope(h, 4) * LOG2E, 0, -1e30f, 0.f,
                                  TMP + rb * TW + T_B + (h * 2 + mp) * 128, (size_t)TW, nullptr, 0);
        }
#endif
#ifndef SKIP_AC
#ifdef PROBE_AC2
    for (int rep_ = 0; rep_ < 2; ++rep_)
#endif
    for (int uu = cu; uu < 1024; uu += G) {
        const bf16_t *qp, *kp, *vp; size_t pitch, opitch, lpitch; int q0, L, W; float slope2, m_init, l_init; float *op, *lp;
        if (uu < 256) {
            const int hq = uu >> 6, blk = uu & 63;
            const int seq = (blk * 256) >> sl_shift, qb = blk - ((seq << sl_shift) >> 8);
            const size_t rb = (size_t)seq * SL; const bf16_t* base = PROJ + rb * DIN;
            qp = base + hq * 64; kp = base + 256 + (hq >> 1) * 64; vp = base + 384 + (hq >> 1) * 64; pitch = DIN; q0 = qb * 256; L = SL;
            slope2 = alibi_slope(hq, 4) * LOG2E; W = 128; m_init = a.in[4][layer * 4 + hq] * LOG2E; l_init = 1.f;
            op = TMP + rb * TW + T_A + hq * 64; opitch = TW; lp = nullptr; lpitch = 0;
        } else {
            const int uc = uu - 256;
            const int gh = uc >> 6, blk = uc & 63, gq = gh >> 2;
            const int dsh = 2 * gq, d = 1 << dsh;
            const int seq = (blk * 256) >> sl_shift, b2 = blk - ((seq << sl_shift) >> 8);
            const int nbr = (SL >> dsh) >> 8;
            const int res = b2 / nbr, qb = b2 % nbr;
            const size_t rb = (size_t)seq * SL + res; const bf16_t* base = PROJ + rb * DIN;
            qp = base + 2048 + gh * 64; kp = base + 2816 + gh * 64; vp = base + 3584 + gh * 64; pitch = (size_t)DIN * d; q0 = qb * 256; L = SL >> dsh;
            slope2 = alibi_slope(gh, 12) * (float)d * LOG2E; W = 64; m_init = -1e30f; l_init = 0.f;
            op = TMP + rb * TW + T_C + gh * 64; opitch = (size_t)TW * d; lp = TMP + rb * TW + T_L + gh; lpitch = (size_t)TW * d;
        }
        attn_unit<64, true>(lds, qp, kp, vp, pitch, q0, L, slope2, W, m_init, l_init, op, opitch, lp, lpitch);
    }
#endif
}

__device__ __forceinline__ void ph_combine(const Args& a, const Ctx& c, int layer) {
    const float* TMP = (const float*)(a.ws + WS_TMP); bf16_t* HB = (bf16_t*)(a.ws + WS_HB);
    const int lane = c.lane;
    const float lam_init = layer == 0 ? 0.2f : (0.8f - 0.6f * 0.7408182206817179f);
    const float s1 = wave_sum(a.in[5][layer * 64 + lane] * a.in[6][layer * 64 + lane]);
    const float s2 = wave_sum(a.in[7][layer * 64 + lane] * a.in[8][layer * 64 + lane]);
    const float lam = expf(s1) - expf(s2) + lam_init;
    const float* subln = a.in[9];
    const float g0 = subln[layer * 128 + 2 * lane] * (1.f - lam_init), g1 = subln[layer * 128 + 2 * lane + 1] * (1.f - lam_init);
    for (int r = c.gw; r < CH_ROWS; r += c.NGW) {
        const float* tr = TMP + (size_t)r * TW; bf16_t* mr = HB + (size_t)r * DM;
        { const f32x4 v = *(const f32x4*)(tr + T_A + 4 * lane); u32x2 w; w.x = pk2(v.x, v.y); w.y = pk2(v.z, v.w); *(u32x2*)(mr + 4 * lane) = w; }
#pragma unroll
        for (int h = 0; h < 4; ++h) {
            const f32x2 o0 = *(const f32x2*)(tr + T_B + (h * 2) * 128 + 2 * lane), o1 = *(const f32x2*)(tr + T_B + (h * 2 + 1) * 128 + 2 * lane);
            const float ox = o0.x - lam * o1.x, oy = o0.y - lam * o1.y;
            const float ss = wave_sum(ox * ox + oy * oy);
            const float rstd = 1.f / sqrtf(ss * (1.f / 128.f) + 1e-5f);
            *(unsigned*)(mr + 256 + h * 128 + 2 * lane) = pk2(ox * rstd * g0, oy * rstd * g1);
        }
#pragma unroll
        for (int h = 0; h < 4; ++h) {
            const float l0 = tr[T_L + h], l1 = tr[T_L + 4 + h], l2 = tr[T_L + 8 + h];
            const float mx = fmaxf(l0, fmaxf(l1, l2));
            const float w0 = expf(l0 - mx), w1 = expf(l1 - mx), w2 = expf(l2 - mx);
            const float inv = 1.f / (w0 + w1 + w2);
            const float o = (w0 * tr[T_C + h * 64 + lane] + w1 * tr[T_C + (4 + h) * 64 + lane] + w2 * tr[T_C + (8 + h) * 64 + lane]) * inv;
            mr[768 + h * 64 + lane] = (bf16_t)f2bf(o);
        }
    }
}

__device__ __forceinline__ void ph_conv(const Args& a, const Ctx& c, int ch, int layer) {
    const bf16_t* UB = (const bf16_t*)(a.ws + WS_PROJ); bf16_t* GB = (bf16_t*)(a.ws + WS_TMP);
    const int SL = ch == 0 ? 16384 : 4096;
    const float* cw = a.in[13] + (size_t)layer * 3 * DUP; const float* cb = a.in[14] + (size_t)layer * DUP;
    constexpr int NCP = DFF / 2, RB = 16;
    const int nitems = (CH_ROWS / RB) * NCP;
    for (int it = c.cu * NTHREADS + c.tid; it < nitems; it += c.G * NTHREADS) {
        const int cp = it % NCP, rb = it / NCP, c0 = cp * 2, r0 = rb * RB;
        float wg[3][2], wv[3][2], bg[2], bv[2];
#pragma unroll
        for (int k = 0; k < 3; ++k)
#pragma unroll
            for (int j = 0; j < 2; ++j) { wg[k][j] = cw[k * DUP + c0 + j]; wv[k][j] = cw[k * DUP + DFF + c0 + j]; }
#pragma unroll
        for (int j = 0; j < 2; ++j) { bg[j] = cb[c0 + j]; bv[j] = cb[DFF + c0 + j]; }
        const bool first = (r0 & (SL - 1)) == 0, last = ((r0 + RB) & (SL - 1)) == 0;
        unsigned pg_, pv_, cg_, cv_, ng_, nv_;
        pg_ = first ? 0u : *(const unsigned*)(UB + (size_t)(r0 - 1) * DUP + c0); pv_ = first ? 0u : *(const unsigned*)(UB + (size_t)(r0 - 1) * DUP + DFF + c0);
        cg_ = *(const unsigned*)(UB + (size_t)r0 * DUP + c0); cv_ = *(const unsigned*)(UB + (size_t)r0 * DUP + DFF + c0);
        for (int rr = 0; rr < RB; ++rr) {
            const int r = r0 + rr; const bool nz = (rr == RB - 1) && last;
            ng_ = nz ? 0u : *(const unsigned*)(UB + (size_t)(r + 1) * DUP + c0); nv_ = nz ? 0u : *(const unsigned*)(UB + (size_t)(r + 1) * DUP + DFF + c0);
            float res[2];
#pragma unroll
            for (int j = 0; j < 2; ++j) {
                const int sh = j * 16;
                const float gp = bf2f((unsigned short)(pg_ >> sh)), gc = bf2f((unsigned short)(cg_ >> sh)), gn = bf2f((unsigned short)(ng_ >> sh));
                const float vp = bf2f((unsigned short)(pv_ >> sh)), vc = bf2f((unsigned short)(cv_ >> sh)), vn = bf2f((unsigned short)(nv_ >> sh));
                const float gate = gp * wg[0][j] + gc * wg[1][j] + gn * wg[2][j] + bg[j];
                const float val = vp * wv[0][j] + vc * wv[1][j] + vn * wv[2][j] + bv[j];
                res[j] = gate / (1.f + __expf(-gate)) * val;
            }
            *(unsigned*)(GB + (size_t)r * DFF + c0) = pk2(res[0], res[1]);
            pg_ = cg_; pv_ = cv_; cg_ = ng_; cv_ = nv_;
        }
    }
}

constexpr int NSTEPS = 1 + NCHUNK * DEPTH * 9 + 1;
__global__ void __launch_bounds__(NTHREADS, 2) mega_fwd(Args a) {
    extern __shared__ __attribute__((aligned(16))) unsigned char lds_raw[];
    LAS unsigned char* lds = (LAS unsigned char*)lds_raw;
    cg::grid_group grid = cg::this_grid();
    volatile LAS unsigned* bst = (volatile LAS unsigned*)(lds + 131072 + 320);
    if (threadIdx.x < 2) bst[threadIdx.x] = 0u;
    __syncthreads();
    XcdBarrier xbar = xcd_barrier_post((unsigned*)(a.ws + WS_CTL), bst);
    for (int step = 0; step < NSTEPS; ++step) {
        int tid_l = threadIdx.x, cu_l = blockIdx.x, G_l = gridDim.x;
        asm volatile("" : "+v"(tid_l)); asm volatile("" : "+s"(cu_l), "+s"(G_l));
        Ctx c; c.tid = tid_l; c.lane = c.tid & 63; c.wave = __builtin_amdgcn_readfirstlane(c.tid >> 6);
        c.G = G_l; c.cu = cu_l; c.gw = c.cu * 8 + c.wave; c.NGW = c.G * 8;
        if (step == 0) ph_weights(a, c, lds);
        else if (step == NSTEPS - 1) ph_final_norm(c, chunk_out(a, NCHUNK - 1), a.in[16]);
        else {
            const int s = step - 1, ph = s % 9, cl = s / 9, layer = cl & 1, ch = cl >> 1;
            unsigned char* ws = a.ws;
            bf16_t* HB = (bf16_t*)(ws + WS_HB);
            float* xo = chunk_out(a, ch);
            const float* xsrc = layer == 0 ? chunk_in(a, ch) : (const float*)xo;
            if (ph == 0) {
                if (layer == 0 && ch > 0) ph_final_norm(c, chunk_out(a, ch - 1), a.in[16]);

#ifdef PROBE_EW2
 for (int rep_ = 0; rep_ < 2; ++rep_)
#endif
                ph_norm_bf16(c, xsrc, a.in[2] + layer * DM, HB);
            } else if (ph == 1) {
#ifndef SKIP_G
                pg8::Gemm g{HB, (const bf16_t*)(ws + WS_WIN) + (size_t)layer * DIN * DM, CH_ROWS, DIN, DM}; pg8::StaticOrder S; S.init(CH_ROWS, DIN, c.G, c.cu);
                pg8::EpiBf16S E{(bf16_t*)(ws + WS_PROJ), DIN, 1805u, QSCALE};
#ifdef PROBE_G2
                for (int rep_ = 0; rep_ < 2; ++rep_)
#endif
                pg8::gemm_phase<pg8::EpiBf16S, pg8::StaticOrder, true, true>(lds, g, S, E);
#endif
            } else if (ph == 2) {
                ph_attn(a, c, lds, ch, layer);
            } else if (ph == 3) {

#ifdef PROBE_EW2
 for (int rep_ = 0; rep_ < 2; ++rep_)
#endif
                ph_combine(a, c, layer);
            } else if (ph == 4) {
#ifndef SKIP_G
                pg8::Gemm g{HB, (const bf16_t*)(ws + WS_WOUT) + (size_t)layer * DM * DM, CH_ROWS, DM, DM}; pg8::StaticOrder S; S.init(CH_ROWS, DM, c.G, c.cu);
                pg8::EpiRes E{xsrc, xo, DM};
                pg8::gemm_phase<pg8::EpiRes, pg8::StaticOrder, true, true>(lds, g, S, E);
#endif
            } else if (ph == 5) {

#ifdef PROBE_EW2
 for (int rep_ = 0; rep_ < 2; ++rep_)
#endif
                ph_norm_bf16(c, xo, a.in[11] + layer * DM, HB);
            } else if (ph == 6) {
#ifndef SKIP_G
                pg8::Gemm g{HB, (const bf16_t*)(ws + WS_WUP) + (size_t)layer * DUP * DM, CH_ROWS, DUP, DM}; pg8::StaticOrder S; S.init(CH_ROWS, DUP, c.G, c.cu);
                pg8::EpiBf16S E{(bf16_t*)(ws + WS_PROJ), DUP, 0u, 1.f};
#ifdef PROBE_G2
                for (int rep_ = 0; rep_ < 2; ++rep_)
#endif
                pg8::gemm_phase<pg8::EpiBf16S, pg8::StaticOrder, true, true>(lds, g, S, E);
#endif
            } else if (ph == 7) {

#ifdef PROBE_EW2
 for (int rep_ = 0; rep_ < 2; ++rep_)
#endif
                ph_conv(a, c, ch, layer);
            } else {
#ifndef SKIP_G
                pg8::Gemm g{(const bf16_t*)(ws + WS_TMP), (const bf16_t*)(ws + WS_WDN) + (size_t)layer * DM * DFF, CH_ROWS, DM, DFF}; pg8::StaticOrder S; S.init(CH_ROWS, DM, c.G, c.cu);
                pg8::EpiRes E{xo, xo, DM};
                pg8::gemm_phase<pg8::EpiRes, pg8::StaticOrder, true, true>(lds, g, S, E);
#endif
            }
        }
        if (step == 0) grid.sync(); else if (step != NSTEPS - 1) xcd_barrier(xbar);
#ifdef PROBE_S2
        if (step != 0 && step != NSTEPS - 1) { xcd_barrier(xbar); xcd_barrier(xbar); xcd_barrier(xbar); }
#endif
    }
}

extern "C" void kernel_launch(void* const* d_in, const int* in_sizes, int n_in, void* d_out, int out_size, void* d_ws, size_t ws_size, hipStream_t stream) {
    static int grid = 0;
    if (grid == 0) {
        if (n_in != 17 || ws_size < WS_END) { fprintf(stderr, "kernel_launch: unexpected n_in %d / ws_size %zu (need %zu)\n", n_in, ws_size, (size_t)WS_END); grid = -1; return; }
        int dev = 0, cus = 0, per_cu = 0;
        (void)hipGetDevice(&dev); (void)hipDeviceGetAttribute(&cus, hipDeviceAttributeMultiprocessorCount, dev);
        if (hipFuncSetAttribute((const void*)mega_fwd, hipFuncAttributeMaxDynamicSharedMemorySize, LDS_BYTES) != hipSuccess) { fprintf(stderr, "hipFuncSetAttribute failed\n"); grid = -1; return; }
        if (hipOccupancyMaxActiveBlocksPerMultiprocessor(&per_cu, (const void*)mega_fwd, NTHREADS, LDS_BYTES) != hipSuccess || per_cu < 1) { fprintf(stderr, "occupancy query: %d\n", per_cu); per_cu = 1; }
        (void)hipGetLastError();
        grid = cus * 1;
    }
    if (grid < 0) return;
    (void)hipMemsetAsync((char*)d_ws + WS_CTL, 0, 65536, stream);
    Args a{};
    for (int i = 0; i < 17; ++i) a.in[i] = (const float*)d_in[i];
    a.out = (float*)d_out; a.ws = (unsigned char*)d_ws;
    void* args[] = {&a};
    hipError_t e = hipLaunchCooperativeKernel((const void*)mega_fwd, dim3(grid), dim3(NTHREADS), args, LDS_BYTES, stream);
    if (e != hipSuccess) fprintf(stderr, "cooperative launch failed: %s (grid %d)\n", hipGetErrorString(e), grid);
}
```

```cpp
#include <hip/hip_runtime.h>
#include <hip/hip_cooperative_groups.h>
#include <cstdio>
#include <cstdint>
#include <cmath>
namespace cg = cooperative_groups;
namespace pg8 {
#define PG8_LAS __attribute__((address_space(3)))
typedef unsigned short bf16_t;
typedef short bf16x8 __attribute__((ext_vector_type(8)));
typedef float f32x4 __attribute__((ext_vector_type(4)));
typedef unsigned u32x4 __attribute__((ext_vector_type(4)));
constexpr int BM = 256, BK = 64, HALF = 128, HTB = HALF * BK * 2  , STAGE_BYTES = 8 * HTB, NXCD = 8, WGM = 8;

__host__ __device__ __forceinline__ int lds_byte(int r, int c) { const int st = (r >> 4) * 2 + (c >> 5), rr = r & 15, cc = c & 31, ob = rr * 64 + cc * 2; return st * 1024 + (ob ^ (((ob >> 9) & 1) << 5)); }
__host__ __device__ __forceinline__ void stage_rc(int b, int& R, int& C) { const int st = b / 1024, sb = b % 1024, swz = sb ^ (((sb >> 9) & 1) << 5); R = (st >> 1) * 16 + swz / 64; C = (st & 1) * 32 + (swz % 64) / 2; }
__host__ __device__ __forceinline__ int perm32(int rho) { const int n = rho >> 4, i = rho & 15; return 8 * (i >> 2) + 4 * n + (i & 3); }

struct Unit { int pm, pn; };
struct Gemm { const bf16_t* A; const bf16_t* Bt; int M, N, K; };

struct StaticOrder {
    int nM, nN, nwg, G, c;
    __host__ __device__ void init(int M, int N, int G_, int c_) { nM = M / BM; nN = N / BM; nwg = nM * nN; G = G_; c = c_; }
    __host__ __device__ bool next(int i, Unit& u) const {
        const long L = (long)i * G + c; if (L >= nwg) return false;
        int wgid = (int)L; { const int q = nwg / NXCD, r = nwg % NXCD, xcd = wgid % NXCD, off = wgid / NXCD; wgid = (xcd < r ? xcd * (q + 1) : r * (q + 1) + (xcd - r) * q) + off; }
        const int nig = WGM * nN, gid = wgid / nig, fm = gid * WGM, gsz = (nM - fm) < WGM ? (nM - fm) : WGM;
        u.pm = fm + ((wgid % nig) % gsz); u.pn = (wgid % nig) / gsz; return true;
    }
    __device__ __forceinline__ void a_ready(const Unit&) const {}
    __device__ __forceinline__ void done(const Unit&) const {}
};

__device__ __forceinline__ unsigned cvt_pk_bf16(float lo, float hi) { unsigned r; asm volatile("v_cvt_pk_bf16_f32 %0, %1, %2" : "=v"(r) : "v"(lo), "v"(hi)); return r; }
struct EpiBf16S {
    static constexpr bool PERM = true, AFTER_DRAIN = false;
    bf16_t* O; int ldc; unsigned scalemask; float sc;
    __device__ __forceinline__ void operator()(const f32x4 (&acc)[2][2][4][2], const Unit& u, int wr, int wc, int fr, int fq) const {
        const int row0 = u.pm * BM + wr * 64 + fr; const int col0 = u.pn * BM + wc * 32 + 8 * fq;
        const float s = ((scalemask >> u.pn) & 1u) ? sc : 1.f;
#pragma unroll
        for (int ai = 0; ai < 2; ++ai)
#pragma unroll
            for (int m = 0; m < 4; ++m) { bf16_t* rowp = O + (size_t)(row0 + ai * HALF + m * 16) * ldc + col0;
#pragma unroll
                for (int bj = 0; bj < 2; ++bj) { f32x4 v0 = acc[ai][bj][m][0] * s, v1 = acc[ai][bj][m][1] * s;
                    u32x4 w; w.x = cvt_pk_bf16(v0[0], v0[1]); w.y = cvt_pk_bf16(v0[2], v0[3]); w.z = cvt_pk_bf16(v1[0], v1[1]); w.w = cvt_pk_bf16(v1[2], v1[3]);
                    *(u32x4*)(rowp + bj * HALF) = w; } }
    }
};
struct EpiRes {
    static constexpr bool PERM = false, AFTER_DRAIN = false;
    const float* base; float* out; int ldc;
    __device__ __forceinline__ void operator()(const f32x4 (&acc)[2][2][4][2], const Unit& u, int wr, int wc, int fr, int fq) const {
        const int col0 = u.pn * BM + wc * 32 + 4 * fq;
#pragma unroll
        for (int ai = 0; ai < 2; ++ai)
#pragma unroll
            for (int m = 0; m < 4; ++m) { const size_t off = (size_t)(u.pm * BM + ai * HALF + wr * 64 + m * 16 + fr) * ldc + col0;
#pragma unroll
                for (int bj = 0; bj < 2; ++bj)
#pragma unroll
                    for (int n = 0; n < 2; ++n) { const f32x4 bs = *(const f32x4*)(base + off + bj * HALF + n * 16); *(f32x4*)(out + off + bj * HALF + n * 16) = bs + acc[ai][bj][m][n]; }
                asm volatile("" ::: "memory"); }
    }
};
template <class Epi, class Sched, bool ALIGN_EPI = false, bool SP2 = false>
__device__ __forceinline__ void gemm_phase(PG8_LAS unsigned char* lds, const Gemm g, const Sched& S, const Epi& E) {
    int tid_l = threadIdx.x; asm volatile("" : "+v"(tid_l)); const int tid = tid_l, wid = __builtin_amdgcn_readfirstlane(tid >> 6), lane = tid & 63, wr = wid >> 2, wc = wid & 3, fr = lane & 15, fq = lane >> 4;
    const int K = g.K, nt = K / BK;
    unsigned voffA[2], voffB[2];
#pragma unroll
    for (int i = 0; i < 2; ++i) { int R, C; stage_rc(tid * 16 + i * 8192, R, C); const int Rb = Epi::PERM ? ((R & ~31) + perm32(R & 31)) : R;
        voffA[i] = (unsigned)(R * K + C) * 2u; voffB[i] = (unsigned)(Rb * K + C) * 2u; }
    const size_t kstep = (size_t)(BK * 2);
    const size_t hstep = (size_t)HALF * K * 2;
    const size_t tstep = 2 * hstep;
    const unsigned ldsw = (unsigned)wid * 1024u;
    const int aoff = lds_byte(wr * 64 + fr, fq * 8), boff = lds_byte(wc * 32 + fr, fq * 8);
#define PG8_SA(b, h) (((b) * 2 + (h)) * HTB)
#define PG8_SB(b, h) ((4 + (b) * 2 + (h)) * HTB)
#define PG8_STAGE(bufoff, gbase, voff) do { _Pragma("unroll") for (int _i = 0; _i < 2; ++_i) \
        __builtin_amdgcn_global_load_lds((const unsigned*)((const char*)(gbase) + (voff)[_i]), (PG8_LAS unsigned*)(lds + (bufoff) + ldsw + _i * 8192), 16, 0, 0); } while (0)
#define PG8_LDA(dst, b, h) do { _Pragma("unroll") for (int m = 0; m < 4; ++m) _Pragma("unroll") for (int k = 0; k < 2; ++k) dst[m][k] = *(const PG8_LAS bf16x8*)(lds + PG8_SA(b, h) + aoff + m * 2048 + k * 1024); } while (0)
#define PG8_LDB(dst, b, h) do { _Pragma("unroll") for (int n = 0; n < 2; ++n) _Pragma("unroll") for (int k = 0; k < 2; ++k) dst[n][k] = *(const PG8_LAS bf16x8*)(lds + PG8_SB(b, h) + boff + n * 2048 + k * 1024); } while (0)
#define PG8_MMA(ai, bj, At, Bt) do { __builtin_amdgcn_s_setprio(1); _Pragma("unroll") for (int m = 0; m < 4; ++m) _Pragma("unroll") for (int n = 0; n < 2; ++n) _Pragma("unroll") for (int k = 0; k < 2; ++k) \
        acc[ai][bj][m][n] = __builtin_amdgcn_mfma_f32_16x16x32_bf16(Bt[n][k], At[m][k], acc[ai][bj][m][n], 0, 0, 0); __builtin_amdgcn_s_setprio(0); } while (0)
#define PG8_WAIT_V(n) asm volatile("s_waitcnt vmcnt(" #n ")" ::: "memory")
#define PG8_WAIT_L(n) asm volatile("s_waitcnt lgkmcnt(" #n ")" ::: "memory")
#define PG8_BAR __builtin_amdgcn_s_barrier()
#define PG8_SCHED __builtin_amdgcn_sched_barrier(0)
    Unit cur, nxt; int ui = 0;
    if (!S.next(0, cur)) return;
    f32x4 acc[2][2][4][2];
#pragma unroll
    for (int a = 0; a < 2; ++a)
#pragma unroll
        for (int b = 0; b < 2; ++b)
#pragma unroll
            for (int m = 0; m < 4; ++m)
#pragma unroll
                for (int n = 0; n < 2; ++n) acc[a][b][m][n] = (f32x4){0.f, 0.f, 0.f, 0.f};
    bf16x8 At[4][2], B0[2][2], B1[2][2];
    const char* cA = (const char*)g.A + (size_t)cur.pm * tstep; const char* cB = (const char*)g.Bt + (size_t)cur.pn * tstep;
    S.a_ready(cur);
    if constexpr (SP2) {
        PG8_STAGE(PG8_SB(0, 0), cB, voffB); PG8_STAGE(PG8_SB(0, 1), cB + hstep, voffB); PG8_STAGE(PG8_SA(0, 0), cA, voffA); PG8_STAGE(PG8_SA(0, 1), cA + hstep, voffA);
        if (wr == 1) PG8_BAR;
        PG8_WAIT_V(2); PG8_BAR;
        PG8_STAGE(PG8_SB(1, 0), cB + kstep, voffB); PG8_STAGE(PG8_SA(1, 0), cA + kstep, voffA); PG8_STAGE(PG8_SB(1, 1), cB + hstep + kstep, voffB);
        PG8_WAIT_V(6); PG8_BAR;
    } else {
        PG8_STAGE(PG8_SB(0, 0), cB, voffB); PG8_STAGE(PG8_SA(0, 0), cA, voffA); PG8_STAGE(PG8_SB(0, 1), cB + hstep, voffB); PG8_STAGE(PG8_SA(0, 1), cA + hstep, voffA);
        if (wr == 1) PG8_BAR;
        PG8_WAIT_V(4); PG8_BAR;
        PG8_STAGE(PG8_SB(1, 0), cB + kstep, voffB); PG8_STAGE(PG8_SA(1, 0), cA + kstep, voffA); PG8_STAGE(PG8_SB(1, 1), cB + hstep + kstep, voffB);
        PG8_WAIT_V(6); PG8_BAR;
    }
    for (;;) {
        const bool has_next = S.next(ui + 1, nxt);
        const char* nA = has_next ? (const char*)g.A + (size_t)nxt.pm * tstep : cA; const char* nB = has_next ? (const char*)g.Bt + (size_t)nxt.pn * tstep : cB;
        for (int t = 0; t < nt; t += 2) {
            const bool last = (t == nt - 2);
            const char* a1 = cA + (size_t)(t + 1) * kstep;
            const char* a2 = last ? nA : cA + (size_t)(t + 2) * kstep; const char* b2 = last ? nB : cB + (size_t)(t + 2) * kstep;
            const char* a3 = a2 + kstep; const char* b3 = b2 + kstep;
            if (last && has_next) S.a_ready(nxt);
            if constexpr (SP2) {
            PG8_LDB(B0, 0, 0); PG8_LDB(B1, 0, 1); PG8_SCHED; PG8_LDA(At, 0, 0); PG8_STAGE(PG8_SA(1, 1), a1 + hstep, voffA);
            PG8_WAIT_V(8); PG8_WAIT_L(0); PG8_BAR; PG8_MMA(0, 0, At, B0); PG8_MMA(0, 1, At, B1); PG8_BAR; PG8_SCHED;
            PG8_LDA(At, 0, 1); PG8_STAGE(PG8_SB(0, 0), b2, voffB); PG8_STAGE(PG8_SB(0, 1), b2 + hstep, voffB); PG8_STAGE(PG8_SA(0, 0), a2, voffA);
            PG8_WAIT_V(8); PG8_WAIT_L(0); PG8_BAR; PG8_MMA(1, 0, At, B0); PG8_MMA(1, 1, At, B1); PG8_BAR; PG8_SCHED;
            PG8_LDB(B0, 1, 0); PG8_LDB(B1, 1, 1); PG8_SCHED; PG8_LDA(At, 1, 0); PG8_STAGE(PG8_SA(0, 1), a2 + hstep, voffA);
            PG8_WAIT_V(8); PG8_WAIT_L(0); PG8_BAR; PG8_MMA(0, 0, At, B0); PG8_MMA(0, 1, At, B1); PG8_BAR; PG8_SCHED;
            PG8_LDA(At, 1, 1); PG8_STAGE(PG8_SB(1, 0), b3, voffB); PG8_STAGE(PG8_SB(1, 1), b3 + hstep, voffB); PG8_STAGE(PG8_SA(1, 0), a3, voffA);
            PG8_WAIT_V(8); PG8_WAIT_L(0); PG8_BAR; PG8_MMA(1, 0, At, B0); PG8_MMA(1, 1, At, B1); PG8_BAR; PG8_SCHED;
            } else {
            PG8_LDB(B0, 0, 0); PG8_SCHED; PG8_LDA(At, 0, 0); PG8_STAGE(PG8_SA(1, 1), a1 + hstep, voffA);
            PG8_WAIT_L(8); PG8_BAR; PG8_WAIT_L(0); PG8_MMA(0, 0, At, B0); PG8_BAR; PG8_SCHED;
            PG8_LDB(B1, 0, 1); PG8_STAGE(PG8_SB(0, 0), b2, voffB);
            PG8_BAR; PG8_WAIT_L(0); PG8_MMA(0, 1, At, B1); PG8_BAR;
            PG8_LDA(At, 0, 1); PG8_STAGE(PG8_SA(0, 0), a2, voffA);
            PG8_BAR; PG8_WAIT_L(0); PG8_MMA(1, 0, At, B0); PG8_BAR; PG8_SCHED;
            PG8_STAGE(PG8_SB(0, 1), b2 + hstep, voffB);
            PG8_WAIT_V(6); PG8_BAR; PG8_MMA(1, 1, At, B1); PG8_BAR;
            PG8_LDB(B0, 1, 0); PG8_SCHED; PG8_LDA(At, 1, 0); PG8_STAGE(PG8_SA(0, 1), a2 + hstep, voffA);
            PG8_WAIT_L(8); PG8_BAR; PG8_WAIT_L(0); PG8_MMA(0, 0, At, B0); PG8_BAR; PG8_SCHED;
            PG8_LDB(B1, 1, 1); PG8_STAGE(PG8_SB(1, 0), b3, voffB);
            PG8_BAR; PG8_WAIT_L(0); PG8_MMA(0, 1, At, B1); PG8_BAR;
            PG8_LDA(At, 1, 1); PG8_STAGE(PG8_SA(1, 0), a3, voffA);
            PG8_BAR; PG8_WAIT_L(0); PG8_MMA(1, 0, At, B0); PG8_BAR; PG8_SCHED;
            PG8_STAGE(PG8_SB(1, 1), b3 + hstep, voffB);
            PG8_WAIT_V(6); PG8_BAR; PG8_MMA(1, 1, At, B1); PG8_BAR;
            }
        }
        if constexpr (ALIGN_EPI) { if (wr == 0) PG8_BAR; }
        if constexpr (!Epi::AFTER_DRAIN) { E(acc, cur, wr, wc, fr, fq); S.done(cur); }
        if (!has_next) break;
#pragma unroll
        for (int a = 0; a < 2; ++a)
#pragma unroll
            for (int b = 0; b < 2; ++b)
#pragma unroll
                for (int m = 0; m < 4; ++m)
#pragma unroll
                    for (int n = 0; n < 2; ++n) acc[a][b][m][n] = (f32x4){0.f, 0.f, 0.f, 0.f};
        cur = nxt; cA = nA; cB = nB; ++ui;
        if constexpr (ALIGN_EPI) { if (wr == 1) PG8_BAR; }
    }
    PG8_WAIT_V(0);
    if constexpr (!ALIGN_EPI) { if (wr == 0) PG8_BAR; }
    PG8_BAR;
    if constexpr (Epi::AFTER_DRAIN) { E.fused(acc, cur, wr, wc, fr, fq, lds, wid, lane); S.done(cur); }
#undef PG8_SA
#undef PG8_SB
#undef PG8_STAGE
#undef PG8_LDA
#undef PG8_LDB
#undef PG8_MMA
#undef PG8_WAIT_V
#undef PG8_WAIT_L
#undef PG8_BAR
#undef PG8_SCHED
}
}
typedef __bf16 bf16x2_t __attribute__((ext_vector_type(2)));
__device__ __forceinline__ unsigned cvt_pk(float lo, float hi) { float __attribute__((ext_vector_type(2))) v = {lo, hi}; bf16x2_t b = __builtin_convertvector(v, bf16x2_t); return __builtin_bit_cast(unsigned, b); }
#define LAS __attribute__((address_space(3)))
#define XB_TMO      128
#define XB_XCNT(j)  (256  + 64 * (j))
#define XB_XSUB(j)  (1280 + 64 * (j))
#define XB_XGEN(j)  (2304 + 64 * (j))
#define XB_TOP      3328
#define XB_TOPGEN   3392
#define XCD_BAR_WORDS 3456
#define XB_SPIN_CAP (1u << 18)

__device__ __forceinline__ unsigned xb_ld(unsigned* p)              { return __hip_atomic_load(p, __ATOMIC_RELAXED, __HIP_MEMORY_SCOPE_AGENT); }
__device__ __forceinline__ unsigned xb_add(unsigned* p, unsigned v) { return __hip_atomic_fetch_add(p, v, __ATOMIC_RELAXED, __HIP_MEMORY_SCOPE_AGENT); }
__device__ __forceinline__ unsigned xb_xcc_id() { return (unsigned)__builtin_amdgcn_s_getreg((3 << 11) | 20) & 0xFu; }
#define XB_SPIN(cond, bar) do { unsigned _sp = 0; while (cond) { __builtin_amdgcn_s_sleep(1); \
    if ((++_sp & 255u) == 0u) { if (xb_ld(&(bar)[XB_TMO])) break; if (_sp > XB_SPIN_CAP) { atomicAdd(&(bar)[XB_TMO], 1u); break; } } } } while (0)

struct XcdBarrier {
    unsigned* bar; unsigned x;
    volatile LAS unsigned* st;
};

__device__ __forceinline__ XcdBarrier xcd_barrier_post(unsigned* bar, volatile LAS unsigned* st) {
    XcdBarrier b; b.bar = bar; b.x = xb_xcc_id(); b.st = st;
    if (threadIdx.x == 0) (void)xb_add(&bar[XB_XCNT(b.x)], 1u);
    return b;
}
__device__ __forceinline__ void xcd_barrier_complete(unsigned* bar, unsigned x, unsigned& nloc, unsigned& nx) {
    const unsigned G = gridDim.x * gridDim.y * gridDim.z;
    unsigned sum, cnt, mine, sp = 0u;
    for (;;) {
        sum = 0u; cnt = 0u; mine = 0u;
#pragma unroll
        for (unsigned j = 0; j < 16; ++j) { const unsigned c = xb_ld(&bar[XB_XCNT(j)]); sum += c; cnt += (c > 0u) ? 1u : 0u; mine = (j == x) ? c : mine; }
        if (sum == G) break;
        __builtin_amdgcn_s_sleep(1);
        if ((++sp & 255u) == 0u) { if (xb_ld(&bar[XB_TMO])) break; if (sp > XB_SPIN_CAP) { atomicAdd(&bar[XB_TMO], 1u); break; } }
    }
    nloc = mine > 0u ? mine : 1u; nx = cnt > 0u ? cnt : 1u;
}

__device__ __forceinline__ void xcd_barrier(const XcdBarrier& b) {
    asm volatile("s_waitcnt vmcnt(0)" ::: "memory");
    __syncthreads();
    if (threadIdx.x == 0) {
        unsigned* bar = b.bar;
        __builtin_amdgcn_s_waitcnt(0);
        unsigned nloc = b.st[0], nx = b.st[1];
        if (nloc == 0u) { xcd_barrier_complete(bar, b.x, nloc, nx); b.st[0] = nloc; b.st[1] = nx; }
        const unsigned old = xb_add(&bar[XB_XSUB(b.x)], 1u);
        const unsigned gen = old / nloc;
        if (old + 1u == (gen + 1u) * nloc) {
            __builtin_amdgcn_fence(__ATOMIC_RELEASE, "agent");
            asm volatile("s_waitcnt vmcnt(0)" ::: "memory");
            const unsigned og = xb_add(&bar[XB_TOP], 1u);
            const unsigned tg = og / nx;
            if (og + 1u == (tg + 1u) * nx) xb_add(&bar[XB_TOPGEN], 1u);
            else XB_SPIN(xb_ld(&bar[XB_TOPGEN]) == tg, bar);
            __builtin_amdgcn_fence(__ATOMIC_ACQUIRE, "agent");
            xb_add(&bar[XB_XGEN(b.x)], 1u);
            asm volatile("s_waitcnt vmcnt(0)" ::: "memory");
        } else {
            XB_SPIN(xb_ld(&bar[XB_XGEN(b.x)]) == gen, bar);
            __builtin_amdgcn_fence(__ATOMIC_ACQUIRE, "agent");
            asm volatile("s_waitcnt vmcnt(0)" ::: "memory");
        }
    }
    __syncthreads();
}
typedef unsigned short bf16_t;
typedef short bf16x8 __attribute__((ext_vector_type(8)));
typedef short s16x4 __attribute__((ext_vector_type(4)));
typedef float f32x16 __attribute__((ext_vector_type(16)));
typedef float f32x4 __attribute__((ext_vector_type(4)));
typedef float f32x2 __attribute__((ext_vector_type(2)));
typedef unsigned u32x4 __attribute__((ext_vector_type(4)));
typedef unsigned u32x2 __attribute__((ext_vector_type(2)));

constexpr int DM = 1024, DIN = 4352, DFF = 2816, DUP = 2 * DFF, DEPTH = 2;
constexpr int CH_ROWS = 16384, NCHUNK = 3;
constexpr int TW = 2064;
constexpr int T_A = 0, T_B = 256, T_C = 1280, T_L = 2048;
constexpr float LOG2E = 1.4426950408889634f, LN2 = 0.6931471805599453f;
constexpr float QSCALE = 0.125f * LOG2E;
constexpr size_t MiB = 1u << 20;
constexpr size_t WS_WIN = 0, WS_WOUT = 18 * MiB, WS_WUP = 22 * MiB, WS_WDN = 44 * MiB, WS_HB = 56 * MiB, WS_PROJ = 88 * MiB, WS_TMP = 264 * MiB, WS_CTL = 394 * MiB, WS_END = 395 * MiB;
constexpr int LDS_BYTES = 147456;
constexpr int NTHREADS = 512;

struct Args { const float* in[17]; float* out; unsigned char* ws; };

__device__ __forceinline__ float wave_sum(float v) {
#pragma unroll
    for (int o = 1; o < 64; o <<= 1) v += __shfl_xor(v, o);
    return v;
}
__device__ __forceinline__ unsigned f2bf(float f) { unsigned u = __builtin_bit_cast(unsigned, f); return (u + 0x7fffu + ((u >> 16) & 1u)) >> 16; }
__device__ __forceinline__ unsigned pk2(float lo, float hi) { return f2bf(lo) | (f2bf(hi) << 16); }
__device__ __forceinline__ float bf2f(unsigned short b) { return __builtin_bit_cast(float, (unsigned)b << 16); }

__device__ __forceinline__ void transpose_item(const float* W, int K, int N, bf16_t* WT, LAS float* scr, int item, int lane) {
    const int nblk = N / 32, kb = item / nblk, nb = item % nblk, k0 = 64 * kb, n0 = 32 * nb;
#pragma unroll 8
    for (int i = 0; i < 32; ++i) { const int kk = 2 * i + (lane >> 5); scr[kk * 33 + (lane & 31)] = W[(size_t)(k0 + kk) * N + n0 + (lane & 31)]; }
    asm volatile("s_waitcnt lgkmcnt(0)" ::: "memory");
    const int c = lane & 7;
#pragma unroll
    for (int j = 0; j < 4; ++j) { const int n = (lane >> 3) + 8 * j; const LAS float* s = scr + (8 * c) * 33 + n;
        u32x4 o; o.x = pk2(s[0 * 33], s[1 * 33]); o.y = pk2(s[2 * 33], s[3 * 33]); o.z = pk2(s[4 * 33], s[5 * 33]); o.w = pk2(s[6 * 33], s[7 * 33]);
        *(u32x4*)(WT + (size_t)(n0 + n) * K + k0 + 8 * c) = o; }
    asm volatile("s_waitcnt lgkmcnt(0)" ::: "memory");
}

__device__ __forceinline__ void rms_row_to_bf16(const float* xrow, const float* gain, bf16_t* orow, int lane) {
    const f32x4* xr = (const f32x4*)xrow + lane; const f32x4* gr = (const f32x4*)gain + lane;
    f32x4 v[4]; float s = 0.f;
#pragma unroll
    for (int j = 0; j < 4; ++j) { v[j] = xr[64 * j]; s += (v[j].x * v[j].x + v[j].y * v[j].y) + (v[j].z * v[j].z + v[j].w * v[j].w); }
    const float rstd = 1.f / sqrtf(wave_sum(s) * (1.f / DM) + 1e-6f);
    u32x2* o8 = (u32x2*)orow + lane;
#pragma unroll
    for (int j = 0; j < 4; ++j) { const f32x4 g = gr[64 * j]; u32x2 w; w.x = pk2(v[j].x * rstd * g.x, v[j].y * rstd * g.y); w.y = pk2(v[j].z * rstd * g.z, v[j].w * rstd * g.w); o8[64 * j] = w; }
}
__device__ __forceinline__ void rms_row_f32(float* xrow, const float* gain, int lane) {
    f32x4* xr = (f32x4*)xrow + lane; const f32x4* gr = (const f32x4*)gain + lane;
    f32x4 v[4]; float s = 0.f;
#pragma unroll
    for (int j = 0; j < 4; ++j) { v[j] = xr[64 * j]; s += (v[j].x * v[j].x + v[j].y * v[j].y) + (v[j].z * v[j].z + v[j].w * v[j].w); }
    const float rstd = 1.f / sqrtf(wave_sum(s) * (1.f / DM) + 1e-6f);
#pragma unroll
    for (int j = 0; j < 4; ++j) { const f32x4 g = gr[64 * j]; xr[64 * j] = v[j] * rstd * g; }
}

constexpr int KSTR = 144;
constexpr int ATT_K_OFF = 0, ATT_V_OFF = 2 * 64 * KSTR, ATT_SCR_OFF = ATT_V_OFF + 2 * 64 * 320;
__device__ __forceinline__ int crow(int r, int hi) { return (r & 3) + 8 * (r >> 2) + 4 * hi; }
typedef short v4i16_t __attribute__((ext_vector_type(4)));
__device__ __forceinline__ s16x4 vtr(const LAS unsigned char* p) { return __builtin_bit_cast(s16x4, __builtin_amdgcn_ds_read_tr16_b64_v4i16((LAS v4i16_t*)p)); }

template <int VD, bool WIN>
__device__ __forceinline__ void attn_unit(LAS unsigned char* lds, const bf16_t* Qp, const bf16_t* Kp, const bf16_t* Vp, size_t pitch,
                                          int q0, int L, float slope2, int W, float m_init, float l_init,
                                          float* Oout, size_t opitch, float* lse_out, size_t lpitch, bf16_t* Obf) {
    constexpr int VSTR = VD * 2 + 64, ND = VD / 32, VCH = VD / 8, VLD = 64 * VCH / NTHREADS;
    int tid_l = threadIdx.x; asm volatile("" : "+v"(tid_l)); const int tid = tid_l, lane = tid & 63, r32 = lane & 31, hi = lane >> 5, wid = __builtin_amdgcn_readfirstlane(tid >> 6);
    const int qw = q0 + wid * 32;
    int tlo = 0, thi = L / 64;
    if (WIN) { const int a = q0 - W; tlo = a > 0 ? a / 64 : 0; const int b = q0 + 256 + W; thi = (b < L ? b : L) / 64; }
    bf16x8 qr[4];
    { const bf16_t* qrow = Qp + (size_t)(qw + r32) * pitch + hi * 8;
#pragma unroll
      for (int d0 = 0; d0 < 4; ++d0) qr[d0] = *(const bf16x8*)(qrow + d0 * 16); }
    f32x16 o[ND];
#pragma unroll
    for (int d = 0; d < ND; ++d)
#pragma unroll
        for (int r = 0; r < 16; ++r) o[d][r] = 0.f;
    float m = m_init, l = hi == 0 ? l_init : 0.f;
    LAS float* wsf = (LAS float*)(lds + ATT_SCR_OFF) + wid * 64;
    const int krow = tid >> 3, kch = tid & 7;
    u32x4 kreg; u32x4 vreg[VLD];
#define ATT_GLOAD(t) do { kreg = *(const u32x4*)(Kp + (size_t)(64 * (t) + krow) * pitch + kch * 8); \
        _Pragma("unroll") for (int i_ = 0; i_ < VLD; ++i_) { const int idx_ = tid + NTHREADS * i_; vreg[i_] = *(const u32x4*)(Vp + (size_t)(64 * (t) + idx_ / VCH) * pitch + (idx_ % VCH) * 8); } } while (0)
#define ATT_LSTORE(b) do { *(LAS u32x4*)(lds + ATT_K_OFF + (b) * 64 * KSTR + krow * KSTR + kch * 16) = kreg; \
        _Pragma("unroll") for (int i_ = 0; i_ < VLD; ++i_) { const int idx_ = tid + NTHREADS * i_; *(LAS u32x4*)(lds + ATT_V_OFF + (b) * 64 * VSTR + (idx_ / VCH) * VSTR + (idx_ % VCH) * 16) = vreg[i_]; } } while (0)
    const int n = thi - tlo;
    ATT_GLOAD(tlo); ATT_LSTORE(0); __syncthreads();
    const float Wf = (float)W;
    for (int i = 0; i < n; ++i) {
        const int t = tlo + i, buf = i & 1;
        if (i + 1 < n) ATT_GLOAD(t + 1);
        bool active = true;
        if (WIN) { const int kb = 64 * t; active = (kb + 63 >= qw - W) && (kb <= qw + 31 + W); }
        if (active) {
            const LAS unsigned char* Kb = lds + ATT_K_OFF + buf * 64 * KSTR + r32 * KSTR + hi * 16;
            f32x16 p0, p1;
#pragma unroll
            for (int r = 0; r < 16; ++r) { p0[r] = 0.f; p1[r] = 0.f; }
#pragma unroll
            for (int d0 = 0; d0 < 4; ++d0) {
                const bf16x8 a0 = *(const LAS bf16x8*)(Kb + d0 * 32), a1 = *(const LAS bf16x8*)(Kb + 32 * KSTR + d0 * 32);
                p0 = __builtin_amdgcn_mfma_f32_32x32x16_bf16(a0, qr[d0], p0, 0, 0, 0);
                p1 = __builtin_amdgcn_mfma_f32_32x32x16_bf16(a1, qr[d0], p1, 0, 0, 0);
                if (d0 & 1) __builtin_amdgcn_sched_barrier(0);
            }
            const float dq = (float)(64 * t + 4 * hi - (qw + r32));
            float rm = -INFINITY;
#pragma unroll
            for (int r = 0; r < 16; ++r) {
                const float t0 = dq + (float)((r & 3) + 8 * (r >> 2)), t1 = t0 + 32.f;
                p0[r] = __builtin_fmaf(-slope2, __builtin_fabsf(t0), p0[r]);
                p1[r] = __builtin_fmaf(-slope2, __builtin_fabsf(t1), p1[r]);
                if (WIN) { if (__builtin_fabsf(t0) > Wf) p0[r] = -INFINITY; if (__builtin_fabsf(t1) > Wf) p1[r] = -INFINITY; }
                rm = __builtin_fmaxf(rm, __builtin_fmaxf(p0[r], p1[r]));
            }
            rm = __builtin_fmaxf(rm, __shfl_xor(rm, 32));
            if (__any(rm > m)) {
                const float mn = __builtin_fmaxf(m, rm); const float f = __builtin_amdgcn_exp2f(m - mn); m = mn; l *= f;
                if (hi == 0) wsf[r32] = f;
#pragma unroll
                for (int r = 0; r < 16; ++r) { const float fr = wsf[crow(r, hi)];
#pragma unroll
                    for (int d = 0; d < ND; ++d) o[d][r] *= fr; }
            }
            float ls = 0.f;
#pragma unroll
            for (int r = 0; r < 16; ++r) { p0[r] = __builtin_amdgcn_exp2f(p0[r] - m); p1[r] = __builtin_amdgcn_exp2f(p1[r] - m); ls += p0[r] + p1[r]; }
            l += ls;
            u32x4 pw[4];
#pragma unroll
            for (int c = 0; c < 4; ++c) {
                const f32x16& P = (c >> 1) ? p1 : p0; const int b = 8 * (c & 1);
                pw[c].x = cvt_pk(P[b + 0], P[b + 1]); pw[c].y = cvt_pk(P[b + 2], P[b + 3]); pw[c].z = cvt_pk(P[b + 4], P[b + 5]); pw[c].w = cvt_pk(P[b + 6], P[b + 7]);
            }
            const LAS unsigned char* Vb = lds + ATT_V_OFF + buf * 64 * VSTR + (4 * hi + ((lane & 15) >> 2)) * VSTR + (16 * ((lane >> 4) & 1) + 4 * (lane & 3)) * 2;
#pragma unroll
            for (int c = 0; c < 4; ++c)
#pragma unroll
                for (int d = 0; d < ND; ++d) {
                    const s16x4 vlo = vtr(Vb + c * 16 * VSTR + d * 64), vhi = vtr(Vb + c * 16 * VSTR + 8 * VSTR + d * 64);
                    const bf16x8 vf = (bf16x8){vlo[0], vlo[1], vlo[2], vlo[3], vhi[0], vhi[1], vhi[2], vhi[3]};
                    o[d] = __builtin_amdgcn_mfma_f32_32x32x16_bf16(__builtin_bit_cast(bf16x8, pw[c]), vf, o[d], 0, 0, 0);
                    if (d == ND - 1) __builtin_amdgcn_sched_barrier(0);
                }
        }
        if (i + 1 < n) ATT_LSTORE(buf ^ 1);
        __syncthreads();
    }
#undef ATT_GLOAD
#undef ATT_LSTORE
    l += __shfl_xor(l, 32);
    if (hi == 0) wsf[r32] = 1.f / l;
#pragma unroll
    for (int r = 0; r < 16; ++r) { const float ir = wsf[crow(r, hi)];
        if (Obf != nullptr) { bf16_t* orow = Obf + (size_t)(qw + crow(r, hi)) * opitch + r32;
#pragma unroll
            for (int d = 0; d < ND; ++d) orow[d * 32] = (bf16_t)f2bf(o[d][r] * ir);
        } else { float* orow = Oout + (size_t)(qw + crow(r, hi)) * opitch + r32;
#pragma unroll
            for (int d = 0; d < ND; ++d) orow[d * 32] = o[d][r] * ir; } }
    if (lse_out != nullptr && hi == 0) lse_out[(size_t)(qw + r32) * lpitch] = (m + __builtin_log2f(l)) * LN2;
    __syncthreads();
}
constexpr int ATT_O0_OFF = 61440;
constexpr float B_THR = 6.0f;
__device__ __forceinline__ void attn_b_unit(LAS unsigned char* lds, const bf16_t* base, int h, int q0, int L, float slope2_, float lam,
                                            const float* subln_l, float postscale, bf16_t* mix) {
    constexpr int VD = 128, VSTR = VD * 2 + 64, ND = 4, VCH = 16, VLD = 2;
    int tid_l = threadIdx.x; asm volatile("" : "+v"(tid_l)); const int tid = tid_l, lane = tid & 63, r32 = lane & 31, hi = lane >> 5, wid = __builtin_amdgcn_readfirstlane(tid >> 6);
    const int qw = q0 + wid * 32, NT = L / 64, c0 = q0 / 64;
    LAS float* wsf = (LAS float*)(lds + ATT_SCR_OFF) + wid * 64;
    const int krow = tid >> 3, kch = tid & 7;
    const bf16_t* Vp = base + 1536 + h * 128;
    const float qposf = (float)(qw + r32);
    for (int mp = 0; mp < 2; ++mp) {
        const bf16_t* Qp = base + 512 + (h * 2 + mp) * 64; const bf16_t* Kp = base + 1024 + (h * 2 + mp) * 64;
        bf16x8 qr[4];
        { const bf16_t* qrow = Qp + (size_t)(qw + r32) * DIN + hi * 8;
#pragma unroll
          for (int d0 = 0; d0 < 4; ++d0) qr[d0] = *(const bf16x8*)(qrow + d0 * 16); }
        f32x16 o[ND];
#pragma unroll
        for (int d = 0; d < ND; ++d)
#pragma unroll
            for (int r = 0; r < 16; ++r) o[d][r] = 0.f;
        float mref = 0.f, l = 0.f;
        u32x4 kreg; u32x4 vreg[VLD];
#define ATT_GLOAD(t) do { kreg = *(const u32x4*)(Kp + (size_t)(64 * (t) + krow) * DIN + kch * 8); \
        _Pragma("unroll") for (int i_ = 0; i_ < VLD; ++i_) { const int idx_ = tid + NTHREADS * i_; vreg[i_] = *(const u32x4*)(Vp + (size_t)(64 * (t) + idx_ / VCH) * DIN + (idx_ % VCH) * 8); } } while (0)
#define ATT_LSTORE(b) do { *(LAS u32x4*)(lds + ATT_K_OFF + (b) * 64 * KSTR + krow * KSTR + kch * 16) = kreg; \
        _Pragma("unroll") for (int i_ = 0; i_ < VLD; ++i_) { const int idx_ = tid + NTHREADS * i_; *(LAS u32x4*)(lds + ATT_V_OFF + (b) * 64 * VSTR + (idx_ / VCH) * VSTR + (idx_ % VCH) * 16) = vreg[i_]; } } while (0)
        int R = c0, Lc = c0 - 1;
        int t = R++;
        ATT_GLOAD(t); ATT_LSTORE(0); __syncthreads();
        for (int i = 0; i < NT; ++i) {
            const int buf = i & 1;
            int tn = 0;
            if (i + 1 < NT) { const bool takeR = (Lc < 0) || (R < NT && ((i + 1) < 4 || ((i + 1) & 1))); tn = takeR ? R++ : Lc--; ATT_GLOAD(tn); }
            f32x16 p0, p1;
            const int kb = 64 * t;
            float slope2 = slope2_; asm volatile("" : "+v"(slope2));
            if (kb + 63 < qw || kb > qw + 31) {
                const float sg = (kb > qw) ? -slope2 : slope2;
                const float b0 = sg * ((float)(kb + 4 * hi) - qposf) - mref, b1 = b0 + 32.f * sg;
#pragma unroll
                for (int r = 0; r < 16; ++r) { const float kv = (float)((r & 3) + 8 * (r >> 2)); p0[r] = __builtin_fmaf(sg, kv, b0); p1[r] = __builtin_fmaf(sg, kv, b1); }
            } else {
                const float dq = (float)(kb + 4 * hi) - qposf;
#pragma unroll
                for (int r = 0; r < 16; ++r) { const float t0 = dq + (float)((r & 3) + 8 * (r >> 2)); p0[r] = __builtin_fmaf(-slope2, __builtin_fabsf(t0), -mref); p1[r] = __builtin_fmaf(-slope2, __builtin_fabsf(t0 + 32.f), -mref); }
            }
            const LAS unsigned char* Kb = lds + ATT_K_OFF + buf * 64 * KSTR + r32 * KSTR + hi * 16;
#pragma unroll
            for (int d0 = 0; d0 < 4; ++d0) {
                const bf16x8 a0 = *(const LAS bf16x8*)(Kb + d0 * 32), a1 = *(const LAS bf16x8*)(Kb + 32 * KSTR + d0 * 32);
                p0 = __builtin_amdgcn_mfma_f32_32x32x16_bf16(a0, qr[d0], p0, 0, 0, 0);
                p1 = __builtin_amdgcn_mfma_f32_32x32x16_bf16(a1, qr[d0], p1, 0, 0, 0);
                if (d0 & 1) __builtin_amdgcn_sched_barrier(0);
            }
            float rm = __builtin_fmaxf(p0[0], p1[0]);
#pragma unroll
            for (int r = 1; r < 16; ++r) rm = __builtin_fmaxf(rm, __builtin_fmaxf(p0[r], p1[r]));
            rm = __builtin_fmaxf(rm, __shfl_xor(rm, 32));
            if (i == 0 || __any(rm > B_THR)) {
                const float delta = (i == 0 || rm > B_THR) ? rm : 0.f; const float f = __builtin_amdgcn_exp2f(-delta); mref += delta; l *= f;
#pragma unroll
                for (int r = 0; r < 16; ++r) { p0[r] -= delta; p1[r] -= delta; }
                if (i != 0) {
                    if (hi == 0) wsf[r32] = f;
#pragma unroll
                    for (int r = 0; r < 16; ++r) { const float fr = wsf[crow(r, hi)];
#pragma unroll
                        for (int d = 0; d < ND; ++d) o[d][r] *= fr; }
                }
            }
            float ls0 = 0.f, ls1 = 0.f;
#pragma unroll
            for (int r = 0; r < 16; ++r) { p0[r] = __builtin_amdgcn_exp2f(p0[r]); p1[r] = __builtin_amdgcn_exp2f(p1[r]); ls0 += p0[r]; ls1 += p1[r]; }
            l += ls0 + ls1;
            u32x4 pw[4];
#pragma unroll
            for (int c = 0; c < 4; ++c) {
                const f32x16& P = (c >> 1) ? p1 : p0; const int b = 8 * (c & 1);
                pw[c].x = cvt_pk(P[b + 0], P[b + 1]); pw[c].y = cvt_pk(P[b + 2], P[b + 3]); pw[c].z = cvt_pk(P[b + 4], P[b + 5]); pw[c].w = cvt_pk(P[b + 6], P[b + 7]);
            }
            const LAS unsigned char* Vb = lds + ATT_V_OFF + buf * 64 * VSTR + (4 * hi + ((lane & 15) >> 2)) * VSTR + (16 * ((lane >> 4) & 1) + 4 * (lane & 3)) * 2;
#pragma unroll
            for (int c = 0; c < 4; ++c)
#pragma unroll
                for (int d = 0; d < ND; ++d) {
                    const s16x4 vlo = vtr(Vb + c * 16 * VSTR + d * 64), vhi = vtr(Vb + c * 16 * VSTR + 8 * VSTR + d * 64);
                    const bf16x8 vf = (bf16x8){vlo[0], vlo[1], vlo[2], vlo[3], vhi[0], vhi[1], vhi[2], vhi[3]};
                    o[d] = __builtin_amdgcn_mfma_f32_32x32x16_bf16(__builtin_bit_cast(bf16x8, pw[c]), vf, o[d], 0, 0, 0);
                    if (d == ND - 1) __builtin_amdgcn_sched_barrier(0);
                }
            if (i + 1 < NT) ATT_LSTORE(buf ^ 1);
            t = tn;
            __syncthreads();
        }
#undef ATT_GLOAD
#undef ATT_LSTORE
        l += __shfl_xor(l, 32);
        if (hi == 0) wsf[r32] = 1.f / l;
        int lane_e = lane, qw_e = qw; asm volatile("" : "+v"(lane_e)); asm volatile("" : "+s"(qw_e));
        const int r32 = lane_e & 31, hi = lane_e >> 5, qw = qw_e;
        LAS unsigned* o0buf = (LAS unsigned*)(lds + ATT_O0_OFF) + wid * 2048 + lane_e;
        if (mp == 0) {
#pragma unroll
            for (int d = 0; d < ND; ++d)
#pragma unroll
                for (int r = 0; r < 16; r += 2) { const float i0 = wsf[crow(r, hi)], i1 = wsf[crow(r + 1, hi)]; o0buf[(d * 8 + (r >> 1)) * 64] = cvt_pk(o[d][r] * i0, o[d][r + 1] * i1); }
        } else {
            float gs[ND];
#pragma unroll
            for (int d = 0; d < ND; ++d) gs[d] = subln_l[d * 32 + r32] * postscale;
#pragma unroll
            for (int r = 0; r < 16; r += 2) {
                const float i0 = wsf[crow(r, hi)], i1 = wsf[crow(r + 1, hi)];
                float v0[ND], v1[ND]; float s0 = 0.f, s1 = 0.f;
#pragma unroll
                for (int d = 0; d < ND; ++d) { const unsigned w = o0buf[(d * 8 + (r >> 1)) * 64];
                    v0[d] = __builtin_bit_cast(float, w << 16) - lam * (o[d][r] * i0); v1[d] = __builtin_bit_cast(float, w & 0xffff0000u) - lam * (o[d][r + 1] * i1);
                    s0 += v0[d] * v0[d]; s1 += v1[d] * v1[d]; }
#pragma unroll
                for (int sh = 1; sh < 32; sh <<= 1) { s0 += __shfl_xor(s0, sh); s1 += __shfl_xor(s1, sh); }
                const float r0 = 1.f / sqrtf(s0 * (1.f / 128.f) + 1e-5f), r1 = 1.f / sqrtf(s1 * (1.f / 128.f) + 1e-5f);
                bf16_t* row0 = mix + (size_t)(qw + crow(r, hi)) * DM + r32; bf16_t* row1 = mix + (size_t)(qw + crow(r + 1, hi)) * DM + r32;
#pragma unroll
                for (int d = 0; d < ND; ++d) { row0[d * 32] = (bf16_t)f2bf(v0[d] * r0 * gs[d]); row1[d * 32] = (bf16_t)f2bf(v1[d] * r1 * gs[d]); }
            }
        }
        __syncthreads();
    }
}
__device__ __forceinline__ float alibi_slope(int i, int n) { return exp2f(-8.0f * (float)(i + 1) / (float)n); }
struct Ctx { int tid, lane, wave, G, cu, gw, NGW; };

__device__ __forceinline__ void ph_weights(const Args& a, const Ctx& c, LAS unsigned char* lds) {
    unsigned char* ws = a.ws;
    bf16_t* WinT = (bf16_t*)(ws + WS_WIN); bf16_t* WoutT = (bf16_t*)(ws + WS_WOUT); bf16_t* WupT = (bf16_t*)(ws + WS_WUP); bf16_t* WdnT = (bf16_t*)(ws + WS_WDN);
    const float* w_in = a.in[3]; const float* w_out = a.in[10]; const float* w_up = a.in[12]; const float* w_down = a.in[15];
    LAS float* scr = (LAS float*)(lds + c.wave * 16384);
    constexpr int I_IN = (DM / 64) * (DIN / 32), I_OUT = (DM / 64) * (DM / 32), I_UP = (DM / 64) * (DUP / 32), I_DN = (DFF / 64) * (DM / 32);
    constexpr int PER_L = I_IN + I_OUT + I_UP + I_DN;
    for (int it = c.gw; it < DEPTH * PER_L; it += c.NGW) {
        const int l = it / PER_L; int r = it % PER_L;
        if (r < I_IN) { transpose_item(w_in + (size_t)l * DM * DIN, DM, DIN, WinT + (size_t)l * DIN * DM, scr, r, c.lane); continue; } r -= I_IN;
        if (r < I_OUT) { transpose_item(w_out + (size_t)l * DM * DM, DM, DM, WoutT + (size_t)l * DM * DM, scr, r, c.lane); continue; } r -= I_OUT;
        if (r < I_UP) { transpose_item(w_up + (size_t)l * DM * DUP, DM, DUP, WupT + (size_t)l * DUP * DM, scr, r, c.lane); continue; } r -= I_UP;
        transpose_item(w_down + (size_t)l * DFF * DM, DFF, DM, WdnT + (size_t)l * DM * DFF, scr, r, c.lane);
    }
}
__device__ __forceinline__ const float* chunk_in(const Args& a, int ch) { return ch == 0 ? a.in[0] : a.in[1] + (size_t)(ch - 1) * CH_ROWS * DM; }
__device__ __forceinline__ float* chunk_out(const Args& a, int ch) { return a.out + (size_t)ch * CH_ROWS * DM; }

__device__ __forceinline__ void ph_norm_bf16(const Ctx& c, const float* xsrc, const float* gain, bf16_t* HB) {
    for (int r = c.gw; r < CH_ROWS; r += c.NGW) rms_row_to_bf16(xsrc + (size_t)r * DM, gain, HB + (size_t)r * DM, c.lane);
}
__device__ __forceinline__ void ph_final_norm(const Ctx& c, float* xo, const float* gain) {
    for (int r = c.gw; r < CH_ROWS; r += c.NGW) rms_row_f32(xo + (size_t)r * DM, gain, c.lane);
}

__device__ __forceinline__ void ph_attn(const Args& a, const Ctx& c, LAS unsigned char* lds, int ch, int layer) {
    const bf16_t* PROJ = (const bf16_t*)(a.ws + WS_PROJ); float* TMP = (float*)(a.ws + WS_TMP);
    const int SL = ch == 0 ? 16384 : 4096, sl_shift = ch == 0 ? 14 : 12;
    const int cu = c.cu, G = c.G;
#ifndef SKIP_B
    {
        const float lam_init = layer == 0 ? 0.2f : (0.8f - 0.6f * 0.7408182206817179f);
        const float s1 = wave_sum(a.in[5][layer * 64 + c.lane] * a.in[6][layer * 64 + c.lane]);
        const float s2 = wave_sum(a.in[7][layer * 64 + c.lane] * a.in[8][layer * 64 + c.lane]);
        const float lam = expf(s1) - expf(s2) + lam_init;
        bf16_t* HBm = (bf16_t*)(a.ws + WS_HB);
#ifdef PROBE_B2
        for (int rep_ = 0; rep_ < 2; ++rep_)
#endif
        for (int u = cu; u < 256; u += G) {
            int seq, h, qb;
            if (ch == 0) { seq = 0; h = u >> 6; qb = u & 63; }
            else { seq = u >> 6; h = (u >> 4) & 3; qb = u & 15; }
            const size_t rb = (size_t)seq * SL;
            attn_b_unit(lds, PROJ + rb * DIN, h, qb * 256, SL, alibi_slope(h, 4) * LOG2E, lam, a.in[9] + layer * 128, 1.f - lam_init, HBm + rb * DM + 256 + h * 128);
        }
    }
#endif
#ifndef SKIP_AC
#ifdef PROBE_AC2
    for (int rep_ = 0; rep_ < 2; ++rep_)
#endif
    for (int uu = cu; uu < 1024; uu += G) {
        const bf16_t *qp, *kp, *vp; size_t pitch, opitch, lpitch; int q0, L, W; float slope2, m_init, l_init; float *op, *lp; bf16_t* obf;
        if (uu < 256) {
            const int hq = uu >> 6, blk = uu & 63;
            const int seq = (blk * 256) >> sl_shift, qb = blk - ((seq << sl_shift) >> 8);
            const size_t rb = (size_t)seq * SL; const bf16_t* base = PROJ + rb * DIN;
            qp = base + hq * 64; kp = base + 256 + (hq >> 1) * 64; vp = base + 384 + (hq >> 1) * 64; pitch = DIN; q0 = qb * 256; L = SL;
            slope2 = alibi_slope(hq, 4) * LOG2E; W = 128; m_init = a.in[4][layer * 4 + hq] * LOG2E; l_init = 1.f;
            op = nullptr; obf = (bf16_t*)(a.ws + WS_HB) + rb * DM + hq * 64; opitch = DM; lp = nullptr; lpitch = 0;
        } else {
            const int uc = uu - 256;
            const int gh = uc >> 6, blk = uc & 63, gq = gh >> 2;
            const int dsh = 2 * gq, d = 1 << dsh;
            const int seq = (blk * 256) >> sl_shift, b2 = blk - ((seq << sl_shift) >> 8);
            const int nbr = (SL >> dsh) >> 8;
            const int res = b2 / nbr, qb = b2 % nbr;
            const size_t rb = (size_t)seq * SL + res; const bf16_t* base = PROJ + rb * DIN;
            qp = base + 2048 + gh * 64; kp = base + 2816 + gh * 64; vp = base + 3584 + gh * 64; pitch = (size_t)DIN * d; q0 = qb * 256; L = SL >> dsh;
            slope2 = alibi_slope(gh, 12) * (float)d * LOG2E; W = 64; m_init = -1e30f; l_init = 0.f;
            op = TMP + rb * TW + T_C + gh * 64; obf = nullptr; opitch = (size_t)TW * d; lp = TMP + rb * TW + T_L + gh; lpitch = (size_t)TW * d;
        }
        attn_unit<64, true>(lds, qp, kp, vp, pitch, q0, L, slope2, W, m_init, l_init, op, opitch, lp, lpitch, obf);
    }
#endif
}

__device__ __forceinline__ void ph_combine(const Args& a, const Ctx& c, int layer) {
    const float* TMP = (const float*)(a.ws + WS_TMP); bf16_t* HB = (bf16_t*)(a.ws + WS_HB);
    const int lane = c.lane;
    for (int r = c.gw; r < CH_ROWS; r += c.NGW) {
        const float* tr = TMP + (size_t)r * TW; bf16_t* mr = HB + (size_t)r * DM;
#pragma unroll
        for (int h = 0; h < 4; ++h) {
            const float l0 = tr[T_L + h], l1 = tr[T_L + 4 + h], l2 = tr[T_L + 8 + h];
            const float mx = fmaxf(l0, fmaxf(l1, l2));
            const float w0 = expf(l0 - mx), w1 = expf(l1 - mx), w2 = expf(l2 - mx);
            const float inv = 1.f / (w0 + w1 + w2);
            const float o = (w0 * tr[T_C + h * 64 + lane] + w1 * tr[T_C + (4 + h) * 64 + lane] + w2 * tr[T_C + (8 + h) * 64 + lane]) * inv;
            mr[768 + h * 64 + lane] = (bf16_t)f2bf(o);
        }
    }
}

__device__ __forceinline__ void ph_conv(const Args& a, const Ctx& c, int ch, int layer) {
    const bf16_t* UB = (const bf16_t*)(a.ws + WS_PROJ); bf16_t* GB = (bf16_t*)(a.ws + WS_TMP);
    const int SL = ch == 0 ? 16384 : 4096;
    const float* cw = a.in[13] + (size_t)layer * 3 * DUP; const float* cb = a.in[14] + (size_t)layer * DUP;
    constexpr int NCP = DFF / 2, RB = 16;
    const int nitems = (CH_ROWS / RB) * NCP;
    for (int it = c.cu * NTHREADS + c.tid; it < nitems; it += c.G * NTHREADS) {
        const int cp = it % NCP, rb = it / NCP, c0 = cp * 2, r0 = rb * RB;
        float wg[3][2], wv[3][2], bg[2], bv[2];
#pragma unroll
        for (int k = 0; k < 3; ++k)
#pragma unroll
            for (int j = 0; j < 2; ++j) { wg[k][j] = cw[k * DUP + c0 + j]; wv[k][j] = cw[k * DUP + DFF + c0 + j]; }
#pragma unroll
        for (int j = 0; j < 2; ++j) { bg[j] = cb[c0 + j]; bv[j] = cb[DFF + c0 + j]; }
        const bool first = (r0 & (SL - 1)) == 0, last = ((r0 + RB) & (SL - 1)) == 0;
        unsigned pg_, pv_, cg_, cv_, ng_, nv_;
        pg_ = first ? 0u : *(const unsigned*)(UB + (size_t)(r0 - 1) * DUP + c0); pv_ = first ? 0u : *(const unsigned*)(UB + (size_t)(r0 - 1) * DUP + DFF + c0);
        cg_ = *(const unsigned*)(UB + (size_t)r0 * DUP + c0); cv_ = *(const unsigned*)(UB + (size_t)r0 * DUP + DFF + c0);
        for (int rr = 0; rr < RB; ++rr) {
            const int r = r0 + rr; const bool nz = (rr == RB - 1) && last;
            ng_ = nz ? 0u : *(const unsigned*)(UB + (size_t)(r + 1) * DUP + c0); nv_ = nz ? 0u : *(const unsigned*)(UB + (size_t)(r + 1) * DUP + DFF + c0);
            float res[2];
#pragma unroll
            for (int j = 0; j < 2; ++j) {
                const int sh = j * 16;
                const float gp = bf2f((unsigned short)(pg_ >> sh)), gc = bf2f((unsigned short)(cg_ >> sh)), gn = bf2f((unsigned short)(ng_ >> sh));
                const float vp = bf2f((unsigned short)(pv_ >> sh)), vc = bf2f((unsigned short)(cv_ >> sh)), vn = bf2f((unsigned short)(nv_ >> sh));
                const float gate = gp * wg[0][j] + gc * wg[1][j] + gn * wg[2][j] + bg[j];
                const float val = vp * wv[0][j] + vc * wv[1][j] + vn * wv[2][j] + bv[j];
                res[j] = gate / (1.f + __expf(-gate)) * val;
            }
            *(unsigned*)(GB + (size_t)r * DFF + c0) = pk2(res[0], res[1]);
            pg_ = cg_; pv_ = cv_; cg_ = ng_; cv_ = nv_;
        }
    }
}

constexpr int NSTEPS = 1 + NCHUNK * DEPTH * 9 + 1;
__global__ void __launch_bounds__(NTHREADS, 2) mega_fwd(Args a) {
    extern __shared__ __attribute__((aligned(16))) unsigned char lds_raw[];
    LAS unsigned char* lds = (LAS unsigned char*)lds_raw;
    cg::grid_group grid = cg::this_grid();
    volatile LAS unsigned* bst = (volatile LAS unsigned*)(lds + 131072 + 320);
    if (threadIdx.x < 2) bst[threadIdx.x] = 0u;
    __syncthreads();
    XcdBarrier xbar = xcd_barrier_post((unsigned*)(a.ws + WS_CTL), bst);
    for (int step = 0; step < NSTEPS; ++step) {
        int tid_l = threadIdx.x, cu_l = blockIdx.x, G_l = gridDim.x;
        asm volatile("" : "+v"(tid_l)); asm volatile("" : "+s"(cu_l), "+s"(G_l));
        Ctx c; c.tid = tid_l; c.lane = c.tid & 63; c.wave = __builtin_amdgcn_readfirstlane(c.tid >> 6);
        c.G = G_l; c.cu = cu_l; c.gw = c.cu * 8 + c.wave; c.NGW = c.G * 8;
        if (step == 0) ph_weights(a, c, lds);
        else if (step == NSTEPS - 1) ph_final_norm(c, chunk_out(a, NCHUNK - 1), a.in[16]);
        else {
            const int s = step - 1, ph = s % 9, cl = s / 9, layer = cl & 1, ch = cl >> 1;
            unsigned char* ws = a.ws;
            bf16_t* HB = (bf16_t*)(ws + WS_HB);
            float* xo = chunk_out(a, ch);
            const float* xsrc = layer == 0 ? chunk_in(a, ch) : (const float*)xo;
            if (ph == 0) {
                if (layer == 0 && ch > 0) ph_final_norm(c, chunk_out(a, ch - 1), a.in[16]);

#ifdef PROBE_EW2
 for (int rep_ = 0; rep_ < 2; ++rep_)
#endif
                ph_norm_bf16(c, xsrc, a.in[2] + layer * DM, HB);
            } else if (ph == 1) {
#ifndef SKIP_G
                pg8::Gemm g{HB, (const bf16_t*)(ws + WS_WIN) + (size_t)layer * DIN * DM, CH_ROWS, DIN, DM}; pg8::StaticOrder S; S.init(CH_ROWS, DIN, c.G, c.cu);
                pg8::EpiBf16S E{(bf16_t*)(ws + WS_PROJ), DIN, 1805u, QSCALE};
#ifdef PROBE_G2
                for (int rep_ = 0; rep_ < 2; ++rep_)
#endif
                pg8::gemm_phase<pg8::EpiBf16S, pg8::StaticOrder, true, true>(lds, g, S, E);
#endif
            } else if (ph == 2) {
                ph_attn(a, c, lds, ch, layer);
            } else if (ph == 3) {

#ifdef PROBE_EW2
 for (int rep_ = 0; rep_ < 2; ++rep_)
#endif
                ph_combine(a, c, layer);
            } else if (ph == 4) {
#ifndef SKIP_G
                pg8::Gemm g{HB, (const bf16_t*)(ws + WS_WOUT) + (size_t)layer * DM * DM, CH_ROWS, DM, DM}; pg8::StaticOrder S; S.init(CH_ROWS, DM, c.G, c.cu);
                pg8::EpiRes E{xsrc, xo, DM};
                pg8::gemm_phase<pg8::EpiRes, pg8::StaticOrder, true, true>(lds, g, S, E);
#endif
            } else if (ph == 5) {

#ifdef PROBE_EW2
 for (int rep_ = 0; rep_ < 2; ++rep_)
#endif
                ph_norm_bf16(c, xo, a.in[11] + layer * DM, HB);
            } else if (ph == 6) {
#ifndef SKIP_G
                pg8::Gemm g{HB, (const bf16_t*)(ws + WS_WUP) + (size_t)layer * DUP * DM, CH_ROWS, DUP, DM}; pg8::StaticOrder S; S.init(CH_ROWS, DUP, c.G, c.cu);
                pg8::EpiBf16S E{(bf16_t*)(ws + WS_PROJ), DUP, 0u, 1.f};
#ifdef PROBE_G2
                for (int rep_ = 0; rep_ < 2; ++rep_)
#endif
                pg8::gemm_phase<pg8::EpiBf16S, pg8::StaticOrder, true, true>(lds, g, S, E);
#endif
            } else if (ph == 7) {

#ifdef PROBE_EW2
 for (int rep_ = 0; rep_ < 2; ++rep_)
#endif
                ph_conv(a, c, ch, layer);
            } else {
#ifndef SKIP_G
                pg8::Gemm g{(const bf16_t*)(ws + WS_TMP), (const bf16_t*)(ws + WS_WDN) + (size_t)layer * DM * DFF, CH_ROWS, DM, DFF}; pg8::StaticOrder S; S.init(CH_ROWS, DM, c.G, c.cu);
                pg8::EpiRes E{xo, xo, DM};
                pg8::gemm_phase<pg8::EpiRes, pg8::StaticOrder, true, true>(lds, g, S, E);
#endif
            }
        }
        if (step == 0) grid.sync(); else if (step != NSTEPS - 1) xcd_barrier(xbar);
#ifdef PROBE_S2
        if (step != 0 && step != NSTEPS - 1) { xcd_barrier(xbar); xcd_barrier(xbar); xcd_barrier(xbar); }
#endif
    }
}

extern "C" void kernel_launch(void* const* d_in, const int* in_sizes, int n_in, void* d_out, int out_size, void* d_ws, size_t ws_size, hipStream_t stream) {
    static int grid = 0;
    if (grid == 0) {
        if (n_in != 17 || ws_size < WS_END) { fprintf(stderr, "kernel_launch: unexpected n_in %d / ws_size %zu (need %zu)\n", n_in, ws_size, (size_t)WS_END); grid = -1; return; }
        int dev = 0, cus = 0, per_cu = 0;
        (void)hipGetDevice(&dev); (void)hipDeviceGetAttribute(&cus, hipDeviceAttributeMultiprocessorCount, dev);
        if (hipFuncSetAttribute((const void*)mega_fwd, hipFuncAttributeMaxDynamicSharedMemorySize, LDS_BYTES) != hipSuccess) { fprintf(stderr, "hipFuncSetAttribute failed\n"); grid = -1; return; }
        if (hipOccupancyMaxActiveBlocksPerMultiprocessor(&per_cu, (const void*)mega_fwd, NTHREADS, LDS_BYTES) != hipSuccess || per_cu < 1) { fprintf(stderr, "occupancy query: %d\n", per_cu); per_cu = 1; }
        (void)hipGetLastError();
        grid = cus * 1;
    }
    if (grid < 0) return;
    (void)hipMemsetAsync((char*)d_ws + WS_CTL, 0, 65536, stream);
    Args a{};
    for (int i = 0; i < 17; ++i) a.in[i] = (const float*)d_in[i];
    a.out = (float*)d_out; a.ws = (unsigned char*)d_ws;
    void* args[] = {&a};
    hipError_t e = hipLaunchCooperativeKernel((const void*)mega_fwd, dim3(grid), dim3(NTHREADS), args, LDS_BYTES, stream);
    if (e != hipSuccess) fprintf(stderr, "cooperative launch failed: %s (grid %d)\n", hipGetErrorString(e), grid);
}
```

```cpp
#include <hip/hip_runtime.h>
#include <hip/hip_cooperative_groups.h>
#include <cstdio>
#include <cstdint>
#include <cmath>
namespace cg = cooperative_groups;
namespace pg8 {
#define PG8_LAS __attribute__((address_space(3)))
typedef unsigned short bf16_t;
typedef short bf16x8 __attribute__((ext_vector_type(8)));
typedef float f32x4 __attribute__((ext_vector_type(4)));
typedef unsigned u32x4 __attribute__((ext_vector_type(4)));
constexpr int BM = 256, BK = 64, HALF = 128, HTB = HALF * BK * 2  , STAGE_BYTES = 8 * HTB, NXCD = 8, WGM = 8;

__host__ __device__ __forceinline__ int lds_byte(int r, int c) { const int st = (r >> 4) * 2 + (c >> 5), rr = r & 15, cc = c & 31, ob = rr * 64 + cc * 2; return st * 1024 + (ob ^ (((ob >> 9) & 1) << 5)); }
__host__ __device__ __forceinline__ void stage_rc(int b, int& R, int& C) { const int st = b / 1024, sb = b % 1024, swz = sb ^ (((sb >> 9) & 1) << 5); R = (st >> 1) * 16 + swz / 64; C = (st & 1) * 32 + (swz % 64) / 2; }
__host__ __device__ __forceinline__ int perm32(int rho) { const int n = rho >> 4, i = rho & 15; return 8 * (i >> 2) + 4 * n + (i & 3); }

struct Unit { int pm, pn; };
struct Gemm { const bf16_t* A; const bf16_t* Bt; int M, N, K; };

struct StaticOrder {
    int nM, nN, nwg, G, c;
    __host__ __device__ void init(int M, int N, int G_, int c_) { nM = M / BM; nN = N / BM; nwg = nM * nN; G = G_; c = c_; }
    __host__ __device__ bool next(int i, Unit& u) const {
        const long L = (long)i * G + c; if (L >= nwg) return false;
        int wgid = (int)L; { const int q = nwg / NXCD, r = nwg % NXCD, xcd = wgid % NXCD, off = wgid / NXCD; wgid = (xcd < r ? xcd * (q + 1) : r * (q + 1) + (xcd - r) * q) + off; }
        const int nig = WGM * nN, gid = wgid / nig, fm = gid * WGM, gsz = (nM - fm) < WGM ? (nM - fm) : WGM;
        u.pm = fm + ((wgid % nig) % gsz); u.pn = (wgid % nig) / gsz; return true;
    }
    __device__ __forceinline__ void a_ready(const Unit&) const {}
    __device__ __forceinline__ void done(const Unit&) const {}
};

__device__ __forceinline__ unsigned cvt_pk_bf16(float lo, float hi) { unsigned r; asm volatile("v_cvt_pk_bf16_f32 %0, %1, %2" : "=v"(r) : "v"(lo), "v"(hi)); return r; }
struct EpiBf16S {
    static constexpr bool PERM = true, AFTER_DRAIN = false;
    bf16_t* O; int ldc; unsigned scalemask; float sc;
    __device__ __forceinline__ void operator()(const f32x4 (&acc)[2][2][4][2], const Unit& u, int wr, int wc, int fr, int fq) const {
        const int row0 = u.pm * BM + wr * 64 + fr; const int col0 = u.pn * BM + wc * 32 + 8 * fq;
        const float s = ((scalemask >> u.pn) & 1u) ? sc : 1.f;
#pragma unroll
        for (int ai = 0; ai < 2; ++ai)
#pragma unroll
            for (int m = 0; m < 4; ++m) { bf16_t* rowp = O + (size_t)(row0 + ai * HALF + m * 16) * ldc + col0;
#pragma unroll
                for (int bj = 0; bj < 2; ++bj) { f32x4 v0 = acc[ai][bj][m][0] * s, v1 = acc[ai][bj][m][1] * s;
                    u32x4 w; w.x = cvt_pk_bf16(v0[0], v0[1]); w.y = cvt_pk_bf16(v0[2], v0[3]); w.z = cvt_pk_bf16(v1[0], v1[1]); w.w = cvt_pk_bf16(v1[2], v1[3]);
                    *(u32x4*)(rowp + bj * HALF) = w; } }
    }
};
struct EpiRes {
    static constexpr bool PERM = false, AFTER_DRAIN = false;
    const float* base; float* out; int ldc;
    __device__ __forceinline__ void operator()(const f32x4 (&acc)[2][2][4][2], const Unit& u, int wr, int wc, int fr, int fq) const {
        const int col0 = u.pn * BM + wc * 32 + 4 * fq;
#pragma unroll
        for (int ai = 0; ai < 2; ++ai)
#pragma unroll
            for (int m = 0; m < 4; ++m) { const size_t off = (size_t)(u.pm * BM + ai * HALF + wr * 64 + m * 16 + fr) * ldc + col0;
#pragma unroll
                for (int bj = 0; bj < 2; ++bj)
#pragma unroll
                    for (int n = 0; n < 2; ++n) { const f32x4 bs = *(const f32x4*)(base + off + bj * HALF + n * 16); *(f32x4*)(out + off + bj * HALF + n * 16) = bs + acc[ai][bj][m][n]; }
                asm volatile("" ::: "memory"); }
    }
};

struct EpiBf16S2 {
    static constexpr bool PERM = true, AFTER_DRAIN = false;
    bf16_t* O; int ldc; unsigned scalemask; float sc; const float* ssq;
    __device__ __forceinline__ void operator()(const f32x4 (&acc)[2][2][4][2], const Unit& u, int wr, int wc, int fr, int fq) const {
        const int row0 = u.pm * BM + wr * 64 + fr; const int col0 = u.pn * BM + wc * 32 + 8 * fq;
        const float s = ((scalemask >> u.pn) & 1u) ? sc : 1.f;
#pragma unroll
        for (int ai = 0; ai < 2; ++ai)
#pragma unroll
            for (int m = 0; m < 4; ++m) { const int row = row0 + ai * HALF + m * 16; bf16_t* rowp = O + (size_t)row * ldc + col0;
                const float rs = s / sqrtf(ssq[row] * (1.f / 1024.f) + 1e-6f);
#pragma unroll
                for (int bj = 0; bj < 2; ++bj) { f32x4 v0 = acc[ai][bj][m][0] * rs, v1 = acc[ai][bj][m][1] * rs;
                    u32x4 w; w.x = cvt_pk_bf16(v0[0], v0[1]); w.y = cvt_pk_bf16(v0[2], v0[3]); w.z = cvt_pk_bf16(v1[0], v1[1]); w.w = cvt_pk_bf16(v1[2], v1[3]);
                    *(u32x4*)(rowp + bj * HALF) = w; } }
    }
};
typedef unsigned u32x2e __attribute__((ext_vector_type(2)));
struct EpiRes2 {
    static constexpr bool PERM = false, AFTER_DRAIN = false;
    const float* base; float* out; bf16_t* xb; float* ssq; int ldc;
    __device__ __forceinline__ void operator()(const f32x4 (&acc)[2][2][4][2], const Unit& u, int wr, int wc, int fr, int fq) const {
        const int col0 = u.pn * BM + wc * 32 + 4 * fq;
#pragma unroll
        for (int ai = 0; ai < 2; ++ai)
#pragma unroll
            for (int m = 0; m < 4; ++m) { const int row = u.pm * BM + ai * HALF + wr * 64 + m * 16 + fr; const size_t off = (size_t)row * ldc + col0; float ps = 0.f;
#pragma unroll
                for (int bj = 0; bj < 2; ++bj)
#pragma unroll
                    for (int n = 0; n < 2; ++n) { const f32x4 bs = *(const f32x4*)(base + off + bj * HALF + n * 16); const f32x4 v = bs + acc[ai][bj][m][n];
                        *(f32x4*)(out + off + bj * HALF + n * 16) = v; ps += (v[0] * v[0] + v[1] * v[1]) + (v[2] * v[2] + v[3] * v[3]);
                        u32x2e w; w.x = cvt_pk_bf16(v[0], v[1]); w.y = cvt_pk_bf16(v[2], v[3]); *(u32x2e*)(xb + off + bj * HALF + n * 16) = w; }
                ps += __shfl_xor(ps, 16); ps += __shfl_xor(ps, 32);
                if (fq == 0) atomicAdd(ssq + row, ps);
                asm volatile("" ::: "memory"); }
    }
};
template <class Epi, class Sched, bool ALIGN_EPI = false, bool SP2 = false>
__device__ __forceinline__ void gemm_phase(PG8_LAS unsigned char* lds, const Gemm g, const Sched& S, const Epi& E) {
    int tid_l = threadIdx.x; asm volatile("" : "+v"(tid_l)); const int tid = tid_l, wid = __builtin_amdgcn_readfirstlane(tid >> 6), lane = tid & 63, wr = wid >> 2, wc = wid & 3, fr = lane & 15, fq = lane >> 4;
    const int K = g.K, nt = K / BK;
    unsigned voffA[2], voffB[2];
#pragma unroll
    for (int i = 0; i < 2; ++i) { int R, C; stage_rc(tid * 16 + i * 8192, R, C); const int Rb = Epi::PERM ? ((R & ~31) + perm32(R & 31)) : R;
        voffA[i] = (unsigned)(R * K + C) * 2u; voffB[i] = (unsigned)(Rb * K + C) * 2u; }
    const size_t kstep = (size_t)(BK * 2);
    const size_t hstep = (size_t)HALF * K * 2;
    const size_t tstep = 2 * hstep;
    const unsigned ldsw = (unsigned)wid * 1024u;
    const int aoff = lds_byte(wr * 64 + fr, fq * 8), boff = lds_byte(wc * 32 + fr, fq * 8);
#define PG8_SA(b, h) (((b) * 2 + (h)) * HTB)
#define PG8_SB(b, h) ((4 + (b) * 2 + (h)) * HTB)
#define PG8_STAGE(bufoff, gbase, voff) do { _Pragma("unroll") for (int _i = 0; _i < 2; ++_i) \
        __builtin_amdgcn_global_load_lds((const unsigned*)((const char*)(gbase) + (voff)[_i]), (PG8_LAS unsigned*)(lds + (bufoff) + ldsw + _i * 8192), 16, 0, 0); } while (0)
#define PG8_LDA(dst, b, h) do { _Pragma("unroll") for (int m = 0; m < 4; ++m) _Pragma("unroll") for (int k = 0; k < 2; ++k) dst[m][k] = *(const PG8_LAS bf16x8*)(lds + PG8_SA(b, h) + aoff + m * 2048 + k * 1024); } while (0)
#define PG8_LDB(dst, b, h) do { _Pragma("unroll") for (int n = 0; n < 2; ++n) _Pragma("unroll") for (int k = 0; k < 2; ++k) dst[n][k] = *(const PG8_LAS bf16x8*)(lds + PG8_SB(b, h) + boff + n * 2048 + k * 1024); } while (0)
#define PG8_MMA(ai, bj, At, Bt) do { __builtin_amdgcn_s_setprio(1); _Pragma("unroll") for (int m = 0; m < 4; ++m) _Pragma("unroll") for (int n = 0; n < 2; ++n) _Pragma("unroll") for (int k = 0; k < 2; ++k) \
        acc[ai][bj][m][n] = __builtin_amdgcn_mfma_f32_16x16x32_bf16(Bt[n][k], At[m][k], acc[ai][bj][m][n], 0, 0, 0); __builtin_amdgcn_s_setprio(0); } while (0)
#define PG8_WAIT_V(n) asm volatile("s_waitcnt vmcnt(" #n ")" ::: "memory")
#define PG8_WAIT_L(n) asm volatile("s_waitcnt lgkmcnt(" #n ")" ::: "memory")
#define PG8_BAR __builtin_amdgcn_s_barrier()
#define PG8_SCHED __builtin_amdgcn_sched_barrier(0)
    Unit cur, nxt; int ui = 0;
    if (!S.next(0, cur)) return;
    f32x4 acc[2][2][4][2];
#pragma unroll
    for (int a = 0; a < 2; ++a)
#pragma unroll
        for (int b = 0; b < 2; ++b)
#pragma unroll
            for (int m = 0; m < 4; ++m)
#pragma unroll
                for (int n = 0; n < 2; ++n) acc[a][b][m][n] = (f32x4){0.f, 0.f, 0.f, 0.f};
    bf16x8 At[4][2], B0[2][2], B1[2][2];
    const char* cA = (const char*)g.A + (size_t)cur.pm * tstep; const char* cB = (const char*)g.Bt + (size_t)cur.pn * tstep;
    S.a_ready(cur);
    if constexpr (SP2) {
        PG8_STAGE(PG8_SB(0, 0), cB, voffB); PG8_STAGE(PG8_SB(0, 1), cB + hstep, voffB); PG8_STAGE(PG8_SA(0, 0), cA, voffA); PG8_STAGE(PG8_SA(0, 1), cA + hstep, voffA);
        if (wr == 1) PG8_BAR;
        PG8_WAIT_V(2); PG8_BAR;
        PG8_STAGE(PG8_SB(1, 0), cB + kstep, voffB); PG8_STAGE(PG8_SA(1, 0), cA + kstep, voffA); PG8_STAGE(PG8_SB(1, 1), cB + hstep + kstep, voffB);
        PG8_WAIT_V(6); PG8_BAR;
    } else {
        PG8_STAGE(PG8_SB(0, 0), cB, voffB); PG8_STAGE(PG8_SA(0, 0), cA, voffA); PG8_STAGE(PG8_SB(0, 1), cB + hstep, voffB); PG8_STAGE(PG8_SA(0, 1), cA + hstep, voffA);
        if (wr == 1) PG8_BAR;
        PG8_WAIT_V(4); PG8_BAR;
        PG8_STAGE(PG8_SB(1, 0), cB + kstep, voffB); PG8_STAGE(PG8_SA(1, 0), cA + kstep, voffA); PG8_STAGE(PG8_SB(1, 1), cB + hstep + kstep, voffB);
        PG8_WAIT_V(6); PG8_BAR;
    }
    for (;;) {
        const bool has_next = S.next(ui + 1, nxt);
        const char* nA = has_next ? (const char*)g.A + (size_t)nxt.pm * tstep : cA; const char* nB = has_next ? (const char*)g.Bt + (size_t)nxt.pn * tstep : cB;
        for (int t = 0; t < nt; t += 2) {
            const bool last = (t == nt - 2);
            const char* a1 = cA + (size_t)(t + 1) * kstep;
            const char* a2 = last ? nA : cA + (size_t)(t + 2) * kstep; const char* b2 = last ? nB : cB + (size_t)(t + 2) * kstep;
            const char* a3 = a2 + kstep; const char* b3 = b2 + kstep;
            if (last && has_next) S.a_ready(nxt);
            if constexpr (SP2) {
            PG8_LDB(B0, 0, 0); PG8_LDB(B1, 0, 1); PG8_SCHED; PG8_LDA(At, 0, 0); PG8_STAGE(PG8_SA(1, 1), a1 + hstep, voffA);
            PG8_WAIT_V(8); PG8_WAIT_L(0); PG8_BAR; PG8_MMA(0, 0, At, B0); PG8_MMA(0, 1, At, B1); PG8_BAR; PG8_SCHED;
            PG8_LDA(At, 0, 1); PG8_STAGE(PG8_SB(0, 0), b2, voffB); PG8_STAGE(PG8_SB(0, 1), b2 + hstep, voffB); PG8_STAGE(PG8_SA(0, 0), a2, voffA);
            PG8_WAIT_V(8); PG8_WAIT_L(0); PG8_BAR; PG8_MMA(1, 0, At, B0); PG8_MMA(1, 1, At, B1); PG8_BAR; PG8_SCHED;
            PG8_LDB(B0, 1, 0); PG8_LDB(B1, 1, 1); PG8_SCHED; PG8_LDA(At, 1, 0); PG8_STAGE(PG8_SA(0, 1), a2 + hstep, voffA);
            PG8_WAIT_V(8); PG8_WAIT_L(0); PG8_BAR; PG8_MMA(0, 0, At, B0); PG8_MMA(0, 1, At, B1); PG8_BAR; PG8_SCHED;
            PG8_LDA(At, 1, 1); PG8_STAGE(PG8_SB(1, 0), b3, voffB); PG8_STAGE(PG8_SB(1, 1), b3 + hstep, voffB); PG8_STAGE(PG8_SA(1, 0), a3, voffA);
            PG8_WAIT_V(8); PG8_WAIT_L(0); PG8_BAR; PG8_MMA(1, 0, At, B0); PG8_MMA(1, 1, At, B1); PG8_BAR; PG8_SCHED;
            } else {
            PG8_LDB(B0, 0, 0); PG8_SCHED; PG8_LDA(At, 0, 0); PG8_STAGE(PG8_SA(1, 1), a1 + hstep, voffA);
            PG8_WAIT_L(8); PG8_BAR; PG8_WAIT_L(0); PG8_MMA(0, 0, At, B0); PG8_BAR; PG8_SCHED;
            PG8_LDB(B1, 0, 1); PG8_STAGE(PG8_SB(0, 0), b2, voffB);
            PG8_BAR; PG8_WAIT_L(0); PG8_MMA(0, 1, At, B1); PG8_BAR;
            PG8_LDA(At, 0, 1); PG8_STAGE(PG8_SA(0, 0), a2, voffA);
            PG8_BAR; PG8_WAIT_L(0); PG8_MMA(1, 0, At, B0); PG8_BAR; PG8_SCHED;
            PG8_STAGE(PG8_SB(0, 1), b2 + hstep, voffB);
            PG8_WAIT_V(6); PG8_BAR; PG8_MMA(1, 1, At, B1); PG8_BAR;
            PG8_LDB(B0, 1, 0); PG8_SCHED; PG8_LDA(At, 1, 0); PG8_STAGE(PG8_SA(0, 1), a2 + hstep, voffA);
            PG8_WAIT_L(8); PG8_BAR; PG8_WAIT_L(0); PG8_MMA(0, 0, At, B0); PG8_BAR; PG8_SCHED;
            PG8_LDB(B1, 1, 1); PG8_STAGE(PG8_SB(1, 0), b3, voffB);
            PG8_BAR; PG8_WAIT_L(0); PG8_MMA(0, 1, At, B1); PG8_BAR;
            PG8_LDA(At, 1, 1); PG8_STAGE(PG8_SA(1, 0), a3, voffA);
            PG8_BAR; PG8_WAIT_L(0); PG8_MMA(1, 0, At, B0); PG8_BAR; PG8_SCHED;
            PG8_STAGE(PG8_SB(1, 1), b3 + hstep, voffB);
            PG8_WAIT_V(6); PG8_BAR; PG8_MMA(1, 1, At, B1); PG8_BAR;
            }
        }
        if constexpr (ALIGN_EPI) { if (wr == 0) PG8_BAR; }
        if constexpr (!Epi::AFTER_DRAIN) { E(acc, cur, wr, wc, fr, fq); S.done(cur); }
        if (!has_next) break;
#pragma unroll
        for (int a = 0; a < 2; ++a)
#pragma unroll
            for (int b = 0; b < 2; ++b)
#pragma unroll
                for (int m = 0; m < 4; ++m)
#pragma unroll
                    for (int n = 0; n < 2; ++n) acc[a][b][m][n] = (f32x4){0.f, 0.f, 0.f, 0.f};
        cur = nxt; cA = nA; cB = nB; ++ui;
        if constexpr (ALIGN_EPI) { if (wr == 1) PG8_BAR; }
    }
    PG8_WAIT_V(0);
    if constexpr (!ALIGN_EPI) { if (wr == 0) PG8_BAR; }
    PG8_BAR;
    if constexpr (Epi::AFTER_DRAIN) { E.fused(acc, cur, wr, wc, fr, fq, lds, wid, lane); S.done(cur); }
#undef PG8_SA
#undef PG8_SB
#undef PG8_STAGE
#undef PG8_LDA
#undef PG8_LDB
#undef PG8_MMA
#undef PG8_WAIT_V
#undef PG8_WAIT_L
#undef PG8_BAR
#undef PG8_SCHED
}
}
typedef __bf16 bf16x2_t __attribute__((ext_vector_type(2)));
__device__ __forceinline__ unsigned cvt_pk(float lo, float hi) { float __attribute__((ext_vector_type(2))) v = {lo, hi}; bf16x2_t b = __builtin_convertvector(v, bf16x2_t); return __builtin_bit_cast(unsigned, b); }
#define LAS __attribute__((address_space(3)))
#define XB_TMO      128
#define XB_XCNT(j)  (256  + 64 * (j))
#define XB_XSUB(j)  (1280 + 64 * (j))
#define XB_XGEN(j)  (2304 + 64 * (j))
#define XB_TOP      3328
#define XB_TOPGEN   3392
#define XCD_BAR_WORDS 3456
#define XB_SPIN_CAP (1u << 18)

__device__ __forceinline__ unsigned xb_ld(unsigned* p)              { return __hip_atomic_load(p, __ATOMIC_RELAXED, __HIP_MEMORY_SCOPE_AGENT); }
__device__ __forceinline__ unsigned xb_add(unsigned* p, unsigned v) { return __hip_atomic_fetch_add(p, v, __ATOMIC_RELAXED, __HIP_MEMORY_SCOPE_AGENT); }
__device__ __forceinline__ unsigned xb_xcc_id() { return (unsigned)__builtin_amdgcn_s_getreg((3 << 11) | 20) & 0xFu; }
#define XB_SPIN(cond, bar) do { unsigned _sp = 0; while (cond) { __builtin_amdgcn_s_sleep(1); \
    if ((++_sp & 255u) == 0u) { if (xb_ld(&(bar)[XB_TMO])) break; if (_sp > XB_SPIN_CAP) { atomicAdd(&(bar)[XB_TMO], 1u); break; } } } } while (0)

struct XcdBarrier {
    unsigned* bar; unsigned x;
    volatile LAS unsigned* st;
};

__device__ __forceinline__ XcdBarrier xcd_barrier_post(unsigned* bar, volatile LAS unsigned* st) {
    XcdBarrier b; b.bar = bar; b.x = xb_xcc_id(); b.st = st;
    if (threadIdx.x == 0) (void)xb_add(&bar[XB_XCNT(b.x)], 1u);
    return b;
}
__device__ __forceinline__ void xcd_barrier_complete(unsigned* bar, unsigned x, unsigned& nloc, unsigned& nx) {
    const unsigned G = gridDim.x * gridDim.y * gridDim.z;
    unsigned sum, cnt, mine, sp = 0u;
    for (;;) {
        sum = 0u; cnt = 0u; mine = 0u;
#pragma unroll
        for (unsigned j = 0; j < 16; ++j) { const unsigned c = xb_ld(&bar[XB_XCNT(j)]); sum += c; cnt += (c > 0u) ? 1u : 0u; mine = (j == x) ? c : mine; }
        if (sum == G) break;
        __builtin_amdgcn_s_sleep(1);
        if ((++sp & 255u) == 0u) { if (xb_ld(&bar[XB_TMO])) break; if (sp > XB_SPIN_CAP) { atomicAdd(&bar[XB_TMO], 1u); break; } }
    }
    nloc = mine > 0u ? mine : 1u; nx = cnt > 0u ? cnt : 1u;
}

__device__ __forceinline__ void xcd_barrier(const XcdBarrier& b) {
    asm volatile("s_waitcnt vmcnt(0)" ::: "memory");
    __syncthreads();
    if (threadIdx.x == 0) {
        unsigned* bar = b.bar;
        __builtin_amdgcn_s_waitcnt(0);
        unsigned nloc = b.st[0], nx = b.st[1];
        if (nloc == 0u) { xcd_barrier_complete(bar, b.x, nloc, nx); b.st[0] = nloc; b.st[1] = nx; }
        const unsigned old = xb_add(&bar[XB_XSUB(b.x)], 1u);
        const unsigned gen = old / nloc;
        if (old + 1u == (gen + 1u) * nloc) {
            __builtin_amdgcn_fence(__ATOMIC_RELEASE, "agent");
            asm volatile("s_waitcnt vmcnt(0)" ::: "memory");
            const unsigned og = xb_add(&bar[XB_TOP], 1u);
            const unsigned tg = og / nx;
            if (og + 1u == (tg + 1u) * nx) xb_add(&bar[XB_TOPGEN], 1u);
            else XB_SPIN(xb_ld(&bar[XB_TOPGEN]) == tg, bar);
            __builtin_amdgcn_fence(__ATOMIC_ACQUIRE, "agent");
            xb_add(&bar[XB_XGEN(b.x)], 1u);
            asm volatile("s_waitcnt vmcnt(0)" ::: "memory");
        } else {
            XB_SPIN(xb_ld(&bar[XB_XGEN(b.x)]) == gen, bar);
            __builtin_amdgcn_fence(__ATOMIC_ACQUIRE, "agent");
            asm volatile("s_waitcnt vmcnt(0)" ::: "memory");
        }
    }
    __syncthreads();
}
typedef unsigned short bf16_t;
typedef short bf16x8 __attribute__((ext_vector_type(8)));
typedef short s16x4 __attribute__((ext_vector_type(4)));
typedef float f32x16 __attribute__((ext_vector_type(16)));
typedef float f32x4 __attribute__((ext_vector_type(4)));
typedef float f32x2 __attribute__((ext_vector_type(2)));
typedef unsigned u32x4 __attribute__((ext_vector_type(4)));
typedef unsigned u32x2 __attribute__((ext_vector_type(2)));

constexpr int DM = 1024, DIN = 4352, DFF = 2816, DUP = 2 * DFF, DEPTH = 2;
constexpr int CH_ROWS = 16384, NCHUNK = 3;
constexpr int TW = 2064;
constexpr int T_A = 0, T_B = 256, T_C = 1280, T_L = 2048;
constexpr float LOG2E = 1.4426950408889634f, LN2 = 0.6931471805599453f;
constexpr float QSCALE = 0.125f * LOG2E;
constexpr size_t MiB = 1u << 20;
constexpr size_t WS_WIN = 0, WS_WOUT = 18 * MiB, WS_WUP = 22 * MiB, WS_WDN = 44 * MiB, WS_HB = 56 * MiB, WS_PROJ = 88 * MiB, WS_TMP = 264 * MiB, WS_CTL = 394 * MiB, WS_XB = 395 * MiB, WS_SSQ = 427 * MiB, WS_END = 428 * MiB;
constexpr int LDS_BYTES = 147456;
constexpr int NTHREADS = 512;

struct Args { const float* in[17]; float* out; unsigned char* ws; };

__device__ __forceinline__ float wave_sum(float v) {
#pragma unroll
    for (int o = 1; o < 64; o <<= 1) v += __shfl_xor(v, o);
    return v;
}
__device__ __forceinline__ unsigned f2bf(float f) { unsigned u = __builtin_bit_cast(unsigned, f); return (u + 0x7fffu + ((u >> 16) & 1u)) >> 16; }
__device__ __forceinline__ unsigned pk2(float lo, float hi) { return f2bf(lo) | (f2bf(hi) << 16); }
__device__ __forceinline__ float bf2f(unsigned short b) { return __builtin_bit_cast(float, (unsigned)b << 16); }

__device__ __forceinline__ void transpose_item(const float* W, int K, int N, bf16_t* WT, LAS float* scr, int item, int lane, const float* gain) {
    const int nblk = N / 32, kb = item / nblk, nb = item % nblk, k0 = 64 * kb, n0 = 32 * nb;
#pragma unroll 8
    for (int i = 0; i < 32; ++i) { const int kk = 2 * i + (lane >> 5); scr[kk * 33 + (lane & 31)] = W[(size_t)(k0 + kk) * N + n0 + (lane & 31)] * (gain ? gain[k0 + kk] : 1.f); }
    asm volatile("s_waitcnt lgkmcnt(0)" ::: "memory");
    const int c = lane & 7;
#pragma unroll
    for (int j = 0; j < 4; ++j) { const int n = (lane >> 3) + 8 * j; const LAS float* s = scr + (8 * c) * 33 + n;
        u32x4 o; o.x = pk2(s[0 * 33], s[1 * 33]); o.y = pk2(s[2 * 33], s[3 * 33]); o.z = pk2(s[4 * 33], s[5 * 33]); o.w = pk2(s[6 * 33], s[7 * 33]);
        *(u32x4*)(WT + (size_t)(n0 + n) * K + k0 + 8 * c) = o; }
    asm volatile("s_waitcnt lgkmcnt(0)" ::: "memory");
}

__device__ __forceinline__ void rms_row_to_bf16(const float* xrow, const float* gain, bf16_t* orow, int lane) {
    const f32x4* xr = (const f32x4*)xrow + lane; const f32x4* gr = (const f32x4*)gain + lane;
    f32x4 v[4]; float s = 0.f;
#pragma unroll
    for (int j = 0; j < 4; ++j) { v[j] = xr[64 * j]; s += (v[j].x * v[j].x + v[j].y * v[j].y) + (v[j].z * v[j].z + v[j].w * v[j].w); }
    const float rstd = 1.f / sqrtf(wave_sum(s) * (1.f / DM) + 1e-6f);
    u32x2* o8 = (u32x2*)orow + lane;
#pragma unroll
    for (int j = 0; j < 4; ++j) { const f32x4 g = gr[64 * j]; u32x2 w; w.x = pk2(v[j].x * rstd * g.x, v[j].y * rstd * g.y); w.y = pk2(v[j].z * rstd * g.z, v[j].w * rstd * g.w); o8[64 * j] = w; }
}
__device__ __forceinline__ void rms_row_f32(float* xrow, const float* gain, int lane) {
    f32x4* xr = (f32x4*)xrow + lane; const f32x4* gr = (const f32x4*)gain + lane;
    f32x4 v[4]; float s = 0.f;
#pragma unroll
    for (int j = 0; j < 4; ++j) { v[j] = xr[64 * j]; s += (v[j].x * v[j].x + v[j].y * v[j].y) + (v[j].z * v[j].z + v[j].w * v[j].w); }
    const float rstd = 1.f / sqrtf(wave_sum(s) * (1.f / DM) + 1e-6f);
#pragma unroll
    for (int j = 0; j < 4; ++j) { const f32x4 g = gr[64 * j]; xr[64 * j] = v[j] * rstd * g; }
}

constexpr int KSTR = 144;
constexpr int ATT_K_OFF = 0, ATT_V_OFF = 2 * 64 * KSTR, ATT_SCR_OFF = ATT_V_OFF + 2 * 64 * 320;
__device__ __forceinline__ int crow(int r, int hi) { return (r & 3) + 8 * (r >> 2) + 4 * hi; }
typedef short v4i16_t __attribute__((ext_vector_type(4)));
__device__ __forceinline__ s16x4 vtr(const LAS unsigned char* p) { return __builtin_bit_cast(s16x4, __builtin_amdgcn_ds_read_tr16_b64_v4i16((LAS v4i16_t*)p)); }

template <int VD, bool WIN>
__device__ __forceinline__ void attn_unit(LAS unsigned char* lds, const bf16_t* Qp, const bf16_t* Kp, const bf16_t* Vp, size_t pitch,
                                          int q0, int L, float slope2, int W, float m_init, float l_init,
                                          float* Oout, size_t opitch, float* lse_out, size_t lpitch, bf16_t* Obf) {
    constexpr int VSTR = VD * 2 + 64, ND = VD / 32, VCH = VD / 8, VLD = 64 * VCH / NTHREADS;
    int tid_l = threadIdx.x; asm volatile("" : "+v"(tid_l)); const int tid = tid_l, lane = tid & 63, r32 = lane & 31, hi = lane >> 5, wid = __builtin_amdgcn_readfirstlane(tid >> 6);
    const int qw = q0 + wid * 32;
    int tlo = 0, thi = L / 64;
    if (WIN) { const int a = q0 - W; tlo = a > 0 ? a / 64 : 0; const int b = q0 + 256 + W; thi = (b < L ? b : L) / 64; }
    bf16x8 qr[4];
    { const bf16_t* qrow = Qp + (size_t)(qw + r32) * pitch + hi * 8;
#pragma unroll
      for (int d0 = 0; d0 < 4; ++d0) qr[d0] = *(const bf16x8*)(qrow + d0 * 16); }
    f32x16 o[ND];
#pragma unroll
    for (int d = 0; d < ND; ++d)
#pragma unroll
        for (int r = 0; r < 16; ++r) o[d][r] = 0.f;
    float m = m_init, l = hi == 0 ? l_init : 0.f;
    LAS float* wsf = (LAS float*)(lds + ATT_SCR_OFF) + wid * 64;
    const int krow = tid >> 3, kch = tid & 7;
    u32x4 kreg; u32x4 vreg[VLD];
#define ATT_GLOAD(t) do { kreg = *(const u32x4*)(Kp + (size_t)(64 * (t) + krow) * pitch + kch * 8); \
        _Pragma("unroll") for (int i_ = 0; i_ < VLD; ++i_) { const int idx_ = tid + NTHREADS * i_; vreg[i_] = *(const u32x4*)(Vp + (size_t)(64 * (t) + idx_ / VCH) * pitch + (idx_ % VCH) * 8); } } while (0)
#define ATT_LSTORE(b) do { *(LAS u32x4*)(lds + ATT_K_OFF + (b) * 64 * KSTR + krow * KSTR + kch * 16) = kreg; \
        _Pragma("unroll") for (int i_ = 0; i_ < VLD; ++i_) { const int idx_ = tid + NTHREADS * i_; *(LAS u32x4*)(lds + ATT_V_OFF + (b) * 64 * VSTR + (idx_ / VCH) * VSTR + (idx_ % VCH) * 16) = vreg[i_]; } } while (0)
    const int n = thi - tlo;
    ATT_GLOAD(tlo); ATT_LSTORE(0); __syncthreads();
    const float Wf = (float)W;
    for (int i = 0; i < n; ++i) {
        const int t = tlo + i, buf = i & 1;
        if (i + 1 < n) ATT_GLOAD(t + 1);
        bool active = true;
        if (WIN) { const int kb = 64 * t; active = (kb + 63 >= qw - W) && (kb <= qw + 31 + W); }
        if (active) {
            const LAS unsigned char* Kb = lds + ATT_K_OFF + buf * 64 * KSTR + r32 * KSTR + hi * 16;
            f32x16 p0, p1;
#pragma unroll
            for (int r = 0; r < 16; ++r) { p0[r] = 0.f; p1[r] = 0.f; }
#pragma unroll
            for (int d0 = 0; d0 < 4; ++d0) {
                const bf16x8 a0 = *(const LAS bf16x8*)(Kb + d0 * 32), a1 = *(const LAS bf16x8*)(Kb + 32 * KSTR + d0 * 32);
                p0 = __builtin_amdgcn_mfma_f32_32x32x16_bf16(a0, qr[d0], p0, 0, 0, 0);
                p1 = __builtin_amdgcn_mfma_f32_32x32x16_bf16(a1, qr[d0], p1, 0, 0, 0);
                if (d0 & 1) __builtin_amdgcn_sched_barrier(0);
            }
            const float dq = (float)(64 * t + 4 * hi - (qw + r32));
            float rm = -INFINITY;
#pragma unroll
            for (int r = 0; r < 16; ++r) {
                const float t0 = dq + (float)((r & 3) + 8 * (r >> 2)), t1 = t0 + 32.f;
                p0[r] = __builtin_fmaf(-slope2, __builtin_fabsf(t0), p0[r]);
                p1[r] = __builtin_fmaf(-slope2, __builtin_fabsf(t1), p1[r]);
                if (WIN) { if (__builtin_fabsf(t0) > Wf) p0[r] = -INFINITY; if (__builtin_fabsf(t1) > Wf) p1[r] = -INFINITY; }
                rm = __builtin_fmaxf(rm, __builtin_fmaxf(p0[r], p1[r]));
            }
            rm = __builtin_fmaxf(rm, __shfl_xor(rm, 32));
            if (__any(rm > m)) {
                const float mn = __builtin_fmaxf(m, rm); const float f = __builtin_amdgcn_exp2f(m - mn); m = mn; l *= f;
                if (hi == 0) wsf[r32] = f;
#pragma unroll
                for (int r = 0; r < 16; ++r) { const float fr = wsf[crow(r, hi)];
#pragma unroll
                    for (int d = 0; d < ND; ++d) o[d][r] *= fr; }
            }
            float ls = 0.f;
#pragma unroll
            for (int r = 0; r < 16; ++r) { p0[r] = __builtin_amdgcn_exp2f(p0[r] - m); p1[r] = __builtin_amdgcn_exp2f(p1[r] - m); ls += p0[r] + p1[r]; }
            l += ls;
            u32x4 pw[4];
#pragma unroll
            for (int c = 0; c < 4; ++c) {
                const f32x16& P = (c >> 1) ? p1 : p0; const int b = 8 * (c & 1);
                pw[c].x = cvt_pk(P[b + 0], P[b + 1]); pw[c].y = cvt_pk(P[b + 2], P[b + 3]); pw[c].z = cvt_pk(P[b + 4], P[b + 5]); pw[c].w = cvt_pk(P[b + 6], P[b + 7]);
            }
            const LAS unsigned char* Vb = lds + ATT_V_OFF + buf * 64 * VSTR + (4 * hi + ((lane & 15) >> 2)) * VSTR + (16 * ((lane >> 4) & 1) + 4 * (lane & 3)) * 2;
#pragma unroll
            for (int c = 0; c < 4; ++c)
#pragma unroll
                for (int d = 0; d < ND; ++d) {
                    const s16x4 vlo = vtr(Vb + c * 16 * VSTR + d * 64), vhi = vtr(Vb + c * 16 * VSTR + 8 * VSTR + d * 64);
                    const bf16x8 vf = (bf16x8){vlo[0], vlo[1], vlo[2], vlo[3], vhi[0], vhi[1], vhi[2], vhi[3]};
                    o[d] = __builtin_amdgcn_mfma_f32_32x32x16_bf16(__builtin_bit_cast(bf16x8, pw[c]), vf, o[d], 0, 0, 0);
                    if (d == ND - 1) __builtin_amdgcn_sched_barrier(0);
                }
        }
        if (i + 1 < n) ATT_LSTORE(buf ^ 1);
        __syncthreads();
    }
#undef ATT_GLOAD
#undef ATT_LSTORE
    l += __shfl_xor(l, 32);
    if (hi == 0) wsf[r32] = 1.f / l;
#pragma unroll
    for (int r = 0; r < 16; ++r) { const float ir = wsf[crow(r, hi)];
        if (Obf != nullptr) { bf16_t* orow = Obf + (size_t)(qw + crow(r, hi)) * opitch + r32;
#pragma unroll
            for (int d = 0; d < ND; ++d) orow[d * 32] = (bf16_t)f2bf(o[d][r] * ir);
        } else { float* orow = Oout + (size_t)(qw + crow(r, hi)) * opitch + r32;
#pragma unroll
            for (int d = 0; d < ND; ++d) orow[d * 32] = o[d][r] * ir; } }
    if (lse_out != nullptr && hi == 0) lse_out[(size_t)(qw + r32) * lpitch] = (m + __builtin_log2f(l)) * LN2;
    __syncthreads();
}

__device__ __forceinline__ void row_to_bf16_ssq(const float* xrow, bf16_t* orow, float* ssq, int lane) {
    const f32x4* xr = (const f32x4*)xrow + lane;
    f32x4 v[4]; float s = 0.f;
#pragma unroll
    for (int j = 0; j < 4; ++j) { v[j] = xr[64 * j]; s += (v[j].x * v[j].x + v[j].y * v[j].y) + (v[j].z * v[j].z + v[j].w * v[j].w); }
    s = wave_sum(s);
    u32x2* o8 = (u32x2*)orow + lane;
#pragma unroll
    for (int j = 0; j < 4; ++j) { u32x2 w; w.x = pk2(v[j].x, v[j].y); w.y = pk2(v[j].z, v[j].w); o8[64 * j] = w; }
    if (lane == 0) *ssq = s;
}
constexpr int ATT_O0_OFF = 61440;
constexpr float B_THR = 6.0f;
__device__ __forceinline__ float max3f(float a, float b, float c) { float r; asm("v_max3_f32 %0, %1, %2, %3" : "=v"(r) : "v"(a), "v"(b), "v"(c)); return r; }
__device__ __forceinline__ void attn_b_unit(LAS unsigned char* lds, const bf16_t* base, int h, int q0, int L, float slope2_, float lam,
                                            const float* subln_l, float postscale, bf16_t* mix) {
    constexpr int VD = 128, VSTR = VD * 2 + 64, ND = 4, VCH = 16, VLD = 2;
    int tid_l = threadIdx.x; asm volatile("" : "+v"(tid_l)); const int tid = tid_l, lane = tid & 63, r32 = lane & 31, hi = lane >> 5, wid = __builtin_amdgcn_readfirstlane(tid >> 6);
    const int qw = q0 + wid * 32, NT = L / 64, c0 = q0 / 64;
    LAS float* wsf = (LAS float*)(lds + ATT_SCR_OFF) + wid * 64;
    const int krow = tid >> 3, kch = tid & 7;
    const bf16_t* Vp = base + 1536 + h * 128;
    const float qposf_ = (float)(qw + r32);
    for (int mp = 0; mp < 2; ++mp) {
        const bf16_t* Qp = base + 512 + (h * 2 + mp) * 64; const bf16_t* Kp = base + 1024 + (h * 2 + mp) * 64;
        bf16x8 qr[4];
        { const bf16_t* qrow = Qp + (size_t)(qw + r32) * DIN + hi * 8;
#pragma unroll
          for (int d0 = 0; d0 < 4; ++d0) qr[d0] = *(const bf16x8*)(qrow + d0 * 16); }
        f32x16 o[ND];
#pragma unroll
        for (int d = 0; d < ND; ++d)
#pragma unroll
            for (int r = 0; r < 16; ++r) o[d][r] = 0.f;
        float mref = 0.f, l = 0.f;
        u32x4 kreg; u32x4 vreg[VLD];
        const unsigned koff = (unsigned)(krow * DIN + kch * 8) * 2u, voff = (unsigned)((tid >> 4) * DIN + (tid & 15) * 8) * 2u;
#define ATT_GLOAD(t) do { const char* kt_ = (const char*)Kp + (size_t)(t) * (64 * DIN * 2); const char* vt_ = (const char*)Vp + (size_t)(t) * (64 * DIN * 2); \
        kreg = *(const u32x4*)(kt_ + koff); vreg[0] = *(const u32x4*)(vt_ + voff); vreg[1] = *(const u32x4*)(vt_ + 32 * DIN * 2 + voff); } while (0)
#define ATT_LSTORE(b) do { *(LAS u32x4*)(lds + ATT_K_OFF + (b) * 64 * KSTR + krow * KSTR + kch * 16) = kreg; \
        _Pragma("unroll") for (int i_ = 0; i_ < VLD; ++i_) { const int idx_ = tid + NTHREADS * i_; *(LAS u32x4*)(lds + ATT_V_OFF + (b) * 64 * VSTR + (idx_ / VCH) * VSTR + (idx_ % VCH) * 16) = vreg[i_]; } } while (0)
        int first = 1; asm volatile("" : "+s"(first));
        int R = c0, Lc = c0 - 1;
        int t = R++;
        ATT_GLOAD(t); ATT_LSTORE(0); __syncthreads();
        for (int i = 0; i < NT; ++i) {
            const int buf = i & 1;
            int tn = 0;
            if (i + 1 < NT) { const bool takeR = (Lc < 0) || (R < NT && ((i + 1) < 4 || ((i + 1) & 1))); tn = takeR ? R++ : Lc--; ATT_GLOAD(tn); }
            f32x16 p0, p1;
            const int kb = 64 * t;
            float slope2 = slope2_, qposf = qposf_; asm volatile("" : "+v"(slope2), "+v"(qposf));
            if (kb + 63 < qw || kb > qw + 31) {
                const float sg = (kb > qw) ? -slope2 : slope2;
                const float b0 = sg * ((float)(kb + 4 * hi) - qposf) - mref, b1 = b0 + 32.f * sg;
#pragma unroll
                for (int r = 0; r < 16; ++r) { const float kv = (float)((r & 3) + 8 * (r >> 2)); p0[r] = __builtin_fmaf(sg, kv, b0); p1[r] = __builtin_fmaf(sg, kv, b1); }
            } else {
                const float dq = (float)(kb + 4 * hi) - qposf;
#pragma unroll
                for (int r = 0; r < 16; ++r) { const float t0 = dq + (float)((r & 3) + 8 * (r >> 2)); p0[r] = __builtin_fmaf(-slope2, __builtin_fabsf(t0), -mref); p1[r] = __builtin_fmaf(-slope2, __builtin_fabsf(t0 + 32.f), -mref); }
            }
            const LAS unsigned char* Kb = lds + ATT_K_OFF + buf * 64 * KSTR + r32 * KSTR + hi * 16;
            bf16x8 kf[8];
#pragma unroll
            for (int d0 = 0; d0 < 4; ++d0) { kf[2 * d0] = *(const LAS bf16x8*)(Kb + d0 * 32); kf[2 * d0 + 1] = *(const LAS bf16x8*)(Kb + 32 * KSTR + d0 * 32); }
            __builtin_amdgcn_sched_barrier(0);
#pragma unroll
            for (int d0 = 0; d0 < 4; ++d0) {
                p0 = __builtin_amdgcn_mfma_f32_32x32x16_bf16(kf[2 * d0], qr[d0], p0, 0, 0, 0);
                p1 = __builtin_amdgcn_mfma_f32_32x32x16_bf16(kf[2 * d0 + 1], qr[d0], p1, 0, 0, 0);
            }
            const LAS unsigned char* Vb = lds + ATT_V_OFF + buf * 64 * VSTR + (4 * hi + ((lane & 15) >> 2)) * VSTR + (16 * ((lane >> 4) & 1) + 4 * (lane & 3)) * 2;
            s16x4 va[ND][2], vb2[ND][2];
#pragma unroll
            for (int d = 0; d < ND; ++d) { va[d][0] = vtr(Vb + d * 64); va[d][1] = vtr(Vb + 8 * VSTR + d * 64); }
            __builtin_amdgcn_sched_barrier(0);
            float rm = max3f(p0[0], p1[0], p0[1]);
#pragma unroll
            for (int r = 1; r < 15; ++r) rm = max3f(rm, p1[r], p0[r + 1]);
            rm = max3f(rm, p1[15], rm);
            rm = max3f(rm, __shfl_xor(rm, 32), rm);
            if (first || __any(rm > B_THR)) {
                const float delta = (first || rm > B_THR) ? rm : 0.f; const float f = __builtin_amdgcn_exp2f(-delta); mref += delta; l *= f;
#pragma unroll
                for (int r = 0; r < 16; ++r) { p0[r] -= delta; p1[r] -= delta; }
                {
                    if (hi == 0) wsf[r32] = f;
#pragma unroll
                    for (int r = 0; r < 16; ++r) { const float fr = wsf[crow(r, hi)];
#pragma unroll
                        for (int d = 0; d < ND; ++d) o[d][r] *= fr; }
                }
            }
            float ls0 = 0.f, ls1 = 0.f;
#pragma unroll
            for (int r = 0; r < 16; ++r) { p0[r] = __builtin_amdgcn_exp2f(p0[r]); p1[r] = __builtin_amdgcn_exp2f(p1[r]); ls0 += p0[r]; ls1 += p1[r]; }
            l += ls0 + ls1;
            u32x4 pw[4];
#pragma unroll
            for (int c = 0; c < 4; ++c) {
                const f32x16& P = (c >> 1) ? p1 : p0; const int b = 8 * (c & 1);
                pw[c].x = cvt_pk(P[b + 0], P[b + 1]); pw[c].y = cvt_pk(P[b + 2], P[b + 3]); pw[c].z = cvt_pk(P[b + 4], P[b + 5]); pw[c].w = cvt_pk(P[b + 6], P[b + 7]);
            }
            __builtin_amdgcn_sched_barrier(0);
#define VFRAG(x, d) (bf16x8){x[d][0][0], x[d][0][1], x[d][0][2], x[d][0][3], x[d][1][0], x[d][1][1], x[d][1][2], x[d][1][3]}
#pragma unroll
            for (int d = 0; d < ND; ++d) { vb2[d][0] = vtr(Vb + 16 * VSTR + d * 64); vb2[d][1] = vtr(Vb + 16 * VSTR + 8 * VSTR + d * 64); }
            __builtin_amdgcn_sched_barrier(0);
#pragma unroll
            for (int d = 0; d < ND; ++d) o[d] = __builtin_amdgcn_mfma_f32_32x32x16_bf16(__builtin_bit_cast(bf16x8, pw[0]), VFRAG(va, d), o[d], 0, 0, 0);
            __builtin_amdgcn_sched_barrier(0);
#pragma unroll
            for (int d = 0; d < ND; ++d) { va[d][0] = vtr(Vb + 32 * VSTR + d * 64); va[d][1] = vtr(Vb + 32 * VSTR + 8 * VSTR + d * 64); }
            __builtin_amdgcn_sched_barrier(0);
#pragma unroll
            for (int d = 0; d < ND; ++d) o[d] = __builtin_amdgcn_mfma_f32_32x32x16_bf16(__builtin_bit_cast(bf16x8, pw[1]), VFRAG(vb2, d), o[d], 0, 0, 0);
            __builtin_amdgcn_sched_barrier(0);
#pragma unroll
            for (int d = 0; d < ND; ++d) { vb2[d][0] = vtr(Vb + 48 * VSTR + d * 64); vb2[d][1] = vtr(Vb + 48 * VSTR + 8 * VSTR + d * 64); }
            __builtin_amdgcn_sched_barrier(0);
#pragma unroll
            for (int d = 0; d < ND; ++d) o[d] = __builtin_amdgcn_mfma_f32_32x32x16_bf16(__builtin_bit_cast(bf16x8, pw[2]), VFRAG(va, d), o[d], 0, 0, 0);
#pragma unroll
            for (int d = 0; d < ND; ++d) o[d] = __builtin_amdgcn_mfma_f32_32x32x16_bf16(__builtin_bit_cast(bf16x8, pw[3]), VFRAG(vb2, d), o[d], 0, 0, 0);
#undef VFRAG
            __builtin_amdgcn_sched_barrier(0);
            first = 0;
            if (i + 1 < NT) ATT_LSTORE(buf ^ 1);
            t = tn;
            __syncthreads();
        }
#undef ATT_GLOAD
#undef ATT_LSTORE
        l += __shfl_xor(l, 32);
        if (hi == 0) wsf[r32] = 1.f / l;
        int lane_e = lane, qw_e = qw; asm volatile("" : "+v"(lane_e)); asm volatile("" : "+s"(qw_e));
        const int r32 = lane_e & 31, hi = lane_e >> 5, qw = qw_e;
        LAS unsigned* o0buf = (LAS unsigned*)(lds + ATT_O0_OFF) + wid * 2048 + lane_e;
        if (mp == 0) {
#pragma unroll
            for (int d = 0; d < ND; ++d)
#pragma unroll
                for (int r = 0; r < 16; r += 2) { const float i0 = wsf[crow(r, hi)], i1 = wsf[crow(r + 1, hi)]; o0buf[(d * 8 + (r >> 1)) * 64] = cvt_pk(o[d][r] * i0, o[d][r + 1] * i1); }
        } else {
            float gs[ND];
#pragma unroll
            for (int d = 0; d < ND; ++d) gs[d] = subln_l[d * 32 + r32] * postscale;
#pragma unroll
            for (int r = 0; r < 16; r += 2) {
                const float i0 = wsf[crow(r, hi)], i1 = wsf[crow(r + 1, hi)];
                float v0[ND], v1[ND]; float s0 = 0.f, s1 = 0.f;
#pragma unroll
                for (int d = 0; d < ND; ++d) { const unsigned w = o0buf[(d * 8 + (r >> 1)) * 64];
                    v0[d] = __builtin_bit_cast(float, w << 16) - lam * (o[d][r] * i0); v1[d] = __builtin_bit_cast(float, w & 0xffff0000u) - lam * (o[d][r + 1] * i1);
                    s0 += v0[d] * v0[d]; s1 += v1[d] * v1[d]; }
#pragma unroll
                for (int sh = 1; sh < 32; sh <<= 1) { s0 += __shfl_xor(s0, sh); s1 += __shfl_xor(s1, sh); }
                const float r0 = 1.f / sqrtf(s0 * (1.f / 128.f) + 1e-5f), r1 = 1.f / sqrtf(s1 * (1.f / 128.f) + 1e-5f);
                bf16_t* row0 = mix + (size_t)(qw + crow(r, hi)) * DM + r32; bf16_t* row1 = mix + (size_t)(qw + crow(r + 1, hi)) * DM + r32;
#pragma unroll
                for (int d = 0; d < ND; ++d) { row0[d * 32] = (bf16_t)f2bf(v0[d] * r0 * gs[d]); row1[d * 32] = (bf16_t)f2bf(v1[d] * r1 * gs[d]); }
            }
        }
        __syncthreads();
    }
}
__device__ __forceinline__ float alibi_slope(int i, int n) { return exp2f(-8.0f * (float)(i + 1) / (float)n); }
struct Ctx { int tid, lane, wave, G, cu, gw, NGW; };

__device__ __forceinline__ void ph_weights(const Args& a, const Ctx& c, LAS unsigned char* lds) {
    unsigned char* ws = a.ws;
    bf16_t* WinT = (bf16_t*)(ws + WS_WIN); bf16_t* WoutT = (bf16_t*)(ws + WS_WOUT); bf16_t* WupT = (bf16_t*)(ws + WS_WUP); bf16_t* WdnT = (bf16_t*)(ws + WS_WDN);
    const float* w_in = a.in[3]; const float* w_out = a.in[10]; const float* w_up = a.in[12]; const float* w_down = a.in[15];
    LAS float* scr = (LAS float*)(lds + c.wave * 16384);
    constexpr int I_IN = (DM / 64) * (DIN / 32), I_OUT = (DM / 64) * (DM / 32), I_UP = (DM / 64) * (DUP / 32), I_DN = (DFF / 64) * (DM / 32);
    constexpr int PER_L = I_IN + I_OUT + I_UP + I_DN;
    for (int it = c.gw; it < DEPTH * PER_L; it += c.NGW) {
        const int l = it / PER_L; int r = it % PER_L;
        if (r < I_IN) { transpose_item(w_in + (size_t)l * DM * DIN, DM, DIN, WinT + (size_t)l * DIN * DM, scr, r, c.lane, a.in[2] + l * DM); continue; } r -= I_IN;
        if (r < I_OUT) { transpose_item(w_out + (size_t)l * DM * DM, DM, DM, WoutT + (size_t)l * DM * DM, scr, r, c.lane, nullptr); continue; } r -= I_OUT;
        if (r < I_UP) { transpose_item(w_up + (size_t)l * DM * DUP, DM, DUP, WupT + (size_t)l * DUP * DM, scr, r, c.lane, a.in[11] + l * DM); continue; } r -= I_UP;
        transpose_item(w_down + (size_t)l * DFF * DM, DFF, DM, WdnT + (size_t)l * DM * DFF, scr, r, c.lane, nullptr);
    }
}
__device__ __forceinline__ const float* chunk_in(const Args& a, int ch) { return ch == 0 ? a.in[0] : a.in[1] + (size_t)(ch - 1) * CH_ROWS * DM; }
__device__ __forceinline__ float* chunk_out(const Args& a, int ch) { return a.out + (size_t)ch * CH_ROWS * DM; }

__device__ __forceinline__ void ph_norm_bf16(const Ctx& c, const float* xsrc, const float* gain, bf16_t* HB) {
    for (int r = c.gw; r < CH_ROWS; r += c.NGW) rms_row_to_bf16(xsrc + (size_t)r * DM, gain, HB + (size_t)r * DM, c.lane);
}
__device__ __forceinline__ void ph_final_norm(const Ctx& c, float* xo, const float* gain) {
    for (int r = c.gw; r < CH_ROWS; r += c.NGW) rms_row_f32(xo + (size_t)r * DM, gain, c.lane);
}

__device__ __forceinline__ void ph_attn(const Args& a, const Ctx& c, LAS unsigned char* lds, int ch, int layer) {
    const bf16_t* PROJ = (const bf16_t*)(a.ws + WS_PROJ); float* TMP = (float*)(a.ws + WS_TMP);
    const int SL = ch == 0 ? 16384 : 4096, sl_shift = ch == 0 ? 14 : 12;
    const int cu = c.cu, G = c.G;
#ifndef SKIP_B
    {
        const float lam_init = layer == 0 ? 0.2f : (0.8f - 0.6f * 0.7408182206817179f);
        const float s1 = wave_sum(a.in[5][layer * 64 + c.lane] * a.in[6][layer * 64 + c.lane]);
        const float s2 = wave_sum(a.in[7][layer * 64 + c.lane] * a.in[8][layer * 64 + c.lane]);
        const float lam = expf(s1) - expf(s2) + lam_init;
        bf16_t* HBm = (bf16_t*)(a.ws + WS_HB);
#ifdef PROBE_B2
        for (int rep_ = 0; rep_ < 2; ++rep_)
#endif
        for (int u = cu; u < 256; u += G) {
            int seq, h, qb;
            if (ch == 0) { seq = 0; h = u >> 6; qb = u & 63; }
            else { seq = u >> 6; h = (u >> 4) & 3; qb = u & 15; }
            const size_t rb = (size_t)seq * SL;
            attn_b_unit(lds, PROJ + rb * DIN, h, qb * 256, SL, alibi_slope(h, 4) * LOG2E, lam, a.in[9] + layer * 128, 1.f - lam_init, HBm + rb * DM + 256 + h * 128);
        }
    }
#endif
#ifndef SKIP_AC
#ifdef PROBE_AC2
    for (int rep_ = 0; rep_ < 2; ++rep_)
#endif
    for (int uu = cu; uu < 1024; uu += G) {
        const bf16_t *qp, *kp, *vp; size_t pitch, opitch, lpitch; int q0, L, W; float slope2, m_init, l_init; float *op, *lp; bf16_t* obf;
        if (uu < 256) {
            const int hq = uu >> 6, blk = uu & 63;
            const int seq = (blk * 256) >> sl_shift, qb = blk - ((seq << sl_shift) >> 8);
            const size_t rb = (size_t)seq * SL; const bf16_t* base = PROJ + rb * DIN;
            qp = base + hq * 64; kp = base + 256 + (hq >> 1) * 64; vp = base + 384 + (hq >> 1) * 64; pitch = DIN; q0 = qb * 256; L = SL;
            slope2 = alibi_slope(hq, 4) * LOG2E; W = 128; m_init = a.in[4][layer * 4 + hq] * LOG2E; l_init = 1.f;
            op = nullptr; obf = (bf16_t*)(a.ws + WS_HB) + rb * DM + hq * 64; opitch = DM; lp = nullptr; lpitch = 0;
        } else {
            const int uc = uu - 256;
            const int gh = uc >> 6, blk = uc & 63, gq = gh >> 2;
            const int dsh = 2 * gq, d = 1 << dsh;
            const int seq = (blk * 256) >> sl_shift, b2 = blk - ((seq << sl_shift) >> 8);
            const int nbr = (SL >> dsh) >> 8;
            const int res = b2 / nbr, qb = b2 % nbr;
            const size_t rb = (size_t)seq * SL + res; const bf16_t* base = PROJ + rb * DIN;
            qp = base + 2048 + gh * 64; kp = base + 2816 + gh * 64; vp = base + 3584 + gh * 64; pitch = (size_t)DIN * d; q0 = qb * 256; L = SL >> dsh;
            slope2 = alibi_slope(gh, 12) * (float)d * LOG2E; W = 64; m_init = -1e30f; l_init = 0.f;
            op = TMP + rb * TW + T_C + gh * 64; obf = nullptr; opitch = (size_t)TW * d; lp = TMP + rb * TW + T_L + gh; lpitch = (size_t)TW * d;
        }
        attn_unit<64, true>(lds, qp, kp, vp, pitch, q0, L, slope2, W, m_init, l_init, op, opitch, lp, lpitch, obf);
    }
#endif
}

__device__ __forceinline__ void ph_combine(const Args& a, const Ctx& c, int layer) {
    const float* TMP = (const float*)(a.ws + WS_TMP); bf16_t* HB = (bf16_t*)(a.ws + WS_HB);
    const int lane = c.lane;
    { float* S2 = (float*)(a.ws + WS_SSQ) + CH_ROWS; for (int r = c.cu * NTHREADS + c.tid; r < CH_ROWS; r += c.G * NTHREADS) S2[r] = 0.f; }
    for (int r = c.gw; r < CH_ROWS; r += c.NGW) {
        const float* tr = TMP + (size_t)r * TW; bf16_t* mr = HB + (size_t)r * DM;
#pragma unroll
        for (int h = 0; h < 4; ++h) {
            const float l0 = tr[T_L + h], l1 = tr[T_L + 4 + h], l2 = tr[T_L + 8 + h];
            const float mx = fmaxf(l0, fmaxf(l1, l2));
            const float w0 = expf(l0 - mx), w1 = expf(l1 - mx), w2 = expf(l2 - mx);
            const float inv = 1.f / (w0 + w1 + w2);
            const float o = (w0 * tr[T_C + h * 64 + lane] + w1 * tr[T_C + (4 + h) * 64 + lane] + w2 * tr[T_C + (8 + h) * 64 + lane]) * inv;
            mr[768 + h * 64 + lane] = (bf16_t)f2bf(o);
        }
    }
}

__device__ __forceinline__ void ph_conv(const Args& a, const Ctx& c, int ch, int layer) {
    const bf16_t* UB = (const bf16_t*)(a.ws + WS_PROJ); bf16_t* GB = (bf16_t*)(a.ws + WS_TMP);
    const int SL = ch == 0 ? 16384 : 4096;
    const float* cw = a.in[13] + (size_t)layer * 3 * DUP; const float* cb = a.in[14] + (size_t)layer * DUP;
    constexpr int NCP = DFF / 2, RB = 16;
    const int nitems = (CH_ROWS / RB) * NCP;
    { float* S1 = (float*)(a.ws + WS_SSQ); for (int r = c.cu * NTHREADS + c.tid; r < CH_ROWS; r += c.G * NTHREADS) S1[r] = 0.f; }
    for (int it = c.cu * NTHREADS + c.tid; it < nitems; it += c.G * NTHREADS) {
        const int cp = it % NCP, rb = it / NCP, c0 = cp * 2, r0 = rb * RB;
        float wg[3][2], wv[3][2], bg[2], bv[2];
#pragma unroll
        for (int k = 0; k < 3; ++k)
#pragma unroll
            for (int j = 0; j < 2; ++j) { wg[k][j] = cw[k * DUP + c0 + j]; wv[k][j] = cw[k * DUP + DFF + c0 + j]; }
#pragma unroll
        for (int j = 0; j < 2; ++j) { bg[j] = cb[c0 + j]; bv[j] = cb[DFF + c0 + j]; }
        const bool first = (r0 & (SL - 1)) == 0, last = ((r0 + RB) & (SL - 1)) == 0;
        unsigned pg_, pv_, cg_, cv_, ng_, nv_;
        pg_ = first ? 0u : *(const unsigned*)(UB + (size_t)(r0 - 1) * DUP + c0); pv_ = first ? 0u : *(const unsigned*)(UB + (size_t)(r0 - 1) * DUP + DFF + c0);
        cg_ = *(const unsigned*)(UB + (size_t)r0 * DUP + c0); cv_ = *(const unsigned*)(UB + (size_t)r0 * DUP + DFF + c0);
        for (int rr = 0; rr < RB; ++rr) {
            const int r = r0 + rr; const bool nz = (rr == RB - 1) && last;
            ng_ = nz ? 0u : *(const unsigned*)(UB + (size_t)(r + 1) * DUP + c0); nv_ = nz ? 0u : *(const unsigned*)(UB + (size_t)(r + 1) * DUP + DFF + c0);
            float res[2];
#pragma unroll
            for (int j = 0; j < 2; ++j) {
                const int sh = j * 16;
                const float gp = bf2f((unsigned short)(pg_ >> sh)), gc = bf2f((unsigned short)(cg_ >> sh)), gn = bf2f((unsigned short)(ng_ >> sh));
                const float vp = bf2f((unsigned short)(pv_ >> sh)), vc = bf2f((unsigned short)(cv_ >> sh)), vn = bf2f((unsigned short)(nv_ >> sh));
                const float gate = gp * wg[0][j] + gc * wg[1][j] + gn * wg[2][j] + bg[j];
                const float val = vp * wv[0][j] + vc * wv[1][j] + vn * wv[2][j] + bv[j];
                res[j] = gate / (1.f + __expf(-gate)) * val;
            }
            *(unsigned*)(GB + (size_t)r * DFF + c0) = pk2(res[0], res[1]);
            pg_ = cg_; pv_ = cv_; cg_ = ng_; cv_ = nv_;
        }
    }
}

constexpr int STEPS_PER_CHUNK = 1 + DEPTH * 7;
constexpr int NSTEPS = 1 + NCHUNK * STEPS_PER_CHUNK + 1;
__global__ void __launch_bounds__(NTHREADS, 2) mega_fwd(Args a) {
    extern __shared__ __attribute__((aligned(16))) unsigned char lds_raw[];
    LAS unsigned char* lds = (LAS unsigned char*)lds_raw;
    cg::grid_group grid = cg::this_grid();
    volatile LAS unsigned* bst = (volatile LAS unsigned*)(lds + 131072 + 320);
    if (threadIdx.x < 2) bst[threadIdx.x] = 0u;
    __syncthreads();
    XcdBarrier xbar = xcd_barrier_post((unsigned*)(a.ws + WS_CTL), bst);
#ifdef PROBE_TA
    unsigned long long tA_ = 0, tB_ = 0, tprev_ = __builtin_amdgcn_s_memrealtime();
#endif
    for (int step = 0; step < NSTEPS; ++step) {
        int tid_l = threadIdx.x, cu_l = blockIdx.x, G_l = gridDim.x;
        asm volatile("" : "+v"(tid_l)); asm volatile("" : "+s"(cu_l), "+s"(G_l));
        Ctx c; c.tid = tid_l; c.lane = c.tid & 63; c.wave = __builtin_amdgcn_readfirstlane(c.tid >> 6);
        c.G = G_l; c.cu = cu_l; c.gw = c.cu * 8 + c.wave; c.NGW = c.G * 8;
        if (step == 0) ph_weights(a, c, lds);
        else if (step == NSTEPS - 1) ph_final_norm(c, chunk_out(a, NCHUNK - 1), a.in[16]);
        else {
            const int s = step - 1, ch = s / STEPS_PER_CHUNK, sc = s % STEPS_PER_CHUNK;
            unsigned char* ws = a.ws;
            bf16_t* HB = (bf16_t*)(ws + WS_HB); bf16_t* XB = (bf16_t*)(ws + WS_XB);
            float* S1 = (float*)(ws + WS_SSQ); float* S2 = S1 + CH_ROWS;
            float* xo = chunk_out(a, ch);
            if (sc == 0) {
                if (ch > 0) ph_final_norm(c, chunk_out(a, ch - 1), a.in[16]);
                const float* xin = chunk_in(a, ch);
                for (int r = c.gw; r < CH_ROWS; r += c.NGW) row_to_bf16_ssq(xin + (size_t)r * DM, XB + (size_t)r * DM, S1 + r, c.lane);
            } else {
                const int layer = (sc - 1) / 7, ph = (sc - 1) % 7;
                const float* xsrc = layer == 0 ? chunk_in(a, ch) : (const float*)xo;
                if (ph == 0) {
                    pg8::Gemm g{XB, (const bf16_t*)(ws + WS_WIN) + (size_t)layer * DIN * DM, CH_ROWS, DIN, DM}; pg8::StaticOrder S; S.init(CH_ROWS, DIN, c.G, c.cu);
                    pg8::EpiBf16S2 E{(bf16_t*)(ws + WS_PROJ), DIN, 1805u, QSCALE, S1};
#ifdef PROBE_G2
                    for (int rep_ = 0; rep_ < 2; ++rep_)
#endif
                    pg8::gemm_phase<pg8::EpiBf16S2, pg8::StaticOrder, true, true>(lds, g, S, E);
                } else if (ph == 1) {
                    ph_attn(a, c, lds, ch, layer);
                } else if (ph == 2) {
                    ph_combine(a, c, layer);
                } else if (ph == 3) {
                    pg8::Gemm g{HB, (const bf16_t*)(ws + WS_WOUT) + (size_t)layer * DM * DM, CH_ROWS, DM, DM}; pg8::StaticOrder S; S.init(CH_ROWS, DM, c.G, c.cu);
                    pg8::EpiRes2 E{xsrc, xo, XB, S2, DM};
                    pg8::gemm_phase<pg8::EpiRes2, pg8::StaticOrder, true, true>(lds, g, S, E);
                } else if (ph == 4) {
                    pg8::Gemm g{XB, (const bf16_t*)(ws + WS_WUP) + (size_t)layer * DUP * DM, CH_ROWS, DUP, DM}; pg8::StaticOrder S; S.init(CH_ROWS, DUP, c.G, c.cu);
                    pg8::EpiBf16S2 E{(bf16_t*)(ws + WS_PROJ), DUP, 0u, 1.f, S2};
#ifdef PROBE_G2
                    for (int rep_ = 0; rep_ < 2; ++rep_)
#endif
                    pg8::gemm_phase<pg8::EpiBf16S2, pg8::StaticOrder, true, true>(lds, g, S, E);
                } else if (ph == 5) {
                    ph_conv(a, c, ch, layer);
                } else {
                    pg8::Gemm g{(const bf16_t*)(ws + WS_TMP), (const bf16_t*)(ws + WS_WDN) + (size_t)layer * DM * DFF, CH_ROWS, DM, DFF}; pg8::StaticOrder S; S.init(CH_ROWS, DM, c.G, c.cu);
                    pg8::EpiRes2 E{xo, xo, XB, S1, DM};
                    pg8::gemm_phase<pg8::EpiRes2, pg8::StaticOrder, true, true>(lds, g, S, E);
                }
            }
        }
#ifdef PROBE_TA
        const unsigned long long tmid_ = __builtin_amdgcn_s_memrealtime();
#endif
        if (step == 0) grid.sync(); else if (step != NSTEPS - 1) xcd_barrier(xbar);
#ifdef PROBE_TA
        {
            const unsigned long long tnow_ = __builtin_amdgcn_s_memrealtime();
            int cls_;
            if (step == 0) cls_ = 0; else if (step == NSTEPS - 1) cls_ = 1;
            else { const int sc_ = (step - 1) % STEPS_PER_CHUNK; if (sc_ == 0) cls_ = 1; else { const int ph_ = (sc_ - 1) % 7; cls_ = ph_ == 0 || ph_ == 4 ? 2 : ph_ == 1 ? 3 : ph_ == 2 ? 4 : ph_ == 5 ? 6 : 5; } }
            if (cls_ == PROBE_TA) tA_ += tnow_ - tprev_; if (PROBE_TA == 7) tA_ += tnow_ - tmid_;
            if (cls_ == PROBE_TB) tB_ += tnow_ - tprev_; if (PROBE_TB == 7) tB_ += tnow_ - tmid_;
            tprev_ = tnow_;
        }
#endif
    }
#ifdef PROBE_TA
    if (blockIdx.x == 0 && threadIdx.x < 64) {
        float* xo = chunk_out(a, NCHUNK - 1);
        const float ua = (float)tA_ * 0.01f, ub = (float)tB_ * 0.01f;
        if (threadIdx.x == 0) xo[0] += 8.f + ua * 0.01f; else xo[4 * threadIdx.x] += sqrtf(ub * 0.01f);
    }
#endif
}

extern "C" void kernel_launch(void* const* d_in, const int* in_sizes, int n_in, void* d_out, int out_size, void* d_ws, size_t ws_size, hipStream_t stream) {
    static int grid = 0;
    if (grid == 0) {
        if (n_in != 17 || ws_size < WS_END) { fprintf(stderr, "kernel_launch: unexpected n_in %d / ws_size %zu (need %zu)\n", n_in, ws_size, (size_t)WS_END); grid = -1; return; }
        int dev = 0, cus = 0, per_cu = 0;
        (void)hipGetDevice(&dev); (void)hipDeviceGetAttribute(&cus, hipDeviceAttributeMultiprocessorCount, dev);
        if (hipFuncSetAttribute((const void*)mega_fwd, hipFuncAttributeMaxDynamicSharedMemorySize, LDS_BYTES) != hipSuccess) { fprintf(stderr, "hipFuncSetAttribute failed\n"); grid = -1; return; }
        if (hipOccupancyMaxActiveBlocksPerMultiprocessor(&per_cu, (const void*)mega_fwd, NTHREADS, LDS_BYTES) != hipSuccess || per_cu < 1) { fprintf(stderr, "occupancy query: %d\n", per_cu); per_cu = 1; }
        (void)hipGetLastError();
        grid = cus * 1;
    }
    if (grid < 0) return;
    (void)hipMemsetAsync((char*)d_ws + WS_CTL, 0, 65536, stream);
    Args a{};
    for (int i = 0; i < 17; ++i) a.in[i] = (const float*)d_in[i];
    a.out = (float*)d_out; a.ws = (unsigned char*)d_ws;
    void* args[] = {&a};
    hipError_t e = hipLaunchCooperativeKernel((const void*)mega_fwd, dim3(grid), dim3(NTHREADS), args, LDS_BYTES, stream);
    if (e != hipSuccess) fprintf(stderr, "cooperative launch failed: %s (grid %d)\n", hipGetErrorString(e), grid);
}
```

```cpp
#include <hip/hip_runtime.h>
#include <hip/hip_cooperative_groups.h>
#include <cstdio>
#include <cstdint>
#include <cmath>
namespace cg = cooperative_groups;
namespace pg8 {
#define PG8_LAS __attribute__((address_space(3)))
typedef unsigned short bf16_t;
typedef short bf16x8 __attribute__((ext_vector_type(8)));
typedef float f32x4 __attribute__((ext_vector_type(4)));
typedef unsigned u32x4 __attribute__((ext_vector_type(4)));
constexpr int BM = 256, BK = 64, HALF = 128, HTB = HALF * BK * 2  , STAGE_BYTES = 8 * HTB, NXCD = 8, WGM = 8;

__host__ __device__ __forceinline__ int lds_byte(int r, int c) { const int st = (r >> 4) * 2 + (c >> 5), rr = r & 15, cc = c & 31, ob = rr * 64 + cc * 2; return st * 1024 + (ob ^ (((ob >> 9) & 1) << 5)); }
__host__ __device__ __forceinline__ void stage_rc(int b, int& R, int& C) { const int st = b / 1024, sb = b % 1024, swz = sb ^ (((sb >> 9) & 1) << 5); R = (st >> 1) * 16 + swz / 64; C = (st & 1) * 32 + (swz % 64) / 2; }
__host__ __device__ __forceinline__ int perm32(int rho) { const int n = rho >> 4, i = rho & 15; return 8 * (i >> 2) + 4 * n + (i & 3); }

struct Unit { int pm, pn; };
struct Gemm { const bf16_t* A; const bf16_t* Bt; int M, N, K; };

struct StaticOrder {
    int nM, nN, nwg, G, c;
    __host__ __device__ void init(int M, int N, int G_, int c_) { nM = M / BM; nN = N / BM; nwg = nM * nN; G = G_; c = c_; }
    __host__ __device__ bool next(int i, Unit& u) const {
        const long L = (long)i * G + c; if (L >= nwg) return false;
        int wgid = (int)L; { const int q = nwg / NXCD, r = nwg % NXCD, xcd = wgid % NXCD, off = wgid / NXCD; wgid = (xcd < r ? xcd * (q + 1) : r * (q + 1) + (xcd - r) * q) + off; }
        const int nig = WGM * nN, gid = wgid / nig, fm = gid * WGM, gsz = (nM - fm) < WGM ? (nM - fm) : WGM;
        u.pm = fm + ((wgid % nig) % gsz); u.pn = (wgid % nig) / gsz; return true;
    }
    __device__ __forceinline__ void a_ready(const Unit&) const {}
    __device__ __forceinline__ void done(const Unit&) const {}
};

__device__ __forceinline__ unsigned cvt_pk_bf16(float lo, float hi) { unsigned r; asm volatile("v_cvt_pk_bf16_f32 %0, %1, %2" : "=v"(r) : "v"(lo), "v"(hi)); return r; }
struct EpiBf16S {
    static constexpr bool PERM = true, AFTER_DRAIN = false;
    bf16_t* O; int ldc; unsigned scalemask; float sc;
    __device__ __forceinline__ void operator()(const f32x4 (&acc)[2][2][4][2], const Unit& u, int wr, int wc, int fr, int fq) const {
        const int row0 = u.pm * BM + wr * 64 + fr; const int col0 = u.pn * BM + wc * 32 + 8 * fq;
        const float s = ((scalemask >> u.pn) & 1u) ? sc : 1.f;
#pragma unroll
        for (int ai = 0; ai < 2; ++ai)
#pragma unroll
            for (int m = 0; m < 4; ++m) { bf16_t* rowp = O + (size_t)(row0 + ai * HALF + m * 16) * ldc + col0;
#pragma unroll
                for (int bj = 0; bj < 2; ++bj) { f32x4 v0 = acc[ai][bj][m][0] * s, v1 = acc[ai][bj][m][1] * s;
                    u32x4 w; w.x = cvt_pk_bf16(v0[0], v0[1]); w.y = cvt_pk_bf16(v0[2], v0[3]); w.z = cvt_pk_bf16(v1[0], v1[1]); w.w = cvt_pk_bf16(v1[2], v1[3]);
                    *(u32x4*)(rowp + bj * HALF) = w; } }
    }
};
struct EpiRes {
    static constexpr bool PERM = false, AFTER_DRAIN = false;
    const float* base; float* out; int ldc;
    __device__ __forceinline__ void operator()(const f32x4 (&acc)[2][2][4][2], const Unit& u, int wr, int wc, int fr, int fq) const {
        const int col0 = u.pn * BM + wc * 32 + 4 * fq;
#pragma unroll
        for (int ai = 0; ai < 2; ++ai)
#pragma unroll
            for (int m = 0; m < 4; ++m) { const size_t off = (size_t)(u.pm * BM + ai * HALF + wr * 64 + m * 16 + fr) * ldc + col0;
#pragma unroll
                for (int bj = 0; bj < 2; ++bj)
#pragma unroll
                    for (int n = 0; n < 2; ++n) { const f32x4 bs = *(const f32x4*)(base + off + bj * HALF + n * 16); *(f32x4*)(out + off + bj * HALF + n * 16) = bs + acc[ai][bj][m][n]; }
                asm volatile("" ::: "memory"); }
    }
};

struct EpiBf16S2 {
    static constexpr bool PERM = true, AFTER_DRAIN = false;
    bf16_t* O; int ldc; unsigned scalemask; float sc; const float* ssq;
    __device__ __forceinline__ void operator()(const f32x4 (&acc)[2][2][4][2], const Unit& u, int wr, int wc, int fr, int fq) const {
        const int row0 = u.pm * BM + wr * 64 + fr; const int col0 = u.pn * BM + wc * 32 + 8 * fq;
        const float s = ((scalemask >> u.pn) & 1u) ? sc : 1.f;
#pragma unroll
        for (int ai = 0; ai < 2; ++ai)
#pragma unroll
            for (int m = 0; m < 4; ++m) { const int row = row0 + ai * HALF + m * 16; bf16_t* rowp = O + (size_t)row * ldc + col0;
                const float rs = s / sqrtf(ssq[row] * (1.f / 1024.f) + 1e-6f);
#pragma unroll
                for (int bj = 0; bj < 2; ++bj) { f32x4 v0 = acc[ai][bj][m][0] * rs, v1 = acc[ai][bj][m][1] * rs;
                    u32x4 w; w.x = cvt_pk_bf16(v0[0], v0[1]); w.y = cvt_pk_bf16(v0[2], v0[3]); w.z = cvt_pk_bf16(v1[0], v1[1]); w.w = cvt_pk_bf16(v1[2], v1[3]);
                    *(u32x4*)(rowp + bj * HALF) = w; } }
    }
};
typedef unsigned u32x2e __attribute__((ext_vector_type(2)));
struct EpiRes2 {
    static constexpr bool PERM = false, AFTER_DRAIN = false;
    const float* base; float* out; bf16_t* xb; float* ssq; int ldc;
    __device__ __forceinline__ void operator()(const f32x4 (&acc)[2][2][4][2], const Unit& u, int wr, int wc, int fr, int fq) const {
        const int col0 = u.pn * BM + wc * 32 + 4 * fq;
#pragma unroll
        for (int ai = 0; ai < 2; ++ai)
#pragma unroll
            for (int m = 0; m < 4; ++m) { const int row = u.pm * BM + ai * HALF + wr * 64 + m * 16 + fr; const size_t off = (size_t)row * ldc + col0; float ps = 0.f;
#pragma unroll
                for (int bj = 0; bj < 2; ++bj)
#pragma unroll
                    for (int n = 0; n < 2; ++n) { const f32x4 bs = *(const f32x4*)(base + off + bj * HALF + n * 16); const f32x4 v = bs + acc[ai][bj][m][n];
                        *(f32x4*)(out + off + bj * HALF + n * 16) = v; ps += (v[0] * v[0] + v[1] * v[1]) + (v[2] * v[2] + v[3] * v[3]);
                        u32x2e w; w.x = cvt_pk_bf16(v[0], v[1]); w.y = cvt_pk_bf16(v[2], v[3]); *(u32x2e*)(xb + off + bj * HALF + n * 16) = w; }
                ps += __shfl_xor(ps, 16); ps += __shfl_xor(ps, 32);
                if (fq == 0) atomicAdd(ssq + row, ps);
                asm volatile("" ::: "memory"); }
    }
};
template <class Epi, class Sched, bool ALIGN_EPI = false, bool SP2 = false>
__device__ __forceinline__ void gemm_phase(PG8_LAS unsigned char* lds, const Gemm g, const Sched& S, const Epi& E) {
    int tid_l = threadIdx.x; asm volatile("" : "+v"(tid_l)); const int tid = tid_l, wid = __builtin_amdgcn_readfirstlane(tid >> 6), lane = tid & 63, wr = wid >> 2, wc = wid & 3, fr = lane & 15, fq = lane >> 4;
    const int K = g.K, nt = K / BK;
    unsigned voffA[2], voffB[2];
#pragma unroll
    for (int i = 0; i < 2; ++i) { int R, C; stage_rc(tid * 16 + i * 8192, R, C); const int Rb = Epi::PERM ? ((R & ~31) + perm32(R & 31)) : R;
        voffA[i] = (unsigned)(R * K + C) * 2u; voffB[i] = (unsigned)(Rb * K + C) * 2u; }
    const size_t kstep = (size_t)(BK * 2);
    const size_t hstep = (size_t)HALF * K * 2;
    const size_t tstep = 2 * hstep;
    const unsigned ldsw = (unsigned)wid * 1024u;
    const int aoff = lds_byte(wr * 64 + fr, fq * 8), boff = lds_byte(wc * 32 + fr, fq * 8);
#define PG8_SA(b, h) (((b) * 2 + (h)) * HTB)
#define PG8_SB(b, h) ((4 + (b) * 2 + (h)) * HTB)
#define PG8_STAGE(bufoff, gbase, voff) do { _Pragma("unroll") for (int _i = 0; _i < 2; ++_i) \
        __builtin_amdgcn_global_load_lds((const unsigned*)((const char*)(gbase) + (voff)[_i]), (PG8_LAS unsigned*)(lds + (bufoff) + ldsw + _i * 8192), 16, 0, 0); } while (0)
#define PG8_LDA(dst, b, h) do { _Pragma("unroll") for (int m = 0; m < 4; ++m) _Pragma("unroll") for (int k = 0; k < 2; ++k) dst[m][k] = *(const PG8_LAS bf16x8*)(lds + PG8_SA(b, h) + aoff + m * 2048 + k * 1024); } while (0)
#define PG8_LDB(dst, b, h) do { _Pragma("unroll") for (int n = 0; n < 2; ++n) _Pragma("unroll") for (int k = 0; k < 2; ++k) dst[n][k] = *(const PG8_LAS bf16x8*)(lds + PG8_SB(b, h) + boff + n * 2048 + k * 1024); } while (0)
#define PG8_MMA(ai, bj, At, Bt) do { __builtin_amdgcn_s_setprio(1); _Pragma("unroll") for (int m = 0; m < 4; ++m) _Pragma("unroll") for (int n = 0; n < 2; ++n) _Pragma("unroll") for (int k = 0; k < 2; ++k) \
        acc[ai][bj][m][n] = __builtin_amdgcn_mfma_f32_16x16x32_bf16(Bt[n][k], At[m][k], acc[ai][bj][m][n], 0, 0, 0); __builtin_amdgcn_s_setprio(0); } while (0)
#define PG8_WAIT_V(n) asm volatile("s_waitcnt vmcnt(" #n ")" ::: "memory")
#define PG8_WAIT_L(n) asm volatile("s_waitcnt lgkmcnt(" #n ")" ::: "memory")
#define PG8_BAR __builtin_amdgcn_s_barrier()
#define PG8_SCHED __builtin_amdgcn_sched_barrier(0)
    Unit cur, nxt; int ui = 0;
    if (!S.next(0, cur)) return;
    f32x4 acc[2][2][4][2];
#pragma unroll
    for (int a = 0; a < 2; ++a)
#pragma unroll
        for (int b = 0; b < 2; ++b)
#pragma unroll
            for (int m = 0; m < 4; ++m)
#pragma unroll
                for (int n = 0; n < 2; ++n) acc[a][b][m][n] = (f32x4){0.f, 0.f, 0.f, 0.f};
    bf16x8 At[4][2], B0[2][2], B1[2][2];
    const char* cA = (const char*)g.A + (size_t)cur.pm * tstep; const char* cB = (const char*)g.Bt + (size_t)cur.pn * tstep;
    S.a_ready(cur);
    if constexpr (SP2) {
        PG8_STAGE(PG8_SB(0, 0), cB, voffB); PG8_STAGE(PG8_SB(0, 1), cB + hstep, voffB); PG8_STAGE(PG8_SA(0, 0), cA, voffA); PG8_STAGE(PG8_SA(0, 1), cA + hstep, voffA);
        if (wr == 1) PG8_BAR;
        PG8_WAIT_V(2); PG8_BAR;
        PG8_STAGE(PG8_SB(1, 0), cB + kstep, voffB); PG8_STAGE(PG8_SA(1, 0), cA + kstep, voffA); PG8_STAGE(PG8_SB(1, 1), cB + hstep + kstep, voffB);
        PG8_WAIT_V(6); PG8_BAR;
    } else {
        PG8_STAGE(PG8_SB(0, 0), cB, voffB); PG8_STAGE(PG8_SA(0, 0), cA, voffA); PG8_STAGE(PG8_SB(0, 1), cB + hstep, voffB); PG8_STAGE(PG8_SA(0, 1), cA + hstep, voffA);
        if (wr == 1) PG8_BAR;
        PG8_WAIT_V(4); PG8_BAR;
        PG8_STAGE(PG8_SB(1, 0), cB + kstep, voffB); PG8_STAGE(PG8_SA(1, 0), cA + kstep, voffA); PG8_STAGE(PG8_SB(1, 1), cB + hstep + kstep, voffB);
        PG8_WAIT_V(6); PG8_BAR;
    }
    for (;;) {
        const bool has_next = S.next(ui + 1, nxt);
        const char* nA = has_next ? (const char*)g.A + (size_t)nxt.pm * tstep : cA; const char* nB = has_next ? (const char*)g.Bt + (size_t)nxt.pn * tstep : cB;
        for (int t = 0; t < nt; t += 2) {
            const bool last = (t == nt - 2);
            const char* a1 = cA + (size_t)(t + 1) * kstep;
            const char* a2 = last ? nA : cA + (size_t)(t + 2) * kstep; const char* b2 = last ? nB : cB + (size_t)(t + 2) * kstep;
            const char* a3 = a2 + kstep; const char* b3 = b2 + kstep;
            if (last && has_next) S.a_ready(nxt);
            if constexpr (SP2) {
            PG8_LDB(B0, 0, 0); PG8_LDB(B1, 0, 1); PG8_SCHED; PG8_LDA(At, 0, 0); PG8_STAGE(PG8_SA(1, 1), a1 + hstep, voffA);
            PG8_WAIT_V(8); PG8_WAIT_L(0); PG8_BAR; PG8_MMA(0, 0, At, B0); PG8_MMA(0, 1, At, B1); PG8_BAR; PG8_SCHED;
            PG8_LDA(At, 0, 1); PG8_STAGE(PG8_SB(0, 0), b2, voffB); PG8_STAGE(PG8_SB(0, 1), b2 + hstep, voffB); PG8_STAGE(PG8_SA(0, 0), a2, voffA);
            PG8_WAIT_V(8); PG8_WAIT_L(0); PG8_BAR; PG8_MMA(1, 0, At, B0); PG8_MMA(1, 1, At, B1); PG8_BAR; PG8_SCHED;
            PG8_LDB(B0, 1, 0); PG8_LDB(B1, 1, 1); PG8_SCHED; PG8_LDA(At, 1, 0); PG8_STAGE(PG8_SA(0, 1), a2 + hstep, voffA);
            PG8_WAIT_V(8); PG8_WAIT_L(0); PG8_BAR; PG8_MMA(0, 0, At, B0); PG8_MMA(0, 1, At, B1); PG8_BAR; PG8_SCHED;
            PG8_LDA(At, 1, 1); PG8_STAGE(PG8_SB(1, 0), b3, voffB); PG8_STAGE(PG8_SB(1, 1), b3 + hstep, voffB); PG8_STAGE(PG8_SA(1, 0), a3, voffA);
            PG8_WAIT_V(8); PG8_WAIT_L(0); PG8_BAR; PG8_MMA(1, 0, At, B0); PG8_MMA(1, 1, At, B1); PG8_BAR; PG8_SCHED;
            } else {
            PG8_LDB(B0, 0, 0); PG8_SCHED; PG8_LDA(At, 0, 0); PG8_STAGE(PG8_SA(1, 1), a1 + hstep, voffA);
            PG8_WAIT_L(8); PG8_BAR; PG8_WAIT_L(0); PG8_MMA(0, 0, At, B0); PG8_BAR; PG8_SCHED;
            PG8_LDB(B1, 0, 1); PG8_STAGE(PG8_SB(0, 0), b2, voffB);
            PG8_BAR; PG8_WAIT_L(0); PG8_MMA(0, 1, At, B1); PG8_BAR;
            PG8_LDA(At, 0, 1); PG8_STAGE(PG8_SA(0, 0), a2, voffA);
            PG8_BAR; PG8_WAIT_L(0); PG8_MMA(1, 0, At, B0); PG8_BAR; PG8_SCHED;
            PG8_STAGE(PG8_SB(0, 1), b2 + hstep, voffB);
            PG8_WAIT_V(6); PG8_BAR; PG8_MMA(1, 1, At, B1); PG8_BAR;
            PG8_LDB(B0, 1, 0); PG8_SCHED; PG8_LDA(At, 1, 0); PG8_STAGE(PG8_SA(0, 1), a2 + hstep, voffA);
            PG8_WAIT_L(8); PG8_BAR; PG8_WAIT_L(0); PG8_MMA(0, 0, At, B0); PG8_BAR; PG8_SCHED;
            PG8_LDB(B1, 1, 1); PG8_STAGE(PG8_SB(1, 0), b3, voffB);
            PG8_BAR; PG8_WAIT_L(0); PG8_MMA(0, 1, At, B1); PG8_BAR;
            PG8_LDA(At, 1, 1); PG8_STAGE(PG8_SA(1, 0), a3, voffA);
            PG8_BAR; PG8_WAIT_L(0); PG8_MMA(1, 0, At, B0); PG8_BAR; PG8_SCHED;
            PG8_STAGE(PG8_SB(1, 1), b3 + hstep, voffB);
            PG8_WAIT_V(6); PG8_BAR; PG8_MMA(1, 1, At, B1); PG8_BAR;
            }
        }
        if constexpr (ALIGN_EPI) { if (wr == 0) PG8_BAR; }
        if constexpr (!Epi::AFTER_DRAIN) { E(acc, cur, wr, wc, fr, fq); S.done(cur); }
        if (!has_next) break;
#pragma unroll
        for (int a = 0; a < 2; ++a)
#pragma unroll
            for (int b = 0; b < 2; ++b)
#pragma unroll
                for (int m = 0; m < 4; ++m)
#pragma unroll
                    for (int n = 0; n < 2; ++n) acc[a][b][m][n] = (f32x4){0.f, 0.f, 0.f, 0.f};
        cur = nxt; cA = nA; cB = nB; ++ui;
        if constexpr (ALIGN_EPI) { if (wr == 1) PG8_BAR; }
    }
    PG8_WAIT_V(0);
    if constexpr (!ALIGN_EPI) { if (wr == 0) PG8_BAR; }
    PG8_BAR;
    if constexpr (Epi::AFTER_DRAIN) { E.fused(acc, cur, wr, wc, fr, fq, lds, wid, lane); S.done(cur); }
#undef PG8_SA
#undef PG8_SB
#undef PG8_STAGE
#undef PG8_LDA
#undef PG8_LDB
#undef PG8_MMA
#undef PG8_WAIT_V
#undef PG8_WAIT_L
#undef PG8_BAR
#undef PG8_SCHED
}
}
typedef __bf16 bf16x2_t __attribute__((ext_vector_type(2)));
__device__ __forceinline__ unsigned cvt_pk(float lo, float hi) { float __attribute__((ext_vector_type(2))) v = {lo, hi}; bf16x2_t b = __builtin_convertvector(v, bf16x2_t); return __builtin_bit_cast(unsigned, b); }
#define LAS __attribute__((address_space(3)))
#define XB_TMO      128
#define XB_XCNT(j)  (256  + 64 * (j))
#define XB_XSUB(j)  (1280 + 64 * (j))
#define XB_XGEN(j)  (2304 + 64 * (j))
#define XB_TOP      3328
#define XB_TOPGEN   3392
#define XCD_BAR_WORDS 3456
#define XB_SPIN_CAP (1u << 18)

__device__ __forceinline__ unsigned xb_ld(unsigned* p)              { return __hip_atomic_load(p, __ATOMIC_RELAXED, __HIP_MEMORY_SCOPE_AGENT); }
__device__ __forceinline__ unsigned xb_add(unsigned* p, unsigned v) { return __hip_atomic_fetch_add(p, v, __ATOMIC_RELAXED, __HIP_MEMORY_SCOPE_AGENT); }
__device__ __forceinline__ unsigned xb_xcc_id() { return (unsigned)__builtin_amdgcn_s_getreg((3 << 11) | 20) & 0xFu; }
#define XB_SPIN(cond, bar) do { unsigned _sp = 0; while (cond) { __builtin_amdgcn_s_sleep(1); \
    if ((++_sp & 255u) == 0u) { if (xb_ld(&(bar)[XB_TMO])) break; if (_sp > XB_SPIN_CAP) { atomicAdd(&(bar)[XB_TMO], 1u); break; } } } } while (0)

struct XcdBarrier {
    unsigned* bar; unsigned x;
    volatile LAS unsigned* st;
};

__device__ __forceinline__ XcdBarrier xcd_barrier_post(unsigned* bar, volatile LAS unsigned* st) {
    XcdBarrier b; b.bar = bar; b.x = xb_xcc_id(); b.st = st;
    if (threadIdx.x == 0) (void)xb_add(&bar[XB_XCNT(b.x)], 1u);
    return b;
}
__device__ __forceinline__ void xcd_barrier_complete(unsigned* bar, unsigned x, unsigned& nloc, unsigned& nx) {
    const unsigned G = gridDim.x * gridDim.y * gridDim.z;
    unsigned sum, cnt, mine, sp = 0u;
    for (;;) {
        sum = 0u; cnt = 0u; mine = 0u;
#pragma unroll
        for (unsigned j = 0; j < 16; ++j) { const unsigned c = xb_ld(&bar[XB_XCNT(j)]); sum += c; cnt += (c > 0u) ? 1u : 0u; mine = (j == x) ? c : mine; }
        if (sum == G) break;
        __builtin_amdgcn_s_sleep(1);
        if ((++sp & 255u) == 0u) { if (xb_ld(&bar[XB_TMO])) break; if (sp > XB_SPIN_CAP) { atomicAdd(&bar[XB_TMO], 1u); break; } }
    }
    nloc = mine > 0u ? mine : 1u; nx = cnt > 0u ? cnt : 1u;
}

__device__ __forceinline__ void xcd_barrier(const XcdBarrier& b) {
    asm volatile("s_waitcnt vmcnt(0)" ::: "memory");
    __syncthreads();
    if (threadIdx.x == 0) {
        unsigned* bar = b.bar;
        __builtin_amdgcn_s_waitcnt(0);
        unsigned nloc = b.st[0], nx = b.st[1];
        if (nloc == 0u) { xcd_barrier_complete(bar, b.x, nloc, nx); b.st[0] = nloc; b.st[1] = nx; }
        const unsigned old = xb_add(&bar[XB_XSUB(b.x)], 1u);
        const unsigned gen = old / nloc;
        if (old + 1u == (gen + 1u) * nloc) {
            __builtin_amdgcn_fence(__ATOMIC_RELEASE, "agent");
            asm volatile("s_waitcnt vmcnt(0)" ::: "memory");
            const unsigned og = xb_add(&bar[XB_TOP], 1u);
            const unsigned tg = og / nx;
            if (og + 1u == (tg + 1u) * nx) xb_add(&bar[XB_TOPGEN], 1u);
            else XB_SPIN(xb_ld(&bar[XB_TOPGEN]) == tg, bar);
            __builtin_amdgcn_fence(__ATOMIC_ACQUIRE, "agent");
            xb_add(&bar[XB_XGEN(b.x)], 1u);
            asm volatile("s_waitcnt vmcnt(0)" ::: "memory");
        } else {
            XB_SPIN(xb_ld(&bar[XB_XGEN(b.x)]) == gen, bar);
            __builtin_amdgcn_fence(__ATOMIC_ACQUIRE, "agent");
            asm volatile("s_waitcnt vmcnt(0)" ::: "memory");
        }
    }
    __syncthreads();
}
typedef unsigned short bf16_t;
typedef short bf16x8 __attribute__((ext_vector_type(8)));
typedef short s16x4 __attribute__((ext_vector_type(4)));
typedef float f32x16 __attribute__((ext_vector_type(16)));
typedef float f32x4 __attribute__((ext_vector_type(4)));
typedef float f32x2 __attribute__((ext_vector_type(2)));
typedef unsigned u32x4 __attribute__((ext_vector_type(4)));
typedef unsigned u32x2 __attribute__((ext_vector_type(2)));

constexpr int DM = 1024, DIN = 4352, DFF = 2816, DUP = 2 * DFF, DEPTH = 2;
constexpr int CH_ROWS = 16384, NCHUNK = 3;
constexpr int TW = 2064;
constexpr int T_A = 0, T_B = 256, T_C = 1280, T_L = 2048;
constexpr float LOG2E = 1.4426950408889634f, LN2 = 0.6931471805599453f;
constexpr float QSCALE = 0.125f * LOG2E;
constexpr size_t MiB = 1u << 20;
constexpr size_t WS_WIN = 0, WS_WOUT = 18 * MiB, WS_WUP = 22 * MiB, WS_WDN = 44 * MiB, WS_HB = 56 * MiB, WS_PROJ = 88 * MiB, WS_TMP = 264 * MiB, WS_CTL = 394 * MiB, WS_XB = 395 * MiB, WS_SSQ = 427 * MiB, WS_END = 428 * MiB;
constexpr int LDS_BYTES = 147456 + 256;
constexpr int NTHREADS = 512;

struct Args { const float* in[17]; float* out; unsigned char* ws; };

__device__ __forceinline__ float wave_sum(float v) {
#pragma unroll
    for (int o = 1; o < 64; o <<= 1) v += __shfl_xor(v, o);
    return v;
}
__device__ __forceinline__ unsigned f2bf(float f) { unsigned u = __builtin_bit_cast(unsigned, f); return (u + 0x7fffu + ((u >> 16) & 1u)) >> 16; }
__device__ __forceinline__ unsigned pk2(float lo, float hi) { return f2bf(lo) | (f2bf(hi) << 16); }
__device__ __forceinline__ float bf2f(unsigned short b) { return __builtin_bit_cast(float, (unsigned)b << 16); }

__device__ __forceinline__ void transpose_item(const float* W, int K, int N, bf16_t* WT, LAS float* scr, int item, int lane, const float* gain) {
    const int nblk = N / 32, kb = item / nblk, nb = item % nblk, k0 = 64 * kb, n0 = 32 * nb;
#pragma unroll 8
    for (int i = 0; i < 32; ++i) { const int kk = 2 * i + (lane >> 5); scr[kk * 33 + (lane & 31)] = W[(size_t)(k0 + kk) * N + n0 + (lane & 31)] * (gain ? gain[k0 + kk] : 1.f); }
    asm volatile("s_waitcnt lgkmcnt(0)" ::: "memory");
    const int c = lane & 7;
#pragma unroll
    for (int j = 0; j < 4; ++j) { const int n = (lane >> 3) + 8 * j; const LAS float* s = scr + (8 * c) * 33 + n;
        u32x4 o; o.x = pk2(s[0 * 33], s[1 * 33]); o.y = pk2(s[2 * 33], s[3 * 33]); o.z = pk2(s[4 * 33], s[5 * 33]); o.w = pk2(s[6 * 33], s[7 * 33]);
        *(u32x4*)(WT + (size_t)(n0 + n) * K + k0 + 8 * c) = o; }
    asm volatile("s_waitcnt lgkmcnt(0)" ::: "memory");
}

__device__ __forceinline__ void rms_row_to_bf16(const float* xrow, const float* gain, bf16_t* orow, int lane) {
    const f32x4* xr = (const f32x4*)xrow + lane; const f32x4* gr = (const f32x4*)gain + lane;
    f32x4 v[4]; float s = 0.f;
#pragma unroll
    for (int j = 0; j < 4; ++j) { v[j] = xr[64 * j]; s += (v[j].x * v[j].x + v[j].y * v[j].y) + (v[j].z * v[j].z + v[j].w * v[j].w); }
    const float rstd = 1.f / sqrtf(wave_sum(s) * (1.f / DM) + 1e-6f);
    u32x2* o8 = (u32x2*)orow + lane;
#pragma unroll
    for (int j = 0; j < 4; ++j) { const f32x4 g = gr[64 * j]; u32x2 w; w.x = pk2(v[j].x * rstd * g.x, v[j].y * rstd * g.y); w.y = pk2(v[j].z * rstd * g.z, v[j].w * rstd * g.w); o8[64 * j] = w; }
}
__device__ __forceinline__ void rms_row_f32(float* xrow, const float* gain, int lane) {
    f32x4* xr = (f32x4*)xrow + lane; const f32x4* gr = (const f32x4*)gain + lane;
    f32x4 v[4]; float s = 0.f;
#pragma unroll
    for (int j = 0; j < 4; ++j) { v[j] = xr[64 * j]; s += (v[j].x * v[j].x + v[j].y * v[j].y) + (v[j].z * v[j].z + v[j].w * v[j].w); }
    const float rstd = 1.f / sqrtf(wave_sum(s) * (1.f / DM) + 1e-6f);
#pragma unroll
    for (int j = 0; j < 4; ++j) { const f32x4 g = gr[64 * j]; xr[64 * j] = v[j] * rstd * g; }
}

constexpr int KSTR = 144;
constexpr int ATT_K_OFF = 0, ATT_V_OFF = 2 * 64 * KSTR, ATT_SCR_OFF = ATT_V_OFF + 2 * 64 * 320;
__device__ __forceinline__ int crow(int r, int hi) { return (r & 3) + 8 * (r >> 2) + 4 * hi; }
typedef short v4i16_t __attribute__((ext_vector_type(4)));
__device__ __forceinline__ s16x4 vtr(const LAS unsigned char* p) { return __builtin_bit_cast(s16x4, __builtin_amdgcn_ds_read_tr16_b64_v4i16((LAS v4i16_t*)p)); }

template <int VD, bool WIN>
__device__ __forceinline__ void attn_unit(LAS unsigned char* lds, const bf16_t* Qp, const bf16_t* Kp, const bf16_t* Vp, size_t pitch,
                                          int q0, int L, float slope2, int W, float m_init, float l_init,
                                          float* Oout, size_t opitch, float* lse_out, size_t lpitch, bf16_t* Obf) {
    constexpr int VSTR = VD * 2 + 64, ND = VD / 32, VCH = VD / 8, VLD = 64 * VCH / NTHREADS;
    int tid_l = threadIdx.x; asm volatile("" : "+v"(tid_l)); const int tid = tid_l, lane = tid & 63, r32 = lane & 31, hi = lane >> 5, wid = __builtin_amdgcn_readfirstlane(tid >> 6);
    const int qw = q0 + wid * 32;
    int tlo = 0, thi = L / 64;
    if (WIN) { const int a = q0 - W; tlo = a > 0 ? a / 64 : 0; const int b = q0 + 256 + W; thi = (b < L ? b : L) / 64; }
    bf16x8 qr[4];
    { const bf16_t* qrow = Qp + (size_t)(qw + r32) * pitch + hi * 8;
#pragma unroll
      for (int d0 = 0; d0 < 4; ++d0) qr[d0] = *(const bf16x8*)(qrow + d0 * 16); }
    f32x16 o[ND];
#pragma unroll
    for (int d = 0; d < ND; ++d)
#pragma unroll
        for (int r = 0; r < 16; ++r) o[d][r] = 0.f;
    float m = m_init, l = hi == 0 ? l_init : 0.f;
    LAS float* wsf = (LAS float*)(lds + ATT_SCR_OFF) + wid * 64;
    const int krow = tid >> 3, kch = tid & 7;
    u32x4 kreg; u32x4 vreg[VLD];
#define ATT_GLOAD(t) do { kreg = *(const u32x4*)(Kp + (size_t)(64 * (t) + krow) * pitch + kch * 8); \
        _Pragma("unroll") for (int i_ = 0; i_ < VLD; ++i_) { const int idx_ = tid + NTHREADS * i_; vreg[i_] = *(const u32x4*)(Vp + (size_t)(64 * (t) + idx_ / VCH) * pitch + (idx_ % VCH) * 8); } } while (0)
#define ATT_LSTORE(b) do { *(LAS u32x4*)(lds + ATT_K_OFF + (b) * 64 * KSTR + krow * KSTR + kch * 16) = kreg; \
        _Pragma("unroll") for (int i_ = 0; i_ < VLD; ++i_) { const int idx_ = tid + NTHREADS * i_; *(LAS u32x4*)(lds + ATT_V_OFF + (b) * 64 * VSTR + (idx_ / VCH) * VSTR + (idx_ % VCH) * 16) = vreg[i_]; } } while (0)
    const int n = thi - tlo;
    ATT_GLOAD(tlo); ATT_LSTORE(0); __syncthreads();
    const float Wf = (float)W;
    for (int i = 0; i < n; ++i) {
        const int t = tlo + i, buf = i & 1;
        if (i + 1 < n) ATT_GLOAD(t + 1);
        bool active = true;
        if (WIN) { const int kb = 64 * t; active = (kb + 63 >= qw - W) && (kb <= qw + 31 + W); }
        if (active) {
            const LAS unsigned char* Kb = lds + ATT_K_OFF + buf * 64 * KSTR + r32 * KSTR + hi * 16;
            f32x16 p0, p1;
#pragma unroll
            for (int r = 0; r < 16; ++r) { p0[r] = 0.f; p1[r] = 0.f; }
#pragma unroll
            for (int d0 = 0; d0 < 4; ++d0) {
                const bf16x8 a0 = *(const LAS bf16x8*)(Kb + d0 * 32), a1 = *(const LAS bf16x8*)(Kb + 32 * KSTR + d0 * 32);
                p0 = __builtin_amdgcn_mfma_f32_32x32x16_bf16(a0, qr[d0], p0, 0, 0, 0);
                p1 = __builtin_amdgcn_mfma_f32_32x32x16_bf16(a1, qr[d0], p1, 0, 0, 0);
                if (d0 & 1) __builtin_amdgcn_sched_barrier(0);
            }
            const float dq = (float)(64 * t + 4 * hi - (qw + r32));
            float rm = -INFINITY;
#pragma unroll
            for (int r = 0; r < 16; ++r) {
                const float t0 = dq + (float)((r & 3) + 8 * (r >> 2)), t1 = t0 + 32.f;
                p0[r] = __builtin_fmaf(-slope2, __builtin_fabsf(t0), p0[r]);
                p1[r] = __builtin_fmaf(-slope2, __builtin_fabsf(t1), p1[r]);
                if (WIN) { if (__builtin_fabsf(t0) > Wf) p0[r] = -INFINITY; if (__builtin_fabsf(t1) > Wf) p1[r] = -INFINITY; }
                rm = __builtin_fmaxf(rm, __builtin_fmaxf(p0[r], p1[r]));
            }
            rm = __builtin_fmaxf(rm, __shfl_xor(rm, 32));
            if (__any(rm > m)) {
                const float mn = __builtin_fmaxf(m, rm); const float f = __builtin_amdgcn_exp2f(m - mn); m = mn; l *= f;
                if (hi == 0) wsf[r32] = f;
#pragma unroll
                for (int r = 0; r < 16; ++r) { const float fr = wsf[crow(r, hi)];
#pragma unroll
                    for (int d = 0; d < ND; ++d) o[d][r] *= fr; }
            }
            float ls = 0.f;
#pragma unroll
            for (int r = 0; r < 16; ++r) { p0[r] = __builtin_amdgcn_exp2f(p0[r] - m); p1[r] = __builtin_amdgcn_exp2f(p1[r] - m); ls += p0[r] + p1[r]; }
            l += ls;
            u32x4 pw[4];
#pragma unroll
            for (int c = 0; c < 4; ++c) {
                const f32x16& P = (c >> 1) ? p1 : p0; const int b = 8 * (c & 1);
                pw[c].x = cvt_pk(P[b + 0], P[b + 1]); pw[c].y = cvt_pk(P[b + 2], P[b + 3]); pw[c].z = cvt_pk(P[b + 4], P[b + 5]); pw[c].w = cvt_pk(P[b + 6], P[b + 7]);
            }
            const LAS unsigned char* Vb = lds + ATT_V_OFF + buf * 64 * VSTR + (4 * hi + ((lane & 15) >> 2)) * VSTR + (16 * ((lane >> 4) & 1) + 4 * (lane & 3)) * 2;
#pragma unroll
            for (int c = 0; c < 4; ++c)
#pragma unroll
                for (int d = 0; d < ND; ++d) {
                    const s16x4 vlo = vtr(Vb + c * 16 * VSTR + d * 64), vhi = vtr(Vb + c * 16 * VSTR + 8 * VSTR + d * 64);
                    const bf16x8 vf = (bf16x8){vlo[0], vlo[1], vlo[2], vlo[3], vhi[0], vhi[1], vhi[2], vhi[3]};
                    o[d] = __builtin_amdgcn_mfma_f32_32x32x16_bf16(__builtin_bit_cast(bf16x8, pw[c]), vf, o[d], 0, 0, 0);
                    if (d == ND - 1) __builtin_amdgcn_sched_barrier(0);
                }
        }
        if (i + 1 < n) ATT_LSTORE(buf ^ 1);
        __syncthreads();
    }
#undef ATT_GLOAD
#undef ATT_LSTORE
    l += __shfl_xor(l, 32);
    if (hi == 0) wsf[r32] = 1.f / l;
#pragma unroll
    for (int r = 0; r < 16; ++r) { const float ir = wsf[crow(r, hi)];
        if (Obf != nullptr) { bf16_t* orow = Obf + (size_t)(qw + crow(r, hi)) * opitch + r32;
#pragma unroll
            for (int d = 0; d < ND; ++d) orow[d * 32] = (bf16_t)f2bf(o[d][r] * ir);
        } else { float* orow = Oout + (size_t)(qw + crow(r, hi)) * opitch + r32;
#pragma unroll
            for (int d = 0; d < ND; ++d) orow[d * 32] = o[d][r] * ir; } }
    if (lse_out != nullptr && hi == 0) lse_out[(size_t)(qw + r32) * lpitch] = (m + __builtin_log2f(l)) * LN2;
    __syncthreads();
}

__device__ __forceinline__ void row_to_bf16_ssq(const float* xrow, bf16_t* orow, float* ssq, int lane) {
    const f32x4* xr = (const f32x4*)xrow + lane;
    f32x4 v[4]; float s = 0.f;
#pragma unroll
    for (int j = 0; j < 4; ++j) { v[j] = xr[64 * j]; s += (v[j].x * v[j].x + v[j].y * v[j].y) + (v[j].z * v[j].z + v[j].w * v[j].w); }
    s = wave_sum(s);
    u32x2* o8 = (u32x2*)orow + lane;
#pragma unroll
    for (int j = 0; j < 4; ++j) { u32x2 w; w.x = pk2(v[j].x, v[j].y); w.y = pk2(v[j].z, v[j].w); o8[64 * j] = w; }
    if (lane == 0) *ssq = s;
}
constexpr int BK_OFF = 0, BV_OFF = 2 * 64 * KSTR, BSCR_OFF = BV_OFF + 3 * 64 * 320, ATT_O0_OFF = BSCR_OFF + 2048;
static_assert(ATT_O0_OFF + 65536 <= 147456, "B attention LDS map");
constexpr float B_THR = 6.0f;
#ifndef B_LATE
#define B_LATE(w) false
#endif
__device__ __forceinline__ float max3f(float a, float b, float c) { float r; asm("v_max3_f32 %0, %1, %2, %3" : "=v"(r) : "v"(a), "v"(b), "v"(c)); return r; }
__device__ __forceinline__ void attn_b_unit(LAS unsigned char* lds, const bf16_t* base, int h, int q0, int L, float slope2_, float lam,
                                            const float* subln_l, float postscale, bf16_t* mix) {
    constexpr int VD = 128, VSTR = VD * 2 + 64, ND = 4, VCH = 16, VLD = 2;
    int tid_l = threadIdx.x; asm volatile("" : "+v"(tid_l)); const int tid = tid_l, lane = tid & 63, r32 = lane & 31, hi = lane >> 5, wid = __builtin_amdgcn_readfirstlane(tid >> 6);
    const int qw = q0 + wid * 32, NT = L / 64, c0 = q0 / 64;
    LAS float* wsf = (LAS float*)(lds + BSCR_OFF) + wid * 64;
    const bool late = B_LATE(wid);
    const int krow = tid >> 3, kch = tid & 7;
    const bf16_t* Vp = base + 1536 + h * 128;
    const float qposf_ = (float)(qw + r32);
    for (int mp = 0; mp < 2; ++mp) {
        const bf16_t* Qp = base + 512 + (h * 2 + mp) * 64; const bf16_t* Kp = base + 1024 + (h * 2 + mp) * 64;
        bf16x8 qr[4];
        { const bf16_t* qrow = Qp + (size_t)(qw + r32) * DIN + hi * 8;
#pragma unroll
          for (int d0 = 0; d0 < 4; ++d0) qr[d0] = *(const bf16x8*)(qrow + d0 * 16); }
        f32x16 o[ND];
#pragma unroll
        for (int d = 0; d < ND; ++d)
#pragma unroll
            for (int r = 0; r < 16; ++r) o[d][r] = 0.f;
        float mref = 0.f, l = 0.f;
        u32x4 kreg; u32x4 vreg[VLD];
        const unsigned koff = (unsigned)(krow * DIN + kch * 8) * 2u, voff = (unsigned)((tid >> 4) * DIN + (tid & 15) * 8) * 2u;
#define ATT_GLOAD(t) do { const char* kt_ = (const char*)Kp + (size_t)(t) * (64 * DIN * 2); const char* vt_ = (const char*)Vp + (size_t)(t) * (64 * DIN * 2); \
        kreg = *(const u32x4*)(kt_ + koff); vreg[0] = *(const u32x4*)(vt_ + voff); vreg[1] = *(const u32x4*)(vt_ + 32 * DIN * 2 + voff); } while (0)
#define ATT_LSTORE(b, vs) do { *(LAS u32x4*)(lds + BK_OFF + (b) * 64 * KSTR + krow * KSTR + kch * 16) = kreg; \
        *(LAS u32x4*)(lds + BV_OFF + (vs) * 64 * VSTR + (tid >> 4) * VSTR + (tid & 15) * 16) = vreg[0]; *(LAS u32x4*)(lds + BV_OFF + (vs) * 64 * VSTR + ((tid >> 4) + 32) * VSTR + (tid & 15) * 16) = vreg[1]; } while (0)
#define VFRAG(x, d) (bf16x8){x[d][0][0], x[d][0][1], x[d][0][2], x[d][0][3], x[d][1][0], x[d][1][1], x[d][1][2], x[d][1][3]}
#define PV_LOAD01(vs) do { \
        const LAS unsigned char* Vb = lds + BV_OFF + (vs) * 64 * VSTR + (4 * hi + ((lane & 15) >> 2)) * VSTR + (16 * ((lane >> 4) & 1) + 4 * (lane & 3)) * 2; \
        _Pragma("unroll") for (int d = 0; d < ND; ++d) { va[d][0] = vtr(Vb + d * 64); va[d][1] = vtr(Vb + 8 * VSTR + d * 64); } \
        _Pragma("unroll") for (int d = 0; d < ND; ++d) { vb2[d][0] = vtr(Vb + 16 * VSTR + d * 64); vb2[d][1] = vtr(Vb + 16 * VSTR + 8 * VSTR + d * 64); } \
        __builtin_amdgcn_sched_barrier(0); } while (0)
#define PV_MMA(vs) do { \
        const LAS unsigned char* Vb = lds + BV_OFF + (vs) * 64 * VSTR + (4 * hi + ((lane & 15) >> 2)) * VSTR + (16 * ((lane >> 4) & 1) + 4 * (lane & 3)) * 2; \
        _Pragma("unroll") for (int d = 0; d < ND; ++d) o[d] = __builtin_amdgcn_mfma_f32_32x32x16_bf16(__builtin_bit_cast(bf16x8, pw[0]), VFRAG(va, d), o[d], 0, 0, 0); \
        __builtin_amdgcn_sched_barrier(0); \
        _Pragma("unroll") for (int d = 0; d < ND; ++d) { va[d][0] = vtr(Vb + 32 * VSTR + d * 64); va[d][1] = vtr(Vb + 32 * VSTR + 8 * VSTR + d * 64); } \
        __builtin_amdgcn_sched_barrier(0); \
        _Pragma("unroll") for (int d = 0; d < ND; ++d) o[d] = __builtin_amdgcn_mfma_f32_32x32x16_bf16(__builtin_bit_cast(bf16x8, pw[1]), VFRAG(vb2, d), o[d], 0, 0, 0); \
        __builtin_amdgcn_sched_barrier(0); \
        _Pragma("unroll") for (int d = 0; d < ND; ++d) { vb2[d][0] = vtr(Vb + 48 * VSTR + d * 64); vb2[d][1] = vtr(Vb + 48 * VSTR + 8 * VSTR + d * 64); } \
        __builtin_amdgcn_sched_barrier(0); \
        _Pragma("unroll") for (int d = 0; d < ND; ++d) o[d] = __builtin_amdgcn_mfma_f32_32x32x16_bf16(__builtin_bit_cast(bf16x8, pw[2]), VFRAG(va, d), o[d], 0, 0, 0); \
        _Pragma("unroll") for (int d = 0; d < ND; ++d) o[d] = __builtin_amdgcn_mfma_f32_32x32x16_bf16(__builtin_bit_cast(bf16x8, pw[3]), VFRAG(vb2, d), o[d], 0, 0, 0); \
        __builtin_amdgcn_sched_barrier(0); } while (0)
        int first = 1; asm volatile("" : "+s"(first));
#define B_TILE(i_) ((i_) < 4 ? c0 + (i_) : ((i_) - 4 < c0 ? (i_) - 4 : (i_)))
        int t = B_TILE(0);
        int vs_prev = 2, vs_cur = 0, vs_next = 1;
        u32x4 pw[4];
        ATT_GLOAD(t); ATT_LSTORE(0, 0); __syncthreads();
        for (int i = 0; i < NT; ++i) {
            const int buf = i & 1;
            int tn = 0;
            if (i + 1 < NT) { tn = B_TILE(i + 1); ATT_GLOAD(tn); }
            s16x4 va[ND][2], vb2[ND][2];
            if (late && !first) { PV_LOAD01(vs_prev); PV_MMA(vs_prev); }
            f32x16 p0, p1;
            const int kb = 64 * t;
            float slope2 = slope2_, qposf = qposf_; asm volatile("" : "+v"(slope2), "+v"(qposf));
            if (kb + 63 < qw || kb > qw + 31) {
                const float sg = (kb > qw) ? -slope2 : slope2;
                const float b0 = sg * ((float)(kb + 4 * hi) - qposf) - mref, b1 = b0 + 32.f * sg;
#pragma unroll
                for (int r = 0; r < 16; ++r) { const float kv = (float)((r & 3) + 8 * (r >> 2)); p0[r] = __builtin_fmaf(sg, kv, b0); p1[r] = __builtin_fmaf(sg, kv, b1); }
            } else {
                const float dq = (float)(kb + 4 * hi) - qposf;
#pragma unroll
                for (int r = 0; r < 16; ++r) { const float t0 = dq + (float)((r & 3) + 8 * (r >> 2)); p0[r] = __builtin_fmaf(-slope2, __builtin_fabsf(t0), -mref); p1[r] = __builtin_fmaf(-slope2, __builtin_fabsf(t0 + 32.f), -mref); }
            }
            const LAS unsigned char* Kb = lds + BK_OFF + buf * 64 * KSTR + r32 * KSTR + hi * 16;
            bf16x8 kf[8];
#pragma unroll
            for (int d0 = 0; d0 < 4; ++d0) { kf[2 * d0] = *(const LAS bf16x8*)(Kb + d0 * 32); kf[2 * d0 + 1] = *(const LAS bf16x8*)(Kb + 32 * KSTR + d0 * 32); }
            __builtin_amdgcn_sched_barrier(0);
#pragma unroll
            for (int d0 = 0; d0 < 4; ++d0) {
                p0 = __builtin_amdgcn_mfma_f32_32x32x16_bf16(kf[2 * d0], qr[d0], p0, 0, 0, 0);
                p1 = __builtin_amdgcn_mfma_f32_32x32x16_bf16(kf[2 * d0 + 1], qr[d0], p1, 0, 0, 0);
            }
            if (!late) PV_LOAD01(vs_cur);
            asm volatile("s_nop 15\n\ts_nop 7" : "+v"(p0), "+v"(p1));
            float rm = max3f(p0[0], p1[0], p0[1]);
#pragma unroll
            for (int r = 1; r < 15; ++r) rm = max3f(rm, p1[r], p0[r + 1]);
            rm = max3f(rm, p1[15], rm);
            rm = max3f(rm, __shfl_xor(rm, 32), rm);
            if (first || __any(rm > B_THR)) {
                const float delta = (first || rm > B_THR) ? rm : 0.f; const float f = __builtin_amdgcn_exp2f(-delta); mref += delta; l *= f;
#pragma unroll
                for (int r = 0; r < 16; ++r) { p0[r] -= delta; p1[r] -= delta; }
                {
                    if (hi == 0) wsf[r32] = f;
#pragma unroll
                    for (int r = 0; r < 16; ++r) { const float fr = wsf[crow(r, hi)];
#pragma unroll
                        for (int d = 0; d < ND; ++d) o[d][r] *= fr; }
                }
            }
            float ls0 = 0.f, ls1 = 0.f;
#pragma unroll
            for (int r = 0; r < 16; ++r) { p0[r] = __builtin_amdgcn_exp2f(p0[r]); p1[r] = __builtin_amdgcn_exp2f(p1[r]); ls0 += p0[r]; ls1 += p1[r]; }
            l += ls0 + ls1;
#pragma unroll
            for (int c = 0; c < 4; ++c) {
                const f32x16& P = (c >> 1) ? p1 : p0; const int b = 8 * (c & 1);
                pw[c].x = cvt_pk(P[b + 0], P[b + 1]); pw[c].y = cvt_pk(P[b + 2], P[b + 3]); pw[c].z = cvt_pk(P[b + 4], P[b + 5]); pw[c].w = cvt_pk(P[b + 6], P[b + 7]);
            }
            __builtin_amdgcn_sched_barrier(0);
            if (!late) PV_MMA(vs_cur);
            first = 0;
            if (i + 1 < NT) ATT_LSTORE(buf ^ 1, vs_next);
            t = tn;
            { const int tmp_ = vs_prev; vs_prev = vs_cur; vs_cur = vs_next; vs_next = tmp_; }
            __syncthreads();
        }
        if (late) { s16x4 va[ND][2], vb2[ND][2]; PV_LOAD01(vs_prev); PV_MMA(vs_prev); }
#undef PV_LOAD01
#undef PV_MMA
#undef B_TILE
#undef VFRAG
#undef ATT_GLOAD
#undef ATT_LSTORE
        l += __shfl_xor(l, 32);
        if (hi == 0) wsf[r32] = 1.f / l;
        int lane_e = lane, qw_e = qw; asm volatile("" : "+v"(lane_e)); asm volatile("" : "+s"(qw_e));
        const int r32 = lane_e & 31, hi = lane_e >> 5, qw = qw_e;
        LAS unsigned* o0buf = (LAS unsigned*)(lds + ATT_O0_OFF) + wid * 2048 + lane_e;
        if (mp == 0) {
#pragma unroll
            for (int d = 0; d < ND; ++d)
#pragma unroll
                for (int r = 0; r < 16; r += 2) { const float i0 = wsf[crow(r, hi)], i1 = wsf[crow(r + 1, hi)]; o0buf[(d * 8 + (r >> 1)) * 64] = cvt_pk(o[d][r] * i0, o[d][r + 1] * i1); }
        } else {
            float gs[ND];
#pragma unroll
            for (int d = 0; d < ND; ++d) gs[d] = subln_l[d * 32 + r32] * postscale;
#pragma unroll
            for (int r = 0; r < 16; r += 2) {
                const float i0 = wsf[crow(r, hi)], i1 = wsf[crow(r + 1, hi)];
                float v0[ND], v1[ND]; float s0 = 0.f, s1 = 0.f;
#pragma unroll
                for (int d = 0; d < ND; ++d) { const unsigned w = o0buf[(d * 8 + (r >> 1)) * 64];
                    v0[d] = __builtin_bit_cast(float, w << 16) - lam * (o[d][r] * i0); v1[d] = __builtin_bit_cast(float, w & 0xffff0000u) - lam * (o[d][r + 1] * i1);
                    s0 += v0[d] * v0[d]; s1 += v1[d] * v1[d]; }
#pragma unroll
                for (int sh = 1; sh < 32; sh <<= 1) { s0 += __shfl_xor(s0, sh); s1 += __shfl_xor(s1, sh); }
                const float r0 = 1.f / sqrtf(s0 * (1.f / 128.f) + 1e-5f), r1 = 1.f / sqrtf(s1 * (1.f / 128.f) + 1e-5f);
                bf16_t* row0 = mix + (size_t)(qw + crow(r, hi)) * DM + r32; bf16_t* row1 = mix + (size_t)(qw + crow(r + 1, hi)) * DM + r32;
#pragma unroll
                for (int d = 0; d < ND; ++d) { row0[d * 32] = (bf16_t)f2bf(v0[d] * r0 * gs[d]); row1[d * 32] = (bf16_t)f2bf(v1[d] * r1 * gs[d]); }
            }
        }
        __syncthreads();
    }
}
__device__ __forceinline__ float alibi_slope(int i, int n) { return exp2f(-8.0f * (float)(i + 1) / (float)n); }
struct Ctx { int tid, lane, wave, G, cu, gw, NGW; };

__device__ __forceinline__ void ph_weights(const Args& a, const Ctx& c, LAS unsigned char* lds) {
    unsigned char* ws = a.ws;
    bf16_t* WinT = (bf16_t*)(ws + WS_WIN); bf16_t* WoutT = (bf16_t*)(ws + WS_WOUT); bf16_t* WupT = (bf16_t*)(ws + WS_WUP); bf16_t* WdnT = (bf16_t*)(ws + WS_WDN);
    const float* w_in = a.in[3]; const float* w_out = a.in[10]; const float* w_up = a.in[12]; const float* w_down = a.in[15];
    LAS float* scr = (LAS float*)(lds + c.wave * 16384);
    constexpr int I_IN = (DM / 64) * (DIN / 32), I_OUT = (DM / 64) * (DM / 32), I_UP = (DM / 64) * (DUP / 32), I_DN = (DFF / 64) * (DM / 32);
    constexpr int PER_L = I_IN + I_OUT + I_UP + I_DN;
    for (int it = c.gw; it < DEPTH * PER_L; it += c.NGW) {
        const int l = it / PER_L; int r = it % PER_L;
        if (r < I_IN) { transpose_item(w_in + (size_t)l * DM * DIN, DM, DIN, WinT + (size_t)l * DIN * DM, scr, r, c.lane, a.in[2] + l * DM); continue; } r -= I_IN;
        if (r < I_OUT) { transpose_item(w_out + (size_t)l * DM * DM, DM, DM, WoutT + (size_t)l * DM * DM, scr, r, c.lane, nullptr); continue; } r -= I_OUT;
        if (r < I_UP) { transpose_item(w_up + (size_t)l * DM * DUP, DM, DUP, WupT + (size_t)l * DUP * DM, scr, r, c.lane, a.in[11] + l * DM); continue; } r -= I_UP;
        transpose_item(w_down + (size_t)l * DFF * DM, DFF, DM, WdnT + (size_t)l * DM * DFF, scr, r, c.lane, nullptr);
    }
}
__device__ __forceinline__ const float* chunk_in(const Args& a, int ch) { return ch == 0 ? a.in[0] : a.in[1] + (size_t)(ch - 1) * CH_ROWS * DM; }
__device__ __forceinline__ float* chunk_out(const Args& a, int ch) { return a.out + (size_t)ch * CH_ROWS * DM; }

__device__ __forceinline__ void ph_norm_bf16(const Ctx& c, const float* xsrc, const float* gain, bf16_t* HB) {
    for (int r = c.gw; r < CH_ROWS; r += c.NGW) rms_row_to_bf16(xsrc + (size_t)r * DM, gain, HB + (size_t)r * DM, c.lane);
}
__device__ __forceinline__ void ph_final_norm(const Ctx& c, float* xo, const float* gain) {
    for (int r = c.gw; r < CH_ROWS; r += c.NGW) rms_row_f32(xo + (size_t)r * DM, gain, c.lane);
}

__device__ __forceinline__ void ph_attn(const Args& a, const Ctx& c, LAS unsigned char* lds, int ch, int layer) {
    const bf16_t* PROJ = (const bf16_t*)(a.ws + WS_PROJ); float* TMP = (float*)(a.ws + WS_TMP);
    const int SL = ch == 0 ? 16384 : 4096, sl_shift = ch == 0 ? 14 : 12;
    const int cu = c.cu, G = c.G;
#ifndef SKIP_B
    {
        const float lam_init = layer == 0 ? 0.2f : (0.8f - 0.6f * 0.7408182206817179f);
        const float s1 = wave_sum(a.in[5][layer * 64 + c.lane] * a.in[6][layer * 64 + c.lane]);
        const float s2 = wave_sum(a.in[7][layer * 64 + c.lane] * a.in[8][layer * 64 + c.lane]);
        const float lam = expf(s1) - expf(s2) + lam_init;
        bf16_t* HBm = (bf16_t*)(a.ws + WS_HB);
#ifdef PROBE_B2
        for (int rep_ = 0; rep_ < 2; ++rep_)
#endif
        for (int u = cu; u < 256; u += G) {
            int seq, h, qb; const int xcd = u & 7, idx = u >> 3;
            if (ch == 0) { seq = 0; h = xcd >> 1; qb = (xcd & 1) * 32 + idx; }
            else { const int pair = xcd * 2 + (idx >> 4); seq = pair >> 2; h = pair & 3; qb = idx & 15; }
            const size_t rb = (size_t)seq * SL;
            attn_b_unit(lds, PROJ + rb * DIN, h, qb * 256, SL, alibi_slope(h, 4) * LOG2E, lam, a.in[9] + layer * 128, 1.f - lam_init, HBm + rb * DM + 256 + h * 128);
        }
    }
#endif
#ifndef SKIP_AC
#ifdef PROBE_AC2
    for (int rep_ = 0; rep_ < 2; ++rep_)
#endif
    for (int uu = cu; uu < 1024; uu += G) {
        const bf16_t *qp, *kp, *vp; size_t pitch, opitch, lpitch; int q0, L, W; float slope2, m_init, l_init; float *op, *lp; bf16_t* obf;
        if (uu < 256) {
            const int hq = uu >> 6, blk = uu & 63;
            const int seq = (blk * 256) >> sl_shift, qb = blk - ((seq << sl_shift) >> 8);
            const size_t rb = (size_t)seq * SL; const bf16_t* base = PROJ + rb * DIN;
            qp = base + hq * 64; kp = base + 256 + (hq >> 1) * 64; vp = base + 384 + (hq >> 1) * 64; pitch = DIN; q0 = qb * 256; L = SL;
            slope2 = alibi_slope(hq, 4) * LOG2E; W = 128; m_init = a.in[4][layer * 4 + hq] * LOG2E; l_init = 1.f;
            op = nullptr; obf = (bf16_t*)(a.ws + WS_HB) + rb * DM + hq * 64; opitch = DM; lp = nullptr; lpitch = 0;
        } else {
            const int uc = uu - 256;
            const int gh = uc >> 6, blk = uc & 63, gq = gh >> 2;
            const int dsh = 2 * gq, d = 1 << dsh;
            const int seq = (blk * 256) >> sl_shift, b2 = blk - ((seq << sl_shift) >> 8);
            const int nbr = (SL >> dsh) >> 8;
            const int res = b2 / nbr, qb = b2 % nbr;
            const size_t rb = (size_t)seq * SL + res; const bf16_t* base = PROJ + rb * DIN;
            qp = base + 2048 + gh * 64; kp = base + 2816 + gh * 64; vp = base + 3584 + gh * 64; pitch = (size_t)DIN * d; q0 = qb * 256; L = SL >> dsh;
            slope2 = alibi_slope(gh, 12) * (float)d * LOG2E; W = 64; m_init = -1e30f; l_init = 0.f;
            op = TMP + rb * TW + T_C + gh * 64; obf = nullptr; opitch = (size_t)TW * d; lp = TMP + rb * TW + T_L + gh; lpitch = (size_t)TW * d;
        }
        attn_unit<64, true>(lds, qp, kp, vp, pitch, q0, L, slope2, W, m_init, l_init, op, opitch, lp, lpitch, obf);
    }
#endif
}

__device__ __forceinline__ void ph_combine(const Args& a, const Ctx& c, int layer) {
    const float* TMP = (const float*)(a.ws + WS_TMP); bf16_t* HB = (bf16_t*)(a.ws + WS_HB);
    const int lane = c.lane;
    { float* S2 = (float*)(a.ws + WS_SSQ) + CH_ROWS; for (int r = c.cu * NTHREADS + c.tid; r < CH_ROWS; r += c.G * NTHREADS) S2[r] = 0.f; }
    for (int r = c.gw; r < CH_ROWS; r += c.NGW) {
        const float* tr = TMP + (size_t)r * TW; bf16_t* mr = HB + (size_t)r * DM;
#pragma unroll
        for (int h = 0; h < 4; ++h) {
            const float l0 = tr[T_L + h], l1 = tr[T_L + 4 + h], l2 = tr[T_L + 8 + h];
            const float mx = fmaxf(l0, fmaxf(l1, l2));
            const float w0 = expf(l0 - mx), w1 = expf(l1 - mx), w2 = expf(l2 - mx);
            const float inv = 1.f / (w0 + w1 + w2);
            const float o = (w0 * tr[T_C + h * 64 + lane] + w1 * tr[T_C + (4 + h) * 64 + lane] + w2 * tr[T_C + (8 + h) * 64 + lane]) * inv;
            mr[768 + h * 64 + lane] = (bf16_t)f2bf(o);
        }
    }
}

__device__ __forceinline__ void ph_conv(const Args& a, const Ctx& c, int ch, int layer) {
    const bf16_t* UB = (const bf16_t*)(a.ws + WS_PROJ); bf16_t* GB = (bf16_t*)(a.ws + WS_TMP);
    const int SL = ch == 0 ? 16384 : 4096;
    const float* cw = a.in[13] + (size_t)layer * 3 * DUP; const float* cb = a.in[14] + (size_t)layer * DUP;
    constexpr int NCP = DFF / 2, RB = 16;
    const int nitems = (CH_ROWS / RB) * NCP;
    { float* S1 = (float*)(a.ws + WS_SSQ); for (int r = c.cu * NTHREADS + c.tid; r < CH_ROWS; r += c.G * NTHREADS) S1[r] = 0.f; }
    for (int it = c.cu * NTHREADS + c.tid; it < nitems; it += c.G * NTHREADS) {
        const int cp = it % NCP, rb = it / NCP, c0 = cp * 2, r0 = rb * RB;
        float wg[3][2], wv[3][2], bg[2], bv[2];
#pragma unroll
        for (int k = 0; k < 3; ++k)
#pragma unroll
            for (int j = 0; j < 2; ++j) { wg[k][j] = cw[k * DUP + c0 + j]; wv[k][j] = cw[k * DUP + DFF + c0 + j]; }
#pragma unroll
        for (int j = 0; j < 2; ++j) { bg[j] = cb[c0 + j]; bv[j] = cb[DFF + c0 + j]; }
        const bool first = (r0 & (SL - 1)) == 0, last = ((r0 + RB) & (SL - 1)) == 0;
        unsigned pg_, pv_, cg_, cv_, ng_, nv_;
        pg_ = first ? 0u : *(const unsigned*)(UB + (size_t)(r0 - 1) * DUP + c0); pv_ = first ? 0u : *(const unsigned*)(UB + (size_t)(r0 - 1) * DUP + DFF + c0);
        cg_ = *(const unsigned*)(UB + (size_t)r0 * DUP + c0); cv_ = *(const unsigned*)(UB + (size_t)r0 * DUP + DFF + c0);
        for (int rr = 0; rr < RB; ++rr) {
            const int r = r0 + rr; const bool nz = (rr == RB - 1) && last;
            ng_ = nz ? 0u : *(const unsigned*)(UB + (size_t)(r + 1) * DUP + c0); nv_ = nz ? 0u : *(const unsigned*)(UB + (size_t)(r + 1) * DUP + DFF + c0);
            float res[2];
#pragma unroll
            for (int j = 0; j < 2; ++j) {
                const int sh = j * 16;
                const float gp = bf2f((unsigned short)(pg_ >> sh)), gc = bf2f((unsigned short)(cg_ >> sh)), gn = bf2f((unsigned short)(ng_ >> sh));
                const float vp = bf2f((unsigned short)(pv_ >> sh)), vc = bf2f((unsigned short)(cv_ >> sh)), vn = bf2f((unsigned short)(nv_ >> sh));
                const float gate = gp * wg[0][j] + gc * wg[1][j] + gn * wg[2][j] + bg[j];
                const float val = vp * wv[0][j] + vc * wv[1][j] + vn * wv[2][j] + bv[j];
                res[j] = gate / (1.f + __expf(-gate)) * val;
            }
            *(unsigned*)(GB + (size_t)r * DFF + c0) = pk2(res[0], res[1]);
            pg_ = cg_; pv_ = cv_; cg_ = ng_; cv_ = nv_;
        }
    }
}

constexpr int STEPS_PER_CHUNK = 1 + DEPTH * 7;
constexpr int NSTEPS = 1 + NCHUNK * STEPS_PER_CHUNK + 1;
__global__ void __launch_bounds__(NTHREADS, 2) mega_fwd(Args a) {
    extern __shared__ __attribute__((aligned(16))) unsigned char lds_raw[];
    LAS unsigned char* lds = (LAS unsigned char*)lds_raw;
    cg::grid_group grid = cg::this_grid();
    volatile LAS unsigned* bst = (volatile LAS unsigned*)(lds + 147456);
    if (threadIdx.x < 2) bst[threadIdx.x] = 0u;
    __syncthreads();
    XcdBarrier xbar = xcd_barrier_post((unsigned*)(a.ws + WS_CTL), bst);
#ifdef PROBE_TA
    unsigned long long tA_ = 0, tB_ = 0, tprev_ = __builtin_amdgcn_s_memrealtime();
#endif
    for (int step = 0; step < NSTEPS; ++step) {
        int tid_l = threadIdx.x, cu_l = blockIdx.x, G_l = gridDim.x;
        asm volatile("" : "+v"(tid_l)); asm volatile("" : "+s"(cu_l), "+s"(G_l));
        Ctx c; c.tid = tid_l; c.lane = c.tid & 63; c.wave = __builtin_amdgcn_readfirstlane(c.tid >> 6);
        c.G = G_l; c.cu = cu_l; c.gw = c.cu * 8 + c.wave; c.NGW = c.G * 8;
        if (step == 0) ph_weights(a, c, lds);
        else if (step == NSTEPS - 1) ph_final_norm(c, chunk_out(a, NCHUNK - 1), a.in[16]);
        else {
            const int s = step - 1, ch = s / STEPS_PER_CHUNK, sc = s % STEPS_PER_CHUNK;
            unsigned char* ws = a.ws;
            bf16_t* HB = (bf16_t*)(ws + WS_HB); bf16_t* XB = (bf16_t*)(ws + WS_XB);
            float* S1 = (float*)(ws + WS_SSQ); float* S2 = S1 + CH_ROWS;
            float* xo = chunk_out(a, ch);
            if (sc == 0) {
                if (ch > 0) ph_final_norm(c, chunk_out(a, ch - 1), a.in[16]);
                const float* xin = chunk_in(a, ch);
                for (int r = c.gw; r < CH_ROWS; r += c.NGW) row_to_bf16_ssq(xin + (size_t)r * DM, XB + (size_t)r * DM, S1 + r, c.lane);
            } else {
                const int layer = (sc - 1) / 7, ph = (sc - 1) % 7;
                const float* xsrc = layer == 0 ? chunk_in(a, ch) : (const float*)xo;
                if (ph == 0) {
                    pg8::Gemm g{XB, (const bf16_t*)(ws + WS_WIN) + (size_t)layer * DIN * DM, CH_ROWS, DIN, DM}; pg8::StaticOrder S; S.init(CH_ROWS, DIN, c.G, c.cu);
                    pg8::EpiBf16S2 E{(bf16_t*)(ws + WS_PROJ), DIN, 1805u, QSCALE, S1};
#ifdef PROBE_G2
                    for (int rep_ = 0; rep_ < 2; ++rep_)
#endif
                    pg8::gemm_phase<pg8::EpiBf16S2, pg8::StaticOrder, true, true>(lds, g, S, E);
                } else if (ph == 1) {
                    ph_attn(a, c, lds, ch, layer);
                } else if (ph == 2) {
                    ph_combine(a, c, layer);
                } else if (ph == 3) {
                    pg8::Gemm g{HB, (const bf16_t*)(ws + WS_WOUT) + (size_t)layer * DM * DM, CH_ROWS, DM, DM}; pg8::StaticOrder S; S.init(CH_ROWS, DM, c.G, c.cu);
                    pg8::EpiRes2 E{xsrc, xo, XB, S2, DM};
                    pg8::gemm_phase<pg8::EpiRes2, pg8::StaticOrder, true, true>(lds, g, S, E);
                } else if (ph == 4) {
                    pg8::Gemm g{XB, (const bf16_t*)(ws + WS_WUP) + (size_t)layer * DUP * DM, CH_ROWS, DUP, DM}; pg8::StaticOrder S; S.init(CH_ROWS, DUP, c.G, c.cu);
                    pg8::EpiBf16S2 E{(bf16_t*)(ws + WS_PROJ), DUP, 0u, 1.f, S2};
#ifdef PROBE_G2
                    for (int rep_ = 0; rep_ < 2; ++rep_)
#endif
                    pg8::gemm_phase<pg8::EpiBf16S2, pg8::StaticOrder, true, true>(lds, g, S, E);
                } else if (ph == 5) {
                    ph_conv(a, c, ch, layer);
                } else {
                    pg8::Gemm g{(const bf16_t*)(ws + WS_TMP), (const bf16_t*)(ws + WS_WDN) + (size_t)layer * DM * DFF, CH_ROWS, DM, DFF}; pg8::StaticOrder S; S.init(CH_ROWS, DM, c.G, c.cu);
                    pg8::EpiRes2 E{xo, xo, XB, S1, DM};
                    pg8::gemm_phase<pg8::EpiRes2, pg8::StaticOrder, true, true>(lds, g, S, E);
                }
            }
        }
#ifdef PROBE_TA
        const unsigned long long tmid_ = __builtin_amdgcn_s_memrealtime();
#endif
        if (step == 0) grid.sync(); else if (step != NSTEPS - 1) xcd_barrier(xbar);
#ifdef PROBE_TA
        {
            const unsigned long long tnow_ = __builtin_amdgcn_s_memrealtime();
            int cls_;
            if (step == 0) cls_ = 0; else if (step == NSTEPS - 1) cls_ = 1;
            else { const int sc_ = (step - 1) % STEPS_PER_CHUNK; if (sc_ == 0) cls_ = 1; else { const int ph_ = (sc_ - 1) % 7; cls_ = ph_ == 0 || ph_ == 4 ? 2 : ph_ == 1 ? 3 : ph_ == 2 ? 4 : ph_ == 5 ? 6 : 5; } }
            if (cls_ == PROBE_TA) tA_ += tnow_ - tprev_; if (PROBE_TA == 7) tA_ += tnow_ - tmid_;
            if (cls_ == PROBE_TB) tB_ += tnow_ - tprev_; if (PROBE_TB == 7) tB_ += tnow_ - tmid_;
            tprev_ = tnow_;
        }
#endif
    }
#ifdef PROBE_TA
    if (blockIdx.x == 0 && threadIdx.x < 64) {
        float* xo = chunk_out(a, NCHUNK - 1);
        const float ua = (float)tA_ * 0.01f, ub = (float)tB_ * 0.01f;
        if (threadIdx.x == 0) xo[0] += 8.f + ua * 0.01f; else xo[4 * threadIdx.x] += sqrtf(ub * 0.01f);
    }
#endif
}

extern "C" void kernel_launch(void* const* d_in, const int* in_sizes, int n_in, void* d_out, int out_size, void* d_ws, size_t ws_size, hipStream_t stream) {
    static int grid = 0;
    if (grid == 0) {
        if (n_in != 17 || ws_size < WS_END) { fprintf(stderr, "kernel_launch: unexpected n_in %d / ws_size %zu (need %zu)\n", n_in, ws_size, (size_t)WS_END); grid = -1; return; }
        int dev = 0, cus = 0, per_cu = 0;
        (void)hipGetDevice(&dev); (void)hipDeviceGetAttribute(&cus, hipDeviceAttributeMultiprocessorCount, dev);
        if (hipFuncSetAttribute((const void*)mega_fwd, hipFuncAttributeMaxDynamicSharedMemorySize, LDS_BYTES) != hipSuccess) { fprintf(stderr, "hipFuncSetAttribute failed\n"); grid = -1; return; }
        if (hipOccupancyMaxActiveBlocksPerMultiprocessor(&per_cu, (const void*)mega_fwd, NTHREADS, LDS_BYTES) != hipSuccess || per_cu < 1) { fprintf(stderr, "occupancy query: %d\n", per_cu); per_cu = 1; }
        (void)hipGetLastError();
        grid = cus * 1;
    }
    if (grid < 0) return;
    (void)hipMemsetAsync((char*)d_ws + WS_CTL, 0, 65536, stream);
    Args a{};
    for (int i = 0; i < 17; ++i) a.in[i] = (const float*)d_in[i];
    a.out = (float*)d_out; a.ws = (unsigned char*)d_ws;
    void* args[] = {&a};
    hipError_t e = hipLaunchCooperativeKernel((const void*)mega_fwd, dim3(grid), dim3(NTHREADS), args, LDS_BYTES, stream);
    if (e != hipSuccess) fprintf(stderr, "cooperative launch failed: %s (grid %d)\n", hipGetErrorString(e), grid);
}
```

```cpp
#include <hip/hip_runtime.h>
#include <hip/hip_cooperative_groups.h>
#include <cstdio>
#include <cstdint>
#include <cmath>
namespace cg = cooperative_groups;
namespace pg8 {
#define PG8_LAS __attribute__((address_space(3)))
typedef unsigned short bf16_t;
typedef short bf16x8 __attribute__((ext_vector_type(8)));
typedef float f32x4 __attribute__((ext_vector_type(4)));
typedef unsigned u32x4 __attribute__((ext_vector_type(4)));
constexpr int BM = 256, BK = 64, HALF = 128, HTB = HALF * BK * 2  , STAGE_BYTES = 8 * HTB, NXCD = 8, WGM = 8;

__host__ __device__ __forceinline__ int lds_byte(int r, int c) { const int st = (r >> 4) * 2 + (c >> 5), rr = r & 15, cc = c & 31, ob = rr * 64 + cc * 2; return st * 1024 + (ob ^ (((ob >> 9) & 1) << 5)); }
__host__ __device__ __forceinline__ void stage_rc(int b, int& R, int& C) { const int st = b / 1024, sb = b % 1024, swz = sb ^ (((sb >> 9) & 1) << 5); R = (st >> 1) * 16 + swz / 64; C = (st & 1) * 32 + (swz % 64) / 2; }
__host__ __device__ __forceinline__ int perm32(int rho) { const int n = rho >> 4, i = rho & 15; return 8 * (i >> 2) + 4 * n + (i & 3); }

struct Unit { int pm, pn; };
struct Gemm { const bf16_t* A; const bf16_t* Bt; int M, N, K; };

struct StaticOrder {
    int nM, nN, nwg, G, c;
    __host__ __device__ void init(int M, int N, int G_, int c_) { nM = M / BM; nN = N / BM; nwg = nM * nN; G = G_; c = c_; }
    __host__ __device__ bool next(int i, Unit& u) const {
        const long L = (long)i * G + c; if (L >= nwg) return false;
        int wgid = (int)L; { const int q = nwg / NXCD, r = nwg % NXCD, xcd = wgid % NXCD, off = wgid / NXCD; wgid = (xcd < r ? xcd * (q + 1) : r * (q + 1) + (xcd - r) * q) + off; }
        const int nig = WGM * nN, gid = wgid / nig, fm = gid * WGM, gsz = (nM - fm) < WGM ? (nM - fm) : WGM;
        u.pm = fm + ((wgid % nig) % gsz); u.pn = (wgid % nig) / gsz; return true;
    }
    __device__ __forceinline__ void a_ready(const Unit&) const {}
    __device__ __forceinline__ void done(const Unit&) const {}
};

__device__ __forceinline__ unsigned cvt_pk_bf16(float lo, float hi) { unsigned r; asm volatile("v_cvt_pk_bf16_f32 %0, %1, %2" : "=v"(r) : "v"(lo), "v"(hi)); return r; }
struct EpiBf16S {
    static constexpr bool PERM = true, AFTER_DRAIN = false;
    bf16_t* O; int ldc; unsigned scalemask; float sc;
    __device__ __forceinline__ void operator()(const f32x4 (&acc)[2][2][4][2], const Unit& u, int wr, int wc, int fr, int fq) const {
        const int row0 = u.pm * BM + wr * 64 + fr; const int col0 = u.pn * BM + wc * 32 + 8 * fq;
        const float s = ((scalemask >> u.pn) & 1u) ? sc : 1.f;
#pragma unroll
        for (int ai = 0; ai < 2; ++ai)
#pragma unroll
            for (int m = 0; m < 4; ++m) { bf16_t* rowp = O + (size_t)(row0 + ai * HALF + m * 16) * ldc + col0;
#pragma unroll
                for (int bj = 0; bj < 2; ++bj) { f32x4 v0 = acc[ai][bj][m][0] * s, v1 = acc[ai][bj][m][1] * s;
                    u32x4 w; w.x = cvt_pk_bf16(v0[0], v0[1]); w.y = cvt_pk_bf16(v0[2], v0[3]); w.z = cvt_pk_bf16(v1[0], v1[1]); w.w = cvt_pk_bf16(v1[2], v1[3]);
                    *(u32x4*)(rowp + bj * HALF) = w; } }
    }
};
struct EpiRes {
    static constexpr bool PERM = false, AFTER_DRAIN = false;
    const float* base; float* out; int ldc;
    __device__ __forceinline__ void operator()(const f32x4 (&acc)[2][2][4][2], const Unit& u, int wr, int wc, int fr, int fq) const {
        const int col0 = u.pn * BM + wc * 32 + 4 * fq;
#pragma unroll
        for (int ai = 0; ai < 2; ++ai)
#pragma unroll
            for (int m = 0; m < 4; ++m) { const size_t off = (size_t)(u.pm * BM + ai * HALF + wr * 64 + m * 16 + fr) * ldc + col0;
#pragma unroll
                for (int bj = 0; bj < 2; ++bj)
#pragma unroll
                    for (int n = 0; n < 2; ++n) { const f32x4 bs = *(const f32x4*)(base + off + bj * HALF + n * 16); *(f32x4*)(out + off + bj * HALF + n * 16) = bs + acc[ai][bj][m][n]; }
                asm volatile("" ::: "memory"); }
    }
};

struct EpiBf16S2 {
    static constexpr bool PERM = true, AFTER_DRAIN = false;
    bf16_t* O; int ldc; unsigned scalemask; float sc; const float* ssq;
    __device__ __forceinline__ void operator()(const f32x4 (&acc)[2][2][4][2], const Unit& u, int wr, int wc, int fr, int fq) const {
        const int row0 = u.pm * BM + wr * 64 + fr; const int col0 = u.pn * BM + wc * 32 + 8 * fq;
        const float s = ((scalemask >> u.pn) & 1u) ? sc : 1.f;
#pragma unroll
        for (int ai = 0; ai < 2; ++ai)
#pragma unroll
            for (int m = 0; m < 4; ++m) { const int row = row0 + ai * HALF + m * 16; bf16_t* rowp = O + (size_t)row * ldc + col0;
                const float rs = s / sqrtf(ssq[row] * (1.f / 1024.f) + 1e-6f);
#pragma unroll
                for (int bj = 0; bj < 2; ++bj) { f32x4 v0 = acc[ai][bj][m][0] * rs, v1 = acc[ai][bj][m][1] * rs;
                    u32x4 w; w.x = cvt_pk_bf16(v0[0], v0[1]); w.y = cvt_pk_bf16(v0[2], v0[3]); w.z = cvt_pk_bf16(v1[0], v1[1]); w.w = cvt_pk_bf16(v1[2], v1[3]);
                    *(u32x4*)(rowp + bj * HALF) = w; } }
    }
};
typedef unsigned u32x2e __attribute__((ext_vector_type(2)));
struct EpiRes2 {
    static constexpr bool PERM = false, AFTER_DRAIN = false;
    const float* base; float* out; bf16_t* xb; float* ssq; int ldc;
    __device__ __forceinline__ void operator()(const f32x4 (&acc)[2][2][4][2], const Unit& u, int wr, int wc, int fr, int fq) const {
        const int col0 = u.pn * BM + wc * 32 + 4 * fq;
#pragma unroll
        for (int ai = 0; ai < 2; ++ai)
#pragma unroll
            for (int m = 0; m < 4; ++m) { const int row = u.pm * BM + ai * HALF + wr * 64 + m * 16 + fr; const size_t off = (size_t)row * ldc + col0; float ps = 0.f;
#pragma unroll
                for (int bj = 0; bj < 2; ++bj)
#pragma unroll
                    for (int n = 0; n < 2; ++n) { const f32x4 bs = *(const f32x4*)(base + off + bj * HALF + n * 16); const f32x4 v = bs + acc[ai][bj][m][n];
                        *(f32x4*)(out + off + bj * HALF + n * 16) = v; ps += (v[0] * v[0] + v[1] * v[1]) + (v[2] * v[2] + v[3] * v[3]);
                        u32x2e w; w.x = cvt_pk_bf16(v[0], v[1]); w.y = cvt_pk_bf16(v[2], v[3]); *(u32x2e*)(xb + off + bj * HALF + n * 16) = w; }
                ps += __shfl_xor(ps, 16); ps += __shfl_xor(ps, 32);
                if (fq == 0) atomicAdd(ssq + row, ps);
                asm volatile("" ::: "memory"); }
    }
};
template <class Epi, class Sched, bool ALIGN_EPI = false, bool SP2 = false>
__device__ __forceinline__ void gemm_phase(PG8_LAS unsigned char* lds, const Gemm g, const Sched& S, const Epi& E) {
    int tid_l = threadIdx.x; asm volatile("" : "+v"(tid_l)); const int tid = tid_l, wid = __builtin_amdgcn_readfirstlane(tid >> 6), lane = tid & 63, wr = wid >> 2, wc = wid & 3, fr = lane & 15, fq = lane >> 4;
    const int K = g.K, nt = K / BK;
    unsigned voffA[2], voffB[2];
#pragma unroll
    for (int i = 0; i < 2; ++i) { int R, C; stage_rc(tid * 16 + i * 8192, R, C); const int Rb = Epi::PERM ? ((R & ~31) + perm32(R & 31)) : R;
        voffA[i] = (unsigned)(R * K + C) * 2u; voffB[i] = (unsigned)(Rb * K + C) * 2u; }
    const size_t kstep = (size_t)(BK * 2);
    const size_t hstep = (size_t)HALF * K * 2;
    const size_t tstep = 2 * hstep;
    const unsigned ldsw = (unsigned)wid * 1024u;
    const int aoff = lds_byte(wr * 64 + fr, fq * 8), boff = lds_byte(wc * 32 + fr, fq * 8);
#define PG8_SA(b, h) (((b) * 2 + (h)) * HTB)
#define PG8_SB(b, h) ((4 + (b) * 2 + (h)) * HTB)
#define PG8_STAGE(bufoff, gbase, voff) do { _Pragma("unroll") for (int _i = 0; _i < 2; ++_i) \
        __builtin_amdgcn_global_load_lds((const unsigned*)((const char*)(gbase) + (voff)[_i]), (PG8_LAS unsigned*)(lds + (bufoff) + ldsw + _i * 8192), 16, 0, 0); } while (0)
#define PG8_LDA(dst, b, h) do { _Pragma("unroll") for (int m = 0; m < 4; ++m) _Pragma("unroll") for (int k = 0; k < 2; ++k) dst[m][k] = *(const PG8_LAS bf16x8*)(lds + PG8_SA(b, h) + aoff + m * 2048 + k * 1024); } while (0)
#define PG8_LDB(dst, b, h) do { _Pragma("unroll") for (int n = 0; n < 2; ++n) _Pragma("unroll") for (int k = 0; k < 2; ++k) dst[n][k] = *(const PG8_LAS bf16x8*)(lds + PG8_SB(b, h) + boff + n * 2048 + k * 1024); } while (0)
#define PG8_MMA(ai, bj, At, Bt) do { __builtin_amdgcn_s_setprio(1); _Pragma("unroll") for (int m = 0; m < 4; ++m) _Pragma("unroll") for (int n = 0; n < 2; ++n) _Pragma("unroll") for (int k = 0; k < 2; ++k) \
        acc[ai][bj][m][n] = __builtin_amdgcn_mfma_f32_16x16x32_bf16(Bt[n][k], At[m][k], acc[ai][bj][m][n], 0, 0, 0); __builtin_amdgcn_s_setprio(0); } while (0)
#define PG8_WAIT_V(n) asm volatile("s_waitcnt vmcnt(" #n ")" ::: "memory")
#define PG8_WAIT_L(n) asm volatile("s_waitcnt lgkmcnt(" #n ")" ::: "memory")
#define PG8_BAR __builtin_amdgcn_s_barrier()
#define PG8_SCHED __builtin_amdgcn_sched_barrier(0)
    Unit cur, nxt; int ui = 0;
    if (!S.next(0, cur)) return;
    f32x4 acc[2][2][4][2];
#pragma unroll
    for (int a = 0; a < 2; ++a)
#pragma unroll
        for (int b = 0; b < 2; ++b)
#pragma unroll
            for (int m = 0; m < 4; ++m)
#pragma unroll
                for (int n = 0; n < 2; ++n) acc[a][b][m][n] = (f32x4){0.f, 0.f, 0.f, 0.f};
    bf16x8 At[4][2], B0[2][2], B1[2][2];
    const char* cA = (const char*)g.A + (size_t)cur.pm * tstep; const char* cB = (const char*)g.Bt + (size_t)cur.pn * tstep;
    S.a_ready(cur);
    if constexpr (SP2) {
        PG8_STAGE(PG8_SB(0, 0), cB, voffB); PG8_STAGE(PG8_SB(0, 1), cB + hstep, voffB); PG8_STAGE(PG8_SA(0, 0), cA, voffA); PG8_STAGE(PG8_SA(0, 1), cA + hstep, voffA);
        if (wr == 1) PG8_BAR;
        PG8_WAIT_V(2); PG8_BAR;
        PG8_STAGE(PG8_SB(1, 0), cB + kstep, voffB); PG8_STAGE(PG8_SA(1, 0), cA + kstep, voffA); PG8_STAGE(PG8_SB(1, 1), cB + hstep + kstep, voffB);
        PG8_WAIT_V(6); PG8_BAR;
    } else {
        PG8_STAGE(PG8_SB(0, 0), cB, voffB); PG8_STAGE(PG8_SA(0, 0), cA, voffA); PG8_STAGE(PG8_SB(0, 1), cB + hstep, voffB); PG8_STAGE(PG8_SA(0, 1), cA + hstep, voffA);
        if (wr == 1) PG8_BAR;
        PG8_WAIT_V(4); PG8_BAR;
        PG8_STAGE(PG8_SB(1, 0), cB + kstep, voffB); PG8_STAGE(PG8_SA(1, 0), cA + kstep, voffA); PG8_STAGE(PG8_SB(1, 1), cB + hstep + kstep, voffB);
        PG8_WAIT_V(6); PG8_BAR;
    }
    for (;;) {
        const bool has_next = S.next(ui + 1, nxt);
        const char* nA = has_next ? (const char*)g.A + (size_t)nxt.pm * tstep : cA; const char* nB = has_next ? (const char*)g.Bt + (size_t)nxt.pn * tstep : cB;
        for (int t = 0; t < nt; t += 2) {
            const bool last = (t == nt - 2);
            const char* a1 = cA + (size_t)(t + 1) * kstep;
            const char* a2 = last ? nA : cA + (size_t)(t + 2) * kstep; const char* b2 = last ? nB : cB + (size_t)(t + 2) * kstep;
            const char* a3 = a2 + kstep; const char* b3 = b2 + kstep;
            if (last && has_next) S.a_ready(nxt);
            if constexpr (SP2) {
            PG8_LDB(B0, 0, 0); PG8_LDB(B1, 0, 1); PG8_SCHED; PG8_LDA(At, 0, 0); PG8_STAGE(PG8_SA(1, 1), a1 + hstep, voffA);
            PG8_WAIT_V(8); PG8_WAIT_L(0); PG8_BAR; PG8_MMA(0, 0, At, B0); PG8_MMA(0, 1, At, B1); PG8_BAR; PG8_SCHED;
            PG8_LDA(At, 0, 1); PG8_STAGE(PG8_SB(0, 0), b2, voffB); PG8_STAGE(PG8_SB(0, 1), b2 + hstep, voffB); PG8_STAGE(PG8_SA(0, 0), a2, voffA);
            PG8_WAIT_V(8); PG8_WAIT_L(0); PG8_BAR; PG8_MMA(1, 0, At, B0); PG8_MMA(1, 1, At, B1); PG8_BAR; PG8_SCHED;
            PG8_LDB(B0, 1, 0); PG8_LDB(B1, 1, 1); PG8_SCHED; PG8_LDA(At, 1, 0); PG8_STAGE(PG8_SA(0, 1), a2 + hstep, voffA);
            PG8_WAIT_V(8); PG8_WAIT_L(0); PG8_BAR; PG8_MMA(0, 0, At, B0); PG8_MMA(0, 1, At, B1); PG8_BAR; PG8_SCHED;
            PG8_LDA(At, 1, 1); PG8_STAGE(PG8_SB(1, 0), b3, voffB); PG8_STAGE(PG8_SB(1, 1), b3 + hstep, voffB); PG8_STAGE(PG8_SA(1, 0), a3, voffA);
            PG8_WAIT_V(8); PG8_WAIT_L(0); PG8_BAR; PG8_MMA(1, 0, At, B0); PG8_MMA(1, 1, At, B1); PG8_BAR; PG8_SCHED;
            } else {
            PG8_LDB(B0, 0, 0); PG8_SCHED; PG8_LDA(At, 0, 0); PG8_STAGE(PG8_SA(1, 1), a1 + hstep, voffA);
            PG8_WAIT_L(8); PG8_BAR; PG8_WAIT_L(0); PG8_MMA(0, 0, At, B0); PG8_BAR; PG8_SCHED;
            PG8_LDB(B1, 0, 1); PG8_STAGE(PG8_SB(0, 0), b2, voffB);
            PG8_BAR; PG8_WAIT_L(0); PG8_MMA(0, 1, At, B1); PG8_BAR;
            PG8_LDA(At, 0, 1); PG8_STAGE(PG8_SA(0, 0), a2, voffA);
            PG8_BAR; PG8_WAIT_L(0); PG8_MMA(1, 0, At, B0); PG8_BAR; PG8_SCHED;
            PG8_STAGE(PG8_SB(0, 1), b2 + hstep, voffB);
            PG8_WAIT_V(6); PG8_BAR; PG8_MMA(1, 1, At, B1); PG8_BAR;
            PG8_LDB(B0, 1, 0); PG8_SCHED; PG8_LDA(At, 1, 0); PG8_STAGE(PG8_SA(0, 1), a2 + hstep, voffA);
            PG8_WAIT_L(8); PG8_BAR; PG8_WAIT_L(0); PG8_MMA(0, 0, At, B0); PG8_BAR; PG8_SCHED;
            PG8_LDB(B1, 1, 1); PG8_STAGE(PG8_SB(1, 0), b3, voffB);
            PG8_BAR; PG8_WAIT_L(0); PG8_MMA(0, 1, At, B1); PG8_BAR;
            PG8_LDA(At, 1, 1); PG8_STAGE(PG8_SA(1, 0), a3, voffA);
            PG8_BAR; PG8_WAIT_L(0); PG8_MMA(1, 0, At, B0); PG8_BAR; PG8_SCHED;
            PG8_STAGE(PG8_SB(1, 1), b3 + hstep, voffB);
            PG8_WAIT_V(6); PG8_BAR; PG8_MMA(1, 1, At, B1); PG8_BAR;
            }
        }
        if constexpr (ALIGN_EPI) { if (wr == 0) PG8_BAR; }
        if constexpr (!Epi::AFTER_DRAIN) { E(acc, cur, wr, wc, fr, fq); S.done(cur); }
        if (!has_next) break;
#pragma unroll
        for (int a = 0; a < 2; ++a)
#pragma unroll
            for (int b = 0; b < 2; ++b)
#pragma unroll
                for (int m = 0; m < 4; ++m)
#pragma unroll
                    for (int n = 0; n < 2; ++n) acc[a][b][m][n] = (f32x4){0.f, 0.f, 0.f, 0.f};
        cur = nxt; cA = nA; cB = nB; ++ui;
        if constexpr (ALIGN_EPI) { if (wr == 1) PG8_BAR; }
    }
    PG8_WAIT_V(0);
    if constexpr (!ALIGN_EPI) { if (wr == 0) PG8_BAR; }
    PG8_BAR;
    if constexpr (Epi::AFTER_DRAIN) { E.fused(acc, cur, wr, wc, fr, fq, lds, wid, lane); S.done(cur); }
#undef PG8_SA
#undef PG8_SB
#undef PG8_STAGE
#undef PG8_LDA
#undef PG8_LDB
#undef PG8_MMA
#undef PG8_WAIT_V
#undef PG8_WAIT_L
#undef PG8_BAR
#undef PG8_SCHED
}
}
typedef __bf16 bf16x2_t __attribute__((ext_vector_type(2)));
__device__ __forceinline__ unsigned cvt_pk(float lo, float hi) { float __attribute__((ext_vector_type(2))) v = {lo, hi}; bf16x2_t b = __builtin_convertvector(v, bf16x2_t); return __builtin_bit_cast(unsigned, b); }
#define LAS __attribute__((address_space(3)))
#define XB_TMO      128
#define XB_XCNT(j)  (256  + 64 * (j))
#define XB_XSUB(j)  (1280 + 64 * (j))
#define XB_XGEN(j)  (2304 + 64 * (j))
#define XB_TOP      3328
#define XB_TOPGEN   3392
#define XCD_BAR_WORDS 3456
#define XB_SPIN_CAP (1u << 18)

__device__ __forceinline__ unsigned xb_ld(unsigned* p)              { return __hip_atomic_load(p, __ATOMIC_RELAXED, __HIP_MEMORY_SCOPE_AGENT); }
__device__ __forceinline__ unsigned xb_add(unsigned* p, unsigned v) { return __hip_atomic_fetch_add(p, v, __ATOMIC_RELAXED, __HIP_MEMORY_SCOPE_AGENT); }
__device__ __forceinline__ unsigned xb_xcc_id() { return (unsigned)__builtin_amdgcn_s_getreg((3 << 11) | 20) & 0xFu; }
#define XB_SPIN(cond, bar) do { unsigned _sp = 0; while (cond) { __builtin_amdgcn_s_sleep(1); \
    if ((++_sp & 255u) == 0u) { if (xb_ld(&(bar)[XB_TMO])) break; if (_sp > XB_SPIN_CAP) { atomicAdd(&(bar)[XB_TMO], 1u); break; } } } } while (0)

struct XcdBarrier {
    unsigned* bar; unsigned x;
    volatile LAS unsigned* st;
};

__device__ __forceinline__ XcdBarrier xcd_barrier_post(unsigned* bar, volatile LAS unsigned* st) {
    XcdBarrier b; b.bar = bar; b.x = xb_xcc_id(); b.st = st;
    if (threadIdx.x == 0) (void)xb_add(&bar[XB_XCNT(b.x)], 1u);
    return b;
}
__device__ __forceinline__ void xcd_barrier_complete(unsigned* bar, unsigned x, unsigned& nloc, unsigned& nx) {
    const unsigned G = gridDim.x * gridDim.y * gridDim.z;
    unsigned sum, cnt, mine, sp = 0u;
    for (;;) {
        sum = 0u; cnt = 0u; mine = 0u;
#pragma unroll
        for (unsigned j = 0; j < 16; ++j) { const unsigned c = xb_ld(&bar[XB_XCNT(j)]); sum += c; cnt += (c > 0u) ? 1u : 0u; mine = (j == x) ? c : mine; }
        if (sum == G) break;
        __builtin_amdgcn_s_sleep(1);
        if ((++sp & 255u) == 0u) { if (xb_ld(&bar[XB_TMO])) break; if (sp > XB_SPIN_CAP) { atomicAdd(&bar[XB_TMO], 1u); break; } }
    }
    nloc = mine > 0u ? mine : 1u; nx = cnt > 0u ? cnt : 1u;
}

__device__ __forceinline__ void xcd_barrier(const XcdBarrier& b) {
    asm volatile("s_waitcnt vmcnt(0)" ::: "memory");
    __syncthreads();
    if (threadIdx.x == 0) {
        unsigned* bar = b.bar;
        __builtin_amdgcn_s_waitcnt(0);
        unsigned nloc = b.st[0], nx = b.st[1];
        if (nloc == 0u) { xcd_barrier_complete(bar, b.x, nloc, nx); b.st[0] = nloc; b.st[1] = nx; }
        const unsigned old = xb_add(&bar[XB_XSUB(b.x)], 1u);
        const unsigned gen = old / nloc;
        if (old + 1u == (gen + 1u) * nloc) {
            __builtin_amdgcn_fence(__ATOMIC_RELEASE, "agent");
            asm volatile("s_waitcnt vmcnt(0)" ::: "memory");
            const unsigned og = xb_add(&bar[XB_TOP], 1u);
            const unsigned tg = og / nx;
            if (og + 1u == (tg + 1u) * nx) xb_add(&bar[XB_TOPGEN], 1u);
            else XB_SPIN(xb_ld(&bar[XB_TOPGEN]) == tg, bar);
            __builtin_amdgcn_fence(__ATOMIC_ACQUIRE, "agent");
            xb_add(&bar[XB_XGEN(b.x)], 1u);
            asm volatile("s_waitcnt vmcnt(0)" ::: "memory");
        } else {
            XB_SPIN(xb_ld(&bar[XB_XGEN(b.x)]) == gen, bar);
            __builtin_amdgcn_fence(__ATOMIC_ACQUIRE, "agent");
            asm volatile("s_waitcnt vmcnt(0)" ::: "memory");
        }
    }
    __syncthreads();
}
typedef unsigned short bf16_t;
typedef short bf16x8 __attribute__((ext_vector_type(8)));
typedef short s16x4 __attribute__((ext_vector_type(4)));
typedef float f32x16 __attribute__((ext_vector_type(16)));
typedef float f32x4 __attribute__((ext_vector_type(4)));
typedef float f32x2 __attribute__((ext_vector_type(2)));
typedef unsigned u32x4 __attribute__((ext_vector_type(4)));
typedef unsigned u32x2 __attribute__((ext_vector_type(2)));

constexpr int DM = 1024, DIN = 4352, DFF = 2816, DUP = 2 * DFF, DEPTH = 2;
constexpr int CH_ROWS = 16384, NCHUNK = 3;
constexpr int TW = 2064;
constexpr int T_A = 0, T_B = 256, T_C = 1280, T_L = 2048;
constexpr float LOG2E = 1.4426950408889634f, LN2 = 0.6931471805599453f;
constexpr float QSCALE = 0.125f * LOG2E;
constexpr size_t MiB = 1u << 20;
constexpr size_t WS_WIN = 0, WS_WOUT = 18 * MiB, WS_WUP = 22 * MiB, WS_WDN = 44 * MiB, WS_HB = 56 * MiB, WS_PROJ = 88 * MiB, WS_TMP = 264 * MiB, WS_CTL = 394 * MiB, WS_XB = 395 * MiB, WS_SSQ = 427 * MiB, WS_END = 428 * MiB;
constexpr int LDS_BYTES = 147456 + 256;
constexpr int NTHREADS = 512;

struct Args { const float* in[17]; float* out; unsigned char* ws; };

__device__ __forceinline__ float wave_sum(float v) {
#pragma unroll
    for (int o = 1; o < 64; o <<= 1) v += __shfl_xor(v, o);
    return v;
}
__device__ __forceinline__ unsigned f2bf(float f) { unsigned u = __builtin_bit_cast(unsigned, f); return (u + 0x7fffu + ((u >> 16) & 1u)) >> 16; }
__device__ __forceinline__ unsigned pk2(float lo, float hi) { return f2bf(lo) | (f2bf(hi) << 16); }
__device__ __forceinline__ float bf2f(unsigned short b) { return __builtin_bit_cast(float, (unsigned)b << 16); }

__device__ __forceinline__ void transpose_item(const float* W, int K, int N, bf16_t* WT, LAS float* scr, int item, int lane, const float* gain) {
    const int nblk = N / 32, kb = item / nblk, nb = item % nblk, k0 = 64 * kb, n0 = 32 * nb;
#pragma unroll 8
    for (int i = 0; i < 32; ++i) { const int kk = 2 * i + (lane >> 5); scr[kk * 33 + (lane & 31)] = W[(size_t)(k0 + kk) * N + n0 + (lane & 31)] * (gain ? gain[k0 + kk] : 1.f); }
    asm volatile("s_waitcnt lgkmcnt(0)" ::: "memory");
    const int c = lane & 7;
#pragma unroll
    for (int j = 0; j < 4; ++j) { const int n = (lane >> 3) + 8 * j; const LAS float* s = scr + (8 * c) * 33 + n;
        u32x4 o; o.x = pk2(s[0 * 33], s[1 * 33]); o.y = pk2(s[2 * 33], s[3 * 33]); o.z = pk2(s[4 * 33], s[5 * 33]); o.w = pk2(s[6 * 33], s[7 * 33]);
        *(u32x4*)(WT + (size_t)(n0 + n) * K + k0 + 8 * c) = o; }
    asm volatile("s_waitcnt lgkmcnt(0)" ::: "memory");
}

__device__ __forceinline__ void rms_row_to_bf16(const float* xrow, const float* gain, bf16_t* orow, int lane) {
    const f32x4* xr = (const f32x4*)xrow + lane; const f32x4* gr = (const f32x4*)gain + lane;
    f32x4 v[4]; float s = 0.f;
#pragma unroll
    for (int j = 0; j < 4; ++j) { v[j] = xr[64 * j]; s += (v[j].x * v[j].x + v[j].y * v[j].y) + (v[j].z * v[j].z + v[j].w * v[j].w); }
    const float rstd = 1.f / sqrtf(wave_sum(s) * (1.f / DM) + 1e-6f);
    u32x2* o8 = (u32x2*)orow + lane;
#pragma unroll
    for (int j = 0; j < 4; ++j) { const f32x4 g = gr[64 * j]; u32x2 w; w.x = pk2(v[j].x * rstd * g.x, v[j].y * rstd * g.y); w.y = pk2(v[j].z * rstd * g.z, v[j].w * rstd * g.w); o8[64 * j] = w; }
}
__device__ __forceinline__ void rms_row_f32(float* xrow, const float* gain, int lane) {
    f32x4* xr = (f32x4*)xrow + lane; const f32x4* gr = (const f32x4*)gain + lane;
    f32x4 v[4]; float s = 0.f;
#pragma unroll
    for (int j = 0; j < 4; ++j) { v[j] = xr[64 * j]; s += (v[j].x * v[j].x + v[j].y * v[j].y) + (v[j].z * v[j].z + v[j].w * v[j].w); }
    const float rstd = 1.f / sqrtf(wave_sum(s) * (1.f / DM) + 1e-6f);
#pragma unroll
    for (int j = 0; j < 4; ++j) { const f32x4 g = gr[64 * j]; xr[64 * j] = v[j] * rstd * g; }
}

constexpr int KSTR = 144;
constexpr int ATT_K_OFF = 0, ATT_V_OFF = 2 * 64 * KSTR, ATT_SCR_OFF = ATT_V_OFF + 2 * 64 * 320;
__device__ __forceinline__ int crow(int r, int hi) { return (r & 3) + 8 * (r >> 2) + 4 * hi; }
typedef short v4i16_t __attribute__((ext_vector_type(4)));
__device__ __forceinline__ s16x4 vtr(const LAS unsigned char* p) { return __builtin_bit_cast(s16x4, __builtin_amdgcn_ds_read_tr16_b64_v4i16((LAS v4i16_t*)p)); }

template <int VD, bool WIN>
__device__ __forceinline__ void attn_unit(LAS unsigned char* lds, const bf16_t* Qp, const bf16_t* Kp, const bf16_t* Vp, size_t pitch,
                                          int q0, int L, float slope2, int W, float m_init, float l_init,
                                          float* Oout, size_t opitch, float* lse_out, size_t lpitch, bf16_t* Obf) {
    constexpr int VSTR = VD * 2 + 64, ND = VD / 32, VCH = VD / 8, VLD = 64 * VCH / NTHREADS;
    int tid_l = threadIdx.x; asm volatile("" : "+v"(tid_l)); const int tid = tid_l, lane = tid & 63, r32 = lane & 31, hi = lane >> 5, wid = __builtin_amdgcn_readfirstlane(tid >> 6);
    const int qw = q0 + wid * 32;
    int tlo = 0, thi = L / 64;
    if (WIN) { const int a = q0 - W; tlo = a > 0 ? a / 64 : 0; const int b = q0 + 256 + W; thi = (b < L ? b : L) / 64; }
    bf16x8 qr[4];
    { const bf16_t* qrow = Qp + (size_t)(qw + r32) * pitch + hi * 8;
#pragma unroll
      for (int d0 = 0; d0 < 4; ++d0) qr[d0] = *(const bf16x8*)(qrow + d0 * 16); }
    f32x16 o[ND];
#pragma unroll
    for (int d = 0; d < ND; ++d)
#pragma unroll
        for (int r = 0; r < 16; ++r) o[d][r] = 0.f;
    float m = m_init, l = hi == 0 ? l_init : 0.f;
    LAS float* wsf = (LAS float*)(lds + ATT_SCR_OFF) + wid * 64;
    const int krow = tid >> 3, kch = tid & 7;
    u32x4 kreg; u32x4 vreg[VLD];
#define ATT_GLOAD(t) do { kreg = *(const u32x4*)(Kp + (size_t)(64 * (t) + krow) * pitch + kch * 8); \
        _Pragma("unroll") for (int i_ = 0; i_ < VLD; ++i_) { const int idx_ = tid + NTHREADS * i_; vreg[i_] = *(const u32x4*)(Vp + (size_t)(64 * (t) + idx_ / VCH) * pitch + (idx_ % VCH) * 8); } } while (0)
#define ATT_LSTORE(b) do { *(LAS u32x4*)(lds + ATT_K_OFF + (b) * 64 * KSTR + krow * KSTR + kch * 16) = kreg; \
        _Pragma("unroll") for (int i_ = 0; i_ < VLD; ++i_) { const int idx_ = tid + NTHREADS * i_; *(LAS u32x4*)(lds + ATT_V_OFF + (b) * 64 * VSTR + (idx_ / VCH) * VSTR + (idx_ % VCH) * 16) = vreg[i_]; } } while (0)
    const int n = thi - tlo;
    ATT_GLOAD(tlo); ATT_LSTORE(0); __syncthreads();
    const float Wf = (float)W;
    for (int i = 0; i < n; ++i) {
        const int t = tlo + i, buf = i & 1;
        if (i + 1 < n) ATT_GLOAD(t + 1);
        bool active = true;
        if (WIN) { const int kb = 64 * t; active = (kb + 63 >= qw - W) && (kb <= qw + 31 + W); }
        if (active) {
            const LAS unsigned char* Kb = lds + ATT_K_OFF + buf * 64 * KSTR + r32 * KSTR + hi * 16;
            f32x16 p0, p1;
#pragma unroll
            for (int r = 0; r < 16; ++r) { p0[r] = 0.f; p1[r] = 0.f; }
#pragma unroll
            for (int d0 = 0; d0 < 4; ++d0) {
                const bf16x8 a0 = *(const LAS bf16x8*)(Kb + d0 * 32), a1 = *(const LAS bf16x8*)(Kb + 32 * KSTR + d0 * 32);
                p0 = __builtin_amdgcn_mfma_f32_32x32x16_bf16(a0, qr[d0], p0, 0, 0, 0);
                p1 = __builtin_amdgcn_mfma_f32_32x32x16_bf16(a1, qr[d0], p1, 0, 0, 0);
                if (d0 & 1) __builtin_amdgcn_sched_barrier(0);
            }
            const float dq = (float)(64 * t + 4 * hi - (qw + r32));
            float rm = -INFINITY;
#pragma unroll
            for (int r = 0; r < 16; ++r) {
                const float t0 = dq + (float)((r & 3) + 8 * (r >> 2)), t1 = t0 + 32.f;
                p0[r] = __builtin_fmaf(-slope2, __builtin_fabsf(t0), p0[r]);
                p1[r] = __builtin_fmaf(-slope2, __builtin_fabsf(t1), p1[r]);
                if (WIN) { if (__builtin_fabsf(t0) > Wf) p0[r] = -INFINITY; if (__builtin_fabsf(t1) > Wf) p1[r] = -INFINITY; }
                rm = __builtin_fmaxf(rm, __builtin_fmaxf(p0[r], p1[r]));
            }
            rm = __builtin_fmaxf(rm, __shfl_xor(rm, 32));
            if (__any(rm > m)) {
                const float mn = __builtin_fmaxf(m, rm); const float f = __builtin_amdgcn_exp2f(m - mn); m = mn; l *= f;
                if (hi == 0) wsf[r32] = f;
#pragma unroll
                for (int r = 0; r < 16; ++r) { const float fr = wsf[crow(r, hi)];
#pragma unroll
                    for (int d = 0; d < ND; ++d) o[d][r] *= fr; }
            }
            float ls = 0.f;
#pragma unroll
            for (int r = 0; r < 16; ++r) { p0[r] = __builtin_amdgcn_exp2f(p0[r] - m); p1[r] = __builtin_amdgcn_exp2f(p1[r] - m); ls += p0[r] + p1[r]; }
            l += ls;
            u32x4 pw[4];
#pragma unroll
            for (int c = 0; c < 4; ++c) {
                const f32x16& P = (c >> 1) ? p1 : p0; const int b = 8 * (c & 1);
                pw[c].x = cvt_pk(P[b + 0], P[b + 1]); pw[c].y = cvt_pk(P[b + 2], P[b + 3]); pw[c].z = cvt_pk(P[b + 4], P[b + 5]); pw[c].w = cvt_pk(P[b + 6], P[b + 7]);
            }
            const LAS unsigned char* Vb = lds + ATT_V_OFF + buf * 64 * VSTR + (4 * hi + ((lane & 15) >> 2)) * VSTR + (16 * ((lane >> 4) & 1) + 4 * (lane & 3)) * 2;
#pragma unroll
            for (int c = 0; c < 4; ++c)
#pragma unroll
                for (int d = 0; d < ND; ++d) {
                    const s16x4 vlo = vtr(Vb + c * 16 * VSTR + d * 64), vhi = vtr(Vb + c * 16 * VSTR + 8 * VSTR + d * 64);
                    const bf16x8 vf = (bf16x8){vlo[0], vlo[1], vlo[2], vlo[3], vhi[0], vhi[1], vhi[2], vhi[3]};
                    o[d] = __builtin_amdgcn_mfma_f32_32x32x16_bf16(__builtin_bit_cast(bf16x8, pw[c]), vf, o[d], 0, 0, 0);
                    if (d == ND - 1) __builtin_amdgcn_sched_barrier(0);
                }
        }
        if (i + 1 < n) ATT_LSTORE(buf ^ 1);
        __syncthreads();
    }
#undef ATT_GLOAD
#undef ATT_LSTORE
    l += __shfl_xor(l, 32);
    if (hi == 0) wsf[r32] = 1.f / l;
#pragma unroll
    for (int r = 0; r < 16; ++r) { const float ir = wsf[crow(r, hi)];
        if (Obf != nullptr) { bf16_t* orow = Obf + (size_t)(qw + crow(r, hi)) * opitch + r32;
#pragma unroll
            for (int d = 0; d < ND; ++d) orow[d * 32] = (bf16_t)f2bf(o[d][r] * ir);
        } else { float* orow = Oout + (size_t)(qw + crow(r, hi)) * opitch + r32;
#pragma unroll
            for (int d = 0; d < ND; ++d) orow[d * 32] = o[d][r] * ir; } }
    if (lse_out != nullptr && hi == 0) lse_out[(size_t)(qw + r32) * lpitch] = (m + __builtin_log2f(l)) * LN2;
    __syncthreads();
}

__device__ __forceinline__ void row_to_bf16_ssq(const float* xrow, bf16_t* orow, float* ssq, int lane) {
    const f32x4* xr = (const f32x4*)xrow + lane;
    f32x4 v[4]; float s = 0.f;
#pragma unroll
    for (int j = 0; j < 4; ++j) { v[j] = xr[64 * j]; s += (v[j].x * v[j].x + v[j].y * v[j].y) + (v[j].z * v[j].z + v[j].w * v[j].w); }
    s = wave_sum(s);
    u32x2* o8 = (u32x2*)orow + lane;
#pragma unroll
    for (int j = 0; j < 4; ++j) { u32x2 w; w.x = pk2(v[j].x, v[j].y); w.y = pk2(v[j].z, v[j].w); o8[64 * j] = w; }
    if (lane == 0) *ssq = s;
}
constexpr int BK_OFF = 0, BV_OFF = 2 * 64 * KSTR, BSCR_OFF = BV_OFF + 3 * 64 * 320, ATT_O0_OFF = BSCR_OFF + 2048;
static_assert(ATT_O0_OFF + 65536 <= 147456, "B attention LDS map");
constexpr float B_THR = 6.0f;
#ifndef B_LATE
#define B_LATE(w) false
#endif
__device__ __forceinline__ float max3f(float a, float b, float c) { float r; asm("v_max3_f32 %0, %1, %2, %3" : "=v"(r) : "v"(a), "v"(b), "v"(c)); return r; }
__device__ __forceinline__ void attn_b_unit(LAS unsigned char* lds, const bf16_t* base, int h, int q0, int L, float slope2_, float lam,
                                            const float* subln_l, float postscale, bf16_t* mix) {
    constexpr int VD = 128, VSTR = VD * 2 + 64, ND = 4, VCH = 16, VLD = 2;
    int tid_l = threadIdx.x; asm volatile("" : "+v"(tid_l)); const int tid = tid_l, lane = tid & 63, r32 = lane & 31, hi = lane >> 5, wid = __builtin_amdgcn_readfirstlane(tid >> 6);
    const int qw = q0 + wid * 32, NT = L / 64, c0 = q0 / 64;
    LAS float* wsf = (LAS float*)(lds + BSCR_OFF) + wid * 64;
    const bool late = B_LATE(wid);
    const int krow = tid >> 3, kch = tid & 7;
    const bf16_t* Vp = base + 1536 + h * 128;
    const float qposf_ = (float)(qw + r32);
    for (int mp = 0; mp < 2; ++mp) {
        const bf16_t* Qp = base + 512 + (h * 2 + mp) * 64; const bf16_t* Kp = base + 1024 + (h * 2 + mp) * 64;
        bf16x8 qr[4];
        { const bf16_t* qrow = Qp + (size_t)(qw + r32) * DIN + hi * 8;
#pragma unroll
          for (int d0 = 0; d0 < 4; ++d0) qr[d0] = *(const bf16x8*)(qrow + d0 * 16); }
        f32x16 o[ND];
#pragma unroll
        for (int d = 0; d < ND; ++d)
#pragma unroll
            for (int r = 0; r < 16; ++r) o[d][r] = 0.f;
        float mref = 0.f, l = 0.f;
        u32x4 kreg; u32x4 vreg[VLD];
        const unsigned koff = (unsigned)(krow * DIN + kch * 8) * 2u, voff = (unsigned)((tid >> 4) * DIN + (tid & 15) * 8) * 2u;
#define ATT_GLOAD(t) do { const char* kt_ = (const char*)Kp + (size_t)(t) * (64 * DIN * 2); const char* vt_ = (const char*)Vp + (size_t)(t) * (64 * DIN * 2); \
        kreg = *(const u32x4*)(kt_ + koff); vreg[0] = *(const u32x4*)(vt_ + voff); vreg[1] = *(const u32x4*)(vt_ + 32 * DIN * 2 + voff); } while (0)
#define ATT_LSTORE(b, vs) do { *(LAS u32x4*)(lds + BK_OFF + (b) * 64 * KSTR + krow * KSTR + kch * 16) = kreg; \
        *(LAS u32x4*)(lds + BV_OFF + (vs) * 64 * VSTR + (tid >> 4) * VSTR + (tid & 15) * 16) = vreg[0]; *(LAS u32x4*)(lds + BV_OFF + (vs) * 64 * VSTR + ((tid >> 4) + 32) * VSTR + (tid & 15) * 16) = vreg[1]; } while (0)
#define VFRAG(x, d) (bf16x8){x[d][0][0], x[d][0][1], x[d][0][2], x[d][0][3], x[d][1][0], x[d][1][1], x[d][1][2], x[d][1][3]}
#define PV_LOAD01(vs) do { \
        const LAS unsigned char* Vb = lds + BV_OFF + (vs) * 64 * VSTR + (4 * hi + ((lane & 15) >> 2)) * VSTR + (16 * ((lane >> 4) & 1) + 4 * (lane & 3)) * 2; \
        _Pragma("unroll") for (int d = 0; d < ND; ++d) { va[d][0] = vtr(Vb + d * 64); va[d][1] = vtr(Vb + 8 * VSTR + d * 64); } \
        _Pragma("unroll") for (int d = 0; d < ND; ++d) { vb2[d][0] = vtr(Vb + 16 * VSTR + d * 64); vb2[d][1] = vtr(Vb + 16 * VSTR + 8 * VSTR + d * 64); } \
        __builtin_amdgcn_sched_barrier(0); } while (0)
#define PV_MMA(vs) do { \
        const LAS unsigned char* Vb = lds + BV_OFF + (vs) * 64 * VSTR + (4 * hi + ((lane & 15) >> 2)) * VSTR + (16 * ((lane >> 4) & 1) + 4 * (lane & 3)) * 2; \
        _Pragma("unroll") for (int d = 0; d < ND; ++d) o[d] = __builtin_amdgcn_mfma_f32_32x32x16_bf16(__builtin_bit_cast(bf16x8, pw[0]), VFRAG(va, d), o[d], 0, 0, 0); \
        __builtin_amdgcn_sched_barrier(0); \
        _Pragma("unroll") for (int d = 0; d < ND; ++d) { va[d][0] = vtr(Vb + 32 * VSTR + d * 64); va[d][1] = vtr(Vb + 32 * VSTR + 8 * VSTR + d * 64); } \
        __builtin_amdgcn_sched_barrier(0); \
        _Pragma("unroll") for (int d = 0; d < ND; ++d) o[d] = __builtin_amdgcn_mfma_f32_32x32x16_bf16(__builtin_bit_cast(bf16x8, pw[1]), VFRAG(vb2, d), o[d], 0, 0, 0); \
        __builtin_amdgcn_sched_barrier(0); \
        _Pragma("unroll") for (int d = 0; d < ND; ++d) { vb2[d][0] = vtr(Vb + 48 * VSTR + d * 64); vb2[d][1] = vtr(Vb + 48 * VSTR + 8 * VSTR + d * 64); } \
        __builtin_amdgcn_sched_barrier(0); \
        _Pragma("unroll") for (int d = 0; d < ND; ++d) o[d] = __builtin_amdgcn_mfma_f32_32x32x16_bf16(__builtin_bit_cast(bf16x8, pw[2]), VFRAG(va, d), o[d], 0, 0, 0); \
        _Pragma("unroll") for (int d = 0; d < ND; ++d) o[d] = __builtin_amdgcn_mfma_f32_32x32x16_bf16(__builtin_bit_cast(bf16x8, pw[3]), VFRAG(vb2, d), o[d], 0, 0, 0); \
        __builtin_amdgcn_sched_barrier(0); } while (0)
        int first = 1; asm volatile("" : "+s"(first));
#define B_TILE(i_) ((i_) < 4 ? c0 + (i_) : ((i_) - 4 < c0 ? (i_) - 4 : (i_)))
        int t = B_TILE(0);
        int vs_prev = 2, vs_cur = 0, vs_next = 1;
        u32x4 pw[4];
        ATT_GLOAD(t); ATT_LSTORE(0, 0); __syncthreads();
        for (int i = 0; i < NT; ++i) {
            const int buf = i & 1;
            int tn = 0;
            if (i + 1 < NT) { tn = B_TILE(i + 1); ATT_GLOAD(tn); }
            s16x4 va[ND][2], vb2[ND][2];
            if (late && !first) { PV_LOAD01(vs_prev); PV_MMA(vs_prev); }
            f32x16 p0, p1;
            const int kb = 64 * t;
            float slope2 = slope2_, qposf = qposf_; asm volatile("" : "+v"(slope2), "+v"(qposf));
            if (kb + 63 < qw || kb > qw + 31) {
                const float sg = (kb > qw) ? -slope2 : slope2;
                const float b0 = sg * ((float)(kb + 4 * hi) - qposf) - mref, b1 = b0 + 32.f * sg;
#pragma unroll
                for (int r = 0; r < 16; ++r) { const float kv = (float)((r & 3) + 8 * (r >> 2)); p0[r] = __builtin_fmaf(sg, kv, b0); p1[r] = __builtin_fmaf(sg, kv, b1); }
            } else {
                const float dq = (float)(kb + 4 * hi) - qposf;
#pragma unroll
                for (int r = 0; r < 16; ++r) { const float t0 = dq + (float)((r & 3) + 8 * (r >> 2)); p0[r] = __builtin_fmaf(-slope2, __builtin_fabsf(t0), -mref); p1[r] = __builtin_fmaf(-slope2, __builtin_fabsf(t0 + 32.f), -mref); }
            }
            const LAS unsigned char* Kb = lds + BK_OFF + buf * 64 * KSTR + r32 * KSTR + hi * 16;
            bf16x8 kf[8];
#pragma unroll
            for (int d0 = 0; d0 < 4; ++d0) { kf[2 * d0] = *(const LAS bf16x8*)(Kb + d0 * 32); kf[2 * d0 + 1] = *(const LAS bf16x8*)(Kb + 32 * KSTR + d0 * 32); }
            __builtin_amdgcn_sched_barrier(0);
#pragma unroll
            for (int d0 = 0; d0 < 4; ++d0) {
                p0 = __builtin_amdgcn_mfma_f32_32x32x16_bf16(kf[2 * d0], qr[d0], p0, 0, 0, 0);
                p1 = __builtin_amdgcn_mfma_f32_32x32x16_bf16(kf[2 * d0 + 1], qr[d0], p1, 0, 0, 0);
            }
            if (!late) PV_LOAD01(vs_cur);
            asm volatile("s_nop 15\n\ts_nop 7" : "+v"(p0), "+v"(p1));
            float rm = max3f(p0[0], p1[0], p0[1]);
#pragma unroll
            for (int r = 1; r < 15; ++r) rm = max3f(rm, p1[r], p0[r + 1]);
            rm = max3f(rm, p1[15], rm);
            rm = max3f(rm, __shfl_xor(rm, 32), rm);
            if (first || __any(rm > B_THR)) {
                const float delta = (first || rm > B_THR) ? rm : 0.f; const float f = __builtin_amdgcn_exp2f(-delta); mref += delta; l *= f;
#pragma unroll
                for (int r = 0; r < 16; ++r) { p0[r] -= delta; p1[r] -= delta; }
                {
                    if (hi == 0) wsf[r32] = f;
#pragma unroll
                    for (int r = 0; r < 16; ++r) { const float fr = wsf[crow(r, hi)];
#pragma unroll
                        for (int d = 0; d < ND; ++d) o[d][r] *= fr; }
                }
            }
            float ls0 = 0.f, ls1 = 0.f;
#pragma unroll
            for (int r = 0; r < 16; ++r) { p0[r] = __builtin_amdgcn_exp2f(p0[r]); p1[r] = __builtin_amdgcn_exp2f(p1[r]); ls0 += p0[r]; ls1 += p1[r]; }
            l += ls0 + ls1;
#pragma unroll
            for (int c = 0; c < 4; ++c) {
                const f32x16& P = (c >> 1) ? p1 : p0; const int b = 8 * (c & 1);
                pw[c].x = cvt_pk(P[b + 0], P[b + 1]); pw[c].y = cvt_pk(P[b + 2], P[b + 3]); pw[c].z = cvt_pk(P[b + 4], P[b + 5]); pw[c].w = cvt_pk(P[b + 6], P[b + 7]);
            }
            __builtin_amdgcn_sched_barrier(0);
            if (!late) PV_MMA(vs_cur);
            first = 0;
            if (i + 1 < NT) ATT_LSTORE(buf ^ 1, vs_next);
            t = tn;
            { const int tmp_ = vs_prev; vs_prev = vs_cur; vs_cur = vs_next; vs_next = tmp_; }
            __syncthreads();
        }
        if (late) { s16x4 va[ND][2], vb2[ND][2]; PV_LOAD01(vs_prev); PV_MMA(vs_prev); }
#undef PV_LOAD01
#undef PV_MMA
#undef B_TILE
#undef VFRAG
#undef ATT_GLOAD
#undef ATT_LSTORE
        l += __shfl_xor(l, 32);
        if (hi == 0) wsf[r32] = 1.f / l;
        int lane_e = lane, qw_e = qw; asm volatile("" : "+v"(lane_e)); asm volatile("" : "+s"(qw_e));
        const int r32 = lane_e & 31, hi = lane_e >> 5, qw = qw_e;
        LAS unsigned* o0buf = (LAS unsigned*)(lds + ATT_O0_OFF) + wid * 2048 + lane_e;
        if (mp == 0) {
#pragma unroll
            for (int d = 0; d < ND; ++d)
#pragma unroll
                for (int r = 0; r < 16; r += 2) { const float i0 = wsf[crow(r, hi)], i1 = wsf[crow(r + 1, hi)]; o0buf[(d * 8 + (r >> 1)) * 64] = cvt_pk(o[d][r] * i0, o[d][r + 1] * i1); }
        } else {
            float gs[ND];
#pragma unroll
            for (int d = 0; d < ND; ++d) gs[d] = subln_l[d * 32 + r32] * postscale;
#pragma unroll
            for (int r = 0; r < 16; r += 2) {
                const float i0 = wsf[crow(r, hi)], i1 = wsf[crow(r + 1, hi)];
                float v0[ND], v1[ND]; float s0 = 0.f, s1 = 0.f;
#pragma unroll
                for (int d = 0; d < ND; ++d) { const unsigned w = o0buf[(d * 8 + (r >> 1)) * 64];
                    v0[d] = __builtin_bit_cast(float, w << 16) - lam * (o[d][r] * i0); v1[d] = __builtin_bit_cast(float, w & 0xffff0000u) - lam * (o[d][r + 1] * i1);
                    s0 += v0[d] * v0[d]; s1 += v1[d] * v1[d]; }
#pragma unroll
                for (int sh = 1; sh < 32; sh <<= 1) { s0 += __shfl_xor(s0, sh); s1 += __shfl_xor(s1, sh); }
                const float r0 = 1.f / sqrtf(s0 * (1.f / 128.f) + 1e-5f), r1 = 1.f / sqrtf(s1 * (1.f / 128.f) + 1e-5f);
                bf16_t* row0 = mix + (size_t)(qw + crow(r, hi)) * DM + r32; bf16_t* row1 = mix + (size_t)(qw + crow(r + 1, hi)) * DM + r32;
#pragma unroll
                for (int d = 0; d < ND; ++d) { row0[d * 32] = (bf16_t)f2bf(v0[d] * r0 * gs[d]); row1[d * 32] = (bf16_t)f2bf(v1[d] * r1 * gs[d]); }
            }
        }
        __syncthreads();
    }
}
__device__ __forceinline__ float alibi_slope(int i, int n) { return exp2f(-8.0f * (float)(i + 1) / (float)n); }
struct Ctx { int tid, lane, wave, G, cu, gw, NGW; };

__device__ __forceinline__ void ph_weights(const Args& a, const Ctx& c, LAS unsigned char* lds) {
    unsigned char* ws = a.ws;
    bf16_t* WinT = (bf16_t*)(ws + WS_WIN); bf16_t* WoutT = (bf16_t*)(ws + WS_WOUT); bf16_t* WupT = (bf16_t*)(ws + WS_WUP); bf16_t* WdnT = (bf16_t*)(ws + WS_WDN);
    const float* w_in = a.in[3]; const float* w_out = a.in[10]; const float* w_up = a.in[12]; const float* w_down = a.in[15];
    LAS float* scr = (LAS float*)(lds + c.wave * 16384);
    constexpr int I_IN = (DM / 64) * (DIN / 32), I_OUT = (DM / 64) * (DM / 32), I_UP = (DM / 64) * (DUP / 32), I_DN = (DFF / 64) * (DM / 32);
    constexpr int PER_L = I_IN + I_OUT + I_UP + I_DN;
    for (int it = c.gw; it < DEPTH * PER_L; it += c.NGW) {
        const int l = it / PER_L; int r = it % PER_L;
        if (r < I_IN) { transpose_item(w_in + (size_t)l * DM * DIN, DM, DIN, WinT + (size_t)l * DIN * DM, scr, r, c.lane, a.in[2] + l * DM); continue; } r -= I_IN;
        if (r < I_OUT) { transpose_item(w_out + (size_t)l * DM * DM, DM, DM, WoutT + (size_t)l * DM * DM, scr, r, c.lane, nullptr); continue; } r -= I_OUT;
        if (r < I_UP) { transpose_item(w_up + (size_t)l * DM * DUP, DM, DUP, WupT + (size_t)l * DUP * DM, scr, r, c.lane, a.in[11] + l * DM); continue; } r -= I_UP;
        transpose_item(w_down + (size_t)l * DFF * DM, DFF, DM, WdnT + (size_t)l * DM * DFF, scr, r, c.lane, nullptr);
    }
}
__device__ __forceinline__ const float* chunk_in(const Args& a, int ch) { return ch == 0 ? a.in[0] : a.in[1] + (size_t)(ch - 1) * CH_ROWS * DM; }
__device__ __forceinline__ float* chunk_out(const Args& a, int ch) { return a.out + (size_t)ch * CH_ROWS * DM; }

__device__ __forceinline__ void ph_norm_bf16(const Ctx& c, const float* xsrc, const float* gain, bf16_t* HB) {
    for (int r = c.gw; r < CH_ROWS; r += c.NGW) rms_row_to_bf16(xsrc + (size_t)r * DM, gain, HB + (size_t)r * DM, c.lane);
}
__device__ __forceinline__ void ph_final_norm(const Ctx& c, float* xo, const float* gain) {
    for (int r = c.gw; r < CH_ROWS; r += c.NGW) rms_row_f32(xo + (size_t)r * DM, gain, c.lane);
}

__device__ __forceinline__ void ph_attn(const Args& a, const Ctx& c, LAS unsigned char* lds, int ch, int layer) {
    const bf16_t* PROJ = (const bf16_t*)(a.ws + WS_PROJ); float* TMP = (float*)(a.ws + WS_TMP);
    const int SL = ch == 0 ? 16384 : 4096, sl_shift = ch == 0 ? 14 : 12;
    const int cu = c.cu, G = c.G;
#ifndef SKIP_B
    {
        const float lam_init = layer == 0 ? 0.2f : (0.8f - 0.6f * 0.7408182206817179f);
        const float s1 = wave_sum(a.in[5][layer * 64 + c.lane] * a.in[6][layer * 64 + c.lane]);
        const float s2 = wave_sum(a.in[7][layer * 64 + c.lane] * a.in[8][layer * 64 + c.lane]);
        const float lam = expf(s1) - expf(s2) + lam_init;
        bf16_t* HBm = (bf16_t*)(a.ws + WS_HB);
#ifdef PROBE_B2
        for (int rep_ = 0; rep_ < 2; ++rep_)
#endif
        for (int u = cu; u < 256; u += G) {
            int seq, h, qb; const int xcd = u & 7, idx = u >> 3;
            if (ch == 0) { seq = 0; h = xcd >> 1; qb = (xcd & 1) * 32 + idx; }
            else { const int pair = xcd * 2 + (idx >> 4); seq = pair >> 2; h = pair & 3; qb = idx & 15; }
            const size_t rb = (size_t)seq * SL;
            attn_b_unit(lds, PROJ + rb * DIN, h, qb * 256, SL, alibi_slope(h, 4) * LOG2E, lam, a.in[9] + layer * 128, 1.f - lam_init, HBm + rb * DM + 256 + h * 128);
        }
    }
#endif
#ifndef SKIP_AC
#ifdef PROBE_AC2
    for (int rep_ = 0; rep_ < 2; ++rep_)
#endif
    for (int uu = cu; uu < 1024; uu += G) {
        const bf16_t *qp, *kp, *vp; size_t pitch, opitch, lpitch; int q0, L, W; float slope2, m_init, l_init; float *op, *lp; bf16_t* obf;
        if (uu < 256) {
            const int hq = uu >> 6, blk = uu & 63;
            const int seq = (blk * 256) >> sl_shift, qb = blk - ((seq << sl_shift) >> 8);
            const size_t rb = (size_t)seq * SL; const bf16_t* base = PROJ + rb * DIN;
            qp = base + hq * 64; kp = base + 256 + (hq >> 1) * 64; vp = base + 384 + (hq >> 1) * 64; pitch = DIN; q0 = qb * 256; L = SL;
            slope2 = alibi_slope(hq, 4) * LOG2E; W = 128; m_init = a.in[4][layer * 4 + hq] * LOG2E; l_init = 1.f;
            op = nullptr; obf = (bf16_t*)(a.ws + WS_HB) + rb * DM + hq * 64; opitch = DM; lp = nullptr; lpitch = 0;
        } else {
            const int uc = uu - 256;
            const int gh = uc >> 6, blk = uc & 63, gq = gh >> 2;
            const int dsh = 2 * gq, d = 1 << dsh;
            const int seq = (blk * 256) >> sl_shift, b2 = blk - ((seq << sl_shift) >> 8);
            const int nbr = (SL >> dsh) >> 8;
            const int res = b2 / nbr, qb = b2 % nbr;
            const size_t rb = (size_t)seq * SL + res; const bf16_t* base = PROJ + rb * DIN;
            qp = base + 2048 + gh * 64; kp = base + 2816 + gh * 64; vp = base + 3584 + gh * 64; pitch = (size_t)DIN * d; q0 = qb * 256; L = SL >> dsh;
            slope2 = alibi_slope(gh, 12) * (float)d * LOG2E; W = 64; m_init = -1e30f; l_init = 0.f;
            op = TMP + rb * TW + T_C + gh * 64; obf = nullptr; opitch = (size_t)TW * d; lp = TMP + rb * TW + T_L + gh; lpitch = (size_t)TW * d;
        }
        attn_unit<64, true>(lds, qp, kp, vp, pitch, q0, L, slope2, W, m_init, l_init, op, opitch, lp, lpitch, obf);
    }
#endif
}

__device__ __forceinline__ void ph_combine(const Args& a, const Ctx& c, int layer) {
    const float* TMP = (const float*)(a.ws + WS_TMP); bf16_t* HB = (bf16_t*)(a.ws + WS_HB);
    const int lane = c.lane;
    { float* S2 = (float*)(a.ws + WS_SSQ) + CH_ROWS; for (int r = c.cu * NTHREADS + c.tid; r < CH_ROWS; r += c.G * NTHREADS) S2[r] = 0.f; }
    for (int r = c.gw; r < CH_ROWS; r += c.NGW) {
        const float* tr = TMP + (size_t)r * TW; bf16_t* mr = HB + (size_t)r * DM;
#pragma unroll
        for (int h = 0; h < 4; ++h) {
            const float l0 = tr[T_L + h], l1 = tr[T_L + 4 + h], l2 = tr[T_L + 8 + h];
            const float mx = fmaxf(l0, fmaxf(l1, l2));
            const float w0 = expf(l0 - mx), w1 = expf(l1 - mx), w2 = expf(l2 - mx);
            const float inv = 1.f / (w0 + w1 + w2);
            const float o = (w0 * tr[T_C + h * 64 + lane] + w1 * tr[T_C + (4 + h) * 64 + lane] + w2 * tr[T_C + (8 + h) * 64 + lane]) * inv;
            mr[768 + h * 64 + lane] = (bf16_t)f2bf(o);
        }
    }
}

__device__ __forceinline__ void ph_conv(const Args& a, const Ctx& c, int ch, int layer) {
    const bf16_t* UB = (const bf16_t*)(a.ws + WS_PROJ); bf16_t* GB = (bf16_t*)(a.ws + WS_TMP);
    const int SL = ch == 0 ? 16384 : 4096;
    const float* cw = a.in[13] + (size_t)layer * 3 * DUP; const float* cb = a.in[14] + (size_t)layer * DUP;
    constexpr int NCG = DFF / 8, RB = 16;
    const int nitems = (CH_ROWS / RB) * NCG;
    { float* S1 = (float*)(a.ws + WS_SSQ); for (int r = c.cu * NTHREADS + c.tid; r < CH_ROWS; r += c.G * NTHREADS) S1[r] = 0.f; }
    for (int it = c.cu * NTHREADS + c.tid; it < nitems; it += c.G * NTHREADS) {
        const int cg8 = it % NCG, rb = it / NCG, c0 = cg8 * 8, r0 = rb * RB;
        f32x4 wg[3][2], wv[3][2], bg[2], bv[2];
#pragma unroll
        for (int k = 0; k < 3; ++k)
#pragma unroll
            for (int j = 0; j < 2; ++j) { wg[k][j] = *(const f32x4*)(cw + k * DUP + c0 + 4 * j); wv[k][j] = *(const f32x4*)(cw + k * DUP + DFF + c0 + 4 * j); }
#pragma unroll
        for (int j = 0; j < 2; ++j) { bg[j] = *(const f32x4*)(cb + c0 + 4 * j); bv[j] = *(const f32x4*)(cb + DFF + c0 + 4 * j); }
        const bool first = (r0 & (SL - 1)) == 0, last = ((r0 + RB) & (SL - 1)) == 0;
        const u32x4 zero = (u32x4){0u, 0u, 0u, 0u};
        const bf16_t* up = UB + (size_t)r0 * DUP + c0;
        u32x4 pg_ = first ? zero : *(const u32x4*)(up - DUP), pv_ = first ? zero : *(const u32x4*)(up - DUP + DFF);
        u32x4 cg_ = *(const u32x4*)(up), cv_ = *(const u32x4*)(up + DFF);
        bf16_t* gp = GB + (size_t)r0 * DFF + c0;
#pragma unroll 4
        for (int rr = 0; rr < RB; ++rr) {
            const bool nz = (rr == RB - 1) && last;
            const u32x4 ng_ = nz ? zero : *(const u32x4*)(up + (size_t)(rr + 1) * DUP), nv_ = nz ? zero : *(const u32x4*)(up + (size_t)(rr + 1) * DUP + DFF);
            unsigned ow[4];
#pragma unroll
            for (int w = 0; w < 4; ++w) {
                float res[2];
#pragma unroll
                for (int hh = 0; hh < 2; ++hh) {
                    const int j = 2 * w + hh, q = j >> 2, e = j & 3;
                    const float gpv = hh ? __builtin_bit_cast(float, pg_[w] & 0xffff0000u) : __builtin_bit_cast(float, pg_[w] << 16);
                    const float gcv = hh ? __builtin_bit_cast(float, cg_[w] & 0xffff0000u) : __builtin_bit_cast(float, cg_[w] << 16);
                    const float gnv = hh ? __builtin_bit_cast(float, ng_[w] & 0xffff0000u) : __builtin_bit_cast(float, ng_[w] << 16);
                    const float vpv = hh ? __builtin_bit_cast(float, pv_[w] & 0xffff0000u) : __builtin_bit_cast(float, pv_[w] << 16);
                    const float vcv = hh ? __builtin_bit_cast(float, cv_[w] & 0xffff0000u) : __builtin_bit_cast(float, cv_[w] << 16);
                    const float vnv = hh ? __builtin_bit_cast(float, nv_[w] & 0xffff0000u) : __builtin_bit_cast(float, nv_[w] << 16);
                    const float gate = gpv * wg[0][q][e] + gcv * wg[1][q][e] + gnv * wg[2][q][e] + bg[q][e];
                    const float val = vpv * wv[0][q][e] + vcv * wv[1][q][e] + vnv * wv[2][q][e] + bv[q][e];
                    res[hh] = gate * __builtin_amdgcn_rcpf(1.f + __builtin_amdgcn_exp2f(-LOG2E * gate)) * val;
                }
                ow[w] = pk2(res[0], res[1]);
            }
            *(u32x4*)(gp + (size_t)rr * DFF) = (u32x4){ow[0], ow[1], ow[2], ow[3]};
            pg_ = cg_; pv_ = cv_; cg_ = ng_; cv_ = nv_;
        }
    }
}

constexpr int STEPS_PER_CHUNK = 1 + DEPTH * 7;
constexpr int NSTEPS = 1 + NCHUNK * STEPS_PER_CHUNK + 1;
__global__ void __launch_bounds__(NTHREADS, 2) mega_fwd(Args a) {
    extern __shared__ __attribute__((aligned(16))) unsigned char lds_raw[];
    LAS unsigned char* lds = (LAS unsigned char*)lds_raw;
    cg::grid_group grid = cg::this_grid();
    volatile LAS unsigned* bst = (volatile LAS unsigned*)(lds + 147456);
    if (threadIdx.x < 2) bst[threadIdx.x] = 0u;
    __syncthreads();
    XcdBarrier xbar = xcd_barrier_post((unsigned*)(a.ws + WS_CTL), bst);
#ifdef PROBE_TA
    unsigned long long tA_ = 0, tB_ = 0, tprev_ = __builtin_amdgcn_s_memrealtime();
#endif
    for (int step = 0; step < NSTEPS; ++step) {
        int tid_l = threadIdx.x, cu_l = blockIdx.x, G_l = gridDim.x;
        asm volatile("" : "+v"(tid_l)); asm volatile("" : "+s"(cu_l), "+s"(G_l));
        Ctx c; c.tid = tid_l; c.lane = c.tid & 63; c.wave = __builtin_amdgcn_readfirstlane(c.tid >> 6);
        c.G = G_l; c.cu = cu_l; c.gw = c.cu * 8 + c.wave; c.NGW = c.G * 8;
        if (step == 0) ph_weights(a, c, lds);
        else if (step == NSTEPS - 1) ph_final_norm(c, chunk_out(a, NCHUNK - 1), a.in[16]);
        else {
            const int s = step - 1, ch = s / STEPS_PER_CHUNK, sc = s % STEPS_PER_CHUNK;
            unsigned char* ws = a.ws;
            bf16_t* HB = (bf16_t*)(ws + WS_HB); bf16_t* XB = (bf16_t*)(ws + WS_XB);
            float* S1 = (float*)(ws + WS_SSQ); float* S2 = S1 + CH_ROWS;
            float* xo = chunk_out(a, ch);
            if (sc == 0) {
                if (ch > 0) ph_final_norm(c, chunk_out(a, ch - 1), a.in[16]);
                const float* xin = chunk_in(a, ch);
                for (int r = c.gw; r < CH_ROWS; r += c.NGW) row_to_bf16_ssq(xin + (size_t)r * DM, XB + (size_t)r * DM, S1 + r, c.lane);
            } else {
                const int layer = (sc - 1) / 7, ph = (sc - 1) % 7;
                const float* xsrc = layer == 0 ? chunk_in(a, ch) : (const float*)xo;
                if (ph == 0) {
                    pg8::Gemm g{XB, (const bf16_t*)(ws + WS_WIN) + (size_t)layer * DIN * DM, CH_ROWS, DIN, DM}; pg8::StaticOrder S; S.init(CH_ROWS, DIN, c.G, c.cu);
                    pg8::EpiBf16S2 E{(bf16_t*)(ws + WS_PROJ), DIN, 1805u, QSCALE, S1};
#ifdef PROBE_G2
                    for (int rep_ = 0; rep_ < 2; ++rep_)
#endif
                    pg8::gemm_phase<pg8::EpiBf16S2, pg8::StaticOrder, true, true>(lds, g, S, E);
                } else if (ph == 1) {
                    ph_attn(a, c, lds, ch, layer);
                } else if (ph == 2) {
                    ph_combine(a, c, layer);
                } else if (ph == 3) {
                    pg8::Gemm g{HB, (const bf16_t*)(ws + WS_WOUT) + (size_t)layer * DM * DM, CH_ROWS, DM, DM}; pg8::StaticOrder S; S.init(CH_ROWS, DM, c.G, c.cu);
                    pg8::EpiRes2 E{xsrc, xo, XB, S2, DM};
                    pg8::gemm_phase<pg8::EpiRes2, pg8::StaticOrder, true, true>(lds, g, S, E);
                } else if (ph == 4) {
                    pg8::Gemm g{XB, (const bf16_t*)(ws + WS_WUP) + (size_t)layer * DUP * DM, CH_ROWS, DUP, DM}; pg8::StaticOrder S; S.init(CH_ROWS, DUP, c.G, c.cu);
                    pg8::EpiBf16S2 E{(bf16_t*)(ws + WS_PROJ), DUP, 0u, 1.f, S2};
#ifdef PROBE_G2
                    for (int rep_ = 0; rep_ < 2; ++rep_)
#endif
                    pg8::gemm_phase<pg8::EpiBf16S2, pg8::StaticOrder, true, true>(lds, g, S, E);
                } else if (ph == 5) {
#ifdef PROBE_CV2
                    ph_conv(a, c, ch, layer);
#endif
                    ph_conv(a, c, ch, layer);
                } else {
                    pg8::Gemm g{(const bf16_t*)(ws + WS_TMP), (const bf16_t*)(ws + WS_WDN) + (size_t)layer * DM * DFF, CH_ROWS, DM, DFF}; pg8::StaticOrder S; S.init(CH_ROWS, DM, c.G, c.cu);
                    pg8::EpiRes2 E{xo, xo, XB, S1, DM};
                    pg8::gemm_phase<pg8::EpiRes2, pg8::StaticOrder, true, true>(lds, g, S, E);
                }
            }
        }
#ifdef PROBE_TA
        const unsigned long long tmid_ = __builtin_amdgcn_s_memrealtime();
#endif
        if (step == 0) grid.sync(); else if (step != NSTEPS - 1) xcd_barrier(xbar);
#ifdef PROBE_S2
        if (step != 0 && step != NSTEPS - 1) { xcd_barrier(xbar); xcd_barrier(xbar); xcd_barrier(xbar); }
#endif
#ifdef PROBE_TA
        {
            const unsigned long long tnow_ = __builtin_amdgcn_s_memrealtime();
            int cls_;
            if (step == 0) cls_ = 0; else if (step == NSTEPS - 1) cls_ = 1;
            else { const int sc_ = (step - 1) % STEPS_PER_CHUNK; if (sc_ == 0) cls_ = 1; else { const int ph_ = (sc_ - 1) % 7; cls_ = ph_ == 0 || ph_ == 4 ? 2 : ph_ == 1 ? 3 : ph_ == 2 ? 4 : ph_ == 5 ? 6 : 5; } }
            if (cls_ == PROBE_TA) tA_ += tnow_ - tprev_; if (PROBE_TA == 7) tA_ += tnow_ - tmid_;
            if (cls_ == PROBE_TB) tB_ += tnow_ - tprev_; if (PROBE_TB == 7) tB_ += tnow_ - tmid_;
            tprev_ = tnow_;
        }
#endif
    }
#ifdef PROBE_TA
    if (blockIdx.x == 0 && threadIdx.x < 64) {
        float* xo = chunk_out(a, NCHUNK - 1);
        const float ua = (float)tA_ * 0.01f, ub = (float)tB_ * 0.01f;
        if (threadIdx.x == 0) xo[0] += 8.f + ua * 0.01f; else xo[4 * threadIdx.x] += sqrtf(ub * 0.01f);
    }
#endif
}

extern "C" void kernel_launch(void* const* d_in, const int* in_sizes, int n_in, void* d_out, int out_size, void* d_ws, size_t ws_size, hipStream_t stream) {
    static int grid = 0;
    if (grid == 0) {
        if (n_in != 17 || ws_size < WS_END) { fprintf(stderr, "kernel_launch: unexpected n_in %d / ws_size %zu (need %zu)\n", n_in, ws_size, (size_t)WS_END); grid = -1; return; }
        int dev = 0, cus = 0, per_cu = 0;
        (void)hipGetDevice(&dev); (void)hipDeviceGetAttribute(&cus, hipDeviceAttributeMultiprocessorCount, dev);
        if (hipFuncSetAttribute((const void*)mega_fwd, hipFuncAttributeMaxDynamicSharedMemorySize, LDS_BYTES) != hipSuccess) { fprintf(stderr, "hipFuncSetAttribute failed\n"); grid = -1; return; }
        if (hipOccupancyMaxActiveBlocksPerMultiprocessor(&per_cu, (const void*)mega_fwd, NTHREADS, LDS_BYTES) != hipSuccess || per_cu < 1) { fprintf(stderr, "occupancy query: %d\n", per_cu); per_cu = 1; }
        (void)hipGetLastError();
        grid = cus * 1;
    }
    if (grid < 0) return;
    (void)hipMemsetAsync((char*)d_ws + WS_CTL, 0, 65536, stream);
    Args a{};
    for (int i = 0; i < 17; ++i) a.in[i] = (const float*)d_in[i];
    a.out = (float*)d_out; a.ws = (unsigned char*)d_ws;
    void* args[] = {&a};
    hipError_t e = hipLaunchCooperativeKernel((const void*)mega_fwd, dim3(grid), dim3(NTHREADS), args, LDS_BYTES, stream);
    if (e != hipSuccess) fprintf(stderr, "cooperative launch failed: %s (grid %d)\n", hipGetErrorString(e), grid);
}
```

```cpp
#include <hip/hip_runtime.h>
#include <hip/hip_cooperative_groups.h>
#include <cstdio>
#include <cstdint>
#include <cmath>
namespace cg = cooperative_groups;
namespace pg8 {
#define PG8_LAS __attribute__((address_space(3)))
typedef unsigned short bf16_t;
typedef short bf16x8 __attribute__((ext_vector_type(8)));
typedef float f32x4 __attribute__((ext_vector_type(4)));
typedef unsigned u32x4 __attribute__((ext_vector_type(4)));
constexpr int BM = 256, BK = 64, HALF = 128, HTB = HALF * BK * 2  , STAGE_BYTES = 8 * HTB, NXCD = 8, WGM = 8;

__host__ __device__ __forceinline__ int lds_byte(int r, int c) { const int st = (r >> 4) * 2 + (c >> 5), rr = r & 15, cc = c & 31, ob = rr * 64 + cc * 2; return st * 1024 + (ob ^ (((ob >> 9) & 1) << 5)); }
__host__ __device__ __forceinline__ void stage_rc(int b, int& R, int& C) { const int st = b / 1024, sb = b % 1024, swz = sb ^ (((sb >> 9) & 1) << 5); R = (st >> 1) * 16 + swz / 64; C = (st & 1) * 32 + (swz % 64) / 2; }
__host__ __device__ __forceinline__ int perm32(int rho) { const int n = rho >> 4, i = rho & 15; return 8 * (i >> 2) + 4 * n + (i & 3); }

struct Unit { int pm, pn; };
struct Gemm { const bf16_t* A; const bf16_t* Bt; int M, N, K; int a_rows = 256; };

struct StaticOrder {
    int nM, nN, nwg, G, c;
    __host__ __device__ void init(int M, int N, int G_, int c_) { nM = M / BM; nN = N / BM; nwg = nM * nN; G = G_; c = c_; }
    __host__ __device__ bool next(int i, Unit& u) const {
        const long L = (long)i * G + c; if (L >= nwg) return false;
        int wgid = (int)L; { const int q = nwg / NXCD, r = nwg % NXCD, xcd = wgid % NXCD, off = wgid / NXCD; wgid = (xcd < r ? xcd * (q + 1) : r * (q + 1) + (xcd - r) * q) + off; }
        const int nig = WGM * nN, gid = wgid / nig, fm = gid * WGM, gsz = (nM - fm) < WGM ? (nM - fm) : WGM;
        u.pm = fm + ((wgid % nig) % gsz); u.pn = (wgid % nig) / gsz; return true;
    }
    __device__ __forceinline__ void a_ready(const Unit&) const {}
    __device__ __forceinline__ void done(const Unit&) const {}
};

__device__ __forceinline__ unsigned cvt_pk_bf16(float lo, float hi) { unsigned r; asm volatile("v_cvt_pk_bf16_f32 %0, %1, %2" : "=v"(r) : "v"(lo), "v"(hi)); return r; }
struct EpiBf16S {
    static constexpr bool PERM = true, AFTER_DRAIN = false;
    bf16_t* O; int ldc; unsigned scalemask; float sc;
    __device__ __forceinline__ void operator()(const f32x4 (&acc)[2][2][4][2], const Unit& u, int wr, int wc, int fr, int fq) const {
        const int row0 = u.pm * BM + wr * 64 + fr; const int col0 = u.pn * BM + wc * 32 + 8 * fq;
        const float s = ((scalemask >> u.pn) & 1u) ? sc : 1.f;
#pragma unroll
        for (int ai = 0; ai < 2; ++ai)
#pragma unroll
            for (int m = 0; m < 4; ++m) { bf16_t* rowp = O + (size_t)(row0 + ai * HALF + m * 16) * ldc + col0;
#pragma unroll
                for (int bj = 0; bj < 2; ++bj) { f32x4 v0 = acc[ai][bj][m][0] * s, v1 = acc[ai][bj][m][1] * s;
                    u32x4 w; w.x = cvt_pk_bf16(v0[0], v0[1]); w.y = cvt_pk_bf16(v0[2], v0[3]); w.z = cvt_pk_bf16(v1[0], v1[1]); w.w = cvt_pk_bf16(v1[2], v1[3]);
                    *(u32x4*)(rowp + bj * HALF) = w; } }
    }
};
struct EpiRes {
    static constexpr bool PERM = false, AFTER_DRAIN = false;
    const float* base; float* out; int ldc;
    __device__ __forceinline__ void operator()(const f32x4 (&acc)[2][2][4][2], const Unit& u, int wr, int wc, int fr, int fq) const {
        const int col0 = u.pn * BM + wc * 32 + 4 * fq;
#pragma unroll
        for (int ai = 0; ai < 2; ++ai)
#pragma unroll
            for (int m = 0; m < 4; ++m) { const size_t off = (size_t)(u.pm * BM + ai * HALF + wr * 64 + m * 16 + fr) * ldc + col0;
#pragma unroll
                for (int bj = 0; bj < 2; ++bj)
#pragma unroll
                    for (int n = 0; n < 2; ++n) { const f32x4 bs = *(const f32x4*)(base + off + bj * HALF + n * 16); *(f32x4*)(out + off + bj * HALF + n * 16) = bs + acc[ai][bj][m][n]; }
                asm volatile("" ::: "memory"); }
    }
};

struct EpiBf16S2 {
    static constexpr bool PERM = true, AFTER_DRAIN = false;
    bf16_t* O; int ldc; unsigned scalemask; float sc; const float* ssq;
    __device__ __forceinline__ void operator()(const f32x4 (&acc)[2][2][4][2], const Unit& u, int wr, int wc, int fr, int fq) const {
        const int row0 = u.pm * BM + wr * 64 + fr; const int col0 = u.pn * BM + wc * 32 + 8 * fq;
        const float s = ((scalemask >> u.pn) & 1u) ? sc : 1.f;
#pragma unroll
        for (int ai = 0; ai < 2; ++ai)
#pragma unroll
            for (int m = 0; m < 4; ++m) { const int row = row0 + ai * HALF + m * 16; bf16_t* rowp = O + (size_t)row * ldc + col0;
                const float rs = s / sqrtf(ssq[row] * (1.f / 1024.f) + 1e-6f);
#pragma unroll
                for (int bj = 0; bj < 2; ++bj) { f32x4 v0 = acc[ai][bj][m][0] * rs, v1 = acc[ai][bj][m][1] * rs;
                    u32x4 w; w.x = cvt_pk_bf16(v0[0], v0[1]); w.y = cvt_pk_bf16(v0[2], v0[3]); w.z = cvt_pk_bf16(v1[0], v1[1]); w.w = cvt_pk_bf16(v1[2], v1[3]);
                    *(u32x4*)(rowp + bj * HALF) = w; } }
    }
};
typedef unsigned u32x2e __attribute__((ext_vector_type(2)));
struct EpiRes2 {
    static constexpr bool PERM = false, AFTER_DRAIN = false;
    const float* base; float* out; bf16_t* xb; float* ssq; int ldc;
    __device__ __forceinline__ void operator()(const f32x4 (&acc)[2][2][4][2], const Unit& u, int wr, int wc, int fr, int fq) const {
        const int col0 = u.pn * BM + wc * 32 + 4 * fq;
#pragma unroll
        for (int ai = 0; ai < 2; ++ai)
#pragma unroll
            for (int m = 0; m < 4; ++m) { const int row = u.pm * BM + ai * HALF + wr * 64 + m * 16 + fr; const size_t off = (size_t)row * ldc + col0; float ps = 0.f;
#pragma unroll
                for (int bj = 0; bj < 2; ++bj)
#pragma unroll
                    for (int n = 0; n < 2; ++n) { const f32x4 bs = *(const f32x4*)(base + off + bj * HALF + n * 16); const f32x4 v = bs + acc[ai][bj][m][n];
                        *(f32x4*)(out + off + bj * HALF + n * 16) = v; ps += (v[0] * v[0] + v[1] * v[1]) + (v[2] * v[2] + v[3] * v[3]);
                        u32x2e w; w.x = cvt_pk_bf16(v[0], v[1]); w.y = cvt_pk_bf16(v[2], v[3]); *(u32x2e*)(xb + off + bj * HALF + n * 16) = w; }
                ps += __shfl_xor(ps, 16); ps += __shfl_xor(ps, 32);
                if (fq == 0) atomicAdd(ssq + row, ps);
                asm volatile("" ::: "memory"); }
    }
};

struct EpiNull {
    static constexpr bool PERM = false, AFTER_DRAIN = false;
    __device__ __forceinline__ void operator()(const f32x4 (&acc)[2][2][4][2], const Unit& u, int wr, int wc, int fr, int fq) const {
#pragma unroll
        for (int ai = 0; ai < 2; ++ai)
#pragma unroll
            for (int bj = 0; bj < 2; ++bj)
#pragma unroll
                for (int m = 0; m < 4; ++m)
#pragma unroll
                    for (int n = 0; n < 2; ++n) asm volatile("" :: "v"(acc[ai][bj][m][n]));
    }
};

#define PG8_DPP(old, src, ctrl) __builtin_bit_cast(float, __builtin_amdgcn_update_dpp(__builtin_bit_cast(int, (float)(old)), __builtin_bit_cast(int, (float)(src)), (ctrl), 0xF, 0xF, false))
struct EpiConv {
    static constexpr bool PERM = true, AFTER_DRAIN = false;
    bf16_t* G; const float* ssq; const float* cw; const float* cb; int slmask; PG8_LAS float* xch; int nrows;
    __device__ __forceinline__ void operator()(f32x4 (&acc)[2][2][4][2], const Unit& u, int wr, int wc, int fr, int fq) const {
        const int t0 = 254 * u.pm - 1 + wr * 64 + fr;
#pragma unroll
        for (int ai = 0; ai < 2; ++ai)
#pragma unroll
            for (int m = 0; m < 4; ++m) { int t = t0 + ai * HALF + m * 16; t = t < 0 ? 0 : (t > nrows - 1 ? nrows - 1 : t);
                const float rs = 1.f / sqrtf(ssq[t] * (1.f / 1024.f) + 1e-6f);
#pragma unroll
                for (int bj = 0; bj < 2; ++bj)
#pragma unroll
                    for (int n = 0; n < 2; ++n) acc[ai][bj][m][n] *= rs; }
        if (fr == 0 || fr == 15) { const int which = fr == 0 ? 0 : 1, m = fr == 0 ? 0 : 3;
#pragma unroll
            for (int ai = 0; ai < 2; ++ai) { PG8_LAS float* d = xch + ((((2 * ai + wr) * 2 + which) * 4 + wc) * 4 + fq) * 16;
#pragma unroll
                for (int bj = 0; bj < 2; ++bj)
#pragma unroll
                    for (int n = 0; n < 2; ++n) *(PG8_LAS f32x4*)(d + bj * 8 + n * 4) = fr == 0 ? acc[ai][bj][0][n] : acc[ai][bj][3][n]; }
            (void)m; }
        asm volatile("s_waitcnt lgkmcnt(0)" ::: "memory"); __builtin_amdgcn_s_barrier(); asm volatile("" ::: "memory");
        const int ch0 = u.pn * 128 + wc * 32 + 8 * fq;
#pragma unroll
        for (int n = 0; n < 2; ++n) {
            const int chn = ch0 + 4 * n;
            const f32x4 wg0 = *(const f32x4*)(cw + chn), wg1 = *(const f32x4*)(cw + 5632 + chn), wg2 = *(const f32x4*)(cw + 2 * 5632 + chn), bgv = *(const f32x4*)(cb + chn);
            const f32x4 wv0 = *(const f32x4*)(cw + 2816 + chn), wv1 = *(const f32x4*)(cw + 5632 + 2816 + chn), wv2 = *(const f32x4*)(cw + 2 * 5632 + 2816 + chn), bvv = *(const f32x4*)(cb + 2816 + chn);
#pragma unroll
            for (int ai = 0; ai < 2; ++ai)
#pragma unroll
                for (int m = 0; m < 4; ++m) {
                    const int lr = ai * HALF + wr * 64 + m * 16 + fr, t = 254 * u.pm - 1 + lr;
                    const int gidx = 2 * ai + wr;
                    f32x4 pv[2], nx[2];
#pragma unroll
                    for (int bj = 0; bj < 2; ++bj) {
                        f32x4 upo, dno;
                        if (m > 0) { const f32x4 s = acc[ai][bj][m - 1][n];
#pragma unroll
                            for (int j = 0; j < 4; ++j) upo[j] = PG8_DPP(0.f, s[j], 0x121); }
                        else upo = gidx > 0 ? *(const PG8_LAS f32x4*)(xch + ((((gidx - 1) * 2 + 1) * 4 + wc) * 4 + fq) * 16 + bj * 8 + n * 4) : (f32x4){0.f, 0.f, 0.f, 0.f};
                        if (m < 3) { const f32x4 s = acc[ai][bj][m + 1][n];
#pragma unroll
                            for (int j = 0; j < 4; ++j) dno[j] = PG8_DPP(0.f, s[j], 0x12F); }
                        else dno = gidx < 3 ? *(const PG8_LAS f32x4*)(xch + ((((gidx + 1) * 2 + 0) * 4 + wc) * 4 + fq) * 16 + bj * 8 + n * 4) : (f32x4){0.f, 0.f, 0.f, 0.f};
                        const f32x4 cur = acc[ai][bj][m][n];
#pragma unroll
                        for (int j = 0; j < 4; ++j) { pv[bj][j] = PG8_DPP(upo[j], cur[j], 0x111);
                                                       nx[bj][j] = PG8_DPP(dno[j], cur[j], 0x101); }
                    }
                    const bool sfirst = (t & slmask) == 0, slast = (t & slmask) == slmask;
                    float res[4];
#pragma unroll
                    for (int j = 0; j < 4; ++j) {
                        const float gp = sfirst ? 0.f : pv[0][j], gn = slast ? 0.f : nx[0][j], vp = sfirst ? 0.f : pv[1][j], vn = slast ? 0.f : nx[1][j];
                        const float gate = gp * wg0[j] + acc[ai][0][m][n][j] * wg1[j] + gn * wg2[j] + bgv[j];
                        const float val = vp * wv0[j] + acc[ai][1][m][n][j] * wv1[j] + vn * wv2[j] + bvv[j];
                        res[j] = gate * __builtin_amdgcn_rcpf(1.f + __builtin_amdgcn_exp2f(-1.4426950408889634f * gate)) * val;
                    }
                    if (lr >= 1 && lr <= 254 && t < nrows) { u32x2e w; w.x = cvt_pk_bf16(res[0], res[1]); w.y = cvt_pk_bf16(res[2], res[3]); *(u32x2e*)(G + (size_t)t * 2816 + chn) = w; }
                }
        }
    }
};
template <class Epi, class Sched, bool ALIGN_EPI = false, bool SP2 = false>
__device__ __forceinline__ void gemm_phase(PG8_LAS unsigned char* lds, const Gemm g, const Sched& S, const Epi& E) {
    int tid_l = threadIdx.x; asm volatile("" : "+v"(tid_l)); const int tid = tid_l, wid = __builtin_amdgcn_readfirstlane(tid >> 6), lane = tid & 63, wr = wid >> 2, wc = wid & 3, fr = lane & 15, fq = lane >> 4;
    const int K = g.K, nt = K / BK;
    unsigned voffA[2], voffB[2];
#pragma unroll
    for (int i = 0; i < 2; ++i) { int R, C; stage_rc(tid * 16 + i * 8192, R, C); const int Rb = Epi::PERM ? ((R & ~31) + perm32(R & 31)) : R;
        voffA[i] = (unsigned)(R * K + C) * 2u; voffB[i] = (unsigned)(Rb * K + C) * 2u; }
    const size_t kstep = (size_t)(BK * 2);
    const size_t hstep = (size_t)HALF * K * 2;
    const size_t tstep = 2 * hstep; const size_t tstepA = (size_t)g.a_rows * K * 2;
    const unsigned ldsw = (unsigned)wid * 1024u;
    const int aoff = lds_byte(wr * 64 + fr, fq * 8), boff = lds_byte(wc * 32 + fr, fq * 8);
#define PG8_SA(b, h) (((b) * 2 + (h)) * HTB)
#define PG8_SB(b, h) ((4 + (b) * 2 + (h)) * HTB)
#define PG8_STAGE(bufoff, gbase, voff) do { _Pragma("unroll") for (int _i = 0; _i < 2; ++_i) \
        __builtin_amdgcn_global_load_lds((const unsigned*)((const char*)(gbase) + (voff)[_i]), (PG8_LAS unsigned*)(lds + (bufoff) + ldsw + _i * 8192), 16, 0, 0); } while (0)
#define PG8_LDA(dst, b, h) do { _Pragma("unroll") for (int m = 0; m < 4; ++m) _Pragma("unroll") for (int k = 0; k < 2; ++k) dst[m][k] = *(const PG8_LAS bf16x8*)(lds + PG8_SA(b, h) + aoff + m * 2048 + k * 1024); } while (0)
#define PG8_LDB(dst, b, h) do { _Pragma("unroll") for (int n = 0; n < 2; ++n) _Pragma("unroll") for (int k = 0; k < 2; ++k) dst[n][k] = *(const PG8_LAS bf16x8*)(lds + PG8_SB(b, h) + boff + n * 2048 + k * 1024); } while (0)
#define PG8_MMA(ai, bj, At, Bt) do { __builtin_amdgcn_s_setprio(1); _Pragma("unroll") for (int m = 0; m < 4; ++m) _Pragma("unroll") for (int n = 0; n < 2; ++n) _Pragma("unroll") for (int k = 0; k < 2; ++k) \
        acc[ai][bj][m][n] = __builtin_amdgcn_mfma_f32_16x16x32_bf16(Bt[n][k], At[m][k], acc[ai][bj][m][n], 0, 0, 0); __builtin_amdgcn_s_setprio(0); } while (0)
#define PG8_WAIT_V(n) asm volatile("s_waitcnt vmcnt(" #n ")" ::: "memory")
#define PG8_WAIT_L(n) asm volatile("s_waitcnt lgkmcnt(" #n ")" ::: "memory")
#define PG8_BAR __builtin_amdgcn_s_barrier()
#define PG8_SCHED __builtin_amdgcn_sched_barrier(0)
    Unit cur, nxt; int ui = 0;
    if (!S.next(0, cur)) return;
    f32x4 acc[2][2][4][2];
#pragma unroll
    for (int a = 0; a < 2; ++a)
#pragma unroll
        for (int b = 0; b < 2; ++b)
#pragma unroll
            for (int m = 0; m < 4; ++m)
#pragma unroll
                for (int n = 0; n < 2; ++n) acc[a][b][m][n] = (f32x4){0.f, 0.f, 0.f, 0.f};
    bf16x8 At[4][2], B0[2][2], B1[2][2];
    const char* cA = (const char*)g.A + (size_t)cur.pm * tstepA; const char* cB = (const char*)g.Bt + (size_t)cur.pn * tstep;
    S.a_ready(cur);
    if constexpr (SP2) {
        PG8_STAGE(PG8_SB(0, 0), cB, voffB); PG8_STAGE(PG8_SB(0, 1), cB + hstep, voffB); PG8_STAGE(PG8_SA(0, 0), cA, voffA); PG8_STAGE(PG8_SA(0, 1), cA + hstep, voffA);
        if (wr == 1) PG8_BAR;
        PG8_WAIT_V(2); PG8_BAR;
        PG8_STAGE(PG8_SB(1, 0), cB + kstep, voffB); PG8_STAGE(PG8_SA(1, 0), cA + kstep, voffA); PG8_STAGE(PG8_SB(1, 1), cB + hstep + kstep, voffB);
        PG8_WAIT_V(6); PG8_BAR;
    } else {
        PG8_STAGE(PG8_SB(0, 0), cB, voffB); PG8_STAGE(PG8_SA(0, 0), cA, voffA); PG8_STAGE(PG8_SB(0, 1), cB + hstep, voffB); PG8_STAGE(PG8_SA(0, 1), cA + hstep, voffA);
        if (wr == 1) PG8_BAR;
        PG8_WAIT_V(4); PG8_BAR;
        PG8_STAGE(PG8_SB(1, 0), cB + kstep, voffB); PG8_STAGE(PG8_SA(1, 0), cA + kstep, voffA); PG8_STAGE(PG8_SB(1, 1), cB + hstep + kstep, voffB);
        PG8_WAIT_V(6); PG8_BAR;
    }
    for (;;) {
        const bool has_next = S.next(ui + 1, nxt);
        const char* nA = has_next ? (const char*)g.A + (size_t)nxt.pm * tstepA : cA; const char* nB = has_next ? (const char*)g.Bt + (size_t)nxt.pn * tstep : cB;
        for (int t = 0; t < nt; t += 2) {
            const bool last = (t == nt - 2);
            const char* a1 = cA + (size_t)(t + 1) * kstep;
            const char* a2 = last ? nA : cA + (size_t)(t + 2) * kstep; const char* b2 = last ? nB : cB + (size_t)(t + 2) * kstep;
            const char* a3 = a2 + kstep; const char* b3 = b2 + kstep;
            if (last && has_next) S.a_ready(nxt);
            if constexpr (SP2) {
            PG8_LDB(B0, 0, 0); PG8_LDB(B1, 0, 1); PG8_SCHED; PG8_LDA(At, 0, 0); PG8_STAGE(PG8_SA(1, 1), a1 + hstep, voffA);
            PG8_WAIT_V(8); PG8_WAIT_L(0); PG8_BAR; PG8_MMA(0, 0, At, B0); PG8_MMA(0, 1, At, B1); PG8_BAR; PG8_SCHED;
            PG8_LDA(At, 0, 1); PG8_STAGE(PG8_SB(0, 0), b2, voffB); PG8_STAGE(PG8_SB(0, 1), b2 + hstep, voffB); PG8_STAGE(PG8_SA(0, 0), a2, voffA);
            PG8_WAIT_V(8); PG8_WAIT_L(0); PG8_BAR; PG8_MMA(1, 0, At, B0); PG8_MMA(1, 1, At, B1); PG8_BAR; PG8_SCHED;
            PG8_LDB(B0, 1, 0); PG8_LDB(B1, 1, 1); PG8_SCHED; PG8_LDA(At, 1, 0); PG8_STAGE(PG8_SA(0, 1), a2 + hstep, voffA);
            PG8_WAIT_V(8); PG8_WAIT_L(0); PG8_BAR; PG8_MMA(0, 0, At, B0); PG8_MMA(0, 1, At, B1); PG8_BAR; PG8_SCHED;
            PG8_LDA(At, 1, 1); PG8_STAGE(PG8_SB(1, 0), b3, voffB); PG8_STAGE(PG8_SB(1, 1), b3 + hstep, voffB); PG8_STAGE(PG8_SA(1, 0), a3, voffA);
            PG8_WAIT_V(8); PG8_WAIT_L(0); PG8_BAR; PG8_MMA(1, 0, At, B0); PG8_MMA(1, 1, At, B1); PG8_BAR; PG8_SCHED;
            } else {
            PG8_LDB(B0, 0, 0); PG8_SCHED; PG8_LDA(At, 0, 0); PG8_STAGE(PG8_SA(1, 1), a1 + hstep, voffA);
            PG8_WAIT_L(8); PG8_BAR; PG8_WAIT_L(0); PG8_MMA(0, 0, At, B0); PG8_BAR; PG8_SCHED;
            PG8_LDB(B1, 0, 1); PG8_STAGE(PG8_SB(0, 0), b2, voffB);
            PG8_BAR; PG8_WAIT_L(0); PG8_MMA(0, 1, At, B1); PG8_BAR;
            PG8_LDA(At, 0, 1); PG8_STAGE(PG8_SA(0, 0), a2, voffA);
            PG8_BAR; PG8_WAIT_L(0); PG8_MMA(1, 0, At, B0); PG8_BAR; PG8_SCHED;
            PG8_STAGE(PG8_SB(0, 1), b2 + hstep, voffB);
            PG8_WAIT_V(6); PG8_BAR; PG8_MMA(1, 1, At, B1); PG8_BAR;
            PG8_LDB(B0, 1, 0); PG8_SCHED; PG8_LDA(At, 1, 0); PG8_STAGE(PG8_SA(0, 1), a2 + hstep, voffA);
            PG8_WAIT_L(8); PG8_BAR; PG8_WAIT_L(0); PG8_MMA(0, 0, At, B0); PG8_BAR; PG8_SCHED;
            PG8_LDB(B1, 1, 1); PG8_STAGE(PG8_SB(1, 0), b3, voffB);
            PG8_BAR; PG8_WAIT_L(0); PG8_MMA(0, 1, At, B1); PG8_BAR;
            PG8_LDA(At, 1, 1); PG8_STAGE(PG8_SA(1, 0), a3, voffA);
            PG8_BAR; PG8_WAIT_L(0); PG8_MMA(1, 0, At, B0); PG8_BAR; PG8_SCHED;
            PG8_STAGE(PG8_SB(1, 1), b3 + hstep, voffB);
            PG8_WAIT_V(6); PG8_BAR; PG8_MMA(1, 1, At, B1); PG8_BAR;
            }
        }
        if constexpr (ALIGN_EPI) { if (wr == 0) PG8_BAR; }
        if constexpr (!Epi::AFTER_DRAIN) { E(acc, cur, wr, wc, fr, fq); S.done(cur); }
        if (!has_next) break;
#pragma unroll
        for (int a = 0; a < 2; ++a)
#pragma unroll
            for (int b = 0; b < 2; ++b)
#pragma unroll
                for (int m = 0; m < 4; ++m)
#pragma unroll
                    for (int n = 0; n < 2; ++n) acc[a][b][m][n] = (f32x4){0.f, 0.f, 0.f, 0.f};
        cur = nxt; cA = nA; cB = nB; ++ui;
        if constexpr (ALIGN_EPI) { if (wr == 1) PG8_BAR; }
    }
    PG8_WAIT_V(0);
    if constexpr (!ALIGN_EPI) { if (wr == 0) PG8_BAR; }
    PG8_BAR;
    if constexpr (Epi::AFTER_DRAIN) { E.fused(acc, cur, wr, wc, fr, fq, lds, wid, lane); S.done(cur); }
#undef PG8_SA
#undef PG8_SB
#undef PG8_STAGE
#undef PG8_LDA
#undef PG8_LDB
#undef PG8_MMA
#undef PG8_WAIT_V
#undef PG8_WAIT_L
#undef PG8_BAR
#undef PG8_SCHED
}
}
typedef __bf16 bf16x2_t __attribute__((ext_vector_type(2)));
__device__ __forceinline__ unsigned cvt_pk(float lo, float hi) { float __attribute__((ext_vector_type(2))) v = {lo, hi}; bf16x2_t b = __builtin_convertvector(v, bf16x2_t); return __builtin_bit_cast(unsigned, b); }
#define LAS __attribute__((address_space(3)))
#define XB_TMO      128
#define XB_XCNT(j)  (256  + 64 * (j))
#define XB_XSUB(j)  (1280 + 64 * (j))
#define XB_XGEN(j)  (2304 + 64 * (j))
#define XB_TOP      3328
#define XB_TOPGEN   3392
#define XCD_BAR_WORDS 3456
#define XB_SPIN_CAP (1u << 18)

__device__ __forceinline__ unsigned xb_ld(unsigned* p)              { return __hip_atomic_load(p, __ATOMIC_RELAXED, __HIP_MEMORY_SCOPE_AGENT); }
__device__ __forceinline__ unsigned xb_add(unsigned* p, unsigned v) { return __hip_atomic_fetch_add(p, v, __ATOMIC_RELAXED, __HIP_MEMORY_SCOPE_AGENT); }
__device__ __forceinline__ unsigned xb_xcc_id() { return (unsigned)__builtin_amdgcn_s_getreg((3 << 11) | 20) & 0xFu; }
#define XB_SPIN(cond, bar) do { unsigned _sp = 0; while (cond) { __builtin_amdgcn_s_sleep(1); \
    if ((++_sp & 255u) == 0u) { if (xb_ld(&(bar)[XB_TMO])) break; if (_sp > XB_SPIN_CAP) { atomicAdd(&(bar)[XB_TMO], 1u); break; } } } } while (0)

struct XcdBarrier {
    unsigned* bar; unsigned x;
    volatile LAS unsigned* st;
};

__device__ __forceinline__ XcdBarrier xcd_barrier_post(unsigned* bar, volatile LAS unsigned* st) {
    XcdBarrier b; b.bar = bar; b.x = xb_xcc_id(); b.st = st;
    if (threadIdx.x == 0) (void)xb_add(&bar[XB_XCNT(b.x)], 1u);
    return b;
}
__device__ __forceinline__ void xcd_barrier_complete(unsigned* bar, unsigned x, unsigned& nloc, unsigned& nx) {
    const unsigned G = gridDim.x * gridDim.y * gridDim.z;
    unsigned sum, cnt, mine, sp = 0u;
    for (;;) {
        sum = 0u; cnt = 0u; mine = 0u;
#pragma unroll
        for (unsigned j = 0; j < 16; ++j) { const unsigned c = xb_ld(&bar[XB_XCNT(j)]); sum += c; cnt += (c > 0u) ? 1u : 0u; mine = (j == x) ? c : mine; }
        if (sum == G) break;
        __builtin_amdgcn_s_sleep(1);
        if ((++sp & 255u) == 0u) { if (xb_ld(&bar[XB_TMO])) break; if (sp > XB_SPIN_CAP) { atomicAdd(&bar[XB_TMO], 1u); break; } }
    }
    nloc = mine > 0u ? mine : 1u; nx = cnt > 0u ? cnt : 1u;
}

__device__ __forceinline__ void xcd_barrier(const XcdBarrier& b) {
    asm volatile("s_waitcnt vmcnt(0)" ::: "memory");
    __syncthreads();
    if (threadIdx.x == 0) {
        unsigned* bar = b.bar;
        __builtin_amdgcn_s_waitcnt(0);
        unsigned nloc = b.st[0], nx = b.st[1];
        if (nloc == 0u) { xcd_barrier_complete(bar, b.x, nloc, nx); b.st[0] = nloc; b.st[1] = nx; }
        const unsigned old = xb_add(&bar[XB_XSUB(b.x)], 1u);
        const unsigned gen = old / nloc;
        if (old + 1u == (gen + 1u) * nloc) {
            __builtin_amdgcn_fence(__ATOMIC_RELEASE, "agent");
            asm volatile("s_waitcnt vmcnt(0)" ::: "memory");
            const unsigned og = xb_add(&bar[XB_TOP], 1u);
            const unsigned tg = og / nx;
            if (og + 1u == (tg + 1u) * nx) xb_add(&bar[XB_TOPGEN], 1u);
            else XB_SPIN(xb_ld(&bar[XB_TOPGEN]) == tg, bar);
            __builtin_amdgcn_fence(__ATOMIC_ACQUIRE, "agent");
            xb_add(&bar[XB_XGEN(b.x)], 1u);
            asm volatile("s_waitcnt vmcnt(0)" ::: "memory");
        } else {
            XB_SPIN(xb_ld(&bar[XB_XGEN(b.x)]) == gen, bar);
            __builtin_amdgcn_fence(__ATOMIC_ACQUIRE, "agent");
            asm volatile("s_waitcnt vmcnt(0)" ::: "memory");
        }
    }
    __syncthreads();
}
typedef unsigned short bf16_t;
typedef short bf16x8 __attribute__((ext_vector_type(8)));
typedef short s16x4 __attribute__((ext_vector_type(4)));
typedef float f32x16 __attribute__((ext_vector_type(16)));
typedef float f32x4 __attribute__((ext_vector_type(4)));
typedef float f32x2 __attribute__((ext_vector_type(2)));
typedef unsigned u32x4 __attribute__((ext_vector_type(4)));
typedef unsigned u32x2 __attribute__((ext_vector_type(2)));

constexpr int DM = 1024, DIN = 4352, DFF = 2816, DUP = 2 * DFF, DEPTH = 2;
constexpr int CH_ROWS = 16384, NCHUNK = 3;
constexpr int TW = 784;
constexpr int T_C = 0, T_L = 768;
constexpr float LOG2E = 1.4426950408889634f, LN2 = 0.6931471805599453f;
constexpr float QSCALE = 0.125f * LOG2E;
constexpr size_t MiB = 1u << 20;
constexpr size_t WS_WIN = 0, WS_WOUT = 18 * MiB, WS_WUP = 22 * MiB, WS_WDN = 44 * MiB, WS_HB = 56 * MiB, WS_PROJ = 88 * MiB, WS_TMP = 264 * MiB, WS_CTL = 394 * MiB, WS_XB = 395 * MiB, WS_SSQ = 459 * MiB, WS_END = 460 * MiB;
constexpr int LDS_BYTES = 147456 + 256 + 8192;
constexpr int NTHREADS = 512;

struct Args { const float* in[17]; float* out; unsigned char* ws; };

__device__ __forceinline__ float wave_sum(float v) {
#pragma unroll
    for (int o = 1; o < 64; o <<= 1) v += __shfl_xor(v, o);
    return v;
}
__device__ __forceinline__ unsigned f2bf(float f) { unsigned u = __builtin_bit_cast(unsigned, f); return (u + 0x7fffu + ((u >> 16) & 1u)) >> 16; }
__device__ __forceinline__ unsigned pk2(float lo, float hi) { return f2bf(lo) | (f2bf(hi) << 16); }
__device__ __forceinline__ float bf2f(unsigned short b) { return __builtin_bit_cast(float, (unsigned)b << 16); }

__device__ __forceinline__ void transpose_item(const float* W, int K, int N, bf16_t* WT, LAS float* scr, int item, int lane, const float* gain, bool gate_perm = false) {
    const int nblk = N / 32, kb = item / nblk, nb = item % nblk, k0 = 64 * kb, n0 = 32 * nb;
#pragma unroll 8
    for (int i = 0; i < 32; ++i) { const int kk = 2 * i + (lane >> 5); scr[kk * 33 + (lane & 31)] = W[(size_t)(k0 + kk) * N + n0 + (lane & 31)] * (gain ? gain[k0 + kk] : 1.f); }
    asm volatile("s_waitcnt lgkmcnt(0)" ::: "memory");
    const int c = lane & 7;
    const int half_ = N / 2, v_ = n0 >= half_ ? n0 - half_ : n0, d0 = gate_perm ? 256 * (v_ / 128) + (n0 >= half_ ? 128 : 0) + (v_ % 128) : n0;
#pragma unroll
    for (int j = 0; j < 4; ++j) { const int n = (lane >> 3) + 8 * j; const LAS float* s = scr + (8 * c) * 33 + n;
        u32x4 o; o.x = pk2(s[0 * 33], s[1 * 33]); o.y = pk2(s[2 * 33], s[3 * 33]); o.z = pk2(s[4 * 33], s[5 * 33]); o.w = pk2(s[6 * 33], s[7 * 33]);
        *(u32x4*)(WT + (size_t)(d0 + n) * K + k0 + 8 * c) = o; }
    asm volatile("s_waitcnt lgkmcnt(0)" ::: "memory");
}

__device__ __forceinline__ void rms_row_to_bf16(const float* xrow, const float* gain, bf16_t* orow, int lane) {
    const f32x4* xr = (const f32x4*)xrow + lane; const f32x4* gr = (const f32x4*)gain + lane;
    f32x4 v[4]; float s = 0.f;
#pragma unroll
    for (int j = 0; j < 4; ++j) { v[j] = xr[64 * j]; s += (v[j].x * v[j].x + v[j].y * v[j].y) + (v[j].z * v[j].z + v[j].w * v[j].w); }
    const float rstd = 1.f / sqrtf(wave_sum(s) * (1.f / DM) + 1e-6f);
    u32x2* o8 = (u32x2*)orow + lane;
#pragma unroll
    for (int j = 0; j < 4; ++j) { const f32x4 g = gr[64 * j]; u32x2 w; w.x = pk2(v[j].x * rstd * g.x, v[j].y * rstd * g.y); w.y = pk2(v[j].z * rstd * g.z, v[j].w * rstd * g.w); o8[64 * j] = w; }
}
__device__ __forceinline__ void rms_row_f32(float* xrow, const float* gain, int lane) {
    f32x4* xr = (f32x4*)xrow + lane; const f32x4* gr = (const f32x4*)gain + lane;
    f32x4 v[4]; float s = 0.f;
#pragma unroll
    for (int j = 0; j < 4; ++j) { v[j] = xr[64 * j]; s += (v[j].x * v[j].x + v[j].y * v[j].y) + (v[j].z * v[j].z + v[j].w * v[j].w); }
    const float rstd = 1.f / sqrtf(wave_sum(s) * (1.f / DM) + 1e-6f);
#pragma unroll
    for (int j = 0; j < 4; ++j) { const f32x4 g = gr[64 * j]; xr[64 * j] = v[j] * rstd * g; }
}

constexpr int KSTR = 144;
constexpr int ATT_K_OFF = 0, ATT_V_OFF = 2 * 64 * KSTR, ATT_SCR_OFF = ATT_V_OFF + 2 * 64 * 320;
__device__ __forceinline__ int crow(int r, int hi) { return (r & 3) + 8 * (r >> 2) + 4 * hi; }
typedef short v4i16_t __attribute__((ext_vector_type(4)));
__device__ __forceinline__ s16x4 vtr(const LAS unsigned char* p) { return __builtin_bit_cast(s16x4, __builtin_amdgcn_ds_read_tr16_b64_v4i16((LAS v4i16_t*)p)); }

template <int VD, bool WIN>
__device__ __forceinline__ void attn_unit(LAS unsigned char* lds, const bf16_t* Qp, const bf16_t* Kp, const bf16_t* Vp, size_t pitch,
                                          int q0, int L, float slope2, int W, float m_init, float l_init,
                                          float* Oout, size_t opitch, float* lse_out, size_t lpitch, bf16_t* Obf) {
    constexpr int VSTR = VD * 2 + 64, ND = VD / 32, VCH = VD / 8, VLD = 64 * VCH / NTHREADS;
    int tid_l = threadIdx.x; asm volatile("" : "+v"(tid_l)); const int tid = tid_l, lane = tid & 63, r32 = lane & 31, hi = lane >> 5, wid = __builtin_amdgcn_readfirstlane(tid >> 6);
    const int qw = q0 + wid * 32;
    int tlo = 0, thi = L / 64;
    if (WIN) { const int a = q0 - W; tlo = a > 0 ? a / 64 : 0; const int b = q0 + 256 + W; thi = (b < L ? b : L) / 64; }
    bf16x8 qr[4];
    { const bf16_t* qrow = Qp + (size_t)(qw + r32) * pitch + hi * 8;
#pragma unroll
      for (int d0 = 0; d0 < 4; ++d0) qr[d0] = *(const bf16x8*)(qrow + d0 * 16); }
    f32x16 o[ND];
#pragma unroll
    for (int d = 0; d < ND; ++d)
#pragma unroll
        for (int r = 0; r < 16; ++r) o[d][r] = 0.f;
    float m = m_init, l = hi == 0 ? l_init : 0.f;
    LAS float* wsf = (LAS float*)(lds + ATT_SCR_OFF) + wid * 64;
    const int krow = tid >> 3, kch = tid & 7;
    u32x4 kreg; u32x4 vreg[VLD];
#define ATT_GLOAD(t) do { kreg = *(const u32x4*)(Kp + (size_t)(64 * (t) + krow) * pitch + kch * 8); \
        _Pragma("unroll") for (int i_ = 0; i_ < VLD; ++i_) { const int idx_ = tid + NTHREADS * i_; vreg[i_] = *(const u32x4*)(Vp + (size_t)(64 * (t) + idx_ / VCH) * pitch + (idx_ % VCH) * 8); } } while (0)
#define ATT_LSTORE(b) do { *(LAS u32x4*)(lds + ATT_K_OFF + (b) * 64 * KSTR + krow * KSTR + kch * 16) = kreg; \
        _Pragma("unroll") for (int i_ = 0; i_ < VLD; ++i_) { const int idx_ = tid + NTHREADS * i_; *(LAS u32x4*)(lds + ATT_V_OFF + (b) * 64 * VSTR + (idx_ / VCH) * VSTR + (idx_ % VCH) * 16) = vreg[i_]; } } while (0)
    const int n = thi - tlo;
    ATT_GLOAD(tlo); ATT_LSTORE(0); __syncthreads();
    const float Wf = (float)W;
    for (int i = 0; i < n; ++i) {
        const int t = tlo + i, buf = i & 1;
        if (i + 1 < n) ATT_GLOAD(t + 1);
        bool active = true;
        if (WIN) { const int kb = 64 * t; active = (kb + 63 >= qw - W) && (kb <= qw + 31 + W); }
        if (active) {
            const LAS unsigned char* Kb = lds + ATT_K_OFF + buf * 64 * KSTR + r32 * KSTR + hi * 16;
            f32x16 p0, p1;
#pragma unroll
            for (int r = 0; r < 16; ++r) { p0[r] = 0.f; p1[r] = 0.f; }
#pragma unroll
            for (int d0 = 0; d0 < 4; ++d0) {
                const bf16x8 a0 = *(const LAS bf16x8*)(Kb + d0 * 32), a1 = *(const LAS bf16x8*)(Kb + 32 * KSTR + d0 * 32);
                p0 = __builtin_amdgcn_mfma_f32_32x32x16_bf16(a0, qr[d0], p0, 0, 0, 0);
                p1 = __builtin_amdgcn_mfma_f32_32x32x16_bf16(a1, qr[d0], p1, 0, 0, 0);
                if (d0 & 1) __builtin_amdgcn_sched_barrier(0);
            }
            const float dq = (float)(64 * t + 4 * hi - (qw + r32));
            float rm = -INFINITY;
#pragma unroll
            for (int r = 0; r < 16; ++r) {
                const float t0 = dq + (float)((r & 3) + 8 * (r >> 2)), t1 = t0 + 32.f;
                p0[r] = __builtin_fmaf(-slope2, __builtin_fabsf(t0), p0[r]);
                p1[r] = __builtin_fmaf(-slope2, __builtin_fabsf(t1), p1[r]);
                if (WIN) { if (__builtin_fabsf(t0) > Wf) p0[r] = -INFINITY; if (__builtin_fabsf(t1) > Wf) p1[r] = -INFINITY; }
                rm = __builtin_fmaxf(rm, __builtin_fmaxf(p0[r], p1[r]));
            }
            rm = __builtin_fmaxf(rm, __shfl_xor(rm, 32));
            if (__any(rm > m)) {
                const float mn = __builtin_fmaxf(m, rm); const float f = __builtin_amdgcn_exp2f(m - mn); m = mn; l *= f;
                if (hi == 0) wsf[r32] = f;
#pragma unroll
                for (int r = 0; r < 16; ++r) { const float fr = wsf[crow(r, hi)];
#pragma unroll
                    for (int d = 0; d < ND; ++d) o[d][r] *= fr; }
            }
            float ls = 0.f;
#pragma unroll
            for (int r = 0; r < 16; ++r) { p0[r] = __builtin_amdgcn_exp2f(p0[r] - m); p1[r] = __builtin_amdgcn_exp2f(p1[r] - m); ls += p0[r] + p1[r]; }
            l += ls;
            u32x4 pw[4];
#pragma unroll
            for (int c = 0; c < 4; ++c) {
                const f32x16& P = (c >> 1) ? p1 : p0; const int b = 8 * (c & 1);
                pw[c].x = cvt_pk(P[b + 0], P[b + 1]); pw[c].y = cvt_pk(P[b + 2], P[b + 3]); pw[c].z = cvt_pk(P[b + 4], P[b + 5]); pw[c].w = cvt_pk(P[b + 6], P[b + 7]);
            }
            const LAS unsigned char* Vb = lds + ATT_V_OFF + buf * 64 * VSTR + (4 * hi + ((lane & 15) >> 2)) * VSTR + (16 * ((lane >> 4) & 1) + 4 * (lane & 3)) * 2;
#pragma unroll
            for (int c = 0; c < 4; ++c)
#pragma unroll
                for (int d = 0; d < ND; ++d) {
                    const s16x4 vlo = vtr(Vb + c * 16 * VSTR + d * 64), vhi = vtr(Vb + c * 16 * VSTR + 8 * VSTR + d * 64);
                    const bf16x8 vf = (bf16x8){vlo[0], vlo[1], vlo[2], vlo[3], vhi[0], vhi[1], vhi[2], vhi[3]};
                    o[d] = __builtin_amdgcn_mfma_f32_32x32x16_bf16(__builtin_bit_cast(bf16x8, pw[c]), vf, o[d], 0, 0, 0);
                    if (d == ND - 1) __builtin_amdgcn_sched_barrier(0);
                }
        }
        if (i + 1 < n) ATT_LSTORE(buf ^ 1);
        __syncthreads();
    }
#undef ATT_GLOAD
#undef ATT_LSTORE
    l += __shfl_xor(l, 32);
    if (hi == 0) wsf[r32] = 1.f / l;
#pragma unroll
    for (int r = 0; r < 16; ++r) { const float ir = wsf[crow(r, hi)];
        if (Obf != nullptr) { bf16_t* orow = Obf + (size_t)(qw + crow(r, hi)) * opitch + r32;
#pragma unroll
            for (int d = 0; d < ND; ++d) orow[d * 32] = (bf16_t)f2bf(o[d][r] * ir);
        } else { float* orow = Oout + (size_t)(qw + crow(r, hi)) * opitch + r32;
#pragma unroll
            for (int d = 0; d < ND; ++d) orow[d * 32] = o[d][r] * ir; } }
    if (lse_out != nullptr && hi == 0) lse_out[(size_t)(qw + r32) * lpitch] = (m + __builtin_log2f(l)) * LN2;
    __syncthreads();
}

__device__ __forceinline__ void row_to_bf16_ssq(const float* xrow, bf16_t* orow, float* ssq, int lane) {
    const f32x4* xr = (const f32x4*)xrow + lane;
    f32x4 v[4]; float s = 0.f;
#pragma unroll
    for (int j = 0; j < 4; ++j) { v[j] = xr[64 * j]; s += (v[j].x * v[j].x + v[j].y * v[j].y) + (v[j].z * v[j].z + v[j].w * v[j].w); }
    s = wave_sum(s);
    u32x2* o8 = (u32x2*)orow + lane;
#pragma unroll
    for (int j = 0; j < 4; ++j) { u32x2 w; w.x = pk2(v[j].x, v[j].y); w.y = pk2(v[j].z, v[j].w); o8[64 * j] = w; }
    if (lane == 0) *ssq = s;
}
constexpr int BK_OFF = 0, BV_OFF = 2 * 64 * KSTR, BSCR_OFF = BV_OFF + 3 * 64 * 320, ATT_O0_OFF = BSCR_OFF + 2048;
static_assert(ATT_O0_OFF + 65536 <= 147456, "B attention LDS map");
constexpr float B_THR = 6.0f;
#ifndef B_LATE
#define B_LATE(w) false
#endif
__device__ __forceinline__ float max3f(float a, float b, float c) { float r; asm("v_max3_f32 %0, %1, %2, %3" : "=v"(r) : "v"(a), "v"(b), "v"(c)); return r; }
__device__ __forceinline__ void attn_b_unit(LAS unsigned char* lds, const bf16_t* base, int h, int q0, int L, float slope2_, float lam,
                                            const float* subln_l, float postscale, bf16_t* mix) {
    constexpr int VD = 128, VSTR = VD * 2 + 64, ND = 4, VCH = 16, VLD = 2;
    int tid_l = threadIdx.x; asm volatile("" : "+v"(tid_l)); const int tid = tid_l, lane = tid & 63, r32 = lane & 31, hi = lane >> 5, wid = __builtin_amdgcn_readfirstlane(tid >> 6);
    const int qw = q0 + wid * 32, NT = L / 64, c0 = q0 / 64;
    LAS float* wsf = (LAS float*)(lds + BSCR_OFF) + wid * 64;
    const bool late = B_LATE(wid);
    const int krow = tid >> 3, kch = tid & 7;
    const bf16_t* Vp = base + 1536 + h * 128;
    const float qposf_ = (float)(qw + r32);
    for (int mp = 0; mp < 2; ++mp) {
        const bf16_t* Qp = base + 512 + (h * 2 + mp) * 64; const bf16_t* Kp = base + 1024 + (h * 2 + mp) * 64;
        bf16x8 qr[4];
        { const bf16_t* qrow = Qp + (size_t)(qw + r32) * DIN + hi * 8;
#pragma unroll
          for (int d0 = 0; d0 < 4; ++d0) qr[d0] = *(const bf16x8*)(qrow + d0 * 16); }
        f32x16 o[ND];
#pragma unroll
        for (int d = 0; d < ND; ++d)
#pragma unroll
            for (int r = 0; r < 16; ++r) o[d][r] = 0.f;
        float mref = 0.f, l = 0.f;
        u32x4 kreg; u32x4 vreg[VLD];
        const unsigned koff = (unsigned)(krow * DIN + kch * 8) * 2u, voff = (unsigned)((tid >> 4) * DIN + (tid & 15) * 8) * 2u;
#define ATT_GLOAD(t) do { const char* kt_ = (const char*)Kp + (size_t)(t) * (64 * DIN * 2); const char* vt_ = (const char*)Vp + (size_t)(t) * (64 * DIN * 2); \
        kreg = *(const u32x4*)(kt_ + koff); vreg[0] = *(const u32x4*)(vt_ + voff); vreg[1] = *(const u32x4*)(vt_ + 32 * DIN * 2 + voff); } while (0)
#define ATT_LSTORE(b, vs) do { *(LAS u32x4*)(lds + BK_OFF + (b) * 64 * KSTR + krow * KSTR + kch * 16) = kreg; \
        *(LAS u32x4*)(lds + BV_OFF + (vs) * 64 * VSTR + (tid >> 4) * VSTR + (tid & 15) * 16) = vreg[0]; *(LAS u32x4*)(lds + BV_OFF + (vs) * 64 * VSTR + ((tid >> 4) + 32) * VSTR + (tid & 15) * 16) = vreg[1]; } while (0)
#define VFRAG(x, d) (bf16x8){x[d][0][0], x[d][0][1], x[d][0][2], x[d][0][3], x[d][1][0], x[d][1][1], x[d][1][2], x[d][1][3]}
#define PV_LOAD01(vs) do { \
        const LAS unsigned char* Vb = lds + BV_OFF + (vs) * 64 * VSTR + (4 * hi + ((lane & 15) >> 2)) * VSTR + (16 * ((lane >> 4) & 1) + 4 * (lane & 3)) * 2; \
        _Pragma("unroll") for (int d = 0; d < ND; ++d) { va[d][0] = vtr(Vb + d * 64); va[d][1] = vtr(Vb + 8 * VSTR + d * 64); } \
        _Pragma("unroll") for (int d = 0; d < ND; ++d) { vb2[d][0] = vtr(Vb + 16 * VSTR + d * 64); vb2[d][1] = vtr(Vb + 16 * VSTR + 8 * VSTR + d * 64); } \
        __builtin_amdgcn_sched_barrier(0); } while (0)
#define PV_MMA(vs) do { \
        const LAS unsigned char* Vb = lds + BV_OFF + (vs) * 64 * VSTR + (4 * hi + ((lane & 15) >> 2)) * VSTR + (16 * ((lane >> 4) & 1) + 4 * (lane & 3)) * 2; \
        _Pragma("unroll") for (int d = 0; d < ND; ++d) o[d] = __builtin_amdgcn_mfma_f32_32x32x16_bf16(__builtin_bit_cast(bf16x8, pw[0]), VFRAG(va, d), o[d], 0, 0, 0); \
        __builtin_amdgcn_sched_barrier(0); \
        _Pragma("unroll") for (int d = 0; d < ND; ++d) { va[d][0] = vtr(Vb + 32 * VSTR + d * 64); va[d][1] = vtr(Vb + 32 * VSTR + 8 * VSTR + d * 64); } \
        __builtin_amdgcn_sched_barrier(0); \
        _Pragma("unroll") for (int d = 0; d < ND; ++d) o[d] = __builtin_amdgcn_mfma_f32_32x32x16_bf16(__builtin_bit_cast(bf16x8, pw[1]), VFRAG(vb2, d), o[d], 0, 0, 0); \
        __builtin_amdgcn_sched_barrier(0); \
        _Pragma("unroll") for (int d = 0; d < ND; ++d) { vb2[d][0] = vtr(Vb + 48 * VSTR + d * 64); vb2[d][1] = vtr(Vb + 48 * VSTR + 8 * VSTR + d * 64); } \
        __builtin_amdgcn_sched_barrier(0); \
        _Pragma("unroll") for (int d = 0; d < ND; ++d) o[d] = __builtin_amdgcn_mfma_f32_32x32x16_bf16(__builtin_bit_cast(bf16x8, pw[2]), VFRAG(va, d), o[d], 0, 0, 0); \
        _Pragma("unroll") for (int d = 0; d < ND; ++d) o[d] = __builtin_amdgcn_mfma_f32_32x32x16_bf16(__builtin_bit_cast(bf16x8, pw[3]), VFRAG(vb2, d), o[d], 0, 0, 0); \
        __builtin_amdgcn_sched_barrier(0); } while (0)
        int first = 1; asm volatile("" : "+s"(first));
#define B_TILE(i_) ((i_) < 4 ? c0 + (i_) : ((i_) - 4 < c0 ? (i_) - 4 : (i_)))
        int t = B_TILE(0);
        int vs_prev = 2, vs_cur = 0, vs_next = 1;
        u32x4 pw[4];
        ATT_GLOAD(t); ATT_LSTORE(0, 0); __syncthreads();
        for (int i = 0; i < NT; ++i) {
            const int buf = i & 1;
            int tn = 0;
            if (i + 1 < NT) { tn = B_TILE(i + 1); ATT_GLOAD(tn); }
            s16x4 va[ND][2], vb2[ND][2];
            if (late && !first) { PV_LOAD01(vs_prev); PV_MMA(vs_prev); }
            f32x16 p0, p1;
            const int kb = 64 * t;
            float slope2 = slope2_, qposf = qposf_; asm volatile("" : "+v"(slope2), "+v"(qposf));
            if (kb + 63 < qw || kb > qw + 31) {
                const float sg = (kb > qw) ? -slope2 : slope2;
                const float b0 = sg * ((float)(kb + 4 * hi) - qposf) - mref, b1 = b0 + 32.f * sg;
#pragma unroll
                for (int r = 0; r < 16; ++r) { const float kv = (float)((r & 3) + 8 * (r >> 2)); p0[r] = __builtin_fmaf(sg, kv, b0); p1[r] = __builtin_fmaf(sg, kv, b1); }
            } else {
                const float dq = (float)(kb + 4 * hi) - qposf;
#pragma unroll
                for (int r = 0; r < 16; ++r) { const float t0 = dq + (float)((r & 3) + 8 * (r >> 2)); p0[r] = __builtin_fmaf(-slope2, __builtin_fabsf(t0), -mref); p1[r] = __builtin_fmaf(-slope2, __builtin_fabsf(t0 + 32.f), -mref); }
            }
            const LAS unsigned char* Kb = lds + BK_OFF + buf * 64 * KSTR + r32 * KSTR + hi * 16;
            bf16x8 kf[8];
#pragma unroll
            for (int d0 = 0; d0 < 4; ++d0) { kf[2 * d0] = *(const LAS bf16x8*)(Kb + d0 * 32); kf[2 * d0 + 1] = *(const LAS bf16x8*)(Kb + 32 * KSTR + d0 * 32); }
            __builtin_amdgcn_sched_barrier(0);
#pragma unroll
            for (int d0 = 0; d0 < 4; ++d0) {
                p0 = __builtin_amdgcn_mfma_f32_32x32x16_bf16(kf[2 * d0], qr[d0], p0, 0, 0, 0);
                p1 = __builtin_amdgcn_mfma_f32_32x32x16_bf16(kf[2 * d0 + 1], qr[d0], p1, 0, 0, 0);
            }
            if (!late) PV_LOAD01(vs_cur);
            asm volatile("s_nop 15\n\ts_nop 7" : "+v"(p0), "+v"(p1));
            float rm = max3f(p0[0], p1[0], p0[1]);
#pragma unroll
            for (int r = 1; r < 15; ++r) rm = max3f(rm, p1[r], p0[r + 1]);
            rm = max3f(rm, p1[15], rm);
            rm = max3f(rm, __shfl_xor(rm, 32), rm);
            if (first || __any(rm > B_THR)) {
                const float delta = (first || rm > B_THR) ? rm : 0.f; const float f = __builtin_amdgcn_exp2f(-delta); mref += delta; l *= f;
#pragma unroll
                for (int r = 0; r < 16; ++r) { p0[r] -= delta; p1[r] -= delta; }
                {
                    if (hi == 0) wsf[r32] = f;
#pragma unroll
                    for (int r = 0; r < 16; ++r) { const float fr = wsf[crow(r, hi)];
#pragma unroll
                        for (int d = 0; d < ND; ++d) o[d][r] *= fr; }
                }
            }
            float ls0 = 0.f, ls1 = 0.f;
#pragma unroll
            for (int r = 0; r < 16; ++r) { p0[r] = __builtin_amdgcn_exp2f(p0[r]); p1[r] = __builtin_amdgcn_exp2f(p1[r]); ls0 += p0[r]; ls1 += p1[r]; }
            l += ls0 + ls1;
#pragma unroll
            for (int c = 0; c < 4; ++c) {
                const f32x16& P = (c >> 1) ? p1 : p0; const int b = 8 * (c & 1);
                pw[c].x = cvt_pk(P[b + 0], P[b + 1]); pw[c].y = cvt_pk(P[b + 2], P[b + 3]); pw[c].z = cvt_pk(P[b + 4], P[b + 5]); pw[c].w = cvt_pk(P[b + 6], P[b + 7]);
            }
            __builtin_amdgcn_sched_barrier(0);
            if (!late) PV_MMA(vs_cur);
            first = 0;
            if (i + 1 < NT) ATT_LSTORE(buf ^ 1, vs_next);
            t = tn;
            { const int tmp_ = vs_prev; vs_prev = vs_cur; vs_cur = vs_next; vs_next = tmp_; }
            __syncthreads();
        }
        if (late) { s16x4 va[ND][2], vb2[ND][2]; PV_LOAD01(vs_prev); PV_MMA(vs_prev); }
#undef PV_LOAD01
#undef PV_MMA
#undef B_TILE
#undef VFRAG
#undef ATT_GLOAD
#undef ATT_LSTORE
        l += __shfl_xor(l, 32);
        if (hi == 0) wsf[r32] = 1.f / l;
        int lane_e = lane, qw_e = qw; asm volatile("" : "+v"(lane_e)); asm volatile("" : "+s"(qw_e));
        const int r32 = lane_e & 31, hi = lane_e >> 5, qw = qw_e;
        LAS unsigned* o0buf = (LAS unsigned*)(lds + ATT_O0_OFF) + wid * 2048 + lane_e;
        if (mp == 0) {
#pragma unroll
            for (int d = 0; d < ND; ++d)
#pragma unroll
                for (int r = 0; r < 16; r += 2) { const float i0 = wsf[crow(r, hi)], i1 = wsf[crow(r + 1, hi)]; o0buf[(d * 8 + (r >> 1)) * 64] = cvt_pk(o[d][r] * i0, o[d][r + 1] * i1); }
        } else {
            float gs[ND];
#pragma unroll
            for (int d = 0; d < ND; ++d) gs[d] = subln_l[d * 32 + r32] * postscale;
#pragma unroll
            for (int r = 0; r < 16; r += 2) {
                const float i0 = wsf[crow(r, hi)], i1 = wsf[crow(r + 1, hi)];
                float v0[ND], v1[ND]; float s0 = 0.f, s1 = 0.f;
#pragma unroll
                for (int d = 0; d < ND; ++d) { const unsigned w = o0buf[(d * 8 + (r >> 1)) * 64];
                    v0[d] = __builtin_bit_cast(float, w << 16) - lam * (o[d][r] * i0); v1[d] = __builtin_bit_cast(float, w & 0xffff0000u) - lam * (o[d][r + 1] * i1);
                    s0 += v0[d] * v0[d]; s1 += v1[d] * v1[d]; }
#pragma unroll
                for (int sh = 1; sh < 32; sh <<= 1) { s0 += __shfl_xor(s0, sh); s1 += __shfl_xor(s1, sh); }
                const float r0 = 1.f / sqrtf(s0 * (1.f / 128.f) + 1e-5f), r1 = 1.f / sqrtf(s1 * (1.f / 128.f) + 1e-5f);
                bf16_t* row0 = mix + (size_t)(qw + crow(r, hi)) * DM + r32; bf16_t* row1 = mix + (size_t)(qw + crow(r + 1, hi)) * DM + r32;
#pragma unroll
                for (int d = 0; d < ND; ++d) { row0[d * 32] = (bf16_t)f2bf(v0[d] * r0 * gs[d]); row1[d * 32] = (bf16_t)f2bf(v1[d] * r1 * gs[d]); }
            }
        }
        __syncthreads();
    }
}
__device__ __forceinline__ float alibi_slope(int i, int n) { return exp2f(-8.0f * (float)(i + 1) / (float)n); }
struct Ctx { int tid, lane, wave, G, cu, gw, NGW; };

__device__ __forceinline__ void ph_weights(const Args& a, const Ctx& c, LAS unsigned char* lds) {
    unsigned char* ws = a.ws;
    bf16_t* WinT = (bf16_t*)(ws + WS_WIN); bf16_t* WoutT = (bf16_t*)(ws + WS_WOUT); bf16_t* WupT = (bf16_t*)(ws + WS_WUP); bf16_t* WdnT = (bf16_t*)(ws + WS_WDN);
    const float* w_in = a.in[3]; const float* w_out = a.in[10]; const float* w_up = a.in[12]; const float* w_down = a.in[15];
    LAS float* scr = (LAS float*)(lds + c.wave * 16384);
    constexpr int I_IN = (DM / 64) * (DIN / 32), I_OUT = (DM / 64) * (DM / 32), I_UP = (DM / 64) * (DUP / 32), I_DN = (DFF / 64) * (DM / 32);
    constexpr int PER_L = I_IN + I_OUT + I_UP + I_DN;
    for (int it = c.gw; it < DEPTH * PER_L; it += c.NGW) {
        const int l = it / PER_L; int r = it % PER_L;
        if (r < I_IN) { transpose_item(w_in + (size_t)l * DM * DIN, DM, DIN, WinT + (size_t)l * DIN * DM, scr, r, c.lane, a.in[2] + l * DM); continue; } r -= I_IN;
        if (r < I_OUT) { transpose_item(w_out + (size_t)l * DM * DM, DM, DM, WoutT + (size_t)l * DM * DM, scr, r, c.lane, nullptr); continue; } r -= I_OUT;
        if (r < I_UP) { transpose_item(w_up + (size_t)l * DM * DUP, DM, DUP, WupT + (size_t)l * DUP * DM, scr, r, c.lane, a.in[11] + l * DM, true); continue; } r -= I_UP;
        transpose_item(w_down + (size_t)l * DFF * DM, DFF, DM, WdnT + (size_t)l * DM * DFF, scr, r, c.lane, nullptr);
    }
}
__device__ __forceinline__ const float* chunk_in(const Args& a, int ch) { return ch == 0 ? a.in[0] : a.in[1] + (size_t)(ch - 1) * CH_ROWS * DM; }
__device__ __forceinline__ float* chunk_out(const Args& a, int ch) { return a.out + (size_t)ch * CH_ROWS * DM; }

__device__ __forceinline__ void ph_norm_bf16(const Ctx& c, const float* xsrc, const float* gain, bf16_t* HB) {
    for (int r = c.gw; r < CH_ROWS; r += c.NGW) rms_row_to_bf16(xsrc + (size_t)r * DM, gain, HB + (size_t)r * DM, c.lane);
}
__device__ __forceinline__ void ph_final_norm(const Ctx& c, float* xo, const float* gain) {
    for (int r = c.gw; r < CH_ROWS; r += c.NGW) rms_row_f32(xo + (size_t)r * DM, gain, c.lane);
}

__device__ __forceinline__ void ph_attn(const Args& a, const Ctx& c, LAS unsigned char* lds, int ch, int layer) {
    const bf16_t* PROJ = (const bf16_t*)(a.ws + WS_PROJ); float* TMP = (float*)(a.ws + WS_TMP);
    const int SL = ch == 0 ? 16384 : 4096, sl_shift = ch == 0 ? 14 : 12;
    const int cu = c.cu, G = c.G;
#ifndef SKIP_B
    {
        const float lam_init = layer == 0 ? 0.2f : (0.8f - 0.6f * 0.7408182206817179f);
        const float s1 = wave_sum(a.in[5][layer * 64 + c.lane] * a.in[6][layer * 64 + c.lane]);
        const float s2 = wave_sum(a.in[7][layer * 64 + c.lane] * a.in[8][layer * 64 + c.lane]);
        const float lam = expf(s1) - expf(s2) + lam_init;
        bf16_t* HBm = (bf16_t*)(a.ws + WS_HB);
#ifdef PROBE_B2
        for (int rep_ = 0; rep_ < 2; ++rep_)
#endif
        for (int u = cu; u < 256; u += G) {
            int seq, h, qb; const int xcd = u & 7, idx = u >> 3;
            if (ch == 0) { seq = 0; h = xcd >> 1; qb = (xcd & 1) * 32 + idx; }
            else { const int pair = xcd * 2 + (idx >> 4); seq = pair >> 2; h = pair & 3; qb = idx & 15; }
            const size_t rb = (size_t)seq * SL;
            attn_b_unit(lds, PROJ + rb * DIN, h, qb * 256, SL, alibi_slope(h, 4) * LOG2E, lam, a.in[9] + layer * 128, 1.f - lam_init, HBm + rb * DM + 256 + h * 128);
        }
    }
#endif
#ifndef SKIP_AC
#ifdef PROBE_AC2
    for (int rep_ = 0; rep_ < 2; ++rep_)
#endif
    for (int uu = cu; uu < 1024; uu += G) {
        const bf16_t *qp, *kp, *vp; size_t pitch, opitch, lpitch; int q0, L, W; float slope2, m_init, l_init; float *op, *lp; bf16_t* obf;
        if (uu < 256) {
            const int hq = uu >> 6, blk = uu & 63;
            const int seq = (blk * 256) >> sl_shift, qb = blk - ((seq << sl_shift) >> 8);
            const size_t rb = (size_t)seq * SL; const bf16_t* base = PROJ + rb * DIN;
            qp = base + hq * 64; kp = base + 256 + (hq >> 1) * 64; vp = base + 384 + (hq >> 1) * 64; pitch = DIN; q0 = qb * 256; L = SL;
            slope2 = alibi_slope(hq, 4) * LOG2E; W = 128; m_init = a.in[4][layer * 4 + hq] * LOG2E; l_init = 1.f;
            op = nullptr; obf = (bf16_t*)(a.ws + WS_HB) + rb * DM + hq * 64; opitch = DM; lp = nullptr; lpitch = 0;
        } else {
            const int uc = uu - 256;
            const int gh = uc >> 6, blk = uc & 63, gq = gh >> 2;
            const int dsh = 2 * gq, d = 1 << dsh;
            const int seq = (blk * 256) >> sl_shift, b2 = blk - ((seq << sl_shift) >> 8);
            const int nbr = (SL >> dsh) >> 8;
            const int res = b2 / nbr, qb = b2 % nbr;
            const size_t rb = (size_t)seq * SL + res; const bf16_t* base = PROJ + rb * DIN;
            qp = base + 2048 + gh * 64; kp = base + 2816 + gh * 64; vp = base + 3584 + gh * 64; pitch = (size_t)DIN * d; q0 = qb * 256; L = SL >> dsh;
            slope2 = alibi_slope(gh, 12) * (float)d * LOG2E; W = 64; m_init = -1e30f; l_init = 0.f;
            op = TMP + rb * TW + T_C + gh * 64; obf = nullptr; opitch = (size_t)TW * d; lp = TMP + rb * TW + T_L + gh; lpitch = (size_t)TW * d;
        }
        attn_unit<64, true>(lds, qp, kp, vp, pitch, q0, L, slope2, W, m_init, l_init, op, opitch, lp, lpitch, obf);
    }
#endif
}

__device__ __forceinline__ void ph_combine(const Args& a, const Ctx& c, int layer) {
    const float* TMP = (const float*)(a.ws + WS_TMP); bf16_t* HB = (bf16_t*)(a.ws + WS_HB);
    { float* S2 = (float*)(a.ws + WS_SSQ) + 2 * CH_ROWS; for (int r = c.cu * NTHREADS + c.tid; r < CH_ROWS; r += c.G * NTHREADS) S2[r] = 0.f; }
    const int nitems = CH_ROWS * 32;
#pragma unroll 2
    for (int it = c.cu * NTHREADS + c.tid; it < nitems; it += c.G * NTHREADS) {
        const int r = it >> 5, h = (it >> 3) & 3, d8 = (it & 7) * 8;
        const float* tr = TMP + (size_t)r * TW;
        const float l0 = tr[T_L + h], l1 = tr[T_L + 4 + h], l2 = tr[T_L + 8 + h];
        const f32x4 a0 = *(const f32x4*)(tr + T_C + h * 64 + d8), a1 = *(const f32x4*)(tr + T_C + h * 64 + d8 + 4);
        const f32x4 b0 = *(const f32x4*)(tr + T_C + (4 + h) * 64 + d8), b1 = *(const f32x4*)(tr + T_C + (4 + h) * 64 + d8 + 4);
        const f32x4 c0 = *(const f32x4*)(tr + T_C + (8 + h) * 64 + d8), c1 = *(const f32x4*)(tr + T_C + (8 + h) * 64 + d8 + 4);
        const float mx = fmaxf(l0, fmaxf(l1, l2));
        float w0 = __expf(l0 - mx), w1 = __expf(l1 - mx), w2 = __expf(l2 - mx);
        const float inv = 1.f / (w0 + w1 + w2); w0 *= inv; w1 *= inv; w2 *= inv;
        const f32x4 o0 = a0 * w0 + b0 * w1 + c0 * w2, o1 = a1 * w0 + b1 * w1 + c1 * w2;
        u32x4 o; o.x = pk2(o0.x, o0.y); o.y = pk2(o0.z, o0.w); o.z = pk2(o1.x, o1.y); o.w = pk2(o1.z, o1.w);
        *(u32x4*)(HB + (size_t)r * DM + 768 + h * 64 + d8) = o;
    }
}

__device__ __forceinline__ void ph_conv(const Args& a, const Ctx& c, int ch, int layer) {
    const int par = ch & 1;
    const bf16_t* UB = (const bf16_t*)(a.ws + WS_PROJ); bf16_t* GB = (bf16_t*)(a.ws + WS_TMP);
    const int SL = ch == 0 ? 16384 : 4096;
    const float* cw = a.in[13] + (size_t)layer * 3 * DUP; const float* cb = a.in[14] + (size_t)layer * DUP;
    constexpr int NCG = DFF / 8, RB = 16;
    const int nitems = (CH_ROWS / RB) * NCG;
    { float* S1 = (float*)(a.ws + WS_SSQ) + par * CH_ROWS; for (int r = c.cu * NTHREADS + c.tid; r < CH_ROWS; r += c.G * NTHREADS) S1[r] = 0.f; }
    for (int it = c.cu * NTHREADS + c.tid; it < nitems; it += c.G * NTHREADS) {
        const int cg8 = it % NCG, rb = it / NCG, c0 = cg8 * 8, r0 = rb * RB;
        f32x4 wg[3][2], wv[3][2], bg[2], bv[2];
#pragma unroll
        for (int k = 0; k < 3; ++k)
#pragma unroll
            for (int j = 0; j < 2; ++j) { wg[k][j] = *(const f32x4*)(cw + k * DUP + c0 + 4 * j); wv[k][j] = *(const f32x4*)(cw + k * DUP + DFF + c0 + 4 * j); }
#pragma unroll
        for (int j = 0; j < 2; ++j) { bg[j] = *(const f32x4*)(cb + c0 + 4 * j); bv[j] = *(const f32x4*)(cb + DFF + c0 + 4 * j); }
        const bool first = (r0 & (SL - 1)) == 0, last = ((r0 + RB) & (SL - 1)) == 0;
        const u32x4 zero = (u32x4){0u, 0u, 0u, 0u};
        const bf16_t* up = UB + (size_t)r0 * DUP + c0;
        u32x4 pg_ = first ? zero : *(const u32x4*)(up - DUP), pv_ = first ? zero : *(const u32x4*)(up - DUP + DFF);
        u32x4 cg_ = *(const u32x4*)(up), cv_ = *(const u32x4*)(up + DFF);
        bf16_t* gp = GB + (size_t)r0 * DFF + c0;
#pragma unroll 4
        for (int rr = 0; rr < RB; ++rr) {
            const bool nz = (rr == RB - 1) && last;
            const u32x4 ng_ = nz ? zero : *(const u32x4*)(up + (size_t)(rr + 1) * DUP), nv_ = nz ? zero : *(const u32x4*)(up + (size_t)(rr + 1) * DUP + DFF);
            unsigned ow[4];
#pragma unroll
            for (int w = 0; w < 4; ++w) {
                float res[2];
#pragma unroll
                for (int hh = 0; hh < 2; ++hh) {
                    const int j = 2 * w + hh, q = j >> 2, e = j & 3;
                    const float gpv = hh ? __builtin_bit_cast(float, pg_[w] & 0xffff0000u) : __builtin_bit_cast(float, pg_[w] << 16);
                    const float gcv = hh ? __builtin_bit_cast(float, cg_[w] & 0xffff0000u) : __builtin_bit_cast(float, cg_[w] << 16);
                    const float gnv = hh ? __builtin_bit_cast(float, ng_[w] & 0xffff0000u) : __builtin_bit_cast(float, ng_[w] << 16);
                    const float vpv = hh ? __builtin_bit_cast(float, pv_[w] & 0xffff0000u) : __builtin_bit_cast(float, pv_[w] << 16);
                    const float vcv = hh ? __builtin_bit_cast(float, cv_[w] & 0xffff0000u) : __builtin_bit_cast(float, cv_[w] << 16);
                    const float vnv = hh ? __builtin_bit_cast(float, nv_[w] & 0xffff0000u) : __builtin_bit_cast(float, nv_[w] << 16);
                    const float gate = gpv * wg[0][q][e] + gcv * wg[1][q][e] + gnv * wg[2][q][e] + bg[q][e];
                    const float val = vpv * wv[0][q][e] + vcv * wv[1][q][e] + vnv * wv[2][q][e] + bv[q][e];
                    res[hh] = gate * __builtin_amdgcn_rcpf(1.f + __builtin_amdgcn_exp2f(-LOG2E * gate)) * val;
                }
                ow[w] = pk2(res[0], res[1]);
            }
            *(u32x4*)(gp + (size_t)rr * DFF) = (u32x4){ow[0], ow[1], ow[2], ow[3]};
            pg_ = cg_; pv_ = cv_; cg_ = ng_; cv_ = nv_;
        }
    }
}

constexpr int STEPS_PER_CHUNK = DEPTH * 6;
constexpr int NSTEPS = 1 + NCHUNK * STEPS_PER_CHUNK + 1;
__global__ void __launch_bounds__(NTHREADS, 2) mega_fwd(Args a) {
    extern __shared__ __attribute__((aligned(16))) unsigned char lds_raw[];
    LAS unsigned char* lds = (LAS unsigned char*)lds_raw;
    cg::grid_group grid = cg::this_grid();
    volatile LAS unsigned* bst = (volatile LAS unsigned*)(lds + 147456);
    if (threadIdx.x < 2) bst[threadIdx.x] = 0u;
    __syncthreads();
    XcdBarrier xbar = xcd_barrier_post((unsigned*)(a.ws + WS_CTL), bst);
#ifdef PROBE_P2
    for (int pass_ = 0; pass_ < 2; ++pass_)
#endif
    for (int step = 0; step < NSTEPS; ++step) {
        int tid_l = threadIdx.x, cu_l = blockIdx.x, G_l = gridDim.x;
        asm volatile("" : "+v"(tid_l)); asm volatile("" : "+s"(cu_l), "+s"(G_l));
        Ctx c; c.tid = tid_l; c.lane = c.tid & 63; c.wave = __builtin_amdgcn_readfirstlane(c.tid >> 6);
        c.G = G_l; c.cu = cu_l; c.gw = c.cu * 8 + c.wave; c.NGW = c.G * 8;
        unsigned char* ws = a.ws;
        if (step == 0) {
            ph_weights(a, c, lds);
            const float* xin = chunk_in(a, 0); bf16_t* XB = (bf16_t*)(ws + WS_XB); float* S1 = (float*)(ws + WS_SSQ);
            for (int r = c.gw; r < CH_ROWS; r += c.NGW) row_to_bf16_ssq(xin + (size_t)r * DM, XB + (size_t)r * DM, S1 + r, c.lane);
        } else if (step == NSTEPS - 1) ph_final_norm(c, chunk_out(a, NCHUNK - 1), a.in[16]);
        else {
            const int s = step - 1, ch = s / STEPS_PER_CHUNK, sc = s % STEPS_PER_CHUNK, par = ch & 1;
            bf16_t* HB = (bf16_t*)(ws + WS_HB); bf16_t* XB = (bf16_t*)(ws + WS_XB) + (size_t)par * CH_ROWS * DM;
            float* S1 = (float*)(ws + WS_SSQ) + par * CH_ROWS; float* S2 = (float*)(ws + WS_SSQ) + 2 * CH_ROWS;
            float* xo = chunk_out(a, ch);
            {
                const int layer = sc / 6, ph = sc % 6;
                const float* xsrc = layer == 0 ? chunk_in(a, ch) : (const float*)xo;
                if (ph == 0) {
                    pg8::Gemm g{XB, (const bf16_t*)(ws + WS_WIN) + (size_t)layer * DIN * DM, CH_ROWS, DIN, DM}; pg8::StaticOrder S; S.init(CH_ROWS, DIN, c.G, c.cu);
                    pg8::EpiBf16S2 E{(bf16_t*)(ws + WS_PROJ), DIN, 1805u, QSCALE, S1};
#ifdef PROBE_G2
                    for (int rep_ = 0; rep_ < 2; ++rep_)
#endif
                    pg8::gemm_phase<pg8::EpiBf16S2, pg8::StaticOrder, true, true>(lds, g, S, E);
                    if (layer == 0 && ch > 0) {
                        const int nfull = (CH_ROWS / 256) * (DIN / 256) % c.G;
                        if (nfull > 0 && c.cu >= nfull) { float* xp = chunk_out(a, ch - 1); const int nw = (c.G - nfull) * 8;
                            for (int r = (c.cu - nfull) * 8 + c.wave; r < CH_ROWS; r += nw) rms_row_f32(xp + (size_t)r * DM, a.in[16], c.lane); }
                        else if (nfull == 0) ph_final_norm(c, chunk_out(a, ch - 1), a.in[16]);
                    }
                } else if (ph == 1) {
                    ph_attn(a, c, lds, ch, layer);
                } else if (ph == 2) {
                    ph_combine(a, c, layer);
                } else if (ph == 3) {
                    pg8::Gemm g{HB, (const bf16_t*)(ws + WS_WOUT) + (size_t)layer * DM * DM, CH_ROWS, DM, DM}; pg8::StaticOrder S; S.init(CH_ROWS, DM, c.G, c.cu);
                    pg8::EpiRes2 E{xsrc, xo, XB, S2, DM};
#ifdef PROBE_GE2
                    { pg8::EpiRes2 E0{xsrc, (float*)(ws + WS_PROJ), (bf16_t*)(ws + WS_PROJ + 72 * MiB), (float*)(ws + WS_PROJ + 110 * MiB), DM}; pg8::gemm_phase<pg8::EpiRes2, pg8::StaticOrder, true, true>(lds, g, S, E0); }
#endif
                    pg8::gemm_phase<pg8::EpiRes2, pg8::StaticOrder, true, true>(lds, g, S, E);
                } else if (ph == 4) {
                    pg8::Gemm g{XB - DM, (const bf16_t*)(ws + WS_WUP) + (size_t)layer * DUP * DM, 65 * 256, DUP, DM, 254}; pg8::StaticOrder S; S.init(65 * 256, DUP, c.G, c.cu);
                    pg8::EpiConv E{(bf16_t*)(ws + WS_TMP), S2, a.in[13] + (size_t)layer * 3 * DUP, a.in[14] + (size_t)layer * DUP, (ch == 0 ? 16384 : 4096) - 1, (LAS float*)(lds + 147456 + 256), CH_ROWS};
                    pg8::gemm_phase<pg8::EpiConv, pg8::StaticOrder, true, true>(lds, g, S, E);
                    { float* S1z = S1; for (int r = c.cu * NTHREADS + c.tid; r < CH_ROWS; r += c.G * NTHREADS) S1z[r] = 0.f; }
                    if (layer == DEPTH - 1 && ch + 1 < NCHUNK) {
                        const float* xin = chunk_in(a, ch + 1); bf16_t* XBn = (bf16_t*)(ws + WS_XB) + (size_t)(par ^ 1) * CH_ROWS * DM; float* S1n = (float*)(ws + WS_SSQ) + (par ^ 1) * CH_ROWS;
                        for (int r = c.gw; r < CH_ROWS; r += c.NGW) row_to_bf16_ssq(xin + (size_t)r * DM, XBn + (size_t)r * DM, S1n + r, c.lane);
                    }
                } else {
                    pg8::Gemm g{(const bf16_t*)(ws + WS_TMP), (const bf16_t*)(ws + WS_WDN) + (size_t)layer * DM * DFF, CH_ROWS, DM, DFF}; pg8::StaticOrder S; S.init(CH_ROWS, DM, c.G, c.cu);
                    pg8::EpiRes2 E{xo, xo, XB, S1, DM};
#ifdef PROBE_GE2
                    { pg8::EpiRes2 E0{xo, (float*)(ws + WS_PROJ), (bf16_t*)(ws + WS_PROJ + 72 * MiB), (float*)(ws + WS_PROJ + 110 * MiB), DM}; pg8::gemm_phase<pg8::EpiRes2, pg8::StaticOrder, true, true>(lds, g, S, E0); }
#endif
                    pg8::gemm_phase<pg8::EpiRes2, pg8::StaticOrder, true, true>(lds, g, S, E);
                }
            }
        }
#ifdef PROBE_P2
        if (step == 0) grid.sync(); else xcd_barrier(xbar);
#else
        if (step == 0) grid.sync(); else if (step != NSTEPS - 1) xcd_barrier(xbar);
#endif
    }
#ifdef PROBE_TA
    if (blockIdx.x == 0 && threadIdx.x < 64) {
        float* xo = chunk_out(a, NCHUNK - 1);
        const float ua = (float)tA_ * 0.01f, ub = (float)tB_ * 0.01f;
        if (threadIdx.x == 0) xo[0] += 8.f + ua * 0.01f; else xo[4 * threadIdx.x] += sqrtf(ub * 0.01f);
    }
#endif
}

extern "C" void kernel_launch(void* const* d_in, const int* in_sizes, int n_in, void* d_out, int out_size, void* d_ws, size_t ws_size, hipStream_t stream) {
    static int grid = 0;
    if (grid == 0) {
        if (n_in != 17 || ws_size < WS_END) { fprintf(stderr, "kernel_launch: unexpected n_in %d / ws_size %zu (need %zu)\n", n_in, ws_size, (size_t)WS_END); grid = -1; return; }
        int dev = 0, cus = 0, per_cu = 0;
        (void)hipGetDevice(&dev); (void)hipDeviceGetAttribute(&cus, hipDeviceAttributeMultiprocessorCount, dev);
        if (hipFuncSetAttribute((const void*)mega_fwd, hipFuncAttributeMaxDynamicSharedMemorySize, LDS_BYTES) != hipSuccess) { fprintf(stderr, "hipFuncSetAttribute failed\n"); grid = -1; return; }
        if (hipOccupancyMaxActiveBlocksPerMultiprocessor(&per_cu, (const void*)mega_fwd, NTHREADS, LDS_BYTES) != hipSuccess || per_cu < 1) { fprintf(stderr, "occupancy query: %d\n", per_cu); per_cu = 1; }
        (void)hipGetLastError();
        grid = cus * 1;
    }
    if (grid < 0) return;
    (void)hipMemsetAsync((char*)d_ws + WS_CTL, 0, 65536, stream);
    Args a{};
    for (int i = 0; i < 17; ++i) a.in[i] = (const float*)d_in[i];
    a.out = (float*)d_out; a.ws = (unsigned char*)d_ws;
    void* args[] = {&a};
    hipError_t e = hipLaunchCooperativeKernel((const void*)mega_fwd, dim3(grid), dim3(NTHREADS), args, LDS_BYTES, stream);
    if (e != hipSuccess) fprintf(stderr, "cooperative launch failed: %s (grid %d)\n", hipGetErrorString(e), grid);
}
```

```cpp
#include <hip/hip_runtime.h>
#include <hip/hip_cooperative_groups.h>
#include <cstdio>
#include <cstdint>
#include <cmath>
namespace cg = cooperative_groups;
namespace pg8 {
#define PG8_LAS __attribute__((address_space(3)))
typedef unsigned short bf16_t;
typedef short bf16x8 __attribute__((ext_vector_type(8)));
typedef float f32x4 __attribute__((ext_vector_type(4)));
typedef unsigned u32x4 __attribute__((ext_vector_type(4)));
constexpr int BM = 256, BK = 64, HALF = 128, HTB = HALF * BK * 2  , STAGE_BYTES = 8 * HTB, NXCD = 8, WGM = 8;

__host__ __device__ __forceinline__ int lds_byte(int r, int c) { const int st = (r >> 4) * 2 + (c >> 5), rr = r & 15, cc = c & 31, ob = rr * 64 + cc * 2; return st * 1024 + (ob ^ (((ob >> 9) & 1) << 5)); }
__host__ __device__ __forceinline__ void stage_rc(int b, int& R, int& C) { const int st = b / 1024, sb = b % 1024, swz = sb ^ (((sb >> 9) & 1) << 5); R = (st >> 1) * 16 + swz / 64; C = (st & 1) * 32 + (swz % 64) / 2; }
__host__ __device__ __forceinline__ int perm32(int rho) { const int n = rho >> 4, i = rho & 15; return 8 * (i >> 2) + 4 * n + (i & 3); }

struct Unit { int pm, pn; };
struct Gemm { const bf16_t* A; const bf16_t* Bt; int M, N, K; int a_rows = 256; };

struct StaticOrder {
    int nM, nN, nwg, G, c;
    __host__ __device__ void init(int M, int N, int G_, int c_) { nM = M / BM; nN = N / BM; nwg = nM * nN; G = G_; c = c_; }
    __host__ __device__ bool next(int i, Unit& u) const {
        const long L = (long)i * G + c; if (L >= nwg) return false;
        int wgid = (int)L; { const int q = nwg / NXCD, r = nwg % NXCD, xcd = wgid % NXCD, off = wgid / NXCD; wgid = (xcd < r ? xcd * (q + 1) : r * (q + 1) + (xcd - r) * q) + off; }
        const int nig = WGM * nN, gid = wgid / nig, fm = gid * WGM, gsz = (nM - fm) < WGM ? (nM - fm) : WGM;
        u.pm = fm + ((wgid % nig) % gsz); u.pn = (wgid % nig) / gsz; return true;
    }
    __device__ __forceinline__ void a_ready(const Unit&) const {}
    __device__ __forceinline__ void done(const Unit&) const {}
};

__device__ __forceinline__ unsigned cvt_pk_bf16(float lo, float hi) { unsigned r; asm volatile("v_cvt_pk_bf16_f32 %0, %1, %2" : "=v"(r) : "v"(lo), "v"(hi)); return r; }
struct EpiBf16S {
    static constexpr bool PERM = true, AFTER_DRAIN = false;
    bf16_t* O; int ldc; unsigned scalemask; float sc;
    __device__ __forceinline__ void operator()(const f32x4 (&acc)[2][2][4][2], const Unit& u, int wr, int wc, int fr, int fq) const {
        const int row0 = u.pm * BM + wr * 64 + fr; const int col0 = u.pn * BM + wc * 32 + 8 * fq;
        const float s = ((scalemask >> u.pn) & 1u) ? sc : 1.f;
#pragma unroll
        for (int ai = 0; ai < 2; ++ai)
#pragma unroll
            for (int m = 0; m < 4; ++m) { bf16_t* rowp = O + (size_t)(row0 + ai * HALF + m * 16) * ldc + col0;
#pragma unroll
                for (int bj = 0; bj < 2; ++bj) { f32x4 v0 = acc[ai][bj][m][0] * s, v1 = acc[ai][bj][m][1] * s;
                    u32x4 w; w.x = cvt_pk_bf16(v0[0], v0[1]); w.y = cvt_pk_bf16(v0[2], v0[3]); w.z = cvt_pk_bf16(v1[0], v1[1]); w.w = cvt_pk_bf16(v1[2], v1[3]);
                    *(u32x4*)(rowp + bj * HALF) = w; } }
    }
};
struct EpiRes {
    static constexpr bool PERM = false, AFTER_DRAIN = false;
    const float* base; float* out; int ldc;
    __device__ __forceinline__ void operator()(const f32x4 (&acc)[2][2][4][2], const Unit& u, int wr, int wc, int fr, int fq) const {
        const int col0 = u.pn * BM + wc * 32 + 4 * fq;
#pragma unroll
        for (int ai = 0; ai < 2; ++ai)
#pragma unroll
            for (int m = 0; m < 4; ++m) { const size_t off = (size_t)(u.pm * BM + ai * HALF + wr * 64 + m * 16 + fr) * ldc + col0;
#pragma unroll
                for (int bj = 0; bj < 2; ++bj)
#pragma unroll
                    for (int n = 0; n < 2; ++n) { const f32x4 bs = *(const f32x4*)(base + off + bj * HALF + n * 16); *(f32x4*)(out + off + bj * HALF + n * 16) = bs + acc[ai][bj][m][n]; }
                asm volatile("" ::: "memory"); }
    }
};

struct EpiBf16S2 {
    static constexpr bool PERM = true, AFTER_DRAIN = false;
    bf16_t* O; int ldc; unsigned scalemask; float sc; const float* ssq;
    __device__ __forceinline__ void operator()(const f32x4 (&acc)[2][2][4][2], const Unit& u, int wr, int wc, int fr, int fq) const {
        const int row0 = u.pm * BM + wr * 64 + fr; const int col0 = u.pn * BM + wc * 32 + 8 * fq;
        const float s = ((scalemask >> u.pn) & 1u) ? sc : 1.f;
#pragma unroll
        for (int ai = 0; ai < 2; ++ai)
#pragma unroll
            for (int m = 0; m < 4; ++m) { const int row = row0 + ai * HALF + m * 16; bf16_t* rowp = O + (size_t)row * ldc + col0;
                const float rs = s / sqrtf(ssq[row] * (1.f / 1024.f) + 1e-6f);
#pragma unroll
                for (int bj = 0; bj < 2; ++bj) { f32x4 v0 = acc[ai][bj][m][0] * rs, v1 = acc[ai][bj][m][1] * rs;
                    u32x4 w; w.x = cvt_pk_bf16(v0[0], v0[1]); w.y = cvt_pk_bf16(v0[2], v0[3]); w.z = cvt_pk_bf16(v1[0], v1[1]); w.w = cvt_pk_bf16(v1[2], v1[3]);
                    *(u32x4*)(rowp + bj * HALF) = w; } }
    }
};
typedef unsigned u32x2e __attribute__((ext_vector_type(2)));
struct EpiRes2 {
    static constexpr bool PERM = false, AFTER_DRAIN = false;
    const float* base; float* out; bf16_t* xb; float* ssq; int ldc;
    __device__ __forceinline__ void operator()(const f32x4 (&acc)[2][2][4][2], const Unit& u, int wr, int wc, int fr, int fq) const {
        const int col0 = u.pn * BM + wc * 32 + 4 * fq;
#pragma unroll
        for (int ai = 0; ai < 2; ++ai)
#pragma unroll
            for (int m = 0; m < 4; ++m) { const int row = u.pm * BM + ai * HALF + wr * 64 + m * 16 + fr; const size_t off = (size_t)row * ldc + col0; float ps = 0.f;
#pragma unroll
                for (int bj = 0; bj < 2; ++bj)
#pragma unroll
                    for (int n = 0; n < 2; ++n) { const f32x4 bs = *(const f32x4*)(base + off + bj * HALF + n * 16); const f32x4 v = bs + acc[ai][bj][m][n];
                        *(f32x4*)(out + off + bj * HALF + n * 16) = v; ps += (v[0] * v[0] + v[1] * v[1]) + (v[2] * v[2] + v[3] * v[3]);
                        u32x2e w; w.x = cvt_pk_bf16(v[0], v[1]); w.y = cvt_pk_bf16(v[2], v[3]); *(u32x2e*)(xb + off + bj * HALF + n * 16) = w; }
                ps += __shfl_xor(ps, 16); ps += __shfl_xor(ps, 32);
                if (fq == 0) atomicAdd(ssq + row, ps);
                asm volatile("" ::: "memory"); }
    }
};

struct EpiNull {
    static constexpr bool PERM = false, AFTER_DRAIN = false;
    __device__ __forceinline__ void operator()(const f32x4 (&acc)[2][2][4][2], const Unit& u, int wr, int wc, int fr, int fq) const {
#pragma unroll
        for (int ai = 0; ai < 2; ++ai)
#pragma unroll
            for (int bj = 0; bj < 2; ++bj)
#pragma unroll
                for (int m = 0; m < 4; ++m)
#pragma unroll
                    for (int n = 0; n < 2; ++n) asm volatile("" :: "v"(acc[ai][bj][m][n]));
    }
};

#define PG8_DPP(old, src, ctrl) __builtin_bit_cast(float, __builtin_amdgcn_update_dpp(__builtin_bit_cast(int, (float)(old)), __builtin_bit_cast(int, (float)(src)), (ctrl), 0xF, 0xF, false))
struct EpiConv {
    static constexpr bool PERM = true, AFTER_DRAIN = false;
    bf16_t* G; const float* ssq; const float* cw; const float* cb; int slmask; PG8_LAS float* xch; int nrows;
    __device__ __forceinline__ void operator()(f32x4 (&acc)[2][2][4][2], const Unit& u, int wr, int wc, int fr, int fq) const {
        const int t0 = 254 * u.pm - 1 + wr * 64 + fr;
#pragma unroll
        for (int ai = 0; ai < 2; ++ai)
#pragma unroll
            for (int m = 0; m < 4; ++m) { int t = t0 + ai * HALF + m * 16; t = t < 0 ? 0 : (t > nrows - 1 ? nrows - 1 : t);
                const float rs = 1.f / sqrtf(ssq[t] * (1.f / 1024.f) + 1e-6f);
#pragma unroll
                for (int bj = 0; bj < 2; ++bj)
#pragma unroll
                    for (int n = 0; n < 2; ++n) acc[ai][bj][m][n] *= rs; }
        if (fr == 0 || fr == 15) { const int which = fr == 0 ? 0 : 1, m = fr == 0 ? 0 : 3;
#pragma unroll
            for (int ai = 0; ai < 2; ++ai) { PG8_LAS float* d = xch + ((((2 * ai + wr) * 2 + which) * 4 + wc) * 4 + fq) * 16;
#pragma unroll
                for (int bj = 0; bj < 2; ++bj)
#pragma unroll
                    for (int n = 0; n < 2; ++n) *(PG8_LAS f32x4*)(d + bj * 8 + n * 4) = fr == 0 ? acc[ai][bj][0][n] : acc[ai][bj][3][n]; }
            (void)m; }
        asm volatile("s_waitcnt lgkmcnt(0)" ::: "memory"); __builtin_amdgcn_s_barrier(); asm volatile("" ::: "memory");
        const int ch0 = u.pn * 128 + wc * 32 + 8 * fq;
#pragma unroll
        for (int n = 0; n < 2; ++n) {
            const int chn = ch0 + 4 * n;
            const f32x4 wg0 = *(const f32x4*)(cw + chn), wg1 = *(const f32x4*)(cw + 5632 + chn), wg2 = *(const f32x4*)(cw + 2 * 5632 + chn), bgv = *(const f32x4*)(cb + chn);
            const f32x4 wv0 = *(const f32x4*)(cw + 2816 + chn), wv1 = *(const f32x4*)(cw + 5632 + 2816 + chn), wv2 = *(const f32x4*)(cw + 2 * 5632 + 2816 + chn), bvv = *(const f32x4*)(cb + 2816 + chn);
#pragma unroll
            for (int ai = 0; ai < 2; ++ai)
#pragma unroll
                for (int m = 0; m < 4; ++m) {
                    const int lr = ai * HALF + wr * 64 + m * 16 + fr, t = 254 * u.pm - 1 + lr;
                    const int gidx = 2 * ai + wr;
                    f32x4 pv[2], nx[2];
#pragma unroll
                    for (int bj = 0; bj < 2; ++bj) {
                        f32x4 upo, dno;
                        if (m > 0) { const f32x4 s = acc[ai][bj][m - 1][n];
#pragma unroll
                            for (int j = 0; j < 4; ++j) upo[j] = PG8_DPP(0.f, s[j], 0x121); }
                        else upo = gidx > 0 ? *(const PG8_LAS f32x4*)(xch + ((((gidx - 1) * 2 + 1) * 4 + wc) * 4 + fq) * 16 + bj * 8 + n * 4) : (f32x4){0.f, 0.f, 0.f, 0.f};
                        if (m < 3) { const f32x4 s = acc[ai][bj][m + 1][n];
#pragma unroll
                            for (int j = 0; j < 4; ++j) dno[j] = PG8_DPP(0.f, s[j], 0x12F); }
                        else dno = gidx < 3 ? *(const PG8_LAS f32x4*)(xch + ((((gidx + 1) * 2 + 0) * 4 + wc) * 4 + fq) * 16 + bj * 8 + n * 4) : (f32x4){0.f, 0.f, 0.f, 0.f};
                        const f32x4 cur = acc[ai][bj][m][n];
#pragma unroll
                        for (int j = 0; j < 4; ++j) { pv[bj][j] = PG8_DPP(upo[j], cur[j], 0x111);
                                                       nx[bj][j] = PG8_DPP(dno[j], cur[j], 0x101); }
                    }
                    const bool sfirst = (t & slmask) == 0, slast = (t & slmask) == slmask;
                    float res[4];
#pragma unroll
                    for (int j = 0; j < 4; ++j) {
                        const float gp = sfirst ? 0.f : pv[0][j], gn = slast ? 0.f : nx[0][j], vp = sfirst ? 0.f : pv[1][j], vn = slast ? 0.f : nx[1][j];
                        const float gate = gp * wg0[j] + acc[ai][0][m][n][j] * wg1[j] + gn * wg2[j] + bgv[j];
                        const float val = vp * wv0[j] + acc[ai][1][m][n][j] * wv1[j] + vn * wv2[j] + bvv[j];
                        res[j] = gate * __builtin_amdgcn_rcpf(1.f + __builtin_amdgcn_exp2f(-1.4426950408889634f * gate)) * val;
                    }
                    if (lr >= 1 && lr <= 254 && t < nrows) { u32x2e w; w.x = cvt_pk_bf16(res[0], res[1]); w.y = cvt_pk_bf16(res[2], res[3]); *(u32x2e*)(G + (size_t)t * 2816 + chn) = w; }
                }
        }
    }
};
template <class Epi, class Sched, bool ALIGN_EPI = false, bool SP2 = false>
__device__ __forceinline__ void gemm_phase(PG8_LAS unsigned char* lds, const Gemm g, const Sched& S, const Epi& E) {
    int tid_l = threadIdx.x; asm volatile("" : "+v"(tid_l)); const int tid = tid_l, wid = __builtin_amdgcn_readfirstlane(tid >> 6), lane = tid & 63, wr = wid >> 2, wc = wid & 3, fr = lane & 15, fq = lane >> 4;
    const int K = g.K, nt = K / BK;
    unsigned voffA[2], voffB[2];
#pragma unroll
    for (int i = 0; i < 2; ++i) { int R, C; stage_rc(tid * 16 + i * 8192, R, C); const int Rb = Epi::PERM ? ((R & ~31) + perm32(R & 31)) : R;
        voffA[i] = (unsigned)(R * K + C) * 2u; voffB[i] = (unsigned)(Rb * K + C) * 2u; }
    const size_t kstep = (size_t)(BK * 2);
    const size_t hstep = (size_t)HALF * K * 2;
    const size_t tstep = 2 * hstep; const size_t tstepA = (size_t)g.a_rows * K * 2;
    const unsigned ldsw = (unsigned)wid * 1024u;
    const int aoff = lds_byte(wr * 64 + fr, fq * 8), boff = lds_byte(wc * 32 + fr, fq * 8);
#define PG8_SA(b, h) (((b) * 2 + (h)) * HTB)
#define PG8_SB(b, h) ((4 + (b) * 2 + (h)) * HTB)
#define PG8_STAGE(bufoff, gbase, voff) do { _Pragma("unroll") for (int _i = 0; _i < 2; ++_i) \
        __builtin_amdgcn_global_load_lds((const unsigned*)((const char*)(gbase) + (voff)[_i]), (PG8_LAS unsigned*)(lds + (bufoff) + ldsw + _i * 8192), 16, 0, 0); } while (0)
#define PG8_LDA(dst, b, h) do { _Pragma("unroll") for (int m = 0; m < 4; ++m) _Pragma("unroll") for (int k = 0; k < 2; ++k) dst[m][k] = *(const PG8_LAS bf16x8*)(lds + PG8_SA(b, h) + aoff + m * 2048 + k * 1024); } while (0)
#define PG8_LDB(dst, b, h) do { _Pragma("unroll") for (int n = 0; n < 2; ++n) _Pragma("unroll") for (int k = 0; k < 2; ++k) dst[n][k] = *(const PG8_LAS bf16x8*)(lds + PG8_SB(b, h) + boff + n * 2048 + k * 1024); } while (0)
#define PG8_MMA(ai, bj, At, Bt) do { __builtin_amdgcn_s_setprio(1); _Pragma("unroll") for (int m = 0; m < 4; ++m) _Pragma("unroll") for (int n = 0; n < 2; ++n) _Pragma("unroll") for (int k = 0; k < 2; ++k) \
        acc[ai][bj][m][n] = __builtin_amdgcn_mfma_f32_16x16x32_bf16(Bt[n][k], At[m][k], acc[ai][bj][m][n], 0, 0, 0); __builtin_amdgcn_s_setprio(0); } while (0)
#define PG8_WAIT_V(n) asm volatile("s_waitcnt vmcnt(" #n ")" ::: "memory")
#define PG8_WAIT_L(n) asm volatile("s_waitcnt lgkmcnt(" #n ")" ::: "memory")
#define PG8_BAR __builtin_amdgcn_s_barrier()
#define PG8_SCHED __builtin_amdgcn_sched_barrier(0)
    Unit cur, nxt; int ui = 0;
    if (!S.next(0, cur)) return;
    f32x4 acc[2][2][4][2];
#pragma unroll
    for (int a = 0; a < 2; ++a)
#pragma unroll
        for (int b = 0; b < 2; ++b)
#pragma unroll
            for (int m = 0; m < 4; ++m)
#pragma unroll
                for (int n = 0; n < 2; ++n) acc[a][b][m][n] = (f32x4){0.f, 0.f, 0.f, 0.f};
    bf16x8 At[4][2], B0[2][2], B1[2][2];
    const char* cA = (const char*)g.A + (size_t)cur.pm * tstepA; const char* cB = (const char*)g.Bt + (size_t)cur.pn * tstep;
    S.a_ready(cur);
    if constexpr (SP2) {
        PG8_STAGE(PG8_SB(0, 0), cB, voffB); PG8_STAGE(PG8_SB(0, 1), cB + hstep, voffB); PG8_STAGE(PG8_SA(0, 0), cA, voffA); PG8_STAGE(PG8_SA(0, 1), cA + hstep, voffA);
        if (wr == 1) PG8_BAR;
        PG8_WAIT_V(2); PG8_BAR;
        PG8_STAGE(PG8_SB(1, 0), cB + kstep, voffB); PG8_STAGE(PG8_SA(1, 0), cA + kstep, voffA); PG8_STAGE(PG8_SB(1, 1), cB + hstep + kstep, voffB);
        PG8_WAIT_V(6); PG8_BAR;
    } else {
        PG8_STAGE(PG8_SB(0, 0), cB, voffB); PG8_STAGE(PG8_SA(0, 0), cA, voffA); PG8_STAGE(PG8_SB(0, 1), cB + hstep, voffB); PG8_STAGE(PG8_SA(0, 1), cA + hstep, voffA);
        if (wr == 1) PG8_BAR;
        PG8_WAIT_V(4); PG8_BAR;
        PG8_STAGE(PG8_SB(1, 0), cB + kstep, voffB); PG8_STAGE(PG8_SA(1, 0), cA + kstep, voffA); PG8_STAGE(PG8_SB(1, 1), cB + hstep + kstep, voffB);
        PG8_WAIT_V(6); PG8_BAR;
    }
    for (;;) {
        const bool has_next = S.next(ui + 1, nxt);
        const char* nA = has_next ? (const char*)g.A + (size_t)nxt.pm * tstepA : cA; const char* nB = has_next ? (const char*)g.Bt + (size_t)nxt.pn * tstep : cB;
        for (int t = 0; t < nt; t += 2) {
            const bool last = (t == nt - 2);
            const char* a1 = cA + (size_t)(t + 1) * kstep;
            const char* a2 = last ? nA : cA + (size_t)(t + 2) * kstep; const char* b2 = last ? nB : cB + (size_t)(t + 2) * kstep;
            const char* a3 = a2 + kstep; const char* b3 = b2 + kstep;
            if (last && has_next) S.a_ready(nxt);
            if constexpr (SP2) {
            PG8_LDB(B0, 0, 0); PG8_LDB(B1, 0, 1); PG8_SCHED; PG8_LDA(At, 0, 0); PG8_STAGE(PG8_SA(1, 1), a1 + hstep, voffA);
            PG8_WAIT_V(8); PG8_WAIT_L(0); PG8_BAR; PG8_MMA(0, 0, At, B0); PG8_MMA(0, 1, At, B1); PG8_BAR; PG8_SCHED;
            PG8_LDA(At, 0, 1); PG8_STAGE(PG8_SB(0, 0), b2, voffB); PG8_STAGE(PG8_SB(0, 1), b2 + hstep, voffB); PG8_STAGE(PG8_SA(0, 0), a2, voffA);
            PG8_WAIT_V(8); PG8_WAIT_L(0); PG8_BAR; PG8_MMA(1, 0, At, B0); PG8_MMA(1, 1, At, B1); PG8_BAR; PG8_SCHED;
            PG8_LDB(B0, 1, 0); PG8_LDB(B1, 1, 1); PG8_SCHED; PG8_LDA(At, 1, 0); PG8_STAGE(PG8_SA(0, 1), a2 + hstep, voffA);
            PG8_WAIT_V(8); PG8_WAIT_L(0); PG8_BAR; PG8_MMA(0, 0, At, B0); PG8_MMA(0, 1, At, B1); PG8_BAR; PG8_SCHED;
            PG8_LDA(At, 1, 1); PG8_STAGE(PG8_SB(1, 0), b3, voffB); PG8_STAGE(PG8_SB(1, 1), b3 + hstep, voffB); PG8_STAGE(PG8_SA(1, 0), a3, voffA);
            PG8_WAIT_V(8); PG8_WAIT_L(0); PG8_BAR; PG8_MMA(1, 0, At, B0); PG8_MMA(1, 1, At, B1); PG8_BAR; PG8_SCHED;
            } else {
            PG8_LDB(B0, 0, 0); PG8_SCHED; PG8_LDA(At, 0, 0); PG8_STAGE(PG8_SA(1, 1), a1 + hstep, voffA);
            PG8_WAIT_L(8); PG8_BAR; PG8_WAIT_L(0); PG8_MMA(0, 0, At, B0); PG8_BAR; PG8_SCHED;
            PG8_LDB(B1, 0, 1); PG8_STAGE(PG8_SB(0, 0), b2, voffB);
            PG8_BAR; PG8_WAIT_L(0); PG8_MMA(0, 1, At, B1); PG8_BAR;
            PG8_LDA(At, 0, 1); PG8_STAGE(PG8_SA(0, 0), a2, voffA);
            PG8_BAR; PG8_WAIT_L(0); PG8_MMA(1, 0, At, B0); PG8_BAR; PG8_SCHED;
            PG8_STAGE(PG8_SB(0, 1), b2 + hstep, voffB);
            PG8_WAIT_V(6); PG8_BAR; PG8_MMA(1, 1, At, B1); PG8_BAR;
            PG8_LDB(B0, 1, 0); PG8_SCHED; PG8_LDA(At, 1, 0); PG8_STAGE(PG8_SA(0, 1), a2 + hstep, voffA);
            PG8_WAIT_L(8); PG8_BAR; PG8_WAIT_L(0); PG8_MMA(0, 0, At, B0); PG8_BAR; PG8_SCHED;
            PG8_LDB(B1, 1, 1); PG8_STAGE(PG8_SB(1, 0), b3, voffB);
            PG8_BAR; PG8_WAIT_L(0); PG8_MMA(0, 1, At, B1); PG8_BAR;
            PG8_LDA(At, 1, 1); PG8_STAGE(PG8_SA(1, 0), a3, voffA);
            PG8_BAR; PG8_WAIT_L(0); PG8_MMA(1, 0, At, B0); PG8_BAR; PG8_SCHED;
            PG8_STAGE(PG8_SB(1, 1), b3 + hstep, voffB);
            PG8_WAIT_V(6); PG8_BAR; PG8_MMA(1, 1, At, B1); PG8_BAR;
            }
        }
        if constexpr (ALIGN_EPI) { if (wr == 0) PG8_BAR; }
        if constexpr (!Epi::AFTER_DRAIN) { E(acc, cur, wr, wc, fr, fq); S.done(cur); }
        if (!has_next) break;
#pragma unroll
        for (int a = 0; a < 2; ++a)
#pragma unroll
            for (int b = 0; b < 2; ++b)
#pragma unroll
                for (int m = 0; m < 4; ++m)
#pragma unroll
                    for (int n = 0; n < 2; ++n) acc[a][b][m][n] = (f32x4){0.f, 0.f, 0.f, 0.f};
        cur = nxt; cA = nA; cB = nB; ++ui;
        if constexpr (ALIGN_EPI) { if (wr == 1) PG8_BAR; }
    }
    PG8_WAIT_V(0);
    if constexpr (!ALIGN_EPI) { if (wr == 0) PG8_BAR; }
    PG8_BAR;
    if constexpr (Epi::AFTER_DRAIN) { E.fused(acc, cur, wr, wc, fr, fq, lds, wid, lane); S.done(cur); }
#undef PG8_SA
#undef PG8_SB
#undef PG8_STAGE
#undef PG8_LDA
#undef PG8_LDB
#undef PG8_MMA
#undef PG8_WAIT_V
#undef PG8_WAIT_L
#undef PG8_BAR
#undef PG8_SCHED
}
}
typedef __bf16 bf16x2_t __attribute__((ext_vector_type(2)));
__device__ __forceinline__ unsigned cvt_pk(float lo, float hi) { float __attribute__((ext_vector_type(2))) v = {lo, hi}; bf16x2_t b = __builtin_convertvector(v, bf16x2_t); return __builtin_bit_cast(unsigned, b); }
#define LAS __attribute__((address_space(3)))
#define XB_TMO      128
#define XB_XCNT(j)  (256  + 64 * (j))
#define XB_XSUB(j)  (1280 + 64 * (j))
#define XB_XGEN(j)  (2304 + 64 * (j))
#define XB_TOP      3328
#define XB_TOPGEN   3392
#define XCD_BAR_WORDS 3456
#define XB_SPIN_CAP (1u << 18)

__device__ __forceinline__ unsigned xb_ld(unsigned* p)              { return __hip_atomic_load(p, __ATOMIC_RELAXED, __HIP_MEMORY_SCOPE_AGENT); }
__device__ __forceinline__ unsigned xb_add(unsigned* p, unsigned v) { return __hip_atomic_fetch_add(p, v, __ATOMIC_RELAXED, __HIP_MEMORY_SCOPE_AGENT); }
__device__ __forceinline__ unsigned xb_xcc_id() { return (unsigned)__builtin_amdgcn_s_getreg((3 << 11) | 20) & 0xFu; }
#define XB_SPIN(cond, bar) do { unsigned _sp = 0; while (cond) { __builtin_amdgcn_s_sleep(1); \
    if ((++_sp & 255u) == 0u) { if (xb_ld(&(bar)[XB_TMO])) break; if (_sp > XB_SPIN_CAP) { atomicAdd(&(bar)[XB_TMO], 1u); break; } } } } while (0)

struct XcdBarrier {
    unsigned* bar; unsigned x;
    volatile LAS unsigned* st;
};

__device__ __forceinline__ XcdBarrier xcd_barrier_post(unsigned* bar, volatile LAS unsigned* st) {
    XcdBarrier b; b.bar = bar; b.x = xb_xcc_id(); b.st = st;
    if (threadIdx.x == 0) (void)xb_add(&bar[XB_XCNT(b.x)], 1u);
    return b;
}
__device__ __forceinline__ void xcd_barrier_complete(unsigned* bar, unsigned x, unsigned& nloc, unsigned& nx) {
    const unsigned G = gridDim.x * gridDim.y * gridDim.z;
    unsigned sum, cnt, mine, sp = 0u;
    for (;;) {
        sum = 0u; cnt = 0u; mine = 0u;
#pragma unroll
        for (unsigned j = 0; j < 16; ++j) { const unsigned c = xb_ld(&bar[XB_XCNT(j)]); sum += c; cnt += (c > 0u) ? 1u : 0u; mine = (j == x) ? c : mine; }
        if (sum == G) break;
        __builtin_amdgcn_s_sleep(1);
        if ((++sp & 255u) == 0u) { if (xb_ld(&bar[XB_TMO])) break; if (sp > XB_SPIN_CAP) { atomicAdd(&bar[XB_TMO], 1u); break; } }
    }
    nloc = mine > 0u ? mine : 1u; nx = cnt > 0u ? cnt : 1u;
}

__device__ __forceinline__ void xcd_barrier(const XcdBarrier& b) {
    asm volatile("s_waitcnt vmcnt(0)" ::: "memory");
    __syncthreads();
    if (threadIdx.x == 0) {
        unsigned* bar = b.bar;
        __builtin_amdgcn_s_waitcnt(0);
        unsigned nloc = b.st[0], nx = b.st[1];
        if (nloc == 0u) { xcd_barrier_complete(bar, b.x, nloc, nx); b.st[0] = nloc; b.st[1] = nx; }
        const unsigned old = xb_add(&bar[XB_XSUB(b.x)], 1u);
        const unsigned gen = old / nloc;
        if (old + 1u == (gen + 1u) * nloc) {
            __builtin_amdgcn_fence(__ATOMIC_RELEASE, "agent");
            asm volatile("s_waitcnt vmcnt(0)" ::: "memory");
            const unsigned og = xb_add(&bar[XB_TOP], 1u);
            const unsigned tg = og / nx;
            if (og + 1u == (tg + 1u) * nx) xb_add(&bar[XB_TOPGEN], 1u);
            else XB_SPIN(xb_ld(&bar[XB_TOPGEN]) == tg, bar);
            __builtin_amdgcn_fence(__ATOMIC_ACQUIRE, "agent");
            xb_add(&bar[XB_XGEN(b.x)], 1u);
            asm volatile("s_waitcnt vmcnt(0)" ::: "memory");
        } else {
            XB_SPIN(xb_ld(&bar[XB_XGEN(b.x)]) == gen, bar);
            __builtin_amdgcn_fence(__ATOMIC_ACQUIRE, "agent");
            asm volatile("s_waitcnt vmcnt(0)" ::: "memory");
        }
    }
    __syncthreads();
}
typedef unsigned short bf16_t;
typedef short bf16x8 __attribute__((ext_vector_type(8)));
typedef short s16x4 __attribute__((ext_vector_type(4)));
typedef float f32x16 __attribute__((ext_vector_type(16)));
typedef float f32x4 __attribute__((ext_vector_type(4)));
typedef float f32x2 __attribute__((ext_vector_type(2)));
typedef unsigned u32x4 __attribute__((ext_vector_type(4)));
typedef unsigned u32x2 __attribute__((ext_vector_type(2)));

constexpr int DM = 1024, DIN = 4352, DFF = 2816, DUP = 2 * DFF, DEPTH = 2;
constexpr int CH_ROWS = 16384, NCHUNK = 3;
constexpr int TW = 784;
constexpr int T_C = 0, T_L = 768;
constexpr float LOG2E = 1.4426950408889634f, LN2 = 0.6931471805599453f;
constexpr float QSCALE = 0.125f * LOG2E;
constexpr size_t MiB = 1u << 20;
constexpr size_t WS_WIN = 0, WS_WOUT = 18 * MiB, WS_WUP = 22 * MiB, WS_WDN = 44 * MiB, WS_HB = 56 * MiB, WS_PROJ = 88 * MiB, WS_TMP = 264 * MiB, WS_CTL = 394 * MiB, WS_XB = 395 * MiB, WS_SSQ = 459 * MiB, WS_END = 460 * MiB;
constexpr int LDS_BYTES = 147456 + 256 + 8192;
constexpr int NTHREADS = 512;

struct Args { const float* in[17]; float* out; unsigned char* ws; };

__device__ __forceinline__ float wave_sum(float v) {
#pragma unroll
    for (int o = 1; o < 64; o <<= 1) v += __shfl_xor(v, o);
    return v;
}
__device__ __forceinline__ unsigned f2bf(float f) { unsigned u = __builtin_bit_cast(unsigned, f); return (u + 0x7fffu + ((u >> 16) & 1u)) >> 16; }
__device__ __forceinline__ unsigned pk2(float lo, float hi) { return f2bf(lo) | (f2bf(hi) << 16); }
__device__ __forceinline__ float bf2f(unsigned short b) { return __builtin_bit_cast(float, (unsigned)b << 16); }

__device__ __forceinline__ void transpose_item(const float* W, int K, int N, bf16_t* WT, LAS float* scr, int item, int lane, const float* gain, bool gate_perm = false) {
    const int nblk = N / 32, kb = item / nblk, nb = item % nblk, k0 = 64 * kb, n0 = 32 * nb;
#pragma unroll 8
    for (int i = 0; i < 32; ++i) { const int kk = 2 * i + (lane >> 5); scr[kk * 33 + (lane & 31)] = W[(size_t)(k0 + kk) * N + n0 + (lane & 31)] * (gain ? gain[k0 + kk] : 1.f); }
    asm volatile("s_waitcnt lgkmcnt(0)" ::: "memory");
    const int c = lane & 7;
    const int half_ = N / 2, v_ = n0 >= half_ ? n0 - half_ : n0, d0 = gate_perm ? 256 * (v_ / 128) + (n0 >= half_ ? 128 : 0) + (v_ % 128) : n0;
#pragma unroll
    for (int j = 0; j < 4; ++j) { const int n = (lane >> 3) + 8 * j; const LAS float* s = scr + (8 * c) * 33 + n;
        u32x4 o; o.x = pk2(s[0 * 33], s[1 * 33]); o.y = pk2(s[2 * 33], s[3 * 33]); o.z = pk2(s[4 * 33], s[5 * 33]); o.w = pk2(s[6 * 33], s[7 * 33]);
        *(u32x4*)(WT + (size_t)(d0 + n) * K + k0 + 8 * c) = o; }
    asm volatile("s_waitcnt lgkmcnt(0)" ::: "memory");
}

__device__ __forceinline__ void rms_row_to_bf16(const float* xrow, const float* gain, bf16_t* orow, int lane) {
    const f32x4* xr = (const f32x4*)xrow + lane; const f32x4* gr = (const f32x4*)gain + lane;
    f32x4 v[4]; float s = 0.f;
#pragma unroll
    for (int j = 0; j < 4; ++j) { v[j] = xr[64 * j]; s += (v[j].x * v[j].x + v[j].y * v[j].y) + (v[j].z * v[j].z + v[j].w * v[j].w); }
    const float rstd = 1.f / sqrtf(wave_sum(s) * (1.f / DM) + 1e-6f);
    u32x2* o8 = (u32x2*)orow + lane;
#pragma unroll
    for (int j = 0; j < 4; ++j) { const f32x4 g = gr[64 * j]; u32x2 w; w.x = pk2(v[j].x * rstd * g.x, v[j].y * rstd * g.y); w.y = pk2(v[j].z * rstd * g.z, v[j].w * rstd * g.w); o8[64 * j] = w; }
}
__device__ __forceinline__ void rms_row_f32(float* xrow, const float* gain, int lane) {
    f32x4* xr = (f32x4*)xrow + lane; const f32x4* gr = (const f32x4*)gain + lane;
    f32x4 v[4]; float s = 0.f;
#pragma unroll
    for (int j = 0; j < 4; ++j) { v[j] = xr[64 * j]; s += (v[j].x * v[j].x + v[j].y * v[j].y) + (v[j].z * v[j].z + v[j].w * v[j].w); }
    const float rstd = 1.f / sqrtf(wave_sum(s) * (1.f / DM) + 1e-6f);
#pragma unroll
    for (int j = 0; j < 4; ++j) { const f32x4 g = gr[64 * j]; xr[64 * j] = v[j] * rstd * g; }
}

constexpr int KSTR = 144;
constexpr int ATT_K_OFF = 0, ATT_V_OFF = 2 * 64 * KSTR, ATT_SCR_OFF = ATT_V_OFF + 2 * 64 * 320;
__device__ __forceinline__ int crow(int r, int hi) { return (r & 3) + 8 * (r >> 2) + 4 * hi; }
typedef short v4i16_t __attribute__((ext_vector_type(4)));
__device__ __forceinline__ s16x4 vtr(const LAS unsigned char* p) { return __builtin_bit_cast(s16x4, __builtin_amdgcn_ds_read_tr16_b64_v4i16((LAS v4i16_t*)p)); }

template <int VD, bool WIN>
__device__ __forceinline__ void attn_unit(LAS unsigned char* lds, const bf16_t* Qp, const bf16_t* Kp, const bf16_t* Vp, size_t pitch,
                                          int q0, int L, float slope2, int W, float m_init, float l_init,
                                          float* Oout, size_t opitch, float* lse_out, size_t lpitch, bf16_t* Obf) {
    constexpr int VSTR = VD * 2 + 64, ND = VD / 32, VCH = VD / 8, VLD = 64 * VCH / NTHREADS;
    int tid_l = threadIdx.x; asm volatile("" : "+v"(tid_l)); const int tid = tid_l, lane = tid & 63, r32 = lane & 31, hi = lane >> 5, wid = __builtin_amdgcn_readfirstlane(tid >> 6);
    const int qw = q0 + wid * 32;
    int tlo = 0, thi = L / 64;
    if (WIN) { const int a = q0 - W; tlo = a > 0 ? a / 64 : 0; const int b = q0 + 256 + W; thi = (b < L ? b : L) / 64; }
    bf16x8 qr[4];
    { const bf16_t* qrow = Qp + (size_t)(qw + r32) * pitch + hi * 8;
#pragma unroll
      for (int d0 = 0; d0 < 4; ++d0) qr[d0] = *(const bf16x8*)(qrow + d0 * 16); }
    f32x16 o[ND];
#pragma unroll
    for (int d = 0; d < ND; ++d)
#pragma unroll
        for (int r = 0; r < 16; ++r) o[d][r] = 0.f;
    float m = m_init, l = hi == 0 ? l_init : 0.f;
    LAS float* wsf = (LAS float*)(lds + 6 * (64 * KSTR + 64 * (VD * 2 + 64))) + wid * 64;
    static_assert(VD == 64, "grouped staging is sized for 64-wide values");
    constexpr int SLOT = 64 * KSTR + 64 * VSTR, GRP = 6;
    const int krow = tid >> 3, kch = tid & 7;
    const float Wf = (float)W;
    for (int g0 = tlo; g0 < thi; g0 += GRP) {
        const int ng = thi - g0 < GRP ? thi - g0 : GRP;
        u32x4 kr[GRP], vr[GRP];
#pragma unroll
        for (int j = 0; j < GRP; ++j) if (j < ng) { kr[j] = *(const u32x4*)(Kp + (size_t)(64 * (g0 + j) + krow) * pitch + kch * 8); vr[j] = *(const u32x4*)(Vp + (size_t)(64 * (g0 + j) + krow) * pitch + kch * 8); }
        if (g0 != tlo) __syncthreads();
#pragma unroll
        for (int j = 0; j < GRP; ++j) if (j < ng) { *(LAS u32x4*)(lds + j * SLOT + krow * KSTR + kch * 16) = kr[j]; *(LAS u32x4*)(lds + j * SLOT + 64 * KSTR + krow * VSTR + kch * 16) = vr[j]; }
        __syncthreads();
      for (int j = 0; j < ng; ++j) {
        const int t = g0 + j;
        bool active = true;
        if (WIN) { const int kb = 64 * t; active = (kb + 63 >= qw - W) && (kb <= qw + 31 + W); }
        if (active) {
            const LAS unsigned char* Kb = lds + j * SLOT + r32 * KSTR + hi * 16;
            f32x16 p0, p1;
#pragma unroll
            for (int r = 0; r < 16; ++r) { p0[r] = 0.f; p1[r] = 0.f; }
#pragma unroll
            for (int d0 = 0; d0 < 4; ++d0) {
                const bf16x8 a0 = *(const LAS bf16x8*)(Kb + d0 * 32), a1 = *(const LAS bf16x8*)(Kb + 32 * KSTR + d0 * 32);
                p0 = __builtin_amdgcn_mfma_f32_32x32x16_bf16(a0, qr[d0], p0, 0, 0, 0);
                p1 = __builtin_amdgcn_mfma_f32_32x32x16_bf16(a1, qr[d0], p1, 0, 0, 0);
                if (d0 & 1) __builtin_amdgcn_sched_barrier(0);
            }
            const float dq = (float)(64 * t + 4 * hi - (qw + r32));
            float rm = -INFINITY;
#pragma unroll
            for (int r = 0; r < 16; ++r) {
                const float t0 = dq + (float)((r & 3) + 8 * (r >> 2)), t1 = t0 + 32.f;
                p0[r] = __builtin_fmaf(-slope2, __builtin_fabsf(t0), p0[r]);
                p1[r] = __builtin_fmaf(-slope2, __builtin_fabsf(t1), p1[r]);
                if (WIN) { if (__builtin_fabsf(t0) > Wf) p0[r] = -INFINITY; if (__builtin_fabsf(t1) > Wf) p1[r] = -INFINITY; }
                rm = __builtin_fmaxf(rm, __builtin_fmaxf(p0[r], p1[r]));
            }
            rm = __builtin_fmaxf(rm, __shfl_xor(rm, 32));
            if (__any(rm > m)) {
                const float mn = __builtin_fmaxf(m, rm); const float f = __builtin_amdgcn_exp2f(m - mn); m = mn; l *= f;
                if (hi == 0) wsf[r32] = f;
#pragma unroll
                for (int r = 0; r < 16; ++r) { const float fr = wsf[crow(r, hi)];
#pragma unroll
                    for (int d = 0; d < ND; ++d) o[d][r] *= fr; }
            }
            float ls = 0.f;
#pragma unroll
            for (int r = 0; r < 16; ++r) { p0[r] = __builtin_amdgcn_exp2f(p0[r] - m); p1[r] = __builtin_amdgcn_exp2f(p1[r] - m); ls += p0[r] + p1[r]; }
            l += ls;
            u32x4 pw[4];
#pragma unroll
            for (int c = 0; c < 4; ++c) {
                const f32x16& P = (c >> 1) ? p1 : p0; const int b = 8 * (c & 1);
                pw[c].x = cvt_pk(P[b + 0], P[b + 1]); pw[c].y = cvt_pk(P[b + 2], P[b + 3]); pw[c].z = cvt_pk(P[b + 4], P[b + 5]); pw[c].w = cvt_pk(P[b + 6], P[b + 7]);
            }
            const LAS unsigned char* Vb = lds + j * SLOT + 64 * KSTR + (4 * hi + ((lane & 15) >> 2)) * VSTR + (16 * ((lane >> 4) & 1) + 4 * (lane & 3)) * 2;
#pragma unroll
            for (int c = 0; c < 4; ++c)
#pragma unroll
                for (int d = 0; d < ND; ++d) {
                    const s16x4 vlo = vtr(Vb + c * 16 * VSTR + d * 64), vhi = vtr(Vb + c * 16 * VSTR + 8 * VSTR + d * 64);
                    const bf16x8 vf = (bf16x8){vlo[0], vlo[1], vlo[2], vlo[3], vhi[0], vhi[1], vhi[2], vhi[3]};
                    o[d] = __builtin_amdgcn_mfma_f32_32x32x16_bf16(__builtin_bit_cast(bf16x8, pw[c]), vf, o[d], 0, 0, 0);
                    if (d == ND - 1) __builtin_amdgcn_sched_barrier(0);
                }
        }
      }
    }
    l += __shfl_xor(l, 32);
    if (hi == 0) wsf[r32] = 1.f / l;
#pragma unroll
    for (int r = 0; r < 16; ++r) { const float ir = wsf[crow(r, hi)];
        if (Obf != nullptr) { bf16_t* orow = Obf + (size_t)(qw + crow(r, hi)) * opitch + r32;
#pragma unroll
            for (int d = 0; d < ND; ++d) orow[d * 32] = (bf16_t)f2bf(o[d][r] * ir);
        } else { float* orow = Oout + (size_t)(qw + crow(r, hi)) * opitch + r32;
#pragma unroll
            for (int d = 0; d < ND; ++d) orow[d * 32] = o[d][r] * ir; } }
    if (lse_out != nullptr && hi == 0) lse_out[(size_t)(qw + r32) * lpitch] = (m + __builtin_log2f(l)) * LN2;
    __syncthreads();
}

__device__ __forceinline__ void row_to_bf16_ssq(const float* xrow, bf16_t* orow, float* ssq, int lane) {
    const f32x4* xr = (const f32x4*)xrow + lane;
    f32x4 v[4]; float s = 0.f;
#pragma unroll
    for (int j = 0; j < 4; ++j) { v[j] = xr[64 * j]; s += (v[j].x * v[j].x + v[j].y * v[j].y) + (v[j].z * v[j].z + v[j].w * v[j].w); }
    s = wave_sum(s);
    u32x2* o8 = (u32x2*)orow + lane;
#pragma unroll
    for (int j = 0; j < 4; ++j) { u32x2 w; w.x = pk2(v[j].x, v[j].y); w.y = pk2(v[j].z, v[j].w); o8[64 * j] = w; }
    if (lane == 0) *ssq = s;
}
constexpr int BK_OFF = 0, BV_OFF = 2 * 64 * KSTR, BSCR_OFF = BV_OFF + 3 * 64 * 320, ATT_O0_OFF = BSCR_OFF + 2048;
static_assert(ATT_O0_OFF + 65536 <= 147456, "B attention LDS map");
constexpr float B_THR = 6.0f;
#ifndef B_LATE
#define B_LATE(w) false
#endif
__device__ __forceinline__ float max3f(float a, float b, float c) { float r; asm("v_max3_f32 %0, %1, %2, %3" : "=v"(r) : "v"(a), "v"(b), "v"(c)); return r; }
__device__ __forceinline__ void attn_b_unit(LAS unsigned char* lds, const bf16_t* base, int h, int q0, int L, float slope2_, float lam,
                                            const float* subln_l, float postscale, bf16_t* mix) {
    constexpr int VD = 128, VSTR = VD * 2 + 64, ND = 4, VCH = 16, VLD = 2;
    int tid_l = threadIdx.x; asm volatile("" : "+v"(tid_l)); const int tid = tid_l, lane = tid & 63, r32 = lane & 31, hi = lane >> 5, wid = __builtin_amdgcn_readfirstlane(tid >> 6);
    const int qw = q0 + wid * 32, NT = L / 64, c0 = q0 / 64;
    LAS float* wsf = (LAS float*)(lds + BSCR_OFF) + wid * 64;
    const bool late = B_LATE(wid);
    const int krow = tid >> 3, kch = tid & 7;
    const bf16_t* Vp = base + 1536 + h * 128;
    const float qposf_ = (float)(qw + r32);
    for (int mp = 0; mp < 2; ++mp) {
        const bf16_t* Qp = base + 512 + (h * 2 + mp) * 64; const bf16_t* Kp = base + 1024 + (h * 2 + mp) * 64;
        bf16x8 qr[4];
        { const bf16_t* qrow = Qp + (size_t)(qw + r32) * DIN + hi * 8;
#pragma unroll
          for (int d0 = 0; d0 < 4; ++d0) qr[d0] = *(const bf16x8*)(qrow + d0 * 16); }
        f32x16 o[ND];
#pragma unroll
        for (int d = 0; d < ND; ++d)
#pragma unroll
            for (int r = 0; r < 16; ++r) o[d][r] = 0.f;
        float mref = 0.f, l = 0.f;
        u32x4 kreg; u32x4 vreg[VLD];
        const unsigned koff = (unsigned)(krow * DIN + kch * 8) * 2u, voff = (unsigned)((tid >> 4) * DIN + (tid & 15) * 8) * 2u;
#define ATT_GLOAD(t) do { const char* kt_ = (const char*)Kp + (size_t)(t) * (64 * DIN * 2); const char* vt_ = (const char*)Vp + (size_t)(t) * (64 * DIN * 2); \
        kreg = *(const u32x4*)(kt_ + koff); vreg[0] = *(const u32x4*)(vt_ + voff); vreg[1] = *(const u32x4*)(vt_ + 32 * DIN * 2 + voff); } while (0)
#define ATT_LSTORE(b, vs) do { *(LAS u32x4*)(lds + BK_OFF + (b) * 64 * KSTR + krow * KSTR + kch * 16) = kreg; \
        *(LAS u32x4*)(lds + BV_OFF + (vs) * 64 * VSTR + (tid >> 4) * VSTR + (tid & 15) * 16) = vreg[0]; *(LAS u32x4*)(lds + BV_OFF + (vs) * 64 * VSTR + ((tid >> 4) + 32) * VSTR + (tid & 15) * 16) = vreg[1]; } while (0)
#define VFRAG(x, d) (bf16x8){x[d][0][0], x[d][0][1], x[d][0][2], x[d][0][3], x[d][1][0], x[d][1][1], x[d][1][2], x[d][1][3]}
#define PV_LOAD01(vs) do { \
        const LAS unsigned char* Vb = lds + BV_OFF + (vs) * 64 * VSTR + (4 * hi + ((lane & 15) >> 2)) * VSTR + (16 * ((lane >> 4) & 1) + 4 * (lane & 3)) * 2; \
        _Pragma("unroll") for (int d = 0; d < ND; ++d) { va[d][0] = vtr(Vb + d * 64); va[d][1] = vtr(Vb + 8 * VSTR + d * 64); } \
        _Pragma("unroll") for (int d = 0; d < ND; ++d) { vb2[d][0] = vtr(Vb + 16 * VSTR + d * 64); vb2[d][1] = vtr(Vb + 16 * VSTR + 8 * VSTR + d * 64); } \
        __builtin_amdgcn_sched_barrier(0); } while (0)
#define PV_MMA(vs) do { \
        const LAS unsigned char* Vb = lds + BV_OFF + (vs) * 64 * VSTR + (4 * hi + ((lane & 15) >> 2)) * VSTR + (16 * ((lane >> 4) & 1) + 4 * (lane & 3)) * 2; \
        _Pragma("unroll") for (int d = 0; d < ND; ++d) o[d] = __builtin_amdgcn_mfma_f32_32x32x16_bf16(__builtin_bit_cast(bf16x8, pw[0]), VFRAG(va, d), o[d], 0, 0, 0); \
        __builtin_amdgcn_sched_barrier(0); \
        _Pragma("unroll") for (int d = 0; d < ND; ++d) { va[d][0] = vtr(Vb + 32 * VSTR + d * 64); va[d][1] = vtr(Vb + 32 * VSTR + 8 * VSTR + d * 64); } \
        __builtin_amdgcn_sched_barrier(0); \
        _Pragma("unroll") for (int d = 0; d < ND; ++d) o[d] = __builtin_amdgcn_mfma_f32_32x32x16_bf16(__builtin_bit_cast(bf16x8, pw[1]), VFRAG(vb2, d), o[d], 0, 0, 0); \
        __builtin_amdgcn_sched_barrier(0); \
        _Pragma("unroll") for (int d = 0; d < ND; ++d) { vb2[d][0] = vtr(Vb + 48 * VSTR + d * 64); vb2[d][1] = vtr(Vb + 48 * VSTR + 8 * VSTR + d * 64); } \
        __builtin_amdgcn_sched_barrier(0); \
        _Pragma("unroll") for (int d = 0; d < ND; ++d) o[d] = __builtin_amdgcn_mfma_f32_32x32x16_bf16(__builtin_bit_cast(bf16x8, pw[2]), VFRAG(va, d), o[d], 0, 0, 0); \
        _Pragma("unroll") for (int d = 0; d < ND; ++d) o[d] = __builtin_amdgcn_mfma_f32_32x32x16_bf16(__builtin_bit_cast(bf16x8, pw[3]), VFRAG(vb2, d), o[d], 0, 0, 0); \
        __builtin_amdgcn_sched_barrier(0); } while (0)
        int first = 1; asm volatile("" : "+s"(first));
#define B_TILE(i_) ((i_) < 4 ? c0 + (i_) : ((i_) - 4 < c0 ? (i_) - 4 : (i_)))
        int t = B_TILE(0);
        int vs_prev = 2, vs_cur = 0, vs_next = 1;
        u32x4 pw[4];
        ATT_GLOAD(t); ATT_LSTORE(0, 0); __syncthreads();
        for (int i = 0; i < NT; ++i) {
            const int buf = i & 1;
            int tn = 0;
            if (i + 1 < NT) { tn = B_TILE(i + 1); ATT_GLOAD(tn); }
            f32x16 p0, p1;
            const int kb = 64 * t;
            float slope2 = slope2_, qposf = qposf_; asm volatile("" : "+v"(slope2), "+v"(qposf));
            const LAS unsigned char* Kb = lds + BK_OFF + buf * 64 * KSTR + r32 * KSTR + hi * 16;
            bf16x8 kf[8];
#pragma unroll
            for (int d0 = 0; d0 < 4; ++d0) { kf[d0] = *(const LAS bf16x8*)(Kb + d0 * 32); kf[4 + d0] = *(const LAS bf16x8*)(Kb + 32 * KSTR + d0 * 32); }
            const LAS unsigned char* Vb = lds + BV_OFF + vs_cur * 64 * VSTR + (4 * hi + ((lane & 15) >> 2)) * VSTR + (16 * ((lane >> 4) & 1) + 4 * (lane & 3)) * 2;
            s16x4 va[ND][2], vb2[ND][2];
            const bool offdiag = (kb + 63 < qw || kb > qw + 31);
            const float dq = (float)(kb + 4 * hi) - qposf;
#define QK_P0(INIT0, INIT1) do { \
            _Pragma("unroll") for (int r = 0; r < 16; ++r) { const float kv = (float)((r & 3) + 8 * (r >> 2)); p0[r] = INIT0; } \
            __builtin_amdgcn_sched_barrier(0); \
            _Pragma("unroll") for (int d0 = 0; d0 < 4; ++d0) { \
                p0 = __builtin_amdgcn_mfma_f32_32x32x16_bf16(kf[d0], qr[d0], p0, 0, 0, 0); \
                _Pragma("unroll") for (int r = 4 * d0; r < 4 * d0 + 4; ++r) { const float kv = (float)((r & 3) + 8 * (r >> 2) + 32); p1[r] = INIT1; } \
                __builtin_amdgcn_sched_barrier(0); } } while (0)
            if (offdiag) {
                const float sg = (kb > qw) ? -slope2 : slope2, b0 = sg * dq - mref;
                QK_P0(__builtin_fmaf(sg, kv, b0), __builtin_fmaf(sg, kv, b0));
            } else {
                const float nmref = -mref;
                QK_P0(__builtin_fmaf(-slope2, __builtin_fabsf(dq + kv), nmref), __builtin_fmaf(-slope2, __builtin_fabsf(dq + kv), nmref));
            }
#undef QK_P0
#pragma unroll
            for (int d = 0; d < ND; ++d) { va[d][0] = vtr(Vb + d * 64); va[d][1] = vtr(Vb + 8 * VSTR + d * 64); }
#pragma unroll
            for (int d = 0; d < ND; ++d) { vb2[d][0] = vtr(Vb + 16 * VSTR + d * 64); vb2[d][1] = vtr(Vb + 16 * VSTR + 8 * VSTR + d * 64); }
            __builtin_amdgcn_sched_barrier(0);
#pragma unroll
            for (int d0 = 0; d0 < 4; ++d0) p1 = __builtin_amdgcn_mfma_f32_32x32x16_bf16(kf[4 + d0], qr[d0], p1, 0, 0, 0);
            __builtin_amdgcn_sched_barrier(0);
            asm volatile("s_nop 15\n\ts_nop 7" : "+v"(p0), "+v"(p1));
            float rm = max3f(p0[0], p1[0], p0[1]);
#pragma unroll
            for (int r = 1; r < 15; ++r) rm = max3f(rm, p1[r], p0[r + 1]);
            rm = max3f(rm, p1[15], rm);
            rm = max3f(rm, __shfl_xor(rm, 32), rm);
            if (first || __any(rm > B_THR)) {
                const float delta = (first || rm > B_THR) ? rm : 0.f; const float f = __builtin_amdgcn_exp2f(-delta); mref += delta; l *= f;
#pragma unroll
                for (int r = 0; r < 16; ++r) { p0[r] -= delta; p1[r] -= delta; }
                {
                    if (hi == 0) wsf[r32] = f;
#pragma unroll
                    for (int r = 0; r < 16; ++r) { const float fr = wsf[crow(r, hi)];
#pragma unroll
                        for (int d = 0; d < ND; ++d) o[d][r] *= fr; }
                }
            }
            float ls0 = 0.f, ls1 = 0.f;
#pragma unroll
            for (int r = 0; r < 16; ++r) { p0[r] = __builtin_amdgcn_exp2f(p0[r]); ls0 += p0[r]; }
            pw[0].x = cvt_pk(p0[0], p0[1]); pw[0].y = cvt_pk(p0[2], p0[3]); pw[0].z = cvt_pk(p0[4], p0[5]); pw[0].w = cvt_pk(p0[6], p0[7]);
            pw[1].x = cvt_pk(p0[8], p0[9]); pw[1].y = cvt_pk(p0[10], p0[11]); pw[1].z = cvt_pk(p0[12], p0[13]); pw[1].w = cvt_pk(p0[14], p0[15]);
            __builtin_amdgcn_sched_barrier(0);
#define VFRAG(x, d) (bf16x8){x[d][0][0], x[d][0][1], x[d][0][2], x[d][0][3], x[d][1][0], x[d][1][1], x[d][1][2], x[d][1][3]}
#pragma unroll
            for (int d = 0; d < ND; ++d) {
                o[d] = __builtin_amdgcn_mfma_f32_32x32x16_bf16(__builtin_bit_cast(bf16x8, pw[0]), VFRAG(va, d), o[d], 0, 0, 0);
                p1[2 * d] = __builtin_amdgcn_exp2f(p1[2 * d]); p1[2 * d + 1] = __builtin_amdgcn_exp2f(p1[2 * d + 1]); ls1 += p1[2 * d]; ls0 += p1[2 * d + 1];
                __builtin_amdgcn_sched_barrier(0);
            }
#pragma unroll
            for (int d = 0; d < ND; ++d) { va[d][0] = vtr(Vb + 32 * VSTR + d * 64); va[d][1] = vtr(Vb + 32 * VSTR + 8 * VSTR + d * 64); }
            __builtin_amdgcn_sched_barrier(0);
#pragma unroll
            for (int d = 0; d < ND; ++d) {
                o[d] = __builtin_amdgcn_mfma_f32_32x32x16_bf16(__builtin_bit_cast(bf16x8, pw[1]), VFRAG(vb2, d), o[d], 0, 0, 0);
                p1[8 + 2 * d] = __builtin_amdgcn_exp2f(p1[8 + 2 * d]); p1[8 + 2 * d + 1] = __builtin_amdgcn_exp2f(p1[8 + 2 * d + 1]); ls1 += p1[8 + 2 * d]; ls0 += p1[8 + 2 * d + 1];
                __builtin_amdgcn_sched_barrier(0);
            }
#pragma unroll
            for (int d = 0; d < ND; ++d) { vb2[d][0] = vtr(Vb + 48 * VSTR + d * 64); vb2[d][1] = vtr(Vb + 48 * VSTR + 8 * VSTR + d * 64); }
            l += ls0 + ls1;
            pw[2].x = cvt_pk(p1[0], p1[1]); pw[2].y = cvt_pk(p1[2], p1[3]); pw[2].z = cvt_pk(p1[4], p1[5]); pw[2].w = cvt_pk(p1[6], p1[7]);
            __builtin_amdgcn_sched_barrier(0);
#pragma unroll
            for (int d = 0; d < ND; ++d) {
                o[d] = __builtin_amdgcn_mfma_f32_32x32x16_bf16(__builtin_bit_cast(bf16x8, pw[2]), VFRAG(va, d), o[d], 0, 0, 0);
                if (d == 0) { pw[3].x = cvt_pk(p1[8], p1[9]); pw[3].y = cvt_pk(p1[10], p1[11]); } else if (d == 1) { pw[3].z = cvt_pk(p1[12], p1[13]); pw[3].w = cvt_pk(p1[14], p1[15]); }
                __builtin_amdgcn_sched_barrier(0);
            }
#pragma unroll
            for (int d = 0; d < ND; ++d) o[d] = __builtin_amdgcn_mfma_f32_32x32x16_bf16(__builtin_bit_cast(bf16x8, pw[3]), VFRAG(vb2, d), o[d], 0, 0, 0);
#undef VFRAG
            __builtin_amdgcn_sched_barrier(0);
            first = 0;
            if (i + 1 < NT) ATT_LSTORE(buf ^ 1, vs_next);
            t = tn;
            { const int tmp_ = vs_prev; vs_prev = vs_cur; vs_cur = vs_next; vs_next = tmp_; }
            __syncthreads();
        }
#undef PV_LOAD01
#undef PV_MMA
#undef B_TILE
#undef VFRAG
#undef ATT_GLOAD
#undef ATT_LSTORE
        l += __shfl_xor(l, 32);
        if (hi == 0) wsf[r32] = 1.f / l;
        int lane_e = lane, qw_e = qw; asm volatile("" : "+v"(lane_e)); asm volatile("" : "+s"(qw_e));
        const int r32 = lane_e & 31, hi = lane_e >> 5, qw = qw_e;
        LAS unsigned* o0buf = (LAS unsigned*)(lds + ATT_O0_OFF) + wid * 2048 + lane_e;
        if (mp == 0) {
#pragma unroll
            for (int d = 0; d < ND; ++d)
#pragma unroll
                for (int r = 0; r < 16; r += 2) { const float i0 = wsf[crow(r, hi)], i1 = wsf[crow(r + 1, hi)]; o0buf[(d * 8 + (r >> 1)) * 64] = cvt_pk(o[d][r] * i0, o[d][r + 1] * i1); }
        } else {
            float gs[ND];
#pragma unroll
            for (int d = 0; d < ND; ++d) gs[d] = subln_l[d * 32 + r32] * postscale;
#pragma unroll
            for (int r = 0; r < 16; r += 2) {
                const float i0 = wsf[crow(r, hi)], i1 = wsf[crow(r + 1, hi)];
                float v0[ND], v1[ND]; float s0 = 0.f, s1 = 0.f;
#pragma unroll
                for (int d = 0; d < ND; ++d) { const unsigned w = o0buf[(d * 8 + (r >> 1)) * 64];
                    v0[d] = __builtin_bit_cast(float, w << 16) - lam * (o[d][r] * i0); v1[d] = __builtin_bit_cast(float, w & 0xffff0000u) - lam * (o[d][r + 1] * i1);
                    s0 += v0[d] * v0[d]; s1 += v1[d] * v1[d]; }
#pragma unroll
                for (int sh = 1; sh < 32; sh <<= 1) { s0 += __shfl_xor(s0, sh); s1 += __shfl_xor(s1, sh); }
                const float r0 = 1.f / sqrtf(s0 * (1.f / 128.f) + 1e-5f), r1 = 1.f / sqrtf(s1 * (1.f / 128.f) + 1e-5f);
                bf16_t* row0 = mix + (size_t)(qw + crow(r, hi)) * DM + r32; bf16_t* row1 = mix + (size_t)(qw + crow(r + 1, hi)) * DM + r32;
#pragma unroll
                for (int d = 0; d < ND; ++d) { row0[d * 32] = (bf16_t)f2bf(v0[d] * r0 * gs[d]); row1[d * 32] = (bf16_t)f2bf(v1[d] * r1 * gs[d]); }
            }
        }
        __syncthreads();
    }
}
__device__ __forceinline__ float alibi_slope(int i, int n) { return exp2f(-8.0f * (float)(i + 1) / (float)n); }
struct Ctx { int tid, lane, wave, G, cu, gw, NGW; };

__device__ __forceinline__ void ph_weights(const Args& a, const Ctx& c, LAS unsigned char* lds) {
    unsigned char* ws = a.ws;
    bf16_t* WinT = (bf16_t*)(ws + WS_WIN); bf16_t* WoutT = (bf16_t*)(ws + WS_WOUT); bf16_t* WupT = (bf16_t*)(ws + WS_WUP); bf16_t* WdnT = (bf16_t*)(ws + WS_WDN);
    const float* w_in = a.in[3]; const float* w_out = a.in[10]; const float* w_up = a.in[12]; const float* w_down = a.in[15];
    LAS float* scr = (LAS float*)(lds + c.wave * 16384);
    constexpr int I_IN = (DM / 64) * (DIN / 32), I_OUT = (DM / 64) * (DM / 32), I_UP = (DM / 64) * (DUP / 32), I_DN = (DFF / 64) * (DM / 32);
    constexpr int PER_L = I_IN + I_OUT + I_UP + I_DN;
    for (int it = c.gw; it < DEPTH * PER_L; it += c.NGW) {
        const int l = it / PER_L; int r = it % PER_L;
        if (r < I_IN) { transpose_item(w_in + (size_t)l * DM * DIN, DM, DIN, WinT + (size_t)l * DIN * DM, scr, r, c.lane, a.in[2] + l * DM); continue; } r -= I_IN;
        if (r < I_OUT) { transpose_item(w_out + (size_t)l * DM * DM, DM, DM, WoutT + (size_t)l * DM * DM, scr, r, c.lane, nullptr); continue; } r -= I_OUT;
        if (r < I_UP) { transpose_item(w_up + (size_t)l * DM * DUP, DM, DUP, WupT + (size_t)l * DUP * DM, scr, r, c.lane, a.in[11] + l * DM, true); continue; } r -= I_UP;
        transpose_item(w_down + (size_t)l * DFF * DM, DFF, DM, WdnT + (size_t)l * DM * DFF, scr, r, c.lane, nullptr);
    }
}
__device__ __forceinline__ const float* chunk_in(const Args& a, int ch) { return ch == 0 ? a.in[0] : a.in[1] + (size_t)(ch - 1) * CH_ROWS * DM; }
__device__ __forceinline__ float* chunk_out(const Args& a, int ch) { return a.out + (size_t)ch * CH_ROWS * DM; }

__device__ __forceinline__ void ph_norm_bf16(const Ctx& c, const float* xsrc, const float* gain, bf16_t* HB) {
    for (int r = c.gw; r < CH_ROWS; r += c.NGW) rms_row_to_bf16(xsrc + (size_t)r * DM, gain, HB + (size_t)r * DM, c.lane);
}
__device__ __forceinline__ void ph_final_norm(const Ctx& c, float* xo, const float* gain) {
    for (int r = c.gw; r < CH_ROWS; r += c.NGW) rms_row_f32(xo + (size_t)r * DM, gain, c.lane);
}

__device__ __forceinline__ void ph_attn(const Args& a, const Ctx& c, LAS unsigned char* lds, int ch, int layer) {
    const bf16_t* PROJ = (const bf16_t*)(a.ws + WS_PROJ); float* TMP = (float*)(a.ws + WS_TMP);
    const int SL = ch == 0 ? 16384 : 4096, sl_shift = ch == 0 ? 14 : 12;
    const int cu = c.cu, G = c.G;
#ifndef SKIP_B
    {
        const float lam_init = layer == 0 ? 0.2f : (0.8f - 0.6f * 0.7408182206817179f);
        const float s1 = wave_sum(a.in[5][layer * 64 + c.lane] * a.in[6][layer * 64 + c.lane]);
        const float s2 = wave_sum(a.in[7][layer * 64 + c.lane] * a.in[8][layer * 64 + c.lane]);
        const float lam = expf(s1) - expf(s2) + lam_init;
        bf16_t* HBm = (bf16_t*)(a.ws + WS_HB);
#ifdef PROBE_B2
        for (int rep_ = 0; rep_ < 2; ++rep_)
#endif
        for (int u = cu; u < 256; u += G) {
            int seq, h, qb; const int xcd = u & 7, idx = u >> 3;
            if (ch == 0) { seq = 0; h = xcd >> 1; qb = (xcd & 1) * 32 + idx; }
            else { const int pair = xcd * 2 + (idx >> 4); seq = pair >> 2; h = pair & 3; qb = idx & 15; }
            const size_t rb = (size_t)seq * SL;
            attn_b_unit(lds, PROJ + rb * DIN, h, qb * 256, SL, alibi_slope(h, 4) * LOG2E, lam, a.in[9] + layer * 128, 1.f - lam_init, HBm + rb * DM + 256 + h * 128);
        }
    }
#endif
#ifndef SKIP_AC
#ifdef PROBE_AC2
    for (int rep_ = 0; rep_ < 2; ++rep_)
#endif
    for (int uu = cu; uu < 1024; uu += G) {
        const bf16_t *qp, *kp, *vp; size_t pitch, opitch, lpitch; int q0, L, W; float slope2, m_init, l_init; float *op, *lp; bf16_t* obf;
        if (uu < 256) {
            const int hq = uu >> 6, blk = uu & 63;
            const int seq = (blk * 256) >> sl_shift, qb = blk - ((seq << sl_shift) >> 8);
            const size_t rb = (size_t)seq * SL; const bf16_t* base = PROJ + rb * DIN;
            qp = base + hq * 64; kp = base + 256 + (hq >> 1) * 64; vp = base + 384 + (hq >> 1) * 64; pitch = DIN; q0 = qb * 256; L = SL;
            slope2 = alibi_slope(hq, 4) * LOG2E; W = 128; m_init = a.in[4][layer * 4 + hq] * LOG2E; l_init = 1.f;
            op = nullptr; obf = (bf16_t*)(a.ws + WS_HB) + rb * DM + hq * 64; opitch = DM; lp = nullptr; lpitch = 0;
        } else {
            const int uc = uu - 256;
            const int gh = uc >> 6, blk = uc & 63, gq = gh >> 2;
            const int dsh = 2 * gq, d = 1 << dsh;
            const int seq = (blk * 256) >> sl_shift, b2 = blk - ((seq << sl_shift) >> 8);
            const int nbr = (SL >> dsh) >> 8;
            const int res = b2 / nbr, qb = b2 % nbr;
            const size_t rb = (size_t)seq * SL + res; const bf16_t* base = PROJ + rb * DIN;
            qp = base + 2048 + gh * 64; kp = base + 2816 + gh * 64; vp = base + 3584 + gh * 64; pitch = (size_t)DIN * d; q0 = qb * 256; L = SL >> dsh;
            slope2 = alibi_slope(gh, 12) * (float)d * LOG2E; W = 64; m_init = -1e30f; l_init = 0.f;
            op = TMP + rb * TW + T_C + gh * 64; obf = nullptr; opitch = (size_t)TW * d; lp = TMP + rb * TW + T_L + gh; lpitch = (size_t)TW * d;
        }
        attn_unit<64, true>(lds, qp, kp, vp, pitch, q0, L, slope2, W, m_init, l_init, op, opitch, lp, lpitch, obf);
    }
#endif
}

__device__ __forceinline__ void ph_combine(const Args& a, const Ctx& c, int layer) {
    const float* TMP = (const float*)(a.ws + WS_TMP); bf16_t* HB = (bf16_t*)(a.ws + WS_HB);
    { float* S2 = (float*)(a.ws + WS_SSQ) + 2 * CH_ROWS; for (int r = c.cu * NTHREADS + c.tid; r < CH_ROWS; r += c.G * NTHREADS) S2[r] = 0.f; }
    const int nitems = CH_ROWS * 32;
#pragma unroll 2
    for (int it = c.cu * NTHREADS + c.tid; it < nitems; it += c.G * NTHREADS) {
        const int r = it >> 5, h = (it >> 3) & 3, d8 = (it & 7) * 8;
        const float* tr = TMP + (size_t)r * TW;
        const float l0 = tr[T_L + h], l1 = tr[T_L + 4 + h], l2 = tr[T_L + 8 + h];
        const f32x4 a0 = *(const f32x4*)(tr + T_C + h * 64 + d8), a1 = *(const f32x4*)(tr + T_C + h * 64 + d8 + 4);
        const f32x4 b0 = *(const f32x4*)(tr + T_C + (4 + h) * 64 + d8), b1 = *(const f32x4*)(tr + T_C + (4 + h) * 64 + d8 + 4);
        const f32x4 c0 = *(const f32x4*)(tr + T_C + (8 + h) * 64 + d8), c1 = *(const f32x4*)(tr + T_C + (8 + h) * 64 + d8 + 4);
        const float mx = fmaxf(l0, fmaxf(l1, l2));
        float w0 = __expf(l0 - mx), w1 = __expf(l1 - mx), w2 = __expf(l2 - mx);
        const float inv = 1.f / (w0 + w1 + w2); w0 *= inv; w1 *= inv; w2 *= inv;
        const f32x4 o0 = a0 * w0 + b0 * w1 + c0 * w2, o1 = a1 * w0 + b1 * w1 + c1 * w2;
        u32x4 o; o.x = pk2(o0.x, o0.y); o.y = pk2(o0.z, o0.w); o.z = pk2(o1.x, o1.y); o.w = pk2(o1.z, o1.w);
        *(u32x4*)(HB + (size_t)r * DM + 768 + h * 64 + d8) = o;
    }
}

__device__ __forceinline__ void ph_conv(const Args& a, const Ctx& c, int ch, int layer) {
    const int par = ch & 1;
    const bf16_t* UB = (const bf16_t*)(a.ws + WS_PROJ); bf16_t* GB = (bf16_t*)(a.ws + WS_TMP);
    const int SL = ch == 0 ? 16384 : 4096;
    const float* cw = a.in[13] + (size_t)layer * 3 * DUP; const float* cb = a.in[14] + (size_t)layer * DUP;
    constexpr int NCG = DFF / 8, RB = 16;
    const int nitems = (CH_ROWS / RB) * NCG;
    { float* S1 = (float*)(a.ws + WS_SSQ) + par * CH_ROWS; for (int r = c.cu * NTHREADS + c.tid; r < CH_ROWS; r += c.G * NTHREADS) S1[r] = 0.f; }
    for (int it = c.cu * NTHREADS + c.tid; it < nitems; it += c.G * NTHREADS) {
        const int cg8 = it % NCG, rb = it / NCG, c0 = cg8 * 8, r0 = rb * RB;
        f32x4 wg[3][2], wv[3][2], bg[2], bv[2];
#pragma unroll
        for (int k = 0; k < 3; ++k)
#pragma unroll
            for (int j = 0; j < 2; ++j) { wg[k][j] = *(const f32x4*)(cw + k * DUP + c0 + 4 * j); wv[k][j] = *(const f32x4*)(cw + k * DUP + DFF + c0 + 4 * j); }
#pragma unroll
        for (int j = 0; j < 2; ++j) { bg[j] = *(const f32x4*)(cb + c0 + 4 * j); bv[j] = *(const f32x4*)(cb + DFF + c0 + 4 * j); }
        const bool first = (r0 & (SL - 1)) == 0, last = ((r0 + RB) & (SL - 1)) == 0;
        const u32x4 zero = (u32x4){0u, 0u, 0u, 0u};
        const bf16_t* up = UB + (size_t)r0 * DUP + c0;
        u32x4 pg_ = first ? zero : *(const u32x4*)(up - DUP), pv_ = first ? zero : *(const u32x4*)(up - DUP + DFF);
        u32x4 cg_ = *(const u32x4*)(up), cv_ = *(const u32x4*)(up + DFF);
        bf16_t* gp = GB + (size_t)r0 * DFF + c0;
#pragma unroll 4
        for (int rr = 0; rr < RB; ++rr) {
            const bool nz = (rr == RB - 1) && last;
            const u32x4 ng_ = nz ? zero : *(const u32x4*)(up + (size_t)(rr + 1) * DUP), nv_ = nz ? zero : *(const u32x4*)(up + (size_t)(rr + 1) * DUP + DFF);
            unsigned ow[4];
#pragma unroll
            for (int w = 0; w < 4; ++w) {
                float res[2];
#pragma unroll
                for (int hh = 0; hh < 2; ++hh) {
                    const int j = 2 * w + hh, q = j >> 2, e = j & 3;
                    const float gpv = hh ? __builtin_bit_cast(float, pg_[w] & 0xffff0000u) : __builtin_bit_cast(float, pg_[w] << 16);
                    const float gcv = hh ? __builtin_bit_cast(float, cg_[w] & 0xffff0000u) : __builtin_bit_cast(float, cg_[w] << 16);
                    const float gnv = hh ? __builtin_bit_cast(float, ng_[w] & 0xffff0000u) : __builtin_bit_cast(float, ng_[w] << 16);
                    const float vpv = hh ? __builtin_bit_cast(float, pv_[w] & 0xffff0000u) : __builtin_bit_cast(float, pv_[w] << 16);
                    const float vcv = hh ? __builtin_bit_cast(float, cv_[w] & 0xffff0000u) : __builtin_bit_cast(float, cv_[w] << 16);
                    const float vnv = hh ? __builtin_bit_cast(float, nv_[w] & 0xffff0000u) : __builtin_bit_cast(float, nv_[w] << 16);
                    const float gate = gpv * wg[0][q][e] + gcv * wg[1][q][e] + gnv * wg[2][q][e] + bg[q][e];
                    const float val = vpv * wv[0][q][e] + vcv * wv[1][q][e] + vnv * wv[2][q][e] + bv[q][e];
                    res[hh] = gate * __builtin_amdgcn_rcpf(1.f + __builtin_amdgcn_exp2f(-LOG2E * gate)) * val;
                }
                ow[w] = pk2(res[0], res[1]);
            }
            *(u32x4*)(gp + (size_t)rr * DFF) = (u32x4){ow[0], ow[1], ow[2], ow[3]};
            pg_ = cg_; pv_ = cv_; cg_ = ng_; cv_ = nv_;
        }
    }
}

constexpr int STEPS_PER_CHUNK = DEPTH * 6;
constexpr int NSTEPS = 1 + NCHUNK * STEPS_PER_CHUNK + 1;
__global__ void __launch_bounds__(NTHREADS, 2) mega_fwd(Args a) {
    extern __shared__ __attribute__((aligned(16))) unsigned char lds_raw[];
    LAS unsigned char* lds = (LAS unsigned char*)lds_raw;
    cg::grid_group grid = cg::this_grid();
    volatile LAS unsigned* bst = (volatile LAS unsigned*)(lds + 147456);
    if (threadIdx.x < 2) bst[threadIdx.x] = 0u;
    __syncthreads();
    XcdBarrier xbar = xcd_barrier_post((unsigned*)(a.ws + WS_CTL), bst);
#ifdef PROBE_P2
    for (int pass_ = 0; pass_ < 2; ++pass_)
#endif
    for (int step = 0; step < NSTEPS; ++step) {
        int tid_l = threadIdx.x, cu_l = blockIdx.x, G_l = gridDim.x;
        asm volatile("" : "+v"(tid_l)); asm volatile("" : "+s"(cu_l), "+s"(G_l));
        Ctx c; c.tid = tid_l; c.lane = c.tid & 63; c.wave = __builtin_amdgcn_readfirstlane(c.tid >> 6);
        c.G = G_l; c.cu = cu_l; c.gw = c.cu * 8 + c.wave; c.NGW = c.G * 8;
        unsigned char* ws = a.ws;
        if (step == 0) {
            ph_weights(a, c, lds);
            const float* xin = chunk_in(a, 0); bf16_t* XB = (bf16_t*)(ws + WS_XB); float* S1 = (float*)(ws + WS_SSQ);
            for (int r = c.gw; r < CH_ROWS; r += c.NGW) row_to_bf16_ssq(xin + (size_t)r * DM, XB + (size_t)r * DM, S1 + r, c.lane);
        } else if (step == NSTEPS - 1) ph_final_norm(c, chunk_out(a, NCHUNK - 1), a.in[16]);
        else {
            const int s = step - 1, ch = s / STEPS_PER_CHUNK, sc = s % STEPS_PER_CHUNK, par = ch & 1;
            bf16_t* HB = (bf16_t*)(ws + WS_HB); bf16_t* XB = (bf16_t*)(ws + WS_XB) + (size_t)par * CH_ROWS * DM;
            float* S1 = (float*)(ws + WS_SSQ) + par * CH_ROWS; float* S2 = (float*)(ws + WS_SSQ) + 2 * CH_ROWS;
            float* xo = chunk_out(a, ch);
            {
                const int layer = sc / 6, ph = sc % 6;
                const float* xsrc = layer == 0 ? chunk_in(a, ch) : (const float*)xo;
                if (ph == 0) {
                    pg8::Gemm g{XB, (const bf16_t*)(ws + WS_WIN) + (size_t)layer * DIN * DM, CH_ROWS, DIN, DM}; pg8::StaticOrder S; S.init(CH_ROWS, DIN, c.G, c.cu);
                    pg8::EpiBf16S2 E{(bf16_t*)(ws + WS_PROJ), DIN, 1805u, QSCALE, S1};
#ifdef PROBE_G2
                    for (int rep_ = 0; rep_ < 2; ++rep_)
#endif
                    pg8::gemm_phase<pg8::EpiBf16S2, pg8::StaticOrder, true, true>(lds, g, S, E);
                    if (layer == 0 && ch > 0) {
                        const int nfull = (CH_ROWS / 256) * (DIN / 256) % c.G;
                        if (nfull > 0 && c.cu >= nfull) { float* xp = chunk_out(a, ch - 1); const int nw = (c.G - nfull) * 8;
                            for (int r = (c.cu - nfull) * 8 + c.wave; r < CH_ROWS; r += nw) rms_row_f32(xp + (size_t)r * DM, a.in[16], c.lane); }
                        else if (nfull == 0) ph_final_norm(c, chunk_out(a, ch - 1), a.in[16]);
                    }
                } else if (ph == 1) {
                    ph_attn(a, c, lds, ch, layer);
                } else if (ph == 2) {
                    ph_combine(a, c, layer);
                } else if (ph == 3) {
                    pg8::Gemm g{HB, (const bf16_t*)(ws + WS_WOUT) + (size_t)layer * DM * DM, CH_ROWS, DM, DM}; pg8::StaticOrder S; S.init(CH_ROWS, DM, c.G, c.cu);
                    pg8::EpiRes2 E{xsrc, xo, XB, S2, DM};
#ifdef PROBE_GE2
                    { pg8::EpiRes2 E0{xsrc, (float*)(ws + WS_PROJ), (bf16_t*)(ws + WS_PROJ + 72 * MiB), (float*)(ws + WS_PROJ + 110 * MiB), DM}; pg8::gemm_phase<pg8::EpiRes2, pg8::StaticOrder, true, true>(lds, g, S, E0); }
#endif
                    pg8::gemm_phase<pg8::EpiRes2, pg8::StaticOrder, true, true>(lds, g, S, E);
                } else if (ph == 4) {
                    pg8::Gemm g{XB - DM, (const bf16_t*)(ws + WS_WUP) + (size_t)layer * DUP * DM, 65 * 256, DUP, DM, 254}; pg8::StaticOrder S; S.init(65 * 256, DUP, c.G, c.cu);
                    pg8::EpiConv E{(bf16_t*)(ws + WS_TMP), S2, a.in[13] + (size_t)layer * 3 * DUP, a.in[14] + (size_t)layer * DUP, (ch == 0 ? 16384 : 4096) - 1, (LAS float*)(lds + 147456 + 256), CH_ROWS};
                    pg8::gemm_phase<pg8::EpiConv, pg8::StaticOrder, true, true>(lds, g, S, E);
                    { float* S1z = S1; for (int r = c.cu * NTHREADS + c.tid; r < CH_ROWS; r += c.G * NTHREADS) S1z[r] = 0.f; }
                    if (layer == DEPTH - 1 && ch + 1 < NCHUNK) {
                        const float* xin = chunk_in(a, ch + 1); bf16_t* XBn = (bf16_t*)(ws + WS_XB) + (size_t)(par ^ 1) * CH_ROWS * DM; float* S1n = (float*)(ws + WS_SSQ) + (par ^ 1) * CH_ROWS;
                        for (int r = c.gw; r < CH_ROWS; r += c.NGW) row_to_bf16_ssq(xin + (size_t)r * DM, XBn + (size_t)r * DM, S1n + r, c.lane);
                    }
                } else {
                    pg8::Gemm g{(const bf16_t*)(ws + WS_TMP), (const bf16_t*)(ws + WS_WDN) + (size_t)layer * DM * DFF, CH_ROWS, DM, DFF}; pg8::StaticOrder S; S.init(CH_ROWS, DM, c.G, c.cu);
                    pg8::EpiRes2 E{xo, xo, XB, S1, DM};
#ifdef PROBE_GE2
                    { pg8::EpiRes2 E0{xo, (float*)(ws + WS_PROJ), (bf16_t*)(ws + WS_PROJ + 72 * MiB), (float*)(ws + WS_PROJ + 110 * MiB), DM}; pg8::gemm_phase<pg8::EpiRes2, pg8::StaticOrder, true, true>(lds, g, S, E0); }
#endif
                    pg8::gemm_phase<pg8::EpiRes2, pg8::StaticOrder, true, true>(lds, g, S, E);
                }
            }
        }
#ifdef PROBE_P2
        if (step == 0) grid.sync(); else xcd_barrier(xbar);
#else
        if (step == 0) grid.sync(); else if (step != NSTEPS - 1) xcd_barrier(xbar);
#endif
    }
#ifdef PROBE_TA
    if (blockIdx.x == 0 && threadIdx.x < 64) {
        float* xo = chunk_out(a, NCHUNK - 1);
        const float ua = (float)tA_ * 0.01f, ub = (float)tB_ * 0.01f;
        if (threadIdx.x == 0) xo[0] += 8.f + ua * 0.01f; else xo[4 * threadIdx.x] += sqrtf(ub * 0.01f);
    }
#endif
}

extern "C" void kernel_launch(void* const* d_in, const int* in_sizes, int n_in, void* d_out, int out_size, void* d_ws, size_t ws_size, hipStream_t stream) {
    static int grid = 0;
    if (grid == 0) {
        if (n_in != 17 || ws_size < WS_END) { fprintf(stderr, "kernel_launch: unexpected n_in %d / ws_size %zu (need %zu)\n", n_in, ws_size, (size_t)WS_END); grid = -1; return; }
        int dev = 0, cus = 0, per_cu = 0;
        (void)hipGetDevice(&dev); (void)hipDeviceGetAttribute(&cus, hipDeviceAttributeMultiprocessorCount, dev);
        if (hipFuncSetAttribute((const void*)mega_fwd, hipFuncAttributeMaxDynamicSharedMemorySize, LDS_BYTES) != hipSuccess) { fprintf(stderr, "hipFuncSetAttribute failed\n"); grid = -1; return; }
        if (hipOccupancyMaxActiveBlocksPerMultiprocessor(&per_cu, (const void*)mega_fwd, NTHREADS, LDS_BYTES) != hipSuccess || per_cu < 1) { fprintf(stderr, "occupancy query: %d\n", per_cu); per_cu = 1; }
        (void)hipGetLastError();
        grid = cus * 1;
    }
    if (grid < 0) return;
    (void)hipMemsetAsync((char*)d_ws + WS_CTL, 0, 65536, stream);
    Args a{};
    for (int i = 0; i < 17; ++i) a.in[i] = (const float*)d_in[i];
    a.out = (float*)d_out; a.ws = (unsigned char*)d_ws;
    void* args[] = {&a};
    hipError_t e = hipLaunchCooperativeKernel((const void*)mega_fwd, dim3(grid), dim3(NTHREADS), args, LDS_BYTES, stream);
    if (e != hipSuccess) fprintf(stderr, "cooperative launch failed: %s (grid %d)\n", hipGetErrorString(e), grid);
}
```

```cpp
#include <hip/hip_runtime.h>
#include <hip/hip_cooperative_groups.h>
#include <cstdio>
#include <cstdint>
#include <cmath>
namespace cg = cooperative_groups;
namespace pg8 {
#define PG8_LAS __attribute__((address_space(3)))
typedef unsigned short bf16_t;
typedef short bf16x8 __attribute__((ext_vector_type(8)));
typedef float f32x4 __attribute__((ext_vector_type(4)));
typedef unsigned u32x4 __attribute__((ext_vector_type(4)));
constexpr int BM = 256, BK = 64, HALF = 128, HTB = HALF * BK * 2  , STAGE_BYTES = 8 * HTB, NXCD = 8, WGM = 8;

__host__ __device__ __forceinline__ int lds_byte(int r, int c) { const int st = (r >> 4) * 2 + (c >> 5), rr = r & 15, cc = c & 31, ob = rr * 64 + cc * 2; return st * 1024 + (ob ^ (((ob >> 9) & 1) << 5)); }
__host__ __device__ __forceinline__ void stage_rc(int b, int& R, int& C) { const int st = b / 1024, sb = b % 1024, swz = sb ^ (((sb >> 9) & 1) << 5); R = (st >> 1) * 16 + swz / 64; C = (st & 1) * 32 + (swz % 64) / 2; }
__host__ __device__ __forceinline__ int perm32(int rho) { const int n = rho >> 4, i = rho & 15; return 8 * (i >> 2) + 4 * n + (i & 3); }

struct Unit { int pm, pn; };
struct Gemm { const bf16_t* A; const bf16_t* Bt; int M, N, K; int a_rows = 256; };

struct StaticOrder {
    int nM, nN, nwg, G, c;
    __host__ __device__ void init(int M, int N, int G_, int c_) { nM = M / BM; nN = N / BM; nwg = nM * nN; G = G_; c = c_; }
    __host__ __device__ bool next(int i, Unit& u) const {
        const long L = (long)i * G + c; if (L >= nwg) return false;
        int wgid = (int)L; { const int q = nwg / NXCD, r = nwg % NXCD, xcd = wgid % NXCD, off = wgid / NXCD; wgid = (xcd < r ? xcd * (q + 1) : r * (q + 1) + (xcd - r) * q) + off; }
        const int nig = WGM * nN, gid = wgid / nig, fm = gid * WGM, gsz = (nM - fm) < WGM ? (nM - fm) : WGM;
        u.pm = fm + ((wgid % nig) % gsz); u.pn = (wgid % nig) / gsz; return true;
    }
    __device__ __forceinline__ void a_ready(const Unit&) const {}
    __device__ __forceinline__ void done(const Unit&) const {}
};

__device__ __forceinline__ unsigned cvt_pk_bf16(float lo, float hi) { unsigned r; asm volatile("v_cvt_pk_bf16_f32 %0, %1, %2" : "=v"(r) : "v"(lo), "v"(hi)); return r; }
struct EpiBf16S {
    static constexpr bool PERM = true, AFTER_DRAIN = false;
    bf16_t* O; int ldc; unsigned scalemask; float sc;
    __device__ __forceinline__ void operator()(const f32x4 (&acc)[2][2][4][2], const Unit& u, int wr, int wc, int fr, int fq) const {
        const int row0 = u.pm * BM + wr * 64 + fr; const int col0 = u.pn * BM + wc * 32 + 8 * fq;
        const float s = ((scalemask >> u.pn) & 1u) ? sc : 1.f;
#pragma unroll
        for (int ai = 0; ai < 2; ++ai)
#pragma unroll
            for (int m = 0; m < 4; ++m) { bf16_t* rowp = O + (size_t)(row0 + ai * HALF + m * 16) * ldc + col0;
#pragma unroll
                for (int bj = 0; bj < 2; ++bj) { f32x4 v0 = acc[ai][bj][m][0] * s, v1 = acc[ai][bj][m][1] * s;
                    u32x4 w; w.x = cvt_pk_bf16(v0[0], v0[1]); w.y = cvt_pk_bf16(v0[2], v0[3]); w.z = cvt_pk_bf16(v1[0], v1[1]); w.w = cvt_pk_bf16(v1[2], v1[3]);
                    *(u32x4*)(rowp + bj * HALF) = w; } }
    }
};
struct EpiRes {
    static constexpr bool PERM = false, AFTER_DRAIN = false;
    const float* base; float* out; int ldc;
    __device__ __forceinline__ void operator()(const f32x4 (&acc)[2][2][4][2], const Unit& u, int wr, int wc, int fr, int fq) const {
        const int col0 = u.pn * BM + wc * 32 + 4 * fq;
#pragma unroll
        for (int ai = 0; ai < 2; ++ai)
#pragma unroll
            for (int m = 0; m < 4; ++m) { const size_t off = (size_t)(u.pm * BM + ai * HALF + wr * 64 + m * 16 + fr) * ldc + col0;
#pragma unroll
                for (int bj = 0; bj < 2; ++bj)
#pragma unroll
                    for (int n = 0; n < 2; ++n) { const f32x4 bs = *(const f32x4*)(base + off + bj * HALF + n * 16); *(f32x4*)(out + off + bj * HALF + n * 16) = bs + acc[ai][bj][m][n]; }
                asm volatile("" ::: "memory"); }
    }
};

struct EpiBf16S2 {
    static constexpr bool PERM = true, AFTER_DRAIN = false;
    bf16_t* O; int ldc; unsigned scalemask; float sc; const float* ssq;
    __device__ __forceinline__ void operator()(const f32x4 (&acc)[2][2][4][2], const Unit& u, int wr, int wc, int fr, int fq) const {
        const int row0 = u.pm * BM + wr * 64 + fr; const int col0 = u.pn * BM + wc * 32 + 8 * fq;
        const float s = ((scalemask >> u.pn) & 1u) ? sc : 1.f;
#pragma unroll
        for (int ai = 0; ai < 2; ++ai)
#pragma unroll
            for (int m = 0; m < 4; ++m) { const int row = row0 + ai * HALF + m * 16; bf16_t* rowp = O + (size_t)row * ldc + col0;
                const float rs = s / sqrtf(ssq[row] * (1.f / 1024.f) + 1e-6f);
#pragma unroll
                for (int bj = 0; bj < 2; ++bj) { f32x4 v0 = acc[ai][bj][m][0] * rs, v1 = acc[ai][bj][m][1] * rs;
                    u32x4 w; w.x = cvt_pk_bf16(v0[0], v0[1]); w.y = cvt_pk_bf16(v0[2], v0[3]); w.z = cvt_pk_bf16(v1[0], v1[1]); w.w = cvt_pk_bf16(v1[2], v1[3]);
                    *(u32x4*)(rowp + bj * HALF) = w; } }
    }
};
typedef unsigned u32x2e __attribute__((ext_vector_type(2)));
struct EpiRes2 {
    static constexpr bool PERM = false, AFTER_DRAIN = false;
    const float* base; float* out; bf16_t* xb; float* ssq; int ldc;
    __device__ __forceinline__ void operator()(const f32x4 (&acc)[2][2][4][2], const Unit& u, int wr, int wc, int fr, int fq) const {
        const int col0 = u.pn * BM + wc * 32 + 4 * fq;
#pragma unroll
        for (int ai = 0; ai < 2; ++ai)
#pragma unroll
            for (int m = 0; m < 4; ++m) { const int row = u.pm * BM + ai * HALF + wr * 64 + m * 16 + fr; const size_t off = (size_t)row * ldc + col0; float ps = 0.f;
#pragma unroll
                for (int bj = 0; bj < 2; ++bj)
#pragma unroll
                    for (int n = 0; n < 2; ++n) { const f32x4 bs = *(const f32x4*)(base + off + bj * HALF + n * 16); const f32x4 v = bs + acc[ai][bj][m][n];
                        *(f32x4*)(out + off + bj * HALF + n * 16) = v; ps += (v[0] * v[0] + v[1] * v[1]) + (v[2] * v[2] + v[3] * v[3]);
                        u32x2e w; w.x = cvt_pk_bf16(v[0], v[1]); w.y = cvt_pk_bf16(v[2], v[3]); *(u32x2e*)(xb + off + bj * HALF + n * 16) = w; }
                ps += __shfl_xor(ps, 16); ps += __shfl_xor(ps, 32);
                if (fq == 0) atomicAdd(ssq + row, ps);
                asm volatile("" ::: "memory"); }
    }
};

struct EpiNull {
    static constexpr bool PERM = false, AFTER_DRAIN = false;
    __device__ __forceinline__ void operator()(const f32x4 (&acc)[2][2][4][2], const Unit& u, int wr, int wc, int fr, int fq) const {
#pragma unroll
        for (int ai = 0; ai < 2; ++ai)
#pragma unroll
            for (int bj = 0; bj < 2; ++bj)
#pragma unroll
                for (int m = 0; m < 4; ++m)
#pragma unroll
                    for (int n = 0; n < 2; ++n) asm volatile("" :: "v"(acc[ai][bj][m][n]));
    }
};

#define PG8_DPP(old, src, ctrl) __builtin_bit_cast(float, __builtin_amdgcn_update_dpp(__builtin_bit_cast(int, (float)(old)), __builtin_bit_cast(int, (float)(src)), (ctrl), 0xF, 0xF, false))
struct EpiConv {
    static constexpr bool PERM = true, AFTER_DRAIN = false;
    bf16_t* G; const float* ssq; const float* cw; const float* cb; int slmask; PG8_LAS float* xch; int nrows;
    __device__ __forceinline__ void operator()(f32x4 (&acc)[2][2][4][2], const Unit& u, int wr, int wc, int fr, int fq) const {
        const int t0 = 254 * u.pm - 1 + wr * 64 + fr;
#pragma unroll
        for (int ai = 0; ai < 2; ++ai)
#pragma unroll
            for (int m = 0; m < 4; ++m) { int t = t0 + ai * HALF + m * 16; t = t < 0 ? 0 : (t > nrows - 1 ? nrows - 1 : t);
                const float rs = 1.f / sqrtf(ssq[t] * (1.f / 1024.f) + 1e-6f);
#pragma unroll
                for (int bj = 0; bj < 2; ++bj)
#pragma unroll
                    for (int n = 0; n < 2; ++n) acc[ai][bj][m][n] *= rs; }
        if (fr == 0 || fr == 15) { const int which = fr == 0 ? 0 : 1, m = fr == 0 ? 0 : 3;
#pragma unroll
            for (int ai = 0; ai < 2; ++ai) { PG8_LAS float* d = xch + ((((2 * ai + wr) * 2 + which) * 4 + wc) * 4 + fq) * 16;
#pragma unroll
                for (int bj = 0; bj < 2; ++bj)
#pragma unroll
                    for (int n = 0; n < 2; ++n) *(PG8_LAS f32x4*)(d + bj * 8 + n * 4) = fr == 0 ? acc[ai][bj][0][n] : acc[ai][bj][3][n]; }
            (void)m; }
        asm volatile("s_waitcnt lgkmcnt(0)" ::: "memory"); __builtin_amdgcn_s_barrier(); asm volatile("" ::: "memory");
        const int ch0 = u.pn * 128 + wc * 32 + 8 * fq;
#pragma unroll
        for (int n = 0; n < 2; ++n) {
            const int chn = ch0 + 4 * n;
            const f32x4 wg0 = *(const f32x4*)(cw + chn), wg1 = *(const f32x4*)(cw + 5632 + chn), wg2 = *(const f32x4*)(cw + 2 * 5632 + chn), bgv = *(const f32x4*)(cb + chn);
            const f32x4 wv0 = *(const f32x4*)(cw + 2816 + chn), wv1 = *(const f32x4*)(cw + 5632 + 2816 + chn), wv2 = *(const f32x4*)(cw + 2 * 5632 + 2816 + chn), bvv = *(const f32x4*)(cb + 2816 + chn);
#pragma unroll
            for (int ai = 0; ai < 2; ++ai)
#pragma unroll
                for (int m = 0; m < 4; ++m) {
                    const int lr = ai * HALF + wr * 64 + m * 16 + fr, t = 254 * u.pm - 1 + lr;
                    const int gidx = 2 * ai + wr;
                    f32x4 pv[2], nx[2];
#pragma unroll
                    for (int bj = 0; bj < 2; ++bj) {
                        f32x4 upo, dno;
                        if (m > 0) { const f32x4 s = acc[ai][bj][m - 1][n];
#pragma unroll
                            for (int j = 0; j < 4; ++j) upo[j] = PG8_DPP(0.f, s[j], 0x121); }
                        else upo = gidx > 0 ? *(const PG8_LAS f32x4*)(xch + ((((gidx - 1) * 2 + 1) * 4 + wc) * 4 + fq) * 16 + bj * 8 + n * 4) : (f32x4){0.f, 0.f, 0.f, 0.f};
                        if (m < 3) { const f32x4 s = acc[ai][bj][m + 1][n];
#pragma unroll
                            for (int j = 0; j < 4; ++j) dno[j] = PG8_DPP(0.f, s[j], 0x12F); }
                        else dno = gidx < 3 ? *(const PG8_LAS f32x4*)(xch + ((((gidx + 1) * 2 + 0) * 4 + wc) * 4 + fq) * 16 + bj * 8 + n * 4) : (f32x4){0.f, 0.f, 0.f, 0.f};
                        const f32x4 cur = acc[ai][bj][m][n];
#pragma unroll
                        for (int j = 0; j < 4; ++j) { pv[bj][j] = PG8_DPP(upo[j], cur[j], 0x111);
                                                       nx[bj][j] = PG8_DPP(dno[j], cur[j], 0x101); }
                    }
                    const bool sfirst = (t & slmask) == 0, slast = (t & slmask) == slmask;
                    float res[4];
#pragma unroll
                    for (int j = 0; j < 4; ++j) {
                        const float gp = sfirst ? 0.f : pv[0][j], gn = slast ? 0.f : nx[0][j], vp = sfirst ? 0.f : pv[1][j], vn = slast ? 0.f : nx[1][j];
                        const float gate = gp * wg0[j] + acc[ai][0][m][n][j] * wg1[j] + gn * wg2[j] + bgv[j];
                        const float val = vp * wv0[j] + acc[ai][1][m][n][j] * wv1[j] + vn * wv2[j] + bvv[j];
                        res[j] = gate * __builtin_amdgcn_rcpf(1.f + __builtin_amdgcn_exp2f(-1.4426950408889634f * gate)) * val;
                    }
                    if (lr >= 1 && lr <= 254 && t < nrows) { u32x2e w; w.x = cvt_pk_bf16(res[0], res[1]); w.y = cvt_pk_bf16(res[2], res[3]); *(u32x2e*)(G + (size_t)t * 2816 + chn) = w; }
                }
        }
    }
};
template <class Epi, class Sched, bool ALIGN_EPI = false, bool SP2 = false>
__device__ __forceinline__ void gemm_phase(PG8_LAS unsigned char* lds, const Gemm g, const Sched& S, const Epi& E) {
    int tid_l = threadIdx.x; asm volatile("" : "+v"(tid_l)); const int tid = tid_l, wid = __builtin_amdgcn_readfirstlane(tid >> 6), lane = tid & 63, wr = wid >> 2, wc = wid & 3, fr = lane & 15, fq = lane >> 4;
    const int K = g.K, nt = K / BK;
    unsigned voffA[2], voffB[2];
#pragma unroll
    for (int i = 0; i < 2; ++i) { int R, C; stage_rc(tid * 16 + i * 8192, R, C); const int Rb = Epi::PERM ? ((R & ~31) + perm32(R & 31)) : R;
        voffA[i] = (unsigned)(R * K + C) * 2u; voffB[i] = (unsigned)(Rb * K + C) * 2u; }
    const size_t kstep = (size_t)(BK * 2);
    const size_t hstep = (size_t)HALF * K * 2;
    const size_t tstep = 2 * hstep; const size_t tstepA = (size_t)g.a_rows * K * 2;
    const unsigned ldsw = (unsigned)wid * 1024u;
    const int aoff = lds_byte(wr * 64 + fr, fq * 8), boff = lds_byte(wc * 32 + fr, fq * 8);
#define PG8_SA(b, h) (((b) * 2 + (h)) * HTB)
#define PG8_SB(b, h) ((4 + (b) * 2 + (h)) * HTB)
#define PG8_STAGE(bufoff, gbase, voff) do { _Pragma("unroll") for (int _i = 0; _i < 2; ++_i) \
        __builtin_amdgcn_global_load_lds((const unsigned*)((const char*)(gbase) + (voff)[_i]), (PG8_LAS unsigned*)(lds + (bufoff) + ldsw + _i * 8192), 16, 0, 0); } while (0)
#define PG8_LDA(dst, b, h) do { _Pragma("unroll") for (int m = 0; m < 4; ++m) _Pragma("unroll") for (int k = 0; k < 2; ++k) dst[m][k] = *(const PG8_LAS bf16x8*)(lds + PG8_SA(b, h) + aoff + m * 2048 + k * 1024); } while (0)
#define PG8_LDB(dst, b, h) do { _Pragma("unroll") for (int n = 0; n < 2; ++n) _Pragma("unroll") for (int k = 0; k < 2; ++k) dst[n][k] = *(const PG8_LAS bf16x8*)(lds + PG8_SB(b, h) + boff + n * 2048 + k * 1024); } while (0)
#define PG8_MMA(ai, bj, At, Bt) do { __builtin_amdgcn_s_setprio(1); _Pragma("unroll") for (int m = 0; m < 4; ++m) _Pragma("unroll") for (int n = 0; n < 2; ++n) _Pragma("unroll") for (int k = 0; k < 2; ++k) \
        acc[ai][bj][m][n] = __builtin_amdgcn_mfma_f32_16x16x32_bf16(Bt[n][k], At[m][k], acc[ai][bj][m][n], 0, 0, 0); __builtin_amdgcn_s_setprio(0); } while (0)
#define PG8_WAIT_V(n) asm volatile("s_waitcnt vmcnt(" #n ")" ::: "memory")
#define PG8_WAIT_L(n) asm volatile("s_waitcnt lgkmcnt(" #n ")" ::: "memory")
#define PG8_BAR __builtin_amdgcn_s_barrier()
#define PG8_SCHED __builtin_amdgcn_sched_barrier(0)
    Unit cur, nxt; int ui = 0;
    if (!S.next(0, cur)) return;
    f32x4 acc[2][2][4][2];
#pragma unroll
    for (int a = 0; a < 2; ++a)
#pragma unroll
        for (int b = 0; b < 2; ++b)
#pragma unroll
            for (int m = 0; m < 4; ++m)
#pragma unroll
                for (int n = 0; n < 2; ++n) acc[a][b][m][n] = (f32x4){0.f, 0.f, 0.f, 0.f};
    bf16x8 At[4][2], B0[2][2], B1[2][2];
    const char* cA = (const char*)g.A + (size_t)cur.pm * tstepA; const char* cB = (const char*)g.Bt + (size_t)cur.pn * tstep;
    S.a_ready(cur);
    if constexpr (SP2) {
        PG8_STAGE(PG8_SB(0, 0), cB, voffB); PG8_STAGE(PG8_SB(0, 1), cB + hstep, voffB); PG8_STAGE(PG8_SA(0, 0), cA, voffA); PG8_STAGE(PG8_SA(0, 1), cA + hstep, voffA);
        if (wr == 1) PG8_BAR;
        PG8_WAIT_V(2); PG8_BAR;
        PG8_STAGE(PG8_SB(1, 0), cB + kstep, voffB); PG8_STAGE(PG8_SA(1, 0), cA + kstep, voffA); PG8_STAGE(PG8_SB(1, 1), cB + hstep + kstep, voffB);
        PG8_WAIT_V(6); PG8_BAR;
    } else {
        PG8_STAGE(PG8_SB(0, 0), cB, voffB); PG8_STAGE(PG8_SA(0, 0), cA, voffA); PG8_STAGE(PG8_SB(0, 1), cB + hstep, voffB); PG8_STAGE(PG8_SA(0, 1), cA + hstep, voffA);
        if (wr == 1) PG8_BAR;
        PG8_WAIT_V(4); PG8_BAR;
        PG8_STAGE(PG8_SB(1, 0), cB + kstep, voffB); PG8_STAGE(PG8_SA(1, 0), cA + kstep, voffA); PG8_STAGE(PG8_SB(1, 1), cB + hstep + kstep, voffB);
        PG8_WAIT_V(6); PG8_BAR;
    }
    for (;;) {
        const bool has_next = S.next(ui + 1, nxt);
        const char* nA = has_next ? (const char*)g.A + (size_t)nxt.pm * tstepA : cA; const char* nB = has_next ? (const char*)g.Bt + (size_t)nxt.pn * tstep : cB;
        for (int t = 0; t < nt; t += 2) {
            const bool last = (t == nt - 2);
            const char* a1 = cA + (size_t)(t + 1) * kstep;
            const char* a2 = last ? nA : cA + (size_t)(t + 2) * kstep; const char* b2 = last ? nB : cB + (size_t)(t + 2) * kstep;
            const char* a3 = a2 + kstep; const char* b3 = b2 + kstep;
            if (last && has_next) S.a_ready(nxt);
            if constexpr (SP2) {
            PG8_LDB(B0, 0, 0); PG8_LDB(B1, 0, 1); PG8_SCHED; PG8_LDA(At, 0, 0); PG8_STAGE(PG8_SA(1, 1), a1 + hstep, voffA);
            PG8_WAIT_V(8); PG8_WAIT_L(0); PG8_BAR; PG8_MMA(0, 0, At, B0); PG8_MMA(0, 1, At, B1); PG8_BAR; PG8_SCHED;
            PG8_LDA(At, 0, 1); PG8_STAGE(PG8_SB(0, 0), b2, voffB); PG8_STAGE(PG8_SB(0, 1), b2 + hstep, voffB); PG8_STAGE(PG8_SA(0, 0), a2, voffA);
            PG8_WAIT_V(8); PG8_WAIT_L(0); PG8_BAR; PG8_MMA(1, 0, At, B0); PG8_MMA(1, 1, At, B1); PG8_BAR; PG8_SCHED;
            PG8_LDB(B0, 1, 0); PG8_LDB(B1, 1, 1); PG8_SCHED; PG8_LDA(At, 1, 0); PG8_STAGE(PG8_SA(0, 1), a2 + hstep, voffA);
            PG8_WAIT_V(8); PG8_WAIT_L(0); PG8_BAR; PG8_MMA(0, 0, At, B0); PG8_MMA(0, 1, At, B1); PG8_BAR; PG8_SCHED;
            PG8_LDA(At, 1, 1); PG8_STAGE(PG8_SB(1, 0), b3, voffB); PG8_STAGE(PG8_SB(1, 1), b3 + hstep, voffB); PG8_STAGE(PG8_SA(1, 0), a3, voffA);
            PG8_WAIT_V(8); PG8_WAIT_L(0); PG8_BAR; PG8_MMA(1, 0, At, B0); PG8_MMA(1, 1, At, B1); PG8_BAR; PG8_SCHED;
            } else {
            PG8_LDB(B0, 0, 0); PG8_SCHED; PG8_LDA(At, 0, 0); PG8_STAGE(PG8_SA(1, 1), a1 + hstep, voffA);
            PG8_WAIT_L(8); PG8_BAR; PG8_WAIT_L(0); PG8_MMA(0, 0, At, B0); PG8_BAR; PG8_SCHED;
            PG8_LDB(B1, 0, 1); PG8_STAGE(PG8_SB(0, 0), b2, voffB);
            PG8_BAR; PG8_WAIT_L(0); PG8_MMA(0, 1, At, B1); PG8_BAR;
            PG8_LDA(At, 0, 1); PG8_STAGE(PG8_SA(0, 0), a2, voffA);
            PG8_BAR; PG8_WAIT_L(0); PG8_MMA(1, 0, At, B0); PG8_BAR; PG8_SCHED;
            PG8_STAGE(PG8_SB(0, 1), b2 + hstep, voffB);
            PG8_WAIT_V(6); PG8_BAR; PG8_MMA(1, 1, At, B1); PG8_BAR;
            PG8_LDB(B0, 1, 0); PG8_SCHED; PG8_LDA(At, 1, 0); PG8_STAGE(PG8_SA(0, 1), a2 + hstep, voffA);
            PG8_WAIT_L(8); PG8_BAR; PG8_WAIT_L(0); PG8_MMA(0, 0, At, B0); PG8_BAR; PG8_SCHED;
            PG8_LDB(B1, 1, 1); PG8_STAGE(PG8_SB(1, 0), b3, voffB);
            PG8_BAR; PG8_WAIT_L(0); PG8_MMA(0, 1, At, B1); PG8_BAR;
            PG8_LDA(At, 1, 1); PG8_STAGE(PG8_SA(1, 0), a3, voffA);
            PG8_BAR; PG8_WAIT_L(0); PG8_MMA(1, 0, At, B0); PG8_BAR; PG8_SCHED;
            PG8_STAGE(PG8_SB(1, 1), b3 + hstep, voffB);
            PG8_WAIT_V(6); PG8_BAR; PG8_MMA(1, 1, At, B1); PG8_BAR;
            }
        }
        if constexpr (ALIGN_EPI) { if (wr == 0) PG8_BAR; }
        if constexpr (!Epi::AFTER_DRAIN) { E(acc, cur, wr, wc, fr, fq); S.done(cur); }
        if (!has_next) break;
#pragma unroll
        for (int a = 0; a < 2; ++a)
#pragma unroll
            for (int b = 0; b < 2; ++b)
#pragma unroll
                for (int m = 0; m < 4; ++m)
#pragma unroll
                    for (int n = 0; n < 2; ++n) acc[a][b][m][n] = (f32x4){0.f, 0.f, 0.f, 0.f};
        cur = nxt; cA = nA; cB = nB; ++ui;
        if constexpr (ALIGN_EPI) { if (wr == 1) PG8_BAR; }
    }
    PG8_WAIT_V(0);
    if constexpr (!ALIGN_EPI) { if (wr == 0) PG8_BAR; }
    PG8_BAR;
    if constexpr (Epi::AFTER_DRAIN) { E.fused(acc, cur, wr, wc, fr, fq, lds, wid, lane); S.done(cur); }
#undef PG8_SA
#undef PG8_SB
#undef PG8_STAGE
#undef PG8_LDA
#undef PG8_LDB
#undef PG8_MMA
#undef PG8_WAIT_V
#undef PG8_WAIT_L
#undef PG8_BAR
#undef PG8_SCHED
}
}
typedef __bf16 bf16x2_t __attribute__((ext_vector_type(2)));
__device__ __forceinline__ unsigned cvt_pk(float lo, float hi) { float __attribute__((ext_vector_type(2))) v = {lo, hi}; bf16x2_t b = __builtin_convertvector(v, bf16x2_t); return __builtin_bit_cast(unsigned, b); }
#define LAS __attribute__((address_space(3)))
#define XB_TMO      128
#define XB_XCNT(j)  (256  + 64 * (j))
#define XB_XSUB(j)  (1280 + 64 * (j))
#define XB_XGEN(j)  (2304 + 64 * (j))
#define XB_TOP      3328
#define XB_TOPGEN   3392
#define XCD_BAR_WORDS 3456
#define XB_SPIN_CAP (1u << 18)

__device__ __forceinline__ unsigned xb_ld(unsigned* p)              { return __hip_atomic_load(p, __ATOMIC_RELAXED, __HIP_MEMORY_SCOPE_AGENT); }
__device__ __forceinline__ unsigned xb_add(unsigned* p, unsigned v) { return __hip_atomic_fetch_add(p, v, __ATOMIC_RELAXED, __HIP_MEMORY_SCOPE_AGENT); }
__device__ __forceinline__ unsigned xb_xcc_id() { return (unsigned)__builtin_amdgcn_s_getreg((3 << 11) | 20) & 0xFu; }
#define XB_SPIN(cond, bar) do { unsigned _sp = 0; while (cond) { __builtin_amdgcn_s_sleep(1); \
    if ((++_sp & 255u) == 0u) { if (xb_ld(&(bar)[XB_TMO])) break; if (_sp > XB_SPIN_CAP) { atomicAdd(&(bar)[XB_TMO], 1u); break; } } } } while (0)

struct XcdBarrier {
    unsigned* bar; unsigned x;
    volatile LAS unsigned* st;
};

__device__ __forceinline__ XcdBarrier xcd_barrier_post(unsigned* bar, volatile LAS unsigned* st) {
    XcdBarrier b; b.bar = bar; b.x = xb_xcc_id(); b.st = st;
    if (threadIdx.x == 0) (void)xb_add(&bar[XB_XCNT(b.x)], 1u);
    return b;
}
__device__ __forceinline__ void xcd_barrier_complete(unsigned* bar, unsigned x, unsigned& nloc, unsigned& nx) {
    const unsigned G = gridDim.x * gridDim.y * gridDim.z;
    unsigned sum, cnt, mine, sp = 0u;
    for (;;) {
        sum = 0u; cnt = 0u; mine = 0u;
#pragma unroll
        for (unsigned j = 0; j < 16; ++j) { const unsigned c = xb_ld(&bar[XB_XCNT(j)]); sum += c; cnt += (c > 0u) ? 1u : 0u; mine = (j == x) ? c : mine; }
        if (sum == G) break;
        __builtin_amdgcn_s_sleep(1);
        if ((++sp & 255u) == 0u) { if (xb_ld(&bar[XB_TMO])) break; if (sp > XB_SPIN_CAP) { atomicAdd(&bar[XB_TMO], 1u); break; } }
    }
    nloc = mine > 0u ? mine : 1u; nx = cnt > 0u ? cnt : 1u;
}

__device__ __forceinline__ void xcd_barrier(const XcdBarrier& b) {
    asm volatile("s_waitcnt vmcnt(0)" ::: "memory");
    __syncthreads();
    if (threadIdx.x == 0) {
        unsigned* bar = b.bar;
        __builtin_amdgcn_s_waitcnt(0);
        unsigned nloc = b.st[0], nx = b.st[1];
        if (nloc == 0u) { xcd_barrier_complete(bar, b.x, nloc, nx); b.st[0] = nloc; b.st[1] = nx; }
        const unsigned old = xb_add(&bar[XB_XSUB(b.x)], 1u);
        const unsigned gen = old / nloc;
        if (old + 1u == (gen + 1u) * nloc) {
            __builtin_amdgcn_fence(__ATOMIC_RELEASE, "agent");
            asm volatile("s_waitcnt vmcnt(0)" ::: "memory");
            const unsigned og = xb_add(&bar[XB_TOP], 1u);
            const unsigned tg = og / nx;
            if (og + 1u == (tg + 1u) * nx) xb_add(&bar[XB_TOPGEN], 1u);
            else XB_SPIN(xb_ld(&bar[XB_TOPGEN]) == tg, bar);
            __builtin_amdgcn_fence(__ATOMIC_ACQUIRE, "agent");
            xb_add(&bar[XB_XGEN(b.x)], 1u);
            asm volatile("s_waitcnt vmcnt(0)" ::: "memory");
        } else {
            XB_SPIN(xb_ld(&bar[XB_XGEN(b.x)]) == gen, bar);
            __builtin_amdgcn_fence(__ATOMIC_ACQUIRE, "agent");
            asm volatile("s_waitcnt vmcnt(0)" ::: "memory");
        }
    }
    __syncthreads();
}
typedef unsigned short bf16_t;
typedef short bf16x8 __attribute__((ext_vector_type(8)));
typedef short s16x4 __attribute__((ext_vector_type(4)));
typedef float f32x16 __attribute__((ext_vector_type(16)));
typedef float f32x4 __attribute__((ext_vector_type(4)));
typedef float f32x2 __attribute__((ext_vector_type(2)));
typedef unsigned u32x4 __attribute__((ext_vector_type(4)));
typedef unsigned u32x2 __attribute__((ext_vector_type(2)));

constexpr int DM = 1024, DIN = 4352, DFF = 2816, DUP = 2 * DFF, DEPTH = 2;
constexpr int CH_ROWS = 16384, NCHUNK = 3;
constexpr int TW = 784;
constexpr int T_C = 0, T_L = 768;
constexpr float LOG2E = 1.4426950408889634f, LN2 = 0.6931471805599453f;
constexpr float QSCALE = 0.125f * LOG2E;
constexpr size_t MiB = 1u << 20;
constexpr size_t WS_WIN = 0, WS_WOUT = 18 * MiB, WS_WUP = 22 * MiB, WS_WDN = 44 * MiB, WS_HB = 56 * MiB, WS_PROJ = 88 * MiB, WS_TMP = 264 * MiB, WS_CTL = 394 * MiB, WS_XB = 395 * MiB, WS_SSQ = 459 * MiB, WS_END = 460 * MiB;
constexpr int LDS_BYTES = 147456 + 256 + 8192;
constexpr int NTHREADS = 512;

struct Args { const float* in[17]; float* out; unsigned char* ws; };

__device__ __forceinline__ float wave_sum(float v) {
#pragma unroll
    for (int o = 1; o < 64; o <<= 1) v += __shfl_xor(v, o);
    return v;
}
__device__ __forceinline__ unsigned f2bf(float f) { unsigned u = __builtin_bit_cast(unsigned, f); return (u + 0x7fffu + ((u >> 16) & 1u)) >> 16; }
__device__ __forceinline__ unsigned pk2(float lo, float hi) { return f2bf(lo) | (f2bf(hi) << 16); }
__device__ __forceinline__ float bf2f(unsigned short b) { return __builtin_bit_cast(float, (unsigned)b << 16); }

__device__ __forceinline__ void transpose_item(const float* W, int K, int N, bf16_t* WT, LAS float* scr, int item, int lane, const float* gain, bool gate_perm = false) {
    const int nblk = N / 32, kb = item / nblk, nb = item % nblk, k0 = 64 * kb, n0 = 32 * nb;
#pragma unroll 8
    for (int i = 0; i < 32; ++i) { const int kk = 2 * i + (lane >> 5); scr[kk * 33 + (lane & 31)] = W[(size_t)(k0 + kk) * N + n0 + (lane & 31)] * (gain ? gain[k0 + kk] : 1.f); }
    asm volatile("s_waitcnt lgkmcnt(0)" ::: "memory");
    const int c = lane & 7;
    const int half_ = N / 2, v_ = n0 >= half_ ? n0 - half_ : n0, d0 = gate_perm ? 256 * (v_ / 128) + (n0 >= half_ ? 128 : 0) + (v_ % 128) : n0;
#pragma unroll
    for (int j = 0; j < 4; ++j) { const int n = (lane >> 3) + 8 * j; const LAS float* s = scr + (8 * c) * 33 + n;
        u32x4 o; o.x = pk2(s[0 * 33], s[1 * 33]); o.y = pk2(s[2 * 33], s[3 * 33]); o.z = pk2(s[4 * 33], s[5 * 33]); o.w = pk2(s[6 * 33], s[7 * 33]);
        *(u32x4*)(WT + (size_t)(d0 + n) * K + k0 + 8 * c) = o; }
    asm volatile("s_waitcnt lgkmcnt(0)" ::: "memory");
}

__device__ __forceinline__ void rms_row_to_bf16(const float* xrow, const float* gain, bf16_t* orow, int lane) {
    const f32x4* xr = (const f32x4*)xrow + lane; const f32x4* gr = (const f32x4*)gain + lane;
    f32x4 v[4]; float s = 0.f;
#pragma unroll
    for (int j = 0; j < 4; ++j) { v[j] = xr[64 * j]; s += (v[j].x * v[j].x + v[j].y * v[j].y) + (v[j].z * v[j].z + v[j].w * v[j].w); }
    const float rstd = 1.f / sqrtf(wave_sum(s) * (1.f / DM) + 1e-6f);
    u32x2* o8 = (u32x2*)orow + lane;
#pragma unroll
    for (int j = 0; j < 4; ++j) { const f32x4 g = gr[64 * j]; u32x2 w; w.x = pk2(v[j].x * rstd * g.x, v[j].y * rstd * g.y); w.y = pk2(v[j].z * rstd * g.z, v[j].w * rstd * g.w); o8[64 * j] = w; }
}
__device__ __forceinline__ void rms_row_f32(float* xrow, const float* gain, int lane) {
    f32x4* xr = (f32x4*)xrow + lane; const f32x4* gr = (const f32x4*)gain + lane;
    f32x4 v[4]; float s = 0.f;
#pragma unroll
    for (int j = 0; j < 4; ++j) { v[j] = xr[64 * j]; s += (v[j].x * v[j].x + v[j].y * v[j].y) + (v[j].z * v[j].z + v[j].w * v[j].w); }
    const float rstd = 1.f / sqrtf(wave_sum(s) * (1.f / DM) + 1e-6f);
#pragma unroll
    for (int j = 0; j < 4; ++j) { const f32x4 g = gr[64 * j]; xr[64 * j] = v[j] * rstd * g; }
}

constexpr int KSTR = 144;
constexpr int ATT_K_OFF = 0, ATT_V_OFF = 2 * 64 * KSTR, ATT_SCR_OFF = ATT_V_OFF + 2 * 64 * 320;
__device__ __forceinline__ int crow(int r, int hi) { return (r & 3) + 8 * (r >> 2) + 4 * hi; }
typedef short v4i16_t __attribute__((ext_vector_type(4)));
__device__ __forceinline__ s16x4 vtr(const LAS unsigned char* p) { return __builtin_bit_cast(s16x4, __builtin_amdgcn_ds_read_tr16_b64_v4i16((LAS v4i16_t*)p)); }

template <int VD, bool WIN>
__device__ __forceinline__ void attn_unit(LAS unsigned char* lds, const bf16_t* Qp, const bf16_t* Kp, const bf16_t* Vp, size_t pitch,
                                          int q0, int L, float slope2, int W, float m_init, float l_init,
                                          float* Oout, size_t opitch, float* lse_out, size_t lpitch, bf16_t* Obf) {
    constexpr int VSTR = VD * 2 + 64, ND = VD / 32, VCH = VD / 8, VLD = 64 * VCH / NTHREADS;
    int tid_l = threadIdx.x; asm volatile("" : "+v"(tid_l)); const int tid = tid_l, lane = tid & 63, r32 = lane & 31, hi = lane >> 5, wid = __builtin_amdgcn_readfirstlane(tid >> 6);
    const int qw = q0 + wid * 32;
    int tlo = 0, thi = L / 64;
    if (WIN) { const int a = q0 - W; tlo = a > 0 ? a / 64 : 0; const int b = q0 + 256 + W; thi = (b < L ? b : L) / 64; }
    bf16x8 qr[4];
    { const bf16_t* qrow = Qp + (size_t)(qw + r32) * pitch + hi * 8;
#pragma unroll
      for (int d0 = 0; d0 < 4; ++d0) qr[d0] = *(const bf16x8*)(qrow + d0 * 16); }
    f32x16 o[ND];
#pragma unroll
    for (int d = 0; d < ND; ++d)
#pragma unroll
        for (int r = 0; r < 16; ++r) o[d][r] = 0.f;
    float m = m_init, l = hi == 0 ? l_init : 0.f;
    LAS float* wsf = (LAS float*)(lds + 6 * (64 * KSTR + 64 * (VD * 2 + 64))) + wid * 64;
    static_assert(VD == 64, "grouped staging is sized for 64-wide values");
    constexpr int SLOT = 64 * KSTR + 64 * VSTR, GRP = 6;
    const int krow = tid >> 3, kch = tid & 7;
    const float Wf = (float)W;
    for (int g0 = tlo; g0 < thi; g0 += GRP) {
        const int ng = thi - g0 < GRP ? thi - g0 : GRP;
        u32x4 kr[GRP], vr[GRP];
#pragma unroll
        for (int j = 0; j < GRP; ++j) if (j < ng) { kr[j] = *(const u32x4*)(Kp + (size_t)(64 * (g0 + j) + krow) * pitch + kch * 8); vr[j] = *(const u32x4*)(Vp + (size_t)(64 * (g0 + j) + krow) * pitch + kch * 8); }
        if (g0 != tlo) __syncthreads();
#pragma unroll
        for (int j = 0; j < GRP; ++j) if (j < ng) { *(LAS u32x4*)(lds + j * SLOT + krow * KSTR + kch * 16) = kr[j]; *(LAS u32x4*)(lds + j * SLOT + 64 * KSTR + krow * VSTR + kch * 16) = vr[j]; }
        __syncthreads();
      for (int j = 0; j < ng; ++j) {
        const int t = g0 + j;
        bool active = true;
        if (WIN) { const int kb = 64 * t; active = (kb + 63 >= qw - W) && (kb <= qw + 31 + W); }
        if (active) {
            const LAS unsigned char* Kb = lds + j * SLOT + r32 * KSTR + hi * 16;
            f32x16 p0, p1;
#pragma unroll
            for (int r = 0; r < 16; ++r) { p0[r] = 0.f; p1[r] = 0.f; }
#pragma unroll
            for (int d0 = 0; d0 < 4; ++d0) {
                const bf16x8 a0 = *(const LAS bf16x8*)(Kb + d0 * 32), a1 = *(const LAS bf16x8*)(Kb + 32 * KSTR + d0 * 32);
                p0 = __builtin_amdgcn_mfma_f32_32x32x16_bf16(a0, qr[d0], p0, 0, 0, 0);
                p1 = __builtin_amdgcn_mfma_f32_32x32x16_bf16(a1, qr[d0], p1, 0, 0, 0);
                if (d0 & 1) __builtin_amdgcn_sched_barrier(0);
            }
            const float dq = (float)(64 * t + 4 * hi - (qw + r32));
            float rm = -INFINITY;
#pragma unroll
            for (int r = 0; r < 16; ++r) {
                const float t0 = dq + (float)((r & 3) + 8 * (r >> 2)), t1 = t0 + 32.f;
                p0[r] = __builtin_fmaf(-slope2, __builtin_fabsf(t0), p0[r]);
                p1[r] = __builtin_fmaf(-slope2, __builtin_fabsf(t1), p1[r]);
                if (WIN) { if (__builtin_fabsf(t0) > Wf) p0[r] = -INFINITY; if (__builtin_fabsf(t1) > Wf) p1[r] = -INFINITY; }
                rm = __builtin_fmaxf(rm, __builtin_fmaxf(p0[r], p1[r]));
            }
            rm = __builtin_fmaxf(rm, __shfl_xor(rm, 32));
            if (__any(rm > m)) {
                const float mn = __builtin_fmaxf(m, rm); const float f = __builtin_amdgcn_exp2f(m - mn); m = mn; l *= f;
                if (hi == 0) wsf[r32] = f;
#pragma unroll
                for (int r = 0; r < 16; ++r) { const float fr = wsf[crow(r, hi)];
#pragma unroll
                    for (int d = 0; d < ND; ++d) o[d][r] *= fr; }
            }
            float ls = 0.f;
#pragma unroll
            for (int r = 0; r < 16; ++r) { p0[r] = __builtin_amdgcn_exp2f(p0[r] - m); p1[r] = __builtin_amdgcn_exp2f(p1[r] - m); ls += p0[r] + p1[r]; }
            l += ls;
            u32x4 pw[4];
#pragma unroll
            for (int c = 0; c < 4; ++c) {
                const f32x16& P = (c >> 1) ? p1 : p0; const int b = 8 * (c & 1);
                pw[c].x = cvt_pk(P[b + 0], P[b + 1]); pw[c].y = cvt_pk(P[b + 2], P[b + 3]); pw[c].z = cvt_pk(P[b + 4], P[b + 5]); pw[c].w = cvt_pk(P[b + 6], P[b + 7]);
            }
            const LAS unsigned char* Vb = lds + j * SLOT + 64 * KSTR + (4 * hi + ((lane & 15) >> 2)) * VSTR + (16 * ((lane >> 4) & 1) + 4 * (lane & 3)) * 2;
#pragma unroll
            for (int c = 0; c < 4; ++c)
#pragma unroll
                for (int d = 0; d < ND; ++d) {
                    const s16x4 vlo = vtr(Vb + c * 16 * VSTR + d * 64), vhi = vtr(Vb + c * 16 * VSTR + 8 * VSTR + d * 64);
                    const bf16x8 vf = (bf16x8){vlo[0], vlo[1], vlo[2], vlo[3], vhi[0], vhi[1], vhi[2], vhi[3]};
                    o[d] = __builtin_amdgcn_mfma_f32_32x32x16_bf16(__builtin_bit_cast(bf16x8, pw[c]), vf, o[d], 0, 0, 0);
                    if (d == ND - 1) __builtin_amdgcn_sched_barrier(0);
                }
        }
      }
    }
    l += __shfl_xor(l, 32);
    if (hi == 0) wsf[r32] = 1.f / l;
#pragma unroll
    for (int r = 0; r < 16; ++r) { const float ir = wsf[crow(r, hi)];
        if (Obf != nullptr) { bf16_t* orow = Obf + (size_t)(qw + crow(r, hi)) * opitch + r32;
#pragma unroll
            for (int d = 0; d < ND; ++d) orow[d * 32] = (bf16_t)f2bf(o[d][r] * ir);
        } else { float* orow = Oout + (size_t)(qw + crow(r, hi)) * opitch + r32;
#pragma unroll
            for (int d = 0; d < ND; ++d) orow[d * 32] = o[d][r] * ir; } }
    if (lse_out != nullptr && hi == 0) lse_out[(size_t)(qw + r32) * lpitch] = (m + __builtin_log2f(l)) * LN2;
    __syncthreads();
}

__device__ __forceinline__ void row_to_bf16_ssq(const float* xrow, bf16_t* orow, float* ssq, int lane) {
    const f32x4* xr = (const f32x4*)xrow + lane;
    f32x4 v[4]; float s = 0.f;
#pragma unroll
    for (int j = 0; j < 4; ++j) { v[j] = xr[64 * j]; s += (v[j].x * v[j].x + v[j].y * v[j].y) + (v[j].z * v[j].z + v[j].w * v[j].w); }
    s = wave_sum(s);
    u32x2* o8 = (u32x2*)orow + lane;
#pragma unroll
    for (int j = 0; j < 4; ++j) { u32x2 w; w.x = pk2(v[j].x, v[j].y); w.y = pk2(v[j].z, v[j].w); o8[64 * j] = w; }
    if (lane == 0) *ssq = s;
}
constexpr int BK_OFF = 0, BV_OFF = 2 * 64 * KSTR, BSCR_OFF = BV_OFF + 3 * 64 * 320, ATT_O0_OFF = BSCR_OFF + 2048;
static_assert(ATT_O0_OFF + 65536 <= 147456, "B attention LDS map");
constexpr float B_THR = 6.0f;
#ifndef B_LATE
#define B_LATE(w) false
#endif
template <int KI> __device__ __forceinline__ float fmamk_t(float a, float c) { float r; asm("v_fmamk_f32 %0, %1, %3, %2" : "=v"(r) : "v"(a), "v"(c), "n"(__builtin_bit_cast(int, (float)KI))); return r; }
__device__ __forceinline__ float max3f(float a, float b, float c) { float r; asm("v_max3_f32 %0, %1, %2, %3" : "=v"(r) : "v"(a), "v"(b), "v"(c)); return r; }
__device__ __forceinline__ void attn_b_unit(LAS unsigned char* lds, const bf16_t* base, int h, int q0, int L, float slope2_, float lam,
                                            const float* subln_l, float postscale, bf16_t* mix) {
    constexpr int VD = 128, VSTR = VD * 2 + 64, ND = 4, VCH = 16, VLD = 2;
    int tid_l = threadIdx.x; asm volatile("" : "+v"(tid_l)); const int tid = tid_l, lane = tid & 63, r32 = lane & 31, hi = lane >> 5, wid = __builtin_amdgcn_readfirstlane(tid >> 6);
    const int qw = q0 + wid * 32, NT = L / 64, c0 = q0 / 64;
    LAS float* wsf = (LAS float*)(lds + BSCR_OFF) + wid * 64;
    const bool late = B_LATE(wid);
    const int krow = tid >> 3, kch = tid & 7;
    const bf16_t* Vp = base + 1536 + h * 128;
    const float qposf_ = (float)(qw + r32);
    for (int mp = 0; mp < 2; ++mp) {
        const bf16_t* Qp = base + 512 + (h * 2 + mp) * 64; const bf16_t* Kp = base + 1024 + (h * 2 + mp) * 64;
        bf16x8 qr[4];
        { const bf16_t* qrow = Qp + (size_t)(qw + r32) * DIN + hi * 8;
#pragma unroll
          for (int d0 = 0; d0 < 4; ++d0) qr[d0] = *(const bf16x8*)(qrow + d0 * 16); }
        f32x16 o[ND];
#pragma unroll
        for (int d = 0; d < ND; ++d)
#pragma unroll
            for (int r = 0; r < 16; ++r) o[d][r] = 0.f;
        float mref = 0.f, l = 0.f;
        u32x4 kreg; u32x4 vreg[VLD];
        const unsigned koff = (unsigned)(krow * DIN + kch * 8) * 2u, voff = (unsigned)((tid >> 4) * DIN + (tid & 15) * 8) * 2u;
#define ATT_GLOAD(t) do { const char* kt_ = (const char*)Kp + (size_t)(t) * (64 * DIN * 2); const char* vt_ = (const char*)Vp + (size_t)(t) * (64 * DIN * 2); \
        kreg = *(const u32x4*)(kt_ + koff); vreg[0] = *(const u32x4*)(vt_ + voff); vreg[1] = *(const u32x4*)(vt_ + 32 * DIN * 2 + voff); } while (0)
#define ATT_LSTORE(b, vs) do { *(LAS u32x4*)(lds + BK_OFF + (b) * 64 * KSTR + krow * KSTR + kch * 16) = kreg; \
        *(LAS u32x4*)(lds + BV_OFF + (vs) * 64 * VSTR + (tid >> 4) * VSTR + (tid & 15) * 16) = vreg[0]; *(LAS u32x4*)(lds + BV_OFF + (vs) * 64 * VSTR + ((tid >> 4) + 32) * VSTR + (tid & 15) * 16) = vreg[1]; } while (0)
#define VFRAG(x, d) (bf16x8){x[d][0][0], x[d][0][1], x[d][0][2], x[d][0][3], x[d][1][0], x[d][1][1], x[d][1][2], x[d][1][3]}
#define PV_LOAD01(vs) do { \
        const LAS unsigned char* Vb = lds + BV_OFF + (vs) * 64 * VSTR + (4 * hi + ((lane & 15) >> 2)) * VSTR + (16 * ((lane >> 4) & 1) + 4 * (lane & 3)) * 2; \
        _Pragma("unroll") for (int d = 0; d < ND; ++d) { va[d][0] = vtr(Vb + d * 64); va[d][1] = vtr(Vb + 8 * VSTR + d * 64); } \
        _Pragma("unroll") for (int d = 0; d < ND; ++d) { vb2[d][0] = vtr(Vb + 16 * VSTR + d * 64); vb2[d][1] = vtr(Vb + 16 * VSTR + 8 * VSTR + d * 64); } \
        __builtin_amdgcn_sched_barrier(0); } while (0)
#define PV_MMA(vs) do { \
        const LAS unsigned char* Vb = lds + BV_OFF + (vs) * 64 * VSTR + (4 * hi + ((lane & 15) >> 2)) * VSTR + (16 * ((lane >> 4) & 1) + 4 * (lane & 3)) * 2; \
        _Pragma("unroll") for (int d = 0; d < ND; ++d) o[d] = __builtin_amdgcn_mfma_f32_32x32x16_bf16(__builtin_bit_cast(bf16x8, pw[0]), VFRAG(va, d), o[d], 0, 0, 0); \
        __builtin_amdgcn_sched_barrier(0); \
        _Pragma("unroll") for (int d = 0; d < ND; ++d) { va[d][0] = vtr(Vb + 32 * VSTR + d * 64); va[d][1] = vtr(Vb + 32 * VSTR + 8 * VSTR + d * 64); } \
        __builtin_amdgcn_sched_barrier(0); \
        _Pragma("unroll") for (int d = 0; d < ND; ++d) o[d] = __builtin_amdgcn_mfma_f32_32x32x16_bf16(__builtin_bit_cast(bf16x8, pw[1]), VFRAG(vb2, d), o[d], 0, 0, 0); \
        __builtin_amdgcn_sched_barrier(0); \
        _Pragma("unroll") for (int d = 0; d < ND; ++d) { vb2[d][0] = vtr(Vb + 48 * VSTR + d * 64); vb2[d][1] = vtr(Vb + 48 * VSTR + 8 * VSTR + d * 64); } \
        __builtin_amdgcn_sched_barrier(0); \
        _Pragma("unroll") for (int d = 0; d < ND; ++d) o[d] = __builtin_amdgcn_mfma_f32_32x32x16_bf16(__builtin_bit_cast(bf16x8, pw[2]), VFRAG(va, d), o[d], 0, 0, 0); \
        _Pragma("unroll") for (int d = 0; d < ND; ++d) o[d] = __builtin_amdgcn_mfma_f32_32x32x16_bf16(__builtin_bit_cast(bf16x8, pw[3]), VFRAG(vb2, d), o[d], 0, 0, 0); \
        __builtin_amdgcn_sched_barrier(0); } while (0)
        int first = 1; asm volatile("" : "+s"(first));
#define B_TILE(i_) ((i_) < 4 ? c0 + (i_) : ((i_) - 4 < c0 ? (i_) - 4 : (i_)))
        int t = B_TILE(0);
        int vs_prev = 2, vs_cur = 0, vs_next = 1;
        u32x4 pw[4];
        ATT_GLOAD(t); ATT_LSTORE(0, 0); __syncthreads();
        for (int i = 0; i < NT; ++i) {
            const int buf = i & 1;
            int tn = 0;
            if (i + 1 < NT) { tn = B_TILE(i + 1); ATT_GLOAD(tn); }
            f32x16 p0, p1;
            const int kb = 64 * t;
            float slope2 = slope2_, qposf = qposf_; asm volatile("" : "+v"(slope2), "+v"(qposf));
            const LAS unsigned char* Kb = lds + BK_OFF + buf * 64 * KSTR + r32 * KSTR + hi * 16;
            bf16x8 kf[8];
#pragma unroll
            for (int d0 = 0; d0 < 4; ++d0) { kf[d0] = *(const LAS bf16x8*)(Kb + d0 * 32); kf[4 + d0] = *(const LAS bf16x8*)(Kb + 32 * KSTR + d0 * 32); }
            const LAS unsigned char* Vb = lds + BV_OFF + vs_cur * 64 * VSTR + (4 * hi + ((lane & 15) >> 2)) * VSTR + (16 * ((lane >> 4) & 1) + 4 * (lane & 3)) * 2;
            s16x4 va[ND][2], vb2[ND][2];
            const bool offdiag = (kb + 63 < qw || kb > qw + 31);
            const float dq = (float)(kb + 4 * hi) - qposf;
#define QK_P0(INIT0, INIT1) do { \
            _Pragma("unroll") for (int r = 0; r < 16; ++r) { const float kv = (float)((r & 3) + 8 * (r >> 2)); p0[r] = INIT0; } \
            __builtin_amdgcn_sched_barrier(0); \
            _Pragma("unroll") for (int d0 = 0; d0 < 4; ++d0) { \
                p0 = __builtin_amdgcn_mfma_f32_32x32x16_bf16(kf[d0], qr[d0], p0, 0, 0, 0); \
                _Pragma("unroll") for (int r = 4 * d0; r < 4 * d0 + 4; ++r) { const float kv = (float)((r & 3) + 8 * (r >> 2) + 32); p1[r] = INIT1; } \
                __builtin_amdgcn_sched_barrier(0); } } while (0)
            if (offdiag) {
                const float sg = (kb > qw) ? -slope2 : slope2, b0 = sg * dq - mref;
                p0[0] = fmamk_t<0>(sg, b0); p0[1] = fmamk_t<1>(sg, b0); p0[2] = fmamk_t<2>(sg, b0); p0[3] = fmamk_t<3>(sg, b0); p0[4] = fmamk_t<8>(sg, b0); p0[5] = fmamk_t<9>(sg, b0); p0[6] = fmamk_t<10>(sg, b0); p0[7] = fmamk_t<11>(sg, b0); p0[8] = fmamk_t<16>(sg, b0); p0[9] = fmamk_t<17>(sg, b0); p0[10] = fmamk_t<18>(sg, b0); p0[11] = fmamk_t<19>(sg, b0); p0[12] = fmamk_t<24>(sg, b0); p0[13] = fmamk_t<25>(sg, b0); p0[14] = fmamk_t<26>(sg, b0); p0[15] = fmamk_t<27>(sg, b0);
                __builtin_amdgcn_sched_barrier(0);
                p0 = __builtin_amdgcn_mfma_f32_32x32x16_bf16(kf[0], qr[0], p0, 0, 0, 0); p1[0] = fmamk_t<32>(sg, b0); p1[1] = fmamk_t<33>(sg, b0); p1[2] = fmamk_t<34>(sg, b0); p1[3] = fmamk_t<35>(sg, b0); __builtin_amdgcn_sched_barrier(0);
                p0 = __builtin_amdgcn_mfma_f32_32x32x16_bf16(kf[1], qr[1], p0, 0, 0, 0); p1[4] = fmamk_t<40>(sg, b0); p1[5] = fmamk_t<41>(sg, b0); p1[6] = fmamk_t<42>(sg, b0); p1[7] = fmamk_t<43>(sg, b0); __builtin_amdgcn_sched_barrier(0);
                p0 = __builtin_amdgcn_mfma_f32_32x32x16_bf16(kf[2], qr[2], p0, 0, 0, 0); p1[8] = fmamk_t<48>(sg, b0); p1[9] = fmamk_t<49>(sg, b0); p1[10] = fmamk_t<50>(sg, b0); p1[11] = fmamk_t<51>(sg, b0); __builtin_amdgcn_sched_barrier(0);
                p0 = __builtin_amdgcn_mfma_f32_32x32x16_bf16(kf[3], qr[3], p0, 0, 0, 0); p1[12] = fmamk_t<56>(sg, b0); p1[13] = fmamk_t<57>(sg, b0); p1[14] = fmamk_t<58>(sg, b0); p1[15] = fmamk_t<59>(sg, b0); __builtin_amdgcn_sched_barrier(0);
            } else {
                const float nmref = -mref;
                QK_P0(__builtin_fmaf(-slope2, __builtin_fabsf(dq + kv), nmref), __builtin_fmaf(-slope2, __builtin_fabsf(dq + kv), nmref));
            }
#undef QK_P0
#pragma unroll
            for (int d = 0; d < ND; ++d) { va[d][0] = vtr(Vb + d * 64); va[d][1] = vtr(Vb + 8 * VSTR + d * 64); }
#pragma unroll
            for (int d = 0; d < ND; ++d) { vb2[d][0] = vtr(Vb + 16 * VSTR + d * 64); vb2[d][1] = vtr(Vb + 16 * VSTR + 8 * VSTR + d * 64); }
            __builtin_amdgcn_sched_barrier(0);
#pragma unroll
            for (int d0 = 0; d0 < 4; ++d0) p1 = __builtin_amdgcn_mfma_f32_32x32x16_bf16(kf[4 + d0], qr[d0], p1, 0, 0, 0);
            __builtin_amdgcn_sched_barrier(0);
            float rm, rmb;
            asm volatile("s_nop 15\n\ts_nop 7\n\tv_max3_f32 %0, %1, %2, %3\n\tv_max3_f32 %0, %0, %4, %5\n\tv_max3_f32 %0, %0, %6, %7\n\tv_max3_f32 %0, %0, %8, %9\n\t"
                         "v_max3_f32 %0, %0, %10, %11\n\tv_max3_f32 %0, %0, %12, %13\n\tv_max3_f32 %0, %0, %14, %15\n\tv_max3_f32 %0, %0, %16, %16"
                         : "=&v"(rm) : "v"(p0[0]), "v"(p0[1]), "v"(p0[2]), "v"(p0[3]), "v"(p0[4]), "v"(p0[5]), "v"(p0[6]), "v"(p0[7]), "v"(p0[8]), "v"(p0[9]), "v"(p0[10]), "v"(p0[11]), "v"(p0[12]), "v"(p0[13]), "v"(p0[14]), "v"(p0[15]));
            asm volatile("v_max3_f32 %0, %1, %2, %3\n\tv_max3_f32 %0, %0, %4, %5\n\tv_max3_f32 %0, %0, %6, %7\n\tv_max3_f32 %0, %0, %8, %9\n\t"
                         "v_max3_f32 %0, %0, %10, %11\n\tv_max3_f32 %0, %0, %12, %13\n\tv_max3_f32 %0, %0, %14, %15\n\tv_max3_f32 %0, %0, %16, %16"
                         : "=&v"(rmb) : "v"(p1[0]), "v"(p1[1]), "v"(p1[2]), "v"(p1[3]), "v"(p1[4]), "v"(p1[5]), "v"(p1[6]), "v"(p1[7]), "v"(p1[8]), "v"(p1[9]), "v"(p1[10]), "v"(p1[11]), "v"(p1[12]), "v"(p1[13]), "v"(p1[14]), "v"(p1[15]));
            rm = __builtin_fmaxf(rm, rmb);
            { auto rr_ = __builtin_amdgcn_permlane32_swap(__float_as_uint(rm), __float_as_uint(rm), false, false); rm = __builtin_fmaxf(__uint_as_float(rr_[0]), __uint_as_float(rr_[1])); }
            if (first || __any(rm > B_THR)) {
                const float delta = (first || rm > B_THR) ? rm : 0.f; const float f = __builtin_amdgcn_exp2f(-delta); mref += delta; l *= f;
#pragma unroll
                for (int r = 0; r < 16; ++r) { p0[r] -= delta; p1[r] -= delta; }
                {
                    if (hi == 0) wsf[r32] = f;
#pragma unroll
                    for (int r = 0; r < 16; ++r) { const float fr = wsf[crow(r, hi)];
#pragma unroll
                        for (int d = 0; d < ND; ++d) o[d][r] *= fr; }
                }
            }
            float ls0 = 0.f, ls1 = 0.f;
#pragma unroll
            for (int r = 0; r < 16; ++r) { p0[r] = __builtin_amdgcn_exp2f(p0[r]); ls0 += p0[r]; }
            pw[0].x = cvt_pk(p0[0], p0[1]); pw[0].y = cvt_pk(p0[2], p0[3]); pw[0].z = cvt_pk(p0[4], p0[5]); pw[0].w = cvt_pk(p0[6], p0[7]);
            pw[1].x = cvt_pk(p0[8], p0[9]); pw[1].y = cvt_pk(p0[10], p0[11]); pw[1].z = cvt_pk(p0[12], p0[13]); pw[1].w = cvt_pk(p0[14], p0[15]);
            __builtin_amdgcn_sched_barrier(0);
#define VFRAG(x, d) (bf16x8){x[d][0][0], x[d][0][1], x[d][0][2], x[d][0][3], x[d][1][0], x[d][1][1], x[d][1][2], x[d][1][3]}
#pragma unroll
            for (int d = 0; d < ND; ++d) {
                o[d] = __builtin_amdgcn_mfma_f32_32x32x16_bf16(__builtin_bit_cast(bf16x8, pw[0]), VFRAG(va, d), o[d], 0, 0, 0);
                p1[2 * d] = __builtin_amdgcn_exp2f(p1[2 * d]); p1[2 * d + 1] = __builtin_amdgcn_exp2f(p1[2 * d + 1]); ls1 += p1[2 * d]; ls0 += p1[2 * d + 1];
                __builtin_amdgcn_sched_barrier(0);
            }
#pragma unroll
            for (int d = 0; d < ND; ++d) { va[d][0] = vtr(Vb + 32 * VSTR + d * 64); va[d][1] = vtr(Vb + 32 * VSTR + 8 * VSTR + d * 64); }
            __builtin_amdgcn_sched_barrier(0);
#pragma unroll
            for (int d = 0; d < ND; ++d) {
                o[d] = __builtin_amdgcn_mfma_f32_32x32x16_bf16(__builtin_bit_cast(bf16x8, pw[1]), VFRAG(vb2, d), o[d], 0, 0, 0);
                p1[8 + 2 * d] = __builtin_amdgcn_exp2f(p1[8 + 2 * d]); p1[8 + 2 * d + 1] = __builtin_amdgcn_exp2f(p1[8 + 2 * d + 1]); ls1 += p1[8 + 2 * d]; ls0 += p1[8 + 2 * d + 1];
                __builtin_amdgcn_sched_barrier(0);
            }
#pragma unroll
            for (int d = 0; d < ND; ++d) { vb2[d][0] = vtr(Vb + 48 * VSTR + d * 64); vb2[d][1] = vtr(Vb + 48 * VSTR + 8 * VSTR + d * 64); }
            l += ls0 + ls1;
            pw[2].x = cvt_pk(p1[0], p1[1]); pw[2].y = cvt_pk(p1[2], p1[3]); pw[2].z = cvt_pk(p1[4], p1[5]); pw[2].w = cvt_pk(p1[6], p1[7]);
            __builtin_amdgcn_sched_barrier(0);
#pragma unroll
            for (int d = 0; d < ND; ++d) {
                o[d] = __builtin_amdgcn_mfma_f32_32x32x16_bf16(__builtin_bit_cast(bf16x8, pw[2]), VFRAG(va, d), o[d], 0, 0, 0);
                if (d == 0) { pw[3].x = cvt_pk(p1[8], p1[9]); pw[3].y = cvt_pk(p1[10], p1[11]); } else if (d == 1) { pw[3].z = cvt_pk(p1[12], p1[13]); pw[3].w = cvt_pk(p1[14], p1[15]); }
                __builtin_amdgcn_sched_barrier(0);
            }
#pragma unroll
            for (int d = 0; d < ND; ++d) o[d] = __builtin_amdgcn_mfma_f32_32x32x16_bf16(__builtin_bit_cast(bf16x8, pw[3]), VFRAG(vb2, d), o[d], 0, 0, 0);
#undef VFRAG
            __builtin_amdgcn_sched_barrier(0);
            first = 0;
            if (i + 1 < NT) ATT_LSTORE(buf ^ 1, vs_next);
            t = tn;
            { const int tmp_ = vs_prev; vs_prev = vs_cur; vs_cur = vs_next; vs_next = tmp_; }
            __syncthreads();
        }
#undef PV_LOAD01
#undef PV_MMA
#undef B_TILE
#undef VFRAG
#undef ATT_GLOAD
#undef ATT_LSTORE
        l += __shfl_xor(l, 32);
        if (hi == 0) wsf[r32] = 1.f / l;
        int lane_e = lane, qw_e = qw; asm volatile("" : "+v"(lane_e)); asm volatile("" : "+s"(qw_e));
        const int r32 = lane_e & 31, hi = lane_e >> 5, qw = qw_e;
        LAS unsigned* o0buf = (LAS unsigned*)(lds + ATT_O0_OFF) + wid * 2048 + lane_e;
        if (mp == 0) {
#pragma unroll
            for (int d = 0; d < ND; ++d)
#pragma unroll
                for (int r = 0; r < 16; r += 2) { const float i0 = wsf[crow(r, hi)], i1 = wsf[crow(r + 1, hi)]; o0buf[(d * 8 + (r >> 1)) * 64] = cvt_pk(o[d][r] * i0, o[d][r + 1] * i1); }
        } else {
            float gs[ND];
#pragma unroll
            for (int d = 0; d < ND; ++d) gs[d] = subln_l[d * 32 + r32] * postscale;
#pragma unroll
            for (int r = 0; r < 16; r += 2) {
                const float i0 = wsf[crow(r, hi)], i1 = wsf[crow(r + 1, hi)];
                float v0[ND], v1[ND]; float s0 = 0.f, s1 = 0.f;
#pragma unroll
                for (int d = 0; d < ND; ++d) { const unsigned w = o0buf[(d * 8 + (r >> 1)) * 64];
                    v0[d] = __builtin_bit_cast(float, w << 16) - lam * (o[d][r] * i0); v1[d] = __builtin_bit_cast(float, w & 0xffff0000u) - lam * (o[d][r + 1] * i1);
                    s0 += v0[d] * v0[d]; s1 += v1[d] * v1[d]; }
#pragma unroll
                for (int sh = 1; sh < 32; sh <<= 1) { s0 += __shfl_xor(s0, sh); s1 += __shfl_xor(s1, sh); }
                const float r0 = 1.f / sqrtf(s0 * (1.f / 128.f) + 1e-5f), r1 = 1.f / sqrtf(s1 * (1.f / 128.f) + 1e-5f);
                bf16_t* row0 = mix + (size_t)(qw + crow(r, hi)) * DM + r32; bf16_t* row1 = mix + (size_t)(qw + crow(r + 1, hi)) * DM + r32;
#pragma unroll
                for (int d = 0; d < ND; ++d) { row0[d * 32] = (bf16_t)f2bf(v0[d] * r0 * gs[d]); row1[d * 32] = (bf16_t)f2bf(v1[d] * r1 * gs[d]); }
            }
        }
        __syncthreads();
    }
}
__device__ __forceinline__ float alibi_slope(int i, int n) { return exp2f(-8.0f * (float)(i + 1) / (float)n); }
struct Ctx { int tid, lane, wave, G, cu, gw, NGW; };

__device__ __forceinline__ void ph_weights(const Args& a, LAS unsigned char* lds, int l, int gw0, int nw, int wave, int lane) {
    unsigned char* ws = a.ws;
    bf16_t* WinT = (bf16_t*)(ws + WS_WIN); bf16_t* WoutT = (bf16_t*)(ws + WS_WOUT); bf16_t* WupT = (bf16_t*)(ws + WS_WUP); bf16_t* WdnT = (bf16_t*)(ws + WS_WDN);
    const float* w_in = a.in[3]; const float* w_out = a.in[10]; const float* w_up = a.in[12]; const float* w_down = a.in[15];
    LAS float* scr = (LAS float*)(lds + wave * 16384);
    constexpr int I_IN = (DM / 64) * (DIN / 32), I_OUT = (DM / 64) * (DM / 32), I_UP = (DM / 64) * (DUP / 32), I_DN = (DFF / 64) * (DM / 32);
    constexpr int PER_L = I_IN + I_OUT + I_UP + I_DN;
    for (int it = gw0; it < PER_L; it += nw) {
        int r = it;
        if (r < I_IN) { transpose_item(w_in + (size_t)l * DM * DIN, DM, DIN, WinT + (size_t)l * DIN * DM, scr, r, lane, a.in[2] + l * DM); continue; } r -= I_IN;
        if (r < I_OUT) { transpose_item(w_out + (size_t)l * DM * DM, DM, DM, WoutT + (size_t)l * DM * DM, scr, r, lane, nullptr); continue; } r -= I_OUT;
        if (r < I_UP) { transpose_item(w_up + (size_t)l * DM * DUP, DM, DUP, WupT + (size_t)l * DUP * DM, scr, r, lane, a.in[11] + l * DM, true); continue; } r -= I_UP;
        transpose_item(w_down + (size_t)l * DFF * DM, DFF, DM, WdnT + (size_t)l * DM * DFF, scr, r, lane, nullptr);
    }
}
__device__ __forceinline__ const float* chunk_in(const Args& a, int ch) { return ch == 0 ? a.in[0] : a.in[1] + (size_t)(ch - 1) * CH_ROWS * DM; }
__device__ __forceinline__ float* chunk_out(const Args& a, int ch) { return a.out + (size_t)ch * CH_ROWS * DM; }

__device__ __forceinline__ void ph_norm_bf16(const Ctx& c, const float* xsrc, const float* gain, bf16_t* HB) {
    for (int r = c.gw; r < CH_ROWS; r += c.NGW) rms_row_to_bf16(xsrc + (size_t)r * DM, gain, HB + (size_t)r * DM, c.lane);
}
__device__ __forceinline__ void ph_final_norm(const Ctx& c, float* xo, const float* gain) {
    for (int r = c.gw; r < CH_ROWS; r += c.NGW) rms_row_f32(xo + (size_t)r * DM, gain, c.lane);
}

__device__ __forceinline__ void ph_attn(const Args& a, const Ctx& c, LAS unsigned char* lds, int ch, int layer) {
    const bf16_t* PROJ = (const bf16_t*)(a.ws + WS_PROJ); float* TMP = (float*)(a.ws + WS_TMP);
    const int SL = ch == 0 ? 16384 : 4096, sl_shift = ch == 0 ? 14 : 12;
    const int cu = c.cu, G = c.G;
#ifndef SKIP_B
    {
        const float lam_init = layer == 0 ? 0.2f : (0.8f - 0.6f * 0.7408182206817179f);
        const float s1 = wave_sum(a.in[5][layer * 64 + c.lane] * a.in[6][layer * 64 + c.lane]);
        const float s2 = wave_sum(a.in[7][layer * 64 + c.lane] * a.in[8][layer * 64 + c.lane]);
        const float lam = expf(s1) - expf(s2) + lam_init;
        bf16_t* HBm = (bf16_t*)(a.ws + WS_HB);
#ifdef PROBE_B2
        for (int rep_ = 0; rep_ < 2; ++rep_)
#endif
        for (int u = cu; u < 256; u += G) {
            int seq, h, qb; const int xcd = u & 7, idx = u >> 3;
            if (ch == 0) { seq = 0; h = xcd >> 1; qb = (xcd & 1) * 32 + idx; }
            else { const int pair = xcd * 2 + (idx >> 4); seq = pair >> 2; h = pair & 3; qb = idx & 15; }
            const size_t rb = (size_t)seq * SL;
            attn_b_unit(lds, PROJ + rb * DIN, h, qb * 256, SL, alibi_slope(h, 4) * LOG2E, lam, a.in[9] + layer * 128, 1.f - lam_init, HBm + rb * DM + 256 + h * 128);
        }
    }
#endif
#ifndef SKIP_AC
#ifdef PROBE_AC2
    for (int rep_ = 0; rep_ < 2; ++rep_)
#endif
    for (int uu = cu; uu < 1024; uu += G) {
        const bf16_t *qp, *kp, *vp; size_t pitch, opitch, lpitch; int q0, L, W; float slope2, m_init, l_init; float *op, *lp; bf16_t* obf;
        if (uu < 256) {
            const int hq = uu >> 6, blk = uu & 63;
            const int seq = (blk * 256) >> sl_shift, qb = blk - ((seq << sl_shift) >> 8);
            const size_t rb = (size_t)seq * SL; const bf16_t* base = PROJ + rb * DIN;
            qp = base + hq * 64; kp = base + 256 + (hq >> 1) * 64; vp = base + 384 + (hq >> 1) * 64; pitch = DIN; q0 = qb * 256; L = SL;
            slope2 = alibi_slope(hq, 4) * LOG2E; W = 128; m_init = a.in[4][layer * 4 + hq] * LOG2E; l_init = 1.f;
            op = nullptr; obf = (bf16_t*)(a.ws + WS_HB) + rb * DM + hq * 64; opitch = DM; lp = nullptr; lpitch = 0;
        } else {
            const int uc = uu - 256;
            const int gh = uc >> 6, blk = uc & 63, gq = gh >> 2;
            const int dsh = 2 * gq, d = 1 << dsh;
            const int seq = (blk * 256) >> sl_shift, b2 = blk - ((seq << sl_shift) >> 8);
            const int nbr = (SL >> dsh) >> 8;
            const int res = b2 / nbr, qb = b2 % nbr;
            const size_t rb = (size_t)seq * SL + res; const bf16_t* base = PROJ + rb * DIN;
            qp = base + 2048 + gh * 64; kp = base + 2816 + gh * 64; vp = base + 3584 + gh * 64; pitch = (size_t)DIN * d; q0 = qb * 256; L = SL >> dsh;
            slope2 = alibi_slope(gh, 12) * (float)d * LOG2E; W = 64; m_init = -1e30f; l_init = 0.f;
            op = TMP + rb * TW + T_C + gh * 64; obf = nullptr; opitch = (size_t)TW * d; lp = TMP + rb * TW + T_L + gh; lpitch = (size_t)TW * d;
        }
        attn_unit<64, true>(lds, qp, kp, vp, pitch, q0, L, slope2, W, m_init, l_init, op, opitch, lp, lpitch, obf);
    }
#endif
}

__device__ __forceinline__ void ph_combine(const Args& a, const Ctx& c, int layer) {
    const float* TMP = (const float*)(a.ws + WS_TMP); bf16_t* HB = (bf16_t*)(a.ws + WS_HB);
    { float* S2 = (float*)(a.ws + WS_SSQ) + 2 * CH_ROWS; for (int r = c.cu * NTHREADS + c.tid; r < CH_ROWS; r += c.G * NTHREADS) S2[r] = 0.f; }
    const int nitems = CH_ROWS * 32;
#pragma unroll 2
    for (int it = c.cu * NTHREADS + c.tid; it < nitems; it += c.G * NTHREADS) {
        const int r = it >> 5, h = (it >> 3) & 3, d8 = (it & 7) * 8;
        const float* tr = TMP + (size_t)r * TW;
        const float l0 = tr[T_L + h], l1 = tr[T_L + 4 + h], l2 = tr[T_L + 8 + h];
        const f32x4 a0 = *(const f32x4*)(tr + T_C + h * 64 + d8), a1 = *(const f32x4*)(tr + T_C + h * 64 + d8 + 4);
        const f32x4 b0 = *(const f32x4*)(tr + T_C + (4 + h) * 64 + d8), b1 = *(const f32x4*)(tr + T_C + (4 + h) * 64 + d8 + 4);
        const f32x4 c0 = *(const f32x4*)(tr + T_C + (8 + h) * 64 + d8), c1 = *(const f32x4*)(tr + T_C + (8 + h) * 64 + d8 + 4);
        const float mx = fmaxf(l0, fmaxf(l1, l2));
        float w0 = __expf(l0 - mx), w1 = __expf(l1 - mx), w2 = __expf(l2 - mx);
        const float inv = 1.f / (w0 + w1 + w2); w0 *= inv; w1 *= inv; w2 *= inv;
        const f32x4 o0 = a0 * w0 + b0 * w1 + c0 * w2, o1 = a1 * w0 + b1 * w1 + c1 * w2;
        u32x4 o; o.x = pk2(o0.x, o0.y); o.y = pk2(o0.z, o0.w); o.z = pk2(o1.x, o1.y); o.w = pk2(o1.z, o1.w);
        *(u32x4*)(HB + (size_t)r * DM + 768 + h * 64 + d8) = o;
    }
}

__device__ __forceinline__ void ph_conv(const Args& a, const Ctx& c, int ch, int layer) {
    const int par = ch & 1;
    const bf16_t* UB = (const bf16_t*)(a.ws + WS_PROJ); bf16_t* GB = (bf16_t*)(a.ws + WS_TMP);
    const int SL = ch == 0 ? 16384 : 4096;
    const float* cw = a.in[13] + (size_t)layer * 3 * DUP; const float* cb = a.in[14] + (size_t)layer * DUP;
    constexpr int NCG = DFF / 8, RB = 16;
    const int nitems = (CH_ROWS / RB) * NCG;
    { float* S1 = (float*)(a.ws + WS_SSQ) + par * CH_ROWS; for (int r = c.cu * NTHREADS + c.tid; r < CH_ROWS; r += c.G * NTHREADS) S1[r] = 0.f; }
    for (int it = c.cu * NTHREADS + c.tid; it < nitems; it += c.G * NTHREADS) {
        const int cg8 = it % NCG, rb = it / NCG, c0 = cg8 * 8, r0 = rb * RB;
        f32x4 wg[3][2], wv[3][2], bg[2], bv[2];
#pragma unroll
        for (int k = 0; k < 3; ++k)
#pragma unroll
            for (int j = 0; j < 2; ++j) { wg[k][j] = *(const f32x4*)(cw + k * DUP + c0 + 4 * j); wv[k][j] = *(const f32x4*)(cw + k * DUP + DFF + c0 + 4 * j); }
#pragma unroll
        for (int j = 0; j < 2; ++j) { bg[j] = *(const f32x4*)(cb + c0 + 4 * j); bv[j] = *(const f32x4*)(cb + DFF + c0 + 4 * j); }
        const bool first = (r0 & (SL - 1)) == 0, last = ((r0 + RB) & (SL - 1)) == 0;
        const u32x4 zero = (u32x4){0u, 0u, 0u, 0u};
        const bf16_t* up = UB + (size_t)r0 * DUP + c0;
        u32x4 pg_ = first ? zero : *(const u32x4*)(up - DUP), pv_ = first ? zero : *(const u32x4*)(up - DUP + DFF);
        u32x4 cg_ = *(const u32x4*)(up), cv_ = *(const u32x4*)(up + DFF);
        bf16_t* gp = GB + (size_t)r0 * DFF + c0;
#pragma unroll 4
        for (int rr = 0; rr < RB; ++rr) {
            const bool nz = (rr == RB - 1) && last;
            const u32x4 ng_ = nz ? zero : *(const u32x4*)(up + (size_t)(rr + 1) * DUP), nv_ = nz ? zero : *(const u32x4*)(up + (size_t)(rr + 1) * DUP + DFF);
            unsigned ow[4];
#pragma unroll
            for (int w = 0; w < 4; ++w) {
                float res[2];
#pragma unroll
                for (int hh = 0; hh < 2; ++hh) {
                    const int j = 2 * w + hh, q = j >> 2, e = j & 3;
                    const float gpv = hh ? __builtin_bit_cast(float, pg_[w] & 0xffff0000u) : __builtin_bit_cast(float, pg_[w] << 16);
                    const float gcv = hh ? __builtin_bit_cast(float, cg_[w] & 0xffff0000u) : __builtin_bit_cast(float, cg_[w] << 16);
                    const float gnv = hh ? __builtin_bit_cast(float, ng_[w] & 0xffff0000u) : __builtin_bit_cast(float, ng_[w] << 16);
                    const float vpv = hh ? __builtin_bit_cast(float, pv_[w] & 0xffff0000u) : __builtin_bit_cast(float, pv_[w] << 16);
                    const float vcv = hh ? __builtin_bit_cast(float, cv_[w] & 0xffff0000u) : __builtin_bit_cast(float, cv_[w] << 16);
                    const float vnv = hh ? __builtin_bit_cast(float, nv_[w] & 0xffff0000u) : __builtin_bit_cast(float, nv_[w] << 16);
                    const float gate = gpv * wg[0][q][e] + gcv * wg[1][q][e] + gnv * wg[2][q][e] + bg[q][e];
                    const float val = vpv * wv[0][q][e] + vcv * wv[1][q][e] + vnv * wv[2][q][e] + bv[q][e];
                    res[hh] = gate * __builtin_amdgcn_rcpf(1.f + __builtin_amdgcn_exp2f(-LOG2E * gate)) * val;
                }
                ow[w] = pk2(res[0], res[1]);
            }
            *(u32x4*)(gp + (size_t)rr * DFF) = (u32x4){ow[0], ow[1], ow[2], ow[3]};
            pg_ = cg_; pv_ = cv_; cg_ = ng_; cv_ = nv_;
        }
    }
}

constexpr int STEPS_PER_CHUNK = DEPTH * 6;
constexpr int NSTEPS = 1 + NCHUNK * STEPS_PER_CHUNK + 1;
__global__ void __launch_bounds__(NTHREADS, 2) mega_fwd(Args a) {
    extern __shared__ __attribute__((aligned(16))) unsigned char lds_raw[];
    LAS unsigned char* lds = (LAS unsigned char*)lds_raw;
    cg::grid_group grid = cg::this_grid();
    volatile LAS unsigned* bst = (volatile LAS unsigned*)(lds + 147456);
    if (threadIdx.x < 2) bst[threadIdx.x] = 0u;
    __syncthreads();
    XcdBarrier xbar = xcd_barrier_post((unsigned*)(a.ws + WS_CTL), bst);
#ifdef PROBE_P2
    for (int pass_ = 0; pass_ < 2; ++pass_)
#endif
    for (int step = 0; step < NSTEPS; ++step) {
        int tid_l = threadIdx.x, cu_l = blockIdx.x, G_l = gridDim.x;
        asm volatile("" : "+v"(tid_l)); asm volatile("" : "+s"(cu_l), "+s"(G_l));
        Ctx c; c.tid = tid_l; c.lane = c.tid & 63; c.wave = __builtin_amdgcn_readfirstlane(c.tid >> 6);
        c.G = G_l; c.cu = cu_l; c.gw = c.cu * 8 + c.wave; c.NGW = c.G * 8;
        unsigned char* ws = a.ws;
        if (step == 0) {
            ph_weights(a, lds, 0, c.gw, c.NGW, c.wave, c.lane); ph_weights(a, lds, 1, c.gw, c.NGW, c.wave, c.lane);
            const float* xin = chunk_in(a, 0); bf16_t* XB = (bf16_t*)(ws + WS_XB); float* S1 = (float*)(ws + WS_SSQ);
            for (int r = c.gw; r < CH_ROWS; r += c.NGW) row_to_bf16_ssq(xin + (size_t)r * DM, XB + (size_t)r * DM, S1 + r, c.lane);
        } else if (step == NSTEPS - 1) ph_final_norm(c, chunk_out(a, NCHUNK - 1), a.in[16]);
        else {
            const int s = step - 1, ch = s / STEPS_PER_CHUNK, sc = s % STEPS_PER_CHUNK, par = ch & 1;
            bf16_t* HB = (bf16_t*)(ws + WS_HB); bf16_t* XB = (bf16_t*)(ws + WS_XB) + (size_t)par * CH_ROWS * DM;
            float* S1 = (float*)(ws + WS_SSQ) + par * CH_ROWS; float* S2 = (float*)(ws + WS_SSQ) + 2 * CH_ROWS;
            float* xo = chunk_out(a, ch);
            {
                const int layer = sc / 6, ph = sc % 6;
                const float* xsrc = layer == 0 ? chunk_in(a, ch) : (const float*)xo;
                if (ph == 0) {
                    pg8::Gemm g{XB, (const bf16_t*)(ws + WS_WIN) + (size_t)layer * DIN * DM, CH_ROWS, DIN, DM}; pg8::StaticOrder S; S.init(CH_ROWS, DIN, c.G, c.cu);
                    pg8::EpiBf16S2 E{(bf16_t*)(ws + WS_PROJ), DIN, 1805u, QSCALE, S1};
#ifdef PROBE_G2
                    for (int rep_ = 0; rep_ < 2; ++rep_)
#endif
                    pg8::gemm_phase<pg8::EpiBf16S2, pg8::StaticOrder, true, true>(lds, g, S, E);
                    if (layer == 0 && ch > 0) {
                        const int nfull = (CH_ROWS / 256) * (DIN / 256) % c.G;
                        if (nfull > 0 && c.cu >= nfull) { float* xp = chunk_out(a, ch - 1); const int nw = (c.G - nfull) * 8;
                            for (int r = (c.cu - nfull) * 8 + c.wave; r < CH_ROWS; r += nw) rms_row_f32(xp + (size_t)r * DM, a.in[16], c.lane); }
                        else if (nfull == 0) ph_final_norm(c, chunk_out(a, ch - 1), a.in[16]);
                    }
                } else if (ph == 1) {
                    ph_attn(a, c, lds, ch, layer);
                } else if (ph == 2) {
                    ph_combine(a, c, layer);
                } else if (ph == 3) {
                    pg8::Gemm g{HB, (const bf16_t*)(ws + WS_WOUT) + (size_t)layer * DM * DM, CH_ROWS, DM, DM}; pg8::StaticOrder S; S.init(CH_ROWS, DM, c.G, c.cu);
                    pg8::EpiRes2 E{xsrc, xo, XB, S2, DM};
#ifdef PROBE_GE2
                    { pg8::EpiRes2 E0{xsrc, (float*)(ws + WS_PROJ), (bf16_t*)(ws + WS_PROJ + 72 * MiB), (float*)(ws + WS_PROJ + 110 * MiB), DM}; pg8::gemm_phase<pg8::EpiRes2, pg8::StaticOrder, true, true>(lds, g, S, E0); }
#endif
                    pg8::gemm_phase<pg8::EpiRes2, pg8::StaticOrder, true, true>(lds, g, S, E);
                } else if (ph == 4) {
                    pg8::Gemm g{XB - DM, (const bf16_t*)(ws + WS_WUP) + (size_t)layer * DUP * DM, 65 * 256, DUP, DM, 254}; pg8::StaticOrder S; S.init(65 * 256, DUP, c.G, c.cu);
                    pg8::EpiConv E{(bf16_t*)(ws + WS_TMP), S2, a.in[13] + (size_t)layer * 3 * DUP, a.in[14] + (size_t)layer * DUP, (ch == 0 ? 16384 : 4096) - 1, (LAS float*)(lds + 147456 + 256), CH_ROWS};
                    pg8::gemm_phase<pg8::EpiConv, pg8::StaticOrder, true, true>(lds, g, S, E);
                    { float* S1z = S1; for (int r = c.cu * NTHREADS + c.tid; r < CH_ROWS; r += c.G * NTHREADS) S1z[r] = 0.f; }
                    if (layer == DEPTH - 1 && ch + 1 < NCHUNK) {
                        const float* xin = chunk_in(a, ch + 1); bf16_t* XBn = (bf16_t*)(ws + WS_XB) + (size_t)(par ^ 1) * CH_ROWS * DM; float* S1n = (float*)(ws + WS_SSQ) + (par ^ 1) * CH_ROWS;
                        for (int r = c.gw; r < CH_ROWS; r += c.NGW) row_to_bf16_ssq(xin + (size_t)r * DM, XBn + (size_t)r * DM, S1n + r, c.lane);
                    }
                } else {
                    pg8::Gemm g{(const bf16_t*)(ws + WS_TMP), (const bf16_t*)(ws + WS_WDN) + (size_t)layer * DM * DFF, CH_ROWS, DM, DFF}; pg8::StaticOrder S; S.init(CH_ROWS, DM, c.G, c.cu);
                    pg8::EpiRes2 E{xo, xo, XB, S1, DM};
#ifdef PROBE_GE2
                    { pg8::EpiRes2 E0{xo, (float*)(ws + WS_PROJ), (bf16_t*)(ws + WS_PROJ + 72 * MiB), (float*)(ws + WS_PROJ + 110 * MiB), DM}; pg8::gemm_phase<pg8::EpiRes2, pg8::StaticOrder, true, true>(lds, g, S, E0); }
#endif
                    pg8::gemm_phase<pg8::EpiRes2, pg8::StaticOrder, true, true>(lds, g, S, E);
                }
            }
        }
#ifdef PROBE_P2
        if (step == 0) grid.sync(); else xcd_barrier(xbar);
#else
        if (step == 0) grid.sync(); else if (step != NSTEPS - 1) xcd_barrier(xbar);
#endif
    }
#ifdef PROBE_TA
    if (blockIdx.x == 0 && threadIdx.x < 64) {
        float* xo = chunk_out(a, NCHUNK - 1);
        const float ua = (float)tA_ * 0.01f, ub = (float)tB_ * 0.01f;
        if (threadIdx.x == 0) xo[0] += 8.f + ua * 0.01f; else xo[4 * threadIdx.x] += sqrtf(ub * 0.01f);
    }
#endif
}

extern "C" void kernel_launch(void* const* d_in, const int* in_sizes, int n_in, void* d_out, int out_size, void* d_ws, size_t ws_size, hipStream_t stream) {
    static int grid = 0;
    if (grid == 0) {
        if (n_in != 17 || ws_size < WS_END) { fprintf(stderr, "kernel_launch: unexpected n_in %d / ws_size %zu (need %zu)\n", n_in, ws_size, (size_t)WS_END); grid = -1; return; }
        int dev = 0, cus = 0, per_cu = 0;
        (void)hipGetDevice(&dev); (void)hipDeviceGetAttribute(&cus, hipDeviceAttributeMultiprocessorCount, dev);
        if (hipFuncSetAttribute((const void*)mega_fwd, hipFuncAttributeMaxDynamicSharedMemorySize, LDS_BYTES) != hipSuccess) { fprintf(stderr, "hipFuncSetAttribute failed\n"); grid = -1; return; }
        if (hipOccupancyMaxActiveBlocksPerMultiprocessor(&per_cu, (const void*)mega_fwd, NTHREADS, LDS_BYTES) != hipSuccess || per_cu < 1) { fprintf(stderr, "occupancy query: %d\n", per_cu); per_cu = 1; }
        (void)hipGetLastError();
        grid = cus * 1;
    }
    if (grid < 0) return;
    (void)hipMemsetAsync((char*)d_ws + WS_CTL, 0, 65536, stream);
    Args a{};
    for (int i = 0; i < 17; ++i) a.in[i] = (const float*)d_in[i];
    a.out = (float*)d_out; a.ws = (unsigned char*)d_ws;
    void* args[] = {&a};
    hipError_t e = hipLaunchCooperativeKernel((const void*)mega_fwd, dim3(grid), dim3(NTHREADS), args, LDS_BYTES, stream);
    if (e != hipSuccess) fprintf(stderr, "cooperative launch failed: %s (grid %d)\n", hipGetErrorString(e), grid);
}
```

```cpp
#include <hip/hip_runtime.h>
#include <hip/hip_cooperative_groups.h>
#include <cstdio>
#include <cstdint>
#include <cmath>
namespace cg = cooperative_groups;
namespace pg8 {
#define PG8_LAS __attribute__((address_space(3)))
typedef unsigned short bf16_t;
typedef short bf16x8 __attribute__((ext_vector_type(8)));
typedef float f32x4 __attribute__((ext_vector_type(4)));
typedef unsigned u32x4 __attribute__((ext_vector_type(4)));
constexpr int BM = 256, BK = 64, HALF = 128, HTB = HALF * BK * 2  , STAGE_BYTES = 8 * HTB, NXCD = 8, WGM = 8;

__host__ __device__ __forceinline__ int lds_byte(int r, int c) { const int st = (r >> 4) * 2 + (c >> 5), rr = r & 15, cc = c & 31, ob = rr * 64 + cc * 2; return st * 1024 + (ob ^ (((ob >> 9) & 1) << 5)); }
__host__ __device__ __forceinline__ void stage_rc(int b, int& R, int& C) { const int st = b / 1024, sb = b % 1024, swz = sb ^ (((sb >> 9) & 1) << 5); R = (st >> 1) * 16 + swz / 64; C = (st & 1) * 32 + (swz % 64) / 2; }
__host__ __device__ __forceinline__ int perm32(int rho) { const int n = rho >> 4, i = rho & 15; return 8 * (i >> 2) + 4 * n + (i & 3); }

struct Unit { int pm, pn; };
struct Gemm { const bf16_t* A; const bf16_t* Bt; int M, N, K; int a_rows = 256; };

struct StaticOrder {
    int nM, nN, nwg, G, c;
    __host__ __device__ void init(int M, int N, int G_, int c_) { nM = M / BM; nN = N / BM; nwg = nM * nN; G = G_; c = c_; }
    __host__ __device__ bool next(int i, Unit& u) const {
        const long L = (long)i * G + c; if (L >= nwg) return false;
        int wgid = (int)L; { const int q = nwg / NXCD, r = nwg % NXCD, xcd = wgid % NXCD, off = wgid / NXCD; wgid = (xcd < r ? xcd * (q + 1) : r * (q + 1) + (xcd - r) * q) + off; }
        const int nig = WGM * nN, gid = wgid / nig, fm = gid * WGM, gsz = (nM - fm) < WGM ? (nM - fm) : WGM;
        u.pm = fm + ((wgid % nig) % gsz); u.pn = (wgid % nig) / gsz; return true;
    }
    __device__ __forceinline__ void a_ready(const Unit&) const {}
    __device__ __forceinline__ void done(const Unit&) const {}
};

__device__ __forceinline__ unsigned cvt_pk_bf16(float lo, float hi) { unsigned r; asm volatile("v_cvt_pk_bf16_f32 %0, %1, %2" : "=v"(r) : "v"(lo), "v"(hi)); return r; }
struct EpiBf16S {
    static constexpr bool PERM = true, AFTER_DRAIN = false;
    bf16_t* O; int ldc; unsigned scalemask; float sc;
    __device__ __forceinline__ void operator()(const f32x4 (&acc)[2][2][4][2], const Unit& u, int wr, int wc, int fr, int fq) const {
        const int row0 = u.pm * BM + wr * 64 + fr; const int col0 = u.pn * BM + wc * 32 + 8 * fq;
        const float s = ((scalemask >> u.pn) & 1u) ? sc : 1.f;
#pragma unroll
        for (int ai = 0; ai < 2; ++ai)
#pragma unroll
            for (int m = 0; m < 4; ++m) { bf16_t* rowp = O + (size_t)(row0 + ai * HALF + m * 16) * ldc + col0;
#pragma unroll
                for (int bj = 0; bj < 2; ++bj) { f32x4 v0 = acc[ai][bj][m][0] * s, v1 = acc[ai][bj][m][1] * s;
                    u32x4 w; w.x = cvt_pk_bf16(v0[0], v0[1]); w.y = cvt_pk_bf16(v0[2], v0[3]); w.z = cvt_pk_bf16(v1[0], v1[1]); w.w = cvt_pk_bf16(v1[2], v1[3]);
                    *(u32x4*)(rowp + bj * HALF) = w; } }
    }
};
struct EpiRes {
    static constexpr bool PERM = false, AFTER_DRAIN = false;
    const float* base; float* out; int ldc;
    __device__ __forceinline__ void operator()(const f32x4 (&acc)[2][2][4][2], const Unit& u, int wr, int wc, int fr, int fq) const {
        const int col0 = u.pn * BM + wc * 32 + 4 * fq;
#pragma unroll
        for (int ai = 0; ai < 2; ++ai)
#pragma unroll
            for (int m = 0; m < 4; ++m) { const size_t off = (size_t)(u.pm * BM + ai * HALF + wr * 64 + m * 16 + fr) * ldc + col0;
#pragma unroll
                for (int bj = 0; bj < 2; ++bj)
#pragma unroll
                    for (int n = 0; n < 2; ++n) { const f32x4 bs = *(const f32x4*)(base + off + bj * HALF + n * 16); *(f32x4*)(out + off + bj * HALF + n * 16) = bs + acc[ai][bj][m][n]; }
                asm volatile("" ::: "memory"); }
    }
};

struct EpiBf16S2 {
    static constexpr bool PERM = true, AFTER_DRAIN = false;
    bf16_t* O; int ldc; unsigned scalemask; float sc; const float* ssq;
    __device__ __forceinline__ void operator()(const f32x4 (&acc)[2][2][4][2], const Unit& u, int wr, int wc, int fr, int fq) const {
        const int row0 = u.pm * BM + wr * 64 + fr; const int col0 = u.pn * BM + wc * 32 + 8 * fq;
        const float s = ((scalemask >> u.pn) & 1u) ? sc : 1.f;
#pragma unroll
        for (int ai = 0; ai < 2; ++ai)
#pragma unroll
            for (int m = 0; m < 4; ++m) { const int row = row0 + ai * HALF + m * 16; bf16_t* rowp = O + (size_t)row * ldc + col0;
                const float rs = s / sqrtf(ssq[row] * (1.f / 1024.f) + 1e-6f);
#pragma unroll
                for (int bj = 0; bj < 2; ++bj) { f32x4 v0 = acc[ai][bj][m][0] * rs, v1 = acc[ai][bj][m][1] * rs;
                    u32x4 w; w.x = cvt_pk_bf16(v0[0], v0[1]); w.y = cvt_pk_bf16(v0[2], v0[3]); w.z = cvt_pk_bf16(v1[0], v1[1]); w.w = cvt_pk_bf16(v1[2], v1[3]);
                    *(u32x4*)(rowp + bj * HALF) = w; } }
    }
};
typedef unsigned u32x2e __attribute__((ext_vector_type(2)));
struct EpiRes2 {
    static constexpr bool PERM = true, AFTER_DRAIN = false;
    const float* base; float* out; bf16_t* xb; float* ssq; int ldc;
    __device__ __forceinline__ void operator()(const f32x4 (&acc)[2][2][4][2], const Unit& u, int wr, int wc, int fr, int fq) const {
        const int col0 = u.pn * BM + wc * 32 + 8 * fq;
#pragma unroll
        for (int ai = 0; ai < 2; ++ai)
#pragma unroll
            for (int m = 0; m < 4; ++m) { const int row = u.pm * BM + ai * HALF + wr * 64 + m * 16 + fr; const size_t off = (size_t)row * ldc + col0; float ps = 0.f;
#pragma unroll
                for (int bj = 0; bj < 2; ++bj) {
                    const f32x4 b0 = *(const f32x4*)(base + off + bj * HALF), b1 = *(const f32x4*)(base + off + bj * HALF + 4);
                    const f32x4 v0 = b0 + acc[ai][bj][m][0], v1 = b1 + acc[ai][bj][m][1];
                    *(f32x4*)(out + off + bj * HALF) = v0; *(f32x4*)(out + off + bj * HALF + 4) = v1;
                    if (xb != nullptr) { ps += ((v0[0] * v0[0] + v0[1] * v0[1]) + (v0[2] * v0[2] + v0[3] * v0[3])) + ((v1[0] * v1[0] + v1[1] * v1[1]) + (v1[2] * v1[2] + v1[3] * v1[3]));
                        u32x4 w; w.x = cvt_pk_bf16(v0[0], v0[1]); w.y = cvt_pk_bf16(v0[2], v0[3]); w.z = cvt_pk_bf16(v1[0], v1[1]); w.w = cvt_pk_bf16(v1[2], v1[3]); *(u32x4*)(xb + off + bj * HALF) = w; } }
                if (xb != nullptr) { ps += __shfl_xor(ps, 16); ps += __shfl_xor(ps, 32);
                    if (fq == 0) atomicAdd(ssq + row, ps); }
                asm volatile("" ::: "memory"); }
    }
};

struct EpiNull {
    static constexpr bool PERM = false, AFTER_DRAIN = false;
    __device__ __forceinline__ void operator()(const f32x4 (&acc)[2][2][4][2], const Unit& u, int wr, int wc, int fr, int fq) const {
#pragma unroll
        for (int ai = 0; ai < 2; ++ai)
#pragma unroll
            for (int bj = 0; bj < 2; ++bj)
#pragma unroll
                for (int m = 0; m < 4; ++m)
#pragma unroll
                    for (int n = 0; n < 2; ++n) asm volatile("" :: "v"(acc[ai][bj][m][n]));
    }
};

#define PG8_DPP(old, src, ctrl) __builtin_bit_cast(float, __builtin_amdgcn_update_dpp(__builtin_bit_cast(int, (float)(old)), __builtin_bit_cast(int, (float)(src)), (ctrl), 0xF, 0xF, false))
struct EpiConv {
    static constexpr bool PERM = true, AFTER_DRAIN = false;
    bf16_t* G; const float* ssq; const float* cw; const float* cb; int slmask; PG8_LAS float* xch; int nrows;
    __device__ __forceinline__ void operator()(f32x4 (&acc)[2][2][4][2], const Unit& u, int wr, int wc, int fr, int fq) const {
        const int t0 = 254 * u.pm - 1 + wr * 64 + fr;
#pragma unroll
        for (int ai = 0; ai < 2; ++ai)
#pragma unroll
            for (int m = 0; m < 4; ++m) { int t = t0 + ai * HALF + m * 16; t = t < 0 ? 0 : (t > nrows - 1 ? nrows - 1 : t);
                const float rs = 1.f / sqrtf(ssq[t] * (1.f / 1024.f) + 1e-6f);
#pragma unroll
                for (int bj = 0; bj < 2; ++bj)
#pragma unroll
                    for (int n = 0; n < 2; ++n) acc[ai][bj][m][n] *= rs; }
        if (fr == 0 || fr == 15) { const int which = fr == 0 ? 0 : 1, m = fr == 0 ? 0 : 3;
#pragma unroll
            for (int ai = 0; ai < 2; ++ai) { PG8_LAS float* d = xch + ((((2 * ai + wr) * 2 + which) * 4 + wc) * 4 + fq) * 16;
#pragma unroll
                for (int bj = 0; bj < 2; ++bj)
#pragma unroll
                    for (int n = 0; n < 2; ++n) *(PG8_LAS f32x4*)(d + bj * 8 + n * 4) = fr == 0 ? acc[ai][bj][0][n] : acc[ai][bj][3][n]; }
            (void)m; }
        asm volatile("s_waitcnt lgkmcnt(0)" ::: "memory"); __builtin_amdgcn_s_barrier(); asm volatile("" ::: "memory");
        const int ch0 = u.pn * 128 + wc * 32 + 8 * fq;
#pragma unroll
        for (int n = 0; n < 2; ++n) {
            const int chn = ch0 + 4 * n;
            const f32x4 wg0 = *(const f32x4*)(cw + chn), wg1 = *(const f32x4*)(cw + 5632 + chn), wg2 = *(const f32x4*)(cw + 2 * 5632 + chn), bgv = *(const f32x4*)(cb + chn);
            const f32x4 wv0 = *(const f32x4*)(cw + 2816 + chn), wv1 = *(const f32x4*)(cw + 5632 + 2816 + chn), wv2 = *(const f32x4*)(cw + 2 * 5632 + 2816 + chn), bvv = *(const f32x4*)(cb + 2816 + chn);
#pragma unroll
            for (int ai = 0; ai < 2; ++ai)
#pragma unroll
                for (int m = 0; m < 4; ++m) {
                    const int lr = ai * HALF + wr * 64 + m * 16 + fr, t = 254 * u.pm - 1 + lr;
                    const int gidx = 2 * ai + wr;
                    f32x4 pv[2], nx[2];
#pragma unroll
                    for (int bj = 0; bj < 2; ++bj) {
                        f32x4 upo, dno;
                        if (m > 0) { const f32x4 s = acc[ai][bj][m - 1][n];
#pragma unroll
                            for (int j = 0; j < 4; ++j) upo[j] = PG8_DPP(0.f, s[j], 0x121); }
                        else upo = gidx > 0 ? *(const PG8_LAS f32x4*)(xch + ((((gidx - 1) * 2 + 1) * 4 + wc) * 4 + fq) * 16 + bj * 8 + n * 4) : (f32x4){0.f, 0.f, 0.f, 0.f};
                        if (m < 3) { const f32x4 s = acc[ai][bj][m + 1][n];
#pragma unroll
                            for (int j = 0; j < 4; ++j) dno[j] = PG8_DPP(0.f, s[j], 0x12F); }
                        else dno = gidx < 3 ? *(const PG8_LAS f32x4*)(xch + ((((gidx + 1) * 2 + 0) * 4 + wc) * 4 + fq) * 16 + bj * 8 + n * 4) : (f32x4){0.f, 0.f, 0.f, 0.f};
                        const f32x4 cur = acc[ai][bj][m][n];
#pragma unroll
                        for (int j = 0; j < 4; ++j) { pv[bj][j] = PG8_DPP(upo[j], cur[j], 0x111);
                                                       nx[bj][j] = PG8_DPP(dno[j], cur[j], 0x101); }
                    }
                    const bool sfirst = (t & slmask) == 0, slast = (t & slmask) == slmask;
                    float res[4];
#pragma unroll
                    for (int j = 0; j < 4; ++j) {
                        const float gp = sfirst ? 0.f : pv[0][j], gn = slast ? 0.f : nx[0][j], vp = sfirst ? 0.f : pv[1][j], vn = slast ? 0.f : nx[1][j];
                        const float gate = gp * wg0[j] + acc[ai][0][m][n][j] * wg1[j] + gn * wg2[j] + bgv[j];
                        const float val = vp * wv0[j] + acc[ai][1][m][n][j] * wv1[j] + vn * wv2[j] + bvv[j];
                        res[j] = gate * __builtin_amdgcn_rcpf(1.f + __builtin_amdgcn_exp2f(-1.4426950408889634f * gate)) * val;
                    }
                    if (lr >= 1 && lr <= 254 && t < nrows) { u32x2e w; w.x = cvt_pk_bf16(res[0], res[1]); w.y = cvt_pk_bf16(res[2], res[3]); *(u32x2e*)(G + (size_t)t * 2816 + chn) = w; }
                }
        }
    }
};
template <class Epi, class Sched, bool ALIGN_EPI = false, bool SP2 = false>
__device__ __forceinline__ void gemm_phase(PG8_LAS unsigned char* lds, const Gemm g, const Sched& S, const Epi& E) {
    int tid_l = threadIdx.x; asm volatile("" : "+v"(tid_l)); const int tid = tid_l, wid = __builtin_amdgcn_readfirstlane(tid >> 6), lane = tid & 63, wr = wid >> 2, wc = wid & 3, fr = lane & 15, fq = lane >> 4;
    const int K = g.K, nt = K / BK;
    unsigned voffA[2], voffB[2];
#pragma unroll
    for (int i = 0; i < 2; ++i) { int R, C; stage_rc(tid * 16 + i * 8192, R, C); const int Rb = Epi::PERM ? ((R & ~31) + perm32(R & 31)) : R;
        voffA[i] = (unsigned)(R * K + C) * 2u; voffB[i] = (unsigned)(Rb * K + C) * 2u; }
    const size_t kstep = (size_t)(BK * 2);
    const size_t hstep = (size_t)HALF * K * 2;
    const size_t tstep = 2 * hstep; const size_t tstepA = (size_t)g.a_rows * K * 2;
    const unsigned ldsw = (unsigned)wid * 1024u;
    const int aoff = lds_byte(wr * 64 + fr, fq * 8), boff = lds_byte(wc * 32 + fr, fq * 8);
#define PG8_SA(b, h) (((b) * 2 + (h)) * HTB)
#define PG8_SB(b, h) ((4 + (b) * 2 + (h)) * HTB)
#define PG8_STAGE(bufoff, gbase, voff) do { _Pragma("unroll") for (int _i = 0; _i < 2; ++_i) \
        __builtin_amdgcn_global_load_lds((const unsigned*)((const char*)(gbase) + (voff)[_i]), (PG8_LAS unsigned*)(lds + (bufoff) + ldsw + _i * 8192), 16, 0, 0); } while (0)
#define PG8_LDA(dst, b, h) do { _Pragma("unroll") for (int m = 0; m < 4; ++m) _Pragma("unroll") for (int k = 0; k < 2; ++k) dst[m][k] = *(const PG8_LAS bf16x8*)(lds + PG8_SA(b, h) + aoff + m * 2048 + k * 1024); } while (0)
#define PG8_LDB(dst, b, h) do { _Pragma("unroll") for (int n = 0; n < 2; ++n) _Pragma("unroll") for (int k = 0; k < 2; ++k) dst[n][k] = *(const PG8_LAS bf16x8*)(lds + PG8_SB(b, h) + boff + n * 2048 + k * 1024); } while (0)
#define PG8_MMA(ai, bj, At, Bt) do { __builtin_amdgcn_s_setprio(1); _Pragma("unroll") for (int m = 0; m < 4; ++m) _Pragma("unroll") for (int n = 0; n < 2; ++n) _Pragma("unroll") for (int k = 0; k < 2; ++k) \
        acc[ai][bj][m][n] = __builtin_amdgcn_mfma_f32_16x16x32_bf16(Bt[n][k], At[m][k], acc[ai][bj][m][n], 0, 0, 0); __builtin_amdgcn_s_setprio(0); } while (0)
#define PG8_WAIT_V(n) asm volatile("s_waitcnt vmcnt(" #n ")" ::: "memory")
#define PG8_WAIT_L(n) asm volatile("s_waitcnt lgkmcnt(" #n ")" ::: "memory")
#define PG8_BAR __builtin_amdgcn_s_barrier()
#define PG8_SCHED __builtin_amdgcn_sched_barrier(0)
    Unit cur, nxt; int ui = 0;
    if (!S.next(0, cur)) return;
    f32x4 acc[2][2][4][2];
#pragma unroll
    for (int a = 0; a < 2; ++a)
#pragma unroll
        for (int b = 0; b < 2; ++b)
#pragma unroll
            for (int m = 0; m < 4; ++m)
#pragma unroll
                for (int n = 0; n < 2; ++n) acc[a][b][m][n] = (f32x4){0.f, 0.f, 0.f, 0.f};
    bf16x8 At[4][2], B0[2][2], B1[2][2];
    const char* cA = (const char*)g.A + (size_t)cur.pm * tstepA; const char* cB = (const char*)g.Bt + (size_t)cur.pn * tstep;
    S.a_ready(cur);
    if constexpr (SP2) {
        PG8_STAGE(PG8_SB(0, 0), cB, voffB); PG8_STAGE(PG8_SB(0, 1), cB + hstep, voffB); PG8_STAGE(PG8_SA(0, 0), cA, voffA); PG8_STAGE(PG8_SA(0, 1), cA + hstep, voffA);
        if (wr == 1) PG8_BAR;
        PG8_WAIT_V(2); PG8_BAR;
        PG8_STAGE(PG8_SB(1, 0), cB + kstep, voffB); PG8_STAGE(PG8_SA(1, 0), cA + kstep, voffA); PG8_STAGE(PG8_SB(1, 1), cB + hstep + kstep, voffB);
        PG8_WAIT_V(6); PG8_BAR;
    } else {
        PG8_STAGE(PG8_SB(0, 0), cB, voffB); PG8_STAGE(PG8_SA(0, 0), cA, voffA); PG8_STAGE(PG8_SB(0, 1), cB + hstep, voffB); PG8_STAGE(PG8_SA(0, 1), cA + hstep, voffA);
        if (wr == 1) PG8_BAR;
        PG8_WAIT_V(4); PG8_BAR;
        PG8_STAGE(PG8_SB(1, 0), cB + kstep, voffB); PG8_STAGE(PG8_SA(1, 0), cA + kstep, voffA); PG8_STAGE(PG8_SB(1, 1), cB + hstep + kstep, voffB);
        PG8_WAIT_V(6); PG8_BAR;
    }
    for (;;) {
        const bool has_next = S.next(ui + 1, nxt);
        const char* nA = has_next ? (const char*)g.A + (size_t)nxt.pm * tstepA : cA; const char* nB = has_next ? (const char*)g.Bt + (size_t)nxt.pn * tstep : cB;
        for (int t = 0; t < nt; t += 2) {
            const bool last = (t == nt - 2);
            const char* a1 = cA + (size_t)(t + 1) * kstep;
            const char* a2 = last ? nA : cA + (size_t)(t + 2) * kstep; const char* b2 = last ? nB : cB + (size_t)(t + 2) * kstep;
            const char* a3 = a2 + kstep; const char* b3 = b2 + kstep;
            if (last && has_next) S.a_ready(nxt);
            if constexpr (SP2) {
            PG8_LDB(B0, 0, 0); PG8_LDB(B1, 0, 1); PG8_SCHED; PG8_LDA(At, 0, 0); PG8_STAGE(PG8_SA(1, 1), a1 + hstep, voffA);
            PG8_WAIT_V(8); PG8_WAIT_L(0); PG8_BAR; PG8_MMA(0, 0, At, B0); PG8_MMA(0, 1, At, B1); PG8_BAR; PG8_SCHED;
            PG8_LDA(At, 0, 1); PG8_STAGE(PG8_SB(0, 0), b2, voffB); PG8_STAGE(PG8_SB(0, 1), b2 + hstep, voffB); PG8_STAGE(PG8_SA(0, 0), a2, voffA);
            PG8_WAIT_V(8); PG8_WAIT_L(0); PG8_BAR; PG8_MMA(1, 0, At, B0); PG8_MMA(1, 1, At, B1); PG8_BAR; PG8_SCHED;
            PG8_LDB(B0, 1, 0); PG8_LDB(B1, 1, 1); PG8_SCHED; PG8_LDA(At, 1, 0); PG8_STAGE(PG8_SA(0, 1), a2 + hstep, voffA);
            PG8_WAIT_V(8); PG8_WAIT_L(0); PG8_BAR; PG8_MMA(0, 0, At, B0); PG8_MMA(0, 1, At, B1); PG8_BAR; PG8_SCHED;
            PG8_LDA(At, 1, 1); PG8_STAGE(PG8_SB(1, 0), b3, voffB); PG8_STAGE(PG8_SB(1, 1), b3 + hstep, voffB); PG8_STAGE(PG8_SA(1, 0), a3, voffA);
            PG8_WAIT_V(8); PG8_WAIT_L(0); PG8_BAR; PG8_MMA(1, 0, At, B0); PG8_MMA(1, 1, At, B1); PG8_BAR; PG8_SCHED;
            } else {
            PG8_LDB(B0, 0, 0); PG8_SCHED; PG8_LDA(At, 0, 0); PG8_STAGE(PG8_SA(1, 1), a1 + hstep, voffA);
            PG8_WAIT_L(8); PG8_BAR; PG8_WAIT_L(0); PG8_MMA(0, 0, At, B0); PG8_BAR; PG8_SCHED;
            PG8_LDB(B1, 0, 1); PG8_STAGE(PG8_SB(0, 0), b2, voffB);
            PG8_BAR; PG8_WAIT_L(0); PG8_MMA(0, 1, At, B1); PG8_BAR;
            PG8_LDA(At, 0, 1); PG8_STAGE(PG8_SA(0, 0), a2, voffA);
            PG8_BAR; PG8_WAIT_L(0); PG8_MMA(1, 0, At, B0); PG8_BAR; PG8_SCHED;
            PG8_STAGE(PG8_SB(0, 1), b2 + hstep, voffB);
            PG8_WAIT_V(6); PG8_BAR; PG8_MMA(1, 1, At, B1); PG8_BAR;
            PG8_LDB(B0, 1, 0); PG8_SCHED; PG8_LDA(At, 1, 0); PG8_STAGE(PG8_SA(0, 1), a2 + hstep, voffA);
            PG8_WAIT_L(8); PG8_BAR; PG8_WAIT_L(0); PG8_MMA(0, 0, At, B0); PG8_BAR; PG8_SCHED;
            PG8_LDB(B1, 1, 1); PG8_STAGE(PG8_SB(1, 0), b3, voffB);
            PG8_BAR; PG8_WAIT_L(0); PG8_MMA(0, 1, At, B1); PG8_BAR;
            PG8_LDA(At, 1, 1); PG8_STAGE(PG8_SA(1, 0), a3, voffA);
            PG8_BAR; PG8_WAIT_L(0); PG8_MMA(1, 0, At, B0); PG8_BAR; PG8_SCHED;
            PG8_STAGE(PG8_SB(1, 1), b3 + hstep, voffB);
            PG8_WAIT_V(6); PG8_BAR; PG8_MMA(1, 1, At, B1); PG8_BAR;
            }
        }
        if constexpr (ALIGN_EPI) { if (wr == 0) PG8_BAR; }
        if constexpr (!Epi::AFTER_DRAIN) { E(acc, cur, wr, wc, fr, fq); S.done(cur); }
        if (!has_next) break;
#pragma unroll
        for (int a = 0; a < 2; ++a)
#pragma unroll
            for (int b = 0; b < 2; ++b)
#pragma unroll
                for (int m = 0; m < 4; ++m)
#pragma unroll
                    for (int n = 0; n < 2; ++n) acc[a][b][m][n] = (f32x4){0.f, 0.f, 0.f, 0.f};
        cur = nxt; cA = nA; cB = nB; ++ui;
        if constexpr (ALIGN_EPI) { if (wr == 1) PG8_BAR; }
    }
    PG8_WAIT_V(0);
    if constexpr (!ALIGN_EPI) { if (wr == 0) PG8_BAR; }
    PG8_BAR;
    if constexpr (Epi::AFTER_DRAIN) { E.fused(acc, cur, wr, wc, fr, fq, lds, wid, lane); S.done(cur); }
#undef PG8_SA
#undef PG8_SB
#undef PG8_STAGE
#undef PG8_LDA
#undef PG8_LDB
#undef PG8_MMA
#undef PG8_WAIT_V
#undef PG8_WAIT_L
#undef PG8_BAR
#undef PG8_SCHED
}
}
typedef __bf16 bf16x2_t __attribute__((ext_vector_type(2)));
__device__ __forceinline__ unsigned cvt_pk(float lo, float hi) { float __attribute__((ext_vector_type(2))) v = {lo, hi}; bf16x2_t b = __builtin_convertvector(v, bf16x2_t); return __builtin_bit_cast(unsigned, b); }
#define LAS __attribute__((address_space(3)))
#define XB_TMO      128
#define XB_XCNT(j)  (256  + 64 * (j))
#define XB_XSUB(j)  (1280 + 64 * (j))
#define XB_XGEN(j)  (2304 + 64 * (j))
#define XB_TOP      3328
#define XB_TOPGEN   3392
#define XCD_BAR_WORDS 3456
#define XB_SPIN_CAP (1u << 18)

__device__ __forceinline__ unsigned xb_ld(unsigned* p)              { return __hip_atomic_load(p, __ATOMIC_RELAXED, __HIP_MEMORY_SCOPE_AGENT); }
__device__ __forceinline__ unsigned xb_add(unsigned* p, unsigned v) { return __hip_atomic_fetch_add(p, v, __ATOMIC_RELAXED, __HIP_MEMORY_SCOPE_AGENT); }
__device__ __forceinline__ unsigned xb_xcc_id() { return (unsigned)__builtin_amdgcn_s_getreg((3 << 11) | 20) & 0xFu; }
#define XB_SPIN(cond, bar) do { unsigned _sp = 0; while (cond) { __builtin_amdgcn_s_sleep(1); \
    if ((++_sp & 255u) == 0u) { if (xb_ld(&(bar)[XB_TMO])) break; if (_sp > XB_SPIN_CAP) { atomicAdd(&(bar)[XB_TMO], 1u); break; } } } } while (0)

struct XcdBarrier {
    unsigned* bar; unsigned x;
    volatile LAS unsigned* st;
};

__device__ __forceinline__ XcdBarrier xcd_barrier_post(unsigned* bar, volatile LAS unsigned* st) {
    XcdBarrier b; b.bar = bar; b.x = xb_xcc_id(); b.st = st;
    if (threadIdx.x == 0) (void)xb_add(&bar[XB_XCNT(b.x)], 1u);
    return b;
}
__device__ __forceinline__ void xcd_barrier_complete(unsigned* bar, unsigned x, unsigned& nloc, unsigned& nx) {
    const unsigned G = gridDim.x * gridDim.y * gridDim.z;
    unsigned sum, cnt, mine, sp = 0u;
    for (;;) {
        sum = 0u; cnt = 0u; mine = 0u;
#pragma unroll
        for (unsigned j = 0; j < 16; ++j) { const unsigned c = xb_ld(&bar[XB_XCNT(j)]); sum += c; cnt += (c > 0u) ? 1u : 0u; mine = (j == x) ? c : mine; }
        if (sum == G) break;
        __builtin_amdgcn_s_sleep(1);
        if ((++sp & 255u) == 0u) { if (xb_ld(&bar[XB_TMO])) break; if (sp > XB_SPIN_CAP) { atomicAdd(&bar[XB_TMO], 1u); break; } }
    }
    nloc = mine > 0u ? mine : 1u; nx = cnt > 0u ? cnt : 1u;
}

__device__ __forceinline__ void xcd_barrier(const XcdBarrier& b) {
    asm volatile("s_waitcnt vmcnt(0)" ::: "memory");
    __syncthreads();
    if (threadIdx.x == 0) {
        unsigned* bar = b.bar;
        __builtin_amdgcn_s_waitcnt(0);
        unsigned nloc = b.st[0], nx = b.st[1];
        if (nloc == 0u) { xcd_barrier_complete(bar, b.x, nloc, nx); b.st[0] = nloc; b.st[1] = nx; }
        const unsigned old = xb_add(&bar[XB_XSUB(b.x)], 1u);
        const unsigned gen = old / nloc;
        if (old + 1u == (gen + 1u) * nloc) {
            __builtin_amdgcn_fence(__ATOMIC_RELEASE, "agent");
            asm volatile("s_waitcnt vmcnt(0)" ::: "memory");
            const unsigned og = xb_add(&bar[XB_TOP], 1u);
            const unsigned tg = og / nx;
            if (og + 1u == (tg + 1u) * nx) xb_add(&bar[XB_TOPGEN], 1u);
            else XB_SPIN(xb_ld(&bar[XB_TOPGEN]) == tg, bar);
            __builtin_amdgcn_fence(__ATOMIC_ACQUIRE, "agent");
            xb_add(&bar[XB_XGEN(b.x)], 1u);
            asm volatile("s_waitcnt vmcnt(0)" ::: "memory");
        } else {
            XB_SPIN(xb_ld(&bar[XB_XGEN(b.x)]) == gen, bar);
            __builtin_amdgcn_fence(__ATOMIC_ACQUIRE, "agent");
            asm volatile("s_waitcnt vmcnt(0)" ::: "memory");
        }
    }
    __syncthreads();
}
typedef unsigned short bf16_t;
typedef short bf16x8 __attribute__((ext_vector_type(8)));
typedef short s16x4 __attribute__((ext_vector_type(4)));
typedef float f32x16 __attribute__((ext_vector_type(16)));
typedef float f32x4 __attribute__((ext_vector_type(4)));
typedef float f32x2 __attribute__((ext_vector_type(2)));
typedef unsigned u32x4 __attribute__((ext_vector_type(4)));
typedef unsigned u32x2 __attribute__((ext_vector_type(2)));

constexpr int DM = 1024, DIN = 4352, DFF = 2816, DUP = 2 * DFF, DEPTH = 2;
constexpr int CH_ROWS = 16384, NCHUNK = 3;
constexpr int TW = 784;
constexpr int T_C = 0, T_L = 768;
constexpr float LOG2E = 1.4426950408889634f, LN2 = 0.6931471805599453f;
constexpr float QSCALE = 0.125f * LOG2E;
constexpr size_t MiB = 1u << 20;
constexpr size_t WS_WIN = 0, WS_WOUT = 18 * MiB, WS_WUP = 22 * MiB, WS_WDN = 44 * MiB, WS_HB = 56 * MiB, WS_PROJ = 88 * MiB, WS_TMP = 264 * MiB, WS_CTL = 394 * MiB, WS_XB = 395 * MiB, WS_SSQ = 459 * MiB, WS_END = 460 * MiB;
constexpr int LDS_BYTES = 147456 + 256 + 8192;
constexpr int NTHREADS = 512;

struct Args { const float* in[17]; float* out; unsigned char* ws; };

__device__ __forceinline__ float wave_sum(float v) {
#pragma unroll
    for (int o = 1; o < 64; o <<= 1) v += __shfl_xor(v, o);
    return v;
}
__device__ __forceinline__ unsigned f2bf(float f) { unsigned u = __builtin_bit_cast(unsigned, f); return (u + 0x7fffu + ((u >> 16) & 1u)) >> 16; }
__device__ __forceinline__ unsigned pk2(float lo, float hi) { return f2bf(lo) | (f2bf(hi) << 16); }
__device__ __forceinline__ float bf2f(unsigned short b) { return __builtin_bit_cast(float, (unsigned)b << 16); }

__device__ __forceinline__ void transpose_item(const float* W, int K, int N, bf16_t* WT, LAS float* scr, int item, int lane, const float* gain, bool gate_perm = false) {
    const int nblk = N / 32, kb = item / nblk, nb = item % nblk, k0 = 64 * kb, n0 = 32 * nb;
#pragma unroll 8
    for (int i = 0; i < 32; ++i) { const int kk = 2 * i + (lane >> 5); scr[kk * 33 + (lane & 31)] = W[(size_t)(k0 + kk) * N + n0 + (lane & 31)] * (gain ? gain[k0 + kk] : 1.f); }
    asm volatile("s_waitcnt lgkmcnt(0)" ::: "memory");
    const int c = lane & 7;
    const int half_ = N / 2, v_ = n0 >= half_ ? n0 - half_ : n0, d0 = gate_perm ? 256 * (v_ / 128) + (n0 >= half_ ? 128 : 0) + (v_ % 128) : n0;
#pragma unroll
    for (int j = 0; j < 4; ++j) { const int n = (lane >> 3) + 8 * j; const LAS float* s = scr + (8 * c) * 33 + n;
        u32x4 o; o.x = pk2(s[0 * 33], s[1 * 33]); o.y = pk2(s[2 * 33], s[3 * 33]); o.z = pk2(s[4 * 33], s[5 * 33]); o.w = pk2(s[6 * 33], s[7 * 33]);
        *(u32x4*)(WT + (size_t)(d0 + n) * K + k0 + 8 * c) = o; }
    asm volatile("s_waitcnt lgkmcnt(0)" ::: "memory");
}

__device__ __forceinline__ void rms_row_to_bf16(const float* xrow, const float* gain, bf16_t* orow, int lane) {
    const f32x4* xr = (const f32x4*)xrow + lane; const f32x4* gr = (const f32x4*)gain + lane;
    f32x4 v[4]; float s = 0.f;
#pragma unroll
    for (int j = 0; j < 4; ++j) { v[j] = xr[64 * j]; s += (v[j].x * v[j].x + v[j].y * v[j].y) + (v[j].z * v[j].z + v[j].w * v[j].w); }
    const float rstd = 1.f / sqrtf(wave_sum(s) * (1.f / DM) + 1e-6f);
    u32x2* o8 = (u32x2*)orow + lane;
#pragma unroll
    for (int j = 0; j < 4; ++j) { const f32x4 g = gr[64 * j]; u32x2 w; w.x = pk2(v[j].x * rstd * g.x, v[j].y * rstd * g.y); w.y = pk2(v[j].z * rstd * g.z, v[j].w * rstd * g.w); o8[64 * j] = w; }
}
__device__ __forceinline__ void rms_row_f32(float* xrow, const float* gain, int lane) {
    f32x4* xr = (f32x4*)xrow + lane; const f32x4* gr = (const f32x4*)gain + lane;
    f32x4 v[4]; float s = 0.f;
#pragma unroll
    for (int j = 0; j < 4; ++j) { v[j] = xr[64 * j]; s += (v[j].x * v[j].x + v[j].y * v[j].y) + (v[j].z * v[j].z + v[j].w * v[j].w); }
    const float rstd = 1.f / sqrtf(wave_sum(s) * (1.f / DM) + 1e-6f);
#pragma unroll
    for (int j = 0; j < 4; ++j) { const f32x4 g = gr[64 * j]; xr[64 * j] = v[j] * rstd * g; }
}

constexpr int KSTR = 144;
constexpr int ATT_K_OFF = 0, ATT_V_OFF = 2 * 64 * KSTR, ATT_SCR_OFF = ATT_V_OFF + 2 * 64 * 320;
__device__ __forceinline__ int crow(int r, int hi) { return (r & 3) + 8 * (r >> 2) + 4 * hi; }
typedef short v4i16_t __attribute__((ext_vector_type(4)));
__device__ __forceinline__ s16x4 vtr(const LAS unsigned char* p) { return __builtin_bit_cast(s16x4, __builtin_amdgcn_ds_read_tr16_b64_v4i16((LAS v4i16_t*)p)); }

template <int VD, bool WIN>
__device__ __forceinline__ void attn_unit(LAS unsigned char* lds, const bf16_t* Qp, const bf16_t* Kp, const bf16_t* Vp, size_t pitch,
                                          int q0, int L, float slope2, int W, float m_init, float l_init,
                                          float* Oout, size_t opitch, float* lse_out, size_t lpitch, bf16_t* Obf) {
    constexpr int VSTR = VD * 2 + 64, ND = VD / 32, VCH = VD / 8, VLD = 64 * VCH / NTHREADS;
    int tid_l = threadIdx.x; asm volatile("" : "+v"(tid_l)); const int tid = tid_l, lane = tid & 63, r32 = lane & 31, hi = lane >> 5, wid = __builtin_amdgcn_readfirstlane(tid >> 6);
    const int qw = q0 + wid * 32;
    int tlo = 0, thi = L / 64;
    if (WIN) { const int a = q0 - W; tlo = a > 0 ? a / 64 : 0; const int b = q0 + 256 + W; thi = (b < L ? b : L) / 64; }
    bf16x8 qr[4];
    { const bf16_t* qrow = Qp + (size_t)(qw + r32) * pitch + hi * 8;
#pragma unroll
      for (int d0 = 0; d0 < 4; ++d0) qr[d0] = *(const bf16x8*)(qrow + d0 * 16); }
    f32x16 o[ND];
#pragma unroll
    for (int d = 0; d < ND; ++d)
#pragma unroll
        for (int r = 0; r < 16; ++r) o[d][r] = 0.f;
    float m = m_init, l = hi == 0 ? l_init : 0.f;
    LAS float* wsf = (LAS float*)(lds + 6 * (64 * KSTR + 64 * (VD * 2 + 64))) + wid * 64;
    static_assert(VD == 64, "grouped staging is sized for 64-wide values");
    constexpr int SLOT = 64 * KSTR + 64 * VSTR, GRP = 6;
    const int krow = tid >> 3, kch = tid & 7;
    const float Wf = (float)W;
    for (int g0 = tlo; g0 < thi; g0 += GRP) {
        const int ng = thi - g0 < GRP ? thi - g0 : GRP;
        u32x4 kr[GRP], vr[GRP];
#pragma unroll
        for (int j = 0; j < GRP; ++j) if (j < ng) { kr[j] = *(const u32x4*)(Kp + (size_t)(64 * (g0 + j) + krow) * pitch + kch * 8); vr[j] = *(const u32x4*)(Vp + (size_t)(64 * (g0 + j) + krow) * pitch + kch * 8); }
        if (g0 != tlo) __syncthreads();
#pragma unroll
        for (int j = 0; j < GRP; ++j) if (j < ng) { *(LAS u32x4*)(lds + j * SLOT + krow * KSTR + kch * 16) = kr[j]; *(LAS u32x4*)(lds + j * SLOT + 64 * KSTR + krow * VSTR + kch * 16) = vr[j]; }
        __syncthreads();
      for (int j = 0; j < ng; ++j) {
        const int t = g0 + j;
        bool active = true;
        if (WIN) { const int kb = 64 * t; active = (kb + 63 >= qw - W) && (kb <= qw + 31 + W); }
        if (active) {
            const LAS unsigned char* Kb = lds + j * SLOT + r32 * KSTR + hi * 16;
            f32x16 p0, p1;
#pragma unroll
            for (int r = 0; r < 16; ++r) { p0[r] = 0.f; p1[r] = 0.f; }
#pragma unroll
            for (int d0 = 0; d0 < 4; ++d0) {
                const bf16x8 a0 = *(const LAS bf16x8*)(Kb + d0 * 32), a1 = *(const LAS bf16x8*)(Kb + 32 * KSTR + d0 * 32);
                p0 = __builtin_amdgcn_mfma_f32_32x32x16_bf16(a0, qr[d0], p0, 0, 0, 0);
                p1 = __builtin_amdgcn_mfma_f32_32x32x16_bf16(a1, qr[d0], p1, 0, 0, 0);
                if (d0 & 1) __builtin_amdgcn_sched_barrier(0);
            }
            const float dq = (float)(64 * t + 4 * hi - (qw + r32));
            float rm = -INFINITY;
#pragma unroll
            for (int r = 0; r < 16; ++r) {
                const float t0 = dq + (float)((r & 3) + 8 * (r >> 2)), t1 = t0 + 32.f;
                p0[r] = __builtin_fmaf(-slope2, __builtin_fabsf(t0), p0[r]);
                p1[r] = __builtin_fmaf(-slope2, __builtin_fabsf(t1), p1[r]);
                if (WIN) { if (__builtin_fabsf(t0) > Wf) p0[r] = -INFINITY; if (__builtin_fabsf(t1) > Wf) p1[r] = -INFINITY; }
                rm = __builtin_fmaxf(rm, __builtin_fmaxf(p0[r], p1[r]));
            }
            rm = __builtin_fmaxf(rm, __shfl_xor(rm, 32));
            if (__any(rm > m)) {
                const float mn = __builtin_fmaxf(m, rm); const float f = __builtin_amdgcn_exp2f(m - mn); m = mn; l *= f;
                if (hi == 0) wsf[r32] = f;
#pragma unroll
                for (int r = 0; r < 16; ++r) { const float fr = wsf[crow(r, hi)];
#pragma unroll
                    for (int d = 0; d < ND; ++d) o[d][r] *= fr; }
            }
            float ls = 0.f;
#pragma unroll
            for (int r = 0; r < 16; ++r) { p0[r] = __builtin_amdgcn_exp2f(p0[r] - m); p1[r] = __builtin_amdgcn_exp2f(p1[r] - m); ls += p0[r] + p1[r]; }
            l += ls;
            u32x4 pw[4];
#pragma unroll
            for (int c = 0; c < 4; ++c) {
                const f32x16& P = (c >> 1) ? p1 : p0; const int b = 8 * (c & 1);
                pw[c].x = cvt_pk(P[b + 0], P[b + 1]); pw[c].y = cvt_pk(P[b + 2], P[b + 3]); pw[c].z = cvt_pk(P[b + 4], P[b + 5]); pw[c].w = cvt_pk(P[b + 6], P[b + 7]);
            }
            const LAS unsigned char* Vb = lds + j * SLOT + 64 * KSTR + (4 * hi + ((lane & 15) >> 2)) * VSTR + (16 * ((lane >> 4) & 1) + 4 * (lane & 3)) * 2;
#pragma unroll
            for (int c = 0; c < 4; ++c)
#pragma unroll
                for (int d = 0; d < ND; ++d) {
                    const s16x4 vlo = vtr(Vb + c * 16 * VSTR + d * 64), vhi = vtr(Vb + c * 16 * VSTR + 8 * VSTR + d * 64);
                    const bf16x8 vf = (bf16x8){vlo[0], vlo[1], vlo[2], vlo[3], vhi[0], vhi[1], vhi[2], vhi[3]};
                    o[d] = __builtin_amdgcn_mfma_f32_32x32x16_bf16(__builtin_bit_cast(bf16x8, pw[c]), vf, o[d], 0, 0, 0);
                    if (d == ND - 1) __builtin_amdgcn_sched_barrier(0);
                }
        }
      }
    }
    l += __shfl_xor(l, 32);
    if (hi == 0) wsf[r32] = 1.f / l;
#pragma unroll
    for (int r = 0; r < 16; ++r) { const float ir = wsf[crow(r, hi)];
        if (Obf != nullptr) { bf16_t* orow = Obf + (size_t)(qw + crow(r, hi)) * opitch + r32;
#pragma unroll
            for (int d = 0; d < ND; ++d) orow[d * 32] = (bf16_t)f2bf(o[d][r] * ir);
        } else { float* orow = Oout + (size_t)(qw + crow(r, hi)) * opitch + r32;
#pragma unroll
            for (int d = 0; d < ND; ++d) orow[d * 32] = o[d][r] * ir; } }
    if (lse_out != nullptr && hi == 0) lse_out[(size_t)(qw + r32) * lpitch] = (m + __builtin_log2f(l)) * LN2;
    __syncthreads();
}

__device__ __forceinline__ void row_to_bf16_ssq(const float* xrow, bf16_t* orow, float* ssq, int lane) {
    const f32x4* xr = (const f32x4*)xrow + lane;
    f32x4 v[4]; float s = 0.f;
#pragma unroll
    for (int j = 0; j < 4; ++j) { v[j] = xr[64 * j]; s += (v[j].x * v[j].x + v[j].y * v[j].y) + (v[j].z * v[j].z + v[j].w * v[j].w); }
    s = wave_sum(s);
    u32x2* o8 = (u32x2*)orow + lane;
#pragma unroll
    for (int j = 0; j < 4; ++j) { u32x2 w; w.x = pk2(v[j].x, v[j].y); w.y = pk2(v[j].z, v[j].w); o8[64 * j] = w; }
    if (lane == 0) *ssq = s;
}
constexpr int BK_OFF = 0, BV_OFF = 2 * 64 * KSTR, BSCR_OFF = BV_OFF + 3 * 64 * 320, ATT_O0_OFF = BSCR_OFF + 2048;
static_assert(ATT_O0_OFF + 65536 <= 147456, "B attention LDS map");
constexpr float B_THR = 6.0f;
#ifndef B_LATE
#define B_LATE(w) false
#endif
template <int KI> __device__ __forceinline__ float fmamk_t(float a, float c) { float r; asm("v_fmamk_f32 %0, %1, %3, %2" : "=v"(r) : "v"(a), "v"(c), "n"(__builtin_bit_cast(int, (float)KI))); return r; }
__device__ __forceinline__ float max3f(float a, float b, float c) { float r; asm("v_max3_f32 %0, %1, %2, %3" : "=v"(r) : "v"(a), "v"(b), "v"(c)); return r; }
__device__ __forceinline__ void attn_b_unit(LAS unsigned char* lds, const bf16_t* base, int h, int q0, int L, float slope2_, float lam,
                                            const float* subln_l, float postscale, bf16_t* mix) {
    constexpr int VD = 128, VSTR = VD * 2 + 64, ND = 4, VCH = 16, VLD = 2;
    int tid_l = threadIdx.x; asm volatile("" : "+v"(tid_l)); const int tid = tid_l, lane = tid & 63, r32 = lane & 31, hi = lane >> 5, wid = __builtin_amdgcn_readfirstlane(tid >> 6);
    const int qw = q0 + wid * 32, NT = L / 64, c0 = q0 / 64;
    LAS float* wsf = (LAS float*)(lds + BSCR_OFF) + wid * 64;
    const bool late = B_LATE(wid);
    const int krow = tid >> 3, kch = tid & 7;
    const bf16_t* Vp = base + 1536 + h * 128;
    const float qposf_ = (float)(qw + r32);
    for (int mp = 0; mp < 2; ++mp) {
        const bf16_t* Qp = base + 512 + (h * 2 + mp) * 64; const bf16_t* Kp = base + 1024 + (h * 2 + mp) * 64;
        bf16x8 qr[4];
        { const bf16_t* qrow = Qp + (size_t)(qw + r32) * DIN + hi * 8;
#pragma unroll
          for (int d0 = 0; d0 < 4; ++d0) qr[d0] = *(const bf16x8*)(qrow + d0 * 16); }
        f32x16 o[ND];
#pragma unroll
        for (int d = 0; d < ND; ++d)
#pragma unroll
            for (int r = 0; r < 16; ++r) o[d][r] = 0.f;
        float mref = 0.f, l = 0.f;
        u32x4 kreg; u32x4 vreg[VLD];
        const unsigned koff = (unsigned)(krow * DIN + kch * 8) * 2u, voff = (unsigned)((tid >> 4) * DIN + (tid & 15) * 8) * 2u;
#define ATT_GLOAD(t) do { const char* kt_ = (const char*)Kp + (size_t)(t) * (64 * DIN * 2); const char* vt_ = (const char*)Vp + (size_t)(t) * (64 * DIN * 2); \
        kreg = *(const u32x4*)(kt_ + koff); vreg[0] = *(const u32x4*)(vt_ + voff); vreg[1] = *(const u32x4*)(vt_ + 32 * DIN * 2 + voff); } while (0)
#define ATT_LSTORE(b, vs) do { *(LAS u32x4*)(lds + BK_OFF + (b) * 64 * KSTR + krow * KSTR + kch * 16) = kreg; \
        *(LAS u32x4*)(lds + BV_OFF + (vs) * 64 * VSTR + (tid >> 4) * VSTR + (tid & 15) * 16) = vreg[0]; *(LAS u32x4*)(lds + BV_OFF + (vs) * 64 * VSTR + ((tid >> 4) + 32) * VSTR + (tid & 15) * 16) = vreg[1]; } while (0)
#define VFRAG(x, d) (bf16x8){x[d][0][0], x[d][0][1], x[d][0][2], x[d][0][3], x[d][1][0], x[d][1][1], x[d][1][2], x[d][1][3]}
#define PV_LOAD01(vs) do { \
        const LAS unsigned char* Vb = lds + BV_OFF + (vs) * 64 * VSTR + (4 * hi + ((lane & 15) >> 2)) * VSTR + (16 * ((lane >> 4) & 1) + 4 * (lane & 3)) * 2; \
        _Pragma("unroll") for (int d = 0; d < ND; ++d) { va[d][0] = vtr(Vb + d * 64); va[d][1] = vtr(Vb + 8 * VSTR + d * 64); } \
        _Pragma("unroll") for (int d = 0; d < ND; ++d) { vb2[d][0] = vtr(Vb + 16 * VSTR + d * 64); vb2[d][1] = vtr(Vb + 16 * VSTR + 8 * VSTR + d * 64); } \
        __builtin_amdgcn_sched_barrier(0); } while (0)
#define PV_MMA(vs) do { \
        const LAS unsigned char* Vb = lds + BV_OFF + (vs) * 64 * VSTR + (4 * hi + ((lane & 15) >> 2)) * VSTR + (16 * ((lane >> 4) & 1) + 4 * (lane & 3)) * 2; \
        _Pragma("unroll") for (int d = 0; d < ND; ++d) o[d] = __builtin_amdgcn_mfma_f32_32x32x16_bf16(__builtin_bit_cast(bf16x8, pw[0]), VFRAG(va, d), o[d], 0, 0, 0); \
        __builtin_amdgcn_sched_barrier(0); \
        _Pragma("unroll") for (int d = 0; d < ND; ++d) { va[d][0] = vtr(Vb + 32 * VSTR + d * 64); va[d][1] = vtr(Vb + 32 * VSTR + 8 * VSTR + d * 64); } \
        __builtin_amdgcn_sched_barrier(0); \
        _Pragma("unroll") for (int d = 0; d < ND; ++d) o[d] = __builtin_amdgcn_mfma_f32_32x32x16_bf16(__builtin_bit_cast(bf16x8, pw[1]), VFRAG(vb2, d), o[d], 0, 0, 0); \
        __builtin_amdgcn_sched_barrier(0); \
        _Pragma("unroll") for (int d = 0; d < ND; ++d) { vb2[d][0] = vtr(Vb + 48 * VSTR + d * 64); vb2[d][1] = vtr(Vb + 48 * VSTR + 8 * VSTR + d * 64); } \
        __builtin_amdgcn_sched_barrier(0); \
        _Pragma("unroll") for (int d = 0; d < ND; ++d) o[d] = __builtin_amdgcn_mfma_f32_32x32x16_bf16(__builtin_bit_cast(bf16x8, pw[2]), VFRAG(va, d), o[d], 0, 0, 0); \
        _Pragma("unroll") for (int d = 0; d < ND; ++d) o[d] = __builtin_amdgcn_mfma_f32_32x32x16_bf16(__builtin_bit_cast(bf16x8, pw[3]), VFRAG(vb2, d), o[d], 0, 0, 0); \
        __builtin_amdgcn_sched_barrier(0); } while (0)
        int first = 1; asm volatile("" : "+s"(first));
#define B_TILE(i_) ((i_) < 4 ? c0 + (i_) : ((i_) - 4 < c0 ? (i_) - 4 : (i_)))
        int t = B_TILE(0);
        int vs_prev = 2, vs_cur = 0, vs_next = 1;
        u32x4 pw[4];
        ATT_GLOAD(t); ATT_LSTORE(0, 0); __syncthreads();
        for (int i = 0; i < NT; ++i) {
            const int buf = i & 1;
            int tn = 0;
            if (i + 1 < NT) { tn = B_TILE(i + 1); ATT_GLOAD(tn); }
            f32x16 p0, p1;
            const int kb = 64 * t;
            float slope2 = slope2_, qposf = qposf_; asm volatile("" : "+v"(slope2), "+v"(qposf));
            const LAS unsigned char* Kb = lds + BK_OFF + buf * 64 * KSTR + r32 * KSTR + hi * 16;
            bf16x8 kf[8];
#pragma unroll
            for (int d0 = 0; d0 < 4; ++d0) { kf[d0] = *(const LAS bf16x8*)(Kb + d0 * 32); kf[4 + d0] = *(const LAS bf16x8*)(Kb + 32 * KSTR + d0 * 32); }
            const LAS unsigned char* Vb = lds + BV_OFF + vs_cur * 64 * VSTR + (4 * hi + ((lane & 15) >> 2)) * VSTR + (16 * ((lane >> 4) & 1) + 4 * (lane & 3)) * 2;
            s16x4 va[ND][2], vb2[ND][2];
            const bool offdiag = (kb + 63 < qw || kb > qw + 31);
            const float dq = (float)(kb + 4 * hi) - qposf;
#define QK_P0(INIT0, INIT1) do { \
            _Pragma("unroll") for (int r = 0; r < 16; ++r) { const float kv = (float)((r & 3) + 8 * (r >> 2)); p0[r] = INIT0; } \
            __builtin_amdgcn_sched_barrier(0); \
            _Pragma("unroll") for (int d0 = 0; d0 < 4; ++d0) { \
                p0 = __builtin_amdgcn_mfma_f32_32x32x16_bf16(kf[d0], qr[d0], p0, 0, 0, 0); \
                _Pragma("unroll") for (int r = 4 * d0; r < 4 * d0 + 4; ++r) { const float kv = (float)((r & 3) + 8 * (r >> 2) + 32); p1[r] = INIT1; } \
                __builtin_amdgcn_sched_barrier(0); } } while (0)
            if (offdiag) {
                const float sg = (kb > qw) ? -slope2 : slope2, b0 = sg * dq - mref;
                p0[0] = fmamk_t<0>(sg, b0); p0[1] = fmamk_t<1>(sg, b0); p0[2] = fmamk_t<2>(sg, b0); p0[3] = fmamk_t<3>(sg, b0); p0[4] = fmamk_t<8>(sg, b0); p0[5] = fmamk_t<9>(sg, b0); p0[6] = fmamk_t<10>(sg, b0); p0[7] = fmamk_t<11>(sg, b0); p0[8] = fmamk_t<16>(sg, b0); p0[9] = fmamk_t<17>(sg, b0); p0[10] = fmamk_t<18>(sg, b0); p0[11] = fmamk_t<19>(sg, b0); p0[12] = fmamk_t<24>(sg, b0); p0[13] = fmamk_t<25>(sg, b0); p0[14] = fmamk_t<26>(sg, b0); p0[15] = fmamk_t<27>(sg, b0);
                __builtin_amdgcn_sched_barrier(0);
                p0 = __builtin_amdgcn_mfma_f32_32x32x16_bf16(kf[0], qr[0], p0, 0, 0, 0); p1[0] = fmamk_t<32>(sg, b0); p1[1] = fmamk_t<33>(sg, b0); p1[2] = fmamk_t<34>(sg, b0); p1[3] = fmamk_t<35>(sg, b0); __builtin_amdgcn_sched_barrier(0);
                p0 = __builtin_amdgcn_mfma_f32_32x32x16_bf16(kf[1], qr[1], p0, 0, 0, 0); p1[4] = fmamk_t<40>(sg, b0); p1[5] = fmamk_t<41>(sg, b0); p1[6] = fmamk_t<42>(sg, b0); p1[7] = fmamk_t<43>(sg, b0); __builtin_amdgcn_sched_barrier(0);
                p0 = __builtin_amdgcn_mfma_f32_32x32x16_bf16(kf[2], qr[2], p0, 0, 0, 0); p1[8] = fmamk_t<48>(sg, b0); p1[9] = fmamk_t<49>(sg, b0); p1[10] = fmamk_t<50>(sg, b0); p1[11] = fmamk_t<51>(sg, b0); __builtin_amdgcn_sched_barrier(0);
                p0 = __builtin_amdgcn_mfma_f32_32x32x16_bf16(kf[3], qr[3], p0, 0, 0, 0); p1[12] = fmamk_t<56>(sg, b0); p1[13] = fmamk_t<57>(sg, b0); p1[14] = fmamk_t<58>(sg, b0); p1[15] = fmamk_t<59>(sg, b0); __builtin_amdgcn_sched_barrier(0);
            } else {
                const float nmref = -mref;
                QK_P0(__builtin_fmaf(-slope2, __builtin_fabsf(dq + kv), nmref), __builtin_fmaf(-slope2, __builtin_fabsf(dq + kv), nmref));
            }
#undef QK_P0
#pragma unroll
            for (int d = 0; d < ND; ++d) { va[d][0] = vtr(Vb + d * 64); va[d][1] = vtr(Vb + 8 * VSTR + d * 64); }
#pragma unroll
            for (int d = 0; d < ND; ++d) { vb2[d][0] = vtr(Vb + 16 * VSTR + d * 64); vb2[d][1] = vtr(Vb + 16 * VSTR + 8 * VSTR + d * 64); }
            __builtin_amdgcn_sched_barrier(0);
#pragma unroll
            for (int d0 = 0; d0 < 4; ++d0) p1 = __builtin_amdgcn_mfma_f32_32x32x16_bf16(kf[4 + d0], qr[d0], p1, 0, 0, 0);
            __builtin_amdgcn_sched_barrier(0);
            float rm, rmb;
            asm volatile("s_nop 15\n\ts_nop 7\n\tv_max3_f32 %0, %1, %2, %3\n\tv_max3_f32 %0, %0, %4, %5\n\tv_max3_f32 %0, %0, %6, %7\n\tv_max3_f32 %0, %0, %8, %9\n\t"
                         "v_max3_f32 %0, %0, %10, %11\n\tv_max3_f32 %0, %0, %12, %13\n\tv_max3_f32 %0, %0, %14, %15\n\tv_max3_f32 %0, %0, %16, %16"
                         : "=&v"(rm) : "v"(p0[0]), "v"(p0[1]), "v"(p0[2]), "v"(p0[3]), "v"(p0[4]), "v"(p0[5]), "v"(p0[6]), "v"(p0[7]), "v"(p0[8]), "v"(p0[9]), "v"(p0[10]), "v"(p0[11]), "v"(p0[12]), "v"(p0[13]), "v"(p0[14]), "v"(p0[15]));
            asm volatile("v_max3_f32 %0, %1, %2, %3\n\tv_max3_f32 %0, %0, %4, %5\n\tv_max3_f32 %0, %0, %6, %7\n\tv_max3_f32 %0, %0, %8, %9\n\t"
                         "v_max3_f32 %0, %0, %10, %11\n\tv_max3_f32 %0, %0, %12, %13\n\tv_max3_f32 %0, %0, %14, %15\n\tv_max3_f32 %0, %0, %16, %16"
                         : "=&v"(rmb) : "v"(p1[0]), "v"(p1[1]), "v"(p1[2]), "v"(p1[3]), "v"(p1[4]), "v"(p1[5]), "v"(p1[6]), "v"(p1[7]), "v"(p1[8]), "v"(p1[9]), "v"(p1[10]), "v"(p1[11]), "v"(p1[12]), "v"(p1[13]), "v"(p1[14]), "v"(p1[15]));
            rm = __builtin_fmaxf(rm, rmb);
            { auto rr_ = __builtin_amdgcn_permlane32_swap(__float_as_uint(rm), __float_as_uint(rm), false, false); rm = __builtin_fmaxf(__uint_as_float(rr_[0]), __uint_as_float(rr_[1])); }
            if (first || __any(rm > B_THR)) {
                const float delta = (first || rm > B_THR) ? rm : 0.f; const float f = __builtin_amdgcn_exp2f(-delta); mref += delta; l *= f;
#pragma unroll
                for (int r = 0; r < 16; ++r) { p0[r] -= delta; p1[r] -= delta; }
                {
                    if (hi == 0) wsf[r32] = f;
#pragma unroll
                    for (int r = 0; r < 16; ++r) { const float fr = wsf[crow(r, hi)];
#pragma unroll
                        for (int d = 0; d < ND; ++d) o[d][r] *= fr; }
                }
            }
            float ls0 = 0.f, ls1 = 0.f;
#pragma unroll
            for (int r = 0; r < 16; ++r) { p0[r] = __builtin_amdgcn_exp2f(p0[r]); ls0 += p0[r]; }
            pw[0].x = cvt_pk(p0[0], p0[1]); pw[0].y = cvt_pk(p0[2], p0[3]); pw[0].z = cvt_pk(p0[4], p0[5]); pw[0].w = cvt_pk(p0[6], p0[7]);
            pw[1].x = cvt_pk(p0[8], p0[9]); pw[1].y = cvt_pk(p0[10], p0[11]); pw[1].z = cvt_pk(p0[12], p0[13]); pw[1].w = cvt_pk(p0[14], p0[15]);
            __builtin_amdgcn_sched_barrier(0);
#define VFRAG(x, d) (bf16x8){x[d][0][0], x[d][0][1], x[d][0][2], x[d][0][3], x[d][1][0], x[d][1][1], x[d][1][2], x[d][1][3]}
#pragma unroll
            for (int d = 0; d < ND; ++d) {
                o[d] = __builtin_amdgcn_mfma_f32_32x32x16_bf16(__builtin_bit_cast(bf16x8, pw[0]), VFRAG(va, d), o[d], 0, 0, 0);
                p1[2 * d] = __builtin_amdgcn_exp2f(p1[2 * d]); p1[2 * d + 1] = __builtin_amdgcn_exp2f(p1[2 * d + 1]); ls1 += p1[2 * d]; ls0 += p1[2 * d + 1];
                __builtin_amdgcn_sched_barrier(0);
            }
#pragma unroll
            for (int d = 0; d < ND; ++d) { va[d][0] = vtr(Vb + 32 * VSTR + d * 64); va[d][1] = vtr(Vb + 32 * VSTR + 8 * VSTR + d * 64); }
            __builtin_amdgcn_sched_barrier(0);
#pragma unroll
            for (int d = 0; d < ND; ++d) {
                o[d] = __builtin_amdgcn_mfma_f32_32x32x16_bf16(__builtin_bit_cast(bf16x8, pw[1]), VFRAG(vb2, d), o[d], 0, 0, 0);
                p1[8 + 2 * d] = __builtin_amdgcn_exp2f(p1[8 + 2 * d]); p1[8 + 2 * d + 1] = __builtin_amdgcn_exp2f(p1[8 + 2 * d + 1]); ls1 += p1[8 + 2 * d]; ls0 += p1[8 + 2 * d + 1];
                __builtin_amdgcn_sched_barrier(0);
            }
#pragma unroll
            for (int d = 0; d < ND; ++d) { vb2[d][0] = vtr(Vb + 48 * VSTR + d * 64); vb2[d][1] = vtr(Vb + 48 * VSTR + 8 * VSTR + d * 64); }
            l += ls0 + ls1;
            pw[2].x = cvt_pk(p1[0], p1[1]); pw[2].y = cvt_pk(p1[2], p1[3]); pw[2].z = cvt_pk(p1[4], p1[5]); pw[2].w = cvt_pk(p1[6], p1[7]);
            __builtin_amdgcn_sched_barrier(0);
#pragma unroll
            for (int d = 0; d < ND; ++d) {
                o[d] = __builtin_amdgcn_mfma_f32_32x32x16_bf16(__builtin_bit_cast(bf16x8, pw[2]), VFRAG(va, d), o[d], 0, 0, 0);
                if (d == 0) { pw[3].x = cvt_pk(p1[8], p1[9]); pw[3].y = cvt_pk(p1[10], p1[11]); } else if (d == 1) { pw[3].z = cvt_pk(p1[12], p1[13]); pw[3].w = cvt_pk(p1[14], p1[15]); }
                __builtin_amdgcn_sched_barrier(0);
            }
#pragma unroll
            for (int d = 0; d < ND; ++d) o[d] = __builtin_amdgcn_mfma_f32_32x32x16_bf16(__builtin_bit_cast(bf16x8, pw[3]), VFRAG(vb2, d), o[d], 0, 0, 0);
#undef VFRAG
            __builtin_amdgcn_sched_barrier(0);
            first = 0;
            if (i + 1 < NT) ATT_LSTORE(buf ^ 1, vs_next);
            t = tn;
            { const int tmp_ = vs_prev; vs_prev = vs_cur; vs_cur = vs_next; vs_next = tmp_; }
            __syncthreads();
        }
#undef PV_LOAD01
#undef PV_MMA
#undef B_TILE
#undef VFRAG
#undef ATT_GLOAD
#undef ATT_LSTORE
        l += __shfl_xor(l, 32);
        if (hi == 0) wsf[r32] = 1.f / l;
        int lane_e = lane, qw_e = qw; asm volatile("" : "+v"(lane_e)); asm volatile("" : "+s"(qw_e));
        const int r32 = lane_e & 31, hi = lane_e >> 5, qw = qw_e;
        LAS unsigned* o0buf = (LAS unsigned*)(lds + ATT_O0_OFF) + wid * 2048 + lane_e;
        if (mp == 0) {
#pragma unroll
            for (int d = 0; d < ND; ++d)
#pragma unroll
                for (int r = 0; r < 16; r += 2) { const float i0 = wsf[crow(r, hi)], i1 = wsf[crow(r + 1, hi)]; o0buf[(d * 8 + (r >> 1)) * 64] = cvt_pk(o[d][r] * i0, o[d][r + 1] * i1); }
        } else {
            float gs[ND];
#pragma unroll
            for (int d = 0; d < ND; ++d) gs[d] = subln_l[d * 32 + r32] * postscale;
#pragma unroll
            for (int r = 0; r < 16; r += 2) {
                const float i0 = wsf[crow(r, hi)], i1 = wsf[crow(r + 1, hi)];
                float v0[ND], v1[ND]; float s0 = 0.f, s1 = 0.f;
#pragma unroll
                for (int d = 0; d < ND; ++d) { const unsigned w = o0buf[(d * 8 + (r >> 1)) * 64];
                    v0[d] = __builtin_bit_cast(float, w << 16) - lam * (o[d][r] * i0); v1[d] = __builtin_bit_cast(float, w & 0xffff0000u) - lam * (o[d][r + 1] * i1);
                    s0 += v0[d] * v0[d]; s1 += v1[d] * v1[d]; }
#pragma unroll
                for (int sh = 1; sh < 32; sh <<= 1) { s0 += __shfl_xor(s0, sh); s1 += __shfl_xor(s1, sh); }
                const float r0 = 1.f / sqrtf(s0 * (1.f / 128.f) + 1e-5f), r1 = 1.f / sqrtf(s1 * (1.f / 128.f) + 1e-5f);
                bf16_t* row0 = mix + (size_t)(qw + crow(r, hi)) * DM + r32; bf16_t* row1 = mix + (size_t)(qw + crow(r + 1, hi)) * DM + r32;
#pragma unroll
                for (int d = 0; d < ND; ++d) { row0[d * 32] = (bf16_t)f2bf(v0[d] * r0 * gs[d]); row1[d * 32] = (bf16_t)f2bf(v1[d] * r1 * gs[d]); }
            }
        }
        __syncthreads();
    }
}
__device__ __forceinline__ float alibi_slope(int i, int n) { return exp2f(-8.0f * (float)(i + 1) / (float)n); }
struct Ctx { int tid, lane, wave, G, cu, gw, NGW; };

__device__ __forceinline__ void ph_weights(const Args& a, LAS unsigned char* lds, int l, int gw0, int nw, int wave, int lane) {
    unsigned char* ws = a.ws;
    bf16_t* WinT = (bf16_t*)(ws + WS_WIN); bf16_t* WoutT = (bf16_t*)(ws + WS_WOUT); bf16_t* WupT = (bf16_t*)(ws + WS_WUP); bf16_t* WdnT = (bf16_t*)(ws + WS_WDN);
    const float* w_in = a.in[3]; const float* w_out = a.in[10]; const float* w_up = a.in[12]; const float* w_down = a.in[15];
    LAS float* scr = (LAS float*)(lds + wave * 16384);
    constexpr int I_IN = (DM / 64) * (DIN / 32), I_OUT = (DM / 64) * (DM / 32), I_UP = (DM / 64) * (DUP / 32), I_DN = (DFF / 64) * (DM / 32);
    constexpr int PER_L = I_IN + I_OUT + I_UP + I_DN;
    for (int it = gw0; it < PER_L; it += nw) {
        int r = it;
        if (r < I_IN) { transpose_item(w_in + (size_t)l * DM * DIN, DM, DIN, WinT + (size_t)l * DIN * DM, scr, r, lane, a.in[2] + l * DM); continue; } r -= I_IN;
        if (r < I_OUT) { transpose_item(w_out + (size_t)l * DM * DM, DM, DM, WoutT + (size_t)l * DM * DM, scr, r, lane, nullptr); continue; } r -= I_OUT;
        if (r < I_UP) { transpose_item(w_up + (size_t)l * DM * DUP, DM, DUP, WupT + (size_t)l * DUP * DM, scr, r, lane, a.in[11] + l * DM, true); continue; } r -= I_UP;
        transpose_item(w_down + (size_t)l * DFF * DM, DFF, DM, WdnT + (size_t)l * DM * DFF, scr, r, lane, nullptr);
    }
}
__device__ __forceinline__ const float* chunk_in(const Args& a, int ch) { return ch == 0 ? a.in[0] : a.in[1] + (size_t)(ch - 1) * CH_ROWS * DM; }
__device__ __forceinline__ float* chunk_out(const Args& a, int ch) { return a.out + (size_t)ch * CH_ROWS * DM; }

__device__ __forceinline__ void ph_norm_bf16(const Ctx& c, const float* xsrc, const float* gain, bf16_t* HB) {
    for (int r = c.gw; r < CH_ROWS; r += c.NGW) rms_row_to_bf16(xsrc + (size_t)r * DM, gain, HB + (size_t)r * DM, c.lane);
}
__device__ __forceinline__ void ph_final_norm(const Ctx& c, float* xo, const float* gain) {
    for (int r = c.gw; r < CH_ROWS; r += c.NGW) rms_row_f32(xo + (size_t)r * DM, gain, c.lane);
}

__device__ __forceinline__ void ph_attn(const Args& a, const Ctx& c, LAS unsigned char* lds, int ch, int layer) {
    const bf16_t* PROJ = (const bf16_t*)(a.ws + WS_PROJ); float* TMP = (float*)(a.ws + WS_TMP);
    const int SL = ch == 0 ? 16384 : 4096, sl_shift = ch == 0 ? 14 : 12;
    const int cu = c.cu, G = c.G;
#ifndef SKIP_B
    {
        const float lam_init = layer == 0 ? 0.2f : (0.8f - 0.6f * 0.7408182206817179f);
        const float s1 = wave_sum(a.in[5][layer * 64 + c.lane] * a.in[6][layer * 64 + c.lane]);
        const float s2 = wave_sum(a.in[7][layer * 64 + c.lane] * a.in[8][layer * 64 + c.lane]);
        const float lam = expf(s1) - expf(s2) + lam_init;
        bf16_t* HBm = (bf16_t*)(a.ws + WS_HB);
#ifdef PROBE_B2
        for (int rep_ = 0; rep_ < 2; ++rep_)
#endif
        for (int u = cu; u < 256; u += G) {
            int seq, h, qb; const int xcd = u & 7, idx = u >> 3;
            if (ch == 0) { seq = 0; h = xcd >> 1; qb = (xcd & 1) * 32 + idx; }
            else { const int pair = xcd * 2 + (idx >> 4); seq = pair >> 2; h = pair & 3; qb = idx & 15; }
            const size_t rb = (size_t)seq * SL;
            attn_b_unit(lds, PROJ + rb * DIN, h, qb * 256, SL, alibi_slope(h, 4) * LOG2E, lam, a.in[9] + layer * 128, 1.f - lam_init, HBm + rb * DM + 256 + h * 128);
        }
    }
#endif
#ifndef SKIP_AC
#ifdef PROBE_AC2
    for (int rep_ = 0; rep_ < 2; ++rep_)
#endif
    for (int uu = cu; uu < 1024; uu += G) {
        const bf16_t *qp, *kp, *vp; size_t pitch, opitch, lpitch; int q0, L, W; float slope2, m_init, l_init; float *op, *lp; bf16_t* obf;
        if (uu < 256) {
            const int hq = uu >> 6, blk = uu & 63;
            const int seq = (blk * 256) >> sl_shift, qb = blk - ((seq << sl_shift) >> 8);
            const size_t rb = (size_t)seq * SL; const bf16_t* base = PROJ + rb * DIN;
            qp = base + hq * 64; kp = base + 256 + (hq >> 1) * 64; vp = base + 384 + (hq >> 1) * 64; pitch = DIN; q0 = qb * 256; L = SL;
            slope2 = alibi_slope(hq, 4) * LOG2E; W = 128; m_init = a.in[4][layer * 4 + hq] * LOG2E; l_init = 1.f;
            op = nullptr; obf = (bf16_t*)(a.ws + WS_HB) + rb * DM + hq * 64; opitch = DM; lp = nullptr; lpitch = 0;
        } else {
            const int uc = uu - 256;
            const int gh = uc >> 6, blk = uc & 63, gq = gh >> 2;
            const int dsh = 2 * gq, d = 1 << dsh;
            const int seq = (blk * 256) >> sl_shift, b2 = blk - ((seq << sl_shift) >> 8);
            const int nbr = (SL >> dsh) >> 8;
            const int res = b2 / nbr, qb = b2 % nbr;
            const size_t rb = (size_t)seq * SL + res; const bf16_t* base = PROJ + rb * DIN;
            qp = base + 2048 + gh * 64; kp = base + 2816 + gh * 64; vp = base + 3584 + gh * 64; pitch = (size_t)DIN * d; q0 = qb * 256; L = SL >> dsh;
            slope2 = alibi_slope(gh, 12) * (float)d * LOG2E; W = 64; m_init = -1e30f; l_init = 0.f;
            op = TMP + rb * TW + T_C + gh * 64; obf = nullptr; opitch = (size_t)TW * d; lp = TMP + rb * TW + T_L + gh; lpitch = (size_t)TW * d;
        }
        attn_unit<64, true>(lds, qp, kp, vp, pitch, q0, L, slope2, W, m_init, l_init, op, opitch, lp, lpitch, obf);
    }
#endif
}

__device__ __forceinline__ void ph_combine(const Args& a, const Ctx& c, int layer) {
    const float* TMP = (const float*)(a.ws + WS_TMP); bf16_t* HB = (bf16_t*)(a.ws + WS_HB);
    { float* S2 = (float*)(a.ws + WS_SSQ) + 2 * CH_ROWS; for (int r = c.cu * NTHREADS + c.tid; r < CH_ROWS; r += c.G * NTHREADS) S2[r] = 0.f; }
    const int nitems = CH_ROWS * 32;
#pragma unroll 2
    for (int it = c.cu * NTHREADS + c.tid; it < nitems; it += c.G * NTHREADS) {
        const int r = it >> 5, h = (it >> 3) & 3, d8 = (it & 7) * 8;
        const float* tr = TMP + (size_t)r * TW;
        const float l0 = tr[T_L + h], l1 = tr[T_L + 4 + h], l2 = tr[T_L + 8 + h];
        const f32x4 a0 = *(const f32x4*)(tr + T_C + h * 64 + d8), a1 = *(const f32x4*)(tr + T_C + h * 64 + d8 + 4);
        const f32x4 b0 = *(const f32x4*)(tr + T_C + (4 + h) * 64 + d8), b1 = *(const f32x4*)(tr + T_C + (4 + h) * 64 + d8 + 4);
        const f32x4 c0 = *(const f32x4*)(tr + T_C + (8 + h) * 64 + d8), c1 = *(const f32x4*)(tr + T_C + (8 + h) * 64 + d8 + 4);
        const float mx = fmaxf(l0, fmaxf(l1, l2));
        float w0 = __expf(l0 - mx), w1 = __expf(l1 - mx), w2 = __expf(l2 - mx);
        const float inv = 1.f / (w0 + w1 + w2); w0 *= inv; w1 *= inv; w2 *= inv;
        const f32x4 o0 = a0 * w0 + b0 * w1 + c0 * w2, o1 = a1 * w0 + b1 * w1 + c1 * w2;
        u32x4 o; o.x = pk2(o0.x, o0.y); o.y = pk2(o0.z, o0.w); o.z = pk2(o1.x, o1.y); o.w = pk2(o1.z, o1.w);
        *(u32x4*)(HB + (size_t)r * DM + 768 + h * 64 + d8) = o;
    }
}

__device__ __forceinline__ void ph_conv(const Args& a, const Ctx& c, int ch, int layer) {
    const int par = ch & 1;
    const bf16_t* UB = (const bf16_t*)(a.ws + WS_PROJ); bf16_t* GB = (bf16_t*)(a.ws + WS_TMP);
    const int SL = ch == 0 ? 16384 : 4096;
    const float* cw = a.in[13] + (size_t)layer * 3 * DUP; const float* cb = a.in[14] + (size_t)layer * DUP;
    constexpr int NCG = DFF / 8, RB = 16;
    const int nitems = (CH_ROWS / RB) * NCG;
    { float* S1 = (float*)(a.ws + WS_SSQ) + par * CH_ROWS; for (int r = c.cu * NTHREADS + c.tid; r < CH_ROWS; r += c.G * NTHREADS) S1[r] = 0.f; }
    for (int it = c.cu * NTHREADS + c.tid; it < nitems; it += c.G * NTHREADS) {
        const int cg8 = it % NCG, rb = it / NCG, c0 = cg8 * 8, r0 = rb * RB;
        f32x4 wg[3][2], wv[3][2], bg[2], bv[2];
#pragma unroll
        for (int k = 0; k < 3; ++k)
#pragma unroll
            for (int j = 0; j < 2; ++j) { wg[k][j] = *(const f32x4*)(cw + k * DUP + c0 + 4 * j); wv[k][j] = *(const f32x4*)(cw + k * DUP + DFF + c0 + 4 * j); }
#pragma unroll
        for (int j = 0; j < 2; ++j) { bg[j] = *(const f32x4*)(cb + c0 + 4 * j); bv[j] = *(const f32x4*)(cb + DFF + c0 + 4 * j); }
        const bool first = (r0 & (SL - 1)) == 0, last = ((r0 + RB) & (SL - 1)) == 0;
        const u32x4 zero = (u32x4){0u, 0u, 0u, 0u};
        const bf16_t* up = UB + (size_t)r0 * DUP + c0;
        u32x4 pg_ = first ? zero : *(const u32x4*)(up - DUP), pv_ = first ? zero : *(const u32x4*)(up - DUP + DFF);
        u32x4 cg_ = *(const u32x4*)(up), cv_ = *(const u32x4*)(up + DFF);
        bf16_t* gp = GB + (size_t)r0 * DFF + c0;
#pragma unroll 4
        for (int rr = 0; rr < RB; ++rr) {
            const bool nz = (rr == RB - 1) && last;
            const u32x4 ng_ = nz ? zero : *(const u32x4*)(up + (size_t)(rr + 1) * DUP), nv_ = nz ? zero : *(const u32x4*)(up + (size_t)(rr + 1) * DUP + DFF);
            unsigned ow[4];
#pragma unroll
            for (int w = 0; w < 4; ++w) {
                float res[2];
#pragma unroll
                for (int hh = 0; hh < 2; ++hh) {
                    const int j = 2 * w + hh, q = j >> 2, e = j & 3;
                    const float gpv = hh ? __builtin_bit_cast(float, pg_[w] & 0xffff0000u) : __builtin_bit_cast(float, pg_[w] << 16);
                    const float gcv = hh ? __builtin_bit_cast(float, cg_[w] & 0xffff0000u) : __builtin_bit_cast(float, cg_[w] << 16);
                    const float gnv = hh ? __builtin_bit_cast(float, ng_[w] & 0xffff0000u) : __builtin_bit_cast(float, ng_[w] << 16);
                    const float vpv = hh ? __builtin_bit_cast(float, pv_[w] & 0xffff0000u) : __builtin_bit_cast(float, pv_[w] << 16);
                    const float vcv = hh ? __builtin_bit_cast(float, cv_[w] & 0xffff0000u) : __builtin_bit_cast(float, cv_[w] << 16);
                    const float vnv = hh ? __builtin_bit_cast(float, nv_[w] & 0xffff0000u) : __builtin_bit_cast(float, nv_[w] << 16);
                    const float gate = gpv * wg[0][q][e] + gcv * wg[1][q][e] + gnv * wg[2][q][e] + bg[q][e];
                    const float val = vpv * wv[0][q][e] + vcv * wv[1][q][e] + vnv * wv[2][q][e] + bv[q][e];
                    res[hh] = gate * __builtin_amdgcn_rcpf(1.f + __builtin_amdgcn_exp2f(-LOG2E * gate)) * val;
                }
                ow[w] = pk2(res[0], res[1]);
            }
            *(u32x4*)(gp + (size_t)rr * DFF) = (u32x4){ow[0], ow[1], ow[2], ow[3]};
            pg_ = cg_; pv_ = cv_; cg_ = ng_; cv_ = nv_;
        }
    }
}

constexpr int STEPS_PER_CHUNK = DEPTH * 6;
constexpr int NSTEPS = 1 + NCHUNK * STEPS_PER_CHUNK + 1;
__global__ void __launch_bounds__(NTHREADS, 2) mega_fwd(Args a) {
    extern __shared__ __attribute__((aligned(16))) unsigned char lds_raw[];
    LAS unsigned char* lds = (LAS unsigned char*)lds_raw;
    cg::grid_group grid = cg::this_grid();
    volatile LAS unsigned* bst = (volatile LAS unsigned*)(lds + 147456);
    if (threadIdx.x < 2) bst[threadIdx.x] = 0u;
    __syncthreads();
    XcdBarrier xbar = xcd_barrier_post((unsigned*)(a.ws + WS_CTL), bst);
#ifdef PROBE_P2
    for (int pass_ = 0; pass_ < 2; ++pass_)
#endif
    for (int step = 0; step < NSTEPS; ++step) {
        int tid_l = threadIdx.x, cu_l = blockIdx.x, G_l = gridDim.x;
        asm volatile("" : "+v"(tid_l)); asm volatile("" : "+s"(cu_l), "+s"(G_l));
        Ctx c; c.tid = tid_l; c.lane = c.tid & 63; c.wave = __builtin_amdgcn_readfirstlane(c.tid >> 6);
        c.G = G_l; c.cu = cu_l; c.gw = c.cu * 8 + c.wave; c.NGW = c.G * 8;
        unsigned char* ws = a.ws;
        if (step == 0) {
            ph_weights(a, lds, 0, c.gw, c.NGW, c.wave, c.lane); ph_weights(a, lds, 1, c.gw, c.NGW, c.wave, c.lane);
            const float* xin = chunk_in(a, 0); bf16_t* XB = (bf16_t*)(ws + WS_XB); float* S1 = (float*)(ws + WS_SSQ);
            for (int r = c.gw; r < CH_ROWS; r += c.NGW) row_to_bf16_ssq(xin + (size_t)r * DM, XB + (size_t)r * DM, S1 + r, c.lane);
        } else if (step == NSTEPS - 1) ph_final_norm(c, chunk_out(a, NCHUNK - 1), a.in[16]);
        else {
            const int s = step - 1, ch = s / STEPS_PER_CHUNK, sc = s % STEPS_PER_CHUNK, par = ch & 1;
            bf16_t* HB = (bf16_t*)(ws + WS_HB); bf16_t* XB = (bf16_t*)(ws + WS_XB) + (size_t)par * CH_ROWS * DM;
            float* S1 = (float*)(ws + WS_SSQ) + par * CH_ROWS; float* S2 = (float*)(ws + WS_SSQ) + 2 * CH_ROWS;
            float* xo = chunk_out(a, ch);
            {
                const int layer = sc / 6, ph = sc % 6;
                const float* xsrc = layer == 0 ? chunk_in(a, ch) : (const float*)xo;
                if (ph == 0) {
                    pg8::Gemm g{XB, (const bf16_t*)(ws + WS_WIN) + (size_t)layer * DIN * DM, CH_ROWS, DIN, DM}; pg8::StaticOrder S; S.init(CH_ROWS, DIN, c.G, c.cu);
                    pg8::EpiBf16S2 E{(bf16_t*)(ws + WS_PROJ), DIN, 1805u, QSCALE, S1};
#ifdef PROBE_G2
                    for (int rep_ = 0; rep_ < 2; ++rep_)
#endif
                    pg8::gemm_phase<pg8::EpiBf16S2, pg8::StaticOrder, true, true>(lds, g, S, E);
                    if (layer == 0 && ch > 0) {
                        const int nfull = (CH_ROWS / 256) * (DIN / 256) % c.G;
                        if (nfull > 0 && c.cu >= nfull) { float* xp = chunk_out(a, ch - 1); const int nw = (c.G - nfull) * 8;
                            for (int r = (c.cu - nfull) * 8 + c.wave; r < CH_ROWS; r += nw) rms_row_f32(xp + (size_t)r * DM, a.in[16], c.lane); }
                        else if (nfull == 0) ph_final_norm(c, chunk_out(a, ch - 1), a.in[16]);
                    }
                } else if (ph == 1) {
                    ph_attn(a, c, lds, ch, layer);
                } else if (ph == 2) {
                    ph_combine(a, c, layer);
                } else if (ph == 3) {
                    pg8::Gemm g{HB, (const bf16_t*)(ws + WS_WOUT) + (size_t)layer * DM * DM, CH_ROWS, DM, DM}; pg8::StaticOrder S; S.init(CH_ROWS, DM, c.G, c.cu);
                    pg8::EpiRes2 E{xsrc, xo, XB, S2, DM};
#ifdef PROBE_GE2
                    { pg8::EpiRes2 E0{xsrc, (float*)(ws + WS_PROJ), (bf16_t*)(ws + WS_PROJ + 72 * MiB), (float*)(ws + WS_PROJ + 110 * MiB), DM}; pg8::gemm_phase<pg8::EpiRes2, pg8::StaticOrder, true, true>(lds, g, S, E0); }
#endif
                    pg8::gemm_phase<pg8::EpiRes2, pg8::StaticOrder, true, true>(lds, g, S, E);
                } else if (ph == 4) {
                    pg8::Gemm g{XB - DM, (const bf16_t*)(ws + WS_WUP) + (size_t)layer * DUP * DM, 65 * 256, DUP, DM, 254}; pg8::StaticOrder S; S.init(65 * 256, DUP, c.G, c.cu);
                    pg8::EpiConv E{(bf16_t*)(ws + WS_TMP), S2, a.in[13] + (size_t)layer * 3 * DUP, a.in[14] + (size_t)layer * DUP, (ch == 0 ? 16384 : 4096) - 1, (LAS float*)(lds + 147456 + 256), CH_ROWS};
                    pg8::gemm_phase<pg8::EpiConv, pg8::StaticOrder, true, true>(lds, g, S, E);
                    { float* S1z = S1; for (int r = c.cu * NTHREADS + c.tid; r < CH_ROWS; r += c.G * NTHREADS) S1z[r] = 0.f; }
                    if (layer == DEPTH - 1 && ch + 1 < NCHUNK) {
                        const float* xin = chunk_in(a, ch + 1); bf16_t* XBn = (bf16_t*)(ws + WS_XB) + (size_t)(par ^ 1) * CH_ROWS * DM; float* S1n = (float*)(ws + WS_SSQ) + (par ^ 1) * CH_ROWS;
                        for (int r = c.gw; r < CH_ROWS; r += c.NGW) row_to_bf16_ssq(xin + (size_t)r * DM, XBn + (size_t)r * DM, S1n + r, c.lane);
                    }
                } else {
                    pg8::Gemm g{(const bf16_t*)(ws + WS_TMP), (const bf16_t*)(ws + WS_WDN) + (size_t)layer * DM * DFF, CH_ROWS, DM, DFF}; pg8::StaticOrder S; S.init(CH_ROWS, DM, c.G, c.cu);
                    pg8::EpiRes2 E{xo, xo, layer == DEPTH - 1 ? (bf16_t*)nullptr : XB, S1, DM};
#ifdef PROBE_GE2
                    { pg8::EpiRes2 E0{xo, (float*)(ws + WS_PROJ), (bf16_t*)(ws + WS_PROJ + 72 * MiB), (float*)(ws + WS_PROJ + 110 * MiB), DM}; pg8::gemm_phase<pg8::EpiRes2, pg8::StaticOrder, true, true>(lds, g, S, E0); }
#endif
                    pg8::gemm_phase<pg8::EpiRes2, pg8::StaticOrder, true, true>(lds, g, S, E);
                }
            }
        }
#ifdef PROBE_P2
        if (step == 0) grid.sync(); else xcd_barrier(xbar);
#else
        if (step == 0) grid.sync(); else if (step != NSTEPS - 1) xcd_barrier(xbar);
#endif
    }
#ifdef PROBE_TA
    if (blockIdx.x == 0 && threadIdx.x < 64) {
        float* xo = chunk_out(a, NCHUNK - 1);
        const float ua = (float)tA_ * 0.01f, ub = (float)tB_ * 0.01f;
        if (threadIdx.x == 0) xo[0] += 8.f + ua * 0.01f; else xo[4 * threadIdx.x] += sqrtf(ub * 0.01f);
    }
#endif
}

extern "C" void kernel_launch(void* const* d_in, const int* in_sizes, int n_in, void* d_out, int out_size, void* d_ws, size_t ws_size, hipStream_t stream) {
    static int grid = 0;
    if (grid == 0) {
        if (n_in != 17 || ws_size < WS_END) { fprintf(stderr, "kernel_launch: unexpected n_in %d / ws_size %zu (need %zu)\n", n_in, ws_size, (size_t)WS_END); grid = -1; return; }
        int dev = 0, cus = 0, per_cu = 0;
        (void)hipGetDevice(&dev); (void)hipDeviceGetAttribute(&cus, hipDeviceAttributeMultiprocessorCount, dev);
        if (hipFuncSetAttribute((const void*)mega_fwd, hipFuncAttributeMaxDynamicSharedMemorySize, LDS_BYTES) != hipSuccess) { fprintf(stderr, "hipFuncSetAttribute failed\n"); grid = -1; return; }
        if (hipOccupancyMaxActiveBlocksPerMultiprocessor(&per_cu, (const void*)mega_fwd, NTHREADS, LDS_BYTES) != hipSuccess || per_cu < 1) { fprintf(stderr, "occupancy query: %d\n", per_cu); per_cu = 1; }
        (void)hipGetLastError();
        grid = cus * 1;
    }
    if (grid < 0) return;
    (void)hipMemsetAsync((char*)d_ws + WS_CTL, 0, 65536, stream);
    Args a{};
    for (int i = 0; i < 17; ++i) a.in[i] = (const float*)d_in[i];
    a.out = (float*)d_out; a.ws = (unsigned char*)d_ws;
    void* args[] = {&a};
    hipError_t e = hipLaunchCooperativeKernel((const void*)mega_fwd, dim3(grid), dim3(NTHREADS), args, LDS_BYTES, stream);
    if (e != hipSuccess) fprintf(stderr, "cooperative launch failed: %s (grid %d)\n", hipGetErrorString(e), grid);
}
```

```cpp
#include <hip/hip_runtime.h>
#include <hip/hip_cooperative_groups.h>
#include <cstdio>
#include <cstdint>
#include <cmath>
namespace cg = cooperative_groups;
namespace pg8 {
#define PG8_LAS __attribute__((address_space(3)))
typedef unsigned short bf16_t;
typedef short bf16x8 __attribute__((ext_vector_type(8)));
typedef float f32x4 __attribute__((ext_vector_type(4)));
typedef unsigned u32x4 __attribute__((ext_vector_type(4)));
constexpr int BM = 256, BK = 64, HALF = 128, HTB = HALF * BK * 2  , STAGE_BYTES = 8 * HTB, NXCD = 8, WGM = 8;

__host__ __device__ __forceinline__ int lds_byte(int r, int c) { const int st = (r >> 4) * 2 + (c >> 5), rr = r & 15, cc = c & 31, ob = rr * 64 + cc * 2; return st * 1024 + (ob ^ (((ob >> 9) & 1) << 5)); }
__host__ __device__ __forceinline__ void stage_rc(int b, int& R, int& C) { const int st = b / 1024, sb = b % 1024, swz = sb ^ (((sb >> 9) & 1) << 5); R = (st >> 1) * 16 + swz / 64; C = (st & 1) * 32 + (swz % 64) / 2; }
__host__ __device__ __forceinline__ int perm32(int rho) { const int n = rho >> 4, i = rho & 15; return 8 * (i >> 2) + 4 * n + (i & 3); }

struct Unit { int pm, pn; };
struct Gemm { const bf16_t* A; const bf16_t* Bt; int M, N, K; int a_rows = 256; };

struct StaticOrder {
    int nM, nN, nwg, G, c;
    __host__ __device__ void init(int M, int N, int G_, int c_) { nM = M / BM; nN = N / BM; nwg = nM * nN; G = G_; c = c_; }
    __host__ __device__ bool next(int i, Unit& u) const {
        const long L = (long)i * G + c; if (L >= nwg) return false;
        int wgid = (int)L; { const int q = nwg / NXCD, r = nwg % NXCD, xcd = wgid % NXCD, off = wgid / NXCD; wgid = (xcd < r ? xcd * (q + 1) : r * (q + 1) + (xcd - r) * q) + off; }
        const int nig = WGM * nN, gid = wgid / nig, fm = gid * WGM, gsz = (nM - fm) < WGM ? (nM - fm) : WGM;
        u.pm = fm + ((wgid % nig) % gsz); u.pn = (wgid % nig) / gsz; return true;
    }
    __device__ __forceinline__ void a_ready(const Unit&) const {}
    __device__ __forceinline__ void done(const Unit&) const {}
};

__device__ __forceinline__ unsigned cvt_pk_bf16(float lo, float hi) { unsigned r; asm volatile("v_cvt_pk_bf16_f32 %0, %1, %2" : "=v"(r) : "v"(lo), "v"(hi)); return r; }
struct EpiBf16S {
    static constexpr bool PERM = true, AFTER_DRAIN = false;
    bf16_t* O; int ldc; unsigned scalemask; float sc;
    __device__ __forceinline__ void operator()(const f32x4 (&acc)[2][2][4][2], const Unit& u, int wr, int wc, int fr, int fq) const {
        const int row0 = u.pm * BM + wr * 64 + fr; const int col0 = u.pn * BM + wc * 32 + 8 * fq;
        const float s = ((scalemask >> u.pn) & 1u) ? sc : 1.f;
#pragma unroll
        for (int ai = 0; ai < 2; ++ai)
#pragma unroll
            for (int m = 0; m < 4; ++m) { bf16_t* rowp = O + (size_t)(row0 + ai * HALF + m * 16) * ldc + col0;
#pragma unroll
                for (int bj = 0; bj < 2; ++bj) { f32x4 v0 = acc[ai][bj][m][0] * s, v1 = acc[ai][bj][m][1] * s;
                    u32x4 w; w.x = cvt_pk_bf16(v0[0], v0[1]); w.y = cvt_pk_bf16(v0[2], v0[3]); w.z = cvt_pk_bf16(v1[0], v1[1]); w.w = cvt_pk_bf16(v1[2], v1[3]);
                    *(u32x4*)(rowp + bj * HALF) = w; } }
    }
};
struct EpiRes {
    static constexpr bool PERM = false, AFTER_DRAIN = false;
    const float* base; float* out; int ldc;
    __device__ __forceinline__ void operator()(const f32x4 (&acc)[2][2][4][2], const Unit& u, int wr, int wc, int fr, int fq) const {
        const int col0 = u.pn * BM + wc * 32 + 4 * fq;
#pragma unroll
        for (int ai = 0; ai < 2; ++ai)
#pragma unroll
            for (int m = 0; m < 4; ++m) { const size_t off = (size_t)(u.pm * BM + ai * HALF + wr * 64 + m * 16 + fr) * ldc + col0;
#pragma unroll
                for (int bj = 0; bj < 2; ++bj)
#pragma unroll
                    for (int n = 0; n < 2; ++n) { const f32x4 bs = *(const f32x4*)(base + off + bj * HALF + n * 16); *(f32x4*)(out + off + bj * HALF + n * 16) = bs + acc[ai][bj][m][n]; }
                asm volatile("" ::: "memory"); }
    }
};

struct EpiBf16S2 {
    static constexpr bool PERM = true, AFTER_DRAIN = false;
    bf16_t* O; int ldc; unsigned scalemask; float sc; const float* ssq;
    __device__ __forceinline__ void operator()(const f32x4 (&acc)[2][2][4][2], const Unit& u, int wr, int wc, int fr, int fq) const {
        const int row0 = u.pm * BM + wr * 64 + fr; const int col0 = u.pn * BM + wc * 32 + 8 * fq;
        const float s = ((scalemask >> u.pn) & 1u) ? sc : 1.f;
#pragma unroll
        for (int ai = 0; ai < 2; ++ai)
#pragma unroll
            for (int m = 0; m < 4; ++m) { const int row = row0 + ai * HALF + m * 16; bf16_t* rowp = O + (size_t)row * ldc + col0;
                const float rs = s / sqrtf(ssq[row] * (1.f / 1024.f) + 1e-6f);
#pragma unroll
                for (int bj = 0; bj < 2; ++bj) { f32x4 v0 = acc[ai][bj][m][0] * rs, v1 = acc[ai][bj][m][1] * rs;
                    u32x4 w; w.x = cvt_pk_bf16(v0[0], v0[1]); w.y = cvt_pk_bf16(v0[2], v0[3]); w.z = cvt_pk_bf16(v1[0], v1[1]); w.w = cvt_pk_bf16(v1[2], v1[3]);
                    *(u32x4*)(rowp + bj * HALF) = w; } }
    }
};
typedef unsigned u32x2e __attribute__((ext_vector_type(2)));
struct EpiRes2 {
    static constexpr bool PERM = true, AFTER_DRAIN = false;
    const float* base; float* out; bf16_t* xb; float* ssq; int ldc;
    __device__ __forceinline__ void operator()(const f32x4 (&acc)[2][2][4][2], const Unit& u, int wr, int wc, int fr, int fq) const {
        const int col0 = u.pn * BM + wc * 32 + 8 * fq;
#pragma unroll
        for (int ai = 0; ai < 2; ++ai)
#pragma unroll
            for (int m = 0; m < 4; ++m) { const int row = u.pm * BM + ai * HALF + wr * 64 + m * 16 + fr; const size_t off = (size_t)row * ldc + col0; float ps = 0.f;
#pragma unroll
                for (int bj = 0; bj < 2; ++bj) {
                    const f32x4 b0 = *(const f32x4*)(base + off + bj * HALF), b1 = *(const f32x4*)(base + off + bj * HALF + 4);
                    const f32x4 v0 = b0 + acc[ai][bj][m][0], v1 = b1 + acc[ai][bj][m][1];
                    *(f32x4*)(out + off + bj * HALF) = v0; *(f32x4*)(out + off + bj * HALF + 4) = v1;
                    if (xb != nullptr) { ps += ((v0[0] * v0[0] + v0[1] * v0[1]) + (v0[2] * v0[2] + v0[3] * v0[3])) + ((v1[0] * v1[0] + v1[1] * v1[1]) + (v1[2] * v1[2] + v1[3] * v1[3]));
                        u32x4 w; w.x = cvt_pk_bf16(v0[0], v0[1]); w.y = cvt_pk_bf16(v0[2], v0[3]); w.z = cvt_pk_bf16(v1[0], v1[1]); w.w = cvt_pk_bf16(v1[2], v1[3]); *(u32x4*)(xb + off + bj * HALF) = w; } }
                if (xb != nullptr) { ps += __shfl_xor(ps, 16); ps += __shfl_xor(ps, 32);
                    if (fq == 0) atomicAdd(ssq + row, ps); }
                asm volatile("" ::: "memory"); }
    }
};

struct EpiNull {
    static constexpr bool PERM = false, AFTER_DRAIN = false;
    __device__ __forceinline__ void operator()(const f32x4 (&acc)[2][2][4][2], const Unit& u, int wr, int wc, int fr, int fq) const {
#pragma unroll
        for (int ai = 0; ai < 2; ++ai)
#pragma unroll
            for (int bj = 0; bj < 2; ++bj)
#pragma unroll
                for (int m = 0; m < 4; ++m)
#pragma unroll
                    for (int n = 0; n < 2; ++n) asm volatile("" :: "v"(acc[ai][bj][m][n]));
    }
};

#define PG8_DPP(old, src, ctrl) __builtin_bit_cast(float, __builtin_amdgcn_update_dpp(__builtin_bit_cast(int, (float)(old)), __builtin_bit_cast(int, (float)(src)), (ctrl), 0xF, 0xF, false))
struct EpiConv {
    static constexpr bool PERM = true, AFTER_DRAIN = false;
    bf16_t* G; const float* ssq; const float* cw; const float* cb; int slmask; PG8_LAS float* xch; int nrows;
    __device__ __forceinline__ void operator()(f32x4 (&acc)[2][2][4][2], const Unit& u, int wr, int wc, int fr, int fq) const {
        const int t0 = 254 * u.pm - 1 + wr * 64 + fr;
#pragma unroll
        for (int ai = 0; ai < 2; ++ai)
#pragma unroll
            for (int m = 0; m < 4; ++m) { int t = t0 + ai * HALF + m * 16; t = t < 0 ? 0 : (t > nrows - 1 ? nrows - 1 : t);
                const float rs = 1.f / sqrtf(ssq[t] * (1.f / 1024.f) + 1e-6f);
#pragma unroll
                for (int bj = 0; bj < 2; ++bj)
#pragma unroll
                    for (int n = 0; n < 2; ++n) acc[ai][bj][m][n] *= rs; }
        if (fr == 0 || fr == 15) { const int which = fr == 0 ? 0 : 1, m = fr == 0 ? 0 : 3;
#pragma unroll
            for (int ai = 0; ai < 2; ++ai) { PG8_LAS float* d = xch + ((((2 * ai + wr) * 2 + which) * 4 + wc) * 4 + fq) * 16;
#pragma unroll
                for (int bj = 0; bj < 2; ++bj)
#pragma unroll
                    for (int n = 0; n < 2; ++n) *(PG8_LAS f32x4*)(d + bj * 8 + n * 4) = fr == 0 ? acc[ai][bj][0][n] : acc[ai][bj][3][n]; }
            (void)m; }
        asm volatile("s_waitcnt lgkmcnt(0)" ::: "memory"); __builtin_amdgcn_s_barrier(); asm volatile("" ::: "memory");
        const int ch0 = u.pn * 128 + wc * 32 + 8 * fq;
#pragma unroll
        for (int n = 0; n < 2; ++n) {
            const int chn = ch0 + 4 * n;
            const f32x4 wg0 = *(const f32x4*)(cw + chn), wg1 = *(const f32x4*)(cw + 5632 + chn), wg2 = *(const f32x4*)(cw + 2 * 5632 + chn), bgv = *(const f32x4*)(cb + chn);
            const f32x4 wv0 = *(const f32x4*)(cw + 2816 + chn), wv1 = *(const f32x4*)(cw + 5632 + 2816 + chn), wv2 = *(const f32x4*)(cw + 2 * 5632 + 2816 + chn), bvv = *(const f32x4*)(cb + 2816 + chn);
#pragma unroll
            for (int ai = 0; ai < 2; ++ai)
#pragma unroll
                for (int m = 0; m < 4; ++m) {
                    const int lr = ai * HALF + wr * 64 + m * 16 + fr, t = 254 * u.pm - 1 + lr;
                    const int gidx = 2 * ai + wr;
                    f32x4 pv[2], nx[2];
#pragma unroll
                    for (int bj = 0; bj < 2; ++bj) {
                        f32x4 upo, dno;
                        if (m > 0) { const f32x4 s = acc[ai][bj][m - 1][n];
#pragma unroll
                            for (int j = 0; j < 4; ++j) upo[j] = PG8_DPP(0.f, s[j], 0x121); }
                        else upo = gidx > 0 ? *(const PG8_LAS f32x4*)(xch + ((((gidx - 1) * 2 + 1) * 4 + wc) * 4 + fq) * 16 + bj * 8 + n * 4) : (f32x4){0.f, 0.f, 0.f, 0.f};
                        if (m < 3) { const f32x4 s = acc[ai][bj][m + 1][n];
#pragma unroll
                            for (int j = 0; j < 4; ++j) dno[j] = PG8_DPP(0.f, s[j], 0x12F); }
                        else dno = gidx < 3 ? *(const PG8_LAS f32x4*)(xch + ((((gidx + 1) * 2 + 0) * 4 + wc) * 4 + fq) * 16 + bj * 8 + n * 4) : (f32x4){0.f, 0.f, 0.f, 0.f};
                        const f32x4 cur = acc[ai][bj][m][n];
#pragma unroll
                        for (int j = 0; j < 4; ++j) { pv[bj][j] = PG8_DPP(upo[j], cur[j], 0x111);
                                                       nx[bj][j] = PG8_DPP(dno[j], cur[j], 0x101); }
                    }
                    const bool sfirst = (t & slmask) == 0, slast = (t & slmask) == slmask;
                    float res[4];
#pragma unroll
                    for (int j = 0; j < 4; ++j) {
                        const float gp = sfirst ? 0.f : pv[0][j], gn = slast ? 0.f : nx[0][j], vp = sfirst ? 0.f : pv[1][j], vn = slast ? 0.f : nx[1][j];
                        const float gate = gp * wg0[j] + acc[ai][0][m][n][j] * wg1[j] + gn * wg2[j] + bgv[j];
                        const float val = vp * wv0[j] + acc[ai][1][m][n][j] * wv1[j] + vn * wv2[j] + bvv[j];
                        res[j] = gate * __builtin_amdgcn_rcpf(1.f + __builtin_amdgcn_exp2f(-1.4426950408889634f * gate)) * val;
                    }
                    if (lr >= 1 && lr <= 254 && t < nrows) { u32x2e w; w.x = cvt_pk_bf16(res[0], res[1]); w.y = cvt_pk_bf16(res[2], res[3]); *(u32x2e*)(G + (size_t)t * 2816 + chn) = w; }
                }
        }
    }
};
template <class Epi, class Sched, bool ALIGN_EPI = false, bool SP2 = false>
__device__ __forceinline__ void gemm_phase(PG8_LAS unsigned char* lds, const Gemm g, const Sched& S, const Epi& E) {
    int tid_l = threadIdx.x; asm volatile("" : "+v"(tid_l)); const int tid = tid_l, wid = __builtin_amdgcn_readfirstlane(tid >> 6), lane = tid & 63, wr = wid >> 2, wc = wid & 3, fr = lane & 15, fq = lane >> 4;
    const int K = g.K, nt = K / BK;
    unsigned voffA[2], voffB[2];
#pragma unroll
    for (int i = 0; i < 2; ++i) { int R, C; stage_rc(tid * 16 + i * 8192, R, C); const int Rb = Epi::PERM ? ((R & ~31) + perm32(R & 31)) : R;
        voffA[i] = (unsigned)(R * K + C) * 2u; voffB[i] = (unsigned)(Rb * K + C) * 2u; }
    const size_t kstep = (size_t)(BK * 2);
    const size_t hstep = (size_t)HALF * K * 2;
    const size_t tstep = 2 * hstep; const size_t tstepA = (size_t)g.a_rows * K * 2;
    const unsigned ldsw = (unsigned)wid * 1024u;
    const int aoff = lds_byte(wr * 64 + fr, fq * 8), boff = lds_byte(wc * 32 + fr, fq * 8);
#define PG8_SA(b, h) (((b) * 2 + (h)) * HTB)
#define PG8_SB(b, h) ((4 + (b) * 2 + (h)) * HTB)
#define PG8_STAGE(bufoff, gbase, voff) do { _Pragma("unroll") for (int _i = 0; _i < 2; ++_i) \
        __builtin_amdgcn_global_load_lds((const unsigned*)((const char*)(gbase) + (voff)[_i]), (PG8_LAS unsigned*)(lds + (bufoff) + ldsw + _i * 8192), 16, 0, 0); } while (0)
#define PG8_LDA(dst, b, h) do { _Pragma("unroll") for (int m = 0; m < 4; ++m) _Pragma("unroll") for (int k = 0; k < 2; ++k) dst[m][k] = *(const PG8_LAS bf16x8*)(lds + PG8_SA(b, h) + aoff + m * 2048 + k * 1024); } while (0)
#define PG8_LDB(dst, b, h) do { _Pragma("unroll") for (int n = 0; n < 2; ++n) _Pragma("unroll") for (int k = 0; k < 2; ++k) dst[n][k] = *(const PG8_LAS bf16x8*)(lds + PG8_SB(b, h) + boff + n * 2048 + k * 1024); } while (0)
#define PG8_MMA(ai, bj, At, Bt) do { __builtin_amdgcn_s_setprio(1); _Pragma("unroll") for (int m = 0; m < 4; ++m) _Pragma("unroll") for (int n = 0; n < 2; ++n) _Pragma("unroll") for (int k = 0; k < 2; ++k) \
        acc[ai][bj][m][n] = __builtin_amdgcn_mfma_f32_16x16x32_bf16(Bt[n][k], At[m][k], acc[ai][bj][m][n], 0, 0, 0); __builtin_amdgcn_s_setprio(0); } while (0)
#define PG8_WAIT_V(n) asm volatile("s_waitcnt vmcnt(" #n ")" ::: "memory")
#define PG8_WAIT_L(n) asm volatile("s_waitcnt lgkmcnt(" #n ")" ::: "memory")
#define PG8_BAR __builtin_amdgcn_s_barrier()
#define PG8_SCHED __builtin_amdgcn_sched_barrier(0)
    Unit cur, nxt; int ui = 0;
    if (!S.next(0, cur)) return;
    f32x4 acc[2][2][4][2];
#pragma unroll
    for (int a = 0; a < 2; ++a)
#pragma unroll
        for (int b = 0; b < 2; ++b)
#pragma unroll
            for (int m = 0; m < 4; ++m)
#pragma unroll
                for (int n = 0; n < 2; ++n) acc[a][b][m][n] = (f32x4){0.f, 0.f, 0.f, 0.f};
    bf16x8 At[4][2], B0[2][2], B1[2][2];
    const char* cA = (const char*)g.A + (size_t)cur.pm * tstepA; const char* cB = (const char*)g.Bt + (size_t)cur.pn * tstep;
    S.a_ready(cur);
    if constexpr (SP2) {
        PG8_STAGE(PG8_SB(0, 0), cB, voffB); PG8_STAGE(PG8_SB(0, 1), cB + hstep, voffB); PG8_STAGE(PG8_SA(0, 0), cA, voffA); PG8_STAGE(PG8_SA(0, 1), cA + hstep, voffA);
        if (wr == 1) PG8_BAR;
        PG8_WAIT_V(2); PG8_BAR;
        PG8_STAGE(PG8_SB(1, 0), cB + kstep, voffB); PG8_STAGE(PG8_SA(1, 0), cA + kstep, voffA); PG8_STAGE(PG8_SB(1, 1), cB + hstep + kstep, voffB);
        PG8_WAIT_V(6); PG8_BAR;
    } else {
        PG8_STAGE(PG8_SB(0, 0), cB, voffB); PG8_STAGE(PG8_SA(0, 0), cA, voffA); PG8_STAGE(PG8_SB(0, 1), cB + hstep, voffB); PG8_STAGE(PG8_SA(0, 1), cA + hstep, voffA);
        if (wr == 1) PG8_BAR;
        PG8_WAIT_V(4); PG8_BAR;
        PG8_STAGE(PG8_SB(1, 0), cB + kstep, voffB); PG8_STAGE(PG8_SA(1, 0), cA + kstep, voffA); PG8_STAGE(PG8_SB(1, 1), cB + hstep + kstep, voffB);
        PG8_WAIT_V(6); PG8_BAR;
    }
    for (;;) {
        const bool has_next = S.next(ui + 1, nxt);
        const char* nA = has_next ? (const char*)g.A + (size_t)nxt.pm * tstepA : cA; const char* nB = has_next ? (const char*)g.Bt + (size_t)nxt.pn * tstep : cB;
        for (int t = 0; t < nt; t += 2) {
            const bool last = (t == nt - 2);
            const char* a1 = cA + (size_t)(t + 1) * kstep;
            const char* a2 = last ? nA : cA + (size_t)(t + 2) * kstep; const char* b2 = last ? nB : cB + (size_t)(t + 2) * kstep;
            const char* a3 = a2 + kstep; const char* b3 = b2 + kstep;
            if (last && has_next) S.a_ready(nxt);
            if constexpr (SP2) {
            PG8_LDB(B0, 0, 0); PG8_LDB(B1, 0, 1); PG8_SCHED; PG8_LDA(At, 0, 0); PG8_STAGE(PG8_SA(1, 1), a1 + hstep, voffA);
            PG8_WAIT_V(8); PG8_WAIT_L(0); PG8_BAR; PG8_MMA(0, 0, At, B0); PG8_MMA(0, 1, At, B1); PG8_BAR; PG8_SCHED;
            PG8_LDA(At, 0, 1); PG8_STAGE(PG8_SB(0, 0), b2, voffB); PG8_STAGE(PG8_SB(0, 1), b2 + hstep, voffB); PG8_STAGE(PG8_SA(0, 0), a2, voffA);
            PG8_WAIT_V(8); PG8_WAIT_L(0); PG8_BAR; PG8_MMA(1, 0, At, B0); PG8_MMA(1, 1, At, B1); PG8_BAR; PG8_SCHED;
            PG8_LDB(B0, 1, 0); PG8_LDB(B1, 1, 1); PG8_SCHED; PG8_LDA(At, 1, 0); PG8_STAGE(PG8_SA(0, 1), a2 + hstep, voffA);
            PG8_WAIT_V(8); PG8_WAIT_L(0); PG8_BAR; PG8_MMA(0, 0, At, B0); PG8_MMA(0, 1, At, B1); PG8_BAR; PG8_SCHED;
            PG8_LDA(At, 1, 1); PG8_STAGE(PG8_SB(1, 0), b3, voffB); PG8_STAGE(PG8_SB(1, 1), b3 + hstep, voffB); PG8_STAGE(PG8_SA(1, 0), a3, voffA);
            PG8_WAIT_V(8); PG8_WAIT_L(0); PG8_BAR; PG8_MMA(1, 0, At, B0); PG8_MMA(1, 1, At, B1); PG8_BAR; PG8_SCHED;
            } else {
            PG8_LDB(B0, 0, 0); PG8_SCHED; PG8_LDA(At, 0, 0); PG8_STAGE(PG8_SA(1, 1), a1 + hstep, voffA);
            PG8_WAIT_L(8); PG8_BAR; PG8_WAIT_L(0); PG8_MMA(0, 0, At, B0); PG8_BAR; PG8_SCHED;
            PG8_LDB(B1, 0, 1); PG8_STAGE(PG8_SB(0, 0), b2, voffB);
            PG8_BAR; PG8_WAIT_L(0); PG8_MMA(0, 1, At, B1); PG8_BAR;
            PG8_LDA(At, 0, 1); PG8_STAGE(PG8_SA(0, 0), a2, voffA);
            PG8_BAR; PG8_WAIT_L(0); PG8_MMA(1, 0, At, B0); PG8_BAR; PG8_SCHED;
            PG8_STAGE(PG8_SB(0, 1), b2 + hstep, voffB);
            PG8_WAIT_V(6); PG8_BAR; PG8_MMA(1, 1, At, B1); PG8_BAR;
            PG8_LDB(B0, 1, 0); PG8_SCHED; PG8_LDA(At, 1, 0); PG8_STAGE(PG8_SA(0, 1), a2 + hstep, voffA);
            PG8_WAIT_L(8); PG8_BAR; PG8_WAIT_L(0); PG8_MMA(0, 0, At, B0); PG8_BAR; PG8_SCHED;
            PG8_LDB(B1, 1, 1); PG8_STAGE(PG8_SB(1, 0), b3, voffB);
            PG8_BAR; PG8_WAIT_L(0); PG8_MMA(0, 1, At, B1); PG8_BAR;
            PG8_LDA(At, 1, 1); PG8_STAGE(PG8_SA(1, 0), a3, voffA);
            PG8_BAR; PG8_WAIT_L(0); PG8_MMA(1, 0, At, B0); PG8_BAR; PG8_SCHED;
            PG8_STAGE(PG8_SB(1, 1), b3 + hstep, voffB);
            PG8_WAIT_V(6); PG8_BAR; PG8_MMA(1, 1, At, B1); PG8_BAR;
            }
        }
        if constexpr (ALIGN_EPI) { if (wr == 0) PG8_BAR; }
        if constexpr (!Epi::AFTER_DRAIN) { E(acc, cur, wr, wc, fr, fq); S.done(cur); }
        if (!has_next) break;
#pragma unroll
        for (int a = 0; a < 2; ++a)
#pragma unroll
            for (int b = 0; b < 2; ++b)
#pragma unroll
                for (int m = 0; m < 4; ++m)
#pragma unroll
                    for (int n = 0; n < 2; ++n) acc[a][b][m][n] = (f32x4){0.f, 0.f, 0.f, 0.f};
        cur = nxt; cA = nA; cB = nB; ++ui;
        if constexpr (ALIGN_EPI) { if (wr == 1) PG8_BAR; }
    }
    PG8_WAIT_V(0);
    if constexpr (!ALIGN_EPI) { if (wr == 0) PG8_BAR; }
    PG8_BAR;
    if constexpr (Epi::AFTER_DRAIN) { E.fused(acc, cur, wr, wc, fr, fq, lds, wid, lane); S.done(cur); }
#undef PG8_SA
#undef PG8_SB
#undef PG8_STAGE
#undef PG8_LDA
#undef PG8_LDB
#undef PG8_MMA
#undef PG8_WAIT_V
#undef PG8_WAIT_L
#undef PG8_BAR
#undef PG8_SCHED
}
}
typedef __bf16 bf16x2_t __attribute__((ext_vector_type(2)));
__device__ __forceinline__ unsigned cvt_pk(float lo, float hi) { float __attribute__((ext_vector_type(2))) v = {lo, hi}; bf16x2_t b = __builtin_convertvector(v, bf16x2_t); return __builtin_bit_cast(unsigned, b); }
#define LAS __attribute__((address_space(3)))
#define XB_TMO      128
#define XB_XCNT(j)  (256  + 64 * (j))
#define XB_XSUB(j)  (1280 + 64 * (j))
#define XB_XGEN(j)  (2304 + 64 * (j))
#define XB_TOP      3328
#define XB_TOPGEN   3392
#define XCD_BAR_WORDS 3456
#define XB_SPIN_CAP (1u << 18)

__device__ __forceinline__ unsigned xb_ld(unsigned* p)              { return __hip_atomic_load(p, __ATOMIC_RELAXED, __HIP_MEMORY_SCOPE_AGENT); }
__device__ __forceinline__ unsigned xb_add(unsigned* p, unsigned v) { return __hip_atomic_fetch_add(p, v, __ATOMIC_RELAXED, __HIP_MEMORY_SCOPE_AGENT); }
__device__ __forceinline__ unsigned xb_xcc_id() { return (unsigned)__builtin_amdgcn_s_getreg((3 << 11) | 20) & 0xFu; }
#define XB_SPIN(cond, bar) do { unsigned _sp = 0; while (cond) { __builtin_amdgcn_s_sleep(1); \
    if ((++_sp & 255u) == 0u) { if (xb_ld(&(bar)[XB_TMO])) break; if (_sp > XB_SPIN_CAP) { atomicAdd(&(bar)[XB_TMO], 1u); break; } } } } while (0)

struct XcdBarrier {
    unsigned* bar; unsigned x;
    volatile LAS unsigned* st;
};

__device__ __forceinline__ XcdBarrier xcd_barrier_post(unsigned* bar, volatile LAS unsigned* st) {
    XcdBarrier b; b.bar = bar; b.x = xb_xcc_id(); b.st = st;
    if (threadIdx.x == 0) (void)xb_add(&bar[XB_XCNT(b.x)], 1u);
    return b;
}
__device__ __forceinline__ void xcd_barrier_complete(unsigned* bar, unsigned x, unsigned& nloc, unsigned& nx) {
    const unsigned G = gridDim.x * gridDim.y * gridDim.z;
    unsigned sum, cnt, mine, sp = 0u;
    for (;;) {
        sum = 0u; cnt = 0u; mine = 0u;
#pragma unroll
        for (unsigned j = 0; j < 16; ++j) { const unsigned c = xb_ld(&bar[XB_XCNT(j)]); sum += c; cnt += (c > 0u) ? 1u : 0u; mine = (j == x) ? c : mine; }
        if (sum == G) break;
        __builtin_amdgcn_s_sleep(1);
        if ((++sp & 255u) == 0u) { if (xb_ld(&bar[XB_TMO])) break; if (sp > XB_SPIN_CAP) { atomicAdd(&bar[XB_TMO], 1u); break; } }
    }
    nloc = mine > 0u ? mine : 1u; nx = cnt > 0u ? cnt : 1u;
}

__device__ __forceinline__ void xcd_barrier(const XcdBarrier& b) {
    asm volatile("s_waitcnt vmcnt(0)" ::: "memory");
    __syncthreads();
    if (threadIdx.x == 0) {
        unsigned* bar = b.bar;
        __builtin_amdgcn_s_waitcnt(0);
        unsigned nloc = b.st[0], nx = b.st[1];
        if (nloc == 0u) { xcd_barrier_complete(bar, b.x, nloc, nx); b.st[0] = nloc; b.st[1] = nx; }
        const unsigned old = xb_add(&bar[XB_XSUB(b.x)], 1u);
        const unsigned gen = old / nloc;
        if (old + 1u == (gen + 1u) * nloc) {
            __builtin_amdgcn_fence(__ATOMIC_RELEASE, "agent");
            asm volatile("s_waitcnt vmcnt(0)" ::: "memory");
            const unsigned og = xb_add(&bar[XB_TOP], 1u);
            const unsigned tg = og / nx;
            if (og + 1u == (tg + 1u) * nx) xb_add(&bar[XB_TOPGEN], 1u);
            else XB_SPIN(xb_ld(&bar[XB_TOPGEN]) == tg, bar);
            __builtin_amdgcn_fence(__ATOMIC_ACQUIRE, "agent");
            xb_add(&bar[XB_XGEN(b.x)], 1u);
            asm volatile("s_waitcnt vmcnt(0)" ::: "memory");
        } else {
            XB_SPIN(xb_ld(&bar[XB_XGEN(b.x)]) == gen, bar);
            __builtin_amdgcn_fence(__ATOMIC_ACQUIRE, "agent");
            asm volatile("s_waitcnt vmcnt(0)" ::: "memory");
        }
    }
    __syncthreads();
}
typedef unsigned short bf16_t;
typedef short bf16x8 __attribute__((ext_vector_type(8)));
typedef short s16x4 __attribute__((ext_vector_type(4)));
typedef float f32x16 __attribute__((ext_vector_type(16)));
typedef float f32x4 __attribute__((ext_vector_type(4)));
typedef float f32x2 __attribute__((ext_vector_type(2)));
typedef unsigned u32x4 __attribute__((ext_vector_type(4)));
typedef unsigned u32x2 __attribute__((ext_vector_type(2)));

constexpr int DM = 1024, DIN = 4352, DFF = 2816, DUP = 2 * DFF, DEPTH = 2;
constexpr int CH_ROWS = 16384, NCHUNK = 3;
constexpr int TW = 784;
constexpr int T_C = 0, T_L = 768;
constexpr float LOG2E = 1.4426950408889634f, LN2 = 0.6931471805599453f;
constexpr float QSCALE = 0.125f * LOG2E;
constexpr size_t MiB = 1u << 20;
constexpr size_t WS_WIN = 0, WS_WOUT = 18 * MiB, WS_WUP = 22 * MiB, WS_WDN = 44 * MiB, WS_HB = 56 * MiB, WS_PROJ = 88 * MiB, WS_TMP = 264 * MiB, WS_CTL = 394 * MiB, WS_XB = 395 * MiB, WS_SSQ = 459 * MiB, WS_END = 460 * MiB;
constexpr int LDS_BYTES = 147456 + 256 + 8192;
constexpr int NTHREADS = 512;

struct Args { const float* in[17]; float* out; unsigned char* ws; };

__device__ __forceinline__ float wave_sum(float v) {
#pragma unroll
    for (int o = 1; o < 64; o <<= 1) v += __shfl_xor(v, o);
    return v;
}
__device__ __forceinline__ unsigned f2bf(float f) { unsigned u = __builtin_bit_cast(unsigned, f); return (u + 0x7fffu + ((u >> 16) & 1u)) >> 16; }
__device__ __forceinline__ unsigned pk2(float lo, float hi) { return f2bf(lo) | (f2bf(hi) << 16); }
__device__ __forceinline__ float bf2f(unsigned short b) { return __builtin_bit_cast(float, (unsigned)b << 16); }

__device__ __forceinline__ void transpose_item(const float* W, int K, int N, bf16_t* WT, LAS float* scr, int item, int lane, const float* gain, bool gate_perm = false) {
    const int nblk = N / 32, kb = item / nblk, nb = item % nblk, k0 = 64 * kb, n0 = 32 * nb;
#pragma unroll 8
    for (int i = 0; i < 32; ++i) { const int kk = 2 * i + (lane >> 5); scr[kk * 33 + (lane & 31)] = W[(size_t)(k0 + kk) * N + n0 + (lane & 31)] * (gain ? gain[k0 + kk] : 1.f); }
    asm volatile("s_waitcnt lgkmcnt(0)" ::: "memory");
    const int c = lane & 7;
    const int half_ = N / 2, v_ = n0 >= half_ ? n0 - half_ : n0, d0 = gate_perm ? 256 * (v_ / 128) + (n0 >= half_ ? 128 : 0) + (v_ % 128) : n0;
#pragma unroll
    for (int j = 0; j < 4; ++j) { const int n = (lane >> 3) + 8 * j; const LAS float* s = scr + (8 * c) * 33 + n;
        u32x4 o; o.x = pk2(s[0 * 33], s[1 * 33]); o.y = pk2(s[2 * 33], s[3 * 33]); o.z = pk2(s[4 * 33], s[5 * 33]); o.w = pk2(s[6 * 33], s[7 * 33]);
        *(u32x4*)(WT + (size_t)(d0 + n) * K + k0 + 8 * c) = o; }
    asm volatile("s_waitcnt lgkmcnt(0)" ::: "memory");
}

__device__ __forceinline__ void rms_row_to_bf16(const float* xrow, const float* gain, bf16_t* orow, int lane) {
    const f32x4* xr = (const f32x4*)xrow + lane; const f32x4* gr = (const f32x4*)gain + lane;
    f32x4 v[4]; float s = 0.f;
#pragma unroll
    for (int j = 0; j < 4; ++j) { v[j] = xr[64 * j]; s += (v[j].x * v[j].x + v[j].y * v[j].y) + (v[j].z * v[j].z + v[j].w * v[j].w); }
    const float rstd = 1.f / sqrtf(wave_sum(s) * (1.f / DM) + 1e-6f);
    u32x2* o8 = (u32x2*)orow + lane;
#pragma unroll
    for (int j = 0; j < 4; ++j) { const f32x4 g = gr[64 * j]; u32x2 w; w.x = pk2(v[j].x * rstd * g.x, v[j].y * rstd * g.y); w.y = pk2(v[j].z * rstd * g.z, v[j].w * rstd * g.w); o8[64 * j] = w; }
}
__device__ __forceinline__ void rms_row_f32(float* xrow, const float* gain, int lane) {
    f32x4* xr = (f32x4*)xrow + lane; const f32x4* gr = (const f32x4*)gain + lane;
    f32x4 v[4]; float s = 0.f;
#pragma unroll
    for (int j = 0; j < 4; ++j) { v[j] = xr[64 * j]; s += (v[j].x * v[j].x + v[j].y * v[j].y) + (v[j].z * v[j].z + v[j].w * v[j].w); }
    const float rstd = 1.f / sqrtf(wave_sum(s) * (1.f / DM) + 1e-6f);
#pragma unroll
    for (int j = 0; j < 4; ++j) { const f32x4 g = gr[64 * j]; xr[64 * j] = v[j] * rstd * g; }
}

constexpr int KSTR = 144;
constexpr int ATT_K_OFF = 0, ATT_V_OFF = 2 * 64 * KSTR, ATT_SCR_OFF = ATT_V_OFF + 2 * 64 * 320;
__device__ __forceinline__ int crow(int r, int hi) { return (r & 3) + 8 * (r >> 2) + 4 * hi; }
typedef short v4i16_t __attribute__((ext_vector_type(4)));
__device__ __forceinline__ s16x4 vtr(const LAS unsigned char* p) { return __builtin_bit_cast(s16x4, __builtin_amdgcn_ds_read_tr16_b64_v4i16((LAS v4i16_t*)p)); }

template <int VD, bool WIN>
__device__ __forceinline__ void attn_unit(LAS unsigned char* lds, const bf16_t* Qp, const bf16_t* Kp, const bf16_t* Vp, size_t pitch,
                                          int q0, int L, float slope2, int W, float m_init, float l_init,
                                          float* Oout, size_t opitch, float* lse_out, size_t lpitch, bf16_t* Obf) {
    constexpr int VSTR = VD * 2 + 64, ND = VD / 32, VCH = VD / 8, VLD = 64 * VCH / NTHREADS;
    int tid_l = threadIdx.x; asm volatile("" : "+v"(tid_l)); const int tid = tid_l, lane = tid & 63, r32 = lane & 31, hi = lane >> 5, wid = __builtin_amdgcn_readfirstlane(tid >> 6);
    const int qw = q0 + wid * 32;
    int tlo = 0, thi = L / 64;
    if (WIN) { const int a = q0 - W; tlo = a > 0 ? a / 64 : 0; const int b = q0 + 256 + W; thi = (b < L ? b : L) / 64; }
    bf16x8 qr[4];
    { const bf16_t* qrow = Qp + (size_t)(qw + r32) * pitch + hi * 8;
#pragma unroll
      for (int d0 = 0; d0 < 4; ++d0) qr[d0] = *(const bf16x8*)(qrow + d0 * 16); }
    f32x16 o[ND];
#pragma unroll
    for (int d = 0; d < ND; ++d)
#pragma unroll
        for (int r = 0; r < 16; ++r) o[d][r] = 0.f;
    float m = m_init, l = hi == 0 ? l_init : 0.f;
    LAS float* wsf = (LAS float*)(lds + 6 * (64 * KSTR + 64 * (VD * 2 + 64))) + wid * 64;
    static_assert(VD == 64, "grouped staging is sized for 64-wide values");
    constexpr int SLOT = 64 * KSTR + 64 * VSTR, GRP = 6;
    const int krow = tid >> 3, kch = tid & 7;
    const float Wf = (float)W;
    for (int g0 = tlo; g0 < thi; g0 += GRP) {
        const int ng = thi - g0 < GRP ? thi - g0 : GRP;
        u32x4 kr[GRP], vr[GRP];
#pragma unroll
        for (int j = 0; j < GRP; ++j) if (j < ng) { kr[j] = *(const u32x4*)(Kp + (size_t)(64 * (g0 + j) + krow) * pitch + kch * 8); vr[j] = *(const u32x4*)(Vp + (size_t)(64 * (g0 + j) + krow) * pitch + kch * 8); }
        if (g0 != tlo) __syncthreads();
#pragma unroll
        for (int j = 0; j < GRP; ++j) if (j < ng) { *(LAS u32x4*)(lds + j * SLOT + krow * KSTR + kch * 16) = kr[j]; *(LAS u32x4*)(lds + j * SLOT + 64 * KSTR + krow * VSTR + kch * 16) = vr[j]; }
        __syncthreads();
      for (int j = 0; j < ng; ++j) {
        const int t = g0 + j;
        bool active = true;
        if (WIN) { const int kb = 64 * t; active = (kb + 63 >= qw - W) && (kb <= qw + 31 + W); }
        if (active) {
            const LAS unsigned char* Kb = lds + j * SLOT + r32 * KSTR + hi * 16;
            f32x16 p0, p1;
#pragma unroll
            for (int r = 0; r < 16; ++r) { p0[r] = 0.f; p1[r] = 0.f; }
#pragma unroll
            for (int d0 = 0; d0 < 4; ++d0) {
                const bf16x8 a0 = *(const LAS bf16x8*)(Kb + d0 * 32), a1 = *(const LAS bf16x8*)(Kb + 32 * KSTR + d0 * 32);
                p0 = __builtin_amdgcn_mfma_f32_32x32x16_bf16(a0, qr[d0], p0, 0, 0, 0);
                p1 = __builtin_amdgcn_mfma_f32_32x32x16_bf16(a1, qr[d0], p1, 0, 0, 0);
                if (d0 & 1) __builtin_amdgcn_sched_barrier(0);
            }
            const float dq = (float)(64 * t + 4 * hi - (qw + r32));
            float rm = -INFINITY;
#pragma unroll
            for (int r = 0; r < 16; ++r) {
                const float t0 = dq + (float)((r & 3) + 8 * (r >> 2)), t1 = t0 + 32.f;
                p0[r] = __builtin_fmaf(-slope2, __builtin_fabsf(t0), p0[r]);
                p1[r] = __builtin_fmaf(-slope2, __builtin_fabsf(t1), p1[r]);
                if (WIN) { if (__builtin_fabsf(t0) > Wf) p0[r] = -INFINITY; if (__builtin_fabsf(t1) > Wf) p1[r] = -INFINITY; }
                rm = __builtin_fmaxf(rm, __builtin_fmaxf(p0[r], p1[r]));
            }
            rm = __builtin_fmaxf(rm, __shfl_xor(rm, 32));
            if (__any(rm > m)) {
                const float mn = __builtin_fmaxf(m, rm); const float f = __builtin_amdgcn_exp2f(m - mn); m = mn; l *= f;
                if (hi == 0) wsf[r32] = f;
#pragma unroll
                for (int r = 0; r < 16; ++r) { const float fr = wsf[crow(r, hi)];
#pragma unroll
                    for (int d = 0; d < ND; ++d) o[d][r] *= fr; }
            }
            float ls = 0.f;
#pragma unroll
            for (int r = 0; r < 16; ++r) { p0[r] = __builtin_amdgcn_exp2f(p0[r] - m); p1[r] = __builtin_amdgcn_exp2f(p1[r] - m); ls += p0[r] + p1[r]; }
            l += ls;
            u32x4 pw[4];
#pragma unroll
            for (int c = 0; c < 4; ++c) {
                const f32x16& P = (c >> 1) ? p1 : p0; const int b = 8 * (c & 1);
                pw[c].x = cvt_pk(P[b + 0], P[b + 1]); pw[c].y = cvt_pk(P[b + 2], P[b + 3]); pw[c].z = cvt_pk(P[b + 4], P[b + 5]); pw[c].w = cvt_pk(P[b + 6], P[b + 7]);
            }
            const LAS unsigned char* Vb = lds + j * SLOT + 64 * KSTR + (4 * hi + ((lane & 15) >> 2)) * VSTR + (16 * ((lane >> 4) & 1) + 4 * (lane & 3)) * 2;
#pragma unroll
            for (int c = 0; c < 4; ++c)
#pragma unroll
                for (int d = 0; d < ND; ++d) {
                    const s16x4 vlo = vtr(Vb + c * 16 * VSTR + d * 64), vhi = vtr(Vb + c * 16 * VSTR + 8 * VSTR + d * 64);
                    const bf16x8 vf = (bf16x8){vlo[0], vlo[1], vlo[2], vlo[3], vhi[0], vhi[1], vhi[2], vhi[3]};
                    o[d] = __builtin_amdgcn_mfma_f32_32x32x16_bf16(__builtin_bit_cast(bf16x8, pw[c]), vf, o[d], 0, 0, 0);
                    if (d == ND - 1) __builtin_amdgcn_sched_barrier(0);
                }
        }
      }
    }
    l += __shfl_xor(l, 32);
    if (hi == 0) wsf[r32] = 1.f / l;
#pragma unroll
    for (int r = 0; r < 16; ++r) { const float ir = wsf[crow(r, hi)];
        if (Obf != nullptr) { bf16_t* orow = Obf + (size_t)(qw + crow(r, hi)) * opitch + r32;
#pragma unroll
            for (int d = 0; d < ND; ++d) orow[d * 32] = (bf16_t)f2bf(o[d][r] * ir);
        } else { float* orow = Oout + (size_t)(qw + crow(r, hi)) * opitch + r32;
#pragma unroll
            for (int d = 0; d < ND; ++d) orow[d * 32] = o[d][r] * ir; } }
    if (lse_out != nullptr && hi == 0) lse_out[(size_t)(qw + r32) * lpitch] = (m + __builtin_log2f(l)) * LN2;
    __syncthreads();
}

__device__ __forceinline__ void row_to_bf16_ssq(const float* xrow, bf16_t* orow, float* ssq, int lane) {
    const f32x4* xr = (const f32x4*)xrow + lane;
    f32x4 v[4]; float s = 0.f;
#pragma unroll
    for (int j = 0; j < 4; ++j) { v[j] = xr[64 * j]; s += (v[j].x * v[j].x + v[j].y * v[j].y) + (v[j].z * v[j].z + v[j].w * v[j].w); }
    s = wave_sum(s);
    u32x2* o8 = (u32x2*)orow + lane;
#pragma unroll
    for (int j = 0; j < 4; ++j) { u32x2 w; w.x = pk2(v[j].x, v[j].y); w.y = pk2(v[j].z, v[j].w); o8[64 * j] = w; }
    if (lane == 0) *ssq = s;
}
constexpr int BK_OFF = 0, BV_OFF = 2 * 64 * KSTR, BSCR_OFF = BV_OFF + 3 * 64 * 320, ATT_O0_OFF = BSCR_OFF + 2048;
static_assert(ATT_O0_OFF + 65536 <= 147456, "B attention LDS map");
constexpr float B_THR = 6.0f;
#ifndef B_LATE
#define B_LATE(w) false
#endif
template <int KI> __device__ __forceinline__ float fmamk_t(float a, float c) { float r; asm("v_fmamk_f32 %0, %1, %3, %2" : "=v"(r) : "v"(a), "v"(c), "n"(__builtin_bit_cast(int, (float)KI))); return r; }
__device__ __forceinline__ float max3f(float a, float b, float c) { float r; asm("v_max3_f32 %0, %1, %2, %3" : "=v"(r) : "v"(a), "v"(b), "v"(c)); return r; }
__device__ __forceinline__ void attn_b_unit(LAS unsigned char* lds, const bf16_t* base, int h, int q0, int L, float slope2_, float lam,
                                            const float* subln_l, float postscale, bf16_t* mix) {
    constexpr int VD = 128, VSTR = VD * 2 + 64, ND = 4, VCH = 16, VLD = 2;
    int tid_l = threadIdx.x; asm volatile("" : "+v"(tid_l)); const int tid = tid_l, lane = tid & 63, r32 = lane & 31, hi = lane >> 5, wid = __builtin_amdgcn_readfirstlane(tid >> 6);
    const int qw = q0 + wid * 32, NT = L / 64, c0 = q0 / 64;
    LAS float* wsf = (LAS float*)(lds + BSCR_OFF) + wid * 64;
    const bool late = B_LATE(wid);
    const int krow = tid >> 3, kch = tid & 7;
    const bf16_t* Vp = base + 1536 + h * 128;
    const float qposf_ = (float)(qw + r32);
    for (int mp = 0; mp < 2; ++mp) {
        const bf16_t* Qp = base + 512 + (h * 2 + mp) * 64; const bf16_t* Kp = base + 1024 + (h * 2 + mp) * 64;
        bf16x8 qr[4];
        { const bf16_t* qrow = Qp + (size_t)(qw + r32) * DIN + hi * 8;
#pragma unroll
          for (int d0 = 0; d0 < 4; ++d0) qr[d0] = *(const bf16x8*)(qrow + d0 * 16); }
        f32x16 o[ND];
#pragma unroll
        for (int d = 0; d < ND; ++d)
#pragma unroll
            for (int r = 0; r < 16; ++r) o[d][r] = 0.f;
        float mref = 0.f, l = 0.f;
        u32x4 kreg; u32x4 vreg[VLD];
        const unsigned koff = (unsigned)(krow * DIN + kch * 8) * 2u, voff = (unsigned)((tid >> 4) * DIN + (tid & 15) * 8) * 2u;
#define ATT_GLOAD(t) do { const char* kt_ = (const char*)Kp + (size_t)(t) * (64 * DIN * 2); const char* vt_ = (const char*)Vp + (size_t)(t) * (64 * DIN * 2); \
        kreg = *(const u32x4*)(kt_ + koff); vreg[0] = *(const u32x4*)(vt_ + voff); vreg[1] = *(const u32x4*)(vt_ + 32 * DIN * 2 + voff); } while (0)
#define ATT_LSTORE(b, vs) do { *(LAS u32x4*)(lds + BK_OFF + (b) * 64 * KSTR + krow * KSTR + kch * 16) = kreg; \
        *(LAS u32x4*)(lds + BV_OFF + (vs) * 64 * VSTR + (tid >> 4) * VSTR + (tid & 15) * 16) = vreg[0]; *(LAS u32x4*)(lds + BV_OFF + (vs) * 64 * VSTR + ((tid >> 4) + 32) * VSTR + (tid & 15) * 16) = vreg[1]; } while (0)
#define VFRAG(x, d) (bf16x8){x[d][0][0], x[d][0][1], x[d][0][2], x[d][0][3], x[d][1][0], x[d][1][1], x[d][1][2], x[d][1][3]}
#define PV_LOAD01(vs) do { \
        const LAS unsigned char* Vb = lds + BV_OFF + (vs) * 64 * VSTR + (4 * hi + ((lane & 15) >> 2)) * VSTR + (16 * ((lane >> 4) & 1) + 4 * (lane & 3)) * 2; \
        _Pragma("unroll") for (int d = 0; d < ND; ++d) { va[d][0] = vtr(Vb + d * 64); va[d][1] = vtr(Vb + 8 * VSTR + d * 64); } \
        _Pragma("unroll") for (int d = 0; d < ND; ++d) { vb2[d][0] = vtr(Vb + 16 * VSTR + d * 64); vb2[d][1] = vtr(Vb + 16 * VSTR + 8 * VSTR + d * 64); } \
        __builtin_amdgcn_sched_barrier(0); } while (0)
#define PV_MMA(vs) do { \
        const LAS unsigned char* Vb = lds + BV_OFF + (vs) * 64 * VSTR + (4 * hi + ((lane & 15) >> 2)) * VSTR + (16 * ((lane >> 4) & 1) + 4 * (lane & 3)) * 2; \
        _Pragma("unroll") for (int d = 0; d < ND; ++d) o[d] = __builtin_amdgcn_mfma_f32_32x32x16_bf16(__builtin_bit_cast(bf16x8, pw[0]), VFRAG(va, d), o[d], 0, 0, 0); \
        __builtin_amdgcn_sched_barrier(0); \
        _Pragma("unroll") for (int d = 0; d < ND; ++d) { va[d][0] = vtr(Vb + 32 * VSTR + d * 64); va[d][1] = vtr(Vb + 32 * VSTR + 8 * VSTR + d * 64); } \
        __builtin_amdgcn_sched_barrier(0); \
        _Pragma("unroll") for (int d = 0; d < ND; ++d) o[d] = __builtin_amdgcn_mfma_f32_32x32x16_bf16(__builtin_bit_cast(bf16x8, pw[1]), VFRAG(vb2, d), o[d], 0, 0, 0); \
        __builtin_amdgcn_sched_barrier(0); \
        _Pragma("unroll") for (int d = 0; d < ND; ++d) { vb2[d][0] = vtr(Vb + 48 * VSTR + d * 64); vb2[d][1] = vtr(Vb + 48 * VSTR + 8 * VSTR + d * 64); } \
        __builtin_amdgcn_sched_barrier(0); \
        _Pragma("unroll") for (int d = 0; d < ND; ++d) o[d] = __builtin_amdgcn_mfma_f32_32x32x16_bf16(__builtin_bit_cast(bf16x8, pw[2]), VFRAG(va, d), o[d], 0, 0, 0); \
        _Pragma("unroll") for (int d = 0; d < ND; ++d) o[d] = __builtin_amdgcn_mfma_f32_32x32x16_bf16(__builtin_bit_cast(bf16x8, pw[3]), VFRAG(vb2, d), o[d], 0, 0, 0); \
        __builtin_amdgcn_sched_barrier(0); } while (0)
        int first = 1; asm volatile("" : "+s"(first));
#define B_TILE(i_) ((i_) < 4 ? c0 + (i_) : ((i_) - 4 < c0 ? (i_) - 4 : (i_)))
        int t = B_TILE(0);
        int vs_prev = 2, vs_cur = 0, vs_next = 1;
        u32x4 pw[4];
        ATT_GLOAD(t); ATT_LSTORE(0, 0); __syncthreads();
        for (int i = 0; i < NT; ++i) {
            const int buf = i & 1;
            int tn = 0;
            if (i + 1 < NT) { tn = B_TILE(i + 1); ATT_GLOAD(tn); }
            f32x16 p0, p1;
            const int kb = 64 * t;
            float slope2 = slope2_, qposf = qposf_; asm volatile("" : "+v"(slope2), "+v"(qposf));
            const LAS unsigned char* Kb = lds + BK_OFF + buf * 64 * KSTR + r32 * KSTR + hi * 16;
            bf16x8 kf[8];
#pragma unroll
            for (int d0 = 0; d0 < 4; ++d0) { kf[d0] = *(const LAS bf16x8*)(Kb + d0 * 32); kf[4 + d0] = *(const LAS bf16x8*)(Kb + 32 * KSTR + d0 * 32); }
            const LAS unsigned char* Vb = lds + BV_OFF + vs_cur * 64 * VSTR + (4 * hi + ((lane & 15) >> 2)) * VSTR + (16 * ((lane >> 4) & 1) + 4 * (lane & 3)) * 2;
            s16x4 va[ND][2], vb2[ND][2];
            const bool offdiag = (kb + 63 < qw || kb > qw + 31);
            const float dq = (float)(kb + 4 * hi) - qposf;
#define QK_P0(INIT0, INIT1) do { \
            _Pragma("unroll") for (int r = 0; r < 16; ++r) { const float kv = (float)((r & 3) + 8 * (r >> 2)); p0[r] = INIT0; } \
            __builtin_amdgcn_sched_barrier(0); \
            _Pragma("unroll") for (int d0 = 0; d0 < 4; ++d0) { \
                p0 = __builtin_amdgcn_mfma_f32_32x32x16_bf16(kf[d0], qr[d0], p0, 0, 0, 0); \
                _Pragma("unroll") for (int r = 4 * d0; r < 4 * d0 + 4; ++r) { const float kv = (float)((r & 3) + 8 * (r >> 2) + 32); p1[r] = INIT1; } \
                __builtin_amdgcn_sched_barrier(0); } } while (0)
            if (offdiag) {
                const float sg = (kb > qw) ? -slope2 : slope2, b0 = sg * dq - mref;
                p0[0] = fmamk_t<0>(sg, b0); p0[1] = fmamk_t<1>(sg, b0); p0[2] = fmamk_t<2>(sg, b0); p0[3] = fmamk_t<3>(sg, b0); p0[4] = fmamk_t<8>(sg, b0); p0[5] = fmamk_t<9>(sg, b0); p0[6] = fmamk_t<10>(sg, b0); p0[7] = fmamk_t<11>(sg, b0); p0[8] = fmamk_t<16>(sg, b0); p0[9] = fmamk_t<17>(sg, b0); p0[10] = fmamk_t<18>(sg, b0); p0[11] = fmamk_t<19>(sg, b0); p0[12] = fmamk_t<24>(sg, b0); p0[13] = fmamk_t<25>(sg, b0); p0[14] = fmamk_t<26>(sg, b0); p0[15] = fmamk_t<27>(sg, b0);
                __builtin_amdgcn_sched_barrier(0);
                p0 = __builtin_amdgcn_mfma_f32_32x32x16_bf16(kf[0], qr[0], p0, 0, 0, 0); p1[0] = fmamk_t<32>(sg, b0); p1[1] = fmamk_t<33>(sg, b0); p1[2] = fmamk_t<34>(sg, b0); p1[3] = fmamk_t<35>(sg, b0); __builtin_amdgcn_sched_barrier(0);
                p0 = __builtin_amdgcn_mfma_f32_32x32x16_bf16(kf[1], qr[1], p0, 0, 0, 0); p1[4] = fmamk_t<40>(sg, b0); p1[5] = fmamk_t<41>(sg, b0); p1[6] = fmamk_t<42>(sg, b0); p1[7] = fmamk_t<43>(sg, b0); __builtin_amdgcn_sched_barrier(0);
                p0 = __builtin_amdgcn_mfma_f32_32x32x16_bf16(kf[2], qr[2], p0, 0, 0, 0); p1[8] = fmamk_t<48>(sg, b0); p1[9] = fmamk_t<49>(sg, b0); p1[10] = fmamk_t<50>(sg, b0); p1[11] = fmamk_t<51>(sg, b0); __builtin_amdgcn_sched_barrier(0);
                p0 = __builtin_amdgcn_mfma_f32_32x32x16_bf16(kf[3], qr[3], p0, 0, 0, 0); p1[12] = fmamk_t<56>(sg, b0); p1[13] = fmamk_t<57>(sg, b0); p1[14] = fmamk_t<58>(sg, b0); p1[15] = fmamk_t<59>(sg, b0); __builtin_amdgcn_sched_barrier(0);
            } else {
                const float nmref = -mref;
                QK_P0(__builtin_fmaf(-slope2, __builtin_fabsf(dq + kv), nmref), __builtin_fmaf(-slope2, __builtin_fabsf(dq + kv), nmref));
            }
#undef QK_P0
#pragma unroll
            for (int d = 0; d < ND; ++d) { va[d][0] = vtr(Vb + d * 64); va[d][1] = vtr(Vb + 8 * VSTR + d * 64); }
#pragma unroll
            for (int d = 0; d < ND; ++d) { vb2[d][0] = vtr(Vb + 16 * VSTR + d * 64); vb2[d][1] = vtr(Vb + 16 * VSTR + 8 * VSTR + d * 64); }
            __builtin_amdgcn_sched_barrier(0);
#pragma unroll
            for (int d0 = 0; d0 < 4; ++d0) p1 = __builtin_amdgcn_mfma_f32_32x32x16_bf16(kf[4 + d0], qr[d0], p1, 0, 0, 0);
            __builtin_amdgcn_sched_barrier(0);
            float rm, rmb;
            asm volatile("s_nop 15\n\ts_nop 7\n\tv_max3_f32 %0, %1, %2, %3\n\tv_max3_f32 %0, %0, %4, %5\n\tv_max3_f32 %0, %0, %6, %7\n\tv_max3_f32 %0, %0, %8, %9\n\t"
                         "v_max3_f32 %0, %0, %10, %11\n\tv_max3_f32 %0, %0, %12, %13\n\tv_max3_f32 %0, %0, %14, %15\n\tv_max3_f32 %0, %0, %16, %16"
                         : "=&v"(rm) : "v"(p0[0]), "v"(p0[1]), "v"(p0[2]), "v"(p0[3]), "v"(p0[4]), "v"(p0[5]), "v"(p0[6]), "v"(p0[7]), "v"(p0[8]), "v"(p0[9]), "v"(p0[10]), "v"(p0[11]), "v"(p0[12]), "v"(p0[13]), "v"(p0[14]), "v"(p0[15]));
            asm volatile("v_max3_f32 %0, %1, %2, %3\n\tv_max3_f32 %0, %0, %4, %5\n\tv_max3_f32 %0, %0, %6, %7\n\tv_max3_f32 %0, %0, %8, %9\n\t"
                         "v_max3_f32 %0, %0, %10, %11\n\tv_max3_f32 %0, %0, %12, %13\n\tv_max3_f32 %0, %0, %14, %15\n\tv_max3_f32 %0, %0, %16, %16"
                         : "=&v"(rmb) : "v"(p1[0]), "v"(p1[1]), "v"(p1[2]), "v"(p1[3]), "v"(p1[4]), "v"(p1[5]), "v"(p1[6]), "v"(p1[7]), "v"(p1[8]), "v"(p1[9]), "v"(p1[10]), "v"(p1[11]), "v"(p1[12]), "v"(p1[13]), "v"(p1[14]), "v"(p1[15]));
            rm = __builtin_fmaxf(rm, rmb);
            { auto rr_ = __builtin_amdgcn_permlane32_swap(__float_as_uint(rm), __float_as_uint(rm), false, false); rm = __builtin_fmaxf(__uint_as_float(rr_[0]), __uint_as_float(rr_[1])); }
            if (first || __any(rm > B_THR)) {
                const float delta = (first || rm > B_THR) ? rm : 0.f; const float f = __builtin_amdgcn_exp2f(-delta); mref += delta; l *= f;
#pragma unroll
                for (int r = 0; r < 16; ++r) { p0[r] -= delta; p1[r] -= delta; }
                {
                    if (hi == 0) wsf[r32] = f;
#pragma unroll
                    for (int r = 0; r < 16; ++r) { const float fr = wsf[crow(r, hi)];
#pragma unroll
                        for (int d = 0; d < ND; ++d) o[d][r] *= fr; }
                }
            }
            float ls0 = 0.f, ls1 = 0.f;
#pragma unroll
            for (int r = 0; r < 16; ++r) { p0[r] = __builtin_amdgcn_exp2f(p0[r]); ls0 += p0[r]; }
            pw[0].x = cvt_pk(p0[0], p0[1]); pw[0].y = cvt_pk(p0[2], p0[3]); pw[0].z = cvt_pk(p0[4], p0[5]); pw[0].w = cvt_pk(p0[6], p0[7]);
            pw[1].x = cvt_pk(p0[8], p0[9]); pw[1].y = cvt_pk(p0[10], p0[11]); pw[1].z = cvt_pk(p0[12], p0[13]); pw[1].w = cvt_pk(p0[14], p0[15]);
            __builtin_amdgcn_sched_barrier(0);
#define VFRAG(x, d) (bf16x8){x[d][0][0], x[d][0][1], x[d][0][2], x[d][0][3], x[d][1][0], x[d][1][1], x[d][1][2], x[d][1][3]}
#pragma unroll
            for (int d = 0; d < ND; ++d) {
                o[d] = __builtin_amdgcn_mfma_f32_32x32x16_bf16(__builtin_bit_cast(bf16x8, pw[0]), VFRAG(va, d), o[d], 0, 0, 0);
                p1[2 * d] = __builtin_amdgcn_exp2f(p1[2 * d]); p1[2 * d + 1] = __builtin_amdgcn_exp2f(p1[2 * d + 1]); ls1 += p1[2 * d]; ls0 += p1[2 * d + 1];
                __builtin_amdgcn_sched_barrier(0);
            }
#pragma unroll
            for (int d = 0; d < ND; ++d) { va[d][0] = vtr(Vb + 32 * VSTR + d * 64); va[d][1] = vtr(Vb + 32 * VSTR + 8 * VSTR + d * 64); }
            __builtin_amdgcn_sched_barrier(0);
#pragma unroll
            for (int d = 0; d < ND; ++d) {
                o[d] = __builtin_amdgcn_mfma_f32_32x32x16_bf16(__builtin_bit_cast(bf16x8, pw[1]), VFRAG(vb2, d), o[d], 0, 0, 0);
                p1[8 + 2 * d] = __builtin_amdgcn_exp2f(p1[8 + 2 * d]); p1[8 + 2 * d + 1] = __builtin_amdgcn_exp2f(p1[8 + 2 * d + 1]); ls1 += p1[8 + 2 * d]; ls0 += p1[8 + 2 * d + 1];
                __builtin_amdgcn_sched_barrier(0);
            }
#pragma unroll
            for (int d = 0; d < ND; ++d) { vb2[d][0] = vtr(Vb + 48 * VSTR + d * 64); vb2[d][1] = vtr(Vb + 48 * VSTR + 8 * VSTR + d * 64); }
            if (i + 1 < NT) ATT_LSTORE(buf ^ 1, vs_next);
            l += ls0 + ls1;
            pw[2].x = cvt_pk(p1[0], p1[1]); pw[2].y = cvt_pk(p1[2], p1[3]); pw[2].z = cvt_pk(p1[4], p1[5]); pw[2].w = cvt_pk(p1[6], p1[7]);
            __builtin_amdgcn_sched_barrier(0);
#pragma unroll
            for (int d = 0; d < ND; ++d) {
                o[d] = __builtin_amdgcn_mfma_f32_32x32x16_bf16(__builtin_bit_cast(bf16x8, pw[2]), VFRAG(va, d), o[d], 0, 0, 0);
                if (d == 0) { pw[3].x = cvt_pk(p1[8], p1[9]); pw[3].y = cvt_pk(p1[10], p1[11]); } else if (d == 1) { pw[3].z = cvt_pk(p1[12], p1[13]); pw[3].w = cvt_pk(p1[14], p1[15]); }
                __builtin_amdgcn_sched_barrier(0);
            }
#pragma unroll
            for (int d = 0; d < ND; ++d) o[d] = __builtin_amdgcn_mfma_f32_32x32x16_bf16(__builtin_bit_cast(bf16x8, pw[3]), VFRAG(vb2, d), o[d], 0, 0, 0);
#undef VFRAG
            __builtin_amdgcn_sched_barrier(0);
            first = 0;
            t = tn;
            { const int tmp_ = vs_prev; vs_prev = vs_cur; vs_cur = vs_next; vs_next = tmp_; }
            __syncthreads();
        }
#undef PV_LOAD01
#undef PV_MMA
#undef B_TILE
#undef VFRAG
#undef ATT_GLOAD
#undef ATT_LSTORE
        l += __shfl_xor(l, 32);
        if (hi == 0) wsf[r32] = 1.f / l;
        int lane_e = lane, qw_e = qw; asm volatile("" : "+v"(lane_e)); asm volatile("" : "+s"(qw_e));
        const int r32 = lane_e & 31, hi = lane_e >> 5, qw = qw_e;
        LAS unsigned* o0buf = (LAS unsigned*)(lds + ATT_O0_OFF) + wid * 2048 + lane_e;
        if (mp == 0) {
#pragma unroll
            for (int d = 0; d < ND; ++d)
#pragma unroll
                for (int r = 0; r < 16; r += 2) { const float i0 = wsf[crow(r, hi)], i1 = wsf[crow(r + 1, hi)]; o0buf[(d * 8 + (r >> 1)) * 64] = cvt_pk(o[d][r] * i0, o[d][r + 1] * i1); }
        } else {
            float gs[ND];
#pragma unroll
            for (int d = 0; d < ND; ++d) gs[d] = subln_l[d * 32 + r32] * postscale;
#pragma unroll
            for (int r = 0; r < 16; r += 2) {
                const float i0 = wsf[crow(r, hi)], i1 = wsf[crow(r + 1, hi)];
                float v0[ND], v1[ND]; float s0 = 0.f, s1 = 0.f;
#pragma unroll
                for (int d = 0; d < ND; ++d) { const unsigned w = o0buf[(d * 8 + (r >> 1)) * 64];
                    v0[d] = __builtin_bit_cast(float, w << 16) - lam * (o[d][r] * i0); v1[d] = __builtin_bit_cast(float, w & 0xffff0000u) - lam * (o[d][r + 1] * i1);
                    s0 += v0[d] * v0[d]; s1 += v1[d] * v1[d]; }
#pragma unroll
                for (int sh = 1; sh < 32; sh <<= 1) { s0 += __shfl_xor(s0, sh); s1 += __shfl_xor(s1, sh); }
                const float r0 = 1.f / sqrtf(s0 * (1.f / 128.f) + 1e-5f), r1 = 1.f / sqrtf(s1 * (1.f / 128.f) + 1e-5f);
                bf16_t* row0 = mix + (size_t)(qw + crow(r, hi)) * DM + r32; bf16_t* row1 = mix + (size_t)(qw + crow(r + 1, hi)) * DM + r32;
#pragma unroll
                for (int d = 0; d < ND; ++d) { row0[d * 32] = (bf16_t)f2bf(v0[d] * r0 * gs[d]); row1[d * 32] = (bf16_t)f2bf(v1[d] * r1 * gs[d]); }
            }
        }
        __syncthreads();
    }
}
__device__ __forceinline__ float alibi_slope(int i, int n) { return exp2f(-8.0f * (float)(i + 1) / (float)n); }
struct Ctx { int tid, lane, wave, G, cu, gw, NGW; };

__device__ __forceinline__ void ph_weights(const Args& a, LAS unsigned char* lds, int l, int gw0, int nw, int wave, int lane) {
    unsigned char* ws = a.ws;
    bf16_t* WinT = (bf16_t*)(ws + WS_WIN); bf16_t* WoutT = (bf16_t*)(ws + WS_WOUT); bf16_t* WupT = (bf16_t*)(ws + WS_WUP); bf16_t* WdnT = (bf16_t*)(ws + WS_WDN);
    const float* w_in = a.in[3]; const float* w_out = a.in[10]; const float* w_up = a.in[12]; const float* w_down = a.in[15];
    LAS float* scr = (LAS float*)(lds + wave * 16384);
    constexpr int I_IN = (DM / 64) * (DIN / 32), I_OUT = (DM / 64) * (DM / 32), I_UP = (DM / 64) * (DUP / 32), I_DN = (DFF / 64) * (DM / 32);
    constexpr int PER_L = I_IN + I_OUT + I_UP + I_DN;
    for (int it = gw0; it < PER_L; it += nw) {
        int r = it;
        if (r < I_IN) { transpose_item(w_in + (size_t)l * DM * DIN, DM, DIN, WinT + (size_t)l * DIN * DM, scr, r, lane, a.in[2] + l * DM); continue; } r -= I_IN;
        if (r < I_OUT) { transpose_item(w_out + (size_t)l * DM * DM, DM, DM, WoutT + (size_t)l * DM * DM, scr, r, lane, nullptr); continue; } r -= I_OUT;
        if (r < I_UP) { transpose_item(w_up + (size_t)l * DM * DUP, DM, DUP, WupT + (size_t)l * DUP * DM, scr, r, lane, a.in[11] + l * DM, true); continue; } r -= I_UP;
        transpose_item(w_down + (size_t)l * DFF * DM, DFF, DM, WdnT + (size_t)l * DM * DFF, scr, r, lane, nullptr);
    }
}
__device__ __forceinline__ const float* chunk_in(const Args& a, int ch) { return ch == 0 ? a.in[0] : a.in[1] + (size_t)(ch - 1) * CH_ROWS * DM; }
__device__ __forceinline__ float* chunk_out(const Args& a, int ch) { return a.out + (size_t)ch * CH_ROWS * DM; }

__device__ __forceinline__ void ph_norm_bf16(const Ctx& c, const float* xsrc, const float* gain, bf16_t* HB) {
    for (int r = c.gw; r < CH_ROWS; r += c.NGW) rms_row_to_bf16(xsrc + (size_t)r * DM, gain, HB + (size_t)r * DM, c.lane);
}
__device__ __forceinline__ void ph_final_norm(const Ctx& c, float* xo, const float* gain) {
    for (int r = c.gw; r < CH_ROWS; r += c.NGW) rms_row_f32(xo + (size_t)r * DM, gain, c.lane);
}

__device__ __forceinline__ void ph_attn(const Args& a, const Ctx& c, LAS unsigned char* lds, int ch, int layer) {
    const bf16_t* PROJ = (const bf16_t*)(a.ws + WS_PROJ); float* TMP = (float*)(a.ws + WS_TMP);
    const int SL = ch == 0 ? 16384 : 4096, sl_shift = ch == 0 ? 14 : 12;
    const int cu = c.cu, G = c.G;
#ifndef SKIP_B
    {
        const float lam_init = layer == 0 ? 0.2f : (0.8f - 0.6f * 0.7408182206817179f);
        const float s1 = wave_sum(a.in[5][layer * 64 + c.lane] * a.in[6][layer * 64 + c.lane]);
        const float s2 = wave_sum(a.in[7][layer * 64 + c.lane] * a.in[8][layer * 64 + c.lane]);
        const float lam = expf(s1) - expf(s2) + lam_init;
        bf16_t* HBm = (bf16_t*)(a.ws + WS_HB);
#ifdef PROBE_B2
        for (int rep_ = 0; rep_ < 2; ++rep_)
#endif
        for (int u = cu; u < 256; u += G) {
            int seq, h, qb; const int xcd = u & 7, idx = u >> 3;
            if (ch == 0) { seq = 0; h = xcd >> 1; qb = (xcd & 1) * 32 + idx; }
            else { const int pair = xcd * 2 + (idx >> 4); seq = pair >> 2; h = pair & 3; qb = idx & 15; }
            const size_t rb = (size_t)seq * SL;
            attn_b_unit(lds, PROJ + rb * DIN, h, qb * 256, SL, alibi_slope(h, 4) * LOG2E, lam, a.in[9] + layer * 128, 1.f - lam_init, HBm + rb * DM + 256 + h * 128);
        }
    }
#endif
#ifndef SKIP_AC
#ifdef PROBE_AC2
    for (int rep_ = 0; rep_ < 2; ++rep_)
#endif
    for (int uu = cu; uu < 1024; uu += G) {
        const bf16_t *qp, *kp, *vp; size_t pitch, opitch, lpitch; int q0, L, W; float slope2, m_init, l_init; float *op, *lp; bf16_t* obf;
        if (uu < 256) {
            const int hq = uu >> 6, blk = uu & 63;
            const int seq = (blk * 256) >> sl_shift, qb = blk - ((seq << sl_shift) >> 8);
            const size_t rb = (size_t)seq * SL; const bf16_t* base = PROJ + rb * DIN;
            qp = base + hq * 64; kp = base + 256 + (hq >> 1) * 64; vp = base + 384 + (hq >> 1) * 64; pitch = DIN; q0 = qb * 256; L = SL;
            slope2 = alibi_slope(hq, 4) * LOG2E; W = 128; m_init = a.in[4][layer * 4 + hq] * LOG2E; l_init = 1.f;
            op = nullptr; obf = (bf16_t*)(a.ws + WS_HB) + rb * DM + hq * 64; opitch = DM; lp = nullptr; lpitch = 0;
        } else {
            const int uc = uu - 256;
            const int gh = uc >> 6, blk = uc & 63, gq = gh >> 2;
            const int dsh = 2 * gq, d = 1 << dsh;
            const int seq = (blk * 256) >> sl_shift, b2 = blk - ((seq << sl_shift) >> 8);
            const int nbr = (SL >> dsh) >> 8;
            const int res = b2 / nbr, qb = b2 % nbr;
            const size_t rb = (size_t)seq * SL + res; const bf16_t* base = PROJ + rb * DIN;
            qp = base + 2048 + gh * 64; kp = base + 2816 + gh * 64; vp = base + 3584 + gh * 64; pitch = (size_t)DIN * d; q0 = qb * 256; L = SL >> dsh;
            slope2 = alibi_slope(gh, 12) * (float)d * LOG2E; W = 64; m_init = -1e30f; l_init = 0.f;
            op = TMP + rb * TW + T_C + gh * 64; obf = nullptr; opitch = (size_t)TW * d; lp = TMP + rb * TW + T_L + gh; lpitch = (size_t)TW * d;
        }
        attn_unit<64, true>(lds, qp, kp, vp, pitch, q0, L, slope2, W, m_init, l_init, op, opitch, lp, lpitch, obf);
    }
#endif
}

__device__ __forceinline__ void ph_combine(const Args& a, const Ctx& c, int layer) {
    const float* TMP = (const float*)(a.ws + WS_TMP); bf16_t* HB = (bf16_t*)(a.ws + WS_HB);
    { float* S2 = (float*)(a.ws + WS_SSQ) + 2 * CH_ROWS; for (int r = c.cu * NTHREADS + c.tid; r < CH_ROWS; r += c.G * NTHREADS) S2[r] = 0.f; }
    const int nitems = CH_ROWS * 32;
#pragma unroll 2
    for (int it = c.cu * NTHREADS + c.tid; it < nitems; it += c.G * NTHREADS) {
        const int r = it >> 5, h = (it >> 3) & 3, d8 = (it & 7) * 8;
        const float* tr = TMP + (size_t)r * TW;
        const float l0 = tr[T_L + h], l1 = tr[T_L + 4 + h], l2 = tr[T_L + 8 + h];
        const f32x4 a0 = *(const f32x4*)(tr + T_C + h * 64 + d8), a1 = *(const f32x4*)(tr + T_C + h * 64 + d8 + 4);
        const f32x4 b0 = *(const f32x4*)(tr + T_C + (4 + h) * 64 + d8), b1 = *(const f32x4*)(tr + T_C + (4 + h) * 64 + d8 + 4);
        const f32x4 c0 = *(const f32x4*)(tr + T_C + (8 + h) * 64 + d8), c1 = *(const f32x4*)(tr + T_C + (8 + h) * 64 + d8 + 4);
        const float mx = fmaxf(l0, fmaxf(l1, l2));
        float w0 = __expf(l0 - mx), w1 = __expf(l1 - mx), w2 = __expf(l2 - mx);
        const float inv = 1.f / (w0 + w1 + w2); w0 *= inv; w1 *= inv; w2 *= inv;
        const f32x4 o0 = a0 * w0 + b0 * w1 + c0 * w2, o1 = a1 * w0 + b1 * w1 + c1 * w2;
        u32x4 o; o.x = pk2(o0.x, o0.y); o.y = pk2(o0.z, o0.w); o.z = pk2(o1.x, o1.y); o.w = pk2(o1.z, o1.w);
        *(u32x4*)(HB + (size_t)r * DM + 768 + h * 64 + d8) = o;
    }
}

__device__ __forceinline__ void ph_conv(const Args& a, const Ctx& c, int ch, int layer) {
    const int par = ch & 1;
    const bf16_t* UB = (const bf16_t*)(a.ws + WS_PROJ); bf16_t* GB = (bf16_t*)(a.ws + WS_TMP);
    const int SL = ch == 0 ? 16384 : 4096;
    const float* cw = a.in[13] + (size_t)layer * 3 * DUP; const float* cb = a.in[14] + (size_t)layer * DUP;
    constexpr int NCG = DFF / 8, RB = 16;
    const int nitems = (CH_ROWS / RB) * NCG;
    { float* S1 = (float*)(a.ws + WS_SSQ) + par * CH_ROWS; for (int r = c.cu * NTHREADS + c.tid; r < CH_ROWS; r += c.G * NTHREADS) S1[r] = 0.f; }
    for (int it = c.cu * NTHREADS + c.tid; it < nitems; it += c.G * NTHREADS) {
        const int cg8 = it % NCG, rb = it / NCG, c0 = cg8 * 8, r0 = rb * RB;
        f32x4 wg[3][2], wv[3][2], bg[2], bv[2];
#pragma unroll
        for (int k = 0; k < 3; ++k)
#pragma unroll
            for (int j = 0; j < 2; ++j) { wg[k][j] = *(const f32x4*)(cw + k * DUP + c0 + 4 * j); wv[k][j] = *(const f32x4*)(cw + k * DUP + DFF + c0 + 4 * j); }
#pragma unroll
        for (int j = 0; j < 2; ++j) { bg[j] = *(const f32x4*)(cb + c0 + 4 * j); bv[j] = *(const f32x4*)(cb + DFF + c0 + 4 * j); }
        const bool first = (r0 & (SL - 1)) == 0, last = ((r0 + RB) & (SL - 1)) == 0;
        const u32x4 zero = (u32x4){0u, 0u, 0u, 0u};
        const bf16_t* up = UB + (size_t)r0 * DUP + c0;
        u32x4 pg_ = first ? zero : *(const u32x4*)(up - DUP), pv_ = first ? zero : *(const u32x4*)(up - DUP + DFF);
        u32x4 cg_ = *(const u32x4*)(up), cv_ = *(const u32x4*)(up + DFF);
        bf16_t* gp = GB + (size_t)r0 * DFF + c0;
#pragma unroll 4
        for (int rr = 0; rr < RB; ++rr) {
            const bool nz = (rr == RB - 1) && last;
            const u32x4 ng_ = nz ? zero : *(const u32x4*)(up + (size_t)(rr + 1) * DUP), nv_ = nz ? zero : *(const u32x4*)(up + (size_t)(rr + 1) * DUP + DFF);
            unsigned ow[4];
#pragma unroll
            for (int w = 0; w < 4; ++w) {
                float res[2];
#pragma unroll
                for (int hh = 0; hh < 2; ++hh) {
                    const int j = 2 * w + hh, q = j >> 2, e = j & 3;
                    const float gpv = hh ? __builtin_bit_cast(float, pg_[w] & 0xffff0000u) : __builtin_bit_cast(float, pg_[w] << 16);
                    const float gcv = hh ? __builtin_bit_cast(float, cg_[w] & 0xffff0000u) : __builtin_bit_cast(float, cg_[w] << 16);
                    const float gnv = hh ? __builtin_bit_cast(float, ng_[w] & 0xffff0000u) : __builtin_bit_cast(float, ng_[w] << 16);
                    const float vpv = hh ? __builtin_bit_cast(float, pv_[w] & 0xffff0000u) : __builtin_bit_cast(float, pv_[w] << 16);
                    const float vcv = hh ? __builtin_bit_cast(float, cv_[w] & 0xffff0000u) : __builtin_bit_cast(float, cv_[w] << 16);
                    const float vnv = hh ? __builtin_bit_cast(float, nv_[w] & 0xffff0000u) : __builtin_bit_cast(float, nv_[w] << 16);
                    const float gate = gpv * wg[0][q][e] + gcv * wg[1][q][e] + gnv * wg[2][q][e] + bg[q][e];
                    const float val = vpv * wv[0][q][e] + vcv * wv[1][q][e] + vnv * wv[2][q][e] + bv[q][e];
                    res[hh] = gate * __builtin_amdgcn_rcpf(1.f + __builtin_amdgcn_exp2f(-LOG2E * gate)) * val;
                }
                ow[w] = pk2(res[0], res[1]);
            }
            *(u32x4*)(gp + (size_t)rr * DFF) = (u32x4){ow[0], ow[1], ow[2], ow[3]};
            pg_ = cg_; pv_ = cv_; cg_ = ng_; cv_ = nv_;
        }
    }
}

constexpr int STEPS_PER_CHUNK = DEPTH * 6;
constexpr int NSTEPS = 1 + NCHUNK * STEPS_PER_CHUNK + 1;
__global__ void __launch_bounds__(NTHREADS, 2) mega_fwd(Args a) {
    extern __shared__ __attribute__((aligned(16))) unsigned char lds_raw[];
    LAS unsigned char* lds = (LAS unsigned char*)lds_raw;
    cg::grid_group grid = cg::this_grid();
    volatile LAS unsigned* bst = (volatile LAS unsigned*)(lds + 147456);
    if (threadIdx.x < 2) bst[threadIdx.x] = 0u;
    __syncthreads();
    XcdBarrier xbar = xcd_barrier_post((unsigned*)(a.ws + WS_CTL), bst);
#ifdef PROBE_P2
    for (int pass_ = 0; pass_ < 2; ++pass_)
#endif
    for (int step = 0; step < NSTEPS; ++step) {
        int tid_l = threadIdx.x, cu_l = blockIdx.x, G_l = gridDim.x;
        asm volatile("" : "+v"(tid_l)); asm volatile("" : "+s"(cu_l), "+s"(G_l));
        Ctx c; c.tid = tid_l; c.lane = c.tid & 63; c.wave = __builtin_amdgcn_readfirstlane(c.tid >> 6);
        c.G = G_l; c.cu = cu_l; c.gw = c.cu * 8 + c.wave; c.NGW = c.G * 8;
        unsigned char* ws = a.ws;
        if (step == 0) {
            ph_weights(a, lds, 0, c.gw, c.NGW, c.wave, c.lane); ph_weights(a, lds, 1, c.gw, c.NGW, c.wave, c.lane);
            const float* xin = chunk_in(a, 0); bf16_t* XB = (bf16_t*)(ws + WS_XB); float* S1 = (float*)(ws + WS_SSQ);
            for (int r = c.gw; r < CH_ROWS; r += c.NGW) row_to_bf16_ssq(xin + (size_t)r * DM, XB + (size_t)r * DM, S1 + r, c.lane);
        } else if (step == NSTEPS - 1) ph_final_norm(c, chunk_out(a, NCHUNK - 1), a.in[16]);
        else {
            const int s = step - 1, ch = s / STEPS_PER_CHUNK, sc = s % STEPS_PER_CHUNK, par = ch & 1;
            bf16_t* HB = (bf16_t*)(ws + WS_HB); bf16_t* XB = (bf16_t*)(ws + WS_XB) + (size_t)par * CH_ROWS * DM;
            float* S1 = (float*)(ws + WS_SSQ) + par * CH_ROWS; float* S2 = (float*)(ws + WS_SSQ) + 2 * CH_ROWS;
            float* xo = chunk_out(a, ch);
            {
                const int layer = sc / 6, ph = sc % 6;
                const float* xsrc = layer == 0 ? chunk_in(a, ch) : (const float*)xo;
                if (ph == 0) {
                    pg8::Gemm g{XB, (const bf16_t*)(ws + WS_WIN) + (size_t)layer * DIN * DM, CH_ROWS, DIN, DM}; pg8::StaticOrder S; S.init(CH_ROWS, DIN, c.G, c.cu);
                    pg8::EpiBf16S2 E{(bf16_t*)(ws + WS_PROJ), DIN, 1805u, QSCALE, S1};
#ifdef PROBE_G2
                    for (int rep_ = 0; rep_ < 2; ++rep_)
#endif
                    pg8::gemm_phase<pg8::EpiBf16S2, pg8::StaticOrder, true, true>(lds, g, S, E);
                    if (layer == 0 && ch > 0) {
                        const int nfull = (CH_ROWS / 256) * (DIN / 256) % c.G;
                        if (nfull > 0 && c.cu >= nfull) { float* xp = chunk_out(a, ch - 1); const int nw = (c.G - nfull) * 8;
                            for (int r = (c.cu - nfull) * 8 + c.wave; r < CH_ROWS; r += nw) rms_row_f32(xp + (size_t)r * DM, a.in[16], c.lane); }
                        else if (nfull == 0) ph_final_norm(c, chunk_out(a, ch - 1), a.in[16]);
                    }
                } else if (ph == 1) {
                    ph_attn(a, c, lds, ch, layer);
                } else if (ph == 2) {
                    ph_combine(a, c, layer);
                } else if (ph == 3) {
                    pg8::Gemm g{HB, (const bf16_t*)(ws + WS_WOUT) + (size_t)layer * DM * DM, CH_ROWS, DM, DM}; pg8::StaticOrder S; S.init(CH_ROWS, DM, c.G, c.cu);
                    pg8::EpiRes2 E{xsrc, xo, XB, S2, DM};
#ifdef PROBE_GE2
                    { pg8::EpiRes2 E0{xsrc, (float*)(ws + WS_PROJ), (bf16_t*)(ws + WS_PROJ + 72 * MiB), (float*)(ws + WS_PROJ + 110 * MiB), DM}; pg8::gemm_phase<pg8::EpiRes2, pg8::StaticOrder, true, true>(lds, g, S, E0); }
#endif
                    pg8::gemm_phase<pg8::EpiRes2, pg8::StaticOrder, true, true>(lds, g, S, E);
                } else if (ph == 4) {
                    pg8::Gemm g{XB - DM, (const bf16_t*)(ws + WS_WUP) + (size_t)layer * DUP * DM, 65 * 256, DUP, DM, 254}; pg8::StaticOrder S; S.init(65 * 256, DUP, c.G, c.cu);
                    pg8::EpiConv E{(bf16_t*)(ws + WS_TMP), S2, a.in[13] + (size_t)layer * 3 * DUP, a.in[14] + (size_t)layer * DUP, (ch == 0 ? 16384 : 4096) - 1, (LAS float*)(lds + 147456 + 256), CH_ROWS};
                    pg8::gemm_phase<pg8::EpiConv, pg8::StaticOrder, true, true>(lds, g, S, E);
                    { float* S1z = S1; for (int r = c.cu * NTHREADS + c.tid; r < CH_ROWS; r += c.G * NTHREADS) S1z[r] = 0.f; }
                    if (layer == DEPTH - 1 && ch + 1 < NCHUNK) {
                        const float* xin = chunk_in(a, ch + 1); bf16_t* XBn = (bf16_t*)(ws + WS_XB) + (size_t)(par ^ 1) * CH_ROWS * DM; float* S1n = (float*)(ws + WS_SSQ) + (par ^ 1) * CH_ROWS;
                        for (int r = c.gw; r < CH_ROWS; r += c.NGW) row_to_bf16_ssq(xin + (size_t)r * DM, XBn + (size_t)r * DM, S1n + r, c.lane);
                    }
                } else {
                    pg8::Gemm g{(const bf16_t*)(ws + WS_TMP), (const bf16_t*)(ws + WS_WDN) + (size_t)layer * DM * DFF, CH_ROWS, DM, DFF}; pg8::StaticOrder S; S.init(CH_ROWS, DM, c.G, c.cu);
                    pg8::EpiRes2 E{xo, xo, layer == DEPTH - 1 ? (bf16_t*)nullptr : XB, S1, DM};
#ifdef PROBE_GE2
                    { pg8::EpiRes2 E0{xo, (float*)(ws + WS_PROJ), (bf16_t*)(ws + WS_PROJ + 72 * MiB), (float*)(ws + WS_PROJ + 110 * MiB), DM}; pg8::gemm_phase<pg8::EpiRes2, pg8::StaticOrder, true, true>(lds, g, S, E0); }
#endif
                    pg8::gemm_phase<pg8::EpiRes2, pg8::StaticOrder, true, true>(lds, g, S, E);
                }
            }
        }
#ifdef PROBE_P2
        if (step == 0) grid.sync(); else xcd_barrier(xbar);
#else
        if (step == 0) grid.sync(); else if (step != NSTEPS - 1) xcd_barrier(xbar);
#endif
    }
#ifdef PROBE_TA
    if (blockIdx.x == 0 && threadIdx.x < 64) {
        float* xo = chunk_out(a, NCHUNK - 1);
        const float ua = (float)tA_ * 0.01f, ub = (float)tB_ * 0.01f;
        if (threadIdx.x == 0) xo[0] += 8.f + ua * 0.01f; else xo[4 * threadIdx.x] += sqrtf(ub * 0.01f);
    }
#endif
}

extern "C" void kernel_launch(void* const* d_in, const int* in_sizes, int n_in, void* d_out, int out_size, void* d_ws, size_t ws_size, hipStream_t stream) {
    static int grid = 0;
    if (grid == 0) {
        if (n_in != 17 || ws_size < WS_END) { fprintf(stderr, "kernel_launch: unexpected n_in %d / ws_size %zu (need %zu)\n", n_in, ws_size, (size_t)WS_END); grid = -1; return; }
        int dev = 0, cus = 0, per_cu = 0;
        (void)hipGetDevice(&dev); (void)hipDeviceGetAttribute(&cus, hipDeviceAttributeMultiprocessorCount, dev);
        if (hipFuncSetAttribute((const void*)mega_fwd, hipFuncAttributeMaxDynamicSharedMemorySize, LDS_BYTES) != hipSuccess) { fprintf(stderr, "hipFuncSetAttribute failed\n"); grid = -1; return; }
        if (hipOccupancyMaxActiveBlocksPerMultiprocessor(&per_cu, (const void*)mega_fwd, NTHREADS, LDS_BYTES) != hipSuccess || per_cu < 1) { fprintf(stderr, "occupancy query: %d\n", per_cu); per_cu = 1; }
        (void)hipGetLastError();
        grid = cus * 1;
    }
    if (grid < 0) return;
    (void)hipMemsetAsync((char*)d_ws + WS_CTL, 0, 65536, stream);
    Args a{};
    for (int i = 0; i < 17; ++i) a.in[i] = (const float*)d_in[i];
    a.out = (float*)d_out; a.ws = (unsigned char*)d_ws;
    void* args[] = {&a};
    hipError_t e = hipLaunchCooperativeKernel((const void*)mega_fwd, dim3(grid), dim3(NTHREADS), args, LDS_BYTES, stream);
    if (e != hipSuccess) fprintf(stderr, "cooperative launch failed: %s (grid %d)\n", hipGetErrorString(e), grid);
}
```

```cpp
#include <hip/hip_runtime.h>
#include <hip/hip_cooperative_groups.h>
#include <cstdio>
#include <cstdint>
#include <cmath>
namespace cg = cooperative_groups;
namespace pg8 {
#define PG8_LAS __attribute__((address_space(3)))
typedef unsigned short bf16_t;
typedef short bf16x8 __attribute__((ext_vector_type(8)));
typedef float f32x4 __attribute__((ext_vector_type(4)));
typedef unsigned u32x4 __attribute__((ext_vector_type(4)));
constexpr int BM = 256, BK = 64, HALF = 128, HTB = HALF * BK * 2  , STAGE_BYTES = 8 * HTB, NXCD = 8, WGM = 8;

__host__ __device__ __forceinline__ int lds_byte(int r, int c) { const int st = (r >> 4) * 2 + (c >> 5), rr = r & 15, cc = c & 31, ob = rr * 64 + cc * 2; return st * 1024 + (ob ^ (((ob >> 9) & 1) << 5)); }
__host__ __device__ __forceinline__ void stage_rc(int b, int& R, int& C) { const int st = b / 1024, sb = b % 1024, swz = sb ^ (((sb >> 9) & 1) << 5); R = (st >> 1) * 16 + swz / 64; C = (st & 1) * 32 + (swz % 64) / 2; }
__host__ __device__ __forceinline__ int perm32(int rho) { const int n = rho >> 4, i = rho & 15; return 8 * (i >> 2) + 4 * n + (i & 3); }

struct Unit { int pm, pn; };
struct Gemm { const bf16_t* A; const bf16_t* Bt; int M, N, K; int a_rows = 256; };

struct StaticOrder {
    int nM, nN, nwg, G, c;
    __host__ __device__ void init(int M, int N, int G_, int c_) { nM = M / BM; nN = N / BM; nwg = nM * nN; G = G_; c = c_; }
    __host__ __device__ bool next(int i, Unit& u) const {
        const long L = (long)i * G + c; if (L >= nwg) return false;
        int wgid = (int)L; { const int q = nwg / NXCD, r = nwg % NXCD, xcd = wgid % NXCD, off = wgid / NXCD; wgid = (xcd < r ? xcd * (q + 1) : r * (q + 1) + (xcd - r) * q) + off; }
        const int nig = WGM * nN, gid = wgid / nig, fm = gid * WGM, gsz = (nM - fm) < WGM ? (nM - fm) : WGM;
        u.pm = fm + ((wgid % nig) % gsz); u.pn = (wgid % nig) / gsz; return true;
    }
    __device__ __forceinline__ void a_ready(const Unit&) const {}
    __device__ __forceinline__ void done(const Unit&) const {}
};

__device__ __forceinline__ unsigned cvt_pk_bf16(float lo, float hi) { unsigned r; asm volatile("v_cvt_pk_bf16_f32 %0, %1, %2" : "=v"(r) : "v"(lo), "v"(hi)); return r; }
struct EpiBf16S {
    static constexpr bool PERM = true, AFTER_DRAIN = false;
    bf16_t* O; int ldc; unsigned scalemask; float sc;
    __device__ __forceinline__ void operator()(const f32x4 (&acc)[2][2][4][2], const Unit& u, int wr, int wc, int fr, int fq) const {
        const int row0 = u.pm * BM + wr * 64 + fr; const int col0 = u.pn * BM + wc * 32 + 8 * fq;
        const float s = ((scalemask >> u.pn) & 1u) ? sc : 1.f;
#pragma unroll
        for (int ai = 0; ai < 2; ++ai)
#pragma unroll
            for (int m = 0; m < 4; ++m) { bf16_t* rowp = O + (size_t)(row0 + ai * HALF + m * 16) * ldc + col0;
#pragma unroll
                for (int bj = 0; bj < 2; ++bj) { f32x4 v0 = acc[ai][bj][m][0] * s, v1 = acc[ai][bj][m][1] * s;
                    u32x4 w; w.x = cvt_pk_bf16(v0[0], v0[1]); w.y = cvt_pk_bf16(v0[2], v0[3]); w.z = cvt_pk_bf16(v1[0], v1[1]); w.w = cvt_pk_bf16(v1[2], v1[3]);
                    *(u32x4*)(rowp + bj * HALF) = w; } }
    }
};
struct EpiRes {
    static constexpr bool PERM = false, AFTER_DRAIN = false;
    const float* base; float* out; int ldc;
    __device__ __forceinline__ void operator()(const f32x4 (&acc)[2][2][4][2], const Unit& u, int wr, int wc, int fr, int fq) const {
        const int col0 = u.pn * BM + wc * 32 + 4 * fq;
#pragma unroll
        for (int ai = 0; ai < 2; ++ai)
#pragma unroll
            for (int m = 0; m < 4; ++m) { const size_t off = (size_t)(u.pm * BM + ai * HALF + wr * 64 + m * 16 + fr) * ldc + col0;
#pragma unroll
                for (int bj = 0; bj < 2; ++bj)
#pragma unroll
                    for (int n = 0; n < 2; ++n) { const f32x4 bs = *(const f32x4*)(base + off + bj * HALF + n * 16); *(f32x4*)(out + off + bj * HALF + n * 16) = bs + acc[ai][bj][m][n]; }
                asm volatile("" ::: "memory"); }
    }
};

struct EpiBf16S2 {
    static constexpr bool PERM = true, AFTER_DRAIN = false;
    bf16_t* O; int ldc; unsigned scalemask; float sc; const float* ssq;
    __device__ __forceinline__ void operator()(const f32x4 (&acc)[2][2][4][2], const Unit& u, int wr, int wc, int fr, int fq) const {
        const int row0 = u.pm * BM + wr * 64 + fr; const int col0 = u.pn * BM + wc * 32 + 8 * fq;
        const float s = ((scalemask >> u.pn) & 1u) ? sc : 1.f;
#pragma unroll
        for (int ai = 0; ai < 2; ++ai)
#pragma unroll
            for (int m = 0; m < 4; ++m) { const int row = row0 + ai * HALF + m * 16; bf16_t* rowp = O + (size_t)row * ldc + col0;
                const float rs = s / sqrtf(ssq[row] * (1.f / 1024.f) + 1e-6f);
#pragma unroll
                for (int bj = 0; bj < 2; ++bj) { f32x4 v0 = acc[ai][bj][m][0] * rs, v1 = acc[ai][bj][m][1] * rs;
                    u32x4 w; w.x = cvt_pk_bf16(v0[0], v0[1]); w.y = cvt_pk_bf16(v0[2], v0[3]); w.z = cvt_pk_bf16(v1[0], v1[1]); w.w = cvt_pk_bf16(v1[2], v1[3]);
                    *(u32x4*)(rowp + bj * HALF) = w; } }
    }
};
typedef unsigned u32x2e __attribute__((ext_vector_type(2)));
struct EpiRes2 {
    static constexpr bool PERM = true, AFTER_DRAIN = false;
    const float* base; float* out; bf16_t* xb; float* ssq; int ldc;
    __device__ __forceinline__ void operator()(const f32x4 (&acc)[2][2][4][2], const Unit& u, int wr, int wc, int fr, int fq) const {
        const int col0 = u.pn * BM + wc * 32 + 8 * fq;
#pragma unroll
        for (int ai = 0; ai < 2; ++ai)
#pragma unroll
            for (int m = 0; m < 4; ++m) { const int row = u.pm * BM + ai * HALF + wr * 64 + m * 16 + fr; const size_t off = (size_t)row * ldc + col0; float ps = 0.f;
#pragma unroll
                for (int bj = 0; bj < 2; ++bj) {
                    const f32x4 b0 = *(const f32x4*)(base + off + bj * HALF), b1 = *(const f32x4*)(base + off + bj * HALF + 4);
                    const f32x4 v0 = b0 + acc[ai][bj][m][0], v1 = b1 + acc[ai][bj][m][1];
                    *(f32x4*)(out + off + bj * HALF) = v0; *(f32x4*)(out + off + bj * HALF + 4) = v1;
                    if (xb != nullptr) { ps += ((v0[0] * v0[0] + v0[1] * v0[1]) + (v0[2] * v0[2] + v0[3] * v0[3])) + ((v1[0] * v1[0] + v1[1] * v1[1]) + (v1[2] * v1[2] + v1[3] * v1[3]));
                        u32x4 w; w.x = cvt_pk_bf16(v0[0], v0[1]); w.y = cvt_pk_bf16(v0[2], v0[3]); w.z = cvt_pk_bf16(v1[0], v1[1]); w.w = cvt_pk_bf16(v1[2], v1[3]); *(u32x4*)(xb + off + bj * HALF) = w; } }
                if (xb != nullptr) { ps += __shfl_xor(ps, 16); ps += __shfl_xor(ps, 32);
                    if (fq == 0) atomicAdd(ssq + row, ps); }
                asm volatile("" ::: "memory"); }
    }
};

struct EpiNull {
    static constexpr bool PERM = false, AFTER_DRAIN = false;
    __device__ __forceinline__ void operator()(const f32x4 (&acc)[2][2][4][2], const Unit& u, int wr, int wc, int fr, int fq) const {
#pragma unroll
        for (int ai = 0; ai < 2; ++ai)
#pragma unroll
            for (int bj = 0; bj < 2; ++bj)
#pragma unroll
                for (int m = 0; m < 4; ++m)
#pragma unroll
                    for (int n = 0; n < 2; ++n) asm volatile("" :: "v"(acc[ai][bj][m][n]));
    }
};

#define PG8_DPP(old, src, ctrl) __builtin_bit_cast(float, __builtin_amdgcn_update_dpp(__builtin_bit_cast(int, (float)(old)), __builtin_bit_cast(int, (float)(src)), (ctrl), 0xF, 0xF, false))
struct EpiConv {
    static constexpr bool PERM = true, AFTER_DRAIN = false;
    bf16_t* G; const float* ssq; const float* cw; const float* cb; int slmask; PG8_LAS float* xch; int nrows;
    __device__ __forceinline__ void operator()(f32x4 (&acc)[2][2][4][2], const Unit& u, int wr, int wc, int fr, int fq) const {
        const int t0 = 254 * u.pm - 1 + wr * 64 + fr;
#pragma unroll
        for (int ai = 0; ai < 2; ++ai)
#pragma unroll
            for (int m = 0; m < 4; ++m) { int t = t0 + ai * HALF + m * 16; t = t < 0 ? 0 : (t > nrows - 1 ? nrows - 1 : t);
                const float rs = 1.f / sqrtf(ssq[t] * (1.f / 1024.f) + 1e-6f);
#pragma unroll
                for (int bj = 0; bj < 2; ++bj)
#pragma unroll
                    for (int n = 0; n < 2; ++n) acc[ai][bj][m][n] *= rs; }
        if (fr == 0 || fr == 15) { const int which = fr == 0 ? 0 : 1, m = fr == 0 ? 0 : 3;
#pragma unroll
            for (int ai = 0; ai < 2; ++ai) { PG8_LAS float* d = xch + ((((2 * ai + wr) * 2 + which) * 4 + wc) * 4 + fq) * 16;
#pragma unroll
                for (int bj = 0; bj < 2; ++bj)
#pragma unroll
                    for (int n = 0; n < 2; ++n) *(PG8_LAS f32x4*)(d + bj * 8 + n * 4) = fr == 0 ? acc[ai][bj][0][n] : acc[ai][bj][3][n]; }
            (void)m; }
        asm volatile("s_waitcnt lgkmcnt(0)" ::: "memory"); __builtin_amdgcn_s_barrier(); asm volatile("" ::: "memory");
        const int ch0 = u.pn * 128 + wc * 32 + 8 * fq;
#pragma unroll
        for (int n = 0; n < 2; ++n) {
            const int chn = ch0 + 4 * n;
            const f32x4 wg0 = *(const f32x4*)(cw + chn), wg1 = *(const f32x4*)(cw + 5632 + chn), wg2 = *(const f32x4*)(cw + 2 * 5632 + chn), bgv = *(const f32x4*)(cb + chn);
            const f32x4 wv0 = *(const f32x4*)(cw + 2816 + chn), wv1 = *(const f32x4*)(cw + 5632 + 2816 + chn), wv2 = *(const f32x4*)(cw + 2 * 5632 + 2816 + chn), bvv = *(const f32x4*)(cb + 2816 + chn);
#pragma unroll
            for (int ai = 0; ai < 2; ++ai)
#pragma unroll
                for (int m = 0; m < 4; ++m) {
                    const int lr = ai * HALF + wr * 64 + m * 16 + fr, t = 254 * u.pm - 1 + lr;
                    const int gidx = 2 * ai + wr;
                    f32x4 pv[2], nx[2];
#pragma unroll
                    for (int bj = 0; bj < 2; ++bj) {
                        f32x4 upo, dno;
                        if (m > 0) { const f32x4 s = acc[ai][bj][m - 1][n];
#pragma unroll
                            for (int j = 0; j < 4; ++j) upo[j] = PG8_DPP(0.f, s[j], 0x121); }
                        else upo = gidx > 0 ? *(const PG8_LAS f32x4*)(xch + ((((gidx - 1) * 2 + 1) * 4 + wc) * 4 + fq) * 16 + bj * 8 + n * 4) : (f32x4){0.f, 0.f, 0.f, 0.f};
                        if (m < 3) { const f32x4 s = acc[ai][bj][m + 1][n];
#pragma unroll
                            for (int j = 0; j < 4; ++j) dno[j] = PG8_DPP(0.f, s[j], 0x12F); }
                        else dno = gidx < 3 ? *(const PG8_LAS f32x4*)(xch + ((((gidx + 1) * 2 + 0) * 4 + wc) * 4 + fq) * 16 + bj * 8 + n * 4) : (f32x4){0.f, 0.f, 0.f, 0.f};
                        const f32x4 cur = acc[ai][bj][m][n];
#pragma unroll
                        for (int j = 0; j < 4; ++j) { pv[bj][j] = PG8_DPP(upo[j], cur[j], 0x111);
                                                       nx[bj][j] = PG8_DPP(dno[j], cur[j], 0x101); }
                    }
                    const bool sfirst = (t & slmask) == 0, slast = (t & slmask) == slmask;
                    float res[4];
#pragma unroll
                    for (int j = 0; j < 4; ++j) {
                        const float gp = sfirst ? 0.f : pv[0][j], gn = slast ? 0.f : nx[0][j], vp = sfirst ? 0.f : pv[1][j], vn = slast ? 0.f : nx[1][j];
                        const float gate = gp * wg0[j] + acc[ai][0][m][n][j] * wg1[j] + gn * wg2[j] + bgv[j];
                        const float val = vp * wv0[j] + acc[ai][1][m][n][j] * wv1[j] + vn * wv2[j] + bvv[j];
                        res[j] = gate * __builtin_amdgcn_rcpf(1.f + __builtin_amdgcn_exp2f(-1.4426950408889634f * gate)) * val;
                    }
                    if (lr >= 1 && lr <= 254 && t < nrows) { u32x2e w; w.x = cvt_pk_bf16(res[0], res[1]); w.y = cvt_pk_bf16(res[2], res[3]); *(u32x2e*)(G + (size_t)t * 2816 + chn) = w; }
                }
        }
    }
};
template <class Epi, class Sched, bool ALIGN_EPI = false, bool SP2 = false>
__device__ __forceinline__ void gemm_phase(PG8_LAS unsigned char* lds, const Gemm g, const Sched& S, const Epi& E) {
    int tid_l = threadIdx.x; asm volatile("" : "+v"(tid_l)); const int tid = tid_l, wid = __builtin_amdgcn_readfirstlane(tid >> 6), lane = tid & 63, wr = wid >> 2, wc = wid & 3, fr = lane & 15, fq = lane >> 4;
    const int K = g.K, nt = K / BK;
    unsigned voffA[2], voffB[2];
#pragma unroll
    for (int i = 0; i < 2; ++i) { int R, C; stage_rc(tid * 16 + i * 8192, R, C); const int Rb = Epi::PERM ? ((R & ~31) + perm32(R & 31)) : R;
        voffA[i] = (unsigned)(R * K + C) * 2u; voffB[i] = (unsigned)(Rb * K + C) * 2u; }
    const size_t kstep = (size_t)(BK * 2);
    const size_t hstep = (size_t)HALF * K * 2;
    const size_t tstep = 2 * hstep; const size_t tstepA = (size_t)g.a_rows * K * 2;
    const unsigned ldsw = (unsigned)wid * 1024u;
    const int aoff = lds_byte(wr * 64 + fr, fq * 8), boff = lds_byte(wc * 32 + fr, fq * 8);
#define PG8_SA(b, h) (((b) * 2 + (h)) * HTB)
#define PG8_SB(b, h) ((4 + (b) * 2 + (h)) * HTB)
#define PG8_STAGE(bufoff, gbase, voff) do { _Pragma("unroll") for (int _i = 0; _i < 2; ++_i) \
        __builtin_amdgcn_global_load_lds((const unsigned*)((const char*)(gbase) + (voff)[_i]), (PG8_LAS unsigned*)(lds + (bufoff) + ldsw + _i * 8192), 16, 0, 0); } while (0)
#define PG8_LDA(dst, b, h) do { _Pragma("unroll") for (int m = 0; m < 4; ++m) _Pragma("unroll") for (int k = 0; k < 2; ++k) dst[m][k] = *(const PG8_LAS bf16x8*)(lds + PG8_SA(b, h) + aoff + m * 2048 + k * 1024); } while (0)
#define PG8_LDB(dst, b, h) do { _Pragma("unroll") for (int n = 0; n < 2; ++n) _Pragma("unroll") for (int k = 0; k < 2; ++k) dst[n][k] = *(const PG8_LAS bf16x8*)(lds + PG8_SB(b, h) + boff + n * 2048 + k * 1024); } while (0)
#define PG8_MMA(ai, bj, At, Bt) do { __builtin_amdgcn_s_setprio(1); _Pragma("unroll") for (int m = 0; m < 4; ++m) _Pragma("unroll") for (int n = 0; n < 2; ++n) _Pragma("unroll") for (int k = 0; k < 2; ++k) \
        acc[ai][bj][m][n] = __builtin_amdgcn_mfma_f32_16x16x32_bf16(Bt[n][k], At[m][k], acc[ai][bj][m][n], 0, 0, 0); __builtin_amdgcn_s_setprio(0); } while (0)
#define PG8_WAIT_V(n) asm volatile("s_waitcnt vmcnt(" #n ")" ::: "memory")
#define PG8_WAIT_L(n) asm volatile("s_waitcnt lgkmcnt(" #n ")" ::: "memory")
#define PG8_BAR __builtin_amdgcn_s_barrier()
#define PG8_SCHED __builtin_amdgcn_sched_barrier(0)
    Unit cur, nxt; int ui = 0;
    if (!S.next(0, cur)) return;
    f32x4 acc[2][2][4][2];
#pragma unroll
    for (int a = 0; a < 2; ++a)
#pragma unroll
        for (int b = 0; b < 2; ++b)
#pragma unroll
            for (int m = 0; m < 4; ++m)
#pragma unroll
                for (int n = 0; n < 2; ++n) acc[a][b][m][n] = (f32x4){0.f, 0.f, 0.f, 0.f};
    bf16x8 At[4][2], B0[2][2], B1[2][2];
    const char* cA = (const char*)g.A + (size_t)cur.pm * tstepA; const char* cB = (const char*)g.Bt + (size_t)cur.pn * tstep;
    S.a_ready(cur);
    if constexpr (SP2) {
        PG8_STAGE(PG8_SB(0, 0), cB, voffB); PG8_STAGE(PG8_SB(0, 1), cB + hstep, voffB); PG8_STAGE(PG8_SA(0, 0), cA, voffA); PG8_STAGE(PG8_SA(0, 1), cA + hstep, voffA);
        if (wr == 1) PG8_BAR;
        PG8_WAIT_V(2); PG8_BAR;
        PG8_STAGE(PG8_SB(1, 0), cB + kstep, voffB); PG8_STAGE(PG8_SA(1, 0), cA + kstep, voffA); PG8_STAGE(PG8_SB(1, 1), cB + hstep + kstep, voffB);
        PG8_WAIT_V(6); PG8_BAR;
    } else {
        PG8_STAGE(PG8_SB(0, 0), cB, voffB); PG8_STAGE(PG8_SA(0, 0), cA, voffA); PG8_STAGE(PG8_SB(0, 1), cB + hstep, voffB); PG8_STAGE(PG8_SA(0, 1), cA + hstep, voffA);
        if (wr == 1) PG8_BAR;
        PG8_WAIT_V(4); PG8_BAR;
        PG8_STAGE(PG8_SB(1, 0), cB + kstep, voffB); PG8_STAGE(PG8_SA(1, 0), cA + kstep, voffA); PG8_STAGE(PG8_SB(1, 1), cB + hstep + kstep, voffB);
        PG8_WAIT_V(6); PG8_BAR;
    }
    for (;;) {
        const bool has_next = S.next(ui + 1, nxt);
        const char* nA = has_next ? (const char*)g.A + (size_t)nxt.pm * tstepA : cA; const char* nB = has_next ? (const char*)g.Bt + (size_t)nxt.pn * tstep : cB;
        for (int t = 0; t < nt; t += 2) {
            const bool last = (t == nt - 2);
            const char* a1 = cA + (size_t)(t + 1) * kstep;
            const char* a2 = last ? nA : cA + (size_t)(t + 2) * kstep; const char* b2 = last ? nB : cB + (size_t)(t + 2) * kstep;
            const char* a3 = a2 + kstep; const char* b3 = b2 + kstep;
            if (last && has_next) S.a_ready(nxt);
            if constexpr (SP2) {
            PG8_LDB(B0, 0, 0); PG8_LDB(B1, 0, 1); PG8_SCHED; PG8_LDA(At, 0, 0); PG8_STAGE(PG8_SA(1, 1), a1 + hstep, voffA);
            PG8_WAIT_V(8); PG8_WAIT_L(0); PG8_BAR; PG8_MMA(0, 0, At, B0); PG8_MMA(0, 1, At, B1); PG8_BAR; PG8_SCHED;
            PG8_LDA(At, 0, 1); PG8_STAGE(PG8_SB(0, 0), b2, voffB); PG8_STAGE(PG8_SB(0, 1), b2 + hstep, voffB); PG8_STAGE(PG8_SA(0, 0), a2, voffA);
            PG8_WAIT_V(8); PG8_WAIT_L(0); PG8_BAR; PG8_MMA(1, 0, At, B0); PG8_MMA(1, 1, At, B1); PG8_BAR; PG8_SCHED;
            PG8_LDB(B0, 1, 0); PG8_LDB(B1, 1, 1); PG8_SCHED; PG8_LDA(At, 1, 0); PG8_STAGE(PG8_SA(0, 1), a2 + hstep, voffA);
            PG8_WAIT_V(8); PG8_WAIT_L(0); PG8_BAR; PG8_MMA(0, 0, At, B0); PG8_MMA(0, 1, At, B1); PG8_BAR; PG8_SCHED;
            PG8_LDA(At, 1, 1); PG8_STAGE(PG8_SB(1, 0), b3, voffB); PG8_STAGE(PG8_SB(1, 1), b3 + hstep, voffB); PG8_STAGE(PG8_SA(1, 0), a3, voffA);
            PG8_WAIT_V(8); PG8_WAIT_L(0); PG8_BAR; PG8_MMA(1, 0, At, B0); PG8_MMA(1, 1, At, B1); PG8_BAR; PG8_SCHED;
            } else {
            PG8_LDB(B0, 0, 0); PG8_SCHED; PG8_LDA(At, 0, 0); PG8_STAGE(PG8_SA(1, 1), a1 + hstep, voffA);
            PG8_WAIT_L(8); PG8_BAR; PG8_WAIT_L(0); PG8_MMA(0, 0, At, B0); PG8_BAR; PG8_SCHED;
            PG8_LDB(B1, 0, 1); PG8_STAGE(PG8_SB(0, 0), b2, voffB);
            PG8_BAR; PG8_WAIT_L(0); PG8_MMA(0, 1, At, B1); PG8_BAR;
            PG8_LDA(At, 0, 1); PG8_STAGE(PG8_SA(0, 0), a2, voffA);
            PG8_BAR; PG8_WAIT_L(0); PG8_MMA(1, 0, At, B0); PG8_BAR; PG8_SCHED;
            PG8_STAGE(PG8_SB(0, 1), b2 + hstep, voffB);
            PG8_WAIT_V(6); PG8_BAR; PG8_MMA(1, 1, At, B1); PG8_BAR;
            PG8_LDB(B0, 1, 0); PG8_SCHED; PG8_LDA(At, 1, 0); PG8_STAGE(PG8_SA(0, 1), a2 + hstep, voffA);
            PG8_WAIT_L(8); PG8_BAR; PG8_WAIT_L(0); PG8_MMA(0, 0, At, B0); PG8_BAR; PG8_SCHED;
            PG8_LDB(B1, 1, 1); PG8_STAGE(PG8_SB(1, 0), b3, voffB);
            PG8_BAR; PG8_WAIT_L(0); PG8_MMA(0, 1, At, B1); PG8_BAR;
            PG8_LDA(At, 1, 1); PG8_STAGE(PG8_SA(1, 0), a3, voffA);
            PG8_BAR; PG8_WAIT_L(0); PG8_MMA(1, 0, At, B0); PG8_BAR; PG8_SCHED;
            PG8_STAGE(PG8_SB(1, 1), b3 + hstep, voffB);
            PG8_WAIT_V(6); PG8_BAR; PG8_MMA(1, 1, At, B1); PG8_BAR;
            }
        }
        if constexpr (ALIGN_EPI) { if (wr == 0) PG8_BAR; }
        if constexpr (!Epi::AFTER_DRAIN) { E(acc, cur, wr, wc, fr, fq); S.done(cur); }
        if (!has_next) break;
#pragma unroll
        for (int a = 0; a < 2; ++a)
#pragma unroll
            for (int b = 0; b < 2; ++b)
#pragma unroll
                for (int m = 0; m < 4; ++m)
#pragma unroll
                    for (int n = 0; n < 2; ++n) acc[a][b][m][n] = (f32x4){0.f, 0.f, 0.f, 0.f};
        cur = nxt; cA = nA; cB = nB; ++ui;
        if constexpr (ALIGN_EPI) { if (wr == 1) PG8_BAR; }
    }
    PG8_WAIT_V(0);
    if constexpr (!ALIGN_EPI) { if (wr == 0) PG8_BAR; }
    PG8_BAR;
    if constexpr (Epi::AFTER_DRAIN) { E.fused(acc, cur, wr, wc, fr, fq, lds, wid, lane); S.done(cur); }
#undef PG8_SA
#undef PG8_SB
#undef PG8_STAGE
#undef PG8_LDA
#undef PG8_LDB
#undef PG8_MMA
#undef PG8_WAIT_V
#undef PG8_WAIT_L
#undef PG8_BAR
#undef PG8_SCHED
}
}
typedef __bf16 bf16x2_t __attribute__((ext_vector_type(2)));
__device__ __forceinline__ unsigned cvt_pk(float lo, float hi) { float __attribute__((ext_vector_type(2))) v = {lo, hi}; bf16x2_t b = __builtin_convertvector(v, bf16x2_t); return __builtin_bit_cast(unsigned, b); }
#define LAS __attribute__((address_space(3)))
#define XB_TMO      128
#define XB_XCNT(j)  (256  + 64 * (j))
#define XB_XSUB(j)  (1280 + 64 * (j))
#define XB_XGEN(j)  (2304 + 64 * (j))
#define XB_TOP      3328
#define XB_TOPGEN   3392
#define XCD_BAR_WORDS 3456
#define XB_SPIN_CAP (1u << 18)

__device__ __forceinline__ unsigned xb_ld(unsigned* p)              { return __hip_atomic_load(p, __ATOMIC_RELAXED, __HIP_MEMORY_SCOPE_AGENT); }
__device__ __forceinline__ unsigned xb_add(unsigned* p, unsigned v) { return __hip_atomic_fetch_add(p, v, __ATOMIC_RELAXED, __HIP_MEMORY_SCOPE_AGENT); }
__device__ __forceinline__ unsigned xb_xcc_id() { return (unsigned)__builtin_amdgcn_s_getreg((3 << 11) | 20) & 0xFu; }
#define XB_SPIN(cond, bar) do { unsigned _sp = 0; while (cond) { __builtin_amdgcn_s_sleep(1); \
    if ((++_sp & 255u) == 0u) { if (xb_ld(&(bar)[XB_TMO])) break; if (_sp > XB_SPIN_CAP) { atomicAdd(&(bar)[XB_TMO], 1u); break; } } } } while (0)

struct XcdBarrier {
    unsigned* bar; unsigned x;
    volatile LAS unsigned* st;
};

__device__ __forceinline__ XcdBarrier xcd_barrier_post(unsigned* bar, volatile LAS unsigned* st) {
    XcdBarrier b; b.bar = bar; b.x = xb_xcc_id(); b.st = st;
    if (threadIdx.x == 0) (void)xb_add(&bar[XB_XCNT(b.x)], 1u);
    return b;
}
__device__ __forceinline__ void xcd_barrier_complete(unsigned* bar, unsigned x, unsigned& nloc, unsigned& nx) {
    const unsigned G = gridDim.x * gridDim.y * gridDim.z;
    unsigned sum, cnt, mine, sp = 0u;
    for (;;) {
        sum = 0u; cnt = 0u; mine = 0u;
#pragma unroll
        for (unsigned j = 0; j < 16; ++j) { const unsigned c = xb_ld(&bar[XB_XCNT(j)]); sum += c; cnt += (c > 0u) ? 1u : 0u; mine = (j == x) ? c : mine; }
        if (sum == G) break;
        __builtin_amdgcn_s_sleep(1);
        if ((++sp & 255u) == 0u) { if (xb_ld(&bar[XB_TMO])) break; if (sp > XB_SPIN_CAP) { atomicAdd(&bar[XB_TMO], 1u); break; } }
    }
    nloc = mine > 0u ? mine : 1u; nx = cnt > 0u ? cnt : 1u;
}

__device__ __forceinline__ void xcd_barrier(const XcdBarrier& b) {
    asm volatile("s_waitcnt vmcnt(0)" ::: "memory");
    __syncthreads();
    if (threadIdx.x == 0) {
        unsigned* bar = b.bar;
        __builtin_amdgcn_s_waitcnt(0);
        unsigned nloc = b.st[0], nx = b.st[1];
        if (nloc == 0u) { xcd_barrier_complete(bar, b.x, nloc, nx); b.st[0] = nloc; b.st[1] = nx; }
        const unsigned old = xb_add(&bar[XB_XSUB(b.x)], 1u);
        const unsigned gen = old / nloc;
        if (old + 1u == (gen + 1u) * nloc) {
            __builtin_amdgcn_fence(__ATOMIC_RELEASE, "agent");
            asm volatile("s_waitcnt vmcnt(0)" ::: "memory");
            const unsigned og = xb_add(&bar[XB_TOP], 1u);
            const unsigned tg = og / nx;
            if (og + 1u == (tg + 1u) * nx) xb_add(&bar[XB_TOPGEN], 1u);
            else XB_SPIN(xb_ld(&bar[XB_TOPGEN]) == tg, bar);
            __builtin_amdgcn_fence(__ATOMIC_ACQUIRE, "agent");
            xb_add(&bar[XB_XGEN(b.x)], 1u);
            asm volatile("s_waitcnt vmcnt(0)" ::: "memory");
        } else {
            XB_SPIN(xb_ld(&bar[XB_XGEN(b.x)]) == gen, bar);
            __builtin_amdgcn_fence(__ATOMIC_ACQUIRE, "agent");
            asm volatile("s_waitcnt vmcnt(0)" ::: "memory");
        }
    }
    __syncthreads();
}
typedef unsigned short bf16_t;
typedef short bf16x8 __attribute__((ext_vector_type(8)));
typedef short s16x4 __attribute__((ext_vector_type(4)));
typedef float f32x16 __attribute__((ext_vector_type(16)));
typedef float f32x4 __attribute__((ext_vector_type(4)));
typedef float f32x2 __attribute__((ext_vector_type(2)));
typedef unsigned u32x4 __attribute__((ext_vector_type(4)));
typedef unsigned u32x2 __attribute__((ext_vector_type(2)));

constexpr int DM = 1024, DIN = 4352, DFF = 2816, DUP = 2 * DFF, DEPTH = 2;
constexpr int CH_ROWS = 16384, NCHUNK = 3;
constexpr int TW = 784;
constexpr int T_C = 0, T_L = 768;
constexpr float LOG2E = 1.4426950408889634f, LN2 = 0.6931471805599453f;
constexpr float QSCALE = 0.125f * LOG2E;
constexpr size_t MiB = 1u << 20;
constexpr size_t WS_WIN = 0, WS_WOUT = 18 * MiB, WS_WUP = 22 * MiB, WS_WDN = 44 * MiB, WS_HB = 56 * MiB, WS_PROJ = 88 * MiB, WS_TMP = 264 * MiB, WS_CTL = 394 * MiB, WS_XB = 395 * MiB, WS_SSQ = 459 * MiB, WS_END = 460 * MiB;
constexpr int LDS_BYTES = 147456 + 256 + 8192;
constexpr int NTHREADS = 512;

struct Args { const float* in[17]; float* out; unsigned char* ws; };

__device__ __forceinline__ float wave_sum(float v) {
#pragma unroll
    for (int o = 1; o < 64; o <<= 1) v += __shfl_xor(v, o);
    return v;
}
__device__ __forceinline__ unsigned f2bf(float f) { unsigned u = __builtin_bit_cast(unsigned, f); return (u + 0x7fffu + ((u >> 16) & 1u)) >> 16; }
__device__ __forceinline__ unsigned pk2(float lo, float hi) { return f2bf(lo) | (f2bf(hi) << 16); }
__device__ __forceinline__ float bf2f(unsigned short b) { return __builtin_bit_cast(float, (unsigned)b << 16); }

__device__ __forceinline__ void transpose_item(const float* W, int K, int N, bf16_t* WT, LAS float* scr, int item, int lane, const float* gain, bool gate_perm = false) {
    const int nblk = N / 32, kb = item / nblk, nb = item % nblk, k0 = 64 * kb, n0 = 32 * nb;
#pragma unroll 8
    for (int i = 0; i < 32; ++i) { const int kk = 2 * i + (lane >> 5); scr[kk * 33 + (lane & 31)] = W[(size_t)(k0 + kk) * N + n0 + (lane & 31)] * (gain ? gain[k0 + kk] : 1.f); }
    asm volatile("s_waitcnt lgkmcnt(0)" ::: "memory");
    const int c = lane & 7;
    const int half_ = N / 2, v_ = n0 >= half_ ? n0 - half_ : n0, d0 = gate_perm ? 256 * (v_ / 128) + (n0 >= half_ ? 128 : 0) + (v_ % 128) : n0;
#pragma unroll
    for (int j = 0; j < 4; ++j) { const int n = (lane >> 3) + 8 * j; const LAS float* s = scr + (8 * c) * 33 + n;
        u32x4 o; o.x = pk2(s[0 * 33], s[1 * 33]); o.y = pk2(s[2 * 33], s[3 * 33]); o.z = pk2(s[4 * 33], s[5 * 33]); o.w = pk2(s[6 * 33], s[7 * 33]);
        *(u32x4*)(WT + (size_t)(d0 + n) * K + k0 + 8 * c) = o; }
    asm volatile("s_waitcnt lgkmcnt(0)" ::: "memory");
}

__device__ __forceinline__ void rms_row_to_bf16(const float* xrow, const float* gain, bf16_t* orow, int lane) {
    const f32x4* xr = (const f32x4*)xrow + lane; const f32x4* gr = (const f32x4*)gain + lane;
    f32x4 v[4]; float s = 0.f;
#pragma unroll
    for (int j = 0; j < 4; ++j) { v[j] = xr[64 * j]; s += (v[j].x * v[j].x + v[j].y * v[j].y) + (v[j].z * v[j].z + v[j].w * v[j].w); }
    const float rstd = 1.f / sqrtf(wave_sum(s) * (1.f / DM) + 1e-6f);
    u32x2* o8 = (u32x2*)orow + lane;
#pragma unroll
    for (int j = 0; j < 4; ++j) { const f32x4 g = gr[64 * j]; u32x2 w; w.x = pk2(v[j].x * rstd * g.x, v[j].y * rstd * g.y); w.y = pk2(v[j].z * rstd * g.z, v[j].w * rstd * g.w); o8[64 * j] = w; }
}
__device__ __forceinline__ void rms_row_f32(float* xrow, const float* gain, int lane) {
    f32x4* xr = (f32x4*)xrow + lane; const f32x4* gr = (const f32x4*)gain + lane;
    f32x4 v[4]; float s = 0.f;
#pragma unroll
    for (int j = 0; j < 4; ++j) { v[j] = xr[64 * j]; s += (v[j].x * v[j].x + v[j].y * v[j].y) + (v[j].z * v[j].z + v[j].w * v[j].w); }
    const float rstd = 1.f / sqrtf(wave_sum(s) * (1.f / DM) + 1e-6f);
#pragma unroll
    for (int j = 0; j < 4; ++j) { const f32x4 g = gr[64 * j]; xr[64 * j] = v[j] * rstd * g; }
}

constexpr int KSTR = 144;
constexpr int ATT_K_OFF = 0, ATT_V_OFF = 2 * 64 * KSTR, ATT_SCR_OFF = ATT_V_OFF + 2 * 64 * 320;
__device__ __forceinline__ int crow(int r, int hi) { return (r & 3) + 8 * (r >> 2) + 4 * hi; }
typedef short v4i16_t __attribute__((ext_vector_type(4)));
__device__ __forceinline__ s16x4 vtr(const LAS unsigned char* p) { return __builtin_bit_cast(s16x4, __builtin_amdgcn_ds_read_tr16_b64_v4i16((LAS v4i16_t*)p)); }

template <int VD, bool WIN>
__device__ __forceinline__ void attn_unit(LAS unsigned char* lds, const bf16_t* Qp, const bf16_t* Kp, const bf16_t* Vp, size_t pitch,
                                          int q0, int L, float slope2, int W, float m_init, float l_init,
                                          float* Oout, size_t opitch, float* lse_out, size_t lpitch, bf16_t* Obf) {
    constexpr int VSTR = VD * 2 + 64, ND = VD / 32, VCH = VD / 8, VLD = 64 * VCH / NTHREADS;
    int tid_l = threadIdx.x; asm volatile("" : "+v"(tid_l)); const int tid = tid_l, lane = tid & 63, r32 = lane & 31, hi = lane >> 5, wid = __builtin_amdgcn_readfirstlane(tid >> 6);
    const int qw = q0 + wid * 32;
    int tlo = 0, thi = L / 64;
    if (WIN) { const int a = q0 - W; tlo = a > 0 ? a / 64 : 0; const int b = q0 + 256 + W; thi = (b < L ? b : L) / 64; }
    bf16x8 qr[4];
    { const bf16_t* qrow = Qp + (size_t)(qw + r32) * pitch + hi * 8;
#pragma unroll
      for (int d0 = 0; d0 < 4; ++d0) qr[d0] = *(const bf16x8*)(qrow + d0 * 16); }
    f32x16 o[ND];
#pragma unroll
    for (int d = 0; d < ND; ++d)
#pragma unroll
        for (int r = 0; r < 16; ++r) o[d][r] = 0.f;
    float m = m_init, l = hi == 0 ? l_init : 0.f;
    LAS float* wsf = (LAS float*)(lds + 6 * (64 * KSTR + 64 * (VD * 2 + 64))) + wid * 64;
    static_assert(VD == 64, "grouped staging is sized for 64-wide values");
    constexpr int SLOT = 64 * KSTR + 64 * VSTR, GRP = 6;
    const int krow = tid >> 3, kch = tid & 7;
    const float Wf = (float)W;
    for (int g0 = tlo; g0 < thi; g0 += GRP) {
        const int ng = thi - g0 < GRP ? thi - g0 : GRP;
        u32x4 kr[GRP], vr[GRP];
#pragma unroll
        for (int j = 0; j < GRP; ++j) if (j < ng) { kr[j] = *(const u32x4*)(Kp + (size_t)(64 * (g0 + j) + krow) * pitch + kch * 8); vr[j] = *(const u32x4*)(Vp + (size_t)(64 * (g0 + j) + krow) * pitch + kch * 8); }
        if (g0 != tlo) __syncthreads();
#pragma unroll
        for (int j = 0; j < GRP; ++j) if (j < ng) { *(LAS u32x4*)(lds + j * SLOT + krow * KSTR + kch * 16) = kr[j]; *(LAS u32x4*)(lds + j * SLOT + 64 * KSTR + krow * VSTR + kch * 16) = vr[j]; }
        __syncthreads();
      for (int j = 0; j < ng; ++j) {
        const int t = g0 + j;
        bool active = true;
        if (WIN) { const int kb = 64 * t; active = (kb + 63 >= qw - W) && (kb <= qw + 31 + W); }
        if (active) {
            const LAS unsigned char* Kb = lds + j * SLOT + r32 * KSTR + hi * 16;
            f32x16 p0, p1;
#pragma unroll
            for (int r = 0; r < 16; ++r) { p0[r] = 0.f; p1[r] = 0.f; }
#pragma unroll
            for (int d0 = 0; d0 < 4; ++d0) {
                const bf16x8 a0 = *(const LAS bf16x8*)(Kb + d0 * 32), a1 = *(const LAS bf16x8*)(Kb + 32 * KSTR + d0 * 32);
                p0 = __builtin_amdgcn_mfma_f32_32x32x16_bf16(a0, qr[d0], p0, 0, 0, 0);
                p1 = __builtin_amdgcn_mfma_f32_32x32x16_bf16(a1, qr[d0], p1, 0, 0, 0);
                if (d0 & 1) __builtin_amdgcn_sched_barrier(0);
            }
            const float dq = (float)(64 * t + 4 * hi - (qw + r32));
            float rm = -INFINITY;
#pragma unroll
            for (int r = 0; r < 16; ++r) {
                const float t0 = dq + (float)((r & 3) + 8 * (r >> 2)), t1 = t0 + 32.f;
                p0[r] = __builtin_fmaf(-slope2, __builtin_fabsf(t0), p0[r]);
                p1[r] = __builtin_fmaf(-slope2, __builtin_fabsf(t1), p1[r]);
                if (WIN) { if (__builtin_fabsf(t0) > Wf) p0[r] = -INFINITY; if (__builtin_fabsf(t1) > Wf) p1[r] = -INFINITY; }
                rm = __builtin_fmaxf(rm, __builtin_fmaxf(p0[r], p1[r]));
            }
            rm = __builtin_fmaxf(rm, __shfl_xor(rm, 32));
            if (__any(rm > m)) {
                const float mn = __builtin_fmaxf(m, rm); const float f = __builtin_amdgcn_exp2f(m - mn); m = mn; l *= f;
                if (hi == 0) wsf[r32] = f;
#pragma unroll
                for (int r = 0; r < 16; ++r) { const float fr = wsf[crow(r, hi)];
#pragma unroll
                    for (int d = 0; d < ND; ++d) o[d][r] *= fr; }
            }
            float ls = 0.f;
#pragma unroll
            for (int r = 0; r < 16; ++r) { p0[r] = __builtin_amdgcn_exp2f(p0[r] - m); p1[r] = __builtin_amdgcn_exp2f(p1[r] - m); ls += p0[r] + p1[r]; }
            l += ls;
            u32x4 pw[4];
#pragma unroll
            for (int c = 0; c < 4; ++c) {
                const f32x16& P = (c >> 1) ? p1 : p0; const int b = 8 * (c & 1);
                pw[c].x = cvt_pk(P[b + 0], P[b + 1]); pw[c].y = cvt_pk(P[b + 2], P[b + 3]); pw[c].z = cvt_pk(P[b + 4], P[b + 5]); pw[c].w = cvt_pk(P[b + 6], P[b + 7]);
            }
            const LAS unsigned char* Vb = lds + j * SLOT + 64 * KSTR + (4 * hi + ((lane & 15) >> 2)) * VSTR + (16 * ((lane >> 4) & 1) + 4 * (lane & 3)) * 2;
#pragma unroll
            for (int c = 0; c < 4; ++c)
#pragma unroll
                for (int d = 0; d < ND; ++d) {
                    const s16x4 vlo = vtr(Vb + c * 16 * VSTR + d * 64), vhi = vtr(Vb + c * 16 * VSTR + 8 * VSTR + d * 64);
                    const bf16x8 vf = (bf16x8){vlo[0], vlo[1], vlo[2], vlo[3], vhi[0], vhi[1], vhi[2], vhi[3]};
                    o[d] = __builtin_amdgcn_mfma_f32_32x32x16_bf16(__builtin_bit_cast(bf16x8, pw[c]), vf, o[d], 0, 0, 0);
                    if (d == ND - 1) __builtin_amdgcn_sched_barrier(0);
                }
        }
      }
    }
    l += __shfl_xor(l, 32);
    if (hi == 0) wsf[r32] = 1.f / l;
#pragma unroll
    for (int r = 0; r < 16; ++r) { const float ir = wsf[crow(r, hi)];
        if (Obf != nullptr) { bf16_t* orow = Obf + (size_t)(qw + crow(r, hi)) * opitch + r32;
#pragma unroll
            for (int d = 0; d < ND; ++d) orow[d * 32] = (bf16_t)f2bf(o[d][r] * ir);
        } else { float* orow = Oout + (size_t)(qw + crow(r, hi)) * opitch + r32;
#pragma unroll
            for (int d = 0; d < ND; ++d) orow[d * 32] = o[d][r] * ir; } }
    if (lse_out != nullptr && hi == 0) lse_out[(size_t)(qw + r32) * lpitch] = (m + __builtin_log2f(l)) * LN2;
    __syncthreads();
}

__device__ __forceinline__ void row_to_bf16_ssq(const float* xrow, bf16_t* orow, float* ssq, int lane) {
    const f32x4* xr = (const f32x4*)xrow + lane;
    f32x4 v[4]; float s = 0.f;
#pragma unroll
    for (int j = 0; j < 4; ++j) { v[j] = xr[64 * j]; s += (v[j].x * v[j].x + v[j].y * v[j].y) + (v[j].z * v[j].z + v[j].w * v[j].w); }
    s = wave_sum(s);
    u32x2* o8 = (u32x2*)orow + lane;
#pragma unroll
    for (int j = 0; j < 4; ++j) { u32x2 w; w.x = pk2(v[j].x, v[j].y); w.y = pk2(v[j].z, v[j].w); o8[64 * j] = w; }
    if (lane == 0) *ssq = s;
}
constexpr int BK_OFF = 0, BV_OFF = 2 * 64 * KSTR, BSCR_OFF = BV_OFF + 3 * 64 * 320, ATT_O0_OFF = BSCR_OFF + 2048;
static_assert(ATT_O0_OFF + 65536 <= 147456, "B attention LDS map");
constexpr float B_THR = 6.0f;
#ifndef B_LATE
#define B_LATE(w) false
#endif
template <int KI> __device__ __forceinline__ float fmamk_t(float a, float c) { float r; asm("v_fmamk_f32 %0, %1, %3, %2" : "=v"(r) : "v"(a), "v"(c), "n"(__builtin_bit_cast(int, (float)KI))); return r; }
__device__ __forceinline__ float max3f(float a, float b, float c) { float r; asm("v_max3_f32 %0, %1, %2, %3" : "=v"(r) : "v"(a), "v"(b), "v"(c)); return r; }
__device__ __forceinline__ void attn_b_unit(LAS unsigned char* lds, const bf16_t* base, int h, int q0, int L, float slope2_, float lam,
                                            const float* subln_l, float postscale, bf16_t* mix) {
    constexpr int VD = 128, VSTR = VD * 2 + 64, ND = 4, VCH = 16, VLD = 2;
    int tid_l = threadIdx.x; asm volatile("" : "+v"(tid_l)); const int tid = tid_l, lane = tid & 63, r32 = lane & 31, hi = lane >> 5, wid = __builtin_amdgcn_readfirstlane(tid >> 6);
    const int qw = q0 + wid * 32, NT = L / 64, c0 = q0 / 64;
    LAS float* wsf = (LAS float*)(lds + BSCR_OFF) + wid * 64;
    const bool late = B_LATE(wid);
    const int krow = tid >> 3, kch = tid & 7;
    const bf16_t* Vp = base + 1536 + h * 128;
    const float qposf_ = (float)(qw + r32);
    for (int mp = 0; mp < 2; ++mp) {
        const bf16_t* Qp = base + 512 + (h * 2 + mp) * 64; const bf16_t* Kp = base + 1024 + (h * 2 + mp) * 64;
        bf16x8 qr[4];
        { const bf16_t* qrow = Qp + (size_t)(qw + r32) * DIN + hi * 8;
#pragma unroll
          for (int d0 = 0; d0 < 4; ++d0) qr[d0] = *(const bf16x8*)(qrow + d0 * 16); }
        f32x16 o[ND];
#pragma unroll
        for (int d = 0; d < ND; ++d)
#pragma unroll
            for (int r = 0; r < 16; ++r) o[d][r] = 0.f;
        float mref = 0.f, l = 0.f;
        u32x4 kreg; u32x4 vreg[VLD];
        const unsigned koff = (unsigned)(krow * DIN + kch * 8) * 2u, voff = (unsigned)((tid >> 4) * DIN + (tid & 15) * 8) * 2u;
#define ATT_GLOAD(t) do { const char* kt_ = (const char*)Kp + (size_t)(t) * (64 * DIN * 2); const char* vt_ = (const char*)Vp + (size_t)(t) * (64 * DIN * 2); \
        kreg = *(const u32x4*)(kt_ + koff); vreg[0] = *(const u32x4*)(vt_ + voff); vreg[1] = *(const u32x4*)(vt_ + 32 * DIN * 2 + voff); } while (0)
#define ATT_LSTORE(b, vs) do { *(LAS u32x4*)(lds + BK_OFF + (b) * 64 * KSTR + krow * KSTR + kch * 16) = kreg; \
        *(LAS u32x4*)(lds + BV_OFF + (vs) * 64 * VSTR + (tid >> 4) * VSTR + (tid & 15) * 16) = vreg[0]; *(LAS u32x4*)(lds + BV_OFF + (vs) * 64 * VSTR + ((tid >> 4) + 32) * VSTR + (tid & 15) * 16) = vreg[1]; } while (0)
#define VFRAG(x, d) (bf16x8){x[d][0][0], x[d][0][1], x[d][0][2], x[d][0][3], x[d][1][0], x[d][1][1], x[d][1][2], x[d][1][3]}
#define PV_LOAD01(vs) do { \
        const LAS unsigned char* Vb = lds + BV_OFF + (vs) * 64 * VSTR + (4 * hi + ((lane & 15) >> 2)) * VSTR + (16 * ((lane >> 4) & 1) + 4 * (lane & 3)) * 2; \
        _Pragma("unroll") for (int d = 0; d < ND; ++d) { va[d][0] = vtr(Vb + d * 64); va[d][1] = vtr(Vb + 8 * VSTR + d * 64); } \
        _Pragma("unroll") for (int d = 0; d < ND; ++d) { vb2[d][0] = vtr(Vb + 16 * VSTR + d * 64); vb2[d][1] = vtr(Vb + 16 * VSTR + 8 * VSTR + d * 64); } \
        __builtin_amdgcn_sched_barrier(0); } while (0)
#define PV_MMA(vs) do { \
        const LAS unsigned char* Vb = lds + BV_OFF + (vs) * 64 * VSTR + (4 * hi + ((lane & 15) >> 2)) * VSTR + (16 * ((lane >> 4) & 1) + 4 * (lane & 3)) * 2; \
        _Pragma("unroll") for (int d = 0; d < ND; ++d) o[d] = __builtin_amdgcn_mfma_f32_32x32x16_bf16(__builtin_bit_cast(bf16x8, pw[0]), VFRAG(va, d), o[d], 0, 0, 0); \
        __builtin_amdgcn_sched_barrier(0); \
        _Pragma("unroll") for (int d = 0; d < ND; ++d) { va[d][0] = vtr(Vb + 32 * VSTR + d * 64); va[d][1] = vtr(Vb + 32 * VSTR + 8 * VSTR + d * 64); } \
        __builtin_amdgcn_sched_barrier(0); \
        _Pragma("unroll") for (int d = 0; d < ND; ++d) o[d] = __builtin_amdgcn_mfma_f32_32x32x16_bf16(__builtin_bit_cast(bf16x8, pw[1]), VFRAG(vb2, d), o[d], 0, 0, 0); \
        __builtin_amdgcn_sched_barrier(0); \
        _Pragma("unroll") for (int d = 0; d < ND; ++d) { vb2[d][0] = vtr(Vb + 48 * VSTR + d * 64); vb2[d][1] = vtr(Vb + 48 * VSTR + 8 * VSTR + d * 64); } \
        __builtin_amdgcn_sched_barrier(0); \
        _Pragma("unroll") for (int d = 0; d < ND; ++d) o[d] = __builtin_amdgcn_mfma_f32_32x32x16_bf16(__builtin_bit_cast(bf16x8, pw[2]), VFRAG(va, d), o[d], 0, 0, 0); \
        _Pragma("unroll") for (int d = 0; d < ND; ++d) o[d] = __builtin_amdgcn_mfma_f32_32x32x16_bf16(__builtin_bit_cast(bf16x8, pw[3]), VFRAG(vb2, d), o[d], 0, 0, 0); \
        __builtin_amdgcn_sched_barrier(0); } while (0)
        int first = 1; asm volatile("" : "+s"(first));
#define B_TILE(i_) ((i_) < 4 ? c0 + (i_) : ((i_) - 4 < c0 ? (i_) - 4 : (i_)))
        int t = B_TILE(0);
        int vs_prev = 2, vs_cur = 0, vs_next = 1;
        u32x4 pw[4];
        ATT_GLOAD(t); ATT_LSTORE(0, 0); __syncthreads();
        for (int i = 0; i < NT; ++i) {
            const int buf = i & 1;
            int tn = 0;
            if (i + 1 < NT) { tn = B_TILE(i + 1); ATT_GLOAD(tn); }
            f32x16 p0, p1;
            const int kb = 64 * t;
            float slope2 = slope2_, qposf = qposf_; asm volatile("" : "+v"(slope2), "+v"(qposf));
            const LAS unsigned char* Kb = lds + BK_OFF + buf * 64 * KSTR + r32 * KSTR + hi * 16;
            bf16x8 kf[8];
#pragma unroll
            for (int d0 = 0; d0 < 4; ++d0) { kf[d0] = *(const LAS bf16x8*)(Kb + d0 * 32); kf[4 + d0] = *(const LAS bf16x8*)(Kb + 32 * KSTR + d0 * 32); }
            const LAS unsigned char* Vb = lds + BV_OFF + vs_cur * 64 * VSTR + (4 * hi + ((lane & 15) >> 2)) * VSTR + (16 * ((lane >> 4) & 1) + 4 * (lane & 3)) * 2;
            s16x4 va[ND][2], vb2[ND][2];
            const bool offdiag = (kb + 63 < qw || kb > qw + 31);
            const float dq = (float)(kb + 4 * hi) - qposf;
#define QK_P0(INIT0, INIT1) do { \
            _Pragma("unroll") for (int r = 0; r < 16; ++r) { const float kv = (float)((r & 3) + 8 * (r >> 2)); p0[r] = INIT0; } \
            __builtin_amdgcn_sched_barrier(0); \
            _Pragma("unroll") for (int d0 = 0; d0 < 4; ++d0) { \
                p0 = __builtin_amdgcn_mfma_f32_32x32x16_bf16(kf[d0], qr[d0], p0, 0, 0, 0); \
                _Pragma("unroll") for (int r = 4 * d0; r < 4 * d0 + 4; ++r) { const float kv = (float)((r & 3) + 8 * (r >> 2) + 32); p1[r] = INIT1; } \
                __builtin_amdgcn_sched_barrier(0); } } while (0)
            if (offdiag) {
                const float sg = (kb > qw) ? -slope2 : slope2, b0 = sg * dq - mref;
                p0[0] = fmamk_t<0>(sg, b0); p0[1] = fmamk_t<1>(sg, b0); p0[2] = fmamk_t<2>(sg, b0); p0[3] = fmamk_t<3>(sg, b0); p0[4] = fmamk_t<8>(sg, b0); p0[5] = fmamk_t<9>(sg, b0); p0[6] = fmamk_t<10>(sg, b0); p0[7] = fmamk_t<11>(sg, b0); p0[8] = fmamk_t<16>(sg, b0); p0[9] = fmamk_t<17>(sg, b0); p0[10] = fmamk_t<18>(sg, b0); p0[11] = fmamk_t<19>(sg, b0); p0[12] = fmamk_t<24>(sg, b0); p0[13] = fmamk_t<25>(sg, b0); p0[14] = fmamk_t<26>(sg, b0); p0[15] = fmamk_t<27>(sg, b0);
                __builtin_amdgcn_sched_barrier(0);
                p0 = __builtin_amdgcn_mfma_f32_32x32x16_bf16(kf[0], qr[0], p0, 0, 0, 0); p1[0] = fmamk_t<32>(sg, b0); p1[1] = fmamk_t<33>(sg, b0); p1[2] = fmamk_t<34>(sg, b0); p1[3] = fmamk_t<35>(sg, b0); __builtin_amdgcn_sched_barrier(0);
                p0 = __builtin_amdgcn_mfma_f32_32x32x16_bf16(kf[1], qr[1], p0, 0, 0, 0); p1[4] = fmamk_t<40>(sg, b0); p1[5] = fmamk_t<41>(sg, b0); p1[6] = fmamk_t<42>(sg, b0); p1[7] = fmamk_t<43>(sg, b0); __builtin_amdgcn_sched_barrier(0);
                p0 = __builtin_amdgcn_mfma_f32_32x32x16_bf16(kf[2], qr[2], p0, 0, 0, 0); p1[8] = fmamk_t<48>(sg, b0); p1[9] = fmamk_t<49>(sg, b0); p1[10] = fmamk_t<50>(sg, b0); p1[11] = fmamk_t<51>(sg, b0); __builtin_amdgcn_sched_barrier(0);
                p0 = __builtin_amdgcn_mfma_f32_32x32x16_bf16(kf[3], qr[3], p0, 0, 0, 0); p1[12] = fmamk_t<56>(sg, b0); p1[13] = fmamk_t<57>(sg, b0); p1[14] = fmamk_t<58>(sg, b0); p1[15] = fmamk_t<59>(sg, b0); __builtin_amdgcn_sched_barrier(0);
            } else {
                const float nmref = -mref;
                QK_P0(__builtin_fmaf(-slope2, __builtin_fabsf(dq + kv), nmref), __builtin_fmaf(-slope2, __builtin_fabsf(dq + kv), nmref));
            }
#undef QK_P0
#pragma unroll
            for (int d = 0; d < ND; ++d) { va[d][0] = vtr(Vb + d * 64); va[d][1] = vtr(Vb + 8 * VSTR + d * 64); }
#pragma unroll
            for (int d = 0; d < ND; ++d) { vb2[d][0] = vtr(Vb + 16 * VSTR + d * 64); vb2[d][1] = vtr(Vb + 16 * VSTR + 8 * VSTR + d * 64); }
            __builtin_amdgcn_sched_barrier(0);
#pragma unroll
            for (int d0 = 0; d0 < 4; ++d0) p1 = __builtin_amdgcn_mfma_f32_32x32x16_bf16(kf[4 + d0], qr[d0], p1, 0, 0, 0);
            __builtin_amdgcn_sched_barrier(0);
            float rm, rmb;
            asm volatile("s_nop 15\n\ts_nop 7\n\tv_max3_f32 %0, %1, %2, %3\n\tv_max3_f32 %0, %0, %4, %5\n\tv_max3_f32 %0, %0, %6, %7\n\tv_max3_f32 %0, %0, %8, %9\n\t"
                         "v_max3_f32 %0, %0, %10, %11\n\tv_max3_f32 %0, %0, %12, %13\n\tv_max3_f32 %0, %0, %14, %15\n\tv_max3_f32 %0, %0, %16, %16"
                         : "=&v"(rm) : "v"(p0[0]), "v"(p0[1]), "v"(p0[2]), "v"(p0[3]), "v"(p0[4]), "v"(p0[5]), "v"(p0[6]), "v"(p0[7]), "v"(p0[8]), "v"(p0[9]), "v"(p0[10]), "v"(p0[11]), "v"(p0[12]), "v"(p0[13]), "v"(p0[14]), "v"(p0[15]));
            asm volatile("v_max3_f32 %0, %1, %2, %3\n\tv_max3_f32 %0, %0, %4, %5\n\tv_max3_f32 %0, %0, %6, %7\n\tv_max3_f32 %0, %0, %8, %9\n\t"
                         "v_max3_f32 %0, %0, %10, %11\n\tv_max3_f32 %0, %0, %12, %13\n\tv_max3_f32 %0, %0, %14, %15\n\tv_max3_f32 %0, %0, %16, %16"
                         : "=&v"(rmb) : "v"(p1[0]), "v"(p1[1]), "v"(p1[2]), "v"(p1[3]), "v"(p1[4]), "v"(p1[5]), "v"(p1[6]), "v"(p1[7]), "v"(p1[8]), "v"(p1[9]), "v"(p1[10]), "v"(p1[11]), "v"(p1[12]), "v"(p1[13]), "v"(p1[14]), "v"(p1[15]));
            rm = __builtin_fmaxf(rm, rmb);
            { auto rr_ = __builtin_amdgcn_permlane32_swap(__float_as_uint(rm), __float_as_uint(rm), false, false); rm = __builtin_fmaxf(__uint_as_float(rr_[0]), __uint_as_float(rr_[1])); }
            if (first || __any(rm > B_THR)) {
                const float delta = (first || rm > B_THR) ? rm : 0.f; const float f = __builtin_amdgcn_exp2f(-delta); mref += delta; l *= f;
#pragma unroll
                for (int r = 0; r < 16; ++r) { p0[r] -= delta; p1[r] -= delta; }
                {
                    if (hi == 0) wsf[r32] = f;
#pragma unroll
                    for (int r = 0; r < 16; ++r) { const float fr = wsf[crow(r, hi)];
#pragma unroll
                        for (int d = 0; d < ND; ++d) o[d][r] *= fr; }
                }
            }
            float ls0 = 0.f, ls1 = 0.f;
#pragma unroll
            for (int r = 0; r < 16; ++r) { p0[r] = __builtin_amdgcn_exp2f(p0[r]); ls0 += p0[r]; }
            pw[0].x = cvt_pk(p0[0], p0[1]); pw[0].y = cvt_pk(p0[2], p0[3]); pw[0].z = cvt_pk(p0[4], p0[5]); pw[0].w = cvt_pk(p0[6], p0[7]);
            pw[1].x = cvt_pk(p0[8], p0[9]); pw[1].y = cvt_pk(p0[10], p0[11]); pw[1].z = cvt_pk(p0[12], p0[13]); pw[1].w = cvt_pk(p0[14], p0[15]);
            __builtin_amdgcn_sched_barrier(0);
#define VFRAG(x, d) (bf16x8){x[d][0][0], x[d][0][1], x[d][0][2], x[d][0][3], x[d][1][0], x[d][1][1], x[d][1][2], x[d][1][3]}
#pragma unroll
            for (int d = 0; d < ND; ++d) {
                o[d] = __builtin_amdgcn_mfma_f32_32x32x16_bf16(__builtin_bit_cast(bf16x8, pw[0]), VFRAG(va, d), o[d], 0, 0, 0);
                p1[2 * d] = __builtin_amdgcn_exp2f(p1[2 * d]); p1[2 * d + 1] = __builtin_amdgcn_exp2f(p1[2 * d + 1]); ls1 += p1[2 * d]; ls0 += p1[2 * d + 1];
                __builtin_amdgcn_sched_barrier(0);
            }
#pragma unroll
            for (int d = 0; d < ND; ++d) { va[d][0] = vtr(Vb + 32 * VSTR + d * 64); va[d][1] = vtr(Vb + 32 * VSTR + 8 * VSTR + d * 64); }
            __builtin_amdgcn_sched_barrier(0);
#pragma unroll
            for (int d = 0; d < ND; ++d) {
                o[d] = __builtin_amdgcn_mfma_f32_32x32x16_bf16(__builtin_bit_cast(bf16x8, pw[1]), VFRAG(vb2, d), o[d], 0, 0, 0);
                p1[8 + 2 * d] = __builtin_amdgcn_exp2f(p1[8 + 2 * d]); p1[8 + 2 * d + 1] = __builtin_amdgcn_exp2f(p1[8 + 2 * d + 1]); ls1 += p1[8 + 2 * d]; ls0 += p1[8 + 2 * d + 1];
                __builtin_amdgcn_sched_barrier(0);
            }
#pragma unroll
            for (int d = 0; d < ND; ++d) { vb2[d][0] = vtr(Vb + 48 * VSTR + d * 64); vb2[d][1] = vtr(Vb + 48 * VSTR + 8 * VSTR + d * 64); }
            if (i + 1 < NT) ATT_LSTORE(buf ^ 1, vs_next);
            l += ls0 + ls1;
            pw[2].x = cvt_pk(p1[0], p1[1]); pw[2].y = cvt_pk(p1[2], p1[3]); pw[2].z = cvt_pk(p1[4], p1[5]); pw[2].w = cvt_pk(p1[6], p1[7]);
            __builtin_amdgcn_sched_barrier(0);
#pragma unroll
            for (int d = 0; d < ND; ++d) {
                o[d] = __builtin_amdgcn_mfma_f32_32x32x16_bf16(__builtin_bit_cast(bf16x8, pw[2]), VFRAG(va, d), o[d], 0, 0, 0);
                if (d == 0) { pw[3].x = cvt_pk(p1[8], p1[9]); pw[3].y = cvt_pk(p1[10], p1[11]); } else if (d == 1) { pw[3].z = cvt_pk(p1[12], p1[13]); pw[3].w = cvt_pk(p1[14], p1[15]); }
                __builtin_amdgcn_sched_barrier(0);
            }
#pragma unroll
            for (int d = 0; d < ND; ++d) o[d] = __builtin_amdgcn_mfma_f32_32x32x16_bf16(__builtin_bit_cast(bf16x8, pw[3]), VFRAG(vb2, d), o[d], 0, 0, 0);
#undef VFRAG
            __builtin_amdgcn_sched_barrier(0);
            first = 0;
            t = tn;
            { const int tmp_ = vs_prev; vs_prev = vs_cur; vs_cur = vs_next; vs_next = tmp_; }
            __syncthreads();
        }
#undef PV_LOAD01
#undef PV_MMA
#undef B_TILE
#undef VFRAG
#undef ATT_GLOAD
#undef ATT_LSTORE
        l += __shfl_xor(l, 32);
        if (hi == 0) wsf[r32] = 1.f / l;
        int lane_e = lane, qw_e = qw; asm volatile("" : "+v"(lane_e)); asm volatile("" : "+s"(qw_e));
        const int r32 = lane_e & 31, hi = lane_e >> 5, qw = qw_e;
        LAS unsigned* o0buf = (LAS unsigned*)(lds + ATT_O0_OFF) + wid * 2048 + lane_e;
        if (mp == 0) {
#pragma unroll
            for (int d = 0; d < ND; ++d)
#pragma unroll
                for (int r = 0; r < 16; r += 2) { const float i0 = wsf[crow(r, hi)], i1 = wsf[crow(r + 1, hi)]; o0buf[(d * 8 + (r >> 1)) * 64] = cvt_pk(o[d][r] * i0, o[d][r + 1] * i1); }
        } else {
            float gs[ND];
#pragma unroll
            for (int d = 0; d < ND; ++d) gs[d] = subln_l[d * 32 + r32] * postscale;
#pragma unroll
            for (int r = 0; r < 16; r += 2) {
                const float i0 = wsf[crow(r, hi)], i1 = wsf[crow(r + 1, hi)];
                float v0[ND], v1[ND]; float s0 = 0.f, s1 = 0.f;
#pragma unroll
                for (int d = 0; d < ND; ++d) { const unsigned w = o0buf[(d * 8 + (r >> 1)) * 64];
                    v0[d] = __builtin_bit_cast(float, w << 16) - lam * (o[d][r] * i0); v1[d] = __builtin_bit_cast(float, w & 0xffff0000u) - lam * (o[d][r + 1] * i1);
                    s0 += v0[d] * v0[d]; s1 += v1[d] * v1[d]; }
#pragma unroll
                for (int sh = 1; sh < 32; sh <<= 1) { s0 += __shfl_xor(s0, sh); s1 += __shfl_xor(s1, sh); }
                const float r0 = 1.f / sqrtf(s0 * (1.f / 128.f) + 1e-5f), r1 = 1.f / sqrtf(s1 * (1.f / 128.f) + 1e-5f);
                bf16_t* row0 = mix + (size_t)(qw + crow(r, hi)) * DM + r32; bf16_t* row1 = mix + (size_t)(qw + crow(r + 1, hi)) * DM + r32;
#pragma unroll
                for (int d = 0; d < ND; ++d) { row0[d * 32] = (bf16_t)f2bf(v0[d] * r0 * gs[d]); row1[d * 32] = (bf16_t)f2bf(v1[d] * r1 * gs[d]); }
            }
        }
        __syncthreads();
    }
}
__device__ __forceinline__ float alibi_slope(int i, int n) { return exp2f(-8.0f * (float)(i + 1) / (float)n); }
struct Ctx { int tid, lane, wave, G, cu, gw, NGW; };

__device__ __forceinline__ void ph_weights(const Args& a, LAS unsigned char* lds, int l, int gw0, int nw, int wave, int lane) {
    unsigned char* ws = a.ws;
    bf16_t* WinT = (bf16_t*)(ws + WS_WIN); bf16_t* WoutT = (bf16_t*)(ws + WS_WOUT); bf16_t* WupT = (bf16_t*)(ws + WS_WUP); bf16_t* WdnT = (bf16_t*)(ws + WS_WDN);
    const float* w_in = a.in[3]; const float* w_out = a.in[10]; const float* w_up = a.in[12]; const float* w_down = a.in[15];
    LAS float* scr = (LAS float*)(lds + wave * 16384);
    constexpr int I_IN = (DM / 64) * (DIN / 32), I_OUT = (DM / 64) * (DM / 32), I_UP = (DM / 64) * (DUP / 32), I_DN = (DFF / 64) * (DM / 32);
    constexpr int PER_L = I_IN + I_OUT + I_UP + I_DN;
    for (int it = gw0; it < PER_L; it += nw) {
        int r = it;
        if (r < I_IN) { transpose_item(w_in + (size_t)l * DM * DIN, DM, DIN, WinT + (size_t)l * DIN * DM, scr, r, lane, a.in[2] + l * DM); continue; } r -= I_IN;
        if (r < I_OUT) { transpose_item(w_out + (size_t)l * DM * DM, DM, DM, WoutT + (size_t)l * DM * DM, scr, r, lane, nullptr); continue; } r -= I_OUT;
        if (r < I_UP) { transpose_item(w_up + (size_t)l * DM * DUP, DM, DUP, WupT + (size_t)l * DUP * DM, scr, r, lane, a.in[11] + l * DM, true); continue; } r -= I_UP;
        transpose_item(w_down + (size_t)l * DFF * DM, DFF, DM, WdnT + (size_t)l * DM * DFF, scr, r, lane, nullptr);
    }
}
__device__ __forceinline__ const float* chunk_in(const Args& a, int ch) { return ch == 0 ? a.in[0] : a.in[1] + (size_t)(ch - 1) * CH_ROWS * DM; }
__device__ __forceinline__ float* chunk_out(const Args& a, int ch) { return a.out + (size_t)ch * CH_ROWS * DM; }

__device__ __forceinline__ void ph_norm_bf16(const Ctx& c, const float* xsrc, const float* gain, bf16_t* HB) {
    for (int r = c.gw; r < CH_ROWS; r += c.NGW) rms_row_to_bf16(xsrc + (size_t)r * DM, gain, HB + (size_t)r * DM, c.lane);
}
__device__ __forceinline__ void ph_final_norm(const Ctx& c, float* xo, const float* gain) {
    for (int r = c.gw; r < CH_ROWS; r += c.NGW) rms_row_f32(xo + (size_t)r * DM, gain, c.lane);
}

__device__ __forceinline__ void ph_attn(const Args& a, const Ctx& c, LAS unsigned char* lds, int ch, int layer) {
    const bf16_t* PROJ = (const bf16_t*)(a.ws + WS_PROJ); float* TMP = (float*)(a.ws + WS_TMP);
    const int SL = ch == 0 ? 16384 : 4096, sl_shift = ch == 0 ? 14 : 12;
    const int cu = c.cu, G = c.G;
#ifndef SKIP_B
    {
        const float lam_init = layer == 0 ? 0.2f : (0.8f - 0.6f * 0.7408182206817179f);
        const float s1 = wave_sum(a.in[5][layer * 64 + c.lane] * a.in[6][layer * 64 + c.lane]);
        const float s2 = wave_sum(a.in[7][layer * 64 + c.lane] * a.in[8][layer * 64 + c.lane]);
        const float lam = expf(s1) - expf(s2) + lam_init;
        bf16_t* HBm = (bf16_t*)(a.ws + WS_HB);
#ifdef PROBE_B2
        for (int rep_ = 0; rep_ < 2; ++rep_)
#endif
        for (int u = cu; u < 256; u += G) {
            int seq, h, qb; const int xcd = u & 7, idx = u >> 3;
            if (ch == 0) { seq = 0; h = xcd >> 1; qb = (xcd & 1) * 32 + idx; }
            else { const int pair = xcd * 2 + (idx >> 4); seq = pair >> 2; h = pair & 3; qb = idx & 15; }
            const size_t rb = (size_t)seq * SL;
            attn_b_unit(lds, PROJ + rb * DIN, h, qb * 256, SL, alibi_slope(h, 4) * LOG2E, lam, a.in[9] + layer * 128, 1.f - lam_init, HBm + rb * DM + 256 + h * 128);
        }
    }
#endif
#ifndef SKIP_AC
#ifdef PROBE_AC2
    for (int rep_ = 0; rep_ < 2; ++rep_)
#endif
    for (int uu = cu; uu < 1024; uu += G) {
        const bf16_t *qp, *kp, *vp; size_t pitch, opitch, lpitch; int q0, L, W; float slope2, m_init, l_init; float *op, *lp; bf16_t* obf;
        if (uu < 256) {
            const int hq = uu >> 6, blk = uu & 63;
            const int seq = (blk * 256) >> sl_shift, qb = blk - ((seq << sl_shift) >> 8);
            const size_t rb = (size_t)seq * SL; const bf16_t* base = PROJ + rb * DIN;
            qp = base + hq * 64; kp = base + 256 + (hq >> 1) * 64; vp = base + 384 + (hq >> 1) * 64; pitch = DIN; q0 = qb * 256; L = SL;
            slope2 = alibi_slope(hq, 4) * LOG2E; W = 128; m_init = a.in[4][layer * 4 + hq] * LOG2E; l_init = 1.f;
            op = nullptr; obf = (bf16_t*)(a.ws + WS_HB) + rb * DM + hq * 64; opitch = DM; lp = nullptr; lpitch = 0;
        } else {
            const int uc = uu - 256;
            const int gh = uc >> 6, blk = uc & 63, gq = gh >> 2;
            const int dsh = 2 * gq, d = 1 << dsh;
            const int seq = (blk * 256) >> sl_shift, b2 = blk - ((seq << sl_shift) >> 8);
            const int nbr = (SL >> dsh) >> 8;
            const int res = b2 / nbr, qb = b2 % nbr;
            const size_t rb = (size_t)seq * SL + res; const bf16_t* base = PROJ + rb * DIN;
            qp = base + 2048 + gh * 64; kp = base + 2816 + gh * 64; vp = base + 3584 + gh * 64; pitch = (size_t)DIN * d; q0 = qb * 256; L = SL >> dsh;
            slope2 = alibi_slope(gh, 12) * (float)d * LOG2E; W = 64; m_init = -1e30f; l_init = 0.f;
            op = nullptr; obf = (bf16_t*)TMP + rb * 768 + gh * 64; opitch = (size_t)768 * d; lp = TMP + 8 * 1024 * 1024 + rb * 16 + gh; lpitch = (size_t)16 * d;
        }
        attn_unit<64, true>(lds, qp, kp, vp, pitch, q0, L, slope2, W, m_init, l_init, op, opitch, lp, lpitch, obf);
    }
#endif
}

__device__ __forceinline__ void ph_combine(const Args& a, const Ctx& c, int layer) {
    const float* TMP = (const float*)(a.ws + WS_TMP); bf16_t* HB = (bf16_t*)(a.ws + WS_HB);
    { float* S2 = (float*)(a.ws + WS_SSQ) + 2 * CH_ROWS; for (int r = c.cu * NTHREADS + c.tid; r < CH_ROWS; r += c.G * NTHREADS) S2[r] = 0.f; }
    const int nitems = CH_ROWS * 32;
#pragma unroll 2
    for (int it = c.cu * NTHREADS + c.tid; it < nitems; it += c.G * NTHREADS) {
        const int r = it >> 5, h = (it >> 3) & 3, d8 = (it & 7) * 8;
        const bf16_t* tr = (const bf16_t*)TMP + (size_t)r * 768; const float* lr = TMP + 8 * 1024 * 1024 + (size_t)r * 16;
        const float l0 = lr[h], l1 = lr[4 + h], l2 = lr[8 + h];
        const u32x4 ua = *(const u32x4*)(tr + h * 64 + d8), ub = *(const u32x4*)(tr + (4 + h) * 64 + d8), uc = *(const u32x4*)(tr + (8 + h) * 64 + d8);
#define BF_LO(w) __builtin_bit_cast(float, (w) << 16)
#define BF_HI(w) __builtin_bit_cast(float, (w) & 0xffff0000u)
        const f32x4 a0 = (f32x4){BF_LO(ua.x), BF_HI(ua.x), BF_LO(ua.y), BF_HI(ua.y)}, a1 = (f32x4){BF_LO(ua.z), BF_HI(ua.z), BF_LO(ua.w), BF_HI(ua.w)};
        const f32x4 b0 = (f32x4){BF_LO(ub.x), BF_HI(ub.x), BF_LO(ub.y), BF_HI(ub.y)}, b1 = (f32x4){BF_LO(ub.z), BF_HI(ub.z), BF_LO(ub.w), BF_HI(ub.w)};
        const f32x4 c0 = (f32x4){BF_LO(uc.x), BF_HI(uc.x), BF_LO(uc.y), BF_HI(uc.y)}, c1 = (f32x4){BF_LO(uc.z), BF_HI(uc.z), BF_LO(uc.w), BF_HI(uc.w)};
#undef BF_LO
#undef BF_HI
        const float mx = fmaxf(l0, fmaxf(l1, l2));
        float w0 = __expf(l0 - mx), w1 = __expf(l1 - mx), w2 = __expf(l2 - mx);
        const float inv = 1.f / (w0 + w1 + w2); w0 *= inv; w1 *= inv; w2 *= inv;
        const f32x4 o0 = a0 * w0 + b0 * w1 + c0 * w2, o1 = a1 * w0 + b1 * w1 + c1 * w2;
        u32x4 o; o.x = pk2(o0.x, o0.y); o.y = pk2(o0.z, o0.w); o.z = pk2(o1.x, o1.y); o.w = pk2(o1.z, o1.w);
        *(u32x4*)(HB + (size_t)r * DM + 768 + h * 64 + d8) = o;
    }
}

__device__ __forceinline__ void ph_conv(const Args& a, const Ctx& c, int ch, int layer) {
    const int par = ch & 1;
    const bf16_t* UB = (const bf16_t*)(a.ws + WS_PROJ); bf16_t* GB = (bf16_t*)(a.ws + WS_TMP);
    const int SL = ch == 0 ? 16384 : 4096;
    const float* cw = a.in[13] + (size_t)layer * 3 * DUP; const float* cb = a.in[14] + (size_t)layer * DUP;
    constexpr int NCG = DFF / 8, RB = 16;
    const int nitems = (CH_ROWS / RB) * NCG;
    { float* S1 = (float*)(a.ws + WS_SSQ) + par * CH_ROWS; for (int r = c.cu * NTHREADS + c.tid; r < CH_ROWS; r += c.G * NTHREADS) S1[r] = 0.f; }
    for (int it = c.cu * NTHREADS + c.tid; it < nitems; it += c.G * NTHREADS) {
        const int cg8 = it % NCG, rb = it / NCG, c0 = cg8 * 8, r0 = rb * RB;
        f32x4 wg[3][2], wv[3][2], bg[2], bv[2];
#pragma unroll
        for (int k = 0; k < 3; ++k)
#pragma unroll
            for (int j = 0; j < 2; ++j) { wg[k][j] = *(const f32x4*)(cw + k * DUP + c0 + 4 * j); wv[k][j] = *(const f32x4*)(cw + k * DUP + DFF + c0 + 4 * j); }
#pragma unroll
        for (int j = 0; j < 2; ++j) { bg[j] = *(const f32x4*)(cb + c0 + 4 * j); bv[j] = *(const f32x4*)(cb + DFF + c0 + 4 * j); }
        const bool first = (r0 & (SL - 1)) == 0, last = ((r0 + RB) & (SL - 1)) == 0;
        const u32x4 zero = (u32x4){0u, 0u, 0u, 0u};
        const bf16_t* up = UB + (size_t)r0 * DUP + c0;
        u32x4 pg_ = first ? zero : *(const u32x4*)(up - DUP), pv_ = first ? zero : *(const u32x4*)(up - DUP + DFF);
        u32x4 cg_ = *(const u32x4*)(up), cv_ = *(const u32x4*)(up + DFF);
        bf16_t* gp = GB + (size_t)r0 * DFF + c0;
#pragma unroll 4
        for (int rr = 0; rr < RB; ++rr) {
            const bool nz = (rr == RB - 1) && last;
            const u32x4 ng_ = nz ? zero : *(const u32x4*)(up + (size_t)(rr + 1) * DUP), nv_ = nz ? zero : *(const u32x4*)(up + (size_t)(rr + 1) * DUP + DFF);
            unsigned ow[4];
#pragma unroll
            for (int w = 0; w < 4; ++w) {
                float res[2];
#pragma unroll
                for (int hh = 0; hh < 2; ++hh) {
                    const int j = 2 * w + hh, q = j >> 2, e = j & 3;
                    const float gpv = hh ? __builtin_bit_cast(float, pg_[w] & 0xffff0000u) : __builtin_bit_cast(float, pg_[w] << 16);
                    const float gcv = hh ? __builtin_bit_cast(float, cg_[w] & 0xffff0000u) : __builtin_bit_cast(float, cg_[w] << 16);
                    const float gnv = hh ? __builtin_bit_cast(float, ng_[w] & 0xffff0000u) : __builtin_bit_cast(float, ng_[w] << 16);
                    const float vpv = hh ? __builtin_bit_cast(float, pv_[w] & 0xffff0000u) : __builtin_bit_cast(float, pv_[w] << 16);
                    const float vcv = hh ? __builtin_bit_cast(float, cv_[w] & 0xffff0000u) : __builtin_bit_cast(float, cv_[w] << 16);
                    const float vnv = hh ? __builtin_bit_cast(float, nv_[w] & 0xffff0000u) : __builtin_bit_cast(float, nv_[w] << 16);
                    const float gate = gpv * wg[0][q][e] + gcv * wg[1][q][e] + gnv * wg[2][q][e] + bg[q][e];
                    const float val = vpv * wv[0][q][e] + vcv * wv[1][q][e] + vnv * wv[2][q][e] + bv[q][e];
                    res[hh] = gate * __builtin_amdgcn_rcpf(1.f + __builtin_amdgcn_exp2f(-LOG2E * gate)) * val;
                }
                ow[w] = pk2(res[0], res[1]);
            }
            *(u32x4*)(gp + (size_t)rr * DFF) = (u32x4){ow[0], ow[1], ow[2], ow[3]};
            pg_ = cg_; pv_ = cv_; cg_ = ng_; cv_ = nv_;
        }
    }
}

constexpr int STEPS_PER_CHUNK = DEPTH * 6;
constexpr int NSTEPS = 1 + NCHUNK * STEPS_PER_CHUNK + 1;
__global__ void __launch_bounds__(NTHREADS, 2) mega_fwd(Args a) {
    extern __shared__ __attribute__((aligned(16))) unsigned char lds_raw[];
    LAS unsigned char* lds = (LAS unsigned char*)lds_raw;
    cg::grid_group grid = cg::this_grid();
    volatile LAS unsigned* bst = (volatile LAS unsigned*)(lds + 147456);
    if (threadIdx.x < 2) bst[threadIdx.x] = 0u;
    __syncthreads();
    XcdBarrier xbar = xcd_barrier_post((unsigned*)(a.ws + WS_CTL), bst);
#ifdef PROBE_P2
    for (int pass_ = 0; pass_ < 2; ++pass_)
#endif
    for (int step = 0; step < NSTEPS; ++step) {
        int tid_l = threadIdx.x, cu_l = blockIdx.x, G_l = gridDim.x;
        asm volatile("" : "+v"(tid_l)); asm volatile("" : "+s"(cu_l), "+s"(G_l));
        Ctx c; c.tid = tid_l; c.lane = c.tid & 63; c.wave = __builtin_amdgcn_readfirstlane(c.tid >> 6);
        c.G = G_l; c.cu = cu_l; c.gw = c.cu * 8 + c.wave; c.NGW = c.G * 8;
        unsigned char* ws = a.ws;
        if (step == 0) {
            ph_weights(a, lds, 0, c.gw, c.NGW, c.wave, c.lane); ph_weights(a, lds, 1, c.gw, c.NGW, c.wave, c.lane);
            const float* xin = chunk_in(a, 0); bf16_t* XB = (bf16_t*)(ws + WS_XB); float* S1 = (float*)(ws + WS_SSQ);
            for (int r = c.gw; r < CH_ROWS; r += c.NGW) row_to_bf16_ssq(xin + (size_t)r * DM, XB + (size_t)r * DM, S1 + r, c.lane);
        } else if (step == NSTEPS - 1) ph_final_norm(c, chunk_out(a, NCHUNK - 1), a.in[16]);
        else {
            const int s = step - 1, ch = s / STEPS_PER_CHUNK, sc = s % STEPS_PER_CHUNK, par = ch & 1;
            bf16_t* HB = (bf16_t*)(ws + WS_HB); bf16_t* XB = (bf16_t*)(ws + WS_XB) + (size_t)par * CH_ROWS * DM;
            float* S1 = (float*)(ws + WS_SSQ) + par * CH_ROWS; float* S2 = (float*)(ws + WS_SSQ) + 2 * CH_ROWS;
            float* xo = chunk_out(a, ch);
            {
                const int layer = sc / 6, ph = sc % 6;
                const float* xsrc = layer == 0 ? chunk_in(a, ch) : (const float*)xo;
                if (ph == 0) {
                    pg8::Gemm g{XB, (const bf16_t*)(ws + WS_WIN) + (size_t)layer * DIN * DM, CH_ROWS, DIN, DM}; pg8::StaticOrder S; S.init(CH_ROWS, DIN, c.G, c.cu);
                    pg8::EpiBf16S2 E{(bf16_t*)(ws + WS_PROJ), DIN, 1805u, QSCALE, S1};
#ifdef PROBE_G2
                    for (int rep_ = 0; rep_ < 2; ++rep_)
#endif
                    pg8::gemm_phase<pg8::EpiBf16S2, pg8::StaticOrder, true, true>(lds, g, S, E);
                    if (layer == 0 && ch > 0) {
                        const int nfull = (CH_ROWS / 256) * (DIN / 256) % c.G;
                        if (nfull > 0 && c.cu >= nfull) { float* xp = chunk_out(a, ch - 1); const int nw = (c.G - nfull) * 8;
                            for (int r = (c.cu - nfull) * 8 + c.wave; r < CH_ROWS; r += nw) rms_row_f32(xp + (size_t)r * DM, a.in[16], c.lane); }
                        else if (nfull == 0) ph_final_norm(c, chunk_out(a, ch - 1), a.in[16]);
                    }
                } else if (ph == 1) {
                    ph_attn(a, c, lds, ch, layer);
                } else if (ph == 2) {
                    ph_combine(a, c, layer);
                } else if (ph == 3) {
                    pg8::Gemm g{HB, (const bf16_t*)(ws + WS_WOUT) + (size_t)layer * DM * DM, CH_ROWS, DM, DM}; pg8::StaticOrder S; S.init(CH_ROWS, DM, c.G, c.cu);
                    pg8::EpiRes2 E{xsrc, xo, XB, S2, DM};
#ifdef PROBE_GE2
                    { pg8::EpiRes2 E0{xsrc, (float*)(ws + WS_PROJ), (bf16_t*)(ws + WS_PROJ + 72 * MiB), (float*)(ws + WS_PROJ + 110 * MiB), DM}; pg8::gemm_phase<pg8::EpiRes2, pg8::StaticOrder, true, true>(lds, g, S, E0); }
#endif
                    pg8::gemm_phase<pg8::EpiRes2, pg8::StaticOrder, true, true>(lds, g, S, E);
                } else if (ph == 4) {
                    pg8::Gemm g{XB - DM, (const bf16_t*)(ws + WS_WUP) + (size_t)layer * DUP * DM, 65 * 256, DUP, DM, 254}; pg8::StaticOrder S; S.init(65 * 256, DUP, c.G, c.cu);
                    pg8::EpiConv E{(bf16_t*)(ws + WS_TMP), S2, a.in[13] + (size_t)layer * 3 * DUP, a.in[14] + (size_t)layer * DUP, (ch == 0 ? 16384 : 4096) - 1, (LAS float*)(lds + 147456 + 256), CH_ROWS};
                    pg8::gemm_phase<pg8::EpiConv, pg8::StaticOrder, true, true>(lds, g, S, E);
                    { float* S1z = S1; for (int r = c.cu * NTHREADS + c.tid; r < CH_ROWS; r += c.G * NTHREADS) S1z[r] = 0.f; }
                    if (layer == DEPTH - 1 && ch + 1 < NCHUNK) {
                        const float* xin = chunk_in(a, ch + 1); bf16_t* XBn = (bf16_t*)(ws + WS_XB) + (size_t)(par ^ 1) * CH_ROWS * DM; float* S1n = (float*)(ws + WS_SSQ) + (par ^ 1) * CH_ROWS;
                        for (int r = c.gw; r < CH_ROWS; r += c.NGW) row_to_bf16_ssq(xin + (size_t)r * DM, XBn + (size_t)r * DM, S1n + r, c.lane);
                    }
                } else {
                    pg8::Gemm g{(const bf16_t*)(ws + WS_TMP), (const bf16_t*)(ws + WS_WDN) + (size_t)layer * DM * DFF, CH_ROWS, DM, DFF}; pg8::StaticOrder S; S.init(CH_ROWS, DM, c.G, c.cu);
                    pg8::EpiRes2 E{xo, xo, layer == DEPTH - 1 ? (bf16_t*)nullptr : XB, S1, DM};
#ifdef PROBE_GE2
                    { pg8::EpiRes2 E0{xo, (float*)(ws + WS_PROJ), (bf16_t*)(ws + WS_PROJ + 72 * MiB), (float*)(ws + WS_PROJ + 110 * MiB), DM}; pg8::gemm_phase<pg8::EpiRes2, pg8::StaticOrder, true, true>(lds, g, S, E0); }
#endif
                    pg8::gemm_phase<pg8::EpiRes2, pg8::StaticOrder, true, true>(lds, g, S, E);
                }
            }
        }
#ifdef PROBE_P2
        if (step == 0) grid.sync(); else xcd_barrier(xbar);
#else
        if (step == 0) grid.sync(); else if (step != NSTEPS - 1) xcd_barrier(xbar);
#endif
    }
#ifdef PROBE_TA
    if (blockIdx.x == 0 && threadIdx.x < 64) {
        float* xo = chunk_out(a, NCHUNK - 1);
        const float ua = (float)tA_ * 0.01f, ub = (float)tB_ * 0.01f;
        if (threadIdx.x == 0) xo[0] += 8.f + ua * 0.01f; else xo[4 * threadIdx.x] += sqrtf(ub * 0.01f);
    }
#endif
}

extern "C" void kernel_launch(void* const* d_in, const int* in_sizes, int n_in, void* d_out, int out_size, void* d_ws, size_t ws_size, hipStream_t stream) {
    static int grid = 0;
    if (grid == 0) {
        if (n_in != 17 || ws_size < WS_END) { fprintf(stderr, "kernel_launch: unexpected n_in %d / ws_size %zu (need %zu)\n", n_in, ws_size, (size_t)WS_END); grid = -1; return; }
        int dev = 0, cus = 0, per_cu = 0;
        (void)hipGetDevice(&dev); (void)hipDeviceGetAttribute(&cus, hipDeviceAttributeMultiprocessorCount, dev);
        if (hipFuncSetAttribute((const void*)mega_fwd, hipFuncAttributeMaxDynamicSharedMemorySize, LDS_BYTES) != hipSuccess) { fprintf(stderr, "hipFuncSetAttribute failed\n"); grid = -1; return; }
        if (hipOccupancyMaxActiveBlocksPerMultiprocessor(&per_cu, (const void*)mega_fwd, NTHREADS, LDS_BYTES) != hipSuccess || per_cu < 1) { fprintf(stderr, "occupancy query: %d\n", per_cu); per_cu = 1; }
        (void)hipGetLastError();
        grid = cus * 1;
    }
    if (grid < 0) return;
    (void)hipMemsetAsync((char*)d_ws + WS_CTL, 0, 65536, stream);
    Args a{};
    for (int i = 0; i < 17; ++i) a.in[i] = (const float*)d_in[i];
    a.out = (float*)d_out; a.ws = (unsigned char*)d_ws;
    void* args[] = {&a};
    hipError_t e = hipLaunchCooperativeKernel((const void*)mega_fwd, dim3(grid), dim3(NTHREADS), args, LDS_BYTES, stream);
    if (e != hipSuccess) fprintf(stderr, "cooperative launch failed: %s (grid %d)\n", hipGetErrorString(e), grid);
}
```

```cpp
#include <hip/hip_runtime.h>
#include <hip/hip_cooperative_groups.h>
#include <cstdio>
#include <cstdint>
#include <cmath>
namespace cg = cooperative_groups;
namespace pg8 {
#define PG8_LAS __attribute__((address_space(3)))
typedef unsigned short bf16_t;
typedef short bf16x8 __attribute__((ext_vector_type(8)));
typedef float f32x4 __attribute__((ext_vector_type(4)));
typedef unsigned u32x4 __attribute__((ext_vector_type(4)));
constexpr int BM = 256, BK = 64, HALF = 128, HTB = HALF * BK * 2  , STAGE_BYTES = 8 * HTB, NXCD = 8, WGM = 8;

__host__ __device__ __forceinline__ int lds_byte(int r, int c) { const int st = (r >> 4) * 2 + (c >> 5), rr = r & 15, cc = c & 31, ob = rr * 64 + cc * 2; return st * 1024 + (ob ^ (((ob >> 9) & 1) << 5)); }
__host__ __device__ __forceinline__ void stage_rc(int b, int& R, int& C) { const int st = b / 1024, sb = b % 1024, swz = sb ^ (((sb >> 9) & 1) << 5); R = (st >> 1) * 16 + swz / 64; C = (st & 1) * 32 + (swz % 64) / 2; }
__host__ __device__ __forceinline__ int perm32(int rho) { const int n = rho >> 4, i = rho & 15; return 8 * (i >> 2) + 4 * n + (i & 3); }

struct Unit { int pm, pn; };
struct Gemm { const bf16_t* A; const bf16_t* Bt; int M, N, K; int a_rows = 256; };

struct StaticOrder {
    int nM, nN, nwg, G, c;
    __host__ __device__ void init(int M, int N, int G_, int c_) { nM = M / BM; nN = N / BM; nwg = nM * nN; G = G_; c = c_; }
    __host__ __device__ bool next(int i, Unit& u) const {
        const long L = (long)i * G + c; if (L >= nwg) return false;
        int wgid = (int)L; { const int q = nwg / NXCD, r = nwg % NXCD, xcd = wgid % NXCD, off = wgid / NXCD; wgid = (xcd < r ? xcd * (q + 1) : r * (q + 1) + (xcd - r) * q) + off; }
        const int nig = WGM * nN, gid = wgid / nig, fm = gid * WGM, gsz = (nM - fm) < WGM ? (nM - fm) : WGM;
        u.pm = fm + ((wgid % nig) % gsz); u.pn = (wgid % nig) / gsz; return true;
    }
    __device__ __forceinline__ void a_ready(const Unit&) const {}
    __device__ __forceinline__ void done(const Unit&) const {}
};

__device__ __forceinline__ unsigned cvt_pk_bf16(float lo, float hi) { unsigned r; asm volatile("v_cvt_pk_bf16_f32 %0, %1, %2" : "=v"(r) : "v"(lo), "v"(hi)); return r; }
struct EpiBf16S {
    static constexpr bool PERM = true, AFTER_DRAIN = false;
    bf16_t* O; int ldc; unsigned scalemask; float sc;
    __device__ __forceinline__ void operator()(const f32x4 (&acc)[2][2][4][2], const Unit& u, int wr, int wc, int fr, int fq) const {
        const int row0 = u.pm * BM + wr * 64 + fr; const int col0 = u.pn * BM + wc * 32 + 8 * fq;
        const float s = ((scalemask >> u.pn) & 1u) ? sc : 1.f;
#pragma unroll
        for (int ai = 0; ai < 2; ++ai)
#pragma unroll
            for (int m = 0; m < 4; ++m) { bf16_t* rowp = O + (size_t)(row0 + ai * HALF + m * 16) * ldc + col0;
#pragma unroll
                for (int bj = 0; bj < 2; ++bj) { f32x4 v0 = acc[ai][bj][m][0] * s, v1 = acc[ai][bj][m][1] * s;
                    u32x4 w; w.x = cvt_pk_bf16(v0[0], v0[1]); w.y = cvt_pk_bf16(v0[2], v0[3]); w.z = cvt_pk_bf16(v1[0], v1[1]); w.w = cvt_pk_bf16(v1[2], v1[3]);
                    *(u32x4*)(rowp + bj * HALF) = w; } }
    }
};
struct EpiRes {
    static constexpr bool PERM = false, AFTER_DRAIN = false;
    const float* base; float* out; int ldc;
    __device__ __forceinline__ void operator()(const f32x4 (&acc)[2][2][4][2], const Unit& u, int wr, int wc, int fr, int fq) const {
        const int col0 = u.pn * BM + wc * 32 + 4 * fq;
#pragma unroll
        for (int ai = 0; ai < 2; ++ai)
#pragma unroll
            for (int m = 0; m < 4; ++m) { const size_t off = (size_t)(u.pm * BM + ai * HALF + wr * 64 + m * 16 + fr) * ldc + col0;
#pragma unroll
                for (int bj = 0; bj < 2; ++bj)
#pragma unroll
                    for (int n = 0; n < 2; ++n) { const f32x4 bs = *(const f32x4*)(base + off + bj * HALF + n * 16); *(f32x4*)(out + off + bj * HALF + n * 16) = bs + acc[ai][bj][m][n]; }
                asm volatile("" ::: "memory"); }
    }
};

struct EpiBf16S2 {
    static constexpr bool PERM = true, AFTER_DRAIN = false;
    bf16_t* O; int ldc; unsigned scalemask; float sc; const float* ssq;
    __device__ __forceinline__ void operator()(const f32x4 (&acc)[2][2][4][2], const Unit& u, int wr, int wc, int fr, int fq) const {
        const int row0 = u.pm * BM + wr * 64 + fr; const int col0 = u.pn * BM + wc * 32 + 8 * fq;
        const float s = ((scalemask >> u.pn) & 1u) ? sc : 1.f;
#pragma unroll
        for (int ai = 0; ai < 2; ++ai)
#pragma unroll
            for (int m = 0; m < 4; ++m) { const int row = row0 + ai * HALF + m * 16; bf16_t* rowp = O + (size_t)row * ldc + col0;
                const float rs = s / sqrtf(ssq[row] * (1.f / 1024.f) + 1e-6f);
#pragma unroll
                for (int bj = 0; bj < 2; ++bj) { f32x4 v0 = acc[ai][bj][m][0] * rs, v1 = acc[ai][bj][m][1] * rs;
                    u32x4 w; w.x = cvt_pk_bf16(v0[0], v0[1]); w.y = cvt_pk_bf16(v0[2], v0[3]); w.z = cvt_pk_bf16(v1[0], v1[1]); w.w = cvt_pk_bf16(v1[2], v1[3]);
                    *(u32x4*)(rowp + bj * HALF) = w; } }
    }
};
typedef unsigned u32x2e __attribute__((ext_vector_type(2)));
struct EpiRes2 {
    static constexpr bool PERM = true, AFTER_DRAIN = false;
    const float* base; float* out; bf16_t* xb; float* ssq; int ldc;
    __device__ __forceinline__ void operator()(const f32x4 (&acc)[2][2][4][2], const Unit& u, int wr, int wc, int fr, int fq) const {
        const int col0 = u.pn * BM + wc * 32 + 8 * fq;
#pragma unroll
        for (int ai = 0; ai < 2; ++ai)
#pragma unroll
            for (int m = 0; m < 4; ++m) { const int row = u.pm * BM + ai * HALF + wr * 64 + m * 16 + fr; const size_t off = (size_t)row * ldc + col0; float ps = 0.f;
#pragma unroll
                for (int bj = 0; bj < 2; ++bj) {
                    const f32x4 b0 = *(const f32x4*)(base + off + bj * HALF), b1 = *(const f32x4*)(base + off + bj * HALF + 4);
                    const f32x4 v0 = b0 + acc[ai][bj][m][0], v1 = b1 + acc[ai][bj][m][1];
                    *(f32x4*)(out + off + bj * HALF) = v0; *(f32x4*)(out + off + bj * HALF + 4) = v1;
                    if (xb != nullptr) { ps += ((v0[0] * v0[0] + v0[1] * v0[1]) + (v0[2] * v0[2] + v0[3] * v0[3])) + ((v1[0] * v1[0] + v1[1] * v1[1]) + (v1[2] * v1[2] + v1[3] * v1[3]));
                        u32x4 w; w.x = cvt_pk_bf16(v0[0], v0[1]); w.y = cvt_pk_bf16(v0[2], v0[3]); w.z = cvt_pk_bf16(v1[0], v1[1]); w.w = cvt_pk_bf16(v1[2], v1[3]); *(u32x4*)(xb + off + bj * HALF) = w; } }
                if (xb != nullptr) { ps += __shfl_xor(ps, 16); ps += __shfl_xor(ps, 32);
                    if (fq == 0) atomicAdd(ssq + row, ps); }
                asm volatile("" ::: "memory"); }
    }
};

struct EpiNull {
    static constexpr bool PERM = false, AFTER_DRAIN = false;
    __device__ __forceinline__ void operator()(const f32x4 (&acc)[2][2][4][2], const Unit& u, int wr, int wc, int fr, int fq) const {
#pragma unroll
        for (int ai = 0; ai < 2; ++ai)
#pragma unroll
            for (int bj = 0; bj < 2; ++bj)
#pragma unroll
                for (int m = 0; m < 4; ++m)
#pragma unroll
                    for (int n = 0; n < 2; ++n) asm volatile("" :: "v"(acc[ai][bj][m][n]));
    }
};

#define PG8_DPP(old, src, ctrl) __builtin_bit_cast(float, __builtin_amdgcn_update_dpp(__builtin_bit_cast(int, (float)(old)), __builtin_bit_cast(int, (float)(src)), (ctrl), 0xF, 0xF, false))
struct EpiConv {
    static constexpr bool PERM = true, AFTER_DRAIN = false;
    bf16_t* G; const float* ssq; const float* cw; const float* cb; int slmask; PG8_LAS float* xch; int nrows;
    __device__ __forceinline__ void operator()(f32x4 (&acc)[2][2][4][2], const Unit& u, int wr, int wc, int fr, int fq) const {
        const int t0 = 254 * u.pm - 1 + wr * 64 + fr;
#pragma unroll
        for (int ai = 0; ai < 2; ++ai)
#pragma unroll
            for (int m = 0; m < 4; ++m) { int t = t0 + ai * HALF + m * 16; t = t < 0 ? 0 : (t > nrows - 1 ? nrows - 1 : t);
                const float rs = 1.f / sqrtf(ssq[t] * (1.f / 1024.f) + 1e-6f);
#pragma unroll
                for (int bj = 0; bj < 2; ++bj)
#pragma unroll
                    for (int n = 0; n < 2; ++n) acc[ai][bj][m][n] *= rs; }
        if (fr == 0 || fr == 15) { const int which = fr == 0 ? 0 : 1, m = fr == 0 ? 0 : 3;
#pragma unroll
            for (int ai = 0; ai < 2; ++ai) { PG8_LAS float* d = xch + ((((2 * ai + wr) * 2 + which) * 4 + wc) * 4 + fq) * 16;
#pragma unroll
                for (int bj = 0; bj < 2; ++bj)
#pragma unroll
                    for (int n = 0; n < 2; ++n) *(PG8_LAS f32x4*)(d + bj * 8 + n * 4) = fr == 0 ? acc[ai][bj][0][n] : acc[ai][bj][3][n]; }
            (void)m; }
        asm volatile("s_waitcnt lgkmcnt(0)" ::: "memory"); __builtin_amdgcn_s_barrier(); asm volatile("" ::: "memory");
        const int ch0 = u.pn * 128 + wc * 32 + 8 * fq;
#pragma unroll
        for (int n = 0; n < 2; ++n) {
            const int chn = ch0 + 4 * n;
            const f32x4 wg0 = *(const f32x4*)(cw + chn), wg1 = *(const f32x4*)(cw + 5632 + chn), wg2 = *(const f32x4*)(cw + 2 * 5632 + chn), bgv = *(const f32x4*)(cb + chn);
            const f32x4 wv0 = *(const f32x4*)(cw + 2816 + chn), wv1 = *(const f32x4*)(cw + 5632 + 2816 + chn), wv2 = *(const f32x4*)(cw + 2 * 5632 + 2816 + chn), bvv = *(const f32x4*)(cb + 2816 + chn);
#pragma unroll
            for (int ai = 0; ai < 2; ++ai)
#pragma unroll
                for (int m = 0; m < 4; ++m) {
                    const int lr = ai * HALF + wr * 64 + m * 16 + fr, t = 254 * u.pm - 1 + lr;
                    const int gidx = 2 * ai + wr;
                    f32x4 pv[2], nx[2];
#pragma unroll
                    for (int bj = 0; bj < 2; ++bj) {
                        f32x4 upo, dno;
                        if (m > 0) { const f32x4 s = acc[ai][bj][m - 1][n];
#pragma unroll
                            for (int j = 0; j < 4; ++j) upo[j] = PG8_DPP(0.f, s[j], 0x121); }
                        else upo = gidx > 0 ? *(const PG8_LAS f32x4*)(xch + ((((gidx - 1) * 2 + 1) * 4 + wc) * 4 + fq) * 16 + bj * 8 + n * 4) : (f32x4){0.f, 0.f, 0.f, 0.f};
                        if (m < 3) { const f32x4 s = acc[ai][bj][m + 1][n];
#pragma unroll
                            for (int j = 0; j < 4; ++j) dno[j] = PG8_DPP(0.f, s[j], 0x12F); }
                        else dno = gidx < 3 ? *(const PG8_LAS f32x4*)(xch + ((((gidx + 1) * 2 + 0) * 4 + wc) * 4 + fq) * 16 + bj * 8 + n * 4) : (f32x4){0.f, 0.f, 0.f, 0.f};
                        const f32x4 cur = acc[ai][bj][m][n];
#pragma unroll
                        for (int j = 0; j < 4; ++j) { pv[bj][j] = PG8_DPP(upo[j], cur[j], 0x111);
                                                       nx[bj][j] = PG8_DPP(dno[j], cur[j], 0x101); }
                    }
                    const bool sfirst = (t & slmask) == 0, slast = (t & slmask) == slmask;
                    float res[4];
#pragma unroll
                    for (int j = 0; j < 4; ++j) {
                        const float gp = sfirst ? 0.f : pv[0][j], gn = slast ? 0.f : nx[0][j], vp = sfirst ? 0.f : pv[1][j], vn = slast ? 0.f : nx[1][j];
                        const float gate = gp * wg0[j] + acc[ai][0][m][n][j] * wg1[j] + gn * wg2[j] + bgv[j];
                        const float val = vp * wv0[j] + acc[ai][1][m][n][j] * wv1[j] + vn * wv2[j] + bvv[j];
                        res[j] = gate * __builtin_amdgcn_rcpf(1.f + __builtin_amdgcn_exp2f(-1.4426950408889634f * gate)) * val;
                    }
                    if (lr >= 1 && lr <= 254 && t < nrows) { u32x2e w; w.x = cvt_pk_bf16(res[0], res[1]); w.y = cvt_pk_bf16(res[2], res[3]); *(u32x2e*)(G + (size_t)t * 2816 + chn) = w; }
                }
        }
    }
};
template <class Epi, class Sched, bool ALIGN_EPI = false, bool SP2 = false>
__device__ __forceinline__ void gemm_phase(PG8_LAS unsigned char* lds, const Gemm g, const Sched& S, const Epi& E) {
    int tid_l = threadIdx.x; asm volatile("" : "+v"(tid_l)); const int tid = tid_l, wid = __builtin_amdgcn_readfirstlane(tid >> 6), lane = tid & 63, wr = wid >> 2, wc = wid & 3, fr = lane & 15, fq = lane >> 4;
    const int K = g.K, nt = K / BK;
    unsigned voffA[2], voffB[2];
#pragma unroll
    for (int i = 0; i < 2; ++i) { int R, C; stage_rc(tid * 16 + i * 8192, R, C); const int Rb = Epi::PERM ? ((R & ~31) + perm32(R & 31)) : R;
        voffA[i] = (unsigned)(R * K + C) * 2u; voffB[i] = (unsigned)(Rb * K + C) * 2u; }
    const size_t kstep = (size_t)(BK * 2);
    const size_t hstep = (size_t)HALF * K * 2;
    const size_t tstep = 2 * hstep; const size_t tstepA = (size_t)g.a_rows * K * 2;
    const unsigned ldsw = (unsigned)wid * 1024u;
    const int aoff = lds_byte(wr * 64 + fr, fq * 8), boff = lds_byte(wc * 32 + fr, fq * 8);
#define PG8_SA(b, h) (((b) * 2 + (h)) * HTB)
#define PG8_SB(b, h) ((4 + (b) * 2 + (h)) * HTB)
#define PG8_STAGE(bufoff, gbase, voff) do { _Pragma("unroll") for (int _i = 0; _i < 2; ++_i) \
        __builtin_amdgcn_global_load_lds((const unsigned*)((const char*)(gbase) + (voff)[_i]), (PG8_LAS unsigned*)(lds + (bufoff) + ldsw + _i * 8192), 16, 0, 0); } while (0)
#define PG8_LDA(dst, b, h) do { _Pragma("unroll") for (int m = 0; m < 4; ++m) _Pragma("unroll") for (int k = 0; k < 2; ++k) dst[m][k] = *(const PG8_LAS bf16x8*)(lds + PG8_SA(b, h) + aoff + m * 2048 + k * 1024); } while (0)
#define PG8_LDB(dst, b, h) do { _Pragma("unroll") for (int n = 0; n < 2; ++n) _Pragma("unroll") for (int k = 0; k < 2; ++k) dst[n][k] = *(const PG8_LAS bf16x8*)(lds + PG8_SB(b, h) + boff + n * 2048 + k * 1024); } while (0)
#define PG8_MMA(ai, bj, At, Bt) do { __builtin_amdgcn_s_setprio(1); _Pragma("unroll") for (int m = 0; m < 4; ++m) _Pragma("unroll") for (int n = 0; n < 2; ++n) _Pragma("unroll") for (int k = 0; k < 2; ++k) \
        acc[ai][bj][m][n] = __builtin_amdgcn_mfma_f32_16x16x32_bf16(Bt[n][k], At[m][k], acc[ai][bj][m][n], 0, 0, 0); __builtin_amdgcn_s_setprio(0); } while (0)
#define PG8_WAIT_V(n) asm volatile("s_waitcnt vmcnt(" #n ")" ::: "memory")
#define PG8_WAIT_L(n) asm volatile("s_waitcnt lgkmcnt(" #n ")" ::: "memory")
#define PG8_BAR __builtin_amdgcn_s_barrier()
#define PG8_SCHED __builtin_amdgcn_sched_barrier(0)
    Unit cur, nxt; int ui = 0;
    if (!S.next(0, cur)) return;
    f32x4 acc[2][2][4][2];
#pragma unroll
    for (int a = 0; a < 2; ++a)
#pragma unroll
        for (int b = 0; b < 2; ++b)
#pragma unroll
            for (int m = 0; m < 4; ++m)
#pragma unroll
                for (int n = 0; n < 2; ++n) acc[a][b][m][n] = (f32x4){0.f, 0.f, 0.f, 0.f};
    bf16x8 At[4][2], B0[2][2], B1[2][2];
    const char* cA = (const char*)g.A + (size_t)cur.pm * tstepA; const char* cB = (const char*)g.Bt + (size_t)cur.pn * tstep;
    S.a_ready(cur);
    if constexpr (SP2) {
        PG8_STAGE(PG8_SB(0, 0), cB, voffB); PG8_STAGE(PG8_SB(0, 1), cB + hstep, voffB); PG8_STAGE(PG8_SA(0, 0), cA, voffA); PG8_STAGE(PG8_SA(0, 1), cA + hstep, voffA);
        if (wr == 1) PG8_BAR;
        PG8_WAIT_V(2); PG8_BAR;
        PG8_STAGE(PG8_SB(1, 0), cB + kstep, voffB); PG8_STAGE(PG8_SA(1, 0), cA + kstep, voffA); PG8_STAGE(PG8_SB(1, 1), cB + hstep + kstep, voffB);
        PG8_WAIT_V(6); PG8_BAR;
    } else {
        PG8_STAGE(PG8_SB(0, 0), cB, voffB); PG8_STAGE(PG8_SA(0, 0), cA, voffA); PG8_STAGE(PG8_SB(0, 1), cB + hstep, voffB); PG8_STAGE(PG8_SA(0, 1), cA + hstep, voffA);
        if (wr == 1) PG8_BAR;
        PG8_WAIT_V(4); PG8_BAR;
        PG8_STAGE(PG8_SB(1, 0), cB + kstep, voffB); PG8_STAGE(PG8_SA(1, 0), cA + kstep, voffA); PG8_STAGE(PG8_SB(1, 1), cB + hstep + kstep, voffB);
        PG8_WAIT_V(6); PG8_BAR;
    }
    for (;;) {
        const bool has_next = S.next(ui + 1, nxt);
        const char* nA = has_next ? (const char*)g.A + (size_t)nxt.pm * tstepA : cA; const char* nB = has_next ? (const char*)g.Bt + (size_t)nxt.pn * tstep : cB;
        for (int t = 0; t < nt; t += 2) {
            const bool last = (t == nt - 2);
            const char* a1 = cA + (size_t)(t + 1) * kstep;
            const char* a2 = last ? nA : cA + (size_t)(t + 2) * kstep; const char* b2 = last ? nB : cB + (size_t)(t + 2) * kstep;
            const char* a3 = a2 + kstep; const char* b3 = b2 + kstep;
            if (last && has_next) S.a_ready(nxt);
            if constexpr (SP2) {
            PG8_LDB(B0, 0, 0); PG8_LDB(B1, 0, 1); PG8_SCHED; PG8_LDA(At, 0, 0); PG8_STAGE(PG8_SA(1, 1), a1 + hstep, voffA);
            PG8_WAIT_V(8); PG8_WAIT_L(0); PG8_BAR; PG8_MMA(0, 0, At, B0); PG8_MMA(0, 1, At, B1); PG8_BAR; PG8_SCHED;
            PG8_LDA(At, 0, 1); PG8_STAGE(PG8_SB(0, 0), b2, voffB); PG8_STAGE(PG8_SB(0, 1), b2 + hstep, voffB); PG8_STAGE(PG8_SA(0, 0), a2, voffA);
            PG8_WAIT_V(8); PG8_WAIT_L(0); PG8_BAR; PG8_MMA(1, 0, At, B0); PG8_MMA(1, 1, At, B1); PG8_BAR; PG8_SCHED;
            PG8_LDB(B0, 1, 0); PG8_LDB(B1, 1, 1); PG8_SCHED; PG8_LDA(At, 1, 0); PG8_STAGE(PG8_SA(0, 1), a2 + hstep, voffA);
            PG8_WAIT_V(8); PG8_WAIT_L(0); PG8_BAR; PG8_MMA(0, 0, At, B0); PG8_MMA(0, 1, At, B1); PG8_BAR; PG8_SCHED;
            PG8_LDA(At, 1, 1); PG8_STAGE(PG8_SB(1, 0), b3, voffB); PG8_STAGE(PG8_SB(1, 1), b3 + hstep, voffB); PG8_STAGE(PG8_SA(1, 0), a3, voffA);
            PG8_WAIT_V(8); PG8_WAIT_L(0); PG8_BAR; PG8_MMA(1, 0, At, B0); PG8_MMA(1, 1, At, B1); PG8_BAR; PG8_SCHED;
            } else {
            PG8_LDB(B0, 0, 0); PG8_SCHED; PG8_LDA(At, 0, 0); PG8_STAGE(PG8_SA(1, 1), a1 + hstep, voffA);
            PG8_WAIT_L(8); PG8_BAR; PG8_WAIT_L(0); PG8_MMA(0, 0, At, B0); PG8_BAR; PG8_SCHED;
            PG8_LDB(B1, 0, 1); PG8_STAGE(PG8_SB(0, 0), b2, voffB);
            PG8_BAR; PG8_WAIT_L(0); PG8_MMA(0, 1, At, B1); PG8_BAR;
            PG8_LDA(At, 0, 1); PG8_STAGE(PG8_SA(0, 0), a2, voffA);
            PG8_BAR; PG8_WAIT_L(0); PG8_MMA(1, 0, At, B0); PG8_BAR; PG8_SCHED;
            PG8_STAGE(PG8_SB(0, 1), b2 + hstep, voffB);
            PG8_WAIT_V(6); PG8_BAR; PG8_MMA(1, 1, At, B1); PG8_BAR;
            PG8_LDB(B0, 1, 0); PG8_SCHED; PG8_LDA(At, 1, 0); PG8_STAGE(PG8_SA(0, 1), a2 + hstep, voffA);
            PG8_WAIT_L(8); PG8_BAR; PG8_WAIT_L(0); PG8_MMA(0, 0, At, B0); PG8_BAR; PG8_SCHED;
            PG8_LDB(B1, 1, 1); PG8_STAGE(PG8_SB(1, 0), b3, voffB);
            PG8_BAR; PG8_WAIT_L(0); PG8_MMA(0, 1, At, B1); PG8_BAR;
            PG8_LDA(At, 1, 1); PG8_STAGE(PG8_SA(1, 0), a3, voffA);
            PG8_BAR; PG8_WAIT_L(0); PG8_MMA(1, 0, At, B0); PG8_BAR; PG8_SCHED;
            PG8_STAGE(PG8_SB(1, 1), b3 + hstep, voffB);
            PG8_WAIT_V(6); PG8_BAR; PG8_MMA(1, 1, At, B1); PG8_BAR;
            }
        }
        if constexpr (ALIGN_EPI) { if (wr == 0) PG8_BAR; }
        if constexpr (!Epi::AFTER_DRAIN) { E(acc, cur, wr, wc, fr, fq); S.done(cur); }
        if (!has_next) break;
#pragma unroll
        for (int a = 0; a < 2; ++a)
#pragma unroll
            for (int b = 0; b < 2; ++b)
#pragma unroll
                for (int m = 0; m < 4; ++m)
#pragma unroll
                    for (int n = 0; n < 2; ++n) acc[a][b][m][n] = (f32x4){0.f, 0.f, 0.f, 0.f};
        cur = nxt; cA = nA; cB = nB; ++ui;
        if constexpr (ALIGN_EPI) { if (wr == 1) PG8_BAR; }
    }
    PG8_WAIT_V(0);
    if constexpr (!ALIGN_EPI) { if (wr == 0) PG8_BAR; }
    PG8_BAR;
    if constexpr (Epi::AFTER_DRAIN) { E.fused(acc, cur, wr, wc, fr, fq, lds, wid, lane); S.done(cur); }
#undef PG8_SA
#undef PG8_SB
#undef PG8_STAGE
#undef PG8_LDA
#undef PG8_LDB
#undef PG8_MMA
#undef PG8_WAIT_V
#undef PG8_WAIT_L
#undef PG8_BAR
#undef PG8_SCHED
}
}
typedef __bf16 bf16x2_t __attribute__((ext_vector_type(2)));
__device__ __forceinline__ unsigned cvt_pk(float lo, float hi) { float __attribute__((ext_vector_type(2))) v = {lo, hi}; bf16x2_t b = __builtin_convertvector(v, bf16x2_t); return __builtin_bit_cast(unsigned, b); }
#define LAS __attribute__((address_space(3)))
#define XB_TMO      128
#define XB_XCNT(j)  (256  + 64 * (j))
#define XB_XSUB(j)  (1280 + 64 * (j))
#define XB_XGEN(j)  (2304 + 64 * (j))
#define XB_TOP      3328
#define XB_TOPGEN   3392
#define XCD_BAR_WORDS 3456
#define XB_SPIN_CAP (1u << 18)

__device__ __forceinline__ unsigned xb_ld(unsigned* p)              { return __hip_atomic_load(p, __ATOMIC_RELAXED, __HIP_MEMORY_SCOPE_AGENT); }
__device__ __forceinline__ unsigned xb_add(unsigned* p, unsigned v) { return __hip_atomic_fetch_add(p, v, __ATOMIC_RELAXED, __HIP_MEMORY_SCOPE_AGENT); }
__device__ __forceinline__ unsigned xb_xcc_id() { return (unsigned)__builtin_amdgcn_s_getreg((3 << 11) | 20) & 0xFu; }
#define XB_SPIN(cond, bar) do { unsigned _sp = 0; while (cond) { __builtin_amdgcn_s_sleep(1); \
    if ((++_sp & 255u) == 0u) { if (xb_ld(&(bar)[XB_TMO])) break; if (_sp > XB_SPIN_CAP) { atomicAdd(&(bar)[XB_TMO], 1u); break; } } } } while (0)

struct XcdBarrier {
    unsigned* bar; unsigned x;
    volatile LAS unsigned* st;
};

__device__ __forceinline__ XcdBarrier xcd_barrier_post(unsigned* bar, volatile LAS unsigned* st) {
    XcdBarrier b; b.bar = bar; b.x = xb_xcc_id(); b.st = st;
    if (threadIdx.x == 0) (void)xb_add(&bar[XB_XCNT(b.x)], 1u);
    return b;
}
__device__ __forceinline__ void xcd_barrier_complete(unsigned* bar, unsigned x, unsigned& nloc, unsigned& nx) {
    const unsigned G = gridDim.x * gridDim.y * gridDim.z;
    unsigned sum, cnt, mine, sp = 0u;
    for (;;) {
        sum = 0u; cnt = 0u; mine = 0u;
#pragma unroll
        for (unsigned j = 0; j < 16; ++j) { const unsigned c = xb_ld(&bar[XB_XCNT(j)]); sum += c; cnt += (c > 0u) ? 1u : 0u; mine = (j == x) ? c : mine; }
        if (sum == G) break;
        __builtin_amdgcn_s_sleep(1);
        if ((++sp & 255u) == 0u) { if (xb_ld(&bar[XB_TMO])) break; if (sp > XB_SPIN_CAP) { atomicAdd(&bar[XB_TMO], 1u); break; } }
    }
    nloc = mine > 0u ? mine : 1u; nx = cnt > 0u ? cnt : 1u;
}

__device__ __forceinline__ void xcd_barrier(const XcdBarrier& b) {
    asm volatile("s_waitcnt vmcnt(0)" ::: "memory");
    __syncthreads();
    if (threadIdx.x == 0) {
        unsigned* bar = b.bar;
        __builtin_amdgcn_s_waitcnt(0);
        unsigned nloc = b.st[0], nx = b.st[1];
        if (nloc == 0u) { xcd_barrier_complete(bar, b.x, nloc, nx); b.st[0] = nloc; b.st[1] = nx; }
        const unsigned old = xb_add(&bar[XB_XSUB(b.x)], 1u);
        const unsigned gen = old / nloc;
        if (old + 1u == (gen + 1u) * nloc) {
            __builtin_amdgcn_fence(__ATOMIC_RELEASE, "agent");
            asm volatile("s_waitcnt vmcnt(0)" ::: "memory");
            const unsigned og = xb_add(&bar[XB_TOP], 1u);
            const unsigned tg = og / nx;
            if (og + 1u == (tg + 1u) * nx) xb_add(&bar[XB_TOPGEN], 1u);
            else XB_SPIN(xb_ld(&bar[XB_TOPGEN]) == tg, bar);
            __builtin_amdgcn_fence(__ATOMIC_ACQUIRE, "agent");
            xb_add(&bar[XB_XGEN(b.x)], 1u);
            asm volatile("s_waitcnt vmcnt(0)" ::: "memory");
        } else {
            XB_SPIN(xb_ld(&bar[XB_XGEN(b.x)]) == gen, bar);
            __builtin_amdgcn_fence(__ATOMIC_ACQUIRE, "agent");
            asm volatile("s_waitcnt vmcnt(0)" ::: "memory");
        }
    }
    __syncthreads();
}
typedef unsigned short bf16_t;
typedef short bf16x8 __attribute__((ext_vector_type(8)));
typedef short s16x4 __attribute__((ext_vector_type(4)));
typedef float f32x16 __attribute__((ext_vector_type(16)));
typedef float f32x4 __attribute__((ext_vector_type(4)));
typedef float f32x2 __attribute__((ext_vector_type(2)));
typedef unsigned u32x4 __attribute__((ext_vector_type(4)));
typedef unsigned u32x2 __attribute__((ext_vector_type(2)));

constexpr int DM = 1024, DIN = 4352, DFF = 2816, DUP = 2 * DFF, DEPTH = 2;
constexpr int CH_ROWS = 16384, NCHUNK = 3;
constexpr int TW = 784;
constexpr int T_C = 0, T_L = 768;
constexpr float LOG2E = 1.4426950408889634f, LN2 = 0.6931471805599453f;
constexpr float QSCALE = 0.125f * LOG2E;
constexpr size_t MiB = 1u << 20;
constexpr size_t WS_WIN = 0, WS_WOUT = 18 * MiB, WS_WUP = 22 * MiB, WS_WDN = 44 * MiB, WS_HB = 56 * MiB, WS_PROJ = 88 * MiB, WS_TMP = 264 * MiB, WS_CTL = 394 * MiB, WS_XB = 395 * MiB, WS_SSQ = 459 * MiB, WS_END = 460 * MiB;
constexpr int LDS_BYTES = 147456 + 256 + 8192;
constexpr int NTHREADS = 512;

struct Args { const float* in[17]; float* out; unsigned char* ws; };

__device__ __forceinline__ float wave_sum(float v) {
#pragma unroll
    for (int o = 1; o < 64; o <<= 1) v += __shfl_xor(v, o);
    return v;
}
__device__ __forceinline__ unsigned f2bf(float f) { unsigned u = __builtin_bit_cast(unsigned, f); return (u + 0x7fffu + ((u >> 16) & 1u)) >> 16; }
__device__ __forceinline__ unsigned pk2(float lo, float hi) { return f2bf(lo) | (f2bf(hi) << 16); }
__device__ __forceinline__ float bf2f(unsigned short b) { return __builtin_bit_cast(float, (unsigned)b << 16); }

__device__ __forceinline__ void transpose_item(const float* W, int K, int N, bf16_t* WT, LAS float* scr, int item, int lane, const float* gain, bool gate_perm = false) {
    const int nblk = N / 32, kb = item / nblk, nb = item % nblk, k0 = 64 * kb, n0 = 32 * nb;
#pragma unroll 32
    for (int i = 0; i < 32; ++i) { const int kk = 2 * i + (lane >> 5); scr[kk * 33 + (lane & 31)] = W[(size_t)(k0 + kk) * N + n0 + (lane & 31)] * (gain ? gain[k0 + kk] : 1.f); }
    asm volatile("s_waitcnt lgkmcnt(0)" ::: "memory");
    const int c = lane & 7;
    const int half_ = N / 2, v_ = n0 >= half_ ? n0 - half_ : n0, d0 = gate_perm ? 256 * (v_ / 128) + (n0 >= half_ ? 128 : 0) + (v_ % 128) : n0;
#pragma unroll
    for (int j = 0; j < 4; ++j) { const int n = (lane >> 3) + 8 * j; const LAS float* s = scr + (8 * c) * 33 + n;
        u32x4 o; o.x = pk2(s[0 * 33], s[1 * 33]); o.y = pk2(s[2 * 33], s[3 * 33]); o.z = pk2(s[4 * 33], s[5 * 33]); o.w = pk2(s[6 * 33], s[7 * 33]);
        *(u32x4*)(WT + (size_t)(d0 + n) * K + k0 + 8 * c) = o; }
    asm volatile("s_waitcnt lgkmcnt(0)" ::: "memory");
}

__device__ __forceinline__ void rms_row_to_bf16(const float* xrow, const float* gain, bf16_t* orow, int lane) {
    const f32x4* xr = (const f32x4*)xrow + lane; const f32x4* gr = (const f32x4*)gain + lane;
    f32x4 v[4]; float s = 0.f;
#pragma unroll
    for (int j = 0; j < 4; ++j) { v[j] = xr[64 * j]; s += (v[j].x * v[j].x + v[j].y * v[j].y) + (v[j].z * v[j].z + v[j].w * v[j].w); }
    const float rstd = 1.f / sqrtf(wave_sum(s) * (1.f / DM) + 1e-6f);
    u32x2* o8 = (u32x2*)orow + lane;
#pragma unroll
    for (int j = 0; j < 4; ++j) { const f32x4 g = gr[64 * j]; u32x2 w; w.x = pk2(v[j].x * rstd * g.x, v[j].y * rstd * g.y); w.y = pk2(v[j].z * rstd * g.z, v[j].w * rstd * g.w); o8[64 * j] = w; }
}
__device__ __forceinline__ void rms_row_f32(float* xrow, const float* gain, int lane) {
    f32x4* xr = (f32x4*)xrow + lane; const f32x4* gr = (const f32x4*)gain + lane;
    f32x4 v[4]; float s = 0.f;
#pragma unroll
    for (int j = 0; j < 4; ++j) { v[j] = xr[64 * j]; s += (v[j].x * v[j].x + v[j].y * v[j].y) + (v[j].z * v[j].z + v[j].w * v[j].w); }
    const float rstd = 1.f / sqrtf(wave_sum(s) * (1.f / DM) + 1e-6f);
#pragma unroll
    for (int j = 0; j < 4; ++j) { const f32x4 g = gr[64 * j]; xr[64 * j] = v[j] * rstd * g; }
}

constexpr int KSTR = 144;
constexpr int ATT_K_OFF = 0, ATT_V_OFF = 2 * 64 * KSTR, ATT_SCR_OFF = ATT_V_OFF + 2 * 64 * 320;
__device__ __forceinline__ int crow(int r, int hi) { return (r & 3) + 8 * (r >> 2) + 4 * hi; }
typedef short v4i16_t __attribute__((ext_vector_type(4)));
__device__ __forceinline__ s16x4 vtr(const LAS unsigned char* p) { return __builtin_bit_cast(s16x4, __builtin_amdgcn_ds_read_tr16_b64_v4i16((LAS v4i16_t*)p)); }

template <int VD, bool WIN>
__device__ __forceinline__ void attn_unit(LAS unsigned char* lds, const bf16_t* Qp, const bf16_t* Kp, const bf16_t* Vp, size_t pitch,
                                          int q0, int L, float slope2, int W, float m_init, float l_init,
                                          float* Oout, size_t opitch, float* lse_out, size_t lpitch, bf16_t* Obf) {
    constexpr int VSTR = VD * 2 + 64, ND = VD / 32, VCH = VD / 8, VLD = 64 * VCH / NTHREADS;
    int tid_l = threadIdx.x; asm volatile("" : "+v"(tid_l)); const int tid = tid_l, lane = tid & 63, r32 = lane & 31, hi = lane >> 5, wid = __builtin_amdgcn_readfirstlane(tid >> 6);
    const int qw = q0 + wid * 32;
    int tlo = 0, thi = L / 64;
    if (WIN) { const int a = q0 - W; tlo = a > 0 ? a / 64 : 0; const int b = q0 + 256 + W; thi = (b < L ? b : L) / 64; }
    bf16x8 qr[4];
    { const bf16_t* qrow = Qp + (size_t)(qw + r32) * pitch + hi * 8;
#pragma unroll
      for (int d0 = 0; d0 < 4; ++d0) qr[d0] = *(const bf16x8*)(qrow + d0 * 16); }
    f32x16 o[ND];
#pragma unroll
    for (int d = 0; d < ND; ++d)
#pragma unroll
        for (int r = 0; r < 16; ++r) o[d][r] = 0.f;
    float m = m_init, l = hi == 0 ? l_init : 0.f;
    LAS float* wsf = (LAS float*)(lds + 6 * (64 * KSTR + 64 * (VD * 2 + 64))) + wid * 64;
    static_assert(VD == 64, "grouped staging is sized for 64-wide values");
    constexpr int SLOT = 64 * KSTR + 64 * VSTR, GRP = 6;
    const int krow = tid >> 3, kch = tid & 7;
    const float Wf = (float)W;
    for (int g0 = tlo; g0 < thi; g0 += GRP) {
        const int ng = thi - g0 < GRP ? thi - g0 : GRP;
        u32x4 kr[GRP], vr[GRP];
#pragma unroll
        for (int j = 0; j < GRP; ++j) if (j < ng) { kr[j] = *(const u32x4*)(Kp + (size_t)(64 * (g0 + j) + krow) * pitch + kch * 8); vr[j] = *(const u32x4*)(Vp + (size_t)(64 * (g0 + j) + krow) * pitch + kch * 8); }
        if (g0 != tlo) __syncthreads();
#pragma unroll
        for (int j = 0; j < GRP; ++j) if (j < ng) { *(LAS u32x4*)(lds + j * SLOT + krow * KSTR + kch * 16) = kr[j]; *(LAS u32x4*)(lds + j * SLOT + 64 * KSTR + krow * VSTR + kch * 16) = vr[j]; }
        __syncthreads();
      for (int j = 0; j < ng; ++j) {
        const int t = g0 + j;
        bool active = true;
        if (WIN) { const int kb = 64 * t; active = (kb + 63 >= qw - W) && (kb <= qw + 31 + W); }
        if (active) {
            const LAS unsigned char* Kb = lds + j * SLOT + r32 * KSTR + hi * 16;
            f32x16 p0, p1;
#pragma unroll
            for (int r = 0; r < 16; ++r) { p0[r] = 0.f; p1[r] = 0.f; }
#pragma unroll
            for (int d0 = 0; d0 < 4; ++d0) {
                const bf16x8 a0 = *(const LAS bf16x8*)(Kb + d0 * 32), a1 = *(const LAS bf16x8*)(Kb + 32 * KSTR + d0 * 32);
                p0 = __builtin_amdgcn_mfma_f32_32x32x16_bf16(a0, qr[d0], p0, 0, 0, 0);
                p1 = __builtin_amdgcn_mfma_f32_32x32x16_bf16(a1, qr[d0], p1, 0, 0, 0);
                if (d0 & 1) __builtin_amdgcn_sched_barrier(0);
            }
            const float dq = (float)(64 * t + 4 * hi - (qw + r32));
            float rm = -INFINITY;
#pragma unroll
            for (int r = 0; r < 16; ++r) {
                const float t0 = dq + (float)((r & 3) + 8 * (r >> 2)), t1 = t0 + 32.f;
                p0[r] = __builtin_fmaf(-slope2, __builtin_fabsf(t0), p0[r]);
                p1[r] = __builtin_fmaf(-slope2, __builtin_fabsf(t1), p1[r]);
                if (WIN) { if (__builtin_fabsf(t0) > Wf) p0[r] = -INFINITY; if (__builtin_fabsf(t1) > Wf) p1[r] = -INFINITY; }
                rm = __builtin_fmaxf(rm, __builtin_fmaxf(p0[r], p1[r]));
            }
            rm = __builtin_fmaxf(rm, __shfl_xor(rm, 32));
            if (__any(rm > m)) {
                const float mn = __builtin_fmaxf(m, rm); const float f = __builtin_amdgcn_exp2f(m - mn); m = mn; l *= f;
                if (hi == 0) wsf[r32] = f;
#pragma unroll
                for (int r = 0; r < 16; ++r) { const float fr = wsf[crow(r, hi)];
#pragma unroll
                    for (int d = 0; d < ND; ++d) o[d][r] *= fr; }
            }
            float ls = 0.f;
#pragma unroll
            for (int r = 0; r < 16; ++r) { p0[r] = __builtin_amdgcn_exp2f(p0[r] - m); p1[r] = __builtin_amdgcn_exp2f(p1[r] - m); ls += p0[r] + p1[r]; }
            l += ls;
            u32x4 pw[4];
#pragma unroll
            for (int c = 0; c < 4; ++c) {
                const f32x16& P = (c >> 1) ? p1 : p0; const int b = 8 * (c & 1);
                pw[c].x = cvt_pk(P[b + 0], P[b + 1]); pw[c].y = cvt_pk(P[b + 2], P[b + 3]); pw[c].z = cvt_pk(P[b + 4], P[b + 5]); pw[c].w = cvt_pk(P[b + 6], P[b + 7]);
            }
            const LAS unsigned char* Vb = lds + j * SLOT + 64 * KSTR + (4 * hi + ((lane & 15) >> 2)) * VSTR + (16 * ((lane >> 4) & 1) + 4 * (lane & 3)) * 2;
#pragma unroll
            for (int c = 0; c < 4; ++c)
#pragma unroll
                for (int d = 0; d < ND; ++d) {
                    const s16x4 vlo = vtr(Vb + c * 16 * VSTR + d * 64), vhi = vtr(Vb + c * 16 * VSTR + 8 * VSTR + d * 64);
                    const bf16x8 vf = (bf16x8){vlo[0], vlo[1], vlo[2], vlo[3], vhi[0], vhi[1], vhi[2], vhi[3]};
                    o[d] = __builtin_amdgcn_mfma_f32_32x32x16_bf16(__builtin_bit_cast(bf16x8, pw[c]), vf, o[d], 0, 0, 0);
                    if (d == ND - 1) __builtin_amdgcn_sched_barrier(0);
                }
        }
      }
    }
    l += __shfl_xor(l, 32);
    if (hi == 0) wsf[r32] = 1.f / l;
#pragma unroll
    for (int r = 0; r < 16; ++r) { const float ir = wsf[crow(r, hi)];
        if (Obf != nullptr) { bf16_t* orow = Obf + (size_t)(qw + crow(r, hi)) * opitch + r32;
#pragma unroll
            for (int d = 0; d < ND; ++d) orow[d * 32] = (bf16_t)f2bf(o[d][r] * ir);
        } else { float* orow = Oout + (size_t)(qw + crow(r, hi)) * opitch + r32;
#pragma unroll
            for (int d = 0; d < ND; ++d) orow[d * 32] = o[d][r] * ir; } }
    if (lse_out != nullptr && hi == 0) lse_out[(size_t)(qw + r32) * lpitch] = (m + __builtin_log2f(l)) * LN2;
    __syncthreads();
}

__device__ __forceinline__ void row_to_bf16_ssq(const float* xrow, bf16_t* orow, float* ssq, int lane) {
    const f32x4* xr = (const f32x4*)xrow + lane;
    f32x4 v[4]; float s = 0.f;
#pragma unroll
    for (int j = 0; j < 4; ++j) { v[j] = xr[64 * j]; s += (v[j].x * v[j].x + v[j].y * v[j].y) + (v[j].z * v[j].z + v[j].w * v[j].w); }
    s = wave_sum(s);
    u32x2* o8 = (u32x2*)orow + lane;
#pragma unroll
    for (int j = 0; j < 4; ++j) { u32x2 w; w.x = pk2(v[j].x, v[j].y); w.y = pk2(v[j].z, v[j].w); o8[64 * j] = w; }
    if (lane == 0) *ssq = s;
}
constexpr int BK_OFF = 0, BV_OFF = 2 * 64 * KSTR, BSCR_OFF = BV_OFF + 3 * 64 * 320, ATT_O0_OFF = BSCR_OFF + 2048;
static_assert(ATT_O0_OFF + 65536 <= 147456, "B attention LDS map");
constexpr float B_THR = 6.0f;
#ifndef B_LATE
#define B_LATE(w) false
#endif
template <int KI> __device__ __forceinline__ float fmamk_t(float a, float c) { float r; asm("v_fmamk_f32 %0, %1, %3, %2" : "=v"(r) : "v"(a), "v"(c), "n"(__builtin_bit_cast(int, (float)KI))); return r; }
__device__ __forceinline__ float max3f(float a, float b, float c) { float r; asm("v_max3_f32 %0, %1, %2, %3" : "=v"(r) : "v"(a), "v"(b), "v"(c)); return r; }
__device__ __forceinline__ void attn_b_unit(LAS unsigned char* lds, const bf16_t* base, int h, int q0, int L, float slope2_, float lam,
                                            const float* subln_l, float postscale, bf16_t* mix) {
    constexpr int VD = 128, VSTR = VD * 2 + 64, ND = 4, VCH = 16, VLD = 2;
    int tid_l = threadIdx.x; asm volatile("" : "+v"(tid_l)); const int tid = tid_l, lane = tid & 63, r32 = lane & 31, hi = lane >> 5, wid = __builtin_amdgcn_readfirstlane(tid >> 6);
    const int qw = q0 + wid * 32, NT = L / 64, c0 = q0 / 64;
    LAS float* wsf = (LAS float*)(lds + BSCR_OFF) + wid * 64;
    const bool late = B_LATE(wid);
    const int krow = tid >> 3, kch = tid & 7;
    const bf16_t* Vp = base + 1536 + h * 128;
    const float qposf_ = (float)(qw + r32);
    for (int mp = 0; mp < 2; ++mp) {
        const bf16_t* Qp = base + 512 + (h * 2 + mp) * 64; const bf16_t* Kp = base + 1024 + (h * 2 + mp) * 64;
        bf16x8 qr[4];
        { const bf16_t* qrow = Qp + (size_t)(qw + r32) * DIN + hi * 8;
#pragma unroll
          for (int d0 = 0; d0 < 4; ++d0) qr[d0] = *(const bf16x8*)(qrow + d0 * 16); }
        f32x16 o[ND];
#pragma unroll
        for (int d = 0; d < ND; ++d)
#pragma unroll
            for (int r = 0; r < 16; ++r) o[d][r] = 0.f;
        float mref = 0.f, l = 0.f;
        u32x4 kreg; u32x4 vreg[VLD];
        const unsigned koff = (unsigned)(krow * DIN + kch * 8) * 2u, voff = (unsigned)((tid >> 4) * DIN + (tid & 15) * 8) * 2u;
#define ATT_GLOAD(t) do { const char* kt_ = (const char*)Kp + (size_t)(t) * (64 * DIN * 2); const char* vt_ = (const char*)Vp + (size_t)(t) * (64 * DIN * 2); \
        kreg = *(const u32x4*)(kt_ + koff); vreg[0] = *(const u32x4*)(vt_ + voff); vreg[1] = *(const u32x4*)(vt_ + 32 * DIN * 2 + voff); } while (0)
#define ATT_LSTORE(b, vs) do { *(LAS u32x4*)(lds + BK_OFF + (b) * 64 * KSTR + krow * KSTR + kch * 16) = kreg; \
        *(LAS u32x4*)(lds + BV_OFF + (vs) * 64 * VSTR + (tid >> 4) * VSTR + (tid & 15) * 16) = vreg[0]; *(LAS u32x4*)(lds + BV_OFF + (vs) * 64 * VSTR + ((tid >> 4) + 32) * VSTR + (tid & 15) * 16) = vreg[1]; } while (0)
#define VFRAG(x, d) (bf16x8){x[d][0][0], x[d][0][1], x[d][0][2], x[d][0][3], x[d][1][0], x[d][1][1], x[d][1][2], x[d][1][3]}
#define PV_LOAD01(vs) do { \
        const LAS unsigned char* Vb = lds + BV_OFF + (vs) * 64 * VSTR + (4 * hi + ((lane & 15) >> 2)) * VSTR + (16 * ((lane >> 4) & 1) + 4 * (lane & 3)) * 2; \
        _Pragma("unroll") for (int d = 0; d < ND; ++d) { va[d][0] = vtr(Vb + d * 64); va[d][1] = vtr(Vb + 8 * VSTR + d * 64); } \
        _Pragma("unroll") for (int d = 0; d < ND; ++d) { vb2[d][0] = vtr(Vb + 16 * VSTR + d * 64); vb2[d][1] = vtr(Vb + 16 * VSTR + 8 * VSTR + d * 64); } \
        __builtin_amdgcn_sched_barrier(0); } while (0)
#define PV_MMA(vs) do { \
        const LAS unsigned char* Vb = lds + BV_OFF + (vs) * 64 * VSTR + (4 * hi + ((lane & 15) >> 2)) * VSTR + (16 * ((lane >> 4) & 1) + 4 * (lane & 3)) * 2; \
        _Pragma("unroll") for (int d = 0; d < ND; ++d) o[d] = __builtin_amdgcn_mfma_f32_32x32x16_bf16(__builtin_bit_cast(bf16x8, pw[0]), VFRAG(va, d), o[d], 0, 0, 0); \
        __builtin_amdgcn_sched_barrier(0); \
        _Pragma("unroll") for (int d = 0; d < ND; ++d) { va[d][0] = vtr(Vb + 32 * VSTR + d * 64); va[d][1] = vtr(Vb + 32 * VSTR + 8 * VSTR + d * 64); } \
        __builtin_amdgcn_sched_barrier(0); \
        _Pragma("unroll") for (int d = 0; d < ND; ++d) o[d] = __builtin_amdgcn_mfma_f32_32x32x16_bf16(__builtin_bit_cast(bf16x8, pw[1]), VFRAG(vb2, d), o[d], 0, 0, 0); \
        __builtin_amdgcn_sched_barrier(0); \
        _Pragma("unroll") for (int d = 0; d < ND; ++d) { vb2[d][0] = vtr(Vb + 48 * VSTR + d * 64); vb2[d][1] = vtr(Vb + 48 * VSTR + 8 * VSTR + d * 64); } \
        __builtin_amdgcn_sched_barrier(0); \
        _Pragma("unroll") for (int d = 0; d < ND; ++d) o[d] = __builtin_amdgcn_mfma_f32_32x32x16_bf16(__builtin_bit_cast(bf16x8, pw[2]), VFRAG(va, d), o[d], 0, 0, 0); \
        _Pragma("unroll") for (int d = 0; d < ND; ++d) o[d] = __builtin_amdgcn_mfma_f32_32x32x16_bf16(__builtin_bit_cast(bf16x8, pw[3]), VFRAG(vb2, d), o[d], 0, 0, 0); \
        __builtin_amdgcn_sched_barrier(0); } while (0)
        int first = 1; asm volatile("" : "+s"(first));
#define B_TILE(i_) ((i_) < 4 ? c0 + (i_) : ((i_) - 4 < c0 ? (i_) - 4 : (i_)))
        int t = B_TILE(0);
        int vs_prev = 2, vs_cur = 0, vs_next = 1;
        u32x4 pw[4];
        ATT_GLOAD(t); ATT_LSTORE(0, 0); __syncthreads();
        for (int i = 0; i < NT; ++i) {
            const int buf = i & 1;
            int tn = 0;
            if (i + 1 < NT) { tn = B_TILE(i + 1); ATT_GLOAD(tn); }
            f32x16 p0, p1;
            const int kb = 64 * t;
            float slope2 = slope2_, qposf = qposf_; asm volatile("" : "+v"(slope2), "+v"(qposf));
            const LAS unsigned char* Kb = lds + BK_OFF + buf * 64 * KSTR + r32 * KSTR + hi * 16;
            bf16x8 kf[8];
#pragma unroll
            for (int d0 = 0; d0 < 4; ++d0) { kf[d0] = *(const LAS bf16x8*)(Kb + d0 * 32); kf[4 + d0] = *(const LAS bf16x8*)(Kb + 32 * KSTR + d0 * 32); }
            const LAS unsigned char* Vb = lds + BV_OFF + vs_cur * 64 * VSTR + (4 * hi + ((lane & 15) >> 2)) * VSTR + (16 * ((lane >> 4) & 1) + 4 * (lane & 3)) * 2;
            s16x4 va[ND][2], vb2[ND][2];
            const bool offdiag = (kb + 63 < qw || kb > qw + 31);
            const float dq = (float)(kb + 4 * hi) - qposf;
#define QK_P0(INIT0, INIT1) do { \
            _Pragma("unroll") for (int r = 0; r < 16; ++r) { const float kv = (float)((r & 3) + 8 * (r >> 2)); p0[r] = INIT0; } \
            __builtin_amdgcn_sched_barrier(0); \
            _Pragma("unroll") for (int d0 = 0; d0 < 4; ++d0) { \
                p0 = __builtin_amdgcn_mfma_f32_32x32x16_bf16(kf[d0], qr[d0], p0, 0, 0, 0); \
                _Pragma("unroll") for (int r = 4 * d0; r < 4 * d0 + 4; ++r) { const float kv = (float)((r & 3) + 8 * (r >> 2) + 32); p1[r] = INIT1; } \
                __builtin_amdgcn_sched_barrier(0); } } while (0)
            if (offdiag) {
                const float sg = (kb > qw) ? -slope2 : slope2, b0 = sg * dq - mref;
                p0[0] = fmamk_t<0>(sg, b0); p0[1] = fmamk_t<1>(sg, b0); p0[2] = fmamk_t<2>(sg, b0); p0[3] = fmamk_t<3>(sg, b0); p0[4] = fmamk_t<8>(sg, b0); p0[5] = fmamk_t<9>(sg, b0); p0[6] = fmamk_t<10>(sg, b0); p0[7] = fmamk_t<11>(sg, b0); p0[8] = fmamk_t<16>(sg, b0); p0[9] = fmamk_t<17>(sg, b0); p0[10] = fmamk_t<18>(sg, b0); p0[11] = fmamk_t<19>(sg, b0); p0[12] = fmamk_t<24>(sg, b0); p0[13] = fmamk_t<25>(sg, b0); p0[14] = fmamk_t<26>(sg, b0); p0[15] = fmamk_t<27>(sg, b0);
                __builtin_amdgcn_sched_barrier(0);
                p0 = __builtin_amdgcn_mfma_f32_32x32x16_bf16(kf[0], qr[0], p0, 0, 0, 0); p1[0] = fmamk_t<32>(sg, b0); p1[1] = fmamk_t<33>(sg, b0); p1[2] = fmamk_t<34>(sg, b0); p1[3] = fmamk_t<35>(sg, b0); __builtin_amdgcn_sched_barrier(0);
                p0 = __builtin_amdgcn_mfma_f32_32x32x16_bf16(kf[1], qr[1], p0, 0, 0, 0); p1[4] = fmamk_t<40>(sg, b0); p1[5] = fmamk_t<41>(sg, b0); p1[6] = fmamk_t<42>(sg, b0); p1[7] = fmamk_t<43>(sg, b0); __builtin_amdgcn_sched_barrier(0);
                p0 = __builtin_amdgcn_mfma_f32_32x32x16_bf16(kf[2], qr[2], p0, 0, 0, 0); p1[8] = fmamk_t<48>(sg, b0); p1[9] = fmamk_t<49>(sg, b0); p1[10] = fmamk_t<50>(sg, b0); p1[11] = fmamk_t<51>(sg, b0); __builtin_amdgcn_sched_barrier(0);
                p0 = __builtin_amdgcn_mfma_f32_32x32x16_bf16(kf[3], qr[3], p0, 0, 0, 0); p1[12] = fmamk_t<56>(sg, b0); p1[13] = fmamk_t<57>(sg, b0); p1[14] = fmamk_t<58>(sg, b0); p1[15] = fmamk_t<59>(sg, b0); __builtin_amdgcn_sched_barrier(0);
            } else {
                const float nmref = -mref;
                QK_P0(__builtin_fmaf(-slope2, __builtin_fabsf(dq + kv), nmref), __builtin_fmaf(-slope2, __builtin_fabsf(dq + kv), nmref));
            }
#undef QK_P0
#pragma unroll
            for (int d = 0; d < ND; ++d) { va[d][0] = vtr(Vb + d * 64); va[d][1] = vtr(Vb + 8 * VSTR + d * 64); }
#pragma unroll
            for (int d = 0; d < ND; ++d) { vb2[d][0] = vtr(Vb + 16 * VSTR + d * 64); vb2[d][1] = vtr(Vb + 16 * VSTR + 8 * VSTR + d * 64); }
            __builtin_amdgcn_sched_barrier(0);
#pragma unroll
            for (int d0 = 0; d0 < 4; ++d0) p1 = __builtin_amdgcn_mfma_f32_32x32x16_bf16(kf[4 + d0], qr[d0], p1, 0, 0, 0);
            __builtin_amdgcn_sched_barrier(0);
            float rm, rmb;
            asm volatile("s_nop 15\n\ts_nop 7\n\tv_max3_f32 %0, %1, %2, %3\n\tv_max3_f32 %0, %0, %4, %5\n\tv_max3_f32 %0, %0, %6, %7\n\tv_max3_f32 %0, %0, %8, %9\n\t"
                         "v_max3_f32 %0, %0, %10, %11\n\tv_max3_f32 %0, %0, %12, %13\n\tv_max3_f32 %0, %0, %14, %15\n\tv_max3_f32 %0, %0, %16, %16"
                         : "=&v"(rm) : "v"(p0[0]), "v"(p0[1]), "v"(p0[2]), "v"(p0[3]), "v"(p0[4]), "v"(p0[5]), "v"(p0[6]), "v"(p0[7]), "v"(p0[8]), "v"(p0[9]), "v"(p0[10]), "v"(p0[11]), "v"(p0[12]), "v"(p0[13]), "v"(p0[14]), "v"(p0[15]));
            asm volatile("v_max3_f32 %0, %1, %2, %3\n\tv_max3_f32 %0, %0, %4, %5\n\tv_max3_f32 %0, %0, %6, %7\n\tv_max3_f32 %0, %0, %8, %9\n\t"
                         "v_max3_f32 %0, %0, %10, %11\n\tv_max3_f32 %0, %0, %12, %13\n\tv_max3_f32 %0, %0, %14, %15\n\tv_max3_f32 %0, %0, %16, %16"
                         : "=&v"(rmb) : "v"(p1[0]), "v"(p1[1]), "v"(p1[2]), "v"(p1[3]), "v"(p1[4]), "v"(p1[5]), "v"(p1[6]), "v"(p1[7]), "v"(p1[8]), "v"(p1[9]), "v"(p1[10]), "v"(p1[11]), "v"(p1[12]), "v"(p1[13]), "v"(p1[14]), "v"(p1[15]));
            rm = __builtin_fmaxf(rm, rmb);
            { auto rr_ = __builtin_amdgcn_permlane32_swap(__float_as_uint(rm), __float_as_uint(rm), false, false); rm = __builtin_fmaxf(__uint_as_float(rr_[0]), __uint_as_float(rr_[1])); }
            if (first || __any(rm > B_THR)) {
                const float delta = (first || rm > B_THR) ? rm : 0.f; const float f = __builtin_amdgcn_exp2f(-delta); mref += delta; l *= f;
#pragma unroll
                for (int r = 0; r < 16; ++r) { p0[r] -= delta; p1[r] -= delta; }
                {
                    if (hi == 0) wsf[r32] = f;
#pragma unroll
                    for (int r = 0; r < 16; ++r) { const float fr = wsf[crow(r, hi)];
#pragma unroll
                        for (int d = 0; d < ND; ++d) o[d][r] *= fr; }
                }
            }
            float ls0 = 0.f, ls1 = 0.f;
#pragma unroll
            for (int r = 0; r < 16; ++r) { p0[r] = __builtin_amdgcn_exp2f(p0[r]); ls0 += p0[r]; }
            pw[0].x = cvt_pk(p0[0], p0[1]); pw[0].y = cvt_pk(p0[2], p0[3]); pw[0].z = cvt_pk(p0[4], p0[5]); pw[0].w = cvt_pk(p0[6], p0[7]);
            pw[1].x = cvt_pk(p0[8], p0[9]); pw[1].y = cvt_pk(p0[10], p0[11]); pw[1].z = cvt_pk(p0[12], p0[13]); pw[1].w = cvt_pk(p0[14], p0[15]);
            __builtin_amdgcn_sched_barrier(0);
#define VFRAG(x, d) (bf16x8){x[d][0][0], x[d][0][1], x[d][0][2], x[d][0][3], x[d][1][0], x[d][1][1], x[d][1][2], x[d][1][3]}
#pragma unroll
            for (int d = 0; d < ND; ++d) {
                o[d] = __builtin_amdgcn_mfma_f32_32x32x16_bf16(__builtin_bit_cast(bf16x8, pw[0]), VFRAG(va, d), o[d], 0, 0, 0);
                p1[2 * d] = __builtin_amdgcn_exp2f(p1[2 * d]); p1[2 * d + 1] = __builtin_amdgcn_exp2f(p1[2 * d + 1]); ls1 += p1[2 * d]; ls0 += p1[2 * d + 1];
                __builtin_amdgcn_sched_barrier(0);
            }
#pragma unroll
            for (int d = 0; d < ND; ++d) { va[d][0] = vtr(Vb + 32 * VSTR + d * 64); va[d][1] = vtr(Vb + 32 * VSTR + 8 * VSTR + d * 64); }
            __builtin_amdgcn_sched_barrier(0);
#pragma unroll
            for (int d = 0; d < ND; ++d) {
                o[d] = __builtin_amdgcn_mfma_f32_32x32x16_bf16(__builtin_bit_cast(bf16x8, pw[1]), VFRAG(vb2, d), o[d], 0, 0, 0);
                p1[8 + 2 * d] = __builtin_amdgcn_exp2f(p1[8 + 2 * d]); p1[8 + 2 * d + 1] = __builtin_amdgcn_exp2f(p1[8 + 2 * d + 1]); ls1 += p1[8 + 2 * d]; ls0 += p1[8 + 2 * d + 1];
                __builtin_amdgcn_sched_barrier(0);
            }
#pragma unroll
            for (int d = 0; d < ND; ++d) { vb2[d][0] = vtr(Vb + 48 * VSTR + d * 64); vb2[d][1] = vtr(Vb + 48 * VSTR + 8 * VSTR + d * 64); }
            if (i + 1 < NT) ATT_LSTORE(buf ^ 1, vs_next);
            l += ls0 + ls1;
            pw[2].x = cvt_pk(p1[0], p1[1]); pw[2].y = cvt_pk(p1[2], p1[3]); pw[2].z = cvt_pk(p1[4], p1[5]); pw[2].w = cvt_pk(p1[6], p1[7]);
            __builtin_amdgcn_sched_barrier(0);
#pragma unroll
            for (int d = 0; d < ND; ++d) {
                o[d] = __builtin_amdgcn_mfma_f32_32x32x16_bf16(__builtin_bit_cast(bf16x8, pw[2]), VFRAG(va, d), o[d], 0, 0, 0);
                if (d == 0) { pw[3].x = cvt_pk(p1[8], p1[9]); pw[3].y = cvt_pk(p1[10], p1[11]); } else if (d == 1) { pw[3].z = cvt_pk(p1[12], p1[13]); pw[3].w = cvt_pk(p1[14], p1[15]); }
                __builtin_amdgcn_sched_barrier(0);
            }
#pragma unroll
            for (int d = 0; d < ND; ++d) o[d] = __builtin_amdgcn_mfma_f32_32x32x16_bf16(__builtin_bit_cast(bf16x8, pw[3]), VFRAG(vb2, d), o[d], 0, 0, 0);
#undef VFRAG
            __builtin_amdgcn_sched_barrier(0);
            first = 0;
            t = tn;
            { const int tmp_ = vs_prev; vs_prev = vs_cur; vs_cur = vs_next; vs_next = tmp_; }
            __syncthreads();
        }
#undef PV_LOAD01
#undef PV_MMA
#undef B_TILE
#undef VFRAG
#undef ATT_GLOAD
#undef ATT_LSTORE
        l += __shfl_xor(l, 32);
        if (hi == 0) wsf[r32] = 1.f / l;
        int lane_e = lane, qw_e = qw; asm volatile("" : "+v"(lane_e)); asm volatile("" : "+s"(qw_e));
        const int r32 = lane_e & 31, hi = lane_e >> 5, qw = qw_e;
        LAS unsigned* o0buf = (LAS unsigned*)(lds + ATT_O0_OFF) + wid * 2048 + lane_e;
        if (mp == 0) {
#pragma unroll
            for (int d = 0; d < ND; ++d)
#pragma unroll
                for (int r = 0; r < 16; r += 2) { const float i0 = wsf[crow(r, hi)], i1 = wsf[crow(r + 1, hi)]; o0buf[(d * 8 + (r >> 1)) * 64] = cvt_pk(o[d][r] * i0, o[d][r + 1] * i1); }
        } else {
            float gs[ND];
#pragma unroll
            for (int d = 0; d < ND; ++d) gs[d] = subln_l[d * 32 + r32] * postscale;
#pragma unroll
            for (int r = 0; r < 16; r += 2) {
                const float i0 = wsf[crow(r, hi)], i1 = wsf[crow(r + 1, hi)];
                float v0[ND], v1[ND]; float s0 = 0.f, s1 = 0.f;
#pragma unroll
                for (int d = 0; d < ND; ++d) { const unsigned w = o0buf[(d * 8 + (r >> 1)) * 64];
                    v0[d] = __builtin_bit_cast(float, w << 16) - lam * (o[d][r] * i0); v1[d] = __builtin_bit_cast(float, w & 0xffff0000u) - lam * (o[d][r + 1] * i1);
                    s0 += v0[d] * v0[d]; s1 += v1[d] * v1[d]; }
#pragma unroll
                for (int sh = 1; sh < 32; sh <<= 1) { s0 += __shfl_xor(s0, sh); s1 += __shfl_xor(s1, sh); }
                const float r0 = 1.f / sqrtf(s0 * (1.f / 128.f) + 1e-5f), r1 = 1.f / sqrtf(s1 * (1.f / 128.f) + 1e-5f);
                bf16_t* row0 = mix + (size_t)(qw + crow(r, hi)) * DM + r32; bf16_t* row1 = mix + (size_t)(qw + crow(r + 1, hi)) * DM + r32;
#pragma unroll
                for (int d = 0; d < ND; ++d) { row0[d * 32] = (bf16_t)f2bf(v0[d] * r0 * gs[d]); row1[d * 32] = (bf16_t)f2bf(v1[d] * r1 * gs[d]); }
            }
        }
        __syncthreads();
    }
}
__device__ __forceinline__ float alibi_slope(int i, int n) { return exp2f(-8.0f * (float)(i + 1) / (float)n); }
struct Ctx { int tid, lane, wave, G, cu, gw, NGW; };

__device__ __forceinline__ void ph_weights(const Args& a, LAS unsigned char* lds, int l, int gw0, int nw, int wave, int lane) {
    unsigned char* ws = a.ws;
    bf16_t* WinT = (bf16_t*)(ws + WS_WIN); bf16_t* WoutT = (bf16_t*)(ws + WS_WOUT); bf16_t* WupT = (bf16_t*)(ws + WS_WUP); bf16_t* WdnT = (bf16_t*)(ws + WS_WDN);
    const float* w_in = a.in[3]; const float* w_out = a.in[10]; const float* w_up = a.in[12]; const float* w_down = a.in[15];
    LAS float* scr = (LAS float*)(lds + wave * 16384);
    constexpr int I_IN = (DM / 64) * (DIN / 32), I_OUT = (DM / 64) * (DM / 32), I_UP = (DM / 64) * (DUP / 32), I_DN = (DFF / 64) * (DM / 32);
    constexpr int PER_L = I_IN + I_OUT + I_UP + I_DN;
    for (int it = gw0; it < PER_L; it += nw) {
        int r = it;
        if (r < I_IN) { transpose_item(w_in + (size_t)l * DM * DIN, DM, DIN, WinT + (size_t)l * DIN * DM, scr, r, lane, a.in[2] + l * DM); continue; } r -= I_IN;
        if (r < I_OUT) { transpose_item(w_out + (size_t)l * DM * DM, DM, DM, WoutT + (size_t)l * DM * DM, scr, r, lane, nullptr); continue; } r -= I_OUT;
        if (r < I_UP) { transpose_item(w_up + (size_t)l * DM * DUP, DM, DUP, WupT + (size_t)l * DUP * DM, scr, r, lane, a.in[11] + l * DM, true); continue; } r -= I_UP;
        transpose_item(w_down + (size_t)l * DFF * DM, DFF, DM, WdnT + (size_t)l * DM * DFF, scr, r, lane, nullptr);
    }
}
__device__ __forceinline__ const float* chunk_in(const Args& a, int ch) { return ch == 0 ? a.in[0] : a.in[1] + (size_t)(ch - 1) * CH_ROWS * DM; }
__device__ __forceinline__ float* chunk_out(const Args& a, int ch) { return a.out + (size_t)ch * CH_ROWS * DM; }

__device__ __forceinline__ void ph_norm_bf16(const Ctx& c, const float* xsrc, const float* gain, bf16_t* HB) {
    for (int r = c.gw; r < CH_ROWS; r += c.NGW) rms_row_to_bf16(xsrc + (size_t)r * DM, gain, HB + (size_t)r * DM, c.lane);
}
__device__ __forceinline__ void ph_final_norm(const Ctx& c, float* xo, const float* gain) {
    for (int r = c.gw; r < CH_ROWS; r += c.NGW) rms_row_f32(xo + (size_t)r * DM, gain, c.lane);
}

__device__ __forceinline__ void ph_attn(const Args& a, const Ctx& c, LAS unsigned char* lds, int ch, int layer) {
    const bf16_t* PROJ = (const bf16_t*)(a.ws + WS_PROJ); float* TMP = (float*)(a.ws + WS_TMP);
    const int SL = ch == 0 ? 16384 : 4096, sl_shift = ch == 0 ? 14 : 12;
    const int cu = c.cu, G = c.G;
#ifndef SKIP_B
    {
        const float lam_init = layer == 0 ? 0.2f : (0.8f - 0.6f * 0.7408182206817179f);
        const float s1 = wave_sum(a.in[5][layer * 64 + c.lane] * a.in[6][layer * 64 + c.lane]);
        const float s2 = wave_sum(a.in[7][layer * 64 + c.lane] * a.in[8][layer * 64 + c.lane]);
        const float lam = expf(s1) - expf(s2) + lam_init;
        bf16_t* HBm = (bf16_t*)(a.ws + WS_HB);
#ifdef PROBE_B2
        for (int rep_ = 0; rep_ < 2; ++rep_)
#endif
        for (int u = cu; u < 256; u += G) {
            int seq, h, qb; const int xcd = u & 7, idx = u >> 3;
            if (ch == 0) { seq = 0; h = xcd >> 1; qb = (xcd & 1) * 32 + idx; }
            else { const int pair = xcd * 2 + (idx >> 4); seq = pair >> 2; h = pair & 3; qb = idx & 15; }
            const size_t rb = (size_t)seq * SL;
            attn_b_unit(lds, PROJ + rb * DIN, h, qb * 256, SL, alibi_slope(h, 4) * LOG2E, lam, a.in[9] + layer * 128, 1.f - lam_init, HBm + rb * DM + 256 + h * 128);
        }
    }
#endif
#ifndef SKIP_AC
#ifdef PROBE_AC2
    for (int rep_ = 0; rep_ < 2; ++rep_)
#endif
    for (int uu = cu; uu < 1024; uu += G) {
        const bf16_t *qp, *kp, *vp; size_t pitch, opitch, lpitch; int q0, L, W; float slope2, m_init, l_init; float *op, *lp; bf16_t* obf;
        if (uu < 256) {
            const int hq = uu >> 6, blk = uu & 63;
            const int seq = (blk * 256) >> sl_shift, qb = blk - ((seq << sl_shift) >> 8);
            const size_t rb = (size_t)seq * SL; const bf16_t* base = PROJ + rb * DIN;
            qp = base + hq * 64; kp = base + 256 + (hq >> 1) * 64; vp = base + 384 + (hq >> 1) * 64; pitch = DIN; q0 = qb * 256; L = SL;
            slope2 = alibi_slope(hq, 4) * LOG2E; W = 128; m_init = a.in[4][layer * 4 + hq] * LOG2E; l_init = 1.f;
            op = nullptr; obf = (bf16_t*)(a.ws + WS_HB) + rb * DM + hq * 64; opitch = DM; lp = nullptr; lpitch = 0;
        } else {
            const int uc = uu - 256;
            const int gh = uc >> 6, blk = uc & 63, gq = gh >> 2;
            const int dsh = 2 * gq, d = 1 << dsh;
            const int seq = (blk * 256) >> sl_shift, b2 = blk - ((seq << sl_shift) >> 8);
            const int nbr = (SL >> dsh) >> 8;
            const int res = b2 / nbr, qb = b2 % nbr;
            const size_t rb = (size_t)seq * SL + res; const bf16_t* base = PROJ + rb * DIN;
            qp = base + 2048 + gh * 64; kp = base + 2816 + gh * 64; vp = base + 3584 + gh * 64; pitch = (size_t)DIN * d; q0 = qb * 256; L = SL >> dsh;
            slope2 = alibi_slope(gh, 12) * (float)d * LOG2E; W = 64; m_init = -1e30f; l_init = 0.f;
            op = nullptr; obf = (bf16_t*)TMP + rb * 768 + gh * 64; opitch = (size_t)768 * d; lp = TMP + 8 * 1024 * 1024 + rb * 16 + gh; lpitch = (size_t)16 * d;
        }
        attn_unit<64, true>(lds, qp, kp, vp, pitch, q0, L, slope2, W, m_init, l_init, op, opitch, lp, lpitch, obf);
    }
#endif
}

__device__ __forceinline__ void ph_combine(const Args& a, const Ctx& c, int layer) {
    const float* TMP = (const float*)(a.ws + WS_TMP); bf16_t* HB = (bf16_t*)(a.ws + WS_HB);
    { float* S2 = (float*)(a.ws + WS_SSQ) + 2 * CH_ROWS; for (int r = c.cu * NTHREADS + c.tid; r < CH_ROWS; r += c.G * NTHREADS) S2[r] = 0.f; }
    const int nitems = CH_ROWS * 32;
#pragma unroll 2
    for (int it = c.cu * NTHREADS + c.tid; it < nitems; it += c.G * NTHREADS) {
        const int r = it >> 5, h = (it >> 3) & 3, d8 = (it & 7) * 8;
        const bf16_t* tr = (const bf16_t*)TMP + (size_t)r * 768; const float* lr = TMP + 8 * 1024 * 1024 + (size_t)r * 16;
        const float l0 = lr[h], l1 = lr[4 + h], l2 = lr[8 + h];
        const u32x4 ua = *(const u32x4*)(tr + h * 64 + d8), ub = *(const u32x4*)(tr + (4 + h) * 64 + d8), uc = *(const u32x4*)(tr + (8 + h) * 64 + d8);
#define BF_LO(w) __builtin_bit_cast(float, (w) << 16)
#define BF_HI(w) __builtin_bit_cast(float, (w) & 0xffff0000u)
        const f32x4 a0 = (f32x4){BF_LO(ua.x), BF_HI(ua.x), BF_LO(ua.y), BF_HI(ua.y)}, a1 = (f32x4){BF_LO(ua.z), BF_HI(ua.z), BF_LO(ua.w), BF_HI(ua.w)};
        const f32x4 b0 = (f32x4){BF_LO(ub.x), BF_HI(ub.x), BF_LO(ub.y), BF_HI(ub.y)}, b1 = (f32x4){BF_LO(ub.z), BF_HI(ub.z), BF_LO(ub.w), BF_HI(ub.w)};
        const f32x4 c0 = (f32x4){BF_LO(uc.x), BF_HI(uc.x), BF_LO(uc.y), BF_HI(uc.y)}, c1 = (f32x4){BF_LO(uc.z), BF_HI(uc.z), BF_LO(uc.w), BF_HI(uc.w)};
#undef BF_LO
#undef BF_HI
        const float mx = fmaxf(l0, fmaxf(l1, l2));
        float w0 = __expf(l0 - mx), w1 = __expf(l1 - mx), w2 = __expf(l2 - mx);
        const float inv = 1.f / (w0 + w1 + w2); w0 *= inv; w1 *= inv; w2 *= inv;
        const f32x4 o0 = a0 * w0 + b0 * w1 + c0 * w2, o1 = a1 * w0 + b1 * w1 + c1 * w2;
        u32x4 o; o.x = pk2(o0.x, o0.y); o.y = pk2(o0.z, o0.w); o.z = pk2(o1.x, o1.y); o.w = pk2(o1.z, o1.w);
        *(u32x4*)(HB + (size_t)r * DM + 768 + h * 64 + d8) = o;
    }
}

__device__ __forceinline__ void ph_conv(const Args& a, const Ctx& c, int ch, int layer) {
    const int par = ch & 1;
    const bf16_t* UB = (const bf16_t*)(a.ws + WS_PROJ); bf16_t* GB = (bf16_t*)(a.ws + WS_TMP);
    const int SL = ch == 0 ? 16384 : 4096;
    const float* cw = a.in[13] + (size_t)layer * 3 * DUP; const float* cb = a.in[14] + (size_t)layer * DUP;
    constexpr int NCG = DFF / 8, RB = 16;
    const int nitems = (CH_ROWS / RB) * NCG;
    { float* S1 = (float*)(a.ws + WS_SSQ) + par * CH_ROWS; for (int r = c.cu * NTHREADS + c.tid; r < CH_ROWS; r += c.G * NTHREADS) S1[r] = 0.f; }
    for (int it = c.cu * NTHREADS + c.tid; it < nitems; it += c.G * NTHREADS) {
        const int cg8 = it % NCG, rb = it / NCG, c0 = cg8 * 8, r0 = rb * RB;
        f32x4 wg[3][2], wv[3][2], bg[2], bv[2];
#pragma unroll
        for (int k = 0; k < 3; ++k)
#pragma unroll
            for (int j = 0; j < 2; ++j) { wg[k][j] = *(const f32x4*)(cw + k * DUP + c0 + 4 * j); wv[k][j] = *(const f32x4*)(cw + k * DUP + DFF + c0 + 4 * j); }
#pragma unroll
        for (int j = 0; j < 2; ++j) { bg[j] = *(const f32x4*)(cb + c0 + 4 * j); bv[j] = *(const f32x4*)(cb + DFF + c0 + 4 * j); }
        const bool first = (r0 & (SL - 1)) == 0, last = ((r0 + RB) & (SL - 1)) == 0;
        const u32x4 zero = (u32x4){0u, 0u, 0u, 0u};
        const bf16_t* up = UB + (size_t)r0 * DUP + c0;
        u32x4 pg_ = first ? zero : *(const u32x4*)(up - DUP), pv_ = first ? zero : *(const u32x4*)(up - DUP + DFF);
        u32x4 cg_ = *(const u32x4*)(up), cv_ = *(const u32x4*)(up + DFF);
        bf16_t* gp = GB + (size_t)r0 * DFF + c0;
#pragma unroll 4
        for (int rr = 0; rr < RB; ++rr) {
            const bool nz = (rr == RB - 1) && last;
            const u32x4 ng_ = nz ? zero : *(const u32x4*)(up + (size_t)(rr + 1) * DUP), nv_ = nz ? zero : *(const u32x4*)(up + (size_t)(rr + 1) * DUP + DFF);
            unsigned ow[4];
#pragma unroll
            for (int w = 0; w < 4; ++w) {
                float res[2];
#pragma unroll
                for (int hh = 0; hh < 2; ++hh) {
                    const int j = 2 * w + hh, q = j >> 2, e = j & 3;
                    const float gpv = hh ? __builtin_bit_cast(float, pg_[w] & 0xffff0000u) : __builtin_bit_cast(float, pg_[w] << 16);
                    const float gcv = hh ? __builtin_bit_cast(float, cg_[w] & 0xffff0000u) : __builtin_bit_cast(float, cg_[w] << 16);
                    const float gnv = hh ? __builtin_bit_cast(float, ng_[w] & 0xffff0000u) : __builtin_bit_cast(float, ng_[w] << 16);
                    const float vpv = hh ? __builtin_bit_cast(float, pv_[w] & 0xffff0000u) : __builtin_bit_cast(float, pv_[w] << 16);
                    const float vcv = hh ? __builtin_bit_cast(float, cv_[w] & 0xffff0000u) : __builtin_bit_cast(float, cv_[w] << 16);
                    const float vnv = hh ? __builtin_bit_cast(float, nv_[w] & 0xffff0000u) : __builtin_bit_cast(float, nv_[w] << 16);
                    const float gate = gpv * wg[0][q][e] + gcv * wg[1][q][e] + gnv * wg[2][q][e] + bg[q][e];
                    const float val = vpv * wv[0][q][e] + vcv * wv[1][q][e] + vnv * wv[2][q][e] + bv[q][e];
                    res[hh] = gate * __builtin_amdgcn_rcpf(1.f + __builtin_amdgcn_exp2f(-LOG2E * gate)) * val;
                }
                ow[w] = pk2(res[0], res[1]);
            }
            *(u32x4*)(gp + (size_t)rr * DFF) = (u32x4){ow[0], ow[1], ow[2], ow[3]};
            pg_ = cg_; pv_ = cv_; cg_ = ng_; cv_ = nv_;
        }
    }
}

constexpr int STEPS_PER_CHUNK = DEPTH * 6;
constexpr int NSTEPS = 1 + NCHUNK * STEPS_PER_CHUNK + 1;
__global__ void __launch_bounds__(NTHREADS, 2) mega_fwd(Args a) {
    extern __shared__ __attribute__((aligned(16))) unsigned char lds_raw[];
    LAS unsigned char* lds = (LAS unsigned char*)lds_raw;
    cg::grid_group grid = cg::this_grid();
    volatile LAS unsigned* bst = (volatile LAS unsigned*)(lds + 147456);
    if (threadIdx.x < 2) bst[threadIdx.x] = 0u;
    __syncthreads();
    XcdBarrier xbar = xcd_barrier_post((unsigned*)(a.ws + WS_CTL), bst);
#ifdef PROBE_P2
    for (int pass_ = 0; pass_ < 2; ++pass_)
#endif
    for (int step = 0; step < NSTEPS; ++step) {
        int tid_l = threadIdx.x, cu_l = blockIdx.x, G_l = gridDim.x;
        asm volatile("" : "+v"(tid_l)); asm volatile("" : "+s"(cu_l), "+s"(G_l));
        Ctx c; c.tid = tid_l; c.lane = c.tid & 63; c.wave = __builtin_amdgcn_readfirstlane(c.tid >> 6);
        c.G = G_l; c.cu = cu_l; c.gw = c.cu * 8 + c.wave; c.NGW = c.G * 8;
        unsigned char* ws = a.ws;
        if (step == 0) {
            ph_weights(a, lds, 0, c.gw, c.NGW, c.wave, c.lane); ph_weights(a, lds, 1, c.gw, c.NGW, c.wave, c.lane);
            const float* xin = chunk_in(a, 0); bf16_t* XB = (bf16_t*)(ws + WS_XB); float* S1 = (float*)(ws + WS_SSQ);
            for (int r = c.gw; r < CH_ROWS; r += c.NGW) row_to_bf16_ssq(xin + (size_t)r * DM, XB + (size_t)r * DM, S1 + r, c.lane);
        } else if (step == NSTEPS - 1) ph_final_norm(c, chunk_out(a, NCHUNK - 1), a.in[16]);
        else {
            const int s = step - 1, ch = s / STEPS_PER_CHUNK, sc = s % STEPS_PER_CHUNK, par = ch & 1;
            bf16_t* HB = (bf16_t*)(ws + WS_HB); bf16_t* XB = (bf16_t*)(ws + WS_XB) + (size_t)par * CH_ROWS * DM;
            float* S1 = (float*)(ws + WS_SSQ) + par * CH_ROWS; float* S2 = (float*)(ws + WS_SSQ) + 2 * CH_ROWS;
            float* xo = chunk_out(a, ch);
            {
                const int layer = sc / 6, ph = sc % 6;
                const float* xsrc = layer == 0 ? chunk_in(a, ch) : (const float*)xo;
                if (ph == 0) {
                    pg8::Gemm g{XB, (const bf16_t*)(ws + WS_WIN) + (size_t)layer * DIN * DM, CH_ROWS, DIN, DM}; pg8::StaticOrder S; S.init(CH_ROWS, DIN, c.G, c.cu);
                    pg8::EpiBf16S2 E{(bf16_t*)(ws + WS_PROJ), DIN, 1805u, QSCALE, S1};
#ifdef PROBE_G2
                    for (int rep_ = 0; rep_ < 2; ++rep_)
#endif
                    pg8::gemm_phase<pg8::EpiBf16S2, pg8::StaticOrder, true, true>(lds, g, S, E);
                    if (layer == 0 && ch > 0) {
                        const int nfull = (CH_ROWS / 256) * (DIN / 256) % c.G;
                        if (nfull > 0 && c.cu >= nfull) { float* xp = chunk_out(a, ch - 1); const int nw = (c.G - nfull) * 8;
                            for (int r = (c.cu - nfull) * 8 + c.wave; r < CH_ROWS; r += nw) rms_row_f32(xp + (size_t)r * DM, a.in[16], c.lane); }
                        else if (nfull == 0) ph_final_norm(c, chunk_out(a, ch - 1), a.in[16]);
                    }
                } else if (ph == 1) {
                    ph_attn(a, c, lds, ch, layer);
                } else if (ph == 2) {
                    ph_combine(a, c, layer);
                } else if (ph == 3) {
                    pg8::Gemm g{HB, (const bf16_t*)(ws + WS_WOUT) + (size_t)layer * DM * DM, CH_ROWS, DM, DM}; pg8::StaticOrder S; S.init(CH_ROWS, DM, c.G, c.cu);
                    pg8::EpiRes2 E{xsrc, xo, XB, S2, DM};
#ifdef PROBE_GE2
                    { pg8::EpiRes2 E0{xsrc, (float*)(ws + WS_PROJ), (bf16_t*)(ws + WS_PROJ + 72 * MiB), (float*)(ws + WS_PROJ + 110 * MiB), DM}; pg8::gemm_phase<pg8::EpiRes2, pg8::StaticOrder, true, true>(lds, g, S, E0); }
#endif
                    pg8::gemm_phase<pg8::EpiRes2, pg8::StaticOrder, true, true>(lds, g, S, E);
                } else if (ph == 4) {
                    pg8::Gemm g{XB - DM, (const bf16_t*)(ws + WS_WUP) + (size_t)layer * DUP * DM, 65 * 256, DUP, DM, 254}; pg8::StaticOrder S; S.init(65 * 256, DUP, c.G, c.cu);
                    pg8::EpiConv E{(bf16_t*)(ws + WS_TMP), S2, a.in[13] + (size_t)layer * 3 * DUP, a.in[14] + (size_t)layer * DUP, (ch == 0 ? 16384 : 4096) - 1, (LAS float*)(lds + 147456 + 256), CH_ROWS};
                    pg8::gemm_phase<pg8::EpiConv, pg8::StaticOrder, true, true>(lds, g, S, E);
                    { float* S1z = S1; for (int r = c.cu * NTHREADS + c.tid; r < CH_ROWS; r += c.G * NTHREADS) S1z[r] = 0.f; }
                    if (layer == DEPTH - 1 && ch + 1 < NCHUNK) {
                        const float* xin = chunk_in(a, ch + 1); bf16_t* XBn = (bf16_t*)(ws + WS_XB) + (size_t)(par ^ 1) * CH_ROWS * DM; float* S1n = (float*)(ws + WS_SSQ) + (par ^ 1) * CH_ROWS;
                        for (int r = c.gw; r < CH_ROWS; r += c.NGW) row_to_bf16_ssq(xin + (size_t)r * DM, XBn + (size_t)r * DM, S1n + r, c.lane);
                    }
                } else {
                    pg8::Gemm g{(const bf16_t*)(ws + WS_TMP), (const bf16_t*)(ws + WS_WDN) + (size_t)layer * DM * DFF, CH_ROWS, DM, DFF}; pg8::StaticOrder S; S.init(CH_ROWS, DM, c.G, c.cu);
                    pg8::EpiRes2 E{xo, xo, layer == DEPTH - 1 ? (bf16_t*)nullptr : XB, S1, DM};
#ifdef PROBE_GE2
                    { pg8::EpiRes2 E0{xo, (float*)(ws + WS_PROJ), (bf16_t*)(ws + WS_PROJ + 72 * MiB), (float*)(ws + WS_PROJ + 110 * MiB), DM}; pg8::gemm_phase<pg8::EpiRes2, pg8::StaticOrder, true, true>(lds, g, S, E0); }
#endif
                    pg8::gemm_phase<pg8::EpiRes2, pg8::StaticOrder, true, true>(lds, g, S, E);
                }
            }
        }
#ifdef PROBE_P2
        if (step == 0) grid.sync(); else xcd_barrier(xbar);
#else
        if (step == 0) grid.sync(); else if (step != NSTEPS - 1) xcd_barrier(xbar);
#endif
    }
#ifdef PROBE_TA
    if (blockIdx.x == 0 && threadIdx.x < 64) {
        float* xo = chunk_out(a, NCHUNK - 1);
        const float ua = (float)tA_ * 0.01f, ub = (float)tB_ * 0.01f;
        if (threadIdx.x == 0) xo[0] += 8.f + ua * 0.01f; else xo[4 * threadIdx.x] += sqrtf(ub * 0.01f);
    }
#endif
}

extern "C" void kernel_launch(void* const* d_in, const int* in_sizes, int n_in, void* d_out, int out_size, void* d_ws, size_t ws_size, hipStream_t stream) {
    static int grid = 0;
    if (grid == 0) {
        if (n_in != 17 || ws_size < WS_END) { fprintf(stderr, "kernel_launch: unexpected n_in %d / ws_size %zu (need %zu)\n", n_in, ws_size, (size_t)WS_END); grid = -1; return; }
        int dev = 0, cus = 0, per_cu = 0;
        (void)hipGetDevice(&dev); (void)hipDeviceGetAttribute(&cus, hipDeviceAttributeMultiprocessorCount, dev);
        if (hipFuncSetAttribute((const void*)mega_fwd, hipFuncAttributeMaxDynamicSharedMemorySize, LDS_BYTES) != hipSuccess) { fprintf(stderr, "hipFuncSetAttribute failed\n"); grid = -1; return; }
        if (hipOccupancyMaxActiveBlocksPerMultiprocessor(&per_cu, (const void*)mega_fwd, NTHREADS, LDS_BYTES) != hipSuccess || per_cu < 1) { fprintf(stderr, "occupancy query: %d\n", per_cu); per_cu = 1; }
        (void)hipGetLastError();
        grid = cus * 1;
    }
    if (grid < 0) return;
    (void)hipMemsetAsync((char*)d_ws + WS_CTL, 0, 65536, stream);
    Args a{};
    for (int i = 0; i < 17; ++i) a.in[i] = (const float*)d_in[i];
    a.out = (float*)d_out; a.ws = (unsigned char*)d_ws;
    void* args[] = {&a};
    hipError_t e = hipLaunchCooperativeKernel((const void*)mega_fwd, dim3(grid), dim3(NTHREADS), args, LDS_BYTES, stream);
    if (e != hipSuccess) fprintf(stderr, "cooperative launch failed: %s (grid %d)\n", hipGetErrorString(e), grid);
}
```

```cpp
#include <hip/hip_runtime.h>
#include <hip/hip_cooperative_groups.h>
#include <cstdio>
#include <cstdint>
#include <cmath>
namespace cg = cooperative_groups;
namespace pg8 {
#define PG8_LAS __attribute__((address_space(3)))
typedef unsigned short bf16_t;
typedef short bf16x8 __attribute__((ext_vector_type(8)));
typedef float f32x4 __attribute__((ext_vector_type(4)));
typedef unsigned u32x4 __attribute__((ext_vector_type(4)));
constexpr int BM = 256, BK = 64, HALF = 128, HTB = HALF * BK * 2  , STAGE_BYTES = 8 * HTB, NXCD = 8, WGM = 8;

__host__ __device__ __forceinline__ int lds_byte(int r, int c) { const int st = (r >> 4) * 2 + (c >> 5), rr = r & 15, cc = c & 31, ob = rr * 64 + cc * 2; return st * 1024 + (ob ^ (((ob >> 9) & 1) << 5)); }
__host__ __device__ __forceinline__ void stage_rc(int b, int& R, int& C) { const int st = b / 1024, sb = b % 1024, swz = sb ^ (((sb >> 9) & 1) << 5); R = (st >> 1) * 16 + swz / 64; C = (st & 1) * 32 + (swz % 64) / 2; }
__host__ __device__ __forceinline__ int perm32(int rho) { const int n = rho >> 4, i = rho & 15; return 8 * (i >> 2) + 4 * n + (i & 3); }

struct Unit { int pm, pn; };
struct Gemm { const bf16_t* A; const bf16_t* Bt; int M, N, K; int a_rows = 256; };

struct StaticOrder {
    int nM, nN, nwg, G, c;
    __host__ __device__ void init(int M, int N, int G_, int c_) { nM = M / BM; nN = N / BM; nwg = nM * nN; G = G_; c = c_; }
    __host__ __device__ bool next(int i, Unit& u) const {
        const long L = (long)i * G + c; if (L >= nwg) return false;
        int wgid = (int)L; { const int q = nwg / NXCD, r = nwg % NXCD, xcd = wgid % NXCD, off = wgid / NXCD; wgid = (xcd < r ? xcd * (q + 1) : r * (q + 1) + (xcd - r) * q) + off; }
        const int nig = WGM * nN, gid = wgid / nig, fm = gid * WGM, gsz = (nM - fm) < WGM ? (nM - fm) : WGM;
        u.pm = fm + ((wgid % nig) % gsz); u.pn = (wgid % nig) / gsz; return true;
    }
    __device__ __forceinline__ void a_ready(const Unit&) const {}
    __device__ __forceinline__ void done(const Unit&) const {}
};

__device__ __forceinline__ unsigned cvt_pk_bf16(float lo, float hi) { unsigned r; asm volatile("v_cvt_pk_bf16_f32 %0, %1, %2" : "=v"(r) : "v"(lo), "v"(hi)); return r; }
struct EpiBf16S {
    static constexpr bool PERM = true, AFTER_DRAIN = false;
    bf16_t* O; int ldc; unsigned scalemask; float sc;
    __device__ __forceinline__ void operator()(const f32x4 (&acc)[2][2][4][2], const Unit& u, int wr, int wc, int fr, int fq) const {
        const int row0 = u.pm * BM + wr * 64 + fr; const int col0 = u.pn * BM + wc * 32 + 8 * fq;
        const float s = ((scalemask >> u.pn) & 1u) ? sc : 1.f;
#pragma unroll
        for (int ai = 0; ai < 2; ++ai)
#pragma unroll
            for (int m = 0; m < 4; ++m) { bf16_t* rowp = O + (size_t)(row0 + ai * HALF + m * 16) * ldc + col0;
#pragma unroll
                for (int bj = 0; bj < 2; ++bj) { f32x4 v0 = acc[ai][bj][m][0] * s, v1 = acc[ai][bj][m][1] * s;
                    u32x4 w; w.x = cvt_pk_bf16(v0[0], v0[1]); w.y = cvt_pk_bf16(v0[2], v0[3]); w.z = cvt_pk_bf16(v1[0], v1[1]); w.w = cvt_pk_bf16(v1[2], v1[3]);
                    *(u32x4*)(rowp + bj * HALF) = w; } }
    }
};
struct EpiRes {
    static constexpr bool PERM = false, AFTER_DRAIN = false;
    const float* base; float* out; int ldc;
    __device__ __forceinline__ void operator()(const f32x4 (&acc)[2][2][4][2], const Unit& u, int wr, int wc, int fr, int fq) const {
        const int col0 = u.pn * BM + wc * 32 + 4 * fq;
#pragma unroll
        for (int ai = 0; ai < 2; ++ai)
#pragma unroll
            for (int m = 0; m < 4; ++m) { const size_t off = (size_t)(u.pm * BM + ai * HALF + wr * 64 + m * 16 + fr) * ldc + col0;
#pragma unroll
                for (int bj = 0; bj < 2; ++bj)
#pragma unroll
                    for (int n = 0; n < 2; ++n) { const f32x4 bs = *(const f32x4*)(base + off + bj * HALF + n * 16); *(f32x4*)(out + off + bj * HALF + n * 16) = bs + acc[ai][bj][m][n]; }
                asm volatile("" ::: "memory"); }
    }
};

struct EpiBf16S2 {
    static constexpr bool PERM = true, AFTER_DRAIN = false;
    bf16_t* O; int ldc; unsigned scalemask; float sc; const float* ssq;
    __device__ __forceinline__ void operator()(const f32x4 (&acc)[2][2][4][2], const Unit& u, int wr, int wc, int fr, int fq) const {
        const int row0 = u.pm * BM + wr * 64 + fr; const int col0 = u.pn * BM + wc * 32 + 8 * fq;
        const float s = ((scalemask >> u.pn) & 1u) ? sc : 1.f;
#pragma unroll
        for (int ai = 0; ai < 2; ++ai)
#pragma unroll
            for (int m = 0; m < 4; ++m) { const int row = row0 + ai * HALF + m * 16; bf16_t* rowp = O + (size_t)row * ldc + col0;
                const float rs = s / sqrtf(ssq[row] * (1.f / 1024.f) + 1e-6f);
#pragma unroll
                for (int bj = 0; bj < 2; ++bj) { f32x4 v0 = acc[ai][bj][m][0] * rs, v1 = acc[ai][bj][m][1] * rs;
                    u32x4 w; w.x = cvt_pk_bf16(v0[0], v0[1]); w.y = cvt_pk_bf16(v0[2], v0[3]); w.z = cvt_pk_bf16(v1[0], v1[1]); w.w = cvt_pk_bf16(v1[2], v1[3]);
                    *(u32x4*)(rowp + bj * HALF) = w; } }
    }
};
typedef unsigned u32x2e __attribute__((ext_vector_type(2)));
struct EpiRes2 {
    static constexpr bool PERM = true, AFTER_DRAIN = false;
    const float* base_f32; const bf16_t* base_hi; const bf16_t* base_lo; float* out_f32; bf16_t* out_hi; bf16_t* out_lo; float* ssq; int ldc;
    static __device__ __forceinline__ float lo16(unsigned w) { return __builtin_bit_cast(float, w << 16); }
    static __device__ __forceinline__ float hi16(unsigned w) { return __builtin_bit_cast(float, w & 0xffff0000u); }
    __device__ __forceinline__ void operator()(const f32x4 (&acc)[2][2][4][2], const Unit& u, int wr, int wc, int fr, int fq) const {
        const int col0 = u.pn * BM + wc * 32 + 8 * fq;
#pragma unroll
        for (int ai = 0; ai < 2; ++ai)
#pragma unroll
            for (int m = 0; m < 4; ++m) { const int row = u.pm * BM + ai * HALF + wr * 64 + m * 16 + fr; const size_t off = (size_t)row * ldc + col0; float ps = 0.f;
#pragma unroll
                for (int bj = 0; bj < 2; ++bj) {
                    f32x4 b0, b1;
                    if (base_f32 != nullptr) { b0 = *(const f32x4*)(base_f32 + off + bj * HALF); b1 = *(const f32x4*)(base_f32 + off + bj * HALF + 4); }
                    else { const u32x4 h = *(const u32x4*)(base_hi + off + bj * HALF), l = *(const u32x4*)(base_lo + off + bj * HALF);
                        b0 = (f32x4){lo16(h.x) + lo16(l.x), hi16(h.x) + hi16(l.x), lo16(h.y) + lo16(l.y), hi16(h.y) + hi16(l.y)};
                        b1 = (f32x4){lo16(h.z) + lo16(l.z), hi16(h.z) + hi16(l.z), lo16(h.w) + lo16(l.w), hi16(h.w) + hi16(l.w)}; }
                    const f32x4 v0 = b0 + acc[ai][bj][m][0], v1 = b1 + acc[ai][bj][m][1];
                    if (out_f32 != nullptr) { *(f32x4*)(out_f32 + off + bj * HALF) = v0; *(f32x4*)(out_f32 + off + bj * HALF + 4) = v1; }
                    else {
                        ps += ((v0[0] * v0[0] + v0[1] * v0[1]) + (v0[2] * v0[2] + v0[3] * v0[3])) + ((v1[0] * v1[0] + v1[1] * v1[1]) + (v1[2] * v1[2] + v1[3] * v1[3]));
                        u32x4 h; h.x = cvt_pk_bf16(v0[0], v0[1]); h.y = cvt_pk_bf16(v0[2], v0[3]); h.z = cvt_pk_bf16(v1[0], v1[1]); h.w = cvt_pk_bf16(v1[2], v1[3]);
                        u32x4 l; l.x = cvt_pk_bf16(v0[0] - lo16(h.x), v0[1] - hi16(h.x)); l.y = cvt_pk_bf16(v0[2] - lo16(h.y), v0[3] - hi16(h.y));
                        l.z = cvt_pk_bf16(v1[0] - lo16(h.z), v1[1] - hi16(h.z)); l.w = cvt_pk_bf16(v1[2] - lo16(h.w), v1[3] - hi16(h.w));
                        *(u32x4*)(out_hi + off + bj * HALF) = h; *(u32x4*)(out_lo + off + bj * HALF) = l; } }
                if (out_f32 == nullptr) { ps += __shfl_xor(ps, 16); ps += __shfl_xor(ps, 32);
                    if (fq == 0) atomicAdd(ssq + row, ps); }
                asm volatile("" ::: "memory"); }
    }
};

struct EpiNull {
    static constexpr bool PERM = false, AFTER_DRAIN = false;
    __device__ __forceinline__ void operator()(const f32x4 (&acc)[2][2][4][2], const Unit& u, int wr, int wc, int fr, int fq) const {
#pragma unroll
        for (int ai = 0; ai < 2; ++ai)
#pragma unroll
            for (int bj = 0; bj < 2; ++bj)
#pragma unroll
                for (int m = 0; m < 4; ++m)
#pragma unroll
                    for (int n = 0; n < 2; ++n) asm volatile("" :: "v"(acc[ai][bj][m][n]));
    }
};

#define PG8_DPP(old, src, ctrl) __builtin_bit_cast(float, __builtin_amdgcn_update_dpp(__builtin_bit_cast(int, (float)(old)), __builtin_bit_cast(int, (float)(src)), (ctrl), 0xF, 0xF, false))
struct EpiConv {
    static constexpr bool PERM = true, AFTER_DRAIN = false;
    bf16_t* G; const float* ssq; const float* cw; const float* cb; int slmask; PG8_LAS float* xch; int nrows;
    __device__ __forceinline__ void operator()(f32x4 (&acc)[2][2][4][2], const Unit& u, int wr, int wc, int fr, int fq) const {
        const int t0 = 254 * u.pm - 1 + wr * 64 + fr;
#pragma unroll
        for (int ai = 0; ai < 2; ++ai)
#pragma unroll
            for (int m = 0; m < 4; ++m) { int t = t0 + ai * HALF + m * 16; t = t < 0 ? 0 : (t > nrows - 1 ? nrows - 1 : t);
                const float rs = 1.f / sqrtf(ssq[t] * (1.f / 1024.f) + 1e-6f);
#pragma unroll
                for (int bj = 0; bj < 2; ++bj)
#pragma unroll
                    for (int n = 0; n < 2; ++n) acc[ai][bj][m][n] *= rs; }
        if (fr == 0 || fr == 15) { const int which = fr == 0 ? 0 : 1, m = fr == 0 ? 0 : 3;
#pragma unroll
            for (int ai = 0; ai < 2; ++ai) { PG8_LAS float* d = xch + ((((2 * ai + wr) * 2 + which) * 4 + wc) * 4 + fq) * 16;
#pragma unroll
                for (int bj = 0; bj < 2; ++bj)
#pragma unroll
                    for (int n = 0; n < 2; ++n) *(PG8_LAS f32x4*)(d + bj * 8 + n * 4) = fr == 0 ? acc[ai][bj][0][n] : acc[ai][bj][3][n]; }
            (void)m; }
        asm volatile("s_waitcnt lgkmcnt(0)" ::: "memory"); __builtin_amdgcn_s_barrier(); asm volatile("" ::: "memory");
        const int ch0 = u.pn * 128 + wc * 32 + 8 * fq;
#pragma unroll
        for (int n = 0; n < 2; ++n) {
            const int chn = ch0 + 4 * n;
            const f32x4 wg0 = *(const f32x4*)(cw + chn), wg1 = *(const f32x4*)(cw + 5632 + chn), wg2 = *(const f32x4*)(cw + 2 * 5632 + chn), bgv = *(const f32x4*)(cb + chn);
            const f32x4 wv0 = *(const f32x4*)(cw + 2816 + chn), wv1 = *(const f32x4*)(cw + 5632 + 2816 + chn), wv2 = *(const f32x4*)(cw + 2 * 5632 + 2816 + chn), bvv = *(const f32x4*)(cb + 2816 + chn);
#pragma unroll
            for (int ai = 0; ai < 2; ++ai)
#pragma unroll
                for (int m = 0; m < 4; ++m) {
                    const int lr = ai * HALF + wr * 64 + m * 16 + fr, t = 254 * u.pm - 1 + lr;
                    const int gidx = 2 * ai + wr;
                    f32x4 pv[2], nx[2];
#pragma unroll
                    for (int bj = 0; bj < 2; ++bj) {
                        f32x4 upo, dno;
                        if (m > 0) { const f32x4 s = acc[ai][bj][m - 1][n];
#pragma unroll
                            for (int j = 0; j < 4; ++j) upo[j] = PG8_DPP(0.f, s[j], 0x121); }
                        else upo = gidx > 0 ? *(const PG8_LAS f32x4*)(xch + ((((gidx - 1) * 2 + 1) * 4 + wc) * 4 + fq) * 16 + bj * 8 + n * 4) : (f32x4){0.f, 0.f, 0.f, 0.f};
                        if (m < 3) { const f32x4 s = acc[ai][bj][m + 1][n];
#pragma unroll
                            for (int j = 0; j < 4; ++j) dno[j] = PG8_DPP(0.f, s[j], 0x12F); }
                        else dno = gidx < 3 ? *(const PG8_LAS f32x4*)(xch + ((((gidx + 1) * 2 + 0) * 4 + wc) * 4 + fq) * 16 + bj * 8 + n * 4) : (f32x4){0.f, 0.f, 0.f, 0.f};
                        const f32x4 cur = acc[ai][bj][m][n];
#pragma unroll
                        for (int j = 0; j < 4; ++j) { pv[bj][j] = PG8_DPP(upo[j], cur[j], 0x111);
                                                       nx[bj][j] = PG8_DPP(dno[j], cur[j], 0x101); }
                    }
                    const bool sfirst = (t & slmask) == 0, slast = (t & slmask) == slmask;
                    float res[4];
#pragma unroll
                    for (int j = 0; j < 4; ++j) {
                        const float gp = sfirst ? 0.f : pv[0][j], gn = slast ? 0.f : nx[0][j], vp = sfirst ? 0.f : pv[1][j], vn = slast ? 0.f : nx[1][j];
                        const float gate = gp * wg0[j] + acc[ai][0][m][n][j] * wg1[j] + gn * wg2[j] + bgv[j];
                        const float val = vp * wv0[j] + acc[ai][1][m][n][j] * wv1[j] + vn * wv2[j] + bvv[j];
                        res[j] = gate * __builtin_amdgcn_rcpf(1.f + __builtin_amdgcn_exp2f(-1.4426950408889634f * gate)) * val;
                    }
                    if (lr >= 1 && lr <= 254 && t < nrows) { u32x2e w; w.x = cvt_pk_bf16(res[0], res[1]); w.y = cvt_pk_bf16(res[2], res[3]); *(u32x2e*)(G + (size_t)t * 2816 + chn) = w; }
                }
        }
    }
};
template <class Epi, class Sched, bool ALIGN_EPI = false, bool SP2 = false>
__device__ __forceinline__ void gemm_phase(PG8_LAS unsigned char* lds, const Gemm g, const Sched& S, const Epi& E) {
    int tid_l = threadIdx.x; asm volatile("" : "+v"(tid_l)); const int tid = tid_l, wid = __builtin_amdgcn_readfirstlane(tid >> 6), lane = tid & 63, wr = wid >> 2, wc = wid & 3, fr = lane & 15, fq = lane >> 4;
    const int K = g.K, nt = K / BK;
    unsigned voffA[2], voffB[2];
#pragma unroll
    for (int i = 0; i < 2; ++i) { int R, C; stage_rc(tid * 16 + i * 8192, R, C); const int Rb = Epi::PERM ? ((R & ~31) + perm32(R & 31)) : R;
        voffA[i] = (unsigned)(R * K + C) * 2u; voffB[i] = (unsigned)(Rb * K + C) * 2u; }
    const size_t kstep = (size_t)(BK * 2);
    const size_t hstep = (size_t)HALF * K * 2;
    const size_t tstep = 2 * hstep; const size_t tstepA = (size_t)g.a_rows * K * 2;
    const unsigned ldsw = (unsigned)wid * 1024u;
    const int aoff = lds_byte(wr * 64 + fr, fq * 8), boff = lds_byte(wc * 32 + fr, fq * 8);
#define PG8_SA(b, h) (((b) * 2 + (h)) * HTB)
#define PG8_SB(b, h) ((4 + (b) * 2 + (h)) * HTB)
#define PG8_STAGE(bufoff, gbase, voff) do { _Pragma("unroll") for (int _i = 0; _i < 2; ++_i) \
        __builtin_amdgcn_global_load_lds((const unsigned*)((const char*)(gbase) + (voff)[_i]), (PG8_LAS unsigned*)(lds + (bufoff) + ldsw + _i * 8192), 16, 0, 0); } while (0)
#define PG8_LDA(dst, b, h) do { _Pragma("unroll") for (int m = 0; m < 4; ++m) _Pragma("unroll") for (int k = 0; k < 2; ++k) dst[m][k] = *(const PG8_LAS bf16x8*)(lds + PG8_SA(b, h) + aoff + m * 2048 + k * 1024); } while (0)
#define PG8_LDB(dst, b, h) do { _Pragma("unroll") for (int n = 0; n < 2; ++n) _Pragma("unroll") for (int k = 0; k < 2; ++k) dst[n][k] = *(const PG8_LAS bf16x8*)(lds + PG8_SB(b, h) + boff + n * 2048 + k * 1024); } while (0)
#define PG8_MMA(ai, bj, At, Bt) do { __builtin_amdgcn_s_setprio(1); _Pragma("unroll") for (int m = 0; m < 4; ++m) _Pragma("unroll") for (int n = 0; n < 2; ++n) _Pragma("unroll") for (int k = 0; k < 2; ++k) \
        acc[ai][bj][m][n] = __builtin_amdgcn_mfma_f32_16x16x32_bf16(Bt[n][k], At[m][k], acc[ai][bj][m][n], 0, 0, 0); __builtin_amdgcn_s_setprio(0); } while (0)
#define PG8_WAIT_V(n) asm volatile("s_waitcnt vmcnt(" #n ")" ::: "memory")
#define PG8_WAIT_L(n) asm volatile("s_waitcnt lgkmcnt(" #n ")" ::: "memory")
#define PG8_BAR __builtin_amdgcn_s_barrier()
#define PG8_SCHED __builtin_amdgcn_sched_barrier(0)
    Unit cur, nxt; int ui = 0;
    if (!S.next(0, cur)) return;
    f32x4 acc[2][2][4][2];
#pragma unroll
    for (int a = 0; a < 2; ++a)
#pragma unroll
        for (int b = 0; b < 2; ++b)
#pragma unroll
            for (int m = 0; m < 4; ++m)
#pragma unroll
                for (int n = 0; n < 2; ++n) acc[a][b][m][n] = (f32x4){0.f, 0.f, 0.f, 0.f};
    bf16x8 At[4][2], B0[2][2], B1[2][2];
    const char* cA = (const char*)g.A + (size_t)cur.pm * tstepA; const char* cB = (const char*)g.Bt + (size_t)cur.pn * tstep;
    S.a_ready(cur);
    if constexpr (SP2) {
        PG8_STAGE(PG8_SB(0, 0), cB, voffB); PG8_STAGE(PG8_SB(0, 1), cB + hstep, voffB); PG8_STAGE(PG8_SA(0, 0), cA, voffA); PG8_STAGE(PG8_SA(0, 1), cA + hstep, voffA);
        if (wr == 1) PG8_BAR;
        PG8_WAIT_V(2); PG8_BAR;
        PG8_STAGE(PG8_SB(1, 0), cB + kstep, voffB); PG8_STAGE(PG8_SA(1, 0), cA + kstep, voffA); PG8_STAGE(PG8_SB(1, 1), cB + hstep + kstep, voffB);
        PG8_WAIT_V(6); PG8_BAR;
    } else {
        PG8_STAGE(PG8_SB(0, 0), cB, voffB); PG8_STAGE(PG8_SA(0, 0), cA, voffA); PG8_STAGE(PG8_SB(0, 1), cB + hstep, voffB); PG8_STAGE(PG8_SA(0, 1), cA + hstep, voffA);
        if (wr == 1) PG8_BAR;
        PG8_WAIT_V(4); PG8_BAR;
        PG8_STAGE(PG8_SB(1, 0), cB + kstep, voffB); PG8_STAGE(PG8_SA(1, 0), cA + kstep, voffA); PG8_STAGE(PG8_SB(1, 1), cB + hstep + kstep, voffB);
        PG8_WAIT_V(6); PG8_BAR;
    }
    for (;;) {
        const bool has_next = S.next(ui + 1, nxt);
        const char* nA = has_next ? (const char*)g.A + (size_t)nxt.pm * tstepA : cA; const char* nB = has_next ? (const char*)g.Bt + (size_t)nxt.pn * tstep : cB;
        for (int t = 0; t < nt; t += 2) {
            const bool last = (t == nt - 2);
            const char* a1 = cA + (size_t)(t + 1) * kstep;
            const char* a2 = last ? nA : cA + (size_t)(t + 2) * kstep; const char* b2 = last ? nB : cB + (size_t)(t + 2) * kstep;
            const char* a3 = a2 + kstep; const char* b3 = b2 + kstep;
            if (last && has_next) S.a_ready(nxt);
            if constexpr (SP2) {
            PG8_LDB(B0, 0, 0); PG8_LDB(B1, 0, 1); PG8_SCHED; PG8_LDA(At, 0, 0); PG8_STAGE(PG8_SA(1, 1), a1 + hstep, voffA);
            PG8_WAIT_V(8); PG8_WAIT_L(0); PG8_BAR; PG8_MMA(0, 0, At, B0); PG8_MMA(0, 1, At, B1); PG8_BAR; PG8_SCHED;
            PG8_LDA(At, 0, 1); PG8_STAGE(PG8_SB(0, 0), b2, voffB); PG8_STAGE(PG8_SB(0, 1), b2 + hstep, voffB); PG8_STAGE(PG8_SA(0, 0), a2, voffA);
            PG8_WAIT_V(8); PG8_WAIT_L(0); PG8_BAR; PG8_MMA(1, 0, At, B0); PG8_MMA(1, 1, At, B1); PG8_BAR; PG8_SCHED;
            PG8_LDB(B0, 1, 0); PG8_LDB(B1, 1, 1); PG8_SCHED; PG8_LDA(At, 1, 0); PG8_STAGE(PG8_SA(0, 1), a2 + hstep, voffA);
            PG8_WAIT_V(8); PG8_WAIT_L(0); PG8_BAR; PG8_MMA(0, 0, At, B0); PG8_MMA(0, 1, At, B1); PG8_BAR; PG8_SCHED;
            PG8_LDA(At, 1, 1); PG8_STAGE(PG8_SB(1, 0), b3, voffB); PG8_STAGE(PG8_SB(1, 1), b3 + hstep, voffB); PG8_STAGE(PG8_SA(1, 0), a3, voffA);
            PG8_WAIT_V(8); PG8_WAIT_L(0); PG8_BAR; PG8_MMA(1, 0, At, B0); PG8_MMA(1, 1, At, B1); PG8_BAR; PG8_SCHED;
            } else {
            PG8_LDB(B0, 0, 0); PG8_SCHED; PG8_LDA(At, 0, 0); PG8_STAGE(PG8_SA(1, 1), a1 + hstep, voffA);
            PG8_WAIT_L(8); PG8_BAR; PG8_WAIT_L(0); PG8_MMA(0, 0, At, B0); PG8_BAR; PG8_SCHED;
            PG8_LDB(B1, 0, 1); PG8_STAGE(PG8_SB(0, 0), b2, voffB);
            PG8_BAR; PG8_WAIT_L(0); PG8_MMA(0, 1, At, B1); PG8_BAR;
            PG8_LDA(At, 0, 1); PG8_STAGE(PG8_SA(0, 0), a2, voffA);
            PG8_BAR; PG8_WAIT_L(0); PG8_MMA(1, 0, At, B0); PG8_BAR; PG8_SCHED;
            PG8_STAGE(PG8_SB(0, 1), b2 + hstep, voffB);
            PG8_WAIT_V(6); PG8_BAR; PG8_MMA(1, 1, At, B1); PG8_BAR;
            PG8_LDB(B0, 1, 0); PG8_SCHED; PG8_LDA(At, 1, 0); PG8_STAGE(PG8_SA(0, 1), a2 + hstep, voffA);
            PG8_WAIT_L(8); PG8_BAR; PG8_WAIT_L(0); PG8_MMA(0, 0, At, B0); PG8_BAR; PG8_SCHED;
            PG8_LDB(B1, 1, 1); PG8_STAGE(PG8_SB(1, 0), b3, voffB);
            PG8_BAR; PG8_WAIT_L(0); PG8_MMA(0, 1, At, B1); PG8_BAR;
            PG8_LDA(At, 1, 1); PG8_STAGE(PG8_SA(1, 0), a3, voffA);
            PG8_BAR; PG8_WAIT_L(0); PG8_MMA(1, 0, At, B0); PG8_BAR; PG8_SCHED;
            PG8_STAGE(PG8_SB(1, 1), b3 + hstep, voffB);
            PG8_WAIT_V(6); PG8_BAR; PG8_MMA(1, 1, At, B1); PG8_BAR;
            }
        }
        if constexpr (ALIGN_EPI) { if (wr == 0) PG8_BAR; }
        if constexpr (!Epi::AFTER_DRAIN) { E(acc, cur, wr, wc, fr, fq); S.done(cur); }
        if (!has_next) break;
#pragma unroll
        for (int a = 0; a < 2; ++a)
#pragma unroll
            for (int b = 0; b < 2; ++b)
#pragma unroll
                for (int m = 0; m < 4; ++m)
#pragma unroll
                    for (int n = 0; n < 2; ++n) acc[a][b][m][n] = (f32x4){0.f, 0.f, 0.f, 0.f};
        cur = nxt; cA = nA; cB = nB; ++ui;
        if constexpr (ALIGN_EPI) { if (wr == 1) PG8_BAR; }
    }
    PG8_WAIT_V(0);
    if constexpr (!ALIGN_EPI) { if (wr == 0) PG8_BAR; }
    PG8_BAR;
    if constexpr (Epi::AFTER_DRAIN) { E.fused(acc, cur, wr, wc, fr, fq, lds, wid, lane); S.done(cur); }
#undef PG8_SA
#undef PG8_SB
#undef PG8_STAGE
#undef PG8_LDA
#undef PG8_LDB
#undef PG8_MMA
#undef PG8_WAIT_V
#undef PG8_WAIT_L
#undef PG8_BAR
#undef PG8_SCHED
}
}
typedef __bf16 bf16x2_t __attribute__((ext_vector_type(2)));
__device__ __forceinline__ unsigned cvt_pk(float lo, float hi) { float __attribute__((ext_vector_type(2))) v = {lo, hi}; bf16x2_t b = __builtin_convertvector(v, bf16x2_t); return __builtin_bit_cast(unsigned, b); }
#define LAS __attribute__((address_space(3)))
#define XB_TMO      128
#define XB_XCNT(j)  (256  + 64 * (j))
#define XB_XSUB(j)  (1280 + 64 * (j))
#define XB_XGEN(j)  (2304 + 64 * (j))
#define XB_TOP      3328
#define XB_TOPGEN   3392
#define XCD_BAR_WORDS 3456
#define XB_SPIN_CAP (1u << 18)

__device__ __forceinline__ unsigned xb_ld(unsigned* p)              { return __hip_atomic_load(p, __ATOMIC_RELAXED, __HIP_MEMORY_SCOPE_AGENT); }
__device__ __forceinline__ unsigned xb_add(unsigned* p, unsigned v) { return __hip_atomic_fetch_add(p, v, __ATOMIC_RELAXED, __HIP_MEMORY_SCOPE_AGENT); }
__device__ __forceinline__ unsigned xb_xcc_id() { return (unsigned)__builtin_amdgcn_s_getreg((3 << 11) | 20) & 0xFu; }
#define XB_SPIN(cond, bar) do { unsigned _sp = 0; while (cond) { __builtin_amdgcn_s_sleep(1); \
    if ((++_sp & 255u) == 0u) { if (xb_ld(&(bar)[XB_TMO])) break; if (_sp > XB_SPIN_CAP) { atomicAdd(&(bar)[XB_TMO], 1u); break; } } } } while (0)

struct XcdBarrier {
    unsigned* bar; unsigned x;
    volatile LAS unsigned* st;
};

__device__ __forceinline__ XcdBarrier xcd_barrier_post(unsigned* bar, volatile LAS unsigned* st) {
    XcdBarrier b; b.bar = bar; b.x = xb_xcc_id(); b.st = st;
    if (threadIdx.x == 0) (void)xb_add(&bar[XB_XCNT(b.x)], 1u);
    return b;
}
__device__ __forceinline__ void xcd_barrier_complete(unsigned* bar, unsigned x, unsigned& nloc, unsigned& nx) {
    const unsigned G = gridDim.x * gridDim.y * gridDim.z;
    unsigned sum, cnt, mine, sp = 0u;
    for (;;) {
        sum = 0u; cnt = 0u; mine = 0u;
#pragma unroll
        for (unsigned j = 0; j < 16; ++j) { const unsigned c = xb_ld(&bar[XB_XCNT(j)]); sum += c; cnt += (c > 0u) ? 1u : 0u; mine = (j == x) ? c : mine; }
        if (sum == G) break;
        __builtin_amdgcn_s_sleep(1);
        if ((++sp & 255u) == 0u) { if (xb_ld(&bar[XB_TMO])) break; if (sp > XB_SPIN_CAP) { atomicAdd(&bar[XB_TMO], 1u); break; } }
    }
    nloc = mine > 0u ? mine : 1u; nx = cnt > 0u ? cnt : 1u;
}

__device__ __forceinline__ void xcd_barrier(const XcdBarrier& b) {
    asm volatile("s_waitcnt vmcnt(0)" ::: "memory");
    __syncthreads();
    if (threadIdx.x == 0) {
        unsigned* bar = b.bar;
        __builtin_amdgcn_s_waitcnt(0);
        unsigned nloc = b.st[0], nx = b.st[1];
        if (nloc == 0u) { xcd_barrier_complete(bar, b.x, nloc, nx); b.st[0] = nloc; b.st[1] = nx; }
        const unsigned old = xb_add(&bar[XB_XSUB(b.x)], 1u);
        const unsigned gen = old / nloc;
        if (old + 1u == (gen + 1u) * nloc) {
            __builtin_amdgcn_fence(__ATOMIC_RELEASE, "agent");
            asm volatile("s_waitcnt vmcnt(0)" ::: "memory");
            const unsigned og = xb_add(&bar[XB_TOP], 1u);
            const unsigned tg = og / nx;
            if (og + 1u == (tg + 1u) * nx) xb_add(&bar[XB_TOPGEN], 1u);
            else XB_SPIN(xb_ld(&bar[XB_TOPGEN]) == tg, bar);
            __builtin_amdgcn_fence(__ATOMIC_ACQUIRE, "agent");
            xb_add(&bar[XB_XGEN(b.x)], 1u);
            asm volatile("s_waitcnt vmcnt(0)" ::: "memory");
        } else {
            XB_SPIN(xb_ld(&bar[XB_XGEN(b.x)]) == gen, bar);
            __builtin_amdgcn_fence(__ATOMIC_ACQUIRE, "agent");
            asm volatile("s_waitcnt vmcnt(0)" ::: "memory");
        }
    }
    __syncthreads();
}
typedef unsigned short bf16_t;
typedef short bf16x8 __attribute__((ext_vector_type(8)));
typedef short s16x4 __attribute__((ext_vector_type(4)));
typedef float f32x16 __attribute__((ext_vector_type(16)));
typedef float f32x4 __attribute__((ext_vector_type(4)));
typedef float f32x2 __attribute__((ext_vector_type(2)));
typedef unsigned u32x4 __attribute__((ext_vector_type(4)));
typedef unsigned u32x2 __attribute__((ext_vector_type(2)));

constexpr int DM = 1024, DIN = 4352, DFF = 2816, DUP = 2 * DFF, DEPTH = 2;
constexpr int CH_ROWS = 16384, NCHUNK = 3;
constexpr int TW = 784;
constexpr int T_C = 0, T_L = 768;
constexpr float LOG2E = 1.4426950408889634f, LN2 = 0.6931471805599453f;
constexpr float QSCALE = 0.125f * LOG2E;
constexpr size_t MiB = 1u << 20;
constexpr size_t WS_WIN = 0, WS_WOUT = 18 * MiB, WS_WUP = 22 * MiB, WS_WDN = 44 * MiB, WS_HB = 56 * MiB, WS_PROJ = 88 * MiB, WS_TMP = 264 * MiB, WS_CTL = 394 * MiB, WS_XB = 395 * MiB, WS_SSQ = 459 * MiB, WS_END = 460 * MiB;
constexpr int LDS_BYTES = 147456 + 256 + 8192;
constexpr int NTHREADS = 512;

struct Args { const float* in[17]; float* out; unsigned char* ws; };

__device__ __forceinline__ float wave_sum(float v) {
#pragma unroll
    for (int o = 1; o < 64; o <<= 1) v += __shfl_xor(v, o);
    return v;
}
__device__ __forceinline__ unsigned f2bf(float f) { unsigned u = __builtin_bit_cast(unsigned, f); return (u + 0x7fffu + ((u >> 16) & 1u)) >> 16; }
__device__ __forceinline__ unsigned pk2(float lo, float hi) { return f2bf(lo) | (f2bf(hi) << 16); }
__device__ __forceinline__ float bf2f(unsigned short b) { return __builtin_bit_cast(float, (unsigned)b << 16); }

__device__ __forceinline__ void transpose_item(const float* W, int K, int N, bf16_t* WT, LAS float* scr, int item, int lane, const float* gain, bool gate_perm = false) {
    const int nblk = N / 32, kb = item / nblk, nb = item % nblk, k0 = 64 * kb, n0 = 32 * nb;
#pragma unroll 32
    for (int i = 0; i < 32; ++i) { const int kk = 2 * i + (lane >> 5); scr[kk * 33 + (lane & 31)] = W[(size_t)(k0 + kk) * N + n0 + (lane & 31)] * (gain ? gain[k0 + kk] : 1.f); }
    asm volatile("s_waitcnt lgkmcnt(0)" ::: "memory");
    const int c = lane & 7;
    const int half_ = N / 2, v_ = n0 >= half_ ? n0 - half_ : n0, d0 = gate_perm ? 256 * (v_ / 128) + (n0 >= half_ ? 128 : 0) + (v_ % 128) : n0;
#pragma unroll
    for (int j = 0; j < 4; ++j) { const int n = (lane >> 3) + 8 * j; const LAS float* s = scr + (8 * c) * 33 + n;
        u32x4 o; o.x = pk2(s[0 * 33], s[1 * 33]); o.y = pk2(s[2 * 33], s[3 * 33]); o.z = pk2(s[4 * 33], s[5 * 33]); o.w = pk2(s[6 * 33], s[7 * 33]);
        *(u32x4*)(WT + (size_t)(d0 + n) * K + k0 + 8 * c) = o; }
    asm volatile("s_waitcnt lgkmcnt(0)" ::: "memory");
}

__device__ __forceinline__ void rms_row_to_bf16(const float* xrow, const float* gain, bf16_t* orow, int lane) {
    const f32x4* xr = (const f32x4*)xrow + lane; const f32x4* gr = (const f32x4*)gain + lane;
    f32x4 v[4]; float s = 0.f;
#pragma unroll
    for (int j = 0; j < 4; ++j) { v[j] = xr[64 * j]; s += (v[j].x * v[j].x + v[j].y * v[j].y) + (v[j].z * v[j].z + v[j].w * v[j].w); }
    const float rstd = 1.f / sqrtf(wave_sum(s) * (1.f / DM) + 1e-6f);
    u32x2* o8 = (u32x2*)orow + lane;
#pragma unroll
    for (int j = 0; j < 4; ++j) { const f32x4 g = gr[64 * j]; u32x2 w; w.x = pk2(v[j].x * rstd * g.x, v[j].y * rstd * g.y); w.y = pk2(v[j].z * rstd * g.z, v[j].w * rstd * g.w); o8[64 * j] = w; }
}
__device__ __forceinline__ void rms_row_f32(float* xrow, const float* gain, int lane) {
    f32x4* xr = (f32x4*)xrow + lane; const f32x4* gr = (const f32x4*)gain + lane;
    f32x4 v[4]; float s = 0.f;
#pragma unroll
    for (int j = 0; j < 4; ++j) { v[j] = xr[64 * j]; s += (v[j].x * v[j].x + v[j].y * v[j].y) + (v[j].z * v[j].z + v[j].w * v[j].w); }
    const float rstd = 1.f / sqrtf(wave_sum(s) * (1.f / DM) + 1e-6f);
#pragma unroll
    for (int j = 0; j < 4; ++j) { const f32x4 g = gr[64 * j]; xr[64 * j] = v[j] * rstd * g; }
}

constexpr int KSTR = 144;
constexpr int ATT_K_OFF = 0, ATT_V_OFF = 2 * 64 * KSTR, ATT_SCR_OFF = ATT_V_OFF + 2 * 64 * 320;
__device__ __forceinline__ int crow(int r, int hi) { return (r & 3) + 8 * (r >> 2) + 4 * hi; }
typedef short v4i16_t __attribute__((ext_vector_type(4)));
__device__ __forceinline__ s16x4 vtr(const LAS unsigned char* p) { return __builtin_bit_cast(s16x4, __builtin_amdgcn_ds_read_tr16_b64_v4i16((LAS v4i16_t*)p)); }

template <int VD, bool WIN>
__device__ __forceinline__ void attn_unit(LAS unsigned char* lds, const bf16_t* Qp, const bf16_t* Kp, const bf16_t* Vp, size_t pitch,
                                          int q0, int L, float slope2, int W, float m_init, float l_init,
                                          float* Oout, size_t opitch, float* lse_out, size_t lpitch, bf16_t* Obf) {
    constexpr int VSTR = VD * 2 + 64, ND = VD / 32, VCH = VD / 8, VLD = 64 * VCH / NTHREADS;
    int tid_l = threadIdx.x; asm volatile("" : "+v"(tid_l)); const int tid = tid_l, lane = tid & 63, r32 = lane & 31, hi = lane >> 5, wid = __builtin_amdgcn_readfirstlane(tid >> 6);
    const int qw = q0 + wid * 32;
    int tlo = 0, thi = L / 64;
    if (WIN) { const int a = q0 - W; tlo = a > 0 ? a / 64 : 0; const int b = q0 + 256 + W; thi = (b < L ? b : L) / 64; }
    bf16x8 qr[4];
    { const bf16_t* qrow = Qp + (size_t)(qw + r32) * pitch + hi * 8;
#pragma unroll
      for (int d0 = 0; d0 < 4; ++d0) qr[d0] = *(const bf16x8*)(qrow + d0 * 16); }
    f32x16 o[ND];
#pragma unroll
    for (int d = 0; d < ND; ++d)
#pragma unroll
        for (int r = 0; r < 16; ++r) o[d][r] = 0.f;
    float m = m_init, l = hi == 0 ? l_init : 0.f;
    LAS float* wsf = (LAS float*)(lds + 6 * (64 * KSTR + 64 * (VD * 2 + 64))) + wid * 64;
    static_assert(VD == 64, "grouped staging is sized for 64-wide values");
    constexpr int SLOT = 64 * KSTR + 64 * VSTR, GRP = 6;
    const int krow = tid >> 3, kch = tid & 7;
    const float Wf = (float)W;
    for (int g0 = tlo; g0 < thi; g0 += GRP) {
        const int ng = thi - g0 < GRP ? thi - g0 : GRP;
        u32x4 kr[GRP], vr[GRP];
#pragma unroll
        for (int j = 0; j < GRP; ++j) if (j < ng) { kr[j] = *(const u32x4*)(Kp + (size_t)(64 * (g0 + j) + krow) * pitch + kch * 8); vr[j] = *(const u32x4*)(Vp + (size_t)(64 * (g0 + j) + krow) * pitch + kch * 8); }
        if (g0 != tlo) __syncthreads();
#pragma unroll
        for (int j = 0; j < GRP; ++j) if (j < ng) { *(LAS u32x4*)(lds + j * SLOT + krow * KSTR + kch * 16) = kr[j]; *(LAS u32x4*)(lds + j * SLOT + 64 * KSTR + krow * VSTR + kch * 16) = vr[j]; }
        __syncthreads();
      for (int j = 0; j < ng; ++j) {
        const int t = g0 + j;
        bool active = true;
        if (WIN) { const int kb = 64 * t; active = (kb + 63 >= qw - W) && (kb <= qw + 31 + W); }
        if (active) {
            const LAS unsigned char* Kb = lds + j * SLOT + r32 * KSTR + hi * 16;
            f32x16 p0, p1;
#pragma unroll
            for (int r = 0; r < 16; ++r) { p0[r] = 0.f; p1[r] = 0.f; }
#pragma unroll
            for (int d0 = 0; d0 < 4; ++d0) {
                const bf16x8 a0 = *(const LAS bf16x8*)(Kb + d0 * 32), a1 = *(const LAS bf16x8*)(Kb + 32 * KSTR + d0 * 32);
                p0 = __builtin_amdgcn_mfma_f32_32x32x16_bf16(a0, qr[d0], p0, 0, 0, 0);
                p1 = __builtin_amdgcn_mfma_f32_32x32x16_bf16(a1, qr[d0], p1, 0, 0, 0);
                if (d0 & 1) __builtin_amdgcn_sched_barrier(0);
            }
            const float dq = (float)(64 * t + 4 * hi - (qw + r32));
            float rm = -INFINITY;
#pragma unroll
            for (int r = 0; r < 16; ++r) {
                const float t0 = dq + (float)((r & 3) + 8 * (r >> 2)), t1 = t0 + 32.f;
                p0[r] = __builtin_fmaf(-slope2, __builtin_fabsf(t0), p0[r]);
                p1[r] = __builtin_fmaf(-slope2, __builtin_fabsf(t1), p1[r]);
                if (WIN) { if (__builtin_fabsf(t0) > Wf) p0[r] = -INFINITY; if (__builtin_fabsf(t1) > Wf) p1[r] = -INFINITY; }
                rm = __builtin_fmaxf(rm, __builtin_fmaxf(p0[r], p1[r]));
            }
            rm = __builtin_fmaxf(rm, __shfl_xor(rm, 32));
            if (__any(rm > m)) {
                const float mn = __builtin_fmaxf(m, rm); const float f = __builtin_amdgcn_exp2f(m - mn); m = mn; l *= f;
                if (hi == 0) wsf[r32] = f;
#pragma unroll
                for (int r = 0; r < 16; ++r) { const float fr = wsf[crow(r, hi)];
#pragma unroll
                    for (int d = 0; d < ND; ++d) o[d][r] *= fr; }
            }
            float ls = 0.f;
#pragma unroll
            for (int r = 0; r < 16; ++r) { p0[r] = __builtin_amdgcn_exp2f(p0[r] - m); p1[r] = __builtin_amdgcn_exp2f(p1[r] - m); ls += p0[r] + p1[r]; }
            l += ls;
            u32x4 pw[4];
#pragma unroll
            for (int c = 0; c < 4; ++c) {
                const f32x16& P = (c >> 1) ? p1 : p0; const int b = 8 * (c & 1);
                pw[c].x = cvt_pk(P[b + 0], P[b + 1]); pw[c].y = cvt_pk(P[b + 2], P[b + 3]); pw[c].z = cvt_pk(P[b + 4], P[b + 5]); pw[c].w = cvt_pk(P[b + 6], P[b + 7]);
            }
            const LAS unsigned char* Vb = lds + j * SLOT + 64 * KSTR + (4 * hi + ((lane & 15) >> 2)) * VSTR + (16 * ((lane >> 4) & 1) + 4 * (lane & 3)) * 2;
#pragma unroll
            for (int c = 0; c < 4; ++c)
#pragma unroll
                for (int d = 0; d < ND; ++d) {
                    const s16x4 vlo = vtr(Vb + c * 16 * VSTR + d * 64), vhi = vtr(Vb + c * 16 * VSTR + 8 * VSTR + d * 64);
                    const bf16x8 vf = (bf16x8){vlo[0], vlo[1], vlo[2], vlo[3], vhi[0], vhi[1], vhi[2], vhi[3]};
                    o[d] = __builtin_amdgcn_mfma_f32_32x32x16_bf16(__builtin_bit_cast(bf16x8, pw[c]), vf, o[d], 0, 0, 0);
                    if (d == ND - 1) __builtin_amdgcn_sched_barrier(0);
                }
        }
      }
    }
    l += __shfl_xor(l, 32);
    if (hi == 0) wsf[r32] = 1.f / l;
#pragma unroll
    for (int r = 0; r < 16; ++r) { const float ir = wsf[crow(r, hi)];
        if (Obf != nullptr) { bf16_t* orow = Obf + (size_t)(qw + crow(r, hi)) * opitch + r32;
#pragma unroll
            for (int d = 0; d < ND; ++d) orow[d * 32] = (bf16_t)f2bf(o[d][r] * ir);
        } else { float* orow = Oout + (size_t)(qw + crow(r, hi)) * opitch + r32;
#pragma unroll
            for (int d = 0; d < ND; ++d) orow[d * 32] = o[d][r] * ir; } }
    if (lse_out != nullptr && hi == 0) lse_out[(size_t)(qw + r32) * lpitch] = (m + __builtin_log2f(l)) * LN2;
    __syncthreads();
}

__device__ __forceinline__ void row_to_bf16_ssq(const float* xrow, bf16_t* orow, float* ssq, int lane) {
    const f32x4* xr = (const f32x4*)xrow + lane;
    f32x4 v[4]; float s = 0.f;
#pragma unroll
    for (int j = 0; j < 4; ++j) { v[j] = xr[64 * j]; s += (v[j].x * v[j].x + v[j].y * v[j].y) + (v[j].z * v[j].z + v[j].w * v[j].w); }
    s = wave_sum(s);
    u32x2* o8 = (u32x2*)orow + lane;
#pragma unroll
    for (int j = 0; j < 4; ++j) { u32x2 w; w.x = pk2(v[j].x, v[j].y); w.y = pk2(v[j].z, v[j].w); o8[64 * j] = w; }
    if (lane == 0) *ssq = s;
}
constexpr int BK_OFF = 0, BV_OFF = 2 * 64 * KSTR, BSCR_OFF = BV_OFF + 3 * 64 * 320, ATT_O0_OFF = BSCR_OFF + 2048;
static_assert(ATT_O0_OFF + 65536 <= 147456, "B attention LDS map");
constexpr float B_THR = 6.0f;
#ifndef B_LATE
#define B_LATE(w) false
#endif
template <int KI> __device__ __forceinline__ float fmamk_t(float a, float c) { float r; asm("v_fmamk_f32 %0, %1, %3, %2" : "=v"(r) : "v"(a), "v"(c), "n"(__builtin_bit_cast(int, (float)KI))); return r; }
__device__ __forceinline__ float max3f(float a, float b, float c) { float r; asm("v_max3_f32 %0, %1, %2, %3" : "=v"(r) : "v"(a), "v"(b), "v"(c)); return r; }
__device__ __forceinline__ void attn_b_unit(LAS unsigned char* lds, const bf16_t* base, int h, int q0, int L, float slope2_, float lam,
                                            const float* subln_l, float postscale, bf16_t* mix) {
    constexpr int VD = 128, VSTR = VD * 2 + 64, ND = 4, VCH = 16, VLD = 2;
    int tid_l = threadIdx.x; asm volatile("" : "+v"(tid_l)); const int tid = tid_l, lane = tid & 63, r32 = lane & 31, hi = lane >> 5, wid = __builtin_amdgcn_readfirstlane(tid >> 6);
    const int qw = q0 + wid * 32, NT = L / 64, c0 = q0 / 64;
    LAS float* wsf = (LAS float*)(lds + BSCR_OFF) + wid * 64;
    const bool late = B_LATE(wid);
    const int krow = tid >> 3, kch = tid & 7;
    const bf16_t* Vp = base + 1536 + h * 128;
    const float qposf_ = (float)(qw + r32);
    for (int mp = 0; mp < 2; ++mp) {
        const bf16_t* Qp = base + 512 + (h * 2 + mp) * 64; const bf16_t* Kp = base + 1024 + (h * 2 + mp) * 64;
        bf16x8 qr[4];
        { const bf16_t* qrow = Qp + (size_t)(qw + r32) * DIN + hi * 8;
#pragma unroll
          for (int d0 = 0; d0 < 4; ++d0) qr[d0] = *(const bf16x8*)(qrow + d0 * 16); }
        f32x16 o[ND];
#pragma unroll
        for (int d = 0; d < ND; ++d)
#pragma unroll
            for (int r = 0; r < 16; ++r) o[d][r] = 0.f;
        float mref = 0.f, l = 0.f;
        u32x4 kreg; u32x4 vreg[VLD];
        const unsigned koff = (unsigned)(krow * DIN + kch * 8) * 2u, voff = (unsigned)((tid >> 4) * DIN + (tid & 15) * 8) * 2u;
#define ATT_GLOAD(t) do { const char* kt_ = (const char*)Kp + (size_t)(t) * (64 * DIN * 2); const char* vt_ = (const char*)Vp + (size_t)(t) * (64 * DIN * 2); \
        kreg = *(const u32x4*)(kt_ + koff); vreg[0] = *(const u32x4*)(vt_ + voff); vreg[1] = *(const u32x4*)(vt_ + 32 * DIN * 2 + voff); } while (0)
#define ATT_LSTORE(b, vs) do { *(LAS u32x4*)(lds + BK_OFF + (b) * 64 * KSTR + krow * KSTR + kch * 16) = kreg; \
        *(LAS u32x4*)(lds + BV_OFF + (vs) * 64 * VSTR + (tid >> 4) * VSTR + (tid & 15) * 16) = vreg[0]; *(LAS u32x4*)(lds + BV_OFF + (vs) * 64 * VSTR + ((tid >> 4) + 32) * VSTR + (tid & 15) * 16) = vreg[1]; } while (0)
#define VFRAG(x, d) (bf16x8){x[d][0][0], x[d][0][1], x[d][0][2], x[d][0][3], x[d][1][0], x[d][1][1], x[d][1][2], x[d][1][3]}
#define PV_LOAD01(vs) do { \
        const LAS unsigned char* Vb = lds + BV_OFF + (vs) * 64 * VSTR + (4 * hi + ((lane & 15) >> 2)) * VSTR + (16 * ((lane >> 4) & 1) + 4 * (lane & 3)) * 2; \
        _Pragma("unroll") for (int d = 0; d < ND; ++d) { va[d][0] = vtr(Vb + d * 64); va[d][1] = vtr(Vb + 8 * VSTR + d * 64); } \
        _Pragma("unroll") for (int d = 0; d < ND; ++d) { vb2[d][0] = vtr(Vb + 16 * VSTR + d * 64); vb2[d][1] = vtr(Vb + 16 * VSTR + 8 * VSTR + d * 64); } \
        __builtin_amdgcn_sched_barrier(0); } while (0)
#define PV_MMA(vs) do { \
        const LAS unsigned char* Vb = lds + BV_OFF + (vs) * 64 * VSTR + (4 * hi + ((lane & 15) >> 2)) * VSTR + (16 * ((lane >> 4) & 1) + 4 * (lane & 3)) * 2; \
        _Pragma("unroll") for (int d = 0; d < ND; ++d) o[d] = __builtin_amdgcn_mfma_f32_32x32x16_bf16(__builtin_bit_cast(bf16x8, pw[0]), VFRAG(va, d), o[d], 0, 0, 0); \
        __builtin_amdgcn_sched_barrier(0); \
        _Pragma("unroll") for (int d = 0; d < ND; ++d) { va[d][0] = vtr(Vb + 32 * VSTR + d * 64); va[d][1] = vtr(Vb + 32 * VSTR + 8 * VSTR + d * 64); } \
        __builtin_amdgcn_sched_barrier(0); \
        _Pragma("unroll") for (int d = 0; d < ND; ++d) o[d] = __builtin_amdgcn_mfma_f32_32x32x16_bf16(__builtin_bit_cast(bf16x8, pw[1]), VFRAG(vb2, d), o[d], 0, 0, 0); \
        __builtin_amdgcn_sched_barrier(0); \
        _Pragma("unroll") for (int d = 0; d < ND; ++d) { vb2[d][0] = vtr(Vb + 48 * VSTR + d * 64); vb2[d][1] = vtr(Vb + 48 * VSTR + 8 * VSTR + d * 64); } \
        __builtin_amdgcn_sched_barrier(0); \
        _Pragma("unroll") for (int d = 0; d < ND; ++d) o[d] = __builtin_amdgcn_mfma_f32_32x32x16_bf16(__builtin_bit_cast(bf16x8, pw[2]), VFRAG(va, d), o[d], 0, 0, 0); \
        _Pragma("unroll") for (int d = 0; d < ND; ++d) o[d] = __builtin_amdgcn_mfma_f32_32x32x16_bf16(__builtin_bit_cast(bf16x8, pw[3]), VFRAG(vb2, d), o[d], 0, 0, 0); \
        __builtin_amdgcn_sched_barrier(0); } while (0)
        int first = 1; asm volatile("" : "+s"(first));
#define B_TILE(i_) ((i_) < 4 ? c0 + (i_) : ((i_) - 4 < c0 ? (i_) - 4 : (i_)))
        int t = B_TILE(0);
        int vs_prev = 2, vs_cur = 0, vs_next = 1;
        u32x4 pw[4];
        ATT_GLOAD(t); ATT_LSTORE(0, 0); __syncthreads();
        for (int i = 0; i < NT; ++i) {
            const int buf = i & 1;
            int tn = 0;
            if (i + 1 < NT) { tn = B_TILE(i + 1); ATT_GLOAD(tn); }
            f32x16 p0, p1;
            const int kb = 64 * t;
            float slope2 = slope2_, qposf = qposf_; asm volatile("" : "+v"(slope2), "+v"(qposf));
            const LAS unsigned char* Kb = lds + BK_OFF + buf * 64 * KSTR + r32 * KSTR + hi * 16;
            bf16x8 kf[8];
#pragma unroll
            for (int d0 = 0; d0 < 4; ++d0) { kf[d0] = *(const LAS bf16x8*)(Kb + d0 * 32); kf[4 + d0] = *(const LAS bf16x8*)(Kb + 32 * KSTR + d0 * 32); }
            const LAS unsigned char* Vb = lds + BV_OFF + vs_cur * 64 * VSTR + (4 * hi + ((lane & 15) >> 2)) * VSTR + (16 * ((lane >> 4) & 1) + 4 * (lane & 3)) * 2;
            s16x4 va[ND][2], vb2[ND][2];
            const bool offdiag = (kb + 63 < qw || kb > qw + 31);
            const float dq = (float)(kb + 4 * hi) - qposf;
#define QK_P0(INIT0, INIT1) do { \
            _Pragma("unroll") for (int r = 0; r < 16; ++r) { const float kv = (float)((r & 3) + 8 * (r >> 2)); p0[r] = INIT0; } \
            __builtin_amdgcn_sched_barrier(0); \
            _Pragma("unroll") for (int d0 = 0; d0 < 4; ++d0) { \
                p0 = __builtin_amdgcn_mfma_f32_32x32x16_bf16(kf[d0], qr[d0], p0, 0, 0, 0); \
                _Pragma("unroll") for (int r = 4 * d0; r < 4 * d0 + 4; ++r) { const float kv = (float)((r & 3) + 8 * (r >> 2) + 32); p1[r] = INIT1; } \
                __builtin_amdgcn_sched_barrier(0); } } while (0)
            if (offdiag) {
                const float sg = (kb > qw) ? -slope2 : slope2, b0 = sg * dq - mref;
                p0[0] = fmamk_t<0>(sg, b0); p0[1] = fmamk_t<1>(sg, b0); p0[2] = fmamk_t<2>(sg, b0); p0[3] = fmamk_t<3>(sg, b0); p0[4] = fmamk_t<8>(sg, b0); p0[5] = fmamk_t<9>(sg, b0); p0[6] = fmamk_t<10>(sg, b0); p0[7] = fmamk_t<11>(sg, b0); p0[8] = fmamk_t<16>(sg, b0); p0[9] = fmamk_t<17>(sg, b0); p0[10] = fmamk_t<18>(sg, b0); p0[11] = fmamk_t<19>(sg, b0); p0[12] = fmamk_t<24>(sg, b0); p0[13] = fmamk_t<25>(sg, b0); p0[14] = fmamk_t<26>(sg, b0); p0[15] = fmamk_t<27>(sg, b0);
                __builtin_amdgcn_sched_barrier(0);
                p0 = __builtin_amdgcn_mfma_f32_32x32x16_bf16(kf[0], qr[0], p0, 0, 0, 0); p1[0] = fmamk_t<32>(sg, b0); p1[1] = fmamk_t<33>(sg, b0); p1[2] = fmamk_t<34>(sg, b0); p1[3] = fmamk_t<35>(sg, b0); __builtin_amdgcn_sched_barrier(0);
                p0 = __builtin_amdgcn_mfma_f32_32x32x16_bf16(kf[1], qr[1], p0, 0, 0, 0); p1[4] = fmamk_t<40>(sg, b0); p1[5] = fmamk_t<41>(sg, b0); p1[6] = fmamk_t<42>(sg, b0); p1[7] = fmamk_t<43>(sg, b0); __builtin_amdgcn_sched_barrier(0);
                p0 = __builtin_amdgcn_mfma_f32_32x32x16_bf16(kf[2], qr[2], p0, 0, 0, 0); p1[8] = fmamk_t<48>(sg, b0); p1[9] = fmamk_t<49>(sg, b0); p1[10] = fmamk_t<50>(sg, b0); p1[11] = fmamk_t<51>(sg, b0); __builtin_amdgcn_sched_barrier(0);
                p0 = __builtin_amdgcn_mfma_f32_32x32x16_bf16(kf[3], qr[3], p0, 0, 0, 0); p1[12] = fmamk_t<56>(sg, b0); p1[13] = fmamk_t<57>(sg, b0); p1[14] = fmamk_t<58>(sg, b0); p1[15] = fmamk_t<59>(sg, b0); __builtin_amdgcn_sched_barrier(0);
            } else {
                const float nmref = -mref;
                QK_P0(__builtin_fmaf(-slope2, __builtin_fabsf(dq + kv), nmref), __builtin_fmaf(-slope2, __builtin_fabsf(dq + kv), nmref));
            }
#undef QK_P0
#pragma unroll
            for (int d = 0; d < ND; ++d) { va[d][0] = vtr(Vb + d * 64); va[d][1] = vtr(Vb + 8 * VSTR + d * 64); }
#pragma unroll
            for (int d = 0; d < ND; ++d) { vb2[d][0] = vtr(Vb + 16 * VSTR + d * 64); vb2[d][1] = vtr(Vb + 16 * VSTR + 8 * VSTR + d * 64); }
            __builtin_amdgcn_sched_barrier(0);
#pragma unroll
            for (int d0 = 0; d0 < 4; ++d0) p1 = __builtin_amdgcn_mfma_f32_32x32x16_bf16(kf[4 + d0], qr[d0], p1, 0, 0, 0);
            __builtin_amdgcn_sched_barrier(0);
            float rm, rmb;
            asm volatile("s_nop 15\n\ts_nop 7\n\tv_max3_f32 %0, %1, %2, %3\n\tv_max3_f32 %0, %0, %4, %5\n\tv_max3_f32 %0, %0, %6, %7\n\tv_max3_f32 %0, %0, %8, %9\n\t"
                         "v_max3_f32 %0, %0, %10, %11\n\tv_max3_f32 %0, %0, %12, %13\n\tv_max3_f32 %0, %0, %14, %15\n\tv_max3_f32 %0, %0, %16, %16"
                         : "=&v"(rm) : "v"(p0[0]), "v"(p0[1]), "v"(p0[2]), "v"(p0[3]), "v"(p0[4]), "v"(p0[5]), "v"(p0[6]), "v"(p0[7]), "v"(p0[8]), "v"(p0[9]), "v"(p0[10]), "v"(p0[11]), "v"(p0[12]), "v"(p0[13]), "v"(p0[14]), "v"(p0[15]));
            asm volatile("v_max3_f32 %0, %1, %2, %3\n\tv_max3_f32 %0, %0, %4, %5\n\tv_max3_f32 %0, %0, %6, %7\n\tv_max3_f32 %0, %0, %8, %9\n\t"
                         "v_max3_f32 %0, %0, %10, %11\n\tv_max3_f32 %0, %0, %12, %13\n\tv_max3_f32 %0, %0, %14, %15\n\tv_max3_f32 %0, %0, %16, %16"
                         : "=&v"(rmb) : "v"(p1[0]), "v"(p1[1]), "v"(p1[2]), "v"(p1[3]), "v"(p1[4]), "v"(p1[5]), "v"(p1[6]), "v"(p1[7]), "v"(p1[8]), "v"(p1[9]), "v"(p1[10]), "v"(p1[11]), "v"(p1[12]), "v"(p1[13]), "v"(p1[14]), "v"(p1[15]));
            rm = __builtin_fmaxf(rm, rmb);
            { auto rr_ = __builtin_amdgcn_permlane32_swap(__float_as_uint(rm), __float_as_uint(rm), false, false); rm = __builtin_fmaxf(__uint_as_float(rr_[0]), __uint_as_float(rr_[1])); }
            if (first || __any(rm > B_THR)) {
                const float delta = (first || rm > B_THR) ? rm : 0.f; const float f = __builtin_amdgcn_exp2f(-delta); mref += delta; l *= f;
#pragma unroll
                for (int r = 0; r < 16; ++r) { p0[r] -= delta; p1[r] -= delta; }
                {
                    if (hi == 0) wsf[r32] = f;
#pragma unroll
                    for (int r = 0; r < 16; ++r) { const float fr = wsf[crow(r, hi)];
#pragma unroll
                        for (int d = 0; d < ND; ++d) o[d][r] *= fr; }
                }
            }
            float ls0 = 0.f, ls1 = 0.f;
#pragma unroll
            for (int r = 0; r < 16; ++r) { p0[r] = __builtin_amdgcn_exp2f(p0[r]); ls0 += p0[r]; }
            pw[0].x = cvt_pk(p0[0], p0[1]); pw[0].y = cvt_pk(p0[2], p0[3]); pw[0].z = cvt_pk(p0[4], p0[5]); pw[0].w = cvt_pk(p0[6], p0[7]);
            pw[1].x = cvt_pk(p0[8], p0[9]); pw[1].y = cvt_pk(p0[10], p0[11]); pw[1].z = cvt_pk(p0[12], p0[13]); pw[1].w = cvt_pk(p0[14], p0[15]);
            __builtin_amdgcn_sched_barrier(0);
#define VFRAG(x, d) (bf16x8){x[d][0][0], x[d][0][1], x[d][0][2], x[d][0][3], x[d][1][0], x[d][1][1], x[d][1][2], x[d][1][3]}
#pragma unroll
            for (int d = 0; d < ND; ++d) {
                o[d] = __builtin_amdgcn_mfma_f32_32x32x16_bf16(__builtin_bit_cast(bf16x8, pw[0]), VFRAG(va, d), o[d], 0, 0, 0);
                p1[2 * d] = __builtin_amdgcn_exp2f(p1[2 * d]); p1[2 * d + 1] = __builtin_amdgcn_exp2f(p1[2 * d + 1]); ls1 += p1[2 * d]; ls0 += p1[2 * d + 1];
                __builtin_amdgcn_sched_barrier(0);
            }
#pragma unroll
            for (int d = 0; d < ND; ++d) { va[d][0] = vtr(Vb + 32 * VSTR + d * 64); va[d][1] = vtr(Vb + 32 * VSTR + 8 * VSTR + d * 64); }
            __builtin_amdgcn_sched_barrier(0);
#pragma unroll
            for (int d = 0; d < ND; ++d) {
                o[d] = __builtin_amdgcn_mfma_f32_32x32x16_bf16(__builtin_bit_cast(bf16x8, pw[1]), VFRAG(vb2, d), o[d], 0, 0, 0);
                p1[8 + 2 * d] = __builtin_amdgcn_exp2f(p1[8 + 2 * d]); p1[8 + 2 * d + 1] = __builtin_amdgcn_exp2f(p1[8 + 2 * d + 1]); ls1 += p1[8 + 2 * d]; ls0 += p1[8 + 2 * d + 1];
                __builtin_amdgcn_sched_barrier(0);
            }
#pragma unroll
            for (int d = 0; d < ND; ++d) { vb2[d][0] = vtr(Vb + 48 * VSTR + d * 64); vb2[d][1] = vtr(Vb + 48 * VSTR + 8 * VSTR + d * 64); }
            if (i + 1 < NT) ATT_LSTORE(buf ^ 1, vs_next);
            l += ls0 + ls1;
            pw[2].x = cvt_pk(p1[0], p1[1]); pw[2].y = cvt_pk(p1[2], p1[3]); pw[2].z = cvt_pk(p1[4], p1[5]); pw[2].w = cvt_pk(p1[6], p1[7]);
            __builtin_amdgcn_sched_barrier(0);
#pragma unroll
            for (int d = 0; d < ND; ++d) {
                o[d] = __builtin_amdgcn_mfma_f32_32x32x16_bf16(__builtin_bit_cast(bf16x8, pw[2]), VFRAG(va, d), o[d], 0, 0, 0);
                if (d == 0) { pw[3].x = cvt_pk(p1[8], p1[9]); pw[3].y = cvt_pk(p1[10], p1[11]); } else if (d == 1) { pw[3].z = cvt_pk(p1[12], p1[13]); pw[3].w = cvt_pk(p1[14], p1[15]); }
                __builtin_amdgcn_sched_barrier(0);
            }
#pragma unroll
            for (int d = 0; d < ND; ++d) o[d] = __builtin_amdgcn_mfma_f32_32x32x16_bf16(__builtin_bit_cast(bf16x8, pw[3]), VFRAG(vb2, d), o[d], 0, 0, 0);
#undef VFRAG
            __builtin_amdgcn_sched_barrier(0);
            first = 0;
            t = tn;
            { const int tmp_ = vs_prev; vs_prev = vs_cur; vs_cur = vs_next; vs_next = tmp_; }
            __syncthreads();
        }
#undef PV_LOAD01
#undef PV_MMA
#undef B_TILE
#undef VFRAG
#undef ATT_GLOAD
#undef ATT_LSTORE
        l += __shfl_xor(l, 32);
        if (hi == 0) wsf[r32] = 1.f / l;
        int lane_e = lane, qw_e = qw; asm volatile("" : "+v"(lane_e)); asm volatile("" : "+s"(qw_e));
        const int r32 = lane_e & 31, hi = lane_e >> 5, qw = qw_e;
        LAS unsigned* o0buf = (LAS unsigned*)(lds + ATT_O0_OFF) + wid * 2048 + lane_e;
        if (mp == 0) {
#pragma unroll
            for (int d = 0; d < ND; ++d)
#pragma unroll
                for (int r = 0; r < 16; r += 2) { const float i0 = wsf[crow(r, hi)], i1 = wsf[crow(r + 1, hi)]; o0buf[(d * 8 + (r >> 1)) * 64] = cvt_pk(o[d][r] * i0, o[d][r + 1] * i1); }
        } else {
            float gs[ND];
#pragma unroll
            for (int d = 0; d < ND; ++d) gs[d] = subln_l[d * 32 + r32] * postscale;
#pragma unroll
            for (int r = 0; r < 16; r += 2) {
                const float i0 = wsf[crow(r, hi)], i1 = wsf[crow(r + 1, hi)];
                float v0[ND], v1[ND]; float s0 = 0.f, s1 = 0.f;
#pragma unroll
                for (int d = 0; d < ND; ++d) { const unsigned w = o0buf[(d * 8 + (r >> 1)) * 64];
                    v0[d] = __builtin_bit_cast(float, w << 16) - lam * (o[d][r] * i0); v1[d] = __builtin_bit_cast(float, w & 0xffff0000u) - lam * (o[d][r + 1] * i1);
                    s0 += v0[d] * v0[d]; s1 += v1[d] * v1[d]; }
#pragma unroll
                for (int sh = 1; sh < 32; sh <<= 1) { s0 += __shfl_xor(s0, sh); s1 += __shfl_xor(s1, sh); }
                const float r0 = 1.f / sqrtf(s0 * (1.f / 128.f) + 1e-5f), r1 = 1.f / sqrtf(s1 * (1.f / 128.f) + 1e-5f);
                bf16_t* row0 = mix + (size_t)(qw + crow(r, hi)) * DM + r32; bf16_t* row1 = mix + (size_t)(qw + crow(r + 1, hi)) * DM + r32;
#pragma unroll
                for (int d = 0; d < ND; ++d) { row0[d * 32] = (bf16_t)f2bf(v0[d] * r0 * gs[d]); row1[d * 32] = (bf16_t)f2bf(v1[d] * r1 * gs[d]); }
            }
        }
        __syncthreads();
    }
}
__device__ __forceinline__ float alibi_slope(int i, int n) { return exp2f(-8.0f * (float)(i + 1) / (float)n); }
struct Ctx { int tid, lane, wave, G, cu, gw, NGW; };

__device__ __forceinline__ void ph_weights(const Args& a, LAS unsigned char* lds, int l, int gw0, int nw, int wave, int lane) {
    unsigned char* ws = a.ws;
    bf16_t* WinT = (bf16_t*)(ws + WS_WIN); bf16_t* WoutT = (bf16_t*)(ws + WS_WOUT); bf16_t* WupT = (bf16_t*)(ws + WS_WUP); bf16_t* WdnT = (bf16_t*)(ws + WS_WDN);
    const float* w_in = a.in[3]; const float* w_out = a.in[10]; const float* w_up = a.in[12]; const float* w_down = a.in[15];
    LAS float* scr = (LAS float*)(lds + wave * 16384);
    constexpr int I_IN = (DM / 64) * (DIN / 32), I_OUT = (DM / 64) * (DM / 32), I_UP = (DM / 64) * (DUP / 32), I_DN = (DFF / 64) * (DM / 32);
    constexpr int PER_L = I_IN + I_OUT + I_UP + I_DN;
    for (int it = gw0; it < PER_L; it += nw) {
        int r = it;
        if (r < I_IN) { transpose_item(w_in + (size_t)l * DM * DIN, DM, DIN, WinT + (size_t)l * DIN * DM, scr, r, lane, a.in[2] + l * DM); continue; } r -= I_IN;
        if (r < I_OUT) { transpose_item(w_out + (size_t)l * DM * DM, DM, DM, WoutT + (size_t)l * DM * DM, scr, r, lane, nullptr); continue; } r -= I_OUT;
        if (r < I_UP) { transpose_item(w_up + (size_t)l * DM * DUP, DM, DUP, WupT + (size_t)l * DUP * DM, scr, r, lane, a.in[11] + l * DM, true); continue; } r -= I_UP;
        transpose_item(w_down + (size_t)l * DFF * DM, DFF, DM, WdnT + (size_t)l * DM * DFF, scr, r, lane, nullptr);
    }
}
__device__ __forceinline__ const float* chunk_in(const Args& a, int ch) { return ch == 0 ? a.in[0] : a.in[1] + (size_t)(ch - 1) * CH_ROWS * DM; }
__device__ __forceinline__ float* chunk_out(const Args& a, int ch) { return a.out + (size_t)ch * CH_ROWS * DM; }

__device__ __forceinline__ void ph_norm_bf16(const Ctx& c, const float* xsrc, const float* gain, bf16_t* HB) {
    for (int r = c.gw; r < CH_ROWS; r += c.NGW) rms_row_to_bf16(xsrc + (size_t)r * DM, gain, HB + (size_t)r * DM, c.lane);
}
__device__ __forceinline__ void ph_final_norm(const Ctx& c, float* xo, const float* gain) {
    for (int r = c.gw; r < CH_ROWS; r += c.NGW) rms_row_f32(xo + (size_t)r * DM, gain, c.lane);
}

__device__ __forceinline__ void ph_attn(const Args& a, const Ctx& c, LAS unsigned char* lds, int ch, int layer) {
    const bf16_t* PROJ = (const bf16_t*)(a.ws + WS_PROJ); float* TMP = (float*)(a.ws + WS_TMP);
    const int SL = ch == 0 ? 16384 : 4096, sl_shift = ch == 0 ? 14 : 12;
    const int cu = c.cu, G = c.G;
#ifndef SKIP_B
    {
        const float lam_init = layer == 0 ? 0.2f : (0.8f - 0.6f * 0.7408182206817179f);
        const float s1 = wave_sum(a.in[5][layer * 64 + c.lane] * a.in[6][layer * 64 + c.lane]);
        const float s2 = wave_sum(a.in[7][layer * 64 + c.lane] * a.in[8][layer * 64 + c.lane]);
        const float lam = expf(s1) - expf(s2) + lam_init;
        bf16_t* HBm = (bf16_t*)(a.ws + WS_HB);
#ifdef PROBE_B2
        for (int rep_ = 0; rep_ < 2; ++rep_)
#endif
        for (int u = cu; u < 256; u += G) {
            int seq, h, qb; const int xcd = u & 7, idx = u >> 3;
            if (ch == 0) { seq = 0; h = xcd >> 1; qb = (xcd & 1) * 32 + idx; }
            else { const int pair = xcd * 2 + (idx >> 4); seq = pair >> 2; h = pair & 3; qb = idx & 15; }
            const size_t rb = (size_t)seq * SL;
            attn_b_unit(lds, PROJ + rb * DIN, h, qb * 256, SL, alibi_slope(h, 4) * LOG2E, lam, a.in[9] + layer * 128, 1.f - lam_init, HBm + rb * DM + 256 + h * 128);
        }
    }
#endif
#ifndef SKIP_AC
#ifdef PROBE_AC2
    for (int rep_ = 0; rep_ < 2; ++rep_)
#endif
    for (int uu = cu; uu < 1024; uu += G) {
        const bf16_t *qp, *kp, *vp; size_t pitch, opitch, lpitch; int q0, L, W; float slope2, m_init, l_init; float *op, *lp; bf16_t* obf;
        if (uu < 256) {
            const int hq = uu >> 6, blk = uu & 63;
            const int seq = (blk * 256) >> sl_shift, qb = blk - ((seq << sl_shift) >> 8);
            const size_t rb = (size_t)seq * SL; const bf16_t* base = PROJ + rb * DIN;
            qp = base + hq * 64; kp = base + 256 + (hq >> 1) * 64; vp = base + 384 + (hq >> 1) * 64; pitch = DIN; q0 = qb * 256; L = SL;
            slope2 = alibi_slope(hq, 4) * LOG2E; W = 128; m_init = a.in[4][layer * 4 + hq] * LOG2E; l_init = 1.f;
            op = nullptr; obf = (bf16_t*)(a.ws + WS_HB) + rb * DM + hq * 64; opitch = DM; lp = nullptr; lpitch = 0;
        } else {
            const int uc = uu - 256;
            const int gh = uc >> 6, blk = uc & 63, gq = gh >> 2;
            const int dsh = 2 * gq, d = 1 << dsh;
            const int seq = (blk * 256) >> sl_shift, b2 = blk - ((seq << sl_shift) >> 8);
            const int nbr = (SL >> dsh) >> 8;
            const int res = b2 / nbr, qb = b2 % nbr;
            const size_t rb = (size_t)seq * SL + res; const bf16_t* base = PROJ + rb * DIN;
            qp = base + 2048 + gh * 64; kp = base + 2816 + gh * 64; vp = base + 3584 + gh * 64; pitch = (size_t)DIN * d; q0 = qb * 256; L = SL >> dsh;
            slope2 = alibi_slope(gh, 12) * (float)d * LOG2E; W = 64; m_init = -1e30f; l_init = 0.f;
            op = nullptr; obf = (bf16_t*)TMP + rb * 768 + gh * 64; opitch = (size_t)768 * d; lp = TMP + 8 * 1024 * 1024 + rb * 16 + gh; lpitch = (size_t)16 * d;
        }
        attn_unit<64, true>(lds, qp, kp, vp, pitch, q0, L, slope2, W, m_init, l_init, op, opitch, lp, lpitch, obf);
    }
#endif
}

__device__ __forceinline__ void ph_combine(const Args& a, const Ctx& c, int layer) {
    const float* TMP = (const float*)(a.ws + WS_TMP); bf16_t* HB = (bf16_t*)(a.ws + WS_HB);
    { float* S2 = (float*)(a.ws + WS_SSQ) + 2 * CH_ROWS; for (int r = c.cu * NTHREADS + c.tid; r < CH_ROWS; r += c.G * NTHREADS) S2[r] = 0.f; }
    const int nitems = CH_ROWS * 32;
#pragma unroll 2
    for (int it = c.cu * NTHREADS + c.tid; it < nitems; it += c.G * NTHREADS) {
        const int r = it >> 5, h = (it >> 3) & 3, d8 = (it & 7) * 8;
        const bf16_t* tr = (const bf16_t*)TMP + (size_t)r * 768; const float* lr = TMP + 8 * 1024 * 1024 + (size_t)r * 16;
        const float l0 = lr[h], l1 = lr[4 + h], l2 = lr[8 + h];
        const u32x4 ua = *(const u32x4*)(tr + h * 64 + d8), ub = *(const u32x4*)(tr + (4 + h) * 64 + d8), uc = *(const u32x4*)(tr + (8 + h) * 64 + d8);
#define BF_LO(w) __builtin_bit_cast(float, (w) << 16)
#define BF_HI(w) __builtin_bit_cast(float, (w) & 0xffff0000u)
        const f32x4 a0 = (f32x4){BF_LO(ua.x), BF_HI(ua.x), BF_LO(ua.y), BF_HI(ua.y)}, a1 = (f32x4){BF_LO(ua.z), BF_HI(ua.z), BF_LO(ua.w), BF_HI(ua.w)};
        const f32x4 b0 = (f32x4){BF_LO(ub.x), BF_HI(ub.x), BF_LO(ub.y), BF_HI(ub.y)}, b1 = (f32x4){BF_LO(ub.z), BF_HI(ub.z), BF_LO(ub.w), BF_HI(ub.w)};
        const f32x4 c0 = (f32x4){BF_LO(uc.x), BF_HI(uc.x), BF_LO(uc.y), BF_HI(uc.y)}, c1 = (f32x4){BF_LO(uc.z), BF_HI(uc.z), BF_LO(uc.w), BF_HI(uc.w)};
#undef BF_LO
#undef BF_HI
        const float mx = fmaxf(l0, fmaxf(l1, l2));
        float w0 = __expf(l0 - mx), w1 = __expf(l1 - mx), w2 = __expf(l2 - mx);
        const float inv = 1.f / (w0 + w1 + w2); w0 *= inv; w1 *= inv; w2 *= inv;
        const f32x4 o0 = a0 * w0 + b0 * w1 + c0 * w2, o1 = a1 * w0 + b1 * w1 + c1 * w2;
        u32x4 o; o.x = pk2(o0.x, o0.y); o.y = pk2(o0.z, o0.w); o.z = pk2(o1.x, o1.y); o.w = pk2(o1.z, o1.w);
        *(u32x4*)(HB + (size_t)r * DM + 768 + h * 64 + d8) = o;
    }
}

__device__ __forceinline__ void ph_conv(const Args& a, const Ctx& c, int ch, int layer) {
    const int par = ch & 1;
    const bf16_t* UB = (const bf16_t*)(a.ws + WS_PROJ); bf16_t* GB = (bf16_t*)(a.ws + WS_TMP);
    const int SL = ch == 0 ? 16384 : 4096;
    const float* cw = a.in[13] + (size_t)layer * 3 * DUP; const float* cb = a.in[14] + (size_t)layer * DUP;
    constexpr int NCG = DFF / 8, RB = 16;
    const int nitems = (CH_ROWS / RB) * NCG;
    { float* S1 = (float*)(a.ws + WS_SSQ) + par * CH_ROWS; for (int r = c.cu * NTHREADS + c.tid; r < CH_ROWS; r += c.G * NTHREADS) S1[r] = 0.f; }
    for (int it = c.cu * NTHREADS + c.tid; it < nitems; it += c.G * NTHREADS) {
        const int cg8 = it % NCG, rb = it / NCG, c0 = cg8 * 8, r0 = rb * RB;
        f32x4 wg[3][2], wv[3][2], bg[2], bv[2];
#pragma unroll
        for (int k = 0; k < 3; ++k)
#pragma unroll
            for (int j = 0; j < 2; ++j) { wg[k][j] = *(const f32x4*)(cw + k * DUP + c0 + 4 * j); wv[k][j] = *(const f32x4*)(cw + k * DUP + DFF + c0 + 4 * j); }
#pragma unroll
        for (int j = 0; j < 2; ++j) { bg[j] = *(const f32x4*)(cb + c0 + 4 * j); bv[j] = *(const f32x4*)(cb + DFF + c0 + 4 * j); }
        const bool first = (r0 & (SL - 1)) == 0, last = ((r0 + RB) & (SL - 1)) == 0;
        const u32x4 zero = (u32x4){0u, 0u, 0u, 0u};
        const bf16_t* up = UB + (size_t)r0 * DUP + c0;
        u32x4 pg_ = first ? zero : *(const u32x4*)(up - DUP), pv_ = first ? zero : *(const u32x4*)(up - DUP + DFF);
        u32x4 cg_ = *(const u32x4*)(up), cv_ = *(const u32x4*)(up + DFF);
        bf16_t* gp = GB + (size_t)r0 * DFF + c0;
#pragma unroll 4
        for (int rr = 0; rr < RB; ++rr) {
            const bool nz = (rr == RB - 1) && last;
            const u32x4 ng_ = nz ? zero : *(const u32x4*)(up + (size_t)(rr + 1) * DUP), nv_ = nz ? zero : *(const u32x4*)(up + (size_t)(rr + 1) * DUP + DFF);
            unsigned ow[4];
#pragma unroll
            for (int w = 0; w < 4; ++w) {
                float res[2];
#pragma unroll
                for (int hh = 0; hh < 2; ++hh) {
                    const int j = 2 * w + hh, q = j >> 2, e = j & 3;
                    const float gpv = hh ? __builtin_bit_cast(float, pg_[w] & 0xffff0000u) : __builtin_bit_cast(float, pg_[w] << 16);
                    const float gcv = hh ? __builtin_bit_cast(float, cg_[w] & 0xffff0000u) : __builtin_bit_cast(float, cg_[w] << 16);
                    const float gnv = hh ? __builtin_bit_cast(float, ng_[w] & 0xffff0000u) : __builtin_bit_cast(float, ng_[w] << 16);
                    const float vpv = hh ? __builtin_bit_cast(float, pv_[w] & 0xffff0000u) : __builtin_bit_cast(float, pv_[w] << 16);
                    const float vcv = hh ? __builtin_bit_cast(float, cv_[w] & 0xffff0000u) : __builtin_bit_cast(float, cv_[w] << 16);
                    const float vnv = hh ? __builtin_bit_cast(float, nv_[w] & 0xffff0000u) : __builtin_bit_cast(float, nv_[w] << 16);
                    const float gate = gpv * wg[0][q][e] + gcv * wg[1][q][e] + gnv * wg[2][q][e] + bg[q][e];
                    const float val = vpv * wv[0][q][e] + vcv * wv[1][q][e] + vnv * wv[2][q][e] + bv[q][e];
                    res[hh] = gate * __builtin_amdgcn_rcpf(1.f + __builtin_amdgcn_exp2f(-LOG2E * gate)) * val;
                }
                ow[w] = pk2(res[0], res[1]);
            }
            *(u32x4*)(gp + (size_t)rr * DFF) = (u32x4){ow[0], ow[1], ow[2], ow[3]};
            pg_ = cg_; pv_ = cv_; cg_ = ng_; cv_ = nv_;
        }
    }
}

constexpr int STEPS_PER_CHUNK = DEPTH * 6;
constexpr int NSTEPS = 1 + NCHUNK * STEPS_PER_CHUNK + 1;
__global__ void __launch_bounds__(NTHREADS, 2) mega_fwd(Args a) {
    extern __shared__ __attribute__((aligned(16))) unsigned char lds_raw[];
    LAS unsigned char* lds = (LAS unsigned char*)lds_raw;
    cg::grid_group grid = cg::this_grid();
    volatile LAS unsigned* bst = (volatile LAS unsigned*)(lds + 147456);
    if (threadIdx.x < 2) bst[threadIdx.x] = 0u;
    __syncthreads();
    XcdBarrier xbar = xcd_barrier_post((unsigned*)(a.ws + WS_CTL), bst);
#ifdef PROBE_P2
    for (int pass_ = 0; pass_ < 2; ++pass_)
#endif
    for (int step = 0; step < NSTEPS; ++step) {
        int tid_l = threadIdx.x, cu_l = blockIdx.x, G_l = gridDim.x;
        asm volatile("" : "+v"(tid_l)); asm volatile("" : "+s"(cu_l), "+s"(G_l));
        Ctx c; c.tid = tid_l; c.lane = c.tid & 63; c.wave = __builtin_amdgcn_readfirstlane(c.tid >> 6);
        c.G = G_l; c.cu = cu_l; c.gw = c.cu * 8 + c.wave; c.NGW = c.G * 8;
        unsigned char* ws = a.ws;
        if (step == 0) {
            ph_weights(a, lds, 0, c.gw, c.NGW, c.wave, c.lane); ph_weights(a, lds, 1, c.gw, c.NGW, c.wave, c.lane);
            const float* xin = chunk_in(a, 0); bf16_t* XB = (bf16_t*)(ws + WS_XB); float* S1 = (float*)(ws + WS_SSQ);
            for (int r = c.gw; r < CH_ROWS; r += c.NGW) row_to_bf16_ssq(xin + (size_t)r * DM, XB + (size_t)r * DM, S1 + r, c.lane);
        } else if (step == NSTEPS - 1) ph_final_norm(c, chunk_out(a, NCHUNK - 1), a.in[16]);
        else {
            const int s = step - 1, ch = s / STEPS_PER_CHUNK, sc = s % STEPS_PER_CHUNK, par = ch & 1;
            bf16_t* HB = (bf16_t*)(ws + WS_HB); bf16_t* XB = (bf16_t*)(ws + WS_XB) + (size_t)par * CH_ROWS * DM;
            float* S1 = (float*)(ws + WS_SSQ) + par * CH_ROWS; float* S2 = (float*)(ws + WS_SSQ) + 2 * CH_ROWS;
            float* xo = chunk_out(a, ch);
            {
                const int layer = sc / 6, ph = sc % 6;
                const float* xsrc = layer == 0 ? chunk_in(a, ch) : (const float*)xo;
                if (ph == 0) {
                    pg8::Gemm g{XB, (const bf16_t*)(ws + WS_WIN) + (size_t)layer * DIN * DM, CH_ROWS, DIN, DM}; pg8::StaticOrder S; S.init(CH_ROWS, DIN, c.G, c.cu);
                    pg8::EpiBf16S2 E{(bf16_t*)(ws + WS_PROJ), DIN, 1805u, QSCALE, S1};
#ifdef PROBE_G2
                    for (int rep_ = 0; rep_ < 2; ++rep_)
#endif
                    pg8::gemm_phase<pg8::EpiBf16S2, pg8::StaticOrder, true, true>(lds, g, S, E);
                    if (layer == 0 && ch > 0) {
                        const int nfull = (CH_ROWS / 256) * (DIN / 256) % c.G;
                        if (nfull > 0 && c.cu >= nfull) { float* xp = chunk_out(a, ch - 1); const int nw = (c.G - nfull) * 8;
                            for (int r = (c.cu - nfull) * 8 + c.wave; r < CH_ROWS; r += nw) rms_row_f32(xp + (size_t)r * DM, a.in[16], c.lane); }
                        else if (nfull == 0) ph_final_norm(c, chunk_out(a, ch - 1), a.in[16]);
                    }
                } else if (ph == 1) {
                    ph_attn(a, c, lds, ch, layer);
                } else if (ph == 2) {
                    ph_combine(a, c, layer);
                } else if (ph == 3) {
                    pg8::Gemm g{HB, (const bf16_t*)(ws + WS_WOUT) + (size_t)layer * DM * DM, CH_ROWS, DM, DM}; pg8::StaticOrder S; S.init(CH_ROWS, DM, c.G, c.cu);
                    bf16_t* XL = (bf16_t*)(ws + WS_PROJ + 140 * MiB);
                    pg8::EpiRes2 E{layer == 0 ? xsrc : (const float*)nullptr, XB, XL, (float*)nullptr, XB, XL, S2, DM};
                    pg8::gemm_phase<pg8::EpiRes2, pg8::StaticOrder, true, true>(lds, g, S, E);
                } else if (ph == 4) {
                    pg8::Gemm g{XB - DM, (const bf16_t*)(ws + WS_WUP) + (size_t)layer * DUP * DM, 65 * 256, DUP, DM, 254}; pg8::StaticOrder S; S.init(65 * 256, DUP, c.G, c.cu);
                    pg8::EpiConv E{(bf16_t*)(ws + WS_TMP), S2, a.in[13] + (size_t)layer * 3 * DUP, a.in[14] + (size_t)layer * DUP, (ch == 0 ? 16384 : 4096) - 1, (LAS float*)(lds + 147456 + 256), CH_ROWS};
                    pg8::gemm_phase<pg8::EpiConv, pg8::StaticOrder, true, true>(lds, g, S, E);
                    { float* S1z = S1; for (int r = c.cu * NTHREADS + c.tid; r < CH_ROWS; r += c.G * NTHREADS) S1z[r] = 0.f; }
                    if (layer == DEPTH - 1 && ch + 1 < NCHUNK) {
                        const float* xin = chunk_in(a, ch + 1); bf16_t* XBn = (bf16_t*)(ws + WS_XB) + (size_t)(par ^ 1) * CH_ROWS * DM; float* S1n = (float*)(ws + WS_SSQ) + (par ^ 1) * CH_ROWS;
                        for (int r = c.gw; r < CH_ROWS; r += c.NGW) row_to_bf16_ssq(xin + (size_t)r * DM, XBn + (size_t)r * DM, S1n + r, c.lane);
                    }
                } else {
                    pg8::Gemm g{(const bf16_t*)(ws + WS_TMP), (const bf16_t*)(ws + WS_WDN) + (size_t)layer * DM * DFF, CH_ROWS, DM, DFF}; pg8::StaticOrder S; S.init(CH_ROWS, DM, c.G, c.cu);
                    bf16_t* XL = (bf16_t*)(ws + WS_PROJ + 140 * MiB);
                    pg8::EpiRes2 E{(const float*)nullptr, XB, XL, layer == DEPTH - 1 ? xo : (float*)nullptr, XB, XL, S1, DM};
                    pg8::gemm_phase<pg8::EpiRes2, pg8::StaticOrder, true, true>(lds, g, S, E);
                }
            }
        }
#ifdef PROBE_P2
        if (step == 0) grid.sync(); else xcd_barrier(xbar);
#else
        if (step == 0) grid.sync(); else if (step != NSTEPS - 1) xcd_barrier(xbar);
#endif
    }
#ifdef PROBE_TA
    if (blockIdx.x == 0 && threadIdx.x < 64) {
        float* xo = chunk_out(a, NCHUNK - 1);
        const float ua = (float)tA_ * 0.01f, ub = (float)tB_ * 0.01f;
        if (threadIdx.x == 0) xo[0] += 8.f + ua * 0.01f; else xo[4 * threadIdx.x] += sqrtf(ub * 0.01f);
    }
#endif
}

extern "C" void kernel_launch(void* const* d_in, const int* in_sizes, int n_in, void* d_out, int out_size, void* d_ws, size_t ws_size, hipStream_t stream) {
    static int grid = 0;
    if (grid == 0) {
        if (n_in != 17 || ws_size < WS_END) { fprintf(stderr, "kernel_launch: unexpected n_in %d / ws_size %zu (need %zu)\n", n_in, ws_size, (size_t)WS_END); grid = -1; return; }
        int dev = 0, cus = 0, per_cu = 0;
        (void)hipGetDevice(&dev); (void)hipDeviceGetAttribute(&cus, hipDeviceAttributeMultiprocessorCount, dev);
        if (hipFuncSetAttribute((const void*)mega_fwd, hipFuncAttributeMaxDynamicSharedMemorySize, LDS_BYTES) != hipSuccess) { fprintf(stderr, "hipFuncSetAttribute failed\n"); grid = -1; return; }
        if (hipOccupancyMaxActiveBlocksPerMultiprocessor(&per_cu, (const void*)mega_fwd, NTHREADS, LDS_BYTES) != hipSuccess || per_cu < 1) { fprintf(stderr, "occupancy query: %d\n", per_cu); per_cu = 1; }
        (void)hipGetLastError();
        grid = cus * 1;
    }
    if (grid < 0) return;
    (void)hipMemsetAsync((char*)d_ws + WS_CTL, 0, 65536, stream);
    Args a{};
    for (int i = 0; i < 17; ++i) a.in[i] = (const float*)d_in[i];
    a.out = (float*)d_out; a.ws = (unsigned char*)d_ws;
    void* args[] = {&a};
    hipError_t e = hipLaunchCooperativeKernel((const void*)mega_fwd, dim3(grid), dim3(NTHREADS), args, LDS_BYTES, stream);
    if (e != hipSuccess) fprintf(stderr, "cooperative launch failed: %s (grid %d)\n", hipGetErrorString(e), grid);
}
```

```cpp
#include <hip/hip_runtime.h>
#include <hip/hip_cooperative_groups.h>
#include <cstdio>
#include <cstdint>
#include <cmath>
namespace cg = cooperative_groups;
namespace pg8 {
#define PG8_LAS __attribute__((address_space(3)))
typedef unsigned short bf16_t;
typedef short bf16x8 __attribute__((ext_vector_type(8)));
typedef float f32x4 __attribute__((ext_vector_type(4)));
typedef unsigned u32x4 __attribute__((ext_vector_type(4)));
constexpr int BM = 256, BK = 64, HALF = 128, HTB = HALF * BK * 2  , STAGE_BYTES = 8 * HTB, NXCD = 8, WGM = 8;

__host__ __device__ __forceinline__ int lds_byte(int r, int c) { const int st = (r >> 4) * 2 + (c >> 5), rr = r & 15, cc = c & 31, ob = rr * 64 + cc * 2; return st * 1024 + (ob ^ (((ob >> 9) & 1) << 5)); }
__host__ __device__ __forceinline__ void stage_rc(int b, int& R, int& C) { const int st = b / 1024, sb = b % 1024, swz = sb ^ (((sb >> 9) & 1) << 5); R = (st >> 1) * 16 + swz / 64; C = (st & 1) * 32 + (swz % 64) / 2; }
__host__ __device__ __forceinline__ int perm32(int rho) { const int n = rho >> 4, i = rho & 15; return 8 * (i >> 2) + 4 * n + (i & 3); }

struct Unit { int pm, pn; };
struct Gemm { const bf16_t* A; const bf16_t* Bt; int M, N, K; int a_rows = 256; };

struct StaticOrder {
    int nM, nN, nwg, G, c;
    __host__ __device__ void init(int M, int N, int G_, int c_) { nM = M / BM; nN = N / BM; nwg = nM * nN; G = G_; c = c_; }
    __host__ __device__ bool next(int i, Unit& u) const {
        const long L = (long)i * G + c; if (L >= nwg) return false;
        int wgid = (int)L; { const int q = nwg / NXCD, r = nwg % NXCD, xcd = wgid % NXCD, off = wgid / NXCD; wgid = (xcd < r ? xcd * (q + 1) : r * (q + 1) + (xcd - r) * q) + off; }
        const int nig = WGM * nN, gid = wgid / nig, fm = gid * WGM, gsz = (nM - fm) < WGM ? (nM - fm) : WGM;
        u.pm = fm + ((wgid % nig) % gsz); u.pn = (wgid % nig) / gsz; return true;
    }
    __device__ __forceinline__ void a_ready(const Unit&) const {}
    __device__ __forceinline__ void done(const Unit&) const {}
};

__device__ __forceinline__ unsigned cvt_pk_bf16(float lo, float hi) { unsigned r; asm volatile("v_cvt_pk_bf16_f32 %0, %1, %2" : "=v"(r) : "v"(lo), "v"(hi)); return r; }
struct EpiBf16S {
    static constexpr bool PERM = true, AFTER_DRAIN = false;
    bf16_t* O; int ldc; unsigned scalemask; float sc;
    __device__ __forceinline__ void operator()(const f32x4 (&acc)[2][2][4][2], const Unit& u, int wr, int wc, int fr, int fq) const {
        const int row0 = u.pm * BM + wr * 64 + fr; const int col0 = u.pn * BM + wc * 32 + 8 * fq;
        const float s = ((scalemask >> u.pn) & 1u) ? sc : 1.f;
#pragma unroll
        for (int ai = 0; ai < 2; ++ai)
#pragma unroll
            for (int m = 0; m < 4; ++m) { bf16_t* rowp = O + (size_t)(row0 + ai * HALF + m * 16) * ldc + col0;
#pragma unroll
                for (int bj = 0; bj < 2; ++bj) { f32x4 v0 = acc[ai][bj][m][0] * s, v1 = acc[ai][bj][m][1] * s;
                    u32x4 w; w.x = cvt_pk_bf16(v0[0], v0[1]); w.y = cvt_pk_bf16(v0[2], v0[3]); w.z = cvt_pk_bf16(v1[0], v1[1]); w.w = cvt_pk_bf16(v1[2], v1[3]);
                    *(u32x4*)(rowp + bj * HALF) = w; } }
    }
};
struct EpiRes {
    static constexpr bool PERM = false, AFTER_DRAIN = false;
    const float* base; float* out; int ldc;
    __device__ __forceinline__ void operator()(const f32x4 (&acc)[2][2][4][2], const Unit& u, int wr, int wc, int fr, int fq) const {
        const int col0 = u.pn * BM + wc * 32 + 4 * fq;
#pragma unroll
        for (int ai = 0; ai < 2; ++ai)
#pragma unroll
            for (int m = 0; m < 4; ++m) { const size_t off = (size_t)(u.pm * BM + ai * HALF + wr * 64 + m * 16 + fr) * ldc + col0;
#pragma unroll
                for (int bj = 0; bj < 2; ++bj)
#pragma unroll
                    for (int n = 0; n < 2; ++n) { const f32x4 bs = *(const f32x4*)(base + off + bj * HALF + n * 16); *(f32x4*)(out + off + bj * HALF + n * 16) = bs + acc[ai][bj][m][n]; }
                asm volatile("" ::: "memory"); }
    }
};

struct EpiBf16S2 {
    static constexpr bool PERM = true, AFTER_DRAIN = false;
    bf16_t* O; int ldc; unsigned scalemask; float sc; const float* ssq;
    __device__ __forceinline__ void operator()(const f32x4 (&acc)[2][2][4][2], const Unit& u, int wr, int wc, int fr, int fq) const {
        const int row0 = u.pm * BM + wr * 64 + fr; const int col0 = u.pn * BM + wc * 32 + 8 * fq;
        const float s = ((scalemask >> u.pn) & 1u) ? sc : 1.f;
#pragma unroll
        for (int ai = 0; ai < 2; ++ai)
#pragma unroll
            for (int m = 0; m < 4; ++m) { const int row = row0 + ai * HALF + m * 16; bf16_t* rowp = O + (size_t)row * ldc + col0;
                const float rs = s / sqrtf(ssq[row] * (1.f / 1024.f) + 1e-6f);
#pragma unroll
                for (int bj = 0; bj < 2; ++bj) { f32x4 v0 = acc[ai][bj][m][0] * rs, v1 = acc[ai][bj][m][1] * rs;
                    u32x4 w; w.x = cvt_pk_bf16(v0[0], v0[1]); w.y = cvt_pk_bf16(v0[2], v0[3]); w.z = cvt_pk_bf16(v1[0], v1[1]); w.w = cvt_pk_bf16(v1[2], v1[3]);
                    *(u32x4*)(rowp + bj * HALF) = w; } }
    }
};
typedef unsigned u32x2e __attribute__((ext_vector_type(2)));
struct EpiRes2 {
    static constexpr bool PERM = true, AFTER_DRAIN = false;
    const float* base_f32; const bf16_t* base_hi; const bf16_t* base_lo; float* out_f32; bf16_t* out_hi; bf16_t* out_lo; float* ssq; int ldc;
    static __device__ __forceinline__ float lo16(unsigned w) { return __builtin_bit_cast(float, w << 16); }
    static __device__ __forceinline__ float hi16(unsigned w) { return __builtin_bit_cast(float, w & 0xffff0000u); }
    __device__ __forceinline__ void operator()(const f32x4 (&acc)[2][2][4][2], const Unit& u, int wr, int wc, int fr, int fq) const {
        const int col0 = u.pn * BM + wc * 32 + 8 * fq;
#pragma unroll
        for (int ai = 0; ai < 2; ++ai)
#pragma unroll
            for (int m = 0; m < 4; ++m) { const int row = u.pm * BM + ai * HALF + wr * 64 + m * 16 + fr; const size_t off = (size_t)row * ldc + col0; float ps = 0.f;
#pragma unroll
                for (int bj = 0; bj < 2; ++bj) {
                    f32x4 b0, b1;
                    if (base_f32 != nullptr) { b0 = *(const f32x4*)(base_f32 + off + bj * HALF); b1 = *(const f32x4*)(base_f32 + off + bj * HALF + 4); }
                    else { const u32x4 h = *(const u32x4*)(base_hi + off + bj * HALF), l = *(const u32x4*)(base_lo + off + bj * HALF);
                        b0 = (f32x4){lo16(h.x) + lo16(l.x), hi16(h.x) + hi16(l.x), lo16(h.y) + lo16(l.y), hi16(h.y) + hi16(l.y)};
                        b1 = (f32x4){lo16(h.z) + lo16(l.z), hi16(h.z) + hi16(l.z), lo16(h.w) + lo16(l.w), hi16(h.w) + hi16(l.w)}; }
                    const f32x4 v0 = b0 + acc[ai][bj][m][0], v1 = b1 + acc[ai][bj][m][1];
                    if (out_f32 != nullptr) { *(f32x4*)(out_f32 + off + bj * HALF) = v0; *(f32x4*)(out_f32 + off + bj * HALF + 4) = v1; }
                    else {
                        ps += ((v0[0] * v0[0] + v0[1] * v0[1]) + (v0[2] * v0[2] + v0[3] * v0[3])) + ((v1[0] * v1[0] + v1[1] * v1[1]) + (v1[2] * v1[2] + v1[3] * v1[3]));
                        u32x4 h; h.x = cvt_pk_bf16(v0[0], v0[1]); h.y = cvt_pk_bf16(v0[2], v0[3]); h.z = cvt_pk_bf16(v1[0], v1[1]); h.w = cvt_pk_bf16(v1[2], v1[3]);
                        u32x4 l; l.x = cvt_pk_bf16(v0[0] - lo16(h.x), v0[1] - hi16(h.x)); l.y = cvt_pk_bf16(v0[2] - lo16(h.y), v0[3] - hi16(h.y));
                        l.z = cvt_pk_bf16(v1[0] - lo16(h.z), v1[1] - hi16(h.z)); l.w = cvt_pk_bf16(v1[2] - lo16(h.w), v1[3] - hi16(h.w));
                        *(u32x4*)(out_hi + off + bj * HALF) = h; *(u32x4*)(out_lo + off + bj * HALF) = l; } }
                if (out_f32 == nullptr) { ps += __shfl_xor(ps, 16); ps += __shfl_xor(ps, 32);
                    if (fq == 0) atomicAdd(ssq + row, ps); }
                asm volatile("" ::: "memory"); }
    }
};

struct EpiNull {
    static constexpr bool PERM = false, AFTER_DRAIN = false;
    __device__ __forceinline__ void operator()(const f32x4 (&acc)[2][2][4][2], const Unit& u, int wr, int wc, int fr, int fq) const {
#pragma unroll
        for (int ai = 0; ai < 2; ++ai)
#pragma unroll
            for (int bj = 0; bj < 2; ++bj)
#pragma unroll
                for (int m = 0; m < 4; ++m)
#pragma unroll
                    for (int n = 0; n < 2; ++n) asm volatile("" :: "v"(acc[ai][bj][m][n]));
    }
};

#define PG8_DPP(old, src, ctrl) __builtin_bit_cast(float, __builtin_amdgcn_update_dpp(__builtin_bit_cast(int, (float)(old)), __builtin_bit_cast(int, (float)(src)), (ctrl), 0xF, 0xF, false))
struct EpiConv {
    static constexpr bool PERM = true, AFTER_DRAIN = false;
    bf16_t* G; const float* ssq; const float* cw; const float* cb; int slmask; PG8_LAS float* xch; int nrows;
    __device__ __forceinline__ void operator()(f32x4 (&acc)[2][2][4][2], const Unit& u, int wr, int wc, int fr, int fq) const {
        const int t0 = 254 * u.pm - 1 + wr * 64 + fr;
#pragma unroll
        for (int ai = 0; ai < 2; ++ai)
#pragma unroll
            for (int m = 0; m < 4; ++m) { int t = t0 + ai * HALF + m * 16; t = t < 0 ? 0 : (t > nrows - 1 ? nrows - 1 : t);
                const float rs = 1.f / sqrtf(ssq[t] * (1.f / 1024.f) + 1e-6f);
#pragma unroll
                for (int bj = 0; bj < 2; ++bj)
#pragma unroll
                    for (int n = 0; n < 2; ++n) acc[ai][bj][m][n] *= rs; }
        if (fr == 0 || fr == 15) { const int which = fr == 0 ? 0 : 1, m = fr == 0 ? 0 : 3;
#pragma unroll
            for (int ai = 0; ai < 2; ++ai) { PG8_LAS float* d = xch + ((((2 * ai + wr) * 2 + which) * 4 + wc) * 4 + fq) * 16;
#pragma unroll
                for (int bj = 0; bj < 2; ++bj)
#pragma unroll
                    for (int n = 0; n < 2; ++n) *(PG8_LAS f32x4*)(d + bj * 8 + n * 4) = fr == 0 ? acc[ai][bj][0][n] : acc[ai][bj][3][n]; }
            (void)m; }
        asm volatile("s_waitcnt lgkmcnt(0)" ::: "memory"); __builtin_amdgcn_s_barrier(); asm volatile("" ::: "memory");
        const int ch0 = u.pn * 128 + wc * 32 + 8 * fq;
#pragma unroll
        for (int n = 0; n < 2; ++n) {
            const int chn = ch0 + 4 * n;
            const f32x4 wg0 = *(const f32x4*)(cw + chn), wg1 = *(const f32x4*)(cw + 5632 + chn), wg2 = *(const f32x4*)(cw + 2 * 5632 + chn), bgv = *(const f32x4*)(cb + chn);
            const f32x4 wv0 = *(const f32x4*)(cw + 2816 + chn), wv1 = *(const f32x4*)(cw + 5632 + 2816 + chn), wv2 = *(const f32x4*)(cw + 2 * 5632 + 2816 + chn), bvv = *(const f32x4*)(cb + 2816 + chn);
#pragma unroll
            for (int ai = 0; ai < 2; ++ai)
#pragma unroll
                for (int m = 0; m < 4; ++m) {
                    const int lr = ai * HALF + wr * 64 + m * 16 + fr, t = 254 * u.pm - 1 + lr;
                    const int gidx = 2 * ai + wr;
                    f32x4 pv[2], nx[2];
#pragma unroll
                    for (int bj = 0; bj < 2; ++bj) {
                        f32x4 upo, dno;
                        if (m > 0) { const f32x4 s = acc[ai][bj][m - 1][n];
#pragma unroll
                            for (int j = 0; j < 4; ++j) upo[j] = PG8_DPP(0.f, s[j], 0x121); }
                        else upo = gidx > 0 ? *(const PG8_LAS f32x4*)(xch + ((((gidx - 1) * 2 + 1) * 4 + wc) * 4 + fq) * 16 + bj * 8 + n * 4) : (f32x4){0.f, 0.f, 0.f, 0.f};
                        if (m < 3) { const f32x4 s = acc[ai][bj][m + 1][n];
#pragma unroll
                            for (int j = 0; j < 4; ++j) dno[j] = PG8_DPP(0.f, s[j], 0x12F); }
                        else dno = gidx < 3 ? *(const PG8_LAS f32x4*)(xch + ((((gidx + 1) * 2 + 0) * 4 + wc) * 4 + fq) * 16 + bj * 8 + n * 4) : (f32x4){0.f, 0.f, 0.f, 0.f};
                        const f32x4 cur = acc[ai][bj][m][n];
#pragma unroll
                        for (int j = 0; j < 4; ++j) { pv[bj][j] = PG8_DPP(upo[j], cur[j], 0x111);
                                                       nx[bj][j] = PG8_DPP(dno[j], cur[j], 0x101); }
                    }
                    const bool sfirst = (t & slmask) == 0, slast = (t & slmask) == slmask;
                    float res[4];
#pragma unroll
                    for (int j = 0; j < 4; ++j) {
                        const float gp = sfirst ? 0.f : pv[0][j], gn = slast ? 0.f : nx[0][j], vp = sfirst ? 0.f : pv[1][j], vn = slast ? 0.f : nx[1][j];
                        const float gate = gp * wg0[j] + acc[ai][0][m][n][j] * wg1[j] + gn * wg2[j] + bgv[j];
                        const float val = vp * wv0[j] + acc[ai][1][m][n][j] * wv1[j] + vn * wv2[j] + bvv[j];
                        res[j] = gate * __builtin_amdgcn_rcpf(1.f + __builtin_amdgcn_exp2f(-1.4426950408889634f * gate)) * val;
                    }
                    if (lr >= 1 && lr <= 254 && t < nrows) { u32x2e w; w.x = cvt_pk_bf16(res[0], res[1]); w.y = cvt_pk_bf16(res[2], res[3]); *(u32x2e*)(G + (size_t)t * 2816 + chn) = w; }
                }
        }
    }
};
template <class Epi, class Sched, bool ALIGN_EPI = false, bool SP2 = false>
__device__ __forceinline__ void gemm_phase(PG8_LAS unsigned char* lds, const Gemm g, const Sched& S, const Epi& E) {
    int tid_l = threadIdx.x; asm volatile("" : "+v"(tid_l)); const int tid = tid_l, wid = __builtin_amdgcn_readfirstlane(tid >> 6), lane = tid & 63, wr = wid >> 2, wc = wid & 3, fr = lane & 15, fq = lane >> 4;
    const int K = g.K, nt = K / BK;
    unsigned voffA[2], voffB[2];
#pragma unroll
    for (int i = 0; i < 2; ++i) { int R, C; stage_rc(tid * 16 + i * 8192, R, C); const int Rb = Epi::PERM ? ((R & ~31) + perm32(R & 31)) : R;
        voffA[i] = (unsigned)(R * K + C) * 2u; voffB[i] = (unsigned)(Rb * K + C) * 2u; }
    const size_t kstep = (size_t)(BK * 2);
    const size_t hstep = (size_t)HALF * K * 2;
    const size_t tstep = 2 * hstep; const size_t tstepA = (size_t)g.a_rows * K * 2;
    const unsigned ldsw = (unsigned)wid * 1024u;
    const int aoff = lds_byte(wr * 64 + fr, fq * 8), boff = lds_byte(wc * 32 + fr, fq * 8);
#define PG8_SA(b, h) (((b) * 2 + (h)) * HTB)
#define PG8_SB(b, h) ((4 + (b) * 2 + (h)) * HTB)
#define PG8_STAGE(bufoff, gbase, voff) do { _Pragma("unroll") for (int _i = 0; _i < 2; ++_i) \
        __builtin_amdgcn_global_load_lds((const unsigned*)((const char*)(gbase) + (voff)[_i]), (PG8_LAS unsigned*)(lds + (bufoff) + ldsw + _i * 8192), 16, 0, 0); } while (0)
#define PG8_LDA(dst, b, h) do { _Pragma("unroll") for (int m = 0; m < 4; ++m) _Pragma("unroll") for (int k = 0; k < 2; ++k) dst[m][k] = *(const PG8_LAS bf16x8*)(lds + PG8_SA(b, h) + aoff + m * 2048 + k * 1024); } while (0)
#define PG8_LDB(dst, b, h) do { _Pragma("unroll") for (int n = 0; n < 2; ++n) _Pragma("unroll") for (int k = 0; k < 2; ++k) dst[n][k] = *(const PG8_LAS bf16x8*)(lds + PG8_SB(b, h) + boff + n * 2048 + k * 1024); } while (0)
#define PG8_MMA(ai, bj, At, Bt) do { __builtin_amdgcn_s_setprio(1); _Pragma("unroll") for (int m = 0; m < 4; ++m) _Pragma("unroll") for (int n = 0; n < 2; ++n) _Pragma("unroll") for (int k = 0; k < 2; ++k) \
        acc[ai][bj][m][n] = __builtin_amdgcn_mfma_f32_16x16x32_bf16(Bt[n][k], At[m][k], acc[ai][bj][m][n], 0, 0, 0); __builtin_amdgcn_s_setprio(0); } while (0)
#define PG8_WAIT_V(n) asm volatile("s_waitcnt vmcnt(" #n ")" ::: "memory")
#define PG8_WAIT_L(n) asm volatile("s_waitcnt lgkmcnt(" #n ")" ::: "memory")
#define PG8_BAR __builtin_amdgcn_s_barrier()
#define PG8_SCHED __builtin_amdgcn_sched_barrier(0)
    Unit cur, nxt; int ui = 0;
    if (!S.next(0, cur)) return;
    f32x4 acc[2][2][4][2];
#pragma unroll
    for (int a = 0; a < 2; ++a)
#pragma unroll
        for (int b = 0; b < 2; ++b)
#pragma unroll
            for (int m = 0; m < 4; ++m)
#pragma unroll
                for (int n = 0; n < 2; ++n) acc[a][b][m][n] = (f32x4){0.f, 0.f, 0.f, 0.f};
    bf16x8 At[4][2], B0[2][2], B1[2][2];
    const char* cA = (const char*)g.A + (size_t)cur.pm * tstepA; const char* cB = (const char*)g.Bt + (size_t)cur.pn * tstep;
    S.a_ready(cur);
    if constexpr (SP2) {
        PG8_STAGE(PG8_SB(0, 0), cB, voffB); PG8_STAGE(PG8_SB(0, 1), cB + hstep, voffB); PG8_STAGE(PG8_SA(0, 0), cA, voffA); PG8_STAGE(PG8_SA(0, 1), cA + hstep, voffA);
        if (wr == 1) PG8_BAR;
        PG8_WAIT_V(2); PG8_BAR;
        PG8_STAGE(PG8_SB(1, 0), cB + kstep, voffB); PG8_STAGE(PG8_SA(1, 0), cA + kstep, voffA); PG8_STAGE(PG8_SB(1, 1), cB + hstep + kstep, voffB);
        PG8_WAIT_V(6); PG8_BAR;
    } else {
        PG8_STAGE(PG8_SB(0, 0), cB, voffB); PG8_STAGE(PG8_SA(0, 0), cA, voffA); PG8_STAGE(PG8_SB(0, 1), cB + hstep, voffB); PG8_STAGE(PG8_SA(0, 1), cA + hstep, voffA);
        if (wr == 1) PG8_BAR;
        PG8_WAIT_V(4); PG8_BAR;
        PG8_STAGE(PG8_SB(1, 0), cB + kstep, voffB); PG8_STAGE(PG8_SA(1, 0), cA + kstep, voffA); PG8_STAGE(PG8_SB(1, 1), cB + hstep + kstep, voffB);
        PG8_WAIT_V(6); PG8_BAR;
    }
    for (;;) {
        const bool has_next = S.next(ui + 1, nxt);
        const char* nA = has_next ? (const char*)g.A + (size_t)nxt.pm * tstepA : cA; const char* nB = has_next ? (const char*)g.Bt + (size_t)nxt.pn * tstep : cB;
        for (int t = 0; t < nt; t += 2) {
            const bool last = (t == nt - 2);
            const char* a1 = cA + (size_t)(t + 1) * kstep;
            const char* a2 = last ? nA : cA + (size_t)(t + 2) * kstep; const char* b2 = last ? nB : cB + (size_t)(t + 2) * kstep;
            const char* a3 = a2 + kstep; const char* b3 = b2 + kstep;
            if (last && has_next) S.a_ready(nxt);
            if constexpr (SP2) {
            PG8_LDB(B0, 0, 0); PG8_LDB(B1, 0, 1); PG8_SCHED; PG8_LDA(At, 0, 0); PG8_STAGE(PG8_SA(1, 1), a1 + hstep, voffA);
            PG8_WAIT_V(8); PG8_WAIT_L(0); PG8_BAR; PG8_MMA(0, 0, At, B0); PG8_MMA(0, 1, At, B1); PG8_BAR; PG8_SCHED;
            PG8_LDA(At, 0, 1); PG8_STAGE(PG8_SB(0, 0), b2, voffB); PG8_STAGE(PG8_SB(0, 1), b2 + hstep, voffB); PG8_STAGE(PG8_SA(0, 0), a2, voffA);
            PG8_WAIT_V(8); PG8_WAIT_L(0); PG8_BAR; PG8_MMA(1, 0, At, B0); PG8_MMA(1, 1, At, B1); PG8_BAR; PG8_SCHED;
            PG8_LDB(B0, 1, 0); PG8_LDB(B1, 1, 1); PG8_SCHED; PG8_LDA(At, 1, 0); PG8_STAGE(PG8_SA(0, 1), a2 + hstep, voffA);
            PG8_WAIT_V(8); PG8_WAIT_L(0); PG8_BAR; PG8_MMA(0, 0, At, B0); PG8_MMA(0, 1, At, B1); PG8_BAR; PG8_SCHED;
            PG8_LDA(At, 1, 1); PG8_STAGE(PG8_SB(1, 0), b3, voffB); PG8_STAGE(PG8_SB(1, 1), b3 + hstep, voffB); PG8_STAGE(PG8_SA(1, 0), a3, voffA);
            PG8_WAIT_V(8); PG8_WAIT_L(0); PG8_BAR; PG8_MMA(1, 0, At, B0); PG8_MMA(1, 1, At, B1); PG8_BAR; PG8_SCHED;
            } else {
            PG8_LDB(B0, 0, 0); PG8_SCHED; PG8_LDA(At, 0, 0); PG8_STAGE(PG8_SA(1, 1), a1 + hstep, voffA);
            PG8_WAIT_L(8); PG8_BAR; PG8_WAIT_L(0); PG8_MMA(0, 0, At, B0); PG8_BAR; PG8_SCHED;
            PG8_LDB(B1, 0, 1); PG8_STAGE(PG8_SB(0, 0), b2, voffB);
            PG8_BAR; PG8_WAIT_L(0); PG8_MMA(0, 1, At, B1); PG8_BAR;
            PG8_LDA(At, 0, 1); PG8_STAGE(PG8_SA(0, 0), a2, voffA);
            PG8_BAR; PG8_WAIT_L(0); PG8_MMA(1, 0, At, B0); PG8_BAR; PG8_SCHED;
            PG8_STAGE(PG8_SB(0, 1), b2 + hstep, voffB);
            PG8_WAIT_V(6); PG8_BAR; PG8_MMA(1, 1, At, B1); PG8_BAR;
            PG8_LDB(B0, 1, 0); PG8_SCHED; PG8_LDA(At, 1, 0); PG8_STAGE(PG8_SA(0, 1), a2 + hstep, voffA);
            PG8_WAIT_L(8); PG8_BAR; PG8_WAIT_L(0); PG8_MMA(0, 0, At, B0); PG8_BAR; PG8_SCHED;
            PG8_LDB(B1, 1, 1); PG8_STAGE(PG8_SB(1, 0), b3, voffB);
            PG8_BAR; PG8_WAIT_L(0); PG8_MMA(0, 1, At, B1); PG8_BAR;
            PG8_LDA(At, 1, 1); PG8_STAGE(PG8_SA(1, 0), a3, voffA);
            PG8_BAR; PG8_WAIT_L(0); PG8_MMA(1, 0, At, B0); PG8_BAR; PG8_SCHED;
            PG8_STAGE(PG8_SB(1, 1), b3 + hstep, voffB);
            PG8_WAIT_V(6); PG8_BAR; PG8_MMA(1, 1, At, B1); PG8_BAR;
            }
        }
        if constexpr (ALIGN_EPI) { if (wr == 0) PG8_BAR; }
        if constexpr (!Epi::AFTER_DRAIN) { E(acc, cur, wr, wc, fr, fq); S.done(cur); }
        if (!has_next) break;
#pragma unroll
        for (int a = 0; a < 2; ++a)
#pragma unroll
            for (int b = 0; b < 2; ++b)
#pragma unroll
                for (int m = 0; m < 4; ++m)
#pragma unroll
                    for (int n = 0; n < 2; ++n) acc[a][b][m][n] = (f32x4){0.f, 0.f, 0.f, 0.f};
        cur = nxt; cA = nA; cB = nB; ++ui;
        if constexpr (ALIGN_EPI) { if (wr == 1) PG8_BAR; }
    }
    PG8_WAIT_V(0);
    if constexpr (!ALIGN_EPI) { if (wr == 0) PG8_BAR; }
    PG8_BAR;
    if constexpr (Epi::AFTER_DRAIN) { E.fused(acc, cur, wr, wc, fr, fq, lds, wid, lane); S.done(cur); }
#undef PG8_SA
#undef PG8_SB
#undef PG8_STAGE
#undef PG8_LDA
#undef PG8_LDB
#undef PG8_MMA
#undef PG8_WAIT_V
#undef PG8_WAIT_L
#undef PG8_BAR
#undef PG8_SCHED
}
}
typedef __bf16 bf16x2_t __attribute__((ext_vector_type(2)));
__device__ __forceinline__ unsigned cvt_pk(float lo, float hi) { float __attribute__((ext_vector_type(2))) v = {lo, hi}; bf16x2_t b = __builtin_convertvector(v, bf16x2_t); return __builtin_bit_cast(unsigned, b); }
#define LAS __attribute__((address_space(3)))
#define XB_TMO      128
#define XB_XCNT(j)  (256  + 64 * (j))
#define XB_XSUB(j)  (1280 + 64 * (j))
#define XB_XGEN(j)  (2304 + 64 * (j))
#define XB_TOP      3328
#define XB_TOPGEN   3392
#define XCD_BAR_WORDS 3456
#define XB_SPIN_CAP (1u << 18)

__device__ __forceinline__ unsigned xb_ld(unsigned* p)              { return __hip_atomic_load(p, __ATOMIC_RELAXED, __HIP_MEMORY_SCOPE_AGENT); }
__device__ __forceinline__ unsigned xb_add(unsigned* p, unsigned v) { return __hip_atomic_fetch_add(p, v, __ATOMIC_RELAXED, __HIP_MEMORY_SCOPE_AGENT); }
__device__ __forceinline__ unsigned xb_xcc_id() { return (unsigned)__builtin_amdgcn_s_getreg((3 << 11) | 20) & 0xFu; }
#define XB_SPIN(cond, bar) do { unsigned _sp = 0; while (cond) { __builtin_amdgcn_s_sleep(1); \
    if ((++_sp & 255u) == 0u) { if (xb_ld(&(bar)[XB_TMO])) break; if (_sp > XB_SPIN_CAP) { atomicAdd(&(bar)[XB_TMO], 1u); break; } } } } while (0)

struct XcdBarrier {
    unsigned* bar; unsigned x;
    volatile LAS unsigned* st;
};

__device__ __forceinline__ XcdBarrier xcd_barrier_post(unsigned* bar, volatile LAS unsigned* st) {
    XcdBarrier b; b.bar = bar; b.x = xb_xcc_id(); b.st = st;
    if (threadIdx.x == 0) (void)xb_add(&bar[XB_XCNT(b.x)], 1u);
    return b;
}
__device__ __forceinline__ void xcd_barrier_complete(unsigned* bar, unsigned x, unsigned& nloc, unsigned& nx) {
    const unsigned G = gridDim.x * gridDim.y * gridDim.z;
    unsigned sum, cnt, mine, sp = 0u;
    for (;;) {
        sum = 0u; cnt = 0u; mine = 0u;
#pragma unroll
        for (unsigned j = 0; j < 16; ++j) { const unsigned c = xb_ld(&bar[XB_XCNT(j)]); sum += c; cnt += (c > 0u) ? 1u : 0u; mine = (j == x) ? c : mine; }
        if (sum == G) break;
        __builtin_amdgcn_s_sleep(1);
        if ((++sp & 255u) == 0u) { if (xb_ld(&bar[XB_TMO])) break; if (sp > XB_SPIN_CAP) { atomicAdd(&bar[XB_TMO], 1u); break; } }
    }
    nloc = mine > 0u ? mine : 1u; nx = cnt > 0u ? cnt : 1u;
}

__device__ __forceinline__ void xcd_barrier(const XcdBarrier& b) {
    asm volatile("s_waitcnt vmcnt(0)" ::: "memory");
    __syncthreads();
    if (threadIdx.x == 0) {
        unsigned* bar = b.bar;
        __builtin_amdgcn_s_waitcnt(0);
        unsigned nloc = b.st[0], nx = b.st[1];
        if (nloc == 0u) { xcd_barrier_complete(bar, b.x, nloc, nx); b.st[0] = nloc; b.st[1] = nx; }
        const unsigned old = xb_add(&bar[XB_XSUB(b.x)], 1u);
        const unsigned gen = old / nloc;
        if (old + 1u == (gen + 1u) * nloc) {
            __builtin_amdgcn_fence(__ATOMIC_RELEASE, "agent");
            asm volatile("s_waitcnt vmcnt(0)" ::: "memory");
            const unsigned og = xb_add(&bar[XB_TOP], 1u);
            const unsigned tg = og / nx;
            if (og + 1u == (tg + 1u) * nx) xb_add(&bar[XB_TOPGEN], 1u);
            else XB_SPIN(xb_ld(&bar[XB_TOPGEN]) == tg, bar);
            __builtin_amdgcn_fence(__ATOMIC_ACQUIRE, "agent");
            xb_add(&bar[XB_XGEN(b.x)], 1u);
            asm volatile("s_waitcnt vmcnt(0)" ::: "memory");
        } else {
            XB_SPIN(xb_ld(&bar[XB_XGEN(b.x)]) == gen, bar);
            __builtin_amdgcn_fence(__ATOMIC_ACQUIRE, "agent");
            asm volatile("s_waitcnt vmcnt(0)" ::: "memory");
        }
    }
    __syncthreads();
}
typedef unsigned short bf16_t;
typedef short bf16x8 __attribute__((ext_vector_type(8)));
typedef short s16x4 __attribute__((ext_vector_type(4)));
typedef float f32x16 __attribute__((ext_vector_type(16)));
typedef float f32x4 __attribute__((ext_vector_type(4)));
typedef float f32x2 __attribute__((ext_vector_type(2)));
typedef unsigned u32x4 __attribute__((ext_vector_type(4)));
typedef unsigned u32x2 __attribute__((ext_vector_type(2)));

constexpr int DM = 1024, DIN = 4352, DFF = 2816, DUP = 2 * DFF, DEPTH = 2;
constexpr int CH_ROWS = 16384, NCHUNK = 3;
constexpr int TW = 784;
constexpr int T_C = 0, T_L = 768;
constexpr float LOG2E = 1.4426950408889634f, LN2 = 0.6931471805599453f;
constexpr float QSCALE = 0.125f * LOG2E;
constexpr size_t MiB = 1u << 20;
constexpr size_t WS_WIN = 0, WS_WOUT = 18 * MiB, WS_WUP = 22 * MiB, WS_WDN = 44 * MiB, WS_HB = 56 * MiB, WS_PROJ = 88 * MiB, WS_TMP = 264 * MiB, WS_CTL = 394 * MiB, WS_XB = 395 * MiB, WS_SSQ = 459 * MiB, WS_END = 460 * MiB;
constexpr int LDS_BYTES = 147456 + 256 + 8192;
constexpr int NTHREADS = 512;

struct Args { const float* in[17]; float* out; unsigned char* ws; };

__device__ __forceinline__ float wave_sum(float v) {
#pragma unroll
    for (int o = 1; o < 64; o <<= 1) v += __shfl_xor(v, o);
    return v;
}
__device__ __forceinline__ unsigned f2bf(float f) { unsigned u = __builtin_bit_cast(unsigned, f); return (u + 0x7fffu + ((u >> 16) & 1u)) >> 16; }
__device__ __forceinline__ unsigned pk2(float lo, float hi) { return f2bf(lo) | (f2bf(hi) << 16); }
__device__ __forceinline__ float bf2f(unsigned short b) { return __builtin_bit_cast(float, (unsigned)b << 16); }

__device__ __forceinline__ void transpose_item(const float* W, int K, int N, bf16_t* WT, LAS float* scr, int item, int lane, const float* gain, bool gate_perm = false) {
    const int nblk = N / 64, kb = item / nblk, nb = item % nblk, k0 = 64 * kb, n0 = 64 * nb;
    const int n4 = (lane & 15) * 4;
#pragma unroll
    for (int i = 0; i < 16; ++i) { const int kk = 4 * i + (lane >> 4); const float g = gain ? gain[k0 + kk] : 1.f;
        const f32x4 v = *(const f32x4*)(W + (size_t)(k0 + kk) * N + n0 + n4);
        LAS float* d = scr + kk * 65 + n4; d[0] = v.x * g; d[1] = v.y * g; d[2] = v.z * g; d[3] = v.w * g; }
    asm volatile("s_waitcnt lgkmcnt(0)" ::: "memory");
    const int c = lane & 7;
    const int half_ = N / 2, v_ = n0 >= half_ ? n0 - half_ : n0, d0 = gate_perm ? 256 * (v_ / 128) + (n0 >= half_ ? 128 : 0) + (v_ % 128) : n0;
#pragma unroll
    for (int j = 0; j < 8; ++j) { const int n = (lane >> 3) + 8 * j; const LAS float* s = scr + (8 * c) * 65 + n;
        u32x4 o; o.x = pk2(s[0 * 65], s[1 * 65]); o.y = pk2(s[2 * 65], s[3 * 65]); o.z = pk2(s[4 * 65], s[5 * 65]); o.w = pk2(s[6 * 65], s[7 * 65]);
        *(u32x4*)(WT + (size_t)(d0 + n) * K + k0 + 8 * c) = o; }
    asm volatile("s_waitcnt lgkmcnt(0)" ::: "memory");
}

__device__ __forceinline__ void rms_row_to_bf16(const float* xrow, const float* gain, bf16_t* orow, int lane) {
    const f32x4* xr = (const f32x4*)xrow + lane; const f32x4* gr = (const f32x4*)gain + lane;
    f32x4 v[4]; float s = 0.f;
#pragma unroll
    for (int j = 0; j < 4; ++j) { v[j] = xr[64 * j]; s += (v[j].x * v[j].x + v[j].y * v[j].y) + (v[j].z * v[j].z + v[j].w * v[j].w); }
    const float rstd = 1.f / sqrtf(wave_sum(s) * (1.f / DM) + 1e-6f);
    u32x2* o8 = (u32x2*)orow + lane;
#pragma unroll
    for (int j = 0; j < 4; ++j) { const f32x4 g = gr[64 * j]; u32x2 w; w.x = pk2(v[j].x * rstd * g.x, v[j].y * rstd * g.y); w.y = pk2(v[j].z * rstd * g.z, v[j].w * rstd * g.w); o8[64 * j] = w; }
}
__device__ __forceinline__ void rms_row_f32(float* xrow, const float* gain, int lane) {
    f32x4* xr = (f32x4*)xrow + lane; const f32x4* gr = (const f32x4*)gain + lane;
    f32x4 v[4]; float s = 0.f;
#pragma unroll
    for (int j = 0; j < 4; ++j) { v[j] = xr[64 * j]; s += (v[j].x * v[j].x + v[j].y * v[j].y) + (v[j].z * v[j].z + v[j].w * v[j].w); }
    const float rstd = 1.f / sqrtf(wave_sum(s) * (1.f / DM) + 1e-6f);
#pragma unroll
    for (int j = 0; j < 4; ++j) { const f32x4 g = gr[64 * j]; xr[64 * j] = v[j] * rstd * g; }
}

constexpr int KSTR = 144;
constexpr int ATT_K_OFF = 0, ATT_V_OFF = 2 * 64 * KSTR, ATT_SCR_OFF = ATT_V_OFF + 2 * 64 * 320;
__device__ __forceinline__ int crow(int r, int hi) { return (r & 3) + 8 * (r >> 2) + 4 * hi; }
typedef short v4i16_t __attribute__((ext_vector_type(4)));
__device__ __forceinline__ s16x4 vtr(const LAS unsigned char* p) { return __builtin_bit_cast(s16x4, __builtin_amdgcn_ds_read_tr16_b64_v4i16((LAS v4i16_t*)p)); }

template <int VD, bool WIN>
__device__ __forceinline__ void attn_unit(LAS unsigned char* lds, const bf16_t* Qp, const bf16_t* Kp, const bf16_t* Vp, size_t pitch,
                                          int q0, int L, float slope2, int W, float m_init, float l_init,
                                          float* Oout, size_t opitch, float* lse_out, size_t lpitch, bf16_t* Obf) {
    constexpr int VSTR = VD * 2 + 64, ND = VD / 32, VCH = VD / 8, VLD = 64 * VCH / NTHREADS;
    int tid_l = threadIdx.x; asm volatile("" : "+v"(tid_l)); const int tid = tid_l, lane = tid & 63, r32 = lane & 31, hi = lane >> 5, wid = __builtin_amdgcn_readfirstlane(tid >> 6);
    const int qw = q0 + wid * 32;
    int tlo = 0, thi = L / 64;
    if (WIN) { const int a = q0 - W; tlo = a > 0 ? a / 64 : 0; const int b = q0 + 256 + W; thi = (b < L ? b : L) / 64; }
    bf16x8 qr[4];
    { const bf16_t* qrow = Qp + (size_t)(qw + r32) * pitch + hi * 8;
#pragma unroll
      for (int d0 = 0; d0 < 4; ++d0) qr[d0] = *(const bf16x8*)(qrow + d0 * 16); }
    f32x16 o[ND];
#pragma unroll
    for (int d = 0; d < ND; ++d)
#pragma unroll
        for (int r = 0; r < 16; ++r) o[d][r] = 0.f;
    float m = m_init, l = hi == 0 ? l_init : 0.f;
    LAS float* wsf = (LAS float*)(lds + 6 * (64 * KSTR + 64 * (VD * 2 + 64))) + wid * 64;
    static_assert(VD == 64, "grouped staging is sized for 64-wide values");
    constexpr int SLOT = 64 * KSTR + 64 * VSTR, GRP = 6;
    const int krow = tid >> 3, kch = tid & 7;
    const float Wf = (float)W;
    for (int g0 = tlo; g0 < thi; g0 += GRP) {
        const int ng = thi - g0 < GRP ? thi - g0 : GRP;
        u32x4 kr[GRP], vr[GRP];
#pragma unroll
        for (int j = 0; j < GRP; ++j) if (j < ng) { kr[j] = *(const u32x4*)(Kp + (size_t)(64 * (g0 + j) + krow) * pitch + kch * 8); vr[j] = *(const u32x4*)(Vp + (size_t)(64 * (g0 + j) + krow) * pitch + kch * 8); }
        if (g0 != tlo) __syncthreads();
#pragma unroll
        for (int j = 0; j < GRP; ++j) if (j < ng) { *(LAS u32x4*)(lds + j * SLOT + krow * KSTR + kch * 16) = kr[j]; *(LAS u32x4*)(lds + j * SLOT + 64 * KSTR + krow * VSTR + kch * 16) = vr[j]; }
        __syncthreads();
      for (int j = 0; j < ng; ++j) {
        const int t = g0 + j;
        bool active = true;
        if (WIN) { const int kb = 64 * t; active = (kb + 63 >= qw - W) && (kb <= qw + 31 + W); }
        if (active) {
            const LAS unsigned char* Kb = lds + j * SLOT + r32 * KSTR + hi * 16;
            f32x16 p0, p1;
#pragma unroll
            for (int r = 0; r < 16; ++r) { p0[r] = 0.f; p1[r] = 0.f; }
#pragma unroll
            for (int d0 = 0; d0 < 4; ++d0) {
                const bf16x8 a0 = *(const LAS bf16x8*)(Kb + d0 * 32), a1 = *(const LAS bf16x8*)(Kb + 32 * KSTR + d0 * 32);
                p0 = __builtin_amdgcn_mfma_f32_32x32x16_bf16(a0, qr[d0], p0, 0, 0, 0);
                p1 = __builtin_amdgcn_mfma_f32_32x32x16_bf16(a1, qr[d0], p1, 0, 0, 0);
                if (d0 & 1) __builtin_amdgcn_sched_barrier(0);
            }
            const float dq = (float)(64 * t + 4 * hi - (qw + r32));
            float rm = -INFINITY;
#pragma unroll
            for (int r = 0; r < 16; ++r) {
                const float t0 = dq + (float)((r & 3) + 8 * (r >> 2)), t1 = t0 + 32.f;
                p0[r] = __builtin_fmaf(-slope2, __builtin_fabsf(t0), p0[r]);
                p1[r] = __builtin_fmaf(-slope2, __builtin_fabsf(t1), p1[r]);
                if (WIN) { if (__builtin_fabsf(t0) > Wf) p0[r] = -INFINITY; if (__builtin_fabsf(t1) > Wf) p1[r] = -INFINITY; }
                rm = __builtin_fmaxf(rm, __builtin_fmaxf(p0[r], p1[r]));
            }
            rm = __builtin_fmaxf(rm, __shfl_xor(rm, 32));
            if (__any(rm > m)) {
                const float mn = __builtin_fmaxf(m, rm); const float f = __builtin_amdgcn_exp2f(m - mn); m = mn; l *= f;
                if (hi == 0) wsf[r32] = f;
#pragma unroll
                for (int r = 0; r < 16; ++r) { const float fr = wsf[crow(r, hi)];
#pragma unroll
                    for (int d = 0; d < ND; ++d) o[d][r] *= fr; }
            }
            float ls = 0.f;
#pragma unroll
            for (int r = 0; r < 16; ++r) { p0[r] = __builtin_amdgcn_exp2f(p0[r] - m); p1[r] = __builtin_amdgcn_exp2f(p1[r] - m); ls += p0[r] + p1[r]; }
            l += ls;
            u32x4 pw[4];
#pragma unroll
            for (int c = 0; c < 4; ++c) {
                const f32x16& P = (c >> 1) ? p1 : p0; const int b = 8 * (c & 1);
                pw[c].x = cvt_pk(P[b + 0], P[b + 1]); pw[c].y = cvt_pk(P[b + 2], P[b + 3]); pw[c].z = cvt_pk(P[b + 4], P[b + 5]); pw[c].w = cvt_pk(P[b + 6], P[b + 7]);
            }
            const LAS unsigned char* Vb = lds + j * SLOT + 64 * KSTR + (4 * hi + ((lane & 15) >> 2)) * VSTR + (16 * ((lane >> 4) & 1) + 4 * (lane & 3)) * 2;
#pragma unroll
            for (int c = 0; c < 4; ++c)
#pragma unroll
                for (int d = 0; d < ND; ++d) {
                    const s16x4 vlo = vtr(Vb + c * 16 * VSTR + d * 64), vhi = vtr(Vb + c * 16 * VSTR + 8 * VSTR + d * 64);
                    const bf16x8 vf = (bf16x8){vlo[0], vlo[1], vlo[2], vlo[3], vhi[0], vhi[1], vhi[2], vhi[3]};
                    o[d] = __builtin_amdgcn_mfma_f32_32x32x16_bf16(__builtin_bit_cast(bf16x8, pw[c]), vf, o[d], 0, 0, 0);
                    if (d == ND - 1) __builtin_amdgcn_sched_barrier(0);
                }
        }
      }
    }
    l += __shfl_xor(l, 32);
    if (hi == 0) wsf[r32] = 1.f / l;
#pragma unroll
    for (int r = 0; r < 16; ++r) { const float ir = wsf[crow(r, hi)];
        if (Obf != nullptr) { bf16_t* orow = Obf + (size_t)(qw + crow(r, hi)) * opitch + r32;
#pragma unroll
            for (int d = 0; d < ND; ++d) orow[d * 32] = (bf16_t)f2bf(o[d][r] * ir);
        } else { float* orow = Oout + (size_t)(qw + crow(r, hi)) * opitch + r32;
#pragma unroll
            for (int d = 0; d < ND; ++d) orow[d * 32] = o[d][r] * ir; } }
    if (lse_out != nullptr && hi == 0) lse_out[(size_t)(qw + r32) * lpitch] = (m + __builtin_log2f(l)) * LN2;
    __syncthreads();
}

__device__ __forceinline__ void row_to_bf16_ssq(const float* xrow, bf16_t* orow, float* ssq, int lane) {
    const f32x4* xr = (const f32x4*)xrow + lane;
    f32x4 v[4]; float s = 0.f;
#pragma unroll
    for (int j = 0; j < 4; ++j) { v[j] = xr[64 * j]; s += (v[j].x * v[j].x + v[j].y * v[j].y) + (v[j].z * v[j].z + v[j].w * v[j].w); }
    s = wave_sum(s);
    u32x2* o8 = (u32x2*)orow + lane;
#pragma unroll
    for (int j = 0; j < 4; ++j) { u32x2 w; w.x = pk2(v[j].x, v[j].y); w.y = pk2(v[j].z, v[j].w); o8[64 * j] = w; }
    if (lane == 0) *ssq = s;
}
constexpr int BK_OFF = 0, BV_OFF = 2 * 64 * KSTR, BSCR_OFF = BV_OFF + 3 * 64 * 320, ATT_O0_OFF = BSCR_OFF + 2048;
static_assert(ATT_O0_OFF + 65536 <= 147456, "B attention LDS map");
constexpr float B_THR = 6.0f;
#ifndef B_LATE
#define B_LATE(w) false
#endif
template <int KI> __device__ __forceinline__ float fmamk_t(float a, float c) { float r; asm("v_fmamk_f32 %0, %1, %3, %2" : "=v"(r) : "v"(a), "v"(c), "n"(__builtin_bit_cast(int, (float)KI))); return r; }
__device__ __forceinline__ float max3f(float a, float b, float c) { float r; asm("v_max3_f32 %0, %1, %2, %3" : "=v"(r) : "v"(a), "v"(b), "v"(c)); return r; }
__device__ __forceinline__ void attn_b_unit(LAS unsigned char* lds, const bf16_t* base, int h, int q0, int L, float slope2_, float lam,
                                            const float* subln_l, float postscale, bf16_t* mix) {
    constexpr int VD = 128, VSTR = VD * 2 + 64, ND = 4, VCH = 16, VLD = 2;
    int tid_l = threadIdx.x; asm volatile("" : "+v"(tid_l)); const int tid = tid_l, lane = tid & 63, r32 = lane & 31, hi = lane >> 5, wid = __builtin_amdgcn_readfirstlane(tid >> 6);
    const int qw = q0 + wid * 32, NT = L / 64, c0 = q0 / 64;
    LAS float* wsf = (LAS float*)(lds + BSCR_OFF) + wid * 64;
    const bool late = B_LATE(wid);
    const int krow = tid >> 3, kch = tid & 7;
    const bf16_t* Vp = base + 1536 + h * 128;
    const float qposf_ = (float)(qw + r32);
    for (int mp = 0; mp < 2; ++mp) {
        const bf16_t* Qp = base + 512 + (h * 2 + mp) * 64; const bf16_t* Kp = base + 1024 + (h * 2 + mp) * 64;
        bf16x8 qr[4];
        { const bf16_t* qrow = Qp + (size_t)(qw + r32) * DIN + hi * 8;
#pragma unroll
          for (int d0 = 0; d0 < 4; ++d0) qr[d0] = *(const bf16x8*)(qrow + d0 * 16); }
        f32x16 o[ND];
#pragma unroll
        for (int d = 0; d < ND; ++d)
#pragma unroll
            for (int r = 0; r < 16; ++r) o[d][r] = 0.f;
        float mref = 0.f, l = 0.f;
        u32x4 kreg; u32x4 vreg[VLD];
        const unsigned koff = (unsigned)(krow * DIN + kch * 8) * 2u, voff = (unsigned)((tid >> 4) * DIN + (tid & 15) * 8) * 2u;
#define ATT_GLOAD(t) do { const char* kt_ = (const char*)Kp + (size_t)(t) * (64 * DIN * 2); const char* vt_ = (const char*)Vp + (size_t)(t) * (64 * DIN * 2); \
        kreg = *(const u32x4*)(kt_ + koff); vreg[0] = *(const u32x4*)(vt_ + voff); vreg[1] = *(const u32x4*)(vt_ + 32 * DIN * 2 + voff); } while (0)
#define ATT_LSTORE(b, vs) do { *(LAS u32x4*)(lds + BK_OFF + (b) * 64 * KSTR + krow * KSTR + kch * 16) = kreg; \
        *(LAS u32x4*)(lds + BV_OFF + (vs) * 64 * VSTR + (tid >> 4) * VSTR + (tid & 15) * 16) = vreg[0]; *(LAS u32x4*)(lds + BV_OFF + (vs) * 64 * VSTR + ((tid >> 4) + 32) * VSTR + (tid & 15) * 16) = vreg[1]; } while (0)
#define VFRAG(x, d) (bf16x8){x[d][0][0], x[d][0][1], x[d][0][2], x[d][0][3], x[d][1][0], x[d][1][1], x[d][1][2], x[d][1][3]}
#define PV_LOAD01(vs) do { \
        const LAS unsigned char* Vb = lds + BV_OFF + (vs) * 64 * VSTR + (4 * hi + ((lane & 15) >> 2)) * VSTR + (16 * ((lane >> 4) & 1) + 4 * (lane & 3)) * 2; \
        _Pragma("unroll") for (int d = 0; d < ND; ++d) { va[d][0] = vtr(Vb + d * 64); va[d][1] = vtr(Vb + 8 * VSTR + d * 64); } \
        _Pragma("unroll") for (int d = 0; d < ND; ++d) { vb2[d][0] = vtr(Vb + 16 * VSTR + d * 64); vb2[d][1] = vtr(Vb + 16 * VSTR + 8 * VSTR + d * 64); } \
        __builtin_amdgcn_sched_barrier(0); } while (0)
#define PV_MMA(vs) do { \
        const LAS unsigned char* Vb = lds + BV_OFF + (vs) * 64 * VSTR + (4 * hi + ((lane & 15) >> 2)) * VSTR + (16 * ((lane >> 4) & 1) + 4 * (lane & 3)) * 2; \
        _Pragma("unroll") for (int d = 0; d < ND; ++d) o[d] = __builtin_amdgcn_mfma_f32_32x32x16_bf16(__builtin_bit_cast(bf16x8, pw[0]), VFRAG(va, d), o[d], 0, 0, 0); \
        __builtin_amdgcn_sched_barrier(0); \
        _Pragma("unroll") for (int d = 0; d < ND; ++d) { va[d][0] = vtr(Vb + 32 * VSTR + d * 64); va[d][1] = vtr(Vb + 32 * VSTR + 8 * VSTR + d * 64); } \
        __builtin_amdgcn_sched_barrier(0); \
        _Pragma("unroll") for (int d = 0; d < ND; ++d) o[d] = __builtin_amdgcn_mfma_f32_32x32x16_bf16(__builtin_bit_cast(bf16x8, pw[1]), VFRAG(vb2, d), o[d], 0, 0, 0); \
        __builtin_amdgcn_sched_barrier(0); \
        _Pragma("unroll") for (int d = 0; d < ND; ++d) { vb2[d][0] = vtr(Vb + 48 * VSTR + d * 64); vb2[d][1] = vtr(Vb + 48 * VSTR + 8 * VSTR + d * 64); } \
        __builtin_amdgcn_sched_barrier(0); \
        _Pragma("unroll") for (int d = 0; d < ND; ++d) o[d] = __builtin_amdgcn_mfma_f32_32x32x16_bf16(__builtin_bit_cast(bf16x8, pw[2]), VFRAG(va, d), o[d], 0, 0, 0); \
        _Pragma("unroll") for (int d = 0; d < ND; ++d) o[d] = __builtin_amdgcn_mfma_f32_32x32x16_bf16(__builtin_bit_cast(bf16x8, pw[3]), VFRAG(vb2, d), o[d], 0, 0, 0); \
        __builtin_amdgcn_sched_barrier(0); } while (0)
        int first = 1; asm volatile("" : "+s"(first));
#define B_TILE(i_) ((i_) < 4 ? c0 + (i_) : ((i_) - 4 < c0 ? (i_) - 4 : (i_)))
        int t = B_TILE(0);
        int vs_prev = 2, vs_cur = 0, vs_next = 1;
        u32x4 pw[4];
        ATT_GLOAD(t); ATT_LSTORE(0, 0); __syncthreads();
        for (int i = 0; i < NT; ++i) {
            const int buf = i & 1;
            int tn = 0;
            if (i + 1 < NT) { tn = B_TILE(i + 1); ATT_GLOAD(tn); }
            f32x16 p0, p1;
            const int kb = 64 * t;
            float slope2 = slope2_, qposf = qposf_; asm volatile("" : "+v"(slope2), "+v"(qposf));
            const LAS unsigned char* Kb = lds + BK_OFF + buf * 64 * KSTR + r32 * KSTR + hi * 16;
            bf16x8 kf[8];
#pragma unroll
            for (int d0 = 0; d0 < 4; ++d0) { kf[d0] = *(const LAS bf16x8*)(Kb + d0 * 32); kf[4 + d0] = *(const LAS bf16x8*)(Kb + 32 * KSTR + d0 * 32); }
            const LAS unsigned char* Vb = lds + BV_OFF + vs_cur * 64 * VSTR + (4 * hi + ((lane & 15) >> 2)) * VSTR + (16 * ((lane >> 4) & 1) + 4 * (lane & 3)) * 2;
            s16x4 va[ND][2], vb2[ND][2];
            const bool offdiag = (kb + 63 < qw || kb > qw + 31);
            const float dq = (float)(kb + 4 * hi) - qposf;
#define QK_P0(INIT0, INIT1) do { \
            _Pragma("unroll") for (int r = 0; r < 16; ++r) { const float kv = (float)((r & 3) + 8 * (r >> 2)); p0[r] = INIT0; } \
            __builtin_amdgcn_sched_barrier(0); \
            _Pragma("unroll") for (int d0 = 0; d0 < 4; ++d0) { \
                p0 = __builtin_amdgcn_mfma_f32_32x32x16_bf16(kf[d0], qr[d0], p0, 0, 0, 0); \
                _Pragma("unroll") for (int r = 4 * d0; r < 4 * d0 + 4; ++r) { const float kv = (float)((r & 3) + 8 * (r >> 2) + 32); p1[r] = INIT1; } \
                __builtin_amdgcn_sched_barrier(0); } } while (0)
            if (offdiag) {
                const float sg = (kb > qw) ? -slope2 : slope2, b0 = sg * dq - mref;
                p0[0] = fmamk_t<0>(sg, b0); p0[1] = fmamk_t<1>(sg, b0); p0[2] = fmamk_t<2>(sg, b0); p0[3] = fmamk_t<3>(sg, b0); p0[4] = fmamk_t<8>(sg, b0); p0[5] = fmamk_t<9>(sg, b0); p0[6] = fmamk_t<10>(sg, b0); p0[7] = fmamk_t<11>(sg, b0); p0[8] = fmamk_t<16>(sg, b0); p0[9] = fmamk_t<17>(sg, b0); p0[10] = fmamk_t<18>(sg, b0); p0[11] = fmamk_t<19>(sg, b0); p0[12] = fmamk_t<24>(sg, b0); p0[13] = fmamk_t<25>(sg, b0); p0[14] = fmamk_t<26>(sg, b0); p0[15] = fmamk_t<27>(sg, b0);
                __builtin_amdgcn_sched_barrier(0);
                p0 = __builtin_amdgcn_mfma_f32_32x32x16_bf16(kf[0], qr[0], p0, 0, 0, 0); p1[0] = fmamk_t<32>(sg, b0); p1[1] = fmamk_t<33>(sg, b0); p1[2] = fmamk_t<34>(sg, b0); p1[3] = fmamk_t<35>(sg, b0); __builtin_amdgcn_sched_barrier(0);
                p0 = __builtin_amdgcn_mfma_f32_32x32x16_bf16(kf[1], qr[1], p0, 0, 0, 0); p1[4] = fmamk_t<40>(sg, b0); p1[5] = fmamk_t<41>(sg, b0); p1[6] = fmamk_t<42>(sg, b0); p1[7] = fmamk_t<43>(sg, b0); __builtin_amdgcn_sched_barrier(0);
                p0 = __builtin_amdgcn_mfma_f32_32x32x16_bf16(kf[2], qr[2], p0, 0, 0, 0); p1[8] = fmamk_t<48>(sg, b0); p1[9] = fmamk_t<49>(sg, b0); p1[10] = fmamk_t<50>(sg, b0); p1[11] = fmamk_t<51>(sg, b0); __builtin_amdgcn_sched_barrier(0);
                p0 = __builtin_amdgcn_mfma_f32_32x32x16_bf16(kf[3], qr[3], p0, 0, 0, 0); p1[12] = fmamk_t<56>(sg, b0); p1[13] = fmamk_t<57>(sg, b0); p1[14] = fmamk_t<58>(sg, b0); p1[15] = fmamk_t<59>(sg, b0); __builtin_amdgcn_sched_barrier(0);
            } else {
                const float nmref = -mref;
                QK_P0(__builtin_fmaf(-slope2, __builtin_fabsf(dq + kv), nmref), __builtin_fmaf(-slope2, __builtin_fabsf(dq + kv), nmref));
            }
#undef QK_P0
#pragma unroll
            for (int d = 0; d < ND; ++d) { va[d][0] = vtr(Vb + d * 64); va[d][1] = vtr(Vb + 8 * VSTR + d * 64); }
#pragma unroll
            for (int d = 0; d < ND; ++d) { vb2[d][0] = vtr(Vb + 16 * VSTR + d * 64); vb2[d][1] = vtr(Vb + 16 * VSTR + 8 * VSTR + d * 64); }
            __builtin_amdgcn_sched_barrier(0);
#pragma unroll
            for (int d0 = 0; d0 < 4; ++d0) p1 = __builtin_amdgcn_mfma_f32_32x32x16_bf16(kf[4 + d0], qr[d0], p1, 0, 0, 0);
            __builtin_amdgcn_sched_barrier(0);
            float rm, rmb;
            asm volatile("s_nop 15\n\ts_nop 7\n\tv_max3_f32 %0, %1, %2, %3\n\tv_max3_f32 %0, %0, %4, %5\n\tv_max3_f32 %0, %0, %6, %7\n\tv_max3_f32 %0, %0, %8, %9\n\t"
                         "v_max3_f32 %0, %0, %10, %11\n\tv_max3_f32 %0, %0, %12, %13\n\tv_max3_f32 %0, %0, %14, %15\n\tv_max3_f32 %0, %0, %16, %16"
                         : "=&v"(rm) : "v"(p0[0]), "v"(p0[1]), "v"(p0[2]), "v"(p0[3]), "v"(p0[4]), "v"(p0[5]), "v"(p0[6]), "v"(p0[7]), "v"(p0[8]), "v"(p0[9]), "v"(p0[10]), "v"(p0[11]), "v"(p0[12]), "v"(p0[13]), "v"(p0[14]), "v"(p0[15]));
            asm volatile("v_max3_f32 %0, %1, %2, %3\n\tv_max3_f32 %0, %0, %4, %5\n\tv_max3_f32 %0, %0, %6, %7\n\tv_max3_f32 %0, %0, %8, %9\n\t"
                         "v_max3_f32 %0, %0, %10, %11\n\tv_max3_f32 %0, %0, %12, %13\n\tv_max3_f32 %0, %0, %14, %15\n\tv_max3_f32 %0, %0, %16, %16"
                         : "=&v"(rmb) : "v"(p1[0]), "v"(p1[1]), "v"(p1[2]), "v"(p1[3]), "v"(p1[4]), "v"(p1[5]), "v"(p1[6]), "v"(p1[7]), "v"(p1[8]), "v"(p1[9]), "v"(p1[10]), "v"(p1[11]), "v"(p1[12]), "v"(p1[13]), "v"(p1[14]), "v"(p1[15]));
            rm = __builtin_fmaxf(rm, rmb);
            { auto rr_ = __builtin_amdgcn_permlane32_swap(__float_as_uint(rm), __float_as_uint(rm), false, false); rm = __builtin_fmaxf(__uint_as_float(rr_[0]), __uint_as_float(rr_[1])); }
            if (first || __any(rm > B_THR)) {
                const float delta = (first || rm > B_THR) ? rm : 0.f; const float f = __builtin_amdgcn_exp2f(-delta); mref += delta; l *= f;
#pragma unroll
                for (int r = 0; r < 16; ++r) { p0[r] -= delta; p1[r] -= delta; }
                {
                    if (hi == 0) wsf[r32] = f;
#pragma unroll
                    for (int r = 0; r < 16; ++r) { const float fr = wsf[crow(r, hi)];
#pragma unroll
                        for (int d = 0; d < ND; ++d) o[d][r] *= fr; }
                }
            }
            float ls0 = 0.f, ls1 = 0.f;
#pragma unroll
            for (int r = 0; r < 16; ++r) { p0[r] = __builtin_amdgcn_exp2f(p0[r]); ls0 += p0[r]; }
            pw[0].x = cvt_pk(p0[0], p0[1]); pw[0].y = cvt_pk(p0[2], p0[3]); pw[0].z = cvt_pk(p0[4], p0[5]); pw[0].w = cvt_pk(p0[6], p0[7]);
            pw[1].x = cvt_pk(p0[8], p0[9]); pw[1].y = cvt_pk(p0[10], p0[11]); pw[1].z = cvt_pk(p0[12], p0[13]); pw[1].w = cvt_pk(p0[14], p0[15]);
            __builtin_amdgcn_sched_barrier(0);
#define VFRAG(x, d) (bf16x8){x[d][0][0], x[d][0][1], x[d][0][2], x[d][0][3], x[d][1][0], x[d][1][1], x[d][1][2], x[d][1][3]}
#pragma unroll
            for (int d = 0; d < ND; ++d) {
                o[d] = __builtin_amdgcn_mfma_f32_32x32x16_bf16(__builtin_bit_cast(bf16x8, pw[0]), VFRAG(va, d), o[d], 0, 0, 0);
                p1[2 * d] = __builtin_amdgcn_exp2f(p1[2 * d]); p1[2 * d + 1] = __builtin_amdgcn_exp2f(p1[2 * d + 1]); ls1 += p1[2 * d]; ls0 += p1[2 * d + 1];
                __builtin_amdgcn_sched_barrier(0);
            }
#pragma unroll
            for (int d = 0; d < ND; ++d) { va[d][0] = vtr(Vb + 32 * VSTR + d * 64); va[d][1] = vtr(Vb + 32 * VSTR + 8 * VSTR + d * 64); }
            __builtin_amdgcn_sched_barrier(0);
#pragma unroll
            for (int d = 0; d < ND; ++d) {
                o[d] = __builtin_amdgcn_mfma_f32_32x32x16_bf16(__builtin_bit_cast(bf16x8, pw[1]), VFRAG(vb2, d), o[d], 0, 0, 0);
                p1[8 + 2 * d] = __builtin_amdgcn_exp2f(p1[8 + 2 * d]); p1[8 + 2 * d + 1] = __builtin_amdgcn_exp2f(p1[8 + 2 * d + 1]); ls1 += p1[8 + 2 * d]; ls0 += p1[8 + 2 * d + 1];
                __builtin_amdgcn_sched_barrier(0);
            }
#pragma unroll
            for (int d = 0; d < ND; ++d) { vb2[d][0] = vtr(Vb + 48 * VSTR + d * 64); vb2[d][1] = vtr(Vb + 48 * VSTR + 8 * VSTR + d * 64); }
            if (i + 1 < NT) ATT_LSTORE(buf ^ 1, vs_next);
            l += ls0 + ls1;
            pw[2].x = cvt_pk(p1[0], p1[1]); pw[2].y = cvt_pk(p1[2], p1[3]); pw[2].z = cvt_pk(p1[4], p1[5]); pw[2].w = cvt_pk(p1[6], p1[7]);
            __builtin_amdgcn_sched_barrier(0);
#pragma unroll
            for (int d = 0; d < ND; ++d) {
                o[d] = __builtin_amdgcn_mfma_f32_32x32x16_bf16(__builtin_bit_cast(bf16x8, pw[2]), VFRAG(va, d), o[d], 0, 0, 0);
                if (d == 0) { pw[3].x = cvt_pk(p1[8], p1[9]); pw[3].y = cvt_pk(p1[10], p1[11]); } else if (d == 1) { pw[3].z = cvt_pk(p1[12], p1[13]); pw[3].w = cvt_pk(p1[14], p1[15]); }
                __builtin_amdgcn_sched_barrier(0);
            }
#pragma unroll
            for (int d = 0; d < ND; ++d) o[d] = __builtin_amdgcn_mfma_f32_32x32x16_bf16(__builtin_bit_cast(bf16x8, pw[3]), VFRAG(vb2, d), o[d], 0, 0, 0);
#undef VFRAG
            __builtin_amdgcn_sched_barrier(0);
            first = 0;
            t = tn;
            { const int tmp_ = vs_prev; vs_prev = vs_cur; vs_cur = vs_next; vs_next = tmp_; }
            __syncthreads();
        }
#undef PV_LOAD01
#undef PV_MMA
#undef B_TILE
#undef VFRAG
#undef ATT_GLOAD
#undef ATT_LSTORE
        l += __shfl_xor(l, 32);
        if (hi == 0) wsf[r32] = 1.f / l;
        int lane_e = lane, qw_e = qw; asm volatile("" : "+v"(lane_e)); asm volatile("" : "+s"(qw_e));
        const int r32 = lane_e & 31, hi = lane_e >> 5, qw = qw_e;
        LAS unsigned* o0buf = (LAS unsigned*)(lds + ATT_O0_OFF) + wid * 2048 + lane_e;
        if (mp == 0) {
#pragma unroll
            for (int d = 0; d < ND; ++d)
#pragma unroll
                for (int r = 0; r < 16; r += 2) { const float i0 = wsf[crow(r, hi)], i1 = wsf[crow(r + 1, hi)]; o0buf[(d * 8 + (r >> 1)) * 64] = cvt_pk(o[d][r] * i0, o[d][r + 1] * i1); }
        } else {
            float gs[ND];
#pragma unroll
            for (int d = 0; d < ND; ++d) gs[d] = subln_l[d * 32 + r32] * postscale;
#pragma unroll
            for (int r = 0; r < 16; r += 2) {
                const float i0 = wsf[crow(r, hi)], i1 = wsf[crow(r + 1, hi)];
                float v0[ND], v1[ND]; float s0 = 0.f, s1 = 0.f;
#pragma unroll
                for (int d = 0; d < ND; ++d) { const unsigned w = o0buf[(d * 8 + (r >> 1)) * 64];
                    v0[d] = __builtin_bit_cast(float, w << 16) - lam * (o[d][r] * i0); v1[d] = __builtin_bit_cast(float, w & 0xffff0000u) - lam * (o[d][r + 1] * i1);
                    s0 += v0[d] * v0[d]; s1 += v1[d] * v1[d]; }
#pragma unroll
                for (int sh = 1; sh < 32; sh <<= 1) { s0 += __shfl_xor(s0, sh); s1 += __shfl_xor(s1, sh); }
                const float r0 = 1.f / sqrtf(s0 * (1.f / 128.f) + 1e-5f), r1 = 1.f / sqrtf(s1 * (1.f / 128.f) + 1e-5f);
                bf16_t* row0 = mix + (size_t)(qw + crow(r, hi)) * DM + r32; bf16_t* row1 = mix + (size_t)(qw + crow(r + 1, hi)) * DM + r32;
#pragma unroll
                for (int d = 0; d < ND; ++d) { row0[d * 32] = (bf16_t)f2bf(v0[d] * r0 * gs[d]); row1[d * 32] = (bf16_t)f2bf(v1[d] * r1 * gs[d]); }
            }
        }
        __syncthreads();
    }
}
__device__ __forceinline__ float alibi_slope(int i, int n) { return exp2f(-8.0f * (float)(i + 1) / (float)n); }
struct Ctx { int tid, lane, wave, G, cu, gw, NGW; };

__device__ __forceinline__ void ph_weights(const Args& a, LAS unsigned char* lds, int l, int gw0, int nw, int wave, int lane) {
    unsigned char* ws = a.ws;
    bf16_t* WinT = (bf16_t*)(ws + WS_WIN); bf16_t* WoutT = (bf16_t*)(ws + WS_WOUT); bf16_t* WupT = (bf16_t*)(ws + WS_WUP); bf16_t* WdnT = (bf16_t*)(ws + WS_WDN);
    const float* w_in = a.in[3]; const float* w_out = a.in[10]; const float* w_up = a.in[12]; const float* w_down = a.in[15];
    LAS float* scr = (LAS float*)(lds + wave * 16896);
    constexpr int I_IN = (DM / 64) * (DIN / 64), I_OUT = (DM / 64) * (DM / 64), I_UP = (DM / 64) * (DUP / 64), I_DN = (DFF / 64) * (DM / 64);
    constexpr int PER_L = I_IN + I_OUT + I_UP + I_DN;
    for (int it = gw0; it < PER_L; it += nw) {
        int r = it;
        if (r < I_IN) { transpose_item(w_in + (size_t)l * DM * DIN, DM, DIN, WinT + (size_t)l * DIN * DM, scr, r, lane, a.in[2] + l * DM); continue; } r -= I_IN;
        if (r < I_OUT) { transpose_item(w_out + (size_t)l * DM * DM, DM, DM, WoutT + (size_t)l * DM * DM, scr, r, lane, nullptr); continue; } r -= I_OUT;
        if (r < I_UP) { transpose_item(w_up + (size_t)l * DM * DUP, DM, DUP, WupT + (size_t)l * DUP * DM, scr, r, lane, a.in[11] + l * DM, true); continue; } r -= I_UP;
        transpose_item(w_down + (size_t)l * DFF * DM, DFF, DM, WdnT + (size_t)l * DM * DFF, scr, r, lane, nullptr);
    }
}
__device__ __forceinline__ const float* chunk_in(const Args& a, int ch) { return ch == 0 ? a.in[0] : a.in[1] + (size_t)(ch - 1) * CH_ROWS * DM; }
__device__ __forceinline__ float* chunk_out(const Args& a, int ch) { return a.out + (size_t)ch * CH_ROWS * DM; }

__device__ __forceinline__ void ph_norm_bf16(const Ctx& c, const float* xsrc, const float* gain, bf16_t* HB) {
    for (int r = c.gw; r < CH_ROWS; r += c.NGW) rms_row_to_bf16(xsrc + (size_t)r * DM, gain, HB + (size_t)r * DM, c.lane);
}
__device__ __forceinline__ void ph_final_norm(const Ctx& c, float* xo, const float* gain) {
    for (int r = c.gw; r < CH_ROWS; r += c.NGW) rms_row_f32(xo + (size_t)r * DM, gain, c.lane);
}

__device__ __forceinline__ void ph_attn(const Args& a, const Ctx& c, LAS unsigned char* lds, int ch, int layer) {
    const bf16_t* PROJ = (const bf16_t*)(a.ws + WS_PROJ); float* TMP = (float*)(a.ws + WS_TMP);
    const int SL = ch == 0 ? 16384 : 4096, sl_shift = ch == 0 ? 14 : 12;
    const int cu = c.cu, G = c.G;
#ifndef SKIP_B
    {
        const float lam_init = layer == 0 ? 0.2f : (0.8f - 0.6f * 0.7408182206817179f);
        const float s1 = wave_sum(a.in[5][layer * 64 + c.lane] * a.in[6][layer * 64 + c.lane]);
        const float s2 = wave_sum(a.in[7][layer * 64 + c.lane] * a.in[8][layer * 64 + c.lane]);
        const float lam = expf(s1) - expf(s2) + lam_init;
        bf16_t* HBm = (bf16_t*)(a.ws + WS_HB);
#ifdef PROBE_B2
        for (int rep_ = 0; rep_ < 2; ++rep_)
#endif
        for (int u = cu; u < 256; u += G) {
            int seq, h, qb; const int xcd = u & 7, idx = u >> 3;
            if (ch == 0) { seq = 0; h = xcd >> 1; qb = (xcd & 1) * 32 + idx; }
            else { const int pair = xcd * 2 + (idx >> 4); seq = pair >> 2; h = pair & 3; qb = idx & 15; }
            const size_t rb = (size_t)seq * SL;
            attn_b_unit(lds, PROJ + rb * DIN, h, qb * 256, SL, alibi_slope(h, 4) * LOG2E, lam, a.in[9] + layer * 128, 1.f - lam_init, HBm + rb * DM + 256 + h * 128);
        }
    }
#endif
#ifndef SKIP_AC
#ifdef PROBE_AC2
    for (int rep_ = 0; rep_ < 2; ++rep_)
#endif
    for (int uu = cu; uu < 1024; uu += G) {
        const bf16_t *qp, *kp, *vp; size_t pitch, opitch, lpitch; int q0, L, W; float slope2, m_init, l_init; float *op, *lp; bf16_t* obf;
        if (uu < 256) {
            const int hq = uu >> 6, blk = uu & 63;
            const int seq = (blk * 256) >> sl_shift, qb = blk - ((seq << sl_shift) >> 8);
            const size_t rb = (size_t)seq * SL; const bf16_t* base = PROJ + rb * DIN;
            qp = base + hq * 64; kp = base + 256 + (hq >> 1) * 64; vp = base + 384 + (hq >> 1) * 64; pitch = DIN; q0 = qb * 256; L = SL;
            slope2 = alibi_slope(hq, 4) * LOG2E; W = 128; m_init = a.in[4][layer * 4 + hq] * LOG2E; l_init = 1.f;
            op = nullptr; obf = (bf16_t*)(a.ws + WS_HB) + rb * DM + hq * 64; opitch = DM; lp = nullptr; lpitch = 0;
        } else {
            const int uc = uu - 256;
            const int gh = uc >> 6, blk = uc & 63, gq = gh >> 2;
            const int dsh = 2 * gq, d = 1 << dsh;
            const int seq = (blk * 256) >> sl_shift, b2 = blk - ((seq << sl_shift) >> 8);
            const int nbr = (SL >> dsh) >> 8;
            const int res = b2 / nbr, qb = b2 % nbr;
            const size_t rb = (size_t)seq * SL + res; const bf16_t* base = PROJ + rb * DIN;
            qp = base + 2048 + gh * 64; kp = base + 2816 + gh * 64; vp = base + 3584 + gh * 64; pitch = (size_t)DIN * d; q0 = qb * 256; L = SL >> dsh;
            slope2 = alibi_slope(gh, 12) * (float)d * LOG2E; W = 64; m_init = -1e30f; l_init = 0.f;
            op = nullptr; obf = (bf16_t*)TMP + rb * 768 + gh * 64; opitch = (size_t)768 * d; lp = TMP + 8 * 1024 * 1024 + rb * 16 + gh; lpitch = (size_t)16 * d;
        }
        attn_unit<64, true>(lds, qp, kp, vp, pitch, q0, L, slope2, W, m_init, l_init, op, opitch, lp, lpitch, obf);
    }
#endif
}

__device__ __forceinline__ void ph_combine(const Args& a, const Ctx& c, int layer) {
    const float* TMP = (const float*)(a.ws + WS_TMP); bf16_t* HB = (bf16_t*)(a.ws + WS_HB);
    { float* S2 = (float*)(a.ws + WS_SSQ) + 2 * CH_ROWS; for (int r = c.cu * NTHREADS + c.tid; r < CH_ROWS; r += c.G * NTHREADS) S2[r] = 0.f; }
    const int nitems = CH_ROWS * 32;
#pragma unroll 2
    for (int it = c.cu * NTHREADS + c.tid; it < nitems; it += c.G * NTHREADS) {
        const int r = it >> 5, h = (it >> 3) & 3, d8 = (it & 7) * 8;
        const bf16_t* tr = (const bf16_t*)TMP + (size_t)r * 768; const float* lr = TMP + 8 * 1024 * 1024 + (size_t)r * 16;
        const float l0 = lr[h], l1 = lr[4 + h], l2 = lr[8 + h];
        const u32x4 ua = *(const u32x4*)(tr + h * 64 + d8), ub = *(const u32x4*)(tr + (4 + h) * 64 + d8), uc = *(const u32x4*)(tr + (8 + h) * 64 + d8);
#define BF_LO(w) __builtin_bit_cast(float, (w) << 16)
#define BF_HI(w) __builtin_bit_cast(float, (w) & 0xffff0000u)
        const f32x4 a0 = (f32x4){BF_LO(ua.x), BF_HI(ua.x), BF_LO(ua.y), BF_HI(ua.y)}, a1 = (f32x4){BF_LO(ua.z), BF_HI(ua.z), BF_LO(ua.w), BF_HI(ua.w)};
        const f32x4 b0 = (f32x4){BF_LO(ub.x), BF_HI(ub.x), BF_LO(ub.y), BF_HI(ub.y)}, b1 = (f32x4){BF_LO(ub.z), BF_HI(ub.z), BF_LO(ub.w), BF_HI(ub.w)};
        const f32x4 c0 = (f32x4){BF_LO(uc.x), BF_HI(uc.x), BF_LO(uc.y), BF_HI(uc.y)}, c1 = (f32x4){BF_LO(uc.z), BF_HI(uc.z), BF_LO(uc.w), BF_HI(uc.w)};
#undef BF_LO
#undef BF_HI
        const float mx = fmaxf(l0, fmaxf(l1, l2));
        float w0 = __expf(l0 - mx), w1 = __expf(l1 - mx), w2 = __expf(l2 - mx);
        const float inv = 1.f / (w0 + w1 + w2); w0 *= inv; w1 *= inv; w2 *= inv;
        const f32x4 o0 = a0 * w0 + b0 * w1 + c0 * w2, o1 = a1 * w0 + b1 * w1 + c1 * w2;
        u32x4 o; o.x = pk2(o0.x, o0.y); o.y = pk2(o0.z, o0.w); o.z = pk2(o1.x, o1.y); o.w = pk2(o1.z, o1.w);
        *(u32x4*)(HB + (size_t)r * DM + 768 + h * 64 + d8) = o;
    }
}

__device__ __forceinline__ void ph_conv(const Args& a, const Ctx& c, int ch, int layer) {
    const int par = ch & 1;
    const bf16_t* UB = (const bf16_t*)(a.ws + WS_PROJ); bf16_t* GB = (bf16_t*)(a.ws + WS_TMP);
    const int SL = ch == 0 ? 16384 : 4096;
    const float* cw = a.in[13] + (size_t)layer * 3 * DUP; const float* cb = a.in[14] + (size_t)layer * DUP;
    constexpr int NCG = DFF / 8, RB = 16;
    const int nitems = (CH_ROWS / RB) * NCG;
    { float* S1 = (float*)(a.ws + WS_SSQ) + par * CH_ROWS; for (int r = c.cu * NTHREADS + c.tid; r < CH_ROWS; r += c.G * NTHREADS) S1[r] = 0.f; }
    for (int it = c.cu * NTHREADS + c.tid; it < nitems; it += c.G * NTHREADS) {
        const int cg8 = it % NCG, rb = it / NCG, c0 = cg8 * 8, r0 = rb * RB;
        f32x4 wg[3][2], wv[3][2], bg[2], bv[2];
#pragma unroll
        for (int k = 0; k < 3; ++k)
#pragma unroll
            for (int j = 0; j < 2; ++j) { wg[k][j] = *(const f32x4*)(cw + k * DUP + c0 + 4 * j); wv[k][j] = *(const f32x4*)(cw + k * DUP + DFF + c0 + 4 * j); }
#pragma unroll
        for (int j = 0; j < 2; ++j) { bg[j] = *(const f32x4*)(cb + c0 + 4 * j); bv[j] = *(const f32x4*)(cb + DFF + c0 + 4 * j); }
        const bool first = (r0 & (SL - 1)) == 0, last = ((r0 + RB) & (SL - 1)) == 0;
        const u32x4 zero = (u32x4){0u, 0u, 0u, 0u};
        const bf16_t* up = UB + (size_t)r0 * DUP + c0;
        u32x4 pg_ = first ? zero : *(const u32x4*)(up - DUP), pv_ = first ? zero : *(const u32x4*)(up - DUP + DFF);
        u32x4 cg_ = *(const u32x4*)(up), cv_ = *(const u32x4*)(up + DFF);
        bf16_t* gp = GB + (size_t)r0 * DFF + c0;
#pragma unroll 4
        for (int rr = 0; rr < RB; ++rr) {
            const bool nz = (rr == RB - 1) && last;
            const u32x4 ng_ = nz ? zero : *(const u32x4*)(up + (size_t)(rr + 1) * DUP), nv_ = nz ? zero : *(const u32x4*)(up + (size_t)(rr + 1) * DUP + DFF);
            unsigned ow[4];
#pragma unroll
            for (int w = 0; w < 4; ++w) {
                float res[2];
#pragma unroll
                for (int hh = 0; hh < 2; ++hh) {
                    const int j = 2 * w + hh, q = j >> 2, e = j & 3;
                    const float gpv = hh ? __builtin_bit_cast(float, pg_[w] & 0xffff0000u) : __builtin_bit_cast(float, pg_[w] << 16);
                    const float gcv = hh ? __builtin_bit_cast(float, cg_[w] & 0xffff0000u) : __builtin_bit_cast(float, cg_[w] << 16);
                    const float gnv = hh ? __builtin_bit_cast(float, ng_[w] & 0xffff0000u) : __builtin_bit_cast(float, ng_[w] << 16);
                    const float vpv = hh ? __builtin_bit_cast(float, pv_[w] & 0xffff0000u) : __builtin_bit_cast(float, pv_[w] << 16);
                    const float vcv = hh ? __builtin_bit_cast(float, cv_[w] & 0xffff0000u) : __builtin_bit_cast(float, cv_[w] << 16);
                    const float vnv = hh ? __builtin_bit_cast(float, nv_[w] & 0xffff0000u) : __builtin_bit_cast(float, nv_[w] << 16);
                    const float gate = gpv * wg[0][q][e] + gcv * wg[1][q][e] + gnv * wg[2][q][e] + bg[q][e];
                    const float val = vpv * wv[0][q][e] + vcv * wv[1][q][e] + vnv * wv[2][q][e] + bv[q][e];
                    res[hh] = gate * __builtin_amdgcn_rcpf(1.f + __builtin_amdgcn_exp2f(-LOG2E * gate)) * val;
                }
                ow[w] = pk2(res[0], res[1]);
            }
            *(u32x4*)(gp + (size_t)rr * DFF) = (u32x4){ow[0], ow[1], ow[2], ow[3]};
            pg_ = cg_; pv_ = cv_; cg_ = ng_; cv_ = nv_;
        }
    }
}

constexpr int STEPS_PER_CHUNK = DEPTH * 6;
constexpr int NSTEPS = 1 + NCHUNK * STEPS_PER_CHUNK + 1;
__global__ void __launch_bounds__(NTHREADS, 2) mega_fwd(Args a) {
    extern __shared__ __attribute__((aligned(16))) unsigned char lds_raw[];
    LAS unsigned char* lds = (LAS unsigned char*)lds_raw;
    cg::grid_group grid = cg::this_grid();
    volatile LAS unsigned* bst = (volatile LAS unsigned*)(lds + 147456);
    if (threadIdx.x < 2) bst[threadIdx.x] = 0u;
    __syncthreads();
    XcdBarrier xbar = xcd_barrier_post((unsigned*)(a.ws + WS_CTL), bst);
#ifdef PROBE_P2
    for (int pass_ = 0; pass_ < 2; ++pass_)
#endif
    for (int step = 0; step < NSTEPS; ++step) {
        int tid_l = threadIdx.x, cu_l = blockIdx.x, G_l = gridDim.x;
        asm volatile("" : "+v"(tid_l)); asm volatile("" : "+s"(cu_l), "+s"(G_l));
        Ctx c; c.tid = tid_l; c.lane = c.tid & 63; c.wave = __builtin_amdgcn_readfirstlane(c.tid >> 6);
        c.G = G_l; c.cu = cu_l; c.gw = c.cu * 8 + c.wave; c.NGW = c.G * 8;
        unsigned char* ws = a.ws;
        if (step == 0) {
            ph_weights(a, lds, 0, c.gw, c.NGW, c.wave, c.lane); ph_weights(a, lds, 1, c.gw, c.NGW, c.wave, c.lane);
            const float* xin = chunk_in(a, 0); bf16_t* XB = (bf16_t*)(ws + WS_XB); float* S1 = (float*)(ws + WS_SSQ);
            for (int r = c.gw; r < CH_ROWS; r += c.NGW) row_to_bf16_ssq(xin + (size_t)r * DM, XB + (size_t)r * DM, S1 + r, c.lane);
        } else if (step == NSTEPS - 1) ph_final_norm(c, chunk_out(a, NCHUNK - 1), a.in[16]);
        else {
            const int s = step - 1, ch = s / STEPS_PER_CHUNK, sc = s % STEPS_PER_CHUNK, par = ch & 1;
            bf16_t* HB = (bf16_t*)(ws + WS_HB); bf16_t* XB = (bf16_t*)(ws + WS_XB) + (size_t)par * CH_ROWS * DM;
            float* S1 = (float*)(ws + WS_SSQ) + par * CH_ROWS; float* S2 = (float*)(ws + WS_SSQ) + 2 * CH_ROWS;
            float* xo = chunk_out(a, ch);
            {
                const int layer = sc / 6, ph = sc % 6;
                const float* xsrc = layer == 0 ? chunk_in(a, ch) : (const float*)xo;
                if (ph == 0) {
                    pg8::Gemm g{XB, (const bf16_t*)(ws + WS_WIN) + (size_t)layer * DIN * DM, CH_ROWS, DIN, DM}; pg8::StaticOrder S; S.init(CH_ROWS, DIN, c.G, c.cu);
                    pg8::EpiBf16S2 E{(bf16_t*)(ws + WS_PROJ), DIN, 1805u, QSCALE, S1};
#ifdef PROBE_G2
                    for (int rep_ = 0; rep_ < 2; ++rep_)
#endif
                    pg8::gemm_phase<pg8::EpiBf16S2, pg8::StaticOrder, true, true>(lds, g, S, E);
                    if (layer == 0 && ch > 0) {
                        const int nfull = (CH_ROWS / 256) * (DIN / 256) % c.G;
                        if (nfull > 0 && c.cu >= nfull) { float* xp = chunk_out(a, ch - 1); const int nw = (c.G - nfull) * 8;
                            for (int r = (c.cu - nfull) * 8 + c.wave; r < CH_ROWS; r += nw) rms_row_f32(xp + (size_t)r * DM, a.in[16], c.lane); }
                        else if (nfull == 0) ph_final_norm(c, chunk_out(a, ch - 1), a.in[16]);
                    }
                } else if (ph == 1) {
                    ph_attn(a, c, lds, ch, layer);
                } else if (ph == 2) {
                    ph_combine(a, c, layer);
                } else if (ph == 3) {
                    pg8::Gemm g{HB, (const bf16_t*)(ws + WS_WOUT) + (size_t)layer * DM * DM, CH_ROWS, DM, DM}; pg8::StaticOrder S; S.init(CH_ROWS, DM, c.G, c.cu);
                    bf16_t* XL = (bf16_t*)(ws + WS_PROJ + 140 * MiB);
                    pg8::EpiRes2 E{layer == 0 ? xsrc : (const float*)nullptr, XB, XL, (float*)nullptr, XB, XL, S2, DM};
                    pg8::gemm_phase<pg8::EpiRes2, pg8::StaticOrder, true, true>(lds, g, S, E);
                } else if (ph == 4) {
                    pg8::Gemm g{XB - DM, (const bf16_t*)(ws + WS_WUP) + (size_t)layer * DUP * DM, 65 * 256, DUP, DM, 254}; pg8::StaticOrder S; S.init(65 * 256, DUP, c.G, c.cu);
                    pg8::EpiConv E{(bf16_t*)(ws + WS_TMP), S2, a.in[13] + (size_t)layer * 3 * DUP, a.in[14] + (size_t)layer * DUP, (ch == 0 ? 16384 : 4096) - 1, (LAS float*)(lds + 147456 + 256), CH_ROWS};
                    pg8::gemm_phase<pg8::EpiConv, pg8::StaticOrder, true, true>(lds, g, S, E);
                    { float* S1z = S1; for (int r = c.cu * NTHREADS + c.tid; r < CH_ROWS; r += c.G * NTHREADS) S1z[r] = 0.f; }
                    if (layer == DEPTH - 1 && ch + 1 < NCHUNK) {
                        const float* xin = chunk_in(a, ch + 1); bf16_t* XBn = (bf16_t*)(ws + WS_XB) + (size_t)(par ^ 1) * CH_ROWS * DM; float* S1n = (float*)(ws + WS_SSQ) + (par ^ 1) * CH_ROWS;
                        for (int r = c.gw; r < CH_ROWS; r += c.NGW) row_to_bf16_ssq(xin + (size_t)r * DM, XBn + (size_t)r * DM, S1n + r, c.lane);
                    }
                } else {
                    pg8::Gemm g{(const bf16_t*)(ws + WS_TMP), (const bf16_t*)(ws + WS_WDN) + (size_t)layer * DM * DFF, CH_ROWS, DM, DFF}; pg8::StaticOrder S; S.init(CH_ROWS, DM, c.G, c.cu);
                    bf16_t* XL = (bf16_t*)(ws + WS_PROJ + 140 * MiB);
                    pg8::EpiRes2 E{(const float*)nullptr, XB, XL, layer == DEPTH - 1 ? xo : (float*)nullptr, XB, XL, S1, DM};
                    pg8::gemm_phase<pg8::EpiRes2, pg8::StaticOrder, true, true>(lds, g, S, E);
                }
            }
        }
#ifdef PROBE_P2
        if (step == 0) grid.sync(); else xcd_barrier(xbar);
#else
        if (step == 0) grid.sync(); else if (step != NSTEPS - 1) xcd_barrier(xbar);
#endif
    }
#ifdef PROBE_TA
    if (blockIdx.x == 0 && threadIdx.x < 64) {
        float* xo = chunk_out(a, NCHUNK - 1);
        const float ua = (float)tA_ * 0.01f, ub = (float)tB_ * 0.01f;
        if (threadIdx.x == 0) xo[0] += 8.f + ua * 0.01f; else xo[4 * threadIdx.x] += sqrtf(ub * 0.01f);
    }
#endif
}

extern "C" void kernel_launch(void* const* d_in, const int* in_sizes, int n_in, void* d_out, int out_size, void* d_ws, size_t ws_size, hipStream_t stream) {
    static int grid = 0;
    if (grid == 0) {
        if (n_in != 17 || ws_size < WS_END) { fprintf(stderr, "kernel_launch: unexpected n_in %d / ws_size %zu (need %zu)\n", n_in, ws_size, (size_t)WS_END); grid = -1; return; }
        int dev = 0, cus = 0, per_cu = 0;
        (void)hipGetDevice(&dev); (void)hipDeviceGetAttribute(&cus, hipDeviceAttributeMultiprocessorCount, dev);
        if (hipFuncSetAttribute((const void*)mega_fwd, hipFuncAttributeMaxDynamicSharedMemorySize, LDS_BYTES) != hipSuccess) { fprintf(stderr, "hipFuncSetAttribute failed\n"); grid = -1; return; }
        if (hipOccupancyMaxActiveBlocksPerMultiprocessor(&per_cu, (const void*)mega_fwd, NTHREADS, LDS_BYTES) != hipSuccess || per_cu < 1) { fprintf(stderr, "occupancy query: %d\n", per_cu); per_cu = 1; }
        (void)hipGetLastError();
        grid = cus * 1;
    }
    if (grid < 0) return;
    (void)hipMemsetAsync((char*)d_ws + WS_CTL, 0, 65536, stream);
    Args a{};
    for (int i = 0; i < 17; ++i) a.in[i] = (const float*)d_in[i];
    a.out = (float*)d_out; a.ws = (unsigned char*)d_ws;
    void* args[] = {&a};
    hipError_t e = hipLaunchCooperativeKernel((const void*)mega_fwd, dim3(grid), dim3(NTHREADS), args, LDS_BYTES, stream);
    if (e != hipSuccess) fprintf(stderr, "cooperative launch failed: %s (grid %d)\n", hipGetErrorString(e), grid);
}
```
